# Optimizing an MI355X kernel written in HIP

```python
import math
import jax, jax.numpy as jnp
from jax import lax
import numpy as np

D_MODEL = 1024
BATCH = 8
SEQ = 4096
DEPTH = 1

N_META = 16
MIX_WIDTH = D_MODEL
ATTN_WIDTH = MIX_WIDTH // 2
CONV_WIDTH = MIX_WIDTH - ATTN_WIDTH
N_ATTN_HEADS = 4
DIFF_HEAD_DIM = ATTN_WIDTH // (2 * N_ATTN_HEADS)
V_HEAD_DIM = 2 * DIFF_HEAD_DIM
CONV_KERNEL = 31
N_CONV_GROUPS = 8
CONV_GROUP_DIM = CONV_WIDTH // N_CONV_GROUPS
Q_BLOCK = 128
PEER_HEADS = 8
PEER_KEYS = 128
PEER_EXPERTS = PEER_KEYS * PEER_KEYS
PEER_QUERY_DIM = 256
PEER_HALF = PEER_QUERY_DIM // 2
PEER_TOPK = 16
PEER_CHUNK = 128
NORM_EPS = 1e-6
IN_COLS = 3 * ATTN_WIDTH + 2 * CONV_WIDTH

kernel_name = "hymba_diffattn_conformer_peer_block"


def lambda_init_for(layer):
    return 0.8 - 0.6 * math.exp(-0.3 * layer)


def alibi_slopes(n_heads):
    return jnp.asarray(np.array([2.0 ** (-8.0 * (i + 1) / n_heads) for i in range(n_heads)], dtype=np.float32))


def rms_norm(x, g):
    xf = x.astype(jnp.float32)
    y = xf * lax.rsqrt(jnp.mean(xf * xf, axis=-1, keepdims=True) + NORM_EPS)
    return (y * g.astype(jnp.float32)).astype(x.dtype)


def diff_attention(q, k, v, lam, lam_init, sub_g, slopes):
    B, Lp = q.shape[0], q.shape[1]
    n_blocks = Lp // Q_BLOCK
    scale = DIFF_HEAD_DIM ** -0.5
    k_pos = jnp.arange(Lp)

    def block(i):
        start = i * Q_BLOCK
        qb = lax.dynamic_slice_in_dim(q, start, Q_BLOCK, axis=1)
        s = jnp.einsum('bqhcd,bkhcd->bhcqk', qb, k).astype(jnp.float32) * scale
        dist = (start + jnp.arange(Q_BLOCK))[:, None] - k_pos[None, :]
        bias = jnp.where(dist[None] >= 0,
                         -slopes[:, None, None] * dist[None].astype(jnp.float32),
                         -jnp.inf)
        p = jax.nn.softmax(s + bias[None, :, None], axis=-1)
        a = p[:, :, 0] - lam * p[:, :, 1]
        return jnp.einsum('bhqk,bkhd->bqhd', a.astype(v.dtype), v)

    out = lax.map(block, jnp.arange(n_blocks))
    out = jnp.moveaxis(out, 0, 1).reshape(B, Lp, N_ATTN_HEADS, V_HEAD_DIM)
    out = rms_norm(out, sub_g) * (1.0 - lam_init)
    return out.reshape(B, Lp, ATTN_WIDTH)


def conformer_conv(a, g, conv_w, conv_b, gn_g, gn_b):
    B, Lp, C = a.shape
    u = a * jax.nn.sigmoid(g)
    y = lax.conv_general_dilated(u, conv_w[:, None, :], window_strides=(1,),
                                 padding=[(CONV_KERNEL - 1, 0)],
                                 dimension_numbers=('NWC', 'WIO', 'NWC'),
                                 feature_group_count=C) + conv_b
    yg = y.reshape(B, Lp, N_CONV_GROUPS, CONV_GROUP_DIM).astype(jnp.float32)
    mu = jnp.mean(yg, axis=-1, keepdims=True)
    var = jnp.mean(jnp.square(yg - mu), axis=-1, keepdims=True)
    yn = ((yg - mu) * lax.rsqrt(var + NORM_EPS)).reshape(B, Lp, C)
    yn = yn * gn_g.astype(jnp.float32) + gn_b.astype(jnp.float32)
    return jax.nn.silu(yn).astype(a.dtype)


def peer_ffn(xn, wq, subkeys, u_tab, v_tab):
    T = xn.shape[0]
    xc = xn.reshape(T // PEER_CHUNK, PEER_CHUNK, D_MODEL)

    def chunk(xt):
        q = (xt @ wq).reshape(PEER_CHUNK, PEER_HEADS, 2, PEER_HALF)
        s = jnp.einsum('thpk,hpnk->thpn', q, subkeys).astype(jnp.float32)
        s_top, i_top = lax.top_k(s, PEER_TOPK)
        cand = s_top[:, :, 0, :, None] + s_top[:, :, 1, None, :]
        cand = cand.reshape(PEER_CHUNK, PEER_HEADS, PEER_TOPK * PEER_TOPK)
        c_top, c_idx = lax.top_k(cand, PEER_TOPK)
        i1 = jnp.take_along_axis(i_top[:, :, 0, :], c_idx // PEER_TOPK, axis=-1)
        i2 = jnp.take_along_axis(i_top[:, :, 1, :], c_idx % PEER_TOPK, axis=-1)
        e = i1 * PEER_KEYS + i2
        gate = jax.nn.softmax(c_top, axis=-1)
        act = jax.nn.gelu(jnp.einsum('thkd,td->thk', u_tab[e], xt).astype(jnp.float32), approximate=False)
        w = (gate * act).astype(xt.dtype)
        return jnp.einsum('thk,thkd->td', w, v_tab[e])

    return lax.map(chunk, xc).reshape(T, D_MODEL)


def setup_inputs(seed: int = 0) -> dict:
    key = jax.random.key(seed)
    ks = jax.random.split(key, 24)
    f32 = jnp.float32
    nrm = lambda k, shape, s: jax.random.normal(k, shape, f32) * s
    return {
        "x": nrm(ks[0], (BATCH, SEQ, D_MODEL), 1.0),
        "meta_tokens": nrm(ks[1], (N_META, D_MODEL), 1.0),
        "norm1_g": 1.0 + nrm(ks[2], (DEPTH, D_MODEL), 0.02),
        "w_in": nrm(ks[3], (DEPTH, D_MODEL, IN_COLS), D_MODEL ** -0.5),
        "lambda_q1": nrm(ks[4], (DEPTH, DIFF_HEAD_DIM), 0.1),
        "lambda_k1": nrm(ks[5], (DEPTH, DIFF_HEAD_DIM), 0.1),
        "lambda_q2": nrm(ks[6], (DEPTH, DIFF_HEAD_DIM), 0.1),
        "lambda_k2": nrm(ks[7], (DEPTH, DIFF_HEAD_DIM), 0.1),
        "attn_subln_g": 1.0 + nrm(ks[8], (DEPTH, V_HEAD_DIM), 0.02),
        "conv_w": nrm(ks[9], (DEPTH, CONV_KERNEL, CONV_WIDTH), CONV_KERNEL ** -0.5),
        "conv_b": nrm(ks[10], (DEPTH, CONV_WIDTH), 0.02),
        "conv_norm_g": 1.0 + nrm(ks[11], (DEPTH, CONV_WIDTH), 0.02),
        "conv_norm_b": nrm(ks[12], (DEPTH, CONV_WIDTH), 0.02),
        "w_out": nrm(ks[13], (DEPTH, MIX_WIDTH, D_MODEL), MIX_WIDTH ** -0.5),
        "norm2_g": 1.0 + nrm(ks[14], (DEPTH, D_MODEL), 0.02),
        "peer_wq": nrm(ks[15], (DEPTH, D_MODEL, PEER_HEADS * PEER_QUERY_DIM), D_MODEL ** -0.5),
        "peer_subkeys": nrm(ks[16], (DEPTH, PEER_HEADS, 2, PEER_KEYS, PEER_HALF), PEER_HALF ** -0.5),
        "peer_u": nrm(ks[17], (DEPTH, PEER_EXPERTS, D_MODEL), D_MODEL ** -0.5),
        "peer_v": nrm(ks[18], (DEPTH, PEER_EXPERTS, D_MODEL), PEER_HEADS ** -0.5),
        "final_norm_g": 1.0 + nrm(ks[19], (D_MODEL,), 0.02),
    }


def reference(x, meta_tokens, norm1_g, w_in, lambda_q1, lambda_k1, lambda_q2, lambda_k2,
              attn_subln_g, conv_w, conv_b, conv_norm_g, conv_norm_b, w_out, norm2_g,
              peer_wq, peer_subkeys, peer_u, peer_v, final_norm_g):
    B, S = x.shape[0], x.shape[1]
    L = N_META + S
    Lp = ((L + Q_BLOCK - 1) // Q_BLOCK) * Q_BLOCK
    meta = jnp.broadcast_to(meta_tokens[None].astype(x.dtype), (B, N_META, D_MODEL))
    h = jnp.concatenate([meta, x], axis=1)
    h = jnp.pad(h, ((0, 0), (0, Lp - L), (0, 0)))
    slopes = alibi_slopes(N_ATTN_HEADS)

    for l in range(DEPTH):
        lam_init = lambda_init_for(l)
        xn = rms_norm(h, norm1_g[l])
        proj = xn @ w_in[l]
        q, k, v, ga, gg = jnp.split(
            proj, [ATTN_WIDTH, 2 * ATTN_WIDTH, 3 * ATTN_WIDTH, 3 * ATTN_WIDTH + CONV_WIDTH], axis=-1)
        q = q.reshape(B, Lp, N_ATTN_HEADS, 2, DIFF_HEAD_DIM)
        k = k.reshape(B, Lp, N_ATTN_HEADS, 2, DIFF_HEAD_DIM)
        v = v.reshape(B, Lp, N_ATTN_HEADS, V_HEAD_DIM)
        lam = (jnp.exp(jnp.sum(lambda_q1[l].astype(jnp.float32) * lambda_k1[l].astype(jnp.float32)))
               - jnp.exp(jnp.sum(lambda_q2[l].astype(jnp.float32) * lambda_k2[l].astype(jnp.float32)))
               + lam_init)
        attn_out = diff_attention(q, k, v, lam, lam_init, attn_subln_g[l], slopes)
        conv_out = conformer_conv(ga, gg, conv_w[l], conv_b[l], conv_norm_g[l], conv_norm_b[l])
        h = h + jnp.concatenate([attn_out, conv_out], axis=-1) @ w_out[l]

        xn2 = rms_norm(h, norm2_g[l])
        ffn = peer_ffn(xn2.reshape(B * Lp, D_MODEL), peer_wq[l], peer_subkeys[l], peer_u[l], peer_v[l])
        h = h + ffn.reshape(B, Lp, D_MODEL)

    h = rms_norm(h, final_norm_g)
    return h[:, N_META:N_META + S]
```

```cpp
#include <hip/hip_runtime.h>
#include <stdint.h>
#include <math.h>

typedef unsigned short bf16_t;

constexpr int D = 1024, BATCH = 8, SEQ = 4096, NMETA = 16, LREAL = NMETA + SEQ  , LP = 4224, ROWS = BATCH * LP;
constexpr int INC = 2560;
constexpr float EPS = 1e-6f;
constexpr float LAM_INIT = 0.2f;

__device__ __forceinline__ float bf2f(unsigned v) { return __uint_as_float(v << 16); }
__device__ __forceinline__ bf16_t f2bf(float f) { unsigned u = __float_as_uint(f); u += 0x7fffu + ((u >> 16) & 1u); return (bf16_t)(u >> 16); }
__device__ __forceinline__ unsigned pack2(float a, float b) { return (unsigned)f2bf(a) | ((unsigned)f2bf(b) << 16); }

__device__ __forceinline__ float wave_sum(float v) {
#pragma unroll
  for (int o = 32; o >= 1; o >>= 1) v += __shfl_xor(v, o);
  return v;
}
__device__ __forceinline__ float wave_max(float v) {
#pragma unroll
  for (int o = 32; o >= 1; o >>= 1) v = fmaxf(v, __shfl_xor(v, o));
  return v;
}

__device__ __forceinline__ const float* hrow_ptr(const float* x, const float* meta, int row) {
  int b = row / LP, pos = row - b * LP;
  if (pos < NMETA) return meta + (size_t)pos * D;
  if (pos < LREAL) return x + ((size_t)b * SEQ + (pos - NMETA)) * D;
  return nullptr;
}

__global__ void __launch_bounds__(256) k_norm1(const float* x, const float* meta, const float* g1, bf16_t* xn1,
                                               const float* lq1, const float* lk1, const float* lq2, const float* lk2, float* scal) {
  __shared__ float red[4];
  int row = blockIdx.x, tid = threadIdx.x;
  const float* src = hrow_ptr(x, meta, row);
  float4 v = src ? ((const float4*)src)[tid] : make_float4(0.f, 0.f, 0.f, 0.f);
  float ss = v.x * v.x + v.y * v.y + v.z * v.z + v.w * v.w;
  ss = wave_sum(ss);
  if ((tid & 63) == 0) red[tid >> 6] = ss;
  __syncthreads();
  float tot = red[0] + red[1] + red[2] + red[3];
  float rstd = rsqrtf(tot * (1.0f / D) + EPS);
  float4 g = ((const float4*)g1)[tid];
  uint2 o; o.x = pack2(v.x * rstd * g.x, v.y * rstd * g.y); o.y = pack2(v.z * rstd * g.z, v.w * rstd * g.w);
  ((uint2*)(xn1 + (size_t)row * D))[tid] = o;
  if (row == 0 && tid < 64) {
    float a = lq1[tid] * lk1[tid], b2 = lq2[tid] * lk2[tid];
    a = wave_sum(a); b2 = wave_sum(b2);
    if (tid == 0) scal[0] = expf(a) - expf(b2) + LAM_INIT;
  }
}

template <class Epi>
__global__ void __launch_bounds__(256) k_gemm_naive(const bf16_t* __restrict__ A, const float* __restrict__ W, int N, int K, Epi epi) {
  __shared__ float As[16][68];
  __shared__ float Bs[16][68];
  int tid = threadIdx.x, tx = tid & 15, ty = tid >> 4;
  int m0 = blockIdx.y * 64, n0 = blockIdx.x * 64;
  float acc[4][4];
#pragma unroll
  for (int i = 0; i < 4; ++i)
#pragma unroll
    for (int j = 0; j < 4; ++j) acc[i][j] = 0.f;
  for (int k0 = 0; k0 < K; k0 += 16) {
    {
      int r = tid >> 2, kk = (tid & 3) * 4;
      uint2 raw = *(const uint2*)(A + (size_t)(m0 + r) * K + k0 + kk);
      As[kk + 0][r] = bf2f(raw.x & 0xffffu); As[kk + 1][r] = bf2f(raw.x >> 16);
      As[kk + 2][r] = bf2f(raw.y & 0xffffu); As[kk + 3][r] = bf2f(raw.y >> 16);
    }
    {
      int kk = tid >> 4, n = (tid & 15) * 4;
      float4 w = *(const float4*)(W + (size_t)(k0 + kk) * N + n0 + n);
      Bs[kk][n] = w.x; Bs[kk][n + 1] = w.y; Bs[kk][n + 2] = w.z; Bs[kk][n + 3] = w.w;
    }
    __syncthreads();
#pragma unroll
    for (int kk = 0; kk < 16; ++kk) {
      float a[4], b[4];
#pragma unroll
      for (int i = 0; i < 4; ++i) { a[i] = As[kk][ty * 4 + i]; b[i] = Bs[kk][tx * 4 + i]; }
#pragma unroll
      for (int i = 0; i < 4; ++i)
#pragma unroll
        for (int j = 0; j < 4; ++j) acc[i][j] += a[i] * b[j];
    }
    __syncthreads();
  }
#pragma unroll
  for (int i = 0; i < 4; ++i)
#pragma unroll
    for (int j = 0; j < 4; ++j) epi(m0 + ty * 4 + i, n0 + tx * 4 + j, acc[i][j]);
}

struct EpiStoreBf16 { bf16_t* out; int ld; int pad; __device__ void operator()(int r, int c, float v) const { out[(size_t)r * ld + c] = f2bf(v); } };
struct EpiResid { const float* x; const float* meta; float* h2; __device__ void operator()(int r, int c, float v) const {
  const float* src = hrow_ptr(x, meta, r); float hv = src ? src[c] : 0.f; h2[(size_t)r * D + c] = hv + v; } };

__global__ void __launch_bounds__(256) k_attn_naive(const bf16_t* __restrict__ proj, bf16_t* mix, const float* subg, const float* scal) {
  int gid = blockIdx.x * 256 + threadIdx.x;
  int dvq = gid & 3, qidx = gid >> 2;
  int pos = qidx % LP, h = (qidx / LP) & 3, b = qidx / (LP * 4);
  if (b >= BATCH) return;
  size_t row = (size_t)b * LP + pos;
  bf16_t* outp = mix + row * D + h * 128 + dvq * 32;
  if (pos >= LREAL) {
#pragma unroll
    for (int i = 0; i < 4; ++i) ((uint4*)outp)[i] = make_uint4(0, 0, 0, 0);
    return;
  }
  const float slope = exp2f(-2.0f * (float)(h + 1));
  const float lam = scal[0];
  float q[128];
  {
    const uint4* qp = (const uint4*)(proj + row * INC + h * 128);
#pragma unroll
    for (int i = 0; i < 16; ++i) {
      uint4 r = qp[i];
      q[i * 8 + 0] = bf2f(r.x & 0xffffu) * 0.125f; q[i * 8 + 1] = bf2f(r.x >> 16) * 0.125f;
      q[i * 8 + 2] = bf2f(r.y & 0xffffu) * 0.125f; q[i * 8 + 3] = bf2f(r.y >> 16) * 0.125f;
      q[i * 8 + 4] = bf2f(r.z & 0xffffu) * 0.125f; q[i * 8 + 5] = bf2f(r.z >> 16) * 0.125f;
      q[i * 8 + 6] = bf2f(r.w & 0xffffu) * 0.125f; q[i * 8 + 7] = bf2f(r.w >> 16) * 0.125f;
    }
  }
  float o1[32], o2[32];
#pragma unroll
  for (int i = 0; i < 32; ++i) { o1[i] = 0.f; o2[i] = 0.f; }
  float m1 = -1e30f, m2 = -1e30f, l1 = 0.f, l2 = 0.f;
  for (int kp = 0; kp <= pos; ++kp) {
    const bf16_t* kr = proj + ((size_t)b * LP + kp) * INC;
    const uint4* kq = (const uint4*)(kr + 512 + h * 128);
    float s1 = 0.f, s2 = 0.f;
#pragma unroll
    for (int i = 0; i < 8; ++i) {
      uint4 r = kq[i];
      s1 += q[i * 8 + 0] * bf2f(r.x & 0xffffu) + q[i * 8 + 1] * bf2f(r.x >> 16) + q[i * 8 + 2] * bf2f(r.y & 0xffffu) + q[i * 8 + 3] * bf2f(r.y >> 16)
          + q[i * 8 + 4] * bf2f(r.z & 0xffffu) + q[i * 8 + 5] * bf2f(r.z >> 16) + q[i * 8 + 6] * bf2f(r.w & 0xffffu) + q[i * 8 + 7] * bf2f(r.w >> 16);
    }
#pragma unroll
    for (int i = 8; i < 16; ++i) {
      uint4 r = kq[i];
      s2 += q[i * 8 + 0] * bf2f(r.x & 0xffffu) + q[i * 8 + 1] * bf2f(r.x >> 16) + q[i * 8 + 2] * bf2f(r.y & 0xffffu) + q[i * 8 + 3] * bf2f(r.y >> 16)
          + q[i * 8 + 4] * bf2f(r.z & 0xffffu) + q[i * 8 + 5] * bf2f(r.z >> 16) + q[i * 8 + 6] * bf2f(r.w & 0xffffu) + q[i * 8 + 7] * bf2f(r.w >> 16);
    }
    float bias = -slope * (float)(pos - kp);
    s1 += bias; s2 += bias;
    float mn1 = fmaxf(m1, s1), mn2 = fmaxf(m2, s2);
    float a1 = __expf(m1 - mn1), a2 = __expf(m2 - mn2);
    float p1 = __expf(s1 - mn1), p2 = __expf(s2 - mn2);
    m1 = mn1; m2 = mn2;
    l1 = l1 * a1 + p1; l2 = l2 * a2 + p2;
    const uint4* vq = (const uint4*)(kr + 1024 + h * 128 + dvq * 32);
#pragma unroll
    for (int i = 0; i < 4; ++i) {
      uint4 r = vq[i];
      float v0 = bf2f(r.x & 0xffffu), v1 = bf2f(r.x >> 16), v2 = bf2f(r.y & 0xffffu), v3 = bf2f(r.y >> 16);
      float v4 = bf2f(r.z & 0xffffu), v5 = bf2f(r.z >> 16), v6 = bf2f(r.w & 0xffffu), v7 = bf2f(r.w >> 16);
      o1[i * 8 + 0] = o1[i * 8 + 0] * a1 + p1 * v0; o2[i * 8 + 0] = o2[i * 8 + 0] * a2 + p2 * v0;
      o1[i * 8 + 1] = o1[i * 8 + 1] * a1 + p1 * v1; o2[i * 8 + 1] = o2[i * 8 + 1] * a2 + p2 * v1;
      o1[i * 8 + 2] = o1[i * 8 + 2] * a1 + p1 * v2; o2[i * 8 + 2] = o2[i * 8 + 2] * a2 + p2 * v2;
      o1[i * 8 + 3] = o1[i * 8 + 3] * a1 + p1 * v3; o2[i * 8 + 3] = o2[i * 8 + 3] * a2 + p2 * v3;
      o1[i * 8 + 4] = o1[i * 8 + 4] * a1 + p1 * v4; o2[i * 8 + 4] = o2[i * 8 + 4] * a2 + p2 * v4;
      o1[i * 8 + 5] = o1[i * 8 + 5] * a1 + p1 * v5; o2[i * 8 + 5] = o2[i * 8 + 5] * a2 + p2 * v5;
      o1[i * 8 + 6] = o1[i * 8 + 6] * a1 + p1 * v6; o2[i * 8 + 6] = o2[i * 8 + 6] * a2 + p2 * v6;
      o1[i * 8 + 7] = o1[i * 8 + 7] * a1 + p1 * v7; o2[i * 8 + 7] = o2[i * 8 + 7] * a2 + p2 * v7;
    }
  }
  float il1 = 1.0f / l1, il2 = lam / l2;
  float ss = 0.f;
#pragma unroll
  for (int i = 0; i < 32; ++i) { o1[i] = o1[i] * il1 - o2[i] * il2; ss += o1[i] * o1[i]; }
  ss += __shfl_xor(ss, 1); ss += __shfl_xor(ss, 2);
  float rstd = rsqrtf(ss * (1.0f / 128.0f) + EPS) * (1.0f - LAM_INIT);
#pragma unroll
  for (int i = 0; i < 4; ++i) {
    uint4 w;
    const float* g = subg + dvq * 32 + i * 8;
    w.x = pack2(o1[i * 8 + 0] * rstd * g[0], o1[i * 8 + 1] * rstd * g[1]);
    w.y = pack2(o1[i * 8 + 2] * rstd * g[2], o1[i * 8 + 3] * rstd * g[3]);
    w.z = pack2(o1[i * 8 + 4] * rstd * g[4], o1[i * 8 + 5] * rstd * g[5]);
    w.w = pack2(o1[i * 8 + 6] * rstd * g[6], o1[i * 8 + 7] * rstd * g[7]);
    ((uint4*)outp)[i] = w;
  }
}

__global__ void __launch_bounds__(256) k_conv_naive(const bf16_t* __restrict__ proj, bf16_t* mix, const float* cw, const float* cb, const float* gg_, const float* gb_) {
  int row = blockIdx.x, tid = threadIdx.x;
  int b = row / LP, pos = row - b * LP;
  int c0 = tid * 2;
  unsigned* outp = (unsigned*)(mix + (size_t)row * D + 512 + c0);
  if (pos >= LREAL) { *outp = 0u; return; }
  float y0 = cb[c0], y1 = cb[c0 + 1];
  for (int j = 0; j < 31; ++j) {
    int p = pos - 30 + j;
    if (p < 0) continue;
    const bf16_t* pr = proj + ((size_t)b * LP + p) * INC;
    unsigned a = *(const unsigned*)(pr + 1536 + c0), g = *(const unsigned*)(pr + 2048 + c0);
    float a0 = bf2f(a & 0xffffu), a1 = bf2f(a >> 16), g0 = bf2f(g & 0xffffu), g1 = bf2f(g >> 16);
    float u0 = a0 / (1.0f + __expf(-g0)), u1 = a1 / (1.0f + __expf(-g1));
    y0 += cw[j * 512 + c0] * u0; y1 += cw[j * 512 + c0 + 1] * u1;
  }
  float s = y0 + y1;
#pragma unroll
  for (int o = 16; o >= 1; o >>= 1) s += __shfl_xor(s, o);
  float mu = s * (1.0f / 64.0f);
  float d0 = y0 - mu, d1 = y1 - mu;
  float v = d0 * d0 + d1 * d1;
#pragma unroll
  for (int o = 16; o >= 1; o >>= 1) v += __shfl_xor(v, o);
  float rstd = rsqrtf(v * (1.0f / 64.0f) + EPS);
  float n0 = d0 * rstd * gg_[c0] + gb_[c0], n1 = d1 * rstd * gg_[c0 + 1] + gb_[c0 + 1];
  float r0 = n0 / (1.0f + __expf(-n0)), r1 = n1 / (1.0f + __expf(-n1));
  *outp = pack2(r0, r1);
}

__global__ void __launch_bounds__(256) k_norm2(const float* h2, const float* g2, bf16_t* xn2) {
  __shared__ float red[4];
  int row = blockIdx.x, tid = threadIdx.x;
  float4 v = ((const float4*)(h2 + (size_t)row * D))[tid];
  float ss = v.x * v.x + v.y * v.y + v.z * v.z + v.w * v.w;
  ss = wave_sum(ss);
  if ((tid & 63) == 0) red[tid >> 6] = ss;
  __syncthreads();
  float tot = red[0] + red[1] + red[2] + red[3];
  float rstd = rsqrtf(tot * (1.0f / D) + EPS);
  float4 g = ((const float4*)g2)[tid];
  uint2 o; o.x = pack2(v.x * rstd * g.x, v.y * rstd * g.y); o.y = pack2(v.z * rstd * g.z, v.w * rstd * g.w);
  ((uint2*)(xn2 + (size_t)row * D))[tid] = o;
}

__global__ void __launch_bounds__(256) k_topk_naive(const bf16_t* __restrict__ qp, const float* __restrict__ sk, int* eb, float* gb) {
  int w = blockIdx.x * 4 + (threadIdx.x >> 6), lane = threadIdx.x & 63;
  int row = w >> 3, h = w & 7;
  int pos = row % LP;
  if (pos < NMETA || pos >= LREAL) return;
  const float NEG = -3.0e38f;
  float top[2];
#pragma unroll
  for (int p = 0; p < 2; ++p) {
    const bf16_t* qv = qp + (size_t)row * 2048 + h * 256 + p * 128;
    const float* k0 = sk + ((size_t)(h * 2 + p) * 128 + lane) * 128;
    const float* k1 = k0 + 64 * 128;
    float s0 = 0.f, s1 = 0.f;
    for (int d = 0; d < 128; d += 8) {
      uint4 r = *(const uint4*)(qv + d);
      float qf[8] = {bf2f(r.x & 0xffffu), bf2f(r.x >> 16), bf2f(r.y & 0xffffu), bf2f(r.y >> 16), bf2f(r.z & 0xffffu), bf2f(r.z >> 16), bf2f(r.w & 0xffffu), bf2f(r.w >> 16)};
      float4 a0 = *(const float4*)(k0 + d), a1 = *(const float4*)(k0 + d + 4), b0 = *(const float4*)(k1 + d), b1 = *(const float4*)(k1 + d + 4);
      s0 += qf[0] * a0.x + qf[1] * a0.y + qf[2] * a0.z + qf[3] * a0.w + qf[4] * a1.x + qf[5] * a1.y + qf[6] * a1.z + qf[7] * a1.w;
      s1 += qf[0] * b0.x + qf[1] * b0.y + qf[2] * b0.z + qf[3] * b0.w + qf[4] * b1.x + qf[5] * b1.y + qf[6] * b1.z + qf[7] * b1.w;
    }
    float v0 = __uint_as_float((__float_as_uint(s0) & ~127u) | (unsigned)lane);
    float v1 = __uint_as_float((__float_as_uint(s1) & ~127u) | (unsigned)(lane + 64));
    float t = NEG;
    for (int it = 0; it < 16; ++it) {
      float m = wave_max(fmaxf(v0, v1));
      if (lane == it) t = m;
      if (v0 == m) v0 = NEG;
      if (v1 == m) v1 = NEG;
    }
    top[p] = t;
  }
  int ci = lane >> 2, jb = (lane & 3) * 4;
  float av = __uint_as_float(__float_as_uint(__shfl(top[0], ci)) & ~127u);
  float c[4];
#pragma unroll
  for (int jj = 0; jj < 4; ++jj) {
    float bv = __uint_as_float(__float_as_uint(__shfl(top[1], jb + jj)) & ~127u);
    float s = av + bv;
    c[jj] = __uint_as_float((__float_as_uint(s) & ~255u) | (unsigned)(ci * 16 + jb + jj));
  }
  float ct = NEG;
  for (int it = 0; it < 16; ++it) {
    float m = wave_max(fmaxf(fmaxf(c[0], c[1]), fmaxf(c[2], c[3])));
    if (lane == it) ct = m;
#pragma unroll
    for (int jj = 0; jj < 4; ++jj) if (c[jj] == m) c[jj] = NEG;
  }
  unsigned cbits = __float_as_uint(ct);
  int cidx = cbits & 255u;
  float cval = __uint_as_float(cbits & ~255u);
  int i1 = __float_as_uint(__shfl(top[0], (cidx >> 4) & 15)) & 127u;
  int i2 = __float_as_uint(__shfl(top[1], cidx & 15)) & 127u;
  float mx = __shfl(cval, 0);
  float ex = lane < 16 ? __expf(cval - mx) : 0.f;
  float sum = wave_sum(ex);
  if (lane < 16) {
    eb[((size_t)row * 8 + h) * 16 + lane] = i1 * 128 + i2;
    gb[((size_t)row * 8 + h) * 16 + lane] = ex / sum;
  }
}

__global__ void __launch_bounds__(256) k_gather_naive(const bf16_t* __restrict__ xn2, const float* __restrict__ h2, const int* __restrict__ eb, const float* __restrict__ gb,
                                                      const float* __restrict__ ut, const float* __restrict__ vt, const float* fg, float* out) {
  int tk = blockIdx.x * 4 + (threadIdx.x >> 6), lane = threadIdx.x & 63;
  int b = tk / SEQ, s = tk - b * SEQ;
  size_t row = (size_t)b * LP + NMETA + s;
  float xv[16];
  {
    const uint4* xp = (const uint4*)(xn2 + row * D + lane * 16);
#pragma unroll
    for (int i = 0; i < 2; ++i) {
      uint4 r = xp[i];
      xv[i * 8 + 0] = bf2f(r.x & 0xffffu); xv[i * 8 + 1] = bf2f(r.x >> 16); xv[i * 8 + 2] = bf2f(r.y & 0xffffu); xv[i * 8 + 3] = bf2f(r.y >> 16);
      xv[i * 8 + 4] = bf2f(r.z & 0xffffu); xv[i * 8 + 5] = bf2f(r.z >> 16); xv[i * 8 + 6] = bf2f(r.w & 0xffffu); xv[i * 8 + 7] = bf2f(r.w >> 16);
    }
  }
  float acc[16];
#pragma unroll
  for (int i = 0; i < 16; ++i) acc[i] = 0.f;
  for (int k = 0; k < 128; ++k) {
    int e = eb[row * 128 + k];
    float gate = gb[row * 128 + k];
    const float4* up = (const float4*)(ut + (size_t)e * D + lane * 16);
    float dsum = 0.f;
#pragma unroll
    for (int i = 0; i < 4; ++i) { float4 u = up[i]; dsum += u.x * xv[i * 4] + u.y * xv[i * 4 + 1] + u.z * xv[i * 4 + 2] + u.w * xv[i * 4 + 3]; }
    dsum = wave_sum(dsum);
    float act = 0.5f * dsum * (1.0f + erff(dsum * 0.70710678118654752f));
    float wgt = gate * act;
    const float4* vp = (const float4*)(vt + (size_t)e * D + lane * 16);
#pragma unroll
    for (int i = 0; i < 4; ++i) { float4 v = vp[i]; acc[i * 4] += wgt * v.x; acc[i * 4 + 1] += wgt * v.y; acc[i * 4 + 2] += wgt * v.z; acc[i * 4 + 3] += wgt * v.w; }
  }
  const float4* hp = (const float4*)(h2 + row * D + lane * 16);
  float ss = 0.f;
#pragma unroll
  for (int i = 0; i < 4; ++i) { float4 hv = hp[i]; acc[i * 4] += hv.x; acc[i * 4 + 1] += hv.y; acc[i * 4 + 2] += hv.z; acc[i * 4 + 3] += hv.w; }
#pragma unroll
  for (int i = 0; i < 16; ++i) ss += acc[i] * acc[i];
  ss = wave_sum(ss);
  float rstd = rsqrtf(ss * (1.0f / D) + EPS);
  float4* op = (float4*)(out + ((size_t)b * SEQ + s) * D + lane * 16);
  const float4* gp = (const float4*)(fg + lane * 16);
#pragma unroll
  for (int i = 0; i < 4; ++i) { float4 g = gp[i]; op[i] = make_float4(acc[i * 4] * rstd * g.x, acc[i * 4 + 1] * rstd * g.y, acc[i * 4 + 2] * rstd * g.z, acc[i * 4 + 3] * rstd * g.w); }
}

extern "C" void kernel_launch(void* const* d_in, const int* in_sizes, int n_in, void* d_out, int out_size, void* d_ws, size_t ws_size, hipStream_t stream) {
  const float* x = (const float*)d_in[0];
  const float* meta = (const float*)d_in[1];
  const float* g1 = (const float*)d_in[2];
  const float* w_in = (const float*)d_in[3];
  const float* lq1 = (const float*)d_in[4];
  const float* lk1 = (const float*)d_in[5];
  const float* lq2 = (const float*)d_in[6];
  const float* lk2 = (const float*)d_in[7];
  const float* subg = (const float*)d_in[8];
  const float* conv_w = (const float*)d_in[9];
  const float* conv_b = (const float*)d_in[10];
  const float* gn_g = (const float*)d_in[11];
  const float* gn_b = (const float*)d_in[12];
  const float* w_out = (const float*)d_in[13];
  const float* g2 = (const float*)d_in[14];
  const float* wq = (const float*)d_in[15];
  const float* sk = (const float*)d_in[16];
  const float* ut = (const float*)d_in[17];
  const float* vt = (const float*)d_in[18];
  const float* fg = (const float*)d_in[19];
  float* out = (float*)d_out;

  char* ws = (char*)d_ws;
  size_t off = 0;
  float* scal = (float*)(ws + off); off += 4096;
  bf16_t* r1 = (bf16_t*)(ws + off); off += (size_t)ROWS * D * 2;
  bf16_t* r2 = (bf16_t*)(ws + off); off += (size_t)ROWS * INC * 2;
  float* h2 = (float*)(ws + off); off += (size_t)ROWS * D * 4;
  bf16_t* xn1 = r1; bf16_t* mix = r1; bf16_t* xn2 = r1;
  bf16_t* proj = r2; bf16_t* qp = r2;
  int* eb = (int*)((char*)r2 + (size_t)ROWS * 2048 * 2);
  float* gb = (float*)((char*)eb + (size_t)ROWS * 128 * 4);

  k_norm1<<<ROWS, 256, 0, stream>>>(x, meta, g1, xn1, lq1, lk1, lq2, lk2, scal);
  k_gemm_naive<EpiStoreBf16><<<dim3(INC / 64, ROWS / 64), 256, 0, stream>>>(xn1, w_in, INC, D, EpiStoreBf16{proj, INC, 0});
  k_attn_naive<<<(BATCH * 4 * LP * 4) / 256, 256, 0, stream>>>(proj, mix, subg, scal);
  k_conv_naive<<<ROWS, 256, 0, stream>>>(proj, mix, conv_w, conv_b, gn_g, gn_b);
  k_gemm_naive<EpiResid><<<dim3(D / 64, ROWS / 64), 256, 0, stream>>>(mix, w_out, D, D, EpiResid{x, meta, h2});
  k_norm2<<<ROWS, 256, 0, stream>>>(h2, g2, xn2);
  k_gemm_naive<EpiStoreBf16><<<dim3(2048 / 64, ROWS / 64), 256, 0, stream>>>(xn2, wq, 2048, D, EpiStoreBf16{qp, 2048, 0});
  k_topk_naive<<<ROWS * 8 / 4, 256, 0, stream>>>(qp, sk, eb, gb);
  k_gather_naive<<<BATCH * SEQ / 4, 256, 0, stream>>>(xn2, h2, eb, gb, ut, vt, fg, out);
}
```

```cpp
#include <hip/hip_runtime.h>
#include <hip/hip_cooperative_groups.h>
#include <cstdio>
namespace cg = cooperative_groups;
#include <stdint.h>
#include <math.h>

typedef unsigned short bf16_t;

constexpr int D = 1024, BATCH = 8, SEQ = 4096, NMETA = 16, LREAL = NMETA + SEQ  , LP = 4224, ROWS = BATCH * LP;
constexpr int INC = 2560;
constexpr float EPS = 1e-6f;
constexpr float LAM_INIT = 0.2f;

__device__ __forceinline__ float bf2f(unsigned v) { return __uint_as_float(v << 16); }
__device__ __forceinline__ bf16_t f2bf(float f) { unsigned u = __float_as_uint(f); u += 0x7fffu + ((u >> 16) & 1u); return (bf16_t)(u >> 16); }
__device__ __forceinline__ unsigned pack2(float a, float b) { return (unsigned)f2bf(a) | ((unsigned)f2bf(b) << 16); }

__device__ __forceinline__ float wave_sum(float v) {
#pragma unroll
  for (int o = 32; o >= 1; o >>= 1) v += __shfl_xor(v, o);
  return v;
}
__device__ __forceinline__ float wave_max(float v) {
#pragma unroll
  for (int o = 32; o >= 1; o >>= 1) v = fmaxf(v, __shfl_xor(v, o));
  return v;
}

__device__ __forceinline__ const float* hrow_ptr(const float* x, const float* meta, int row) {
  int b = row / LP, pos = row - b * LP;
  if (pos < NMETA) return meta + (size_t)pos * D;
  if (pos < LREAL) return x + ((size_t)b * SEQ + (pos - NMETA)) * D;
  return nullptr;
}

__device__ __forceinline__ void p_norm1(int blk, float* red, const float* x, const float* meta, const float* g1, bf16_t* xn1,
                                               const float* lq1, const float* lk1, const float* lq2, const float* lk2, float* scal) {
  int row = blk, tid = threadIdx.x;
  __syncthreads();
  const float* src = hrow_ptr(x, meta, row);
  float4 v = src ? ((const float4*)src)[tid] : make_float4(0.f, 0.f, 0.f, 0.f);
  float ss = v.x * v.x + v.y * v.y + v.z * v.z + v.w * v.w;
  ss = wave_sum(ss);
  if ((tid & 63) == 0) red[tid >> 6] = ss;
  __syncthreads();
  float tot = red[0] + red[1] + red[2] + red[3];
  float rstd = rsqrtf(tot * (1.0f / D) + EPS);
  float4 g = ((const float4*)g1)[tid];
  uint2 o; o.x = pack2(v.x * rstd * g.x, v.y * rstd * g.y); o.y = pack2(v.z * rstd * g.z, v.w * rstd * g.w);
  ((uint2*)(xn1 + (size_t)row * D))[tid] = o;
  if (row == 0 && tid < 64) {
    float a = lq1[tid] * lk1[tid], b2 = lq2[tid] * lk2[tid];
    a = wave_sum(a); b2 = wave_sum(b2);
    if (tid == 0) scal[0] = expf(a) - expf(b2) + LAM_INIT;
  }
}

template <class Epi>
__device__ __forceinline__ void p_gemm_naive(int blk, float* smem, const bf16_t* __restrict__ A, const float* __restrict__ W, int N, int K, Epi epi) {
  float (*As)[68] = (float (*)[68])smem;
  float (*Bs)[68] = (float (*)[68])(smem + 16 * 68);
  int tid = threadIdx.x, tx = tid & 15, ty = tid >> 4;
  int nbx = N / 64;
  int m0 = (blk / nbx) * 64, n0 = (blk % nbx) * 64;
  float acc[4][4];
#pragma unroll
  for (int i = 0; i < 4; ++i)
#pragma unroll
    for (int j = 0; j < 4; ++j) acc[i][j] = 0.f;
  for (int k0 = 0; k0 < K; k0 += 16) {
    {
      int r = tid >> 2, kk = (tid & 3) * 4;
      uint2 raw = *(const uint2*)(A + (size_t)(m0 + r) * K + k0 + kk);
      As[kk + 0][r] = bf2f(raw.x & 0xffffu); As[kk + 1][r] = bf2f(raw.x >> 16);
      As[kk + 2][r] = bf2f(raw.y & 0xffffu); As[kk + 3][r] = bf2f(raw.y >> 16);
    }
    {
      int kk = tid >> 4, n = (tid & 15) * 4;
      float4 w = *(const float4*)(W + (size_t)(k0 + kk) * N + n0 + n);
      Bs[kk][n] = w.x; Bs[kk][n + 1] = w.y; Bs[kk][n + 2] = w.z; Bs[kk][n + 3] = w.w;
    }
    __syncthreads();
#pragma unroll
    for (int kk = 0; kk < 16; ++kk) {
      float a[4], b[4];
#pragma unroll
      for (int i = 0; i < 4; ++i) { a[i] = As[kk][ty * 4 + i]; b[i] = Bs[kk][tx * 4 + i]; }
#pragma unroll
      for (int i = 0; i < 4; ++i)
#pragma unroll
        for (int j = 0; j < 4; ++j) acc[i][j] += a[i] * b[j];
    }
    __syncthreads();
  }
#pragma unroll
  for (int i = 0; i < 4; ++i)
#pragma unroll
    for (int j = 0; j < 4; ++j) epi(m0 + ty * 4 + i, n0 + tx * 4 + j, acc[i][j]);
}

struct EpiStoreBf16 { bf16_t* out; int ld; int pad; __device__ void operator()(int r, int c, float v) const { out[(size_t)r * ld + c] = f2bf(v); } };
struct EpiResid { const float* x; const float* meta; float* h2; __device__ void operator()(int r, int c, float v) const {
  const float* src = hrow_ptr(x, meta, r); float hv = src ? src[c] : 0.f; h2[(size_t)r * D + c] = hv + v; } };

__device__ __forceinline__ void p_attn_naive(int blk, const bf16_t* __restrict__ proj, bf16_t* mix, const float* subg, const float* scal) {
  int gid = blk * 256 + threadIdx.x;
  int dvq = gid & 3, qidx = gid >> 2;
  int pos = qidx % LP, h = (qidx / LP) & 3, b = qidx / (LP * 4);
  if (b >= BATCH) return;
  size_t row = (size_t)b * LP + pos;
  bf16_t* outp = mix + row * D + h * 128 + dvq * 32;
  if (pos >= LREAL) {
#pragma unroll
    for (int i = 0; i < 4; ++i) ((uint4*)outp)[i] = make_uint4(0, 0, 0, 0);
    return;
  }
  const float slope = exp2f(-2.0f * (float)(h + 1));
  const float lam = scal[0];
  float q[128];
  {
    const uint4* qp = (const uint4*)(proj + row * INC + h * 128);
#pragma unroll
    for (int i = 0; i < 16; ++i) {
      uint4 r = qp[i];
      q[i * 8 + 0] = bf2f(r.x & 0xffffu) * 0.125f; q[i * 8 + 1] = bf2f(r.x >> 16) * 0.125f;
      q[i * 8 + 2] = bf2f(r.y & 0xffffu) * 0.125f; q[i * 8 + 3] = bf2f(r.y >> 16) * 0.125f;
      q[i * 8 + 4] = bf2f(r.z & 0xffffu) * 0.125f; q[i * 8 + 5] = bf2f(r.z >> 16) * 0.125f;
      q[i * 8 + 6] = bf2f(r.w & 0xffffu) * 0.125f; q[i * 8 + 7] = bf2f(r.w >> 16) * 0.125f;
    }
  }
  float o1[32], o2[32];
#pragma unroll
  for (int i = 0; i < 32; ++i) { o1[i] = 0.f; o2[i] = 0.f; }
  float m1 = -1e30f, m2 = -1e30f, l1 = 0.f, l2 = 0.f;
  for (int kp = 0; kp <= pos; ++kp) {
    const bf16_t* kr = proj + ((size_t)b * LP + kp) * INC;
    const uint4* kq = (const uint4*)(kr + 512 + h * 128);
    float s1 = 0.f, s2 = 0.f;
#pragma unroll
    for (int i = 0; i < 8; ++i) {
      uint4 r = kq[i];
      s1 += q[i * 8 + 0] * bf2f(r.x & 0xffffu) + q[i * 8 + 1] * bf2f(r.x >> 16) + q[i * 8 + 2] * bf2f(r.y & 0xffffu) + q[i * 8 + 3] * bf2f(r.y >> 16)
          + q[i * 8 + 4] * bf2f(r.z & 0xffffu) + q[i * 8 + 5] * bf2f(r.z >> 16) + q[i * 8 + 6] * bf2f(r.w & 0xffffu) + q[i * 8 + 7] * bf2f(r.w >> 16);
    }
#pragma unroll
    for (int i = 8; i < 16; ++i) {
      uint4 r = kq[i];
      s2 += q[i * 8 + 0] * bf2f(r.x & 0xffffu) + q[i * 8 + 1] * bf2f(r.x >> 16) + q[i * 8 + 2] * bf2f(r.y & 0xffffu) + q[i * 8 + 3] * bf2f(r.y >> 16)
          + q[i * 8 + 4] * bf2f(r.z & 0xffffu) + q[i * 8 + 5] * bf2f(r.z >> 16) + q[i * 8 + 6] * bf2f(r.w & 0xffffu) + q[i * 8 + 7] * bf2f(r.w >> 16);
    }
    float bias = -slope * (float)(pos - kp);
    s1 += bias; s2 += bias;
    float mn1 = fmaxf(m1, s1), mn2 = fmaxf(m2, s2);
    float a1 = __expf(m1 - mn1), a2 = __expf(m2 - mn2);
    float p1 = __expf(s1 - mn1), p2 = __expf(s2 - mn2);
    m1 = mn1; m2 = mn2;
    l1 = l1 * a1 + p1; l2 = l2 * a2 + p2;
    const uint4* vq = (const uint4*)(kr + 1024 + h * 128 + dvq * 32);
#pragma unroll
    for (int i = 0; i < 4; ++i) {
      uint4 r = vq[i];
      float v0 = bf2f(r.x & 0xffffu), v1 = bf2f(r.x >> 16), v2 = bf2f(r.y & 0xffffu), v3 = bf2f(r.y >> 16);
      float v4 = bf2f(r.z & 0xffffu), v5 = bf2f(r.z >> 16), v6 = bf2f(r.w & 0xffffu), v7 = bf2f(r.w >> 16);
      o1[i * 8 + 0] = o1[i * 8 + 0] * a1 + p1 * v0; o2[i * 8 + 0] = o2[i * 8 + 0] * a2 + p2 * v0;
      o1[i * 8 + 1] = o1[i * 8 + 1] * a1 + p1 * v1; o2[i * 8 + 1] = o2[i * 8 + 1] * a2 + p2 * v1;
      o1[i * 8 + 2] = o1[i * 8 + 2] * a1 + p1 * v2; o2[i * 8 + 2] = o2[i * 8 + 2] * a2 + p2 * v2;
      o1[i * 8 + 3] = o1[i * 8 + 3] * a1 + p1 * v3; o2[i * 8 + 3] = o2[i * 8 + 3] * a2 + p2 * v3;
      o1[i * 8 + 4] = o1[i * 8 + 4] * a1 + p1 * v4; o2[i * 8 + 4] = o2[i * 8 + 4] * a2 + p2 * v4;
      o1[i * 8 + 5] = o1[i * 8 + 5] * a1 + p1 * v5; o2[i * 8 + 5] = o2[i * 8 + 5] * a2 + p2 * v5;
      o1[i * 8 + 6] = o1[i * 8 + 6] * a1 + p1 * v6; o2[i * 8 + 6] = o2[i * 8 + 6] * a2 + p2 * v6;
      o1[i * 8 + 7] = o1[i * 8 + 7] * a1 + p1 * v7; o2[i * 8 + 7] = o2[i * 8 + 7] * a2 + p2 * v7;
    }
  }
  float il1 = 1.0f / l1, il2 = lam / l2;
  float ss = 0.f;
#pragma unroll
  for (int i = 0; i < 32; ++i) { o1[i] = o1[i] * il1 - o2[i] * il2; ss += o1[i] * o1[i]; }
  ss += __shfl_xor(ss, 1); ss += __shfl_xor(ss, 2);
  float rstd = rsqrtf(ss * (1.0f / 128.0f) + EPS) * (1.0f - LAM_INIT);
#pragma unroll
  for (int i = 0; i < 4; ++i) {
    uint4 w;
    const float* g = subg + dvq * 32 + i * 8;
    w.x = pack2(o1[i * 8 + 0] * rstd * g[0], o1[i * 8 + 1] * rstd * g[1]);
    w.y = pack2(o1[i * 8 + 2] * rstd * g[2], o1[i * 8 + 3] * rstd * g[3]);
    w.z = pack2(o1[i * 8 + 4] * rstd * g[4], o1[i * 8 + 5] * rstd * g[5]);
    w.w = pack2(o1[i * 8 + 6] * rstd * g[6], o1[i * 8 + 7] * rstd * g[7]);
    ((uint4*)outp)[i] = w;
  }
}

__device__ __forceinline__ void p_conv_naive(int blk, const bf16_t* __restrict__ proj, bf16_t* mix, const float* cw, const float* cb, const float* gg_, const float* gb_) {
  int row = blk, tid = threadIdx.x;
  int b = row / LP, pos = row - b * LP;
  int c0 = tid * 2;
  unsigned* outp = (unsigned*)(mix + (size_t)row * D + 512 + c0);
  if (pos >= LREAL) { *outp = 0u; return; }
  float y0 = cb[c0], y1 = cb[c0 + 1];
  for (int j = 0; j < 31; ++j) {
    int p = pos - 30 + j;
    if (p < 0) continue;
    const bf16_t* pr = proj + ((size_t)b * LP + p) * INC;
    unsigned a = *(const unsigned*)(pr + 1536 + c0), g = *(const unsigned*)(pr + 2048 + c0);
    float a0 = bf2f(a & 0xffffu), a1 = bf2f(a >> 16), g0 = bf2f(g & 0xffffu), g1 = bf2f(g >> 16);
    float u0 = a0 / (1.0f + __expf(-g0)), u1 = a1 / (1.0f + __expf(-g1));
    y0 += cw[j * 512 + c0] * u0; y1 += cw[j * 512 + c0 + 1] * u1;
  }
  float s = y0 + y1;
#pragma unroll
  for (int o = 16; o >= 1; o >>= 1) s += __shfl_xor(s, o);
  float mu = s * (1.0f / 64.0f);
  float d0 = y0 - mu, d1 = y1 - mu;
  float v = d0 * d0 + d1 * d1;
#pragma unroll
  for (int o = 16; o >= 1; o >>= 1) v += __shfl_xor(v, o);
  float rstd = rsqrtf(v * (1.0f / 64.0f) + EPS);
  float n0 = d0 * rstd * gg_[c0] + gb_[c0], n1 = d1 * rstd * gg_[c0 + 1] + gb_[c0 + 1];
  float r0 = n0 / (1.0f + __expf(-n0)), r1 = n1 / (1.0f + __expf(-n1));
  *outp = pack2(r0, r1);
}

__device__ __forceinline__ void p_norm2(int blk, float* red, const float* h2, const float* g2, bf16_t* xn2) {
  int row = blk, tid = threadIdx.x;
  __syncthreads();
  float4 v = ((const float4*)(h2 + (size_t)row * D))[tid];
  float ss = v.x * v.x + v.y * v.y + v.z * v.z + v.w * v.w;
  ss = wave_sum(ss);
  if ((tid & 63) == 0) red[tid >> 6] = ss;
  __syncthreads();
  float tot = red[0] + red[1] + red[2] + red[3];
  float rstd = rsqrtf(tot * (1.0f / D) + EPS);
  float4 g = ((const float4*)g2)[tid];
  uint2 o; o.x = pack2(v.x * rstd * g.x, v.y * rstd * g.y); o.y = pack2(v.z * rstd * g.z, v.w * rstd * g.w);
  ((uint2*)(xn2 + (size_t)row * D))[tid] = o;
}

__device__ __forceinline__ void p_topk_naive(int blk, const bf16_t* __restrict__ qp, const float* __restrict__ sk, int* eb, float* gb) {
  int w = blk * 4 + (threadIdx.x >> 6), lane = threadIdx.x & 63;
  int row = w >> 3, h = w & 7;
  int pos = row % LP;
  if (pos < NMETA || pos >= LREAL) return;
  const float NEG = -3.0e38f;
  float top[2];
#pragma unroll
  for (int p = 0; p < 2; ++p) {
    const bf16_t* qv = qp + (size_t)row * 2048 + h * 256 + p * 128;
    const float* k0 = sk + ((size_t)(h * 2 + p) * 128 + lane) * 128;
    const float* k1 = k0 + 64 * 128;
    float s0 = 0.f, s1 = 0.f;
    for (int d = 0; d < 128; d += 8) {
      uint4 r = *(const uint4*)(qv + d);
      float qf[8] = {bf2f(r.x & 0xffffu), bf2f(r.x >> 16), bf2f(r.y & 0xffffu), bf2f(r.y >> 16), bf2f(r.z & 0xffffu), bf2f(r.z >> 16), bf2f(r.w & 0xffffu), bf2f(r.w >> 16)};
      float4 a0 = *(const float4*)(k0 + d), a1 = *(const float4*)(k0 + d + 4), b0 = *(const float4*)(k1 + d), b1 = *(const float4*)(k1 + d + 4);
      s0 += qf[0] * a0.x + qf[1] * a0.y + qf[2] * a0.z + qf[3] * a0.w + qf[4] * a1.x + qf[5] * a1.y + qf[6] * a1.z + qf[7] * a1.w;
      s1 += qf[0] * b0.x + qf[1] * b0.y + qf[2] * b0.z + qf[3] * b0.w + qf[4] * b1.x + qf[5] * b1.y + qf[6] * b1.z + qf[7] * b1.w;
    }
    float v0 = __uint_as_float((__float_as_uint(s0) & ~127u) | (unsigned)lane);
    float v1 = __uint_as_float((__float_as_uint(s1) & ~127u) | (unsigned)(lane + 64));
    float t = NEG;
    for (int it = 0; it < 16; ++it) {
      float m = wave_max(fmaxf(v0, v1));
      if (lane == it) t = m;
      if (v0 == m) v0 = NEG;
      if (v1 == m) v1 = NEG;
    }
    top[p] = t;
  }
  int ci = lane >> 2, jb = (lane & 3) * 4;
  float av = __uint_as_float(__float_as_uint(__shfl(top[0], ci)) & ~127u);
  float c[4];
#pragma unroll
  for (int jj = 0; jj < 4; ++jj) {
    float bv = __uint_as_float(__float_as_uint(__shfl(top[1], jb + jj)) & ~127u);
    float s = av + bv;
    c[jj] = __uint_as_float((__float_as_uint(s) & ~255u) | (unsigned)(ci * 16 + jb + jj));
  }
  float ct = NEG;
  for (int it = 0; it < 16; ++it) {
    float m = wave_max(fmaxf(fmaxf(c[0], c[1]), fmaxf(c[2], c[3])));
    if (lane == it) ct = m;
#pragma unroll
    for (int jj = 0; jj < 4; ++jj) if (c[jj] == m) c[jj] = NEG;
  }
  unsigned cbits = __float_as_uint(ct);
  int cidx = cbits & 255u;
  float cval = __uint_as_float(cbits & ~255u);
  int i1 = __float_as_uint(__shfl(top[0], (cidx >> 4) & 15)) & 127u;
  int i2 = __float_as_uint(__shfl(top[1], cidx & 15)) & 127u;
  float mx = __shfl(cval, 0);
  float ex = lane < 16 ? __expf(cval - mx) : 0.f;
  float sum = wave_sum(ex);
  if (lane < 16) {
    eb[((size_t)row * 8 + h) * 16 + lane] = i1 * 128 + i2;
    gb[((size_t)row * 8 + h) * 16 + lane] = ex / sum;
  }
}

__device__ __forceinline__ void p_gather_naive(int blk, const bf16_t* __restrict__ xn2, const float* __restrict__ h2, const int* __restrict__ eb, const float* __restrict__ gb,
                                                      const float* __restrict__ ut, const float* __restrict__ vt, const float* fg, float* out) {
  int tk = blk * 4 + (threadIdx.x >> 6), lane = threadIdx.x & 63;
  int b = tk / SEQ, s = tk - b * SEQ;
  size_t row = (size_t)b * LP + NMETA + s;
  float xv[16];
  {
    const uint4* xp = (const uint4*)(xn2 + row * D + lane * 16);
#pragma unroll
    for (int i = 0; i < 2; ++i) {
      uint4 r = xp[i];
      xv[i * 8 + 0] = bf2f(r.x & 0xffffu); xv[i * 8 + 1] = bf2f(r.x >> 16); xv[i * 8 + 2] = bf2f(r.y & 0xffffu); xv[i * 8 + 3] = bf2f(r.y >> 16);
      xv[i * 8 + 4] = bf2f(r.z & 0xffffu); xv[i * 8 + 5] = bf2f(r.z >> 16); xv[i * 8 + 6] = bf2f(r.w & 0xffffu); xv[i * 8 + 7] = bf2f(r.w >> 16);
    }
  }
  float acc[16];
#pragma unroll
  for (int i = 0; i < 16; ++i) acc[i] = 0.f;
  for (int k = 0; k < 128; ++k) {
    int e = eb[row * 128 + k];
    float gate = gb[row * 128 + k];
    const float4* up = (const float4*)(ut + (size_t)e * D + lane * 16);
    float dsum = 0.f;
#pragma unroll
    for (int i = 0; i < 4; ++i) { float4 u = up[i]; dsum += u.x * xv[i * 4] + u.y * xv[i * 4 + 1] + u.z * xv[i * 4 + 2] + u.w * xv[i * 4 + 3]; }
    dsum = wave_sum(dsum);
    float act = 0.5f * dsum * (1.0f + erff(dsum * 0.70710678118654752f));
    float wgt = gate * act;
    const float4* vp = (const float4*)(vt + (size_t)e * D + lane * 16);
#pragma unroll
    for (int i = 0; i < 4; ++i) { float4 v = vp[i]; acc[i * 4] += wgt * v.x; acc[i * 4 + 1] += wgt * v.y; acc[i * 4 + 2] += wgt * v.z; acc[i * 4 + 3] += wgt * v.w; }
  }
  const float4* hp = (const float4*)(h2 + row * D + lane * 16);
  float ss = 0.f;
#pragma unroll
  for (int i = 0; i < 4; ++i) { float4 hv = hp[i]; acc[i * 4] += hv.x; acc[i * 4 + 1] += hv.y; acc[i * 4 + 2] += hv.z; acc[i * 4 + 3] += hv.w; }
#pragma unroll
  for (int i = 0; i < 16; ++i) ss += acc[i] * acc[i];
  ss = wave_sum(ss);
  float rstd = rsqrtf(ss * (1.0f / D) + EPS);
  float4* op = (float4*)(out + ((size_t)b * SEQ + s) * D + lane * 16);
  const float4* gp = (const float4*)(fg + lane * 16);
#pragma unroll
  for (int i = 0; i < 4; ++i) { float4 g = gp[i]; op[i] = make_float4(acc[i * 4] * rstd * g.x, acc[i * 4 + 1] * rstd * g.y, acc[i * 4 + 2] * rstd * g.z, acc[i * 4 + 3] * rstd * g.w); }
}

struct Params {
  const float *x, *meta, *g1, *w_in, *lq1, *lk1, *lq2, *lk2, *subg, *conv_w, *conv_b, *gn_g, *gn_b, *w_out, *g2, *wq, *sk, *ut, *vt, *fg;
  float* out; float* scal; bf16_t* r1; bf16_t* r2; float* h2; int* eb; float* gb;
};

__global__ void __launch_bounds__(256, 2) mega(Params p) {
  cg::grid_group grid = cg::this_grid();
  __shared__ __attribute__((aligned(16))) float smem[2 * 16 * 68];
  const int G = gridDim.x;
  bf16_t* xn1 = p.r1; bf16_t* mix = p.r1; bf16_t* xn2 = p.r1; bf16_t* proj = p.r2; bf16_t* qp = p.r2;
  for (int b = blockIdx.x; b < ROWS; b += G) p_norm1(b, smem, p.x, p.meta, p.g1, xn1, p.lq1, p.lk1, p.lq2, p.lk2, p.scal);
  grid.sync();
  for (int b = blockIdx.x; b < (INC / 64) * (ROWS / 64); b += G) p_gemm_naive(b, smem, xn1, p.w_in, INC, D, EpiStoreBf16{proj, INC, 0});
  grid.sync();
  for (int b = blockIdx.x; b < (BATCH * 4 * LP * 4) / 256; b += G) p_attn_naive(b, proj, mix, p.subg, p.scal);
  for (int b = blockIdx.x; b < ROWS; b += G) p_conv_naive(b, proj, mix, p.conv_w, p.conv_b, p.gn_g, p.gn_b);
  grid.sync();
  for (int b = blockIdx.x; b < (D / 64) * (ROWS / 64); b += G) p_gemm_naive(b, smem, mix, p.w_out, D, D, EpiResid{p.x, p.meta, p.h2});
  grid.sync();
  for (int b = blockIdx.x; b < ROWS; b += G) p_norm2(b, smem, p.h2, p.g2, xn2);
  grid.sync();
  for (int b = blockIdx.x; b < (2048 / 64) * (ROWS / 64); b += G) p_gemm_naive(b, smem, xn2, p.wq, 2048, D, EpiStoreBf16{qp, 2048, 0});
  grid.sync();
  for (int b = blockIdx.x; b < ROWS * 8 / 4; b += G) p_topk_naive(b, qp, p.sk, p.eb, p.gb);
  grid.sync();
  for (int b = blockIdx.x; b < BATCH * SEQ / 4; b += G) p_gather_naive(b, xn2, p.h2, p.eb, p.gb, p.ut, p.vt, p.fg, p.out);
}

extern "C" void kernel_launch(void* const* d_in, const int* in_sizes, int n_in, void* d_out, int out_size, void* d_ws, size_t ws_size, hipStream_t stream) {
  static int grid_blocks = 0;
  if (!grid_blocks) {
    int dev = 0, cus = 0, per_cu = 0;
    hipGetDevice(&dev);
    hipDeviceGetAttribute(&cus, hipDeviceAttributeMultiprocessorCount, dev);
    hipOccupancyMaxActiveBlocksPerMultiprocessor(&per_cu, mega, 256, 0);
    if (per_cu > 2) per_cu = 2;
    if (per_cu < 1) per_cu = 1;
    grid_blocks = cus * per_cu;
  }
  Params p{};
  const float** pp = (const float**)&p;
  for (int i = 0; i < 20; ++i) pp[i] = (const float*)d_in[i];
  p.out = (float*)d_out;
  char* ws = (char*)d_ws;
  size_t off = 0;
  p.scal = (float*)(ws + off); off += 4096;
  p.r1 = (bf16_t*)(ws + off); off += (size_t)ROWS * D * 2;
  p.r2 = (bf16_t*)(ws + off); off += (size_t)ROWS * INC * 2;
  p.h2 = (float*)(ws + off); off += (size_t)ROWS * D * 4;
  p.eb = (int*)((char*)p.r2 + (size_t)ROWS * 2048 * 2);
  p.gb = (float*)((char*)p.eb + (size_t)ROWS * 128 * 4);
  void* args[] = {&p};
  hipError_t e = hipLaunchCooperativeKernel((void*)mega, dim3(grid_blocks), dim3(256), args, 0, stream);
  if (e != hipSuccess) fprintf(stderr, "cooperative launch failed: %s (grid %d)\n", hipGetErrorString(e), grid_blocks);
}
```

```cpp
#include <hip/hip_runtime.h>
#include <hip/hip_cooperative_groups.h>
#include <cstdio>
namespace cg = cooperative_groups;
#include <stdint.h>
#include <math.h>

typedef unsigned short bf16_t;
typedef short bf16x8 __attribute__((ext_vector_type(8)));
typedef float f32x4 __attribute__((ext_vector_type(4)));

constexpr int D = 1024, BATCH = 8, SEQ = 4096, NMETA = 16, LREAL = NMETA + SEQ  , LP = 4224, ROWS = BATCH * LP;
constexpr int INC = 2560;
constexpr float EPS = 1e-6f;
constexpr float LAM_INIT = 0.2f;

__device__ __forceinline__ float bf2f(unsigned v) { return __uint_as_float(v << 16); }
__device__ __forceinline__ bf16_t f2bf(float f) { unsigned u = __float_as_uint(f); u += 0x7fffu + ((u >> 16) & 1u); return (bf16_t)(u >> 16); }
__device__ __forceinline__ unsigned pack2(float a, float b) { return (unsigned)f2bf(a) | ((unsigned)f2bf(b) << 16); }

__device__ __forceinline__ float wave_sum(float v) {
#pragma unroll
  for (int o = 32; o >= 1; o >>= 1) v += __shfl_xor(v, o);
  return v;
}
__device__ __forceinline__ float wave_max(float v) {
#pragma unroll
  for (int o = 32; o >= 1; o >>= 1) v = fmaxf(v, __shfl_xor(v, o));
  return v;
}

__device__ __forceinline__ int opaque_tid() { int t = threadIdx.x; asm volatile("" : "+v"(t)); return t; }

__device__ __forceinline__ const float* hrow_ptr(const float* x, const float* meta, int row) {
  int b = row / LP, pos = row - b * LP;
  if (pos < NMETA) return meta + (size_t)pos * D;
  if (pos < LREAL) return x + ((size_t)b * SEQ + (pos - NMETA)) * D;
  return nullptr;
}

__device__ __forceinline__ void p_norm1(int blk, float* red, const float* x, const float* meta, const float* g1, bf16_t* xn1,
                                               const float* lq1, const float* lk1, const float* lq2, const float* lk2, float* scal) {
  const int tix = opaque_tid();
  int row = blk, tid = (tix & 255);
  __syncthreads();
  const float* src = hrow_ptr(x, meta, row);
  float4 v = src ? ((const float4*)src)[tid] : make_float4(0.f, 0.f, 0.f, 0.f);
  float ss = v.x * v.x + v.y * v.y + v.z * v.z + v.w * v.w;
  ss = wave_sum(ss);
  if ((tid & 63) == 0) red[tid >> 6] = ss;
  __syncthreads();
  float tot = red[0] + red[1] + red[2] + red[3];
  float rstd = rsqrtf(tot * (1.0f / D) + EPS);
  float4 g = ((const float4*)g1)[tid];
  uint2 o; o.x = pack2(v.x * rstd * g.x, v.y * rstd * g.y); o.y = pack2(v.z * rstd * g.z, v.w * rstd * g.w);
  ((uint2*)(xn1 + (size_t)row * D))[tid] = o;
  if (row == 0 && tid < 64) {
    float a = lq1[tid] * lk1[tid], b2 = lq2[tid] * lk2[tid];
    a = wave_sum(a); b2 = wave_sum(b2);
    if (tid == 0) scal[0] = expf(a) - expf(b2) + LAM_INIT;
  }
}


typedef float f32x16 __attribute__((ext_vector_type(16)));
typedef short v4i16_t __attribute__((ext_vector_type(4)));
typedef __bf16 bf16v2_t __attribute__((ext_vector_type(2)));
typedef float f32x2_t __attribute__((ext_vector_type(2)));
#define LDSP(T, p) ((__attribute__((address_space(3))) T*)(p))
#define MFMA32(a, b, c) __builtin_amdgcn_mfma_f32_32x32x16_bf16((a), (b), (c), 0, 0, 0)
__device__ __forceinline__ unsigned cvtpk(float lo, float hi) { f32x2_t v = {lo, hi}; return __builtin_bit_cast(unsigned, __builtin_convertvector(v, bf16v2_t)); }
__device__ __forceinline__ float half_swap_max(float m) { auto rr = __builtin_amdgcn_permlane32_swap(__float_as_uint(m), __float_as_uint(m), false, false); return fmaxf(__uint_as_float(rr[0]), __uint_as_float(rr[1])); }
__device__ __forceinline__ float half_swap_sum(float m) { auto rr = __builtin_amdgcn_permlane32_swap(__float_as_uint(m), __float_as_uint(m), false, false); return __uint_as_float(rr[0]) + __uint_as_float(rr[1]); }

__device__ __forceinline__ void attn_issue_kv(char* kvbuf, const bf16_t* __restrict__ kvrow0  , int tid, int wid) {
  const char* base = (const char*)kvrow0;
#pragma unroll
  for (int i = 0; i < 2; ++i) {
    const int g = i * 512 + tid, row = g >> 4, pos = g & 15;
    const unsigned offk = (unsigned)(row * (INC * 2) + 1024 + ((pos ^ (row & 15)) << 4));
    const unsigned offv = (unsigned)(row * (INC * 2) + 2048 + ((pos ^ ((row & 3) << 2)) << 4));
    __builtin_amdgcn_global_load_lds((const unsigned*)(base + offk), LDSP(unsigned, kvbuf + (i * 512 + wid * 64) * 16), 16, 0, 0);
    __builtin_amdgcn_global_load_lds((const unsigned*)(base + offv), LDSP(unsigned, kvbuf + 16384 + (i * 512 + wid * 64) * 16), 16, 0, 0);
  }
}

template <bool MASKED>
__device__ __forceinline__ void attn_map(f32x16 (&o)[4], float& mref_io, float& l_io, const char* qbase, int qsw, const char* kb, const char* vb, int c, int kq, float sl8, int lane, int r32, int hi) {
  const float c1 = 0.125f * 1.4426950408889634f;
  asm volatile("" : "+v"(qsw), "+v"(lane));
  f32x16 s0, s1;
  {
    const float a1 = sl8, a2 = 2.0f * sl8, a3 = 3.0f * sl8, b8 = 8.0f * sl8;
    float gb = sl8 * (float)kq;
#pragma unroll
    for (int g = 0; g < 4; ++g) { s0[4 * g] = gb; s0[4 * g + 1] = gb + a1; s0[4 * g + 2] = gb + a2; s0[4 * g + 3] = gb + a3; gb += b8; }
#pragma unroll
    for (int g = 0; g < 4; ++g) { s1[4 * g] = gb; s1[4 * g + 1] = gb + a1; s1[4 * g + 2] = gb + a2; s1[4 * g + 3] = gb + a3; gb += b8; }
    if (MASKED) {
#pragma unroll
      for (int r = 0; r < 16; ++r) { s0[r] = s0[r] > 0.f ? -1e30f : s0[r]; s1[r] = s1[r] > 0.f ? -1e30f : s1[r]; }
    }
  }
#pragma unroll
  for (int ks = 0; ks < 4; ++ks) {
    const int ch = c * 8 + ks * 2 + hi;
    bf16x8 bq = *(const bf16x8*)(qbase + ((ch ^ qsw) << 4));
    bf16x8 ka0 = *(const bf16x8*)(kb + r32 * 256 + ((ch ^ qsw) << 4));
    bf16x8 ka1 = *(const bf16x8*)(kb + (32 + r32) * 256 + ((ch ^ qsw) << 4));
    s0 = MFMA32(ka0, bq, s0);
    s1 = MFMA32(ka1, bq, s1);
    __builtin_amdgcn_sched_barrier(0);
  }
  float mx = fmaxf(s0[0], s1[0]);
#pragma unroll
  for (int r = 1; r < 16; ++r) mx = fmaxf(mx, fmaxf(s0[r], s1[r]));
  mx = half_swap_max(mx);
  float mref = mref_io;
  if (__any((mx - mref) * c1 > 6.0f)) {
    const float mn = fmaxf(mref, mx);
    const float alpha = exp2f((mref - mn) * c1);
    l_io *= alpha;
#pragma unroll
    for (int i = 0; i < 4; ++i)
#pragma unroll
      for (int r = 0; r < 16; ++r) o[i][r] *= alpha;
    mref = mn; mref_io = mn;
  }
  const float nm = -mref * c1;
  float ls = 0.f;
#pragma unroll
  for (int r = 0; r < 16; ++r) { s0[r] = __builtin_amdgcn_exp2f(fmaf(s0[r], c1, nm)); s1[r] = __builtin_amdgcn_exp2f(fmaf(s1[r], c1, nm)); ls += s0[r] + s1[r]; }
  l_io += ls;
  const int q4 = (lane & 15) >> 2, g1 = (lane >> 4) & 1, p4 = lane & 3;
#pragma unroll
  for (int kk = 0; kk < 4; ++kk) {
    const int key0 = 16 * kk + 4 * hi + q4;
    uint4 pwv;
    if (kk < 2) { pwv.x = cvtpk(s0[8 * kk], s0[8 * kk + 1]); pwv.y = cvtpk(s0[8 * kk + 2], s0[8 * kk + 3]); pwv.z = cvtpk(s0[8 * kk + 4], s0[8 * kk + 5]); pwv.w = cvtpk(s0[8 * kk + 6], s0[8 * kk + 7]); }
    else { const int k2 = kk - 2; pwv.x = cvtpk(s1[8 * k2], s1[8 * k2 + 1]); pwv.y = cvtpk(s1[8 * k2 + 2], s1[8 * k2 + 3]); pwv.z = cvtpk(s1[8 * k2 + 4], s1[8 * k2 + 5]); pwv.w = cvtpk(s1[8 * k2 + 6], s1[8 * k2 + 7]); }
    const bf16x8 pb = __builtin_bit_cast(bf16x8, pwv);
#pragma unroll
    for (int dvt = 0; dvt < 4; ++dvt) {
      const int c8 = 8 * (dvt ^ q4) + 4 * g1 + p4;
      v4i16_t lo = __builtin_amdgcn_ds_read_tr16_b64_v4i16(LDSP(v4i16_t, vb + key0 * 256 + c8 * 8));
      v4i16_t hi4 = __builtin_amdgcn_ds_read_tr16_b64_v4i16(LDSP(v4i16_t, vb + (key0 + 8) * 256 + c8 * 8));
      bf16x8 va = (bf16x8){lo[0], lo[1], lo[2], lo[3], hi4[0], hi4[1], hi4[2], hi4[3]};
      o[dvt] = MFMA32(va, pb, o[dvt]);
    }
    __builtin_amdgcn_sched_barrier(0);
  }
}

__device__ __forceinline__ void attn_unit(char* lds, const bf16_t* __restrict__ proj, bf16_t* mix, const float* __restrict__ subg, float lam, int b, int h, int t) {
  const int tix = opaque_tid();
  const int tid = tix, lane = tid & 63, r32 = lane & 31, hi = lane >> 5;
  const int wid = __builtin_amdgcn_readfirstlane(tid >> 6);
  const int c = wid >> 2, qg = wid & 3;
  const int q0 = NMETA + 128 * t, qw0 = q0 + 32 * qg, qpos = qw0 + r32;
  const size_t rowb = (size_t)b * LP;
  const int NT = 2 * t + 3;
  char* Qs = lds;
  char* KV = lds + 32768;
  const float sl8 = exp2f(1.0f - 2.0f * (float)h);
  __syncthreads();
  attn_issue_kv(KV, proj + rowb * INC + h * 128, tid, wid);
#pragma unroll
  for (int i = 0; i < 4; ++i) {
    const int g = i * 512 + tid, row = g >> 4, pos = g & 15;
    uint4 v = *(const uint4*)(proj + (rowb + q0 + row) * INC + h * 128 + ((pos ^ (row & 15)) << 3));
    *(uint4*)(Qs + g * 16) = v;
  }
  f32x16 o[4];
#pragma unroll
  for (int i = 0; i < 4; ++i)
#pragma unroll
    for (int r = 0; r < 16; ++r) o[i][r] = 0.f;
  float m = -1e30f, l = 0.f;
  const int qrow = 32 * qg + r32;
  const char* qbase = Qs + qrow * 256;
  const int qsw = qrow & 15;
  for (int j = 0; j < NT; ++j) {
    __syncthreads();
    if (j + 1 < NT) attn_issue_kv(KV + ((j + 1) & 1) * 32768, proj + (rowb + 64 * (j + 1)) * INC + h * 128, tid, wid);
    if (64 * j > qw0 + 31) continue;
    const char* kb = KV + (j & 1) * 32768;
    const char* vb = kb + 16384;
    const int kq = 64 * j + 4 * hi - qpos;
    if (64 * j + 63 > qw0) attn_map<true>(o, m, l, qbase, qsw, kb, vb, c, kq, sl8, lane, r32, hi);
    else attn_map<false>(o, m, l, qbase, qsw, kb, vb, c, kq, sl8, lane, r32, hi);
  }
  l = half_swap_sum(l);
  const float sc = (c == 0 ? 1.0f : lam) / l;
  __syncthreads();
  float* X = (float*)(lds + 32768);
  if (c == 1) {
#pragma unroll
    for (int i = 0; i < 4; ++i)
#pragma unroll
      for (int r = 0; r < 16; ++r) X[(qg * 64 + i * 16 + r) * 64 + lane] = o[i][r] * sc;
  }
  __syncthreads();
  if (c == 0) {
    float ss = 0.f;
#pragma unroll
    for (int i = 0; i < 4; ++i) {
#pragma unroll
      for (int r = 0; r < 16; ++r) { float v = o[i][r] * sc - X[(qg * 64 + i * 16 + r) * 64 + lane]; o[i][r] = v; ss += v * v; }
      __builtin_amdgcn_sched_barrier(0);
    }
    ss = half_swap_sum(ss);
    const float rstd = rsqrtf(ss * (1.0f / 128.0f) + EPS) * (1.0f - LAM_INIT);
    bf16_t* orow = mix + (rowb + qpos) * D + h * 128;
#pragma unroll
    for (int i = 0; i < 4; ++i) {
#pragma unroll
      for (int g = 0; g < 4; ++g) {
        const int dv0 = 32 * i + 8 * g + 4 * hi;
        const float4 sg = *(const float4*)(subg + dv0);
        uint2 w; w.x = cvtpk(o[i][4 * g] * rstd * sg.x, o[i][4 * g + 1] * rstd * sg.y); w.y = cvtpk(o[i][4 * g + 2] * rstd * sg.z, o[i][4 * g + 3] * rstd * sg.w);
        *(uint2*)(orow + dv0) = w;
      }
      __builtin_amdgcn_sched_barrier(0);
    }
  }
}

__device__ __forceinline__ void p_conv_naive(int blk, const bf16_t* __restrict__ proj, bf16_t* mix, const float* cw, const float* cb, const float* gg_, const float* gb_) {
  const int tix = opaque_tid();
  int row = blk, tid = (tix & 255);
  int b = row / LP, pos = row - b * LP;
  int c0 = tid * 2;
  unsigned* outp = (unsigned*)(mix + (size_t)row * D + 512 + c0);
  if (pos >= LREAL) { *outp = 0u; return; }
  float y0 = cb[c0], y1 = cb[c0 + 1];
  for (int j = 0; j < 31; ++j) {
    int p = pos - 30 + j;
    if (p < 0) continue;
    const bf16_t* pr = proj + ((size_t)b * LP + p) * INC;
    unsigned a = *(const unsigned*)(pr + 1536 + c0), g = *(const unsigned*)(pr + 2048 + c0);
    float a0 = bf2f(a & 0xffffu), a1 = bf2f(a >> 16), g0 = bf2f(g & 0xffffu), g1 = bf2f(g >> 16);
    float u0 = a0 / (1.0f + __expf(-g0)), u1 = a1 / (1.0f + __expf(-g1));
    y0 += cw[j * 512 + c0] * u0; y1 += cw[j * 512 + c0 + 1] * u1;
  }
  float s = y0 + y1;
#pragma unroll
  for (int o = 16; o >= 1; o >>= 1) s += __shfl_xor(s, o);
  float mu = s * (1.0f / 64.0f);
  float d0 = y0 - mu, d1 = y1 - mu;
  float v = d0 * d0 + d1 * d1;
#pragma unroll
  for (int o = 16; o >= 1; o >>= 1) v += __shfl_xor(v, o);
  float rstd = rsqrtf(v * (1.0f / 64.0f) + EPS);
  float n0 = d0 * rstd * gg_[c0] + gb_[c0], n1 = d1 * rstd * gg_[c0 + 1] + gb_[c0 + 1];
  float r0 = n0 / (1.0f + __expf(-n0)), r1 = n1 / (1.0f + __expf(-n1));
  *outp = pack2(r0, r1);
}

__device__ __forceinline__ void p_norm2(int blk, float* red, const float* h2, const float* g2, bf16_t* xn2) {
  const int tix = opaque_tid();
  int row = blk, tid = (tix & 255);
  __syncthreads();
  float4 v = ((const float4*)(h2 + (size_t)row * D))[tid];
  float ss = v.x * v.x + v.y * v.y + v.z * v.z + v.w * v.w;
  ss = wave_sum(ss);
  if ((tid & 63) == 0) red[tid >> 6] = ss;
  __syncthreads();
  float tot = red[0] + red[1] + red[2] + red[3];
  float rstd = rsqrtf(tot * (1.0f / D) + EPS);
  float4 g = ((const float4*)g2)[tid];
  uint2 o; o.x = pack2(v.x * rstd * g.x, v.y * rstd * g.y); o.y = pack2(v.z * rstd * g.z, v.w * rstd * g.w);
  ((uint2*)(xn2 + (size_t)row * D))[tid] = o;
}

__device__ __forceinline__ void p_topk_naive(int blk, const bf16_t* __restrict__ qp, const float* __restrict__ sk, int* eb, float* gb) {
  const int tix = opaque_tid();
  int w = blk * 4 + ((tix & 255) >> 6), lane = (tix & 255) & 63;
  int row = w >> 3, h = w & 7;
  int pos = row % LP;
  if (pos < NMETA || pos >= LREAL) return;
  const float NEG = -3.0e38f;
  float top[2];
#pragma unroll
  for (int p = 0; p < 2; ++p) {
    const bf16_t* qv = qp + (size_t)row * 2048 + h * 256 + p * 128;
    const float* k0 = sk + ((size_t)(h * 2 + p) * 128 + lane) * 128;
    const float* k1 = k0 + 64 * 128;
    float s0 = 0.f, s1 = 0.f;
    for (int d = 0; d < 128; d += 8) {
      uint4 r = *(const uint4*)(qv + d);
      float qf[8] = {bf2f(r.x & 0xffffu), bf2f(r.x >> 16), bf2f(r.y & 0xffffu), bf2f(r.y >> 16), bf2f(r.z & 0xffffu), bf2f(r.z >> 16), bf2f(r.w & 0xffffu), bf2f(r.w >> 16)};
      float4 a0 = *(const float4*)(k0 + d), a1 = *(const float4*)(k0 + d + 4), b0 = *(const float4*)(k1 + d), b1 = *(const float4*)(k1 + d + 4);
      s0 += qf[0] * a0.x + qf[1] * a0.y + qf[2] * a0.z + qf[3] * a0.w + qf[4] * a1.x + qf[5] * a1.y + qf[6] * a1.z + qf[7] * a1.w;
      s1 += qf[0] * b0.x + qf[1] * b0.y + qf[2] * b0.z + qf[3] * b0.w + qf[4] * b1.x + qf[5] * b1.y + qf[6] * b1.z + qf[7] * b1.w;
    }
    float v0 = __uint_as_float((__float_as_uint(s0) & ~127u) | (unsigned)lane);
    float v1 = __uint_as_float((__float_as_uint(s1) & ~127u) | (unsigned)(lane + 64));
    float t = NEG;
    for (int it = 0; it < 16; ++it) {
      float m = wave_max(fmaxf(v0, v1));
      if (lane == it) t = m;
      if (v0 == m) v0 = NEG;
      if (v1 == m) v1 = NEG;
    }
    top[p] = t;
  }
  int ci = lane >> 2, jb = (lane & 3) * 4;
  float av = __uint_as_float(__float_as_uint(__shfl(top[0], ci)) & ~127u);
  float c[4];
#pragma unroll
  for (int jj = 0; jj < 4; ++jj) {
    float bv = __uint_as_float(__float_as_uint(__shfl(top[1], jb + jj)) & ~127u);
    float s = av + bv;
    c[jj] = __uint_as_float((__float_as_uint(s) & ~255u) | (unsigned)(ci * 16 + jb + jj));
  }
  float ct = NEG;
  for (int it = 0; it < 16; ++it) {
    float m = wave_max(fmaxf(fmaxf(c[0], c[1]), fmaxf(c[2], c[3])));
    if (lane == it) ct = m;
#pragma unroll
    for (int jj = 0; jj < 4; ++jj) if (c[jj] == m) c[jj] = NEG;
  }
  unsigned cbits = __float_as_uint(ct);
  int cidx = cbits & 255u;
  float cval = __uint_as_float(cbits & ~255u);
  int i1 = __float_as_uint(__shfl(top[0], (cidx >> 4) & 15)) & 127u;
  int i2 = __float_as_uint(__shfl(top[1], cidx & 15)) & 127u;
  float mx = __shfl(cval, 0);
  float ex = lane < 16 ? __expf(cval - mx) : 0.f;
  float sum = wave_sum(ex);
  if (lane < 16) {
    eb[((size_t)row * 8 + h) * 16 + lane] = i1 * 128 + i2;
    gb[((size_t)row * 8 + h) * 16 + lane] = ex / sum;
  }
}

__device__ __forceinline__ void p_gather_naive(int blk, const bf16_t* __restrict__ xn2, const float* __restrict__ h2, const int* __restrict__ eb, const float* __restrict__ gb,
                                                      const float* __restrict__ ut, const float* __restrict__ vt, const float* fg, float* out) {
  const int tix = opaque_tid();
  int tk = blk * 4 + ((tix & 255) >> 6), lane = (tix & 255) & 63;
  int b = tk / SEQ, s = tk - b * SEQ;
  size_t row = (size_t)b * LP + NMETA + s;
  float xv[16];
  {
    const uint4* xp = (const uint4*)(xn2 + row * D + lane * 16);
#pragma unroll
    for (int i = 0; i < 2; ++i) {
      uint4 r = xp[i];
      xv[i * 8 + 0] = bf2f(r.x & 0xffffu); xv[i * 8 + 1] = bf2f(r.x >> 16); xv[i * 8 + 2] = bf2f(r.y & 0xffffu); xv[i * 8 + 3] = bf2f(r.y >> 16);
      xv[i * 8 + 4] = bf2f(r.z & 0xffffu); xv[i * 8 + 5] = bf2f(r.z >> 16); xv[i * 8 + 6] = bf2f(r.w & 0xffffu); xv[i * 8 + 7] = bf2f(r.w >> 16);
    }
  }
  float acc[16];
#pragma unroll
  for (int i = 0; i < 16; ++i) acc[i] = 0.f;
  for (int k = 0; k < 128; ++k) {
    int e = eb[row * 128 + k];
    float gate = gb[row * 128 + k];
    const float4* up = (const float4*)(ut + (size_t)e * D + lane * 16);
    float dsum = 0.f;
#pragma unroll
    for (int i = 0; i < 4; ++i) { float4 u = up[i]; dsum += u.x * xv[i * 4] + u.y * xv[i * 4 + 1] + u.z * xv[i * 4 + 2] + u.w * xv[i * 4 + 3]; }
    dsum = wave_sum(dsum);
    float act = 0.5f * dsum * (1.0f + erff(dsum * 0.70710678118654752f));
    float wgt = gate * act;
    const float4* vp = (const float4*)(vt + (size_t)e * D + lane * 16);
#pragma unroll
    for (int i = 0; i < 4; ++i) { float4 v = vp[i]; acc[i * 4] += wgt * v.x; acc[i * 4 + 1] += wgt * v.y; acc[i * 4 + 2] += wgt * v.z; acc[i * 4 + 3] += wgt * v.w; }
  }
  const float4* hp = (const float4*)(h2 + row * D + lane * 16);
  float ss = 0.f;
#pragma unroll
  for (int i = 0; i < 4; ++i) { float4 hv = hp[i]; acc[i * 4] += hv.x; acc[i * 4 + 1] += hv.y; acc[i * 4 + 2] += hv.z; acc[i * 4 + 3] += hv.w; }
#pragma unroll
  for (int i = 0; i < 16; ++i) ss += acc[i] * acc[i];
  ss = wave_sum(ss);
  float rstd = rsqrtf(ss * (1.0f / D) + EPS);
  float4* op = (float4*)(out + ((size_t)b * SEQ + s) * D + lane * 16);
  const float4* gp = (const float4*)(fg + lane * 16);
#pragma unroll
  for (int i = 0; i < 4; ++i) { float4 g = gp[i]; op[i] = make_float4(acc[i * 4] * rstd * g.x, acc[i * 4 + 1] * rstd * g.y, acc[i * 4 + 2] * rstd * g.z, acc[i * 4 + 3] * rstd * g.w); }
}


template <class Epi>
__device__ __forceinline__ void gemm_tile(char* lds, const bf16_t* __restrict__ X, int ldx, const bf16_t* __restrict__ Wt, int ldw, int K, int m0, int n0, const Epi& epi) {
  const int tix = opaque_tid();
  const int tid = tix, lane = tid & 63, wid = tid >> 6;
  const int wm = wid >> 1, wn = wid & 1;
  const int sc = tid & 7, sr = tid >> 3;
  f32x4 acc[4][4];
#pragma unroll
  for (int i = 0; i < 4; ++i)
#pragma unroll
    for (int j = 0; j < 4; ++j) acc[i][j] = (f32x4){0.f, 0.f, 0.f, 0.f};
  uint4 ra[4], rb[2];
  const bf16_t* xp = X + (size_t)(m0 + sr) * ldx + sc * 8;
  const bf16_t* wp = Wt + (size_t)(n0 + sr) * ldw + sc * 8;
  const int nk = K >> 6;
#pragma unroll
  for (int i = 0; i < 4; ++i) ra[i] = *(const uint4*)(xp + (size_t)(64 * i) * ldx);
#pragma unroll
  for (int i = 0; i < 2; ++i) rb[i] = *(const uint4*)(wp + (size_t)(64 * i) * ldw);
#pragma unroll
  for (int i = 0; i < 4; ++i) { int r = sr + 64 * i; *(uint4*)(lds + r * 128 + ((sc ^ ((r >> 1) & 7)) << 4)) = ra[i]; }
#pragma unroll
  for (int i = 0; i < 2; ++i) { int r = sr + 64 * i; *(uint4*)(lds + 32768 + r * 128 + ((sc ^ ((r >> 1) & 7)) << 4)) = rb[i]; }
  __syncthreads();
  const int fr = lane & 15, fq = lane >> 4;
  for (int kt = 0; kt < nk; ++kt) {
    if (kt + 1 < nk) {
#pragma unroll
      for (int i = 0; i < 4; ++i) ra[i] = *(const uint4*)(xp + (size_t)(64 * i) * ldx + (kt + 1) * 64);
#pragma unroll
      for (int i = 0; i < 2; ++i) rb[i] = *(const uint4*)(wp + (size_t)(64 * i) * ldw + (kt + 1) * 64);
    }
    const char* la = lds + (kt & 1) * 49152;
    const char* lb = la + 32768;
#pragma unroll
    for (int kk = 0; kk < 2; ++kk) {
      bf16x8 xa[4], wb[4];
      const int c = kk * 4 + fq;
#pragma unroll
      for (int t = 0; t < 4; ++t) {
        int r = wm * 64 + t * 16 + fr; xa[t] = *(const bf16x8*)(la + r * 128 + ((c ^ ((r >> 1) & 7)) << 4));
        int r2 = wn * 64 + t * 16 + fr; wb[t] = *(const bf16x8*)(lb + r2 * 128 + ((c ^ ((r2 >> 1) & 7)) << 4));
      }
#pragma unroll
      for (int nt = 0; nt < 4; ++nt)
#pragma unroll
        for (int tt = 0; tt < 4; ++tt) acc[nt][tt] = __builtin_amdgcn_mfma_f32_16x16x32_bf16(wb[nt], xa[tt], acc[nt][tt], 0, 0, 0);
    }
    if (kt + 1 < nk) {
      char* lw = lds + ((kt + 1) & 1) * 49152;
#pragma unroll
      for (int i = 0; i < 4; ++i) { int r = sr + 64 * i; *(uint4*)(lw + r * 128 + ((sc ^ ((r >> 1) & 7)) << 4)) = ra[i]; }
#pragma unroll
      for (int i = 0; i < 2; ++i) { int r = sr + 64 * i; *(uint4*)(lw + 32768 + r * 128 + ((sc ^ ((r >> 1) & 7)) << 4)) = rb[i]; }
    }
    __syncthreads();
  }
#pragma unroll
  for (int nt = 0; nt < 4; ++nt)
#pragma unroll
    for (int tt = 0; tt < 4; ++tt) epi(m0 + wm * 64 + tt * 16 + fr, n0 + wn * 64 + nt * 16 + fq * 4, acc[nt][tt]);
}

struct Epi4StoreBf16 { bf16_t* out; int ld; int pad; __device__ __forceinline__ void operator()(int r, int c, f32x4 v) const {
  uint2 w; w.x = pack2(v[0], v[1]); w.y = pack2(v[2], v[3]); *(uint2*)(out + (size_t)r * ld + c) = w; } };
struct Epi4Resid { const float* x; const float* meta; float* h2; __device__ __forceinline__ void operator()(int r, int c, f32x4 v) const {
  const float* src = hrow_ptr(x, meta, r); float4 hv = src ? *(const float4*)(src + c) : make_float4(0.f, 0.f, 0.f, 0.f);
  *(float4*)(h2 + (size_t)r * D + c) = make_float4(hv.x + v[0], hv.y + v[1], hv.z + v[2], hv.w + v[3]); } };

__device__ __forceinline__ void p_transpose(int t, float* smem, const float* __restrict__ W, bf16_t* Wt, int K, int N) {
  const int tix = opaque_tid();
  float (*T)[65] = (float (*)[65])smem;
  const int nbx = N / 64, k0 = (t / nbx) * 64, n0 = (t % nbx) * 64, tid = (tix & 255);
  const int j = tid & 63, i0 = tid >> 6;
#pragma unroll
  for (int ii = 0; ii < 16; ++ii) { int i = i0 + 4 * ii; T[i][j] = W[(size_t)(k0 + i) * N + n0 + j]; }
  __syncthreads();
#pragma unroll
  for (int ii = 0; ii < 16; ++ii) { int jj = i0 + 4 * ii; Wt[(size_t)(n0 + jj) * K + k0 + j] = f2bf(T[j][jj]); }
  __syncthreads();
}
struct Params {
  const float *x, *meta, *g1, *w_in, *lq1, *lk1, *lq2, *lk2, *subg, *conv_w, *conv_b, *gn_g, *gn_b, *w_out, *g2, *wq, *sk, *ut, *vt, *fg;
  float* out; float* scal; bf16_t* r1; bf16_t* r2; float* h2; int* eb; float* gb; bf16_t* wt_in; bf16_t* wt_out; bf16_t* wt_q;
};

__global__ void __launch_bounds__(512, 2) mega(Params p) {
  cg::grid_group grid = cg::this_grid();
  __shared__ __attribute__((aligned(16))) char smem_c[131072];
  float* smem = (float*)smem_c;
  const int G = gridDim.x, vh = threadIdx.x >> 8;
  bf16_t* xn1 = p.r1; bf16_t* mix = p.r1; bf16_t* xn2 = p.r1; bf16_t* proj = p.r2; bf16_t* qp = p.r2;
  for (int b = blockIdx.x; b < ROWS / 2; b += G) p_norm1(b * 2 + vh, smem + 4 * vh, p.x, p.meta, p.g1, xn1, p.lq1, p.lk1, p.lq2, p.lk2, p.scal);
  for (int b = blockIdx.x; b < (640 + 256 + 512) / 2; b += G) {
    const int bb = b * 2 + vh; float* sm = smem + vh * (64 * 65);
    if (bb < 640) p_transpose(bb, sm, p.w_in, p.wt_in, D, INC);
    else if (bb < 896) p_transpose(bb - 640, sm, p.w_out, p.wt_out, D, D);
    else p_transpose(bb - 896, sm, p.wq, p.wt_q, D, 2048);
  }
  grid.sync();
  for (int b = blockIdx.x; b < (INC / 128) * (ROWS / 256); b += G) gemm_tile(smem_c, xn1, D, p.wt_in, D, D, (b / (INC / 128)) * 256, (b % (INC / 128)) * 128, Epi4StoreBf16{proj, INC, 0});
  grid.sync();
  {
    const float lam = p.scal[0];
    for (int u = blockIdx.x; u < 256; u += G) {
      const int bh = (u & 7) * 4 + (u >> 6), tp = (u >> 3) & 7;
#pragma unroll 1
      for (int k = 0; k < 4; ++k) {
        const int t = (k == 0) ? 31 - tp : (k == 1) ? 16 + tp : (k == 2) ? 15 - tp : tp;
        attn_unit(smem_c, proj, mix, p.subg, lam, bh >> 2, bh & 3, t);
      }
    }
  }
  for (int b = blockIdx.x; b < ROWS / 2; b += G) p_conv_naive(b * 2 + vh, proj, mix, p.conv_w, p.conv_b, p.gn_g, p.gn_b);
  grid.sync();
  for (int b = blockIdx.x; b < (D / 128) * (ROWS / 256); b += G) gemm_tile(smem_c, mix, D, p.wt_out, D, D, (b / (D / 128)) * 256, (b % (D / 128)) * 128, Epi4Resid{p.x, p.meta, p.h2});
  grid.sync();
  for (int b = blockIdx.x; b < ROWS / 2; b += G) p_norm2(b * 2 + vh, smem + 4 * vh, p.h2, p.g2, xn2);
  grid.sync();
  for (int b = blockIdx.x; b < (2048 / 128) * (ROWS / 256); b += G) gemm_tile(smem_c, xn2, D, p.wt_q, D, D, (b / 16) * 256, (b % 16) * 128, Epi4StoreBf16{qp, 2048, 0});
  grid.sync();
  for (int b = blockIdx.x; b < ROWS * 8 / 8; b += G) p_topk_naive(b * 2 + vh, qp, p.sk, p.eb, p.gb);
  grid.sync();
  for (int b = blockIdx.x; b < BATCH * SEQ / 8; b += G) p_gather_naive(b * 2 + vh, xn2, p.h2, p.eb, p.gb, p.ut, p.vt, p.fg, p.out);
}

extern "C" void kernel_launch(void* const* d_in, const int* in_sizes, int n_in, void* d_out, int out_size, void* d_ws, size_t ws_size, hipStream_t stream) {
  static int grid_blocks = 0;
  if (!grid_blocks) {
    int dev = 0, cus = 0, per_cu = 0;
    hipGetDevice(&dev);
    hipDeviceGetAttribute(&cus, hipDeviceAttributeMultiprocessorCount, dev);
    hipOccupancyMaxActiveBlocksPerMultiprocessor(&per_cu, mega, 512, 0);
    if (per_cu > 1) per_cu = 1;
    if (per_cu < 1) per_cu = 1;
    grid_blocks = cus * per_cu;
  }
  Params p{};
  const float** pp = (const float**)&p;
  for (int i = 0; i < 20; ++i) pp[i] = (const float*)d_in[i];
  p.out = (float*)d_out;
  char* ws = (char*)d_ws;
  size_t off = 0;
  p.scal = (float*)(ws + off); off += 4096;
  p.r1 = (bf16_t*)(ws + off); off += (size_t)ROWS * D * 2;
  p.r2 = (bf16_t*)(ws + off); off += (size_t)ROWS * INC * 2;
  p.h2 = (float*)(ws + off); off += (size_t)ROWS * D * 4;
  p.wt_in = (bf16_t*)(ws + off); off += (size_t)INC * D * 2;
  p.wt_out = (bf16_t*)(ws + off); off += (size_t)D * D * 2;
  p.wt_q = (bf16_t*)(ws + off); off += (size_t)2048 * D * 2;
  p.eb = (int*)((char*)p.r2 + (size_t)ROWS * 2048 * 2);
  p.gb = (float*)((char*)p.eb + (size_t)ROWS * 128 * 4);
  void* args[] = {&p};
  hipError_t e = hipLaunchCooperativeKernel((void*)mega, dim3(grid_blocks), dim3(512), args, 0, stream);
  if (e != hipSuccess) fprintf(stderr, "cooperative launch failed: %s (grid %d)\n", hipGetErrorString(e), grid_blocks);
}
```

```cpp
#include <hip/hip_runtime.h>
#include <hip/hip_cooperative_groups.h>
#include <cstdio>
namespace cg = cooperative_groups;
#include <stdint.h>
#include <math.h>

typedef unsigned short bf16_t;
typedef short bf16x8 __attribute__((ext_vector_type(8)));
typedef float f32x4 __attribute__((ext_vector_type(4)));

constexpr int D = 1024, BATCH = 8, SEQ = 4096, NMETA = 16, LREAL = NMETA + SEQ  , LP = 4224, ROWS = BATCH * LP;
constexpr int INC = 2560;
constexpr float EPS = 1e-6f;
constexpr float LAM_INIT = 0.2f;

__device__ __forceinline__ float bf2f(unsigned v) { return __uint_as_float(v << 16); }
__device__ __forceinline__ bf16_t f2bf(float f) { unsigned u = __float_as_uint(f); u += 0x7fffu + ((u >> 16) & 1u); return (bf16_t)(u >> 16); }
__device__ __forceinline__ unsigned pack2(float a, float b) { return (unsigned)f2bf(a) | ((unsigned)f2bf(b) << 16); }

__device__ __forceinline__ float wave_sum(float v) {
#pragma unroll
  for (int o = 32; o >= 1; o >>= 1) v += __shfl_xor(v, o);
  return v;
}
__device__ __forceinline__ float wave_max(float v) {
#pragma unroll
  for (int o = 32; o >= 1; o >>= 1) v = fmaxf(v, __shfl_xor(v, o));
  return v;
}

__device__ __forceinline__ int opaque_tid() { int t = threadIdx.x; asm volatile("" : "+v"(t)); return t; }

__device__ __forceinline__ const float* hrow_ptr(const float* x, const float* meta, int row) {
  int b = row / LP, pos = row - b * LP;
  if (pos < NMETA) return meta + (size_t)pos * D;
  if (pos < LREAL) return x + ((size_t)b * SEQ + (pos - NMETA)) * D;
  return nullptr;
}

__device__ __forceinline__ void p_norm1(int blk, float* red, const float* x, const float* meta, const float* g1, bf16_t* xn1,
                                               const float* lq1, const float* lk1, const float* lq2, const float* lk2, float* scal) {
  const int tix = opaque_tid();
  int row = blk, tid = (tix & 255);
  __syncthreads();
  const float* src = hrow_ptr(x, meta, row);
  float4 v = src ? ((const float4*)src)[tid] : make_float4(0.f, 0.f, 0.f, 0.f);
  float ss = v.x * v.x + v.y * v.y + v.z * v.z + v.w * v.w;
  ss = wave_sum(ss);
  if ((tid & 63) == 0) red[tid >> 6] = ss;
  __syncthreads();
  float tot = red[0] + red[1] + red[2] + red[3];
  float rstd = rsqrtf(tot * (1.0f / D) + EPS);
  float4 g = ((const float4*)g1)[tid];
  uint2 o; o.x = pack2(v.x * rstd * g.x, v.y * rstd * g.y); o.y = pack2(v.z * rstd * g.z, v.w * rstd * g.w);
  ((uint2*)(xn1 + (size_t)row * D))[tid] = o;
  if (row == 0 && tid < 64) {
    float a = lq1[tid] * lk1[tid], b2 = lq2[tid] * lk2[tid];
    a = wave_sum(a); b2 = wave_sum(b2);
    if (tid == 0) scal[0] = expf(a) - expf(b2) + LAM_INIT;
  }
}


typedef float f32x16 __attribute__((ext_vector_type(16)));
typedef short v4i16_t __attribute__((ext_vector_type(4)));
typedef __bf16 bf16v2_t __attribute__((ext_vector_type(2)));
typedef float f32x2_t __attribute__((ext_vector_type(2)));
#define LDSP(T, p) ((__attribute__((address_space(3))) T*)(p))
#define MFMA32(a, b, c) __builtin_amdgcn_mfma_f32_32x32x16_bf16((a), (b), (c), 0, 0, 0)
__device__ __forceinline__ unsigned cvtpk(float lo, float hi) { f32x2_t v = {lo, hi}; return __builtin_bit_cast(unsigned, __builtin_convertvector(v, bf16v2_t)); }
__device__ __forceinline__ float half_swap_max(float m) { auto rr = __builtin_amdgcn_permlane32_swap(__float_as_uint(m), __float_as_uint(m), false, false); return fmaxf(__uint_as_float(rr[0]), __uint_as_float(rr[1])); }
__device__ __forceinline__ float half_swap_sum(float m) { auto rr = __builtin_amdgcn_permlane32_swap(__float_as_uint(m), __float_as_uint(m), false, false); return __uint_as_float(rr[0]) + __uint_as_float(rr[1]); }

__device__ __forceinline__ void attn_issue_kv(char* kvbuf, const bf16_t* __restrict__ kvrow0  , int tid, int wid) {
  const char* base = (const char*)kvrow0;
#pragma unroll
  for (int i = 0; i < 2; ++i) {
    const int g = i * 512 + tid, row = g >> 4, pos = g & 15;
    const unsigned offk = (unsigned)(row * (INC * 2) + 1024 + ((pos ^ (row & 15)) << 4));
    const unsigned offv = (unsigned)(row * (INC * 2) + 2048 + ((pos ^ ((row & 3) << 2)) << 4));
    __builtin_amdgcn_global_load_lds((const unsigned*)(base + offk), LDSP(unsigned, kvbuf + (i * 512 + wid * 64) * 16), 16, 0, 0);
    __builtin_amdgcn_global_load_lds((const unsigned*)(base + offv), LDSP(unsigned, kvbuf + 16384 + (i * 512 + wid * 64) * 16), 16, 0, 0);
  }
}

template <bool MASKED>
__device__ __forceinline__ void attn_map(f32x16 (&o)[4], float& mref_io, float& l_io, const char* qbase, int qsw, const char* kb, const char* vb, int c, int kq, float sl8, int lane, int r32, int hi) {
  const float c1 = 0.125f * 1.4426950408889634f;
  asm volatile("" : "+v"(qsw), "+v"(lane));
  f32x16 s0, s1;
  {
    const float a1 = sl8, a2 = 2.0f * sl8, a3 = 3.0f * sl8, b8 = 8.0f * sl8;
    float gb = sl8 * (float)kq;
#pragma unroll
    for (int g = 0; g < 4; ++g) { s0[4 * g] = gb; s0[4 * g + 1] = gb + a1; s0[4 * g + 2] = gb + a2; s0[4 * g + 3] = gb + a3; gb += b8; }
#pragma unroll
    for (int g = 0; g < 4; ++g) { s1[4 * g] = gb; s1[4 * g + 1] = gb + a1; s1[4 * g + 2] = gb + a2; s1[4 * g + 3] = gb + a3; gb += b8; }
    if (MASKED) {
#pragma unroll
      for (int r = 0; r < 16; ++r) { s0[r] = s0[r] > 0.f ? -1e30f : s0[r]; s1[r] = s1[r] > 0.f ? -1e30f : s1[r]; }
    }
  }
#pragma unroll
  for (int ks = 0; ks < 4; ++ks) {
    const int ch = c * 8 + ks * 2 + hi;
    bf16x8 bq = *(const bf16x8*)(qbase + ((ch ^ qsw) << 4));
    bf16x8 ka0 = *(const bf16x8*)(kb + r32 * 256 + ((ch ^ qsw) << 4));
    bf16x8 ka1 = *(const bf16x8*)(kb + (32 + r32) * 256 + ((ch ^ qsw) << 4));
    s0 = MFMA32(ka0, bq, s0);
    s1 = MFMA32(ka1, bq, s1);
    __builtin_amdgcn_sched_barrier(0);
  }
  float mx = fmaxf(s0[0], s1[0]);
#pragma unroll
  for (int r = 1; r < 16; ++r) mx = fmaxf(mx, fmaxf(s0[r], s1[r]));
  mx = half_swap_max(mx);
  float mref = mref_io;
  if (__any((mx - mref) * c1 > 6.0f)) {
    const float mn = fmaxf(mref, mx);
    const float alpha = exp2f((mref - mn) * c1);
    l_io *= alpha;
#pragma unroll
    for (int i = 0; i < 4; ++i)
#pragma unroll
      for (int r = 0; r < 16; ++r) o[i][r] *= alpha;
    mref = mn; mref_io = mn;
  }
  const float nm = -mref * c1;
  float ls = 0.f;
#pragma unroll
  for (int r = 0; r < 16; ++r) { s0[r] = __builtin_amdgcn_exp2f(fmaf(s0[r], c1, nm)); s1[r] = __builtin_amdgcn_exp2f(fmaf(s1[r], c1, nm)); ls += s0[r] + s1[r]; }
  l_io += ls;
  const int q4 = (lane & 15) >> 2, g1 = (lane >> 4) & 1, p4 = lane & 3;
#pragma unroll
  for (int kk = 0; kk < 4; ++kk) {
    const int key0 = 16 * kk + 4 * hi + q4;
    uint4 pwv;
    if (kk < 2) { pwv.x = cvtpk(s0[8 * kk], s0[8 * kk + 1]); pwv.y = cvtpk(s0[8 * kk + 2], s0[8 * kk + 3]); pwv.z = cvtpk(s0[8 * kk + 4], s0[8 * kk + 5]); pwv.w = cvtpk(s0[8 * kk + 6], s0[8 * kk + 7]); }
    else { const int k2 = kk - 2; pwv.x = cvtpk(s1[8 * k2], s1[8 * k2 + 1]); pwv.y = cvtpk(s1[8 * k2 + 2], s1[8 * k2 + 3]); pwv.z = cvtpk(s1[8 * k2 + 4], s1[8 * k2 + 5]); pwv.w = cvtpk(s1[8 * k2 + 6], s1[8 * k2 + 7]); }
    const bf16x8 pb = __builtin_bit_cast(bf16x8, pwv);
#pragma unroll
    for (int dvt = 0; dvt < 4; ++dvt) {
      const int c8 = 8 * (dvt ^ q4) + 4 * g1 + p4;
      v4i16_t lo = __builtin_amdgcn_ds_read_tr16_b64_v4i16(LDSP(v4i16_t, vb + key0 * 256 + c8 * 8));
      v4i16_t hi4 = __builtin_amdgcn_ds_read_tr16_b64_v4i16(LDSP(v4i16_t, vb + (key0 + 8) * 256 + c8 * 8));
      bf16x8 va = (bf16x8){lo[0], lo[1], lo[2], lo[3], hi4[0], hi4[1], hi4[2], hi4[3]};
      o[dvt] = MFMA32(va, pb, o[dvt]);
    }
    __builtin_amdgcn_sched_barrier(0);
  }
}

__device__ __forceinline__ void attn_unit(char* lds, const bf16_t* __restrict__ proj, bf16_t* mix, const float* __restrict__ subg, float lam, int b, int h, int t) {
  const int tix = opaque_tid();
  const int tid = tix, lane = tid & 63, r32 = lane & 31, hi = lane >> 5;
  const int wid = __builtin_amdgcn_readfirstlane(tid >> 6);
  const int c = wid >> 2, qg = wid & 3;
  const int q0 = NMETA + 128 * t, qw0 = q0 + 32 * qg, qpos = qw0 + r32;
  const size_t rowb = (size_t)b * LP;
  const int NT = 2 * t + 3;
  char* Qs = lds;
  char* KV = lds + 32768;
  const float sl8 = exp2f(1.0f - 2.0f * (float)h);
  __syncthreads();
  attn_issue_kv(KV, proj + rowb * INC + h * 128, tid, wid);
#pragma unroll
  for (int i = 0; i < 4; ++i) {
    const int g = i * 512 + tid, row = g >> 4, pos = g & 15;
    uint4 v = *(const uint4*)(proj + (rowb + q0 + row) * INC + h * 128 + ((pos ^ (row & 15)) << 3));
    *(uint4*)(Qs + g * 16) = v;
  }
  f32x16 o[4];
#pragma unroll
  for (int i = 0; i < 4; ++i)
#pragma unroll
    for (int r = 0; r < 16; ++r) o[i][r] = 0.f;
  float m = -1e30f, l = 0.f;
  const int qrow = 32 * qg + r32;
  const char* qbase = Qs + qrow * 256;
  const int qsw = qrow & 15;
  for (int j = 0; j < NT; ++j) {
    __syncthreads();
    if (j + 1 < NT) attn_issue_kv(KV + ((j + 1) & 1) * 32768, proj + (rowb + 64 * (j + 1)) * INC + h * 128, tid, wid);
    if (64 * j > qw0 + 31) continue;
    const char* kb = KV + (j & 1) * 32768;
    const char* vb = kb + 16384;
    const int kq = 64 * j + 4 * hi - qpos;
    if (64 * j + 63 > qw0) attn_map<true>(o, m, l, qbase, qsw, kb, vb, c, kq, sl8, lane, r32, hi);
    else attn_map<false>(o, m, l, qbase, qsw, kb, vb, c, kq, sl8, lane, r32, hi);
  }
  l = half_swap_sum(l);
  const float sc = (c == 0 ? 1.0f : lam) / l;
  __syncthreads();
  float* X = (float*)(lds + 32768);
  if (c == 1) {
#pragma unroll
    for (int i = 0; i < 4; ++i)
#pragma unroll
      for (int r = 0; r < 16; ++r) X[(qg * 64 + i * 16 + r) * 64 + lane] = o[i][r] * sc;
  }
  __syncthreads();
  if (c == 0) {
    float ss = 0.f;
#pragma unroll
    for (int i = 0; i < 4; ++i) {
#pragma unroll
      for (int r = 0; r < 16; ++r) { float v = o[i][r] * sc - X[(qg * 64 + i * 16 + r) * 64 + lane]; o[i][r] = v; ss += v * v; }
      __builtin_amdgcn_sched_barrier(0);
    }
    ss = half_swap_sum(ss);
    const float rstd = rsqrtf(ss * (1.0f / 128.0f) + EPS) * (1.0f - LAM_INIT);
    bf16_t* orow = mix + (rowb + qpos) * D + h * 128;
#pragma unroll
    for (int i = 0; i < 4; ++i) {
#pragma unroll
      for (int g = 0; g < 4; ++g) {
        const int dv0 = 32 * i + 8 * g + 4 * hi;
        const float4 sg = *(const float4*)(subg + dv0);
        uint2 w; w.x = cvtpk(o[i][4 * g] * rstd * sg.x, o[i][4 * g + 1] * rstd * sg.y); w.y = cvtpk(o[i][4 * g + 2] * rstd * sg.z, o[i][4 * g + 3] * rstd * sg.w);
        *(uint2*)(orow + dv0) = w;
      }
      __builtin_amdgcn_sched_barrier(0);
    }
  }
}

__device__ __forceinline__ void p_conv_naive(int blk, const bf16_t* __restrict__ proj, bf16_t* mix, const float* cw, const float* cb, const float* gg_, const float* gb_) {
  const int tix = opaque_tid();
  int row = blk, tid = (tix & 255);
  int b = row / LP, pos = row - b * LP;
  int c0 = tid * 2;
  unsigned* outp = (unsigned*)(mix + (size_t)row * D + 512 + c0);
  if (pos >= LREAL) { *outp = 0u; return; }
  float y0 = cb[c0], y1 = cb[c0 + 1];
  for (int j = 0; j < 31; ++j) {
    int p = pos - 30 + j;
    if (p < 0) continue;
    const bf16_t* pr = proj + ((size_t)b * LP + p) * INC;
    unsigned a = *(const unsigned*)(pr + 1536 + c0), g = *(const unsigned*)(pr + 2048 + c0);
    float a0 = bf2f(a & 0xffffu), a1 = bf2f(a >> 16), g0 = bf2f(g & 0xffffu), g1 = bf2f(g >> 16);
    float u0 = a0 / (1.0f + __expf(-g0)), u1 = a1 / (1.0f + __expf(-g1));
    y0 += cw[j * 512 + c0] * u0; y1 += cw[j * 512 + c0 + 1] * u1;
  }
  float s = y0 + y1;
#pragma unroll
  for (int o = 16; o >= 1; o >>= 1) s += __shfl_xor(s, o);
  float mu = s * (1.0f / 64.0f);
  float d0 = y0 - mu, d1 = y1 - mu;
  float v = d0 * d0 + d1 * d1;
#pragma unroll
  for (int o = 16; o >= 1; o >>= 1) v += __shfl_xor(v, o);
  float rstd = rsqrtf(v * (1.0f / 64.0f) + EPS);
  float n0 = d0 * rstd * gg_[c0] + gb_[c0], n1 = d1 * rstd * gg_[c0 + 1] + gb_[c0 + 1];
  float r0 = n0 / (1.0f + __expf(-n0)), r1 = n1 / (1.0f + __expf(-n1));
  *outp = pack2(r0, r1);
}

__device__ __forceinline__ void p_norm2(int blk, float* red, const float* h2, const float* g2, bf16_t* xn2) {
  const int tix = opaque_tid();
  int row = blk, tid = (tix & 255);
  __syncthreads();
  float4 v = ((const float4*)(h2 + (size_t)row * D))[tid];
  float ss = v.x * v.x + v.y * v.y + v.z * v.z + v.w * v.w;
  ss = wave_sum(ss);
  if ((tid & 63) == 0) red[tid >> 6] = ss;
  __syncthreads();
  float tot = red[0] + red[1] + red[2] + red[3];
  float rstd = rsqrtf(tot * (1.0f / D) + EPS);
  float4 g = ((const float4*)g2)[tid];
  uint2 o; o.x = pack2(v.x * rstd * g.x, v.y * rstd * g.y); o.y = pack2(v.z * rstd * g.z, v.w * rstd * g.w);
  ((uint2*)(xn2 + (size_t)row * D))[tid] = o;
}

__device__ __forceinline__ void p_topk_naive(int blk, const bf16_t* __restrict__ qp, const float* __restrict__ sk, int* eb, float* gb) {
  const int tix = opaque_tid();
  int w = blk * 4 + ((tix & 255) >> 6), lane = (tix & 255) & 63;
  int row = w >> 3, h = w & 7;
  int pos = row % LP;
  if (pos < NMETA || pos >= LREAL) return;
  const float NEG = -3.0e38f;
  float top[2];
#pragma unroll
  for (int p = 0; p < 2; ++p) {
    const bf16_t* qv = qp + (size_t)row * 2048 + h * 256 + p * 128;
    const float* k0 = sk + ((size_t)(h * 2 + p) * 128 + lane) * 128;
    const float* k1 = k0 + 64 * 128;
    float s0 = 0.f, s1 = 0.f;
    for (int d = 0; d < 128; d += 8) {
      uint4 r = *(const uint4*)(qv + d);
      float qf[8] = {bf2f(r.x & 0xffffu), bf2f(r.x >> 16), bf2f(r.y & 0xffffu), bf2f(r.y >> 16), bf2f(r.z & 0xffffu), bf2f(r.z >> 16), bf2f(r.w & 0xffffu), bf2f(r.w >> 16)};
      float4 a0 = *(const float4*)(k0 + d), a1 = *(const float4*)(k0 + d + 4), b0 = *(const float4*)(k1 + d), b1 = *(const float4*)(k1 + d + 4);
      s0 += qf[0] * a0.x + qf[1] * a0.y + qf[2] * a0.z + qf[3] * a0.w + qf[4] * a1.x + qf[5] * a1.y + qf[6] * a1.z + qf[7] * a1.w;
      s1 += qf[0] * b0.x + qf[1] * b0.y + qf[2] * b0.z + qf[3] * b0.w + qf[4] * b1.x + qf[5] * b1.y + qf[6] * b1.z + qf[7] * b1.w;
    }
    float v0 = __uint_as_float((__float_as_uint(s0) & ~127u) | (unsigned)lane);
    float v1 = __uint_as_float((__float_as_uint(s1) & ~127u) | (unsigned)(lane + 64));
    float t = NEG;
    for (int it = 0; it < 16; ++it) {
      float m = wave_max(fmaxf(v0, v1));
      if (lane == it) t = m;
      if (v0 == m) v0 = NEG;
      if (v1 == m) v1 = NEG;
    }
    top[p] = t;
  }
  int ci = lane >> 2, jb = (lane & 3) * 4;
  float av = __uint_as_float(__float_as_uint(__shfl(top[0], ci)) & ~127u);
  float c[4];
#pragma unroll
  for (int jj = 0; jj < 4; ++jj) {
    float bv = __uint_as_float(__float_as_uint(__shfl(top[1], jb + jj)) & ~127u);
    float s = av + bv;
    c[jj] = __uint_as_float((__float_as_uint(s) & ~255u) | (unsigned)(ci * 16 + jb + jj));
  }
  float ct = NEG;
  for (int it = 0; it < 16; ++it) {
    float m = wave_max(fmaxf(fmaxf(c[0], c[1]), fmaxf(c[2], c[3])));
    if (lane == it) ct = m;
#pragma unroll
    for (int jj = 0; jj < 4; ++jj) if (c[jj] == m) c[jj] = NEG;
  }
  unsigned cbits = __float_as_uint(ct);
  int cidx = cbits & 255u;
  float cval = __uint_as_float(cbits & ~255u);
  int i1 = __float_as_uint(__shfl(top[0], (cidx >> 4) & 15)) & 127u;
  int i2 = __float_as_uint(__shfl(top[1], cidx & 15)) & 127u;
  float mx = __shfl(cval, 0);
  float ex = lane < 16 ? __expf(cval - mx) : 0.f;
  float sum = wave_sum(ex);
  if (lane < 16) {
    eb[((size_t)row * 8 + h) * 16 + lane] = i1 * 128 + i2;
    gb[((size_t)row * 8 + h) * 16 + lane] = ex / sum;
  }
}


__device__ __forceinline__ void ce_desc(float& a, float& b) { const float hi = fmaxf(a, b), lo = fminf(a, b); a = hi; b = lo; }
__device__ __forceinline__ void ce_asc(float& a, float& b) { const float hi = fmaxf(a, b), lo = fminf(a, b); a = lo; b = hi; }
template <int N> __device__ __forceinline__ void bitonic_sort_desc(float (&v)[N]) {
#pragma unroll
  for (int k = 2; k <= N; k <<= 1)
#pragma unroll
    for (int j = k >> 1; j > 0; j >>= 1)
#pragma unroll
      for (int i = 0; i < N; ++i) { const int l = i ^ j; if (l > i) { if ((i & k) == 0) ce_desc(v[i], v[l]); else ce_asc(v[i], v[l]); } }
}
template <int N> __device__ __forceinline__ void bitonic_merge_desc(float (&v)[N]) {
#pragma unroll
  for (int j = N >> 1; j > 0; j >>= 1)
#pragma unroll
    for (int i = 0; i < N; ++i) { const int l = i ^ j; if (l > i) ce_desc(v[i], v[l]); }
}
__device__ __forceinline__ void cep_desc(float& a, float& b, int& pa, int& pb) { const bool sw = b > a; const float hi = sw ? b : a, lo = sw ? a : b; const int ph = sw ? pb : pa, pl = sw ? pa : pb; a = hi; b = lo; pa = ph; pb = pl; }
__device__ __forceinline__ void cep_asc(float& a, float& b, int& pa, int& pb) { const bool sw = b < a; const float lo = sw ? b : a, hi = sw ? a : b; const int pl = sw ? pb : pa, ph = sw ? pa : pb; a = lo; b = hi; pa = pl; pb = ph; }
template <int N> __device__ __forceinline__ void bitonic_sortp_desc(float (&v)[N], int (&q)[N]) {
#pragma unroll
  for (int k = 2; k <= N; k <<= 1)
#pragma unroll
    for (int j = k >> 1; j > 0; j >>= 1)
#pragma unroll
      for (int i = 0; i < N; ++i) { const int l = i ^ j; if (l > i) { if ((i & k) == 0) cep_desc(v[i], v[l], q[i], q[l]); else cep_asc(v[i], v[l], q[i], q[l]); } }
}
template <int N> __device__ __forceinline__ void bitonic_mergep_desc(float (&v)[N], int (&q)[N]) {
#pragma unroll
  for (int j = N >> 1; j > 0; j >>= 1)
#pragma unroll
    for (int i = 0; i < N; ++i) { const int l = i ^ j; if (l > i) cep_desc(v[i], v[l], q[i], q[l]); }
}
__host__ __device__ constexpr int cand_slot(int i, int j) { int s = 0; for (int ii = 0; ii < i; ++ii) s += 16 / (ii + 1); return s + j; }

__device__ __forceinline__ void peer_topk_unit(char* lds, const bf16_t* __restrict__ qp, const bf16_t* __restrict__ skb, int* eb, float* gb, int row0, int h) {
  const int tix = opaque_tid();
  const int tid = tix, lane = tid & 63, wid = tid >> 6, fr = lane & 15, fq = lane >> 4;
  __syncthreads();
#pragma unroll
  for (int i = 0; i < 8; ++i) {
    const int g = i * 512 + tid, row = g >> 4, pos = g & 15;
    *(uint4*)(lds + g * 16) = *(const uint4*)(skb + ((size_t)(h * 2) * 128 + row) * 128 + ((pos ^ (row & 15)) << 3));
  }
  __syncthreads();
  const int tok = row0 + wid * 16 + fr;
  float top[2][16];
#pragma unroll
  for (int p = 0; p < 2; ++p) {
    f32x4 acc[8];
#pragma unroll
    for (int i = 0; i < 8; ++i) acc[i] = (f32x4){0.f, 0.f, 0.f, 0.f};
    const bf16_t* xrow = qp + (size_t)tok * 2048 + h * 256 + p * 128 + fq * 8;
#pragma unroll
    for (int ks = 0; ks < 4; ++ks) {
      const bf16x8 xb = *(const bf16x8*)(xrow + ks * 32);
      const int ch = ks * 4 + fq;
#pragma unroll
      for (int nt = 0; nt < 8; ++nt) {
        const int r = p * 128 + nt * 16 + fr;
        const bf16x8 wa = *(const bf16x8*)(lds + r * 256 + ((ch ^ (r & 15)) << 4));
        acc[nt] = __builtin_amdgcn_mfma_f32_16x16x32_bf16(wa, xb, acc[nt], 0, 0, 0);
      }
    }
    float v[32];
#pragma unroll
    for (int nt = 0; nt < 8; ++nt)
#pragma unroll
      for (int r = 0; r < 4; ++r) v[nt * 4 + r] = __uint_as_float((__float_as_uint(acc[nt][r]) & ~127u) | (unsigned)(nt * 16 + fq * 4 + r));
    bitonic_sort_desc<32>(v);
    float t[16];
#pragma unroll
    for (int i = 0; i < 16; ++i) t[i] = v[i];
#pragma unroll
    for (int rnd = 0; rnd < 2; ++rnd) {
      float pb[16];
#pragma unroll
      for (int i = 0; i < 16; ++i) pb[i] = __shfl_xor(t[15 - i], rnd == 0 ? 16 : 32);
#pragma unroll
      for (int i = 0; i < 16; ++i) t[i] = fmaxf(t[i], pb[i]);
      bitonic_merge_desc<16>(t);
    }
#pragma unroll
    for (int i = 0; i < 16; ++i) top[p][i] = t[i];
  }
  float cv[64]; int cq[64];
#pragma unroll
  for (int i = 50; i < 64; ++i) { cv[i] = -3.0e38f; cq[i] = 0; }
#pragma unroll
  for (int i = 0; i < 16; ++i)
#pragma unroll
    for (int j = 0; j < 16; ++j)
      if ((i + 1) * (j + 1) <= 16) {
        const unsigned ab = __float_as_uint(top[0][i]), bb = __float_as_uint(top[1][j]);
        cv[cand_slot(i, j)] = __uint_as_float(ab & ~127u) + __uint_as_float(bb & ~127u);
        cq[cand_slot(i, j)] = (int)(((ab & 127u) << 7) | (bb & 127u));
      }
  bitonic_sortp_desc<64>(cv, cq);
  float ex[16]; float sum = 0.f;
#pragma unroll
  for (int i = 0; i < 16; ++i) { ex[i] = __expf(cv[i] - cv[0]); sum += ex[i]; }
  const float inv = 1.0f / sum;
  int* ep = eb + ((size_t)tok * 8 + h) * 16;
  float* gp = gb + ((size_t)tok * 8 + h) * 16;
  if (fq == 0) { *(int4*)(ep) = make_int4(cq[0], cq[1], cq[2], cq[3]); *(float4*)(gp) = make_float4(ex[0] * inv, ex[1] * inv, ex[2] * inv, ex[3] * inv); }
  else if (fq == 1) { *(int4*)(ep + 4) = make_int4(cq[4], cq[5], cq[6], cq[7]); *(float4*)(gp + 4) = make_float4(ex[4] * inv, ex[5] * inv, ex[6] * inv, ex[7] * inv); }
  else if (fq == 2) { *(int4*)(ep + 8) = make_int4(cq[8], cq[9], cq[10], cq[11]); *(float4*)(gp + 8) = make_float4(ex[8] * inv, ex[9] * inv, ex[10] * inv, ex[11] * inv); }
  else { *(int4*)(ep + 12) = make_int4(cq[12], cq[13], cq[14], cq[15]); *(float4*)(gp + 12) = make_float4(ex[12] * inv, ex[13] * inv, ex[14] * inv, ex[15] * inv); }
}

__device__ __forceinline__ void p_cvt_bf16(int blk, int nblk, const float* __restrict__ src, bf16_t* dst, size_t n8) {
  const int tix = opaque_tid();
  for (size_t i = (size_t)blk * 512 + tix; i < n8; i += (size_t)nblk * 512) {
    const float4 a = ((const float4*)src)[2 * i], b = ((const float4*)src)[2 * i + 1];
    uint4 w; w.x = cvtpk(a.x, a.y); w.y = cvtpk(a.z, a.w); w.z = cvtpk(b.x, b.y); w.w = cvtpk(b.z, b.w);
    ((uint4*)dst)[i] = w;
  }
}


typedef __bf16 bf16v2 __attribute__((ext_vector_type(2)));
__device__ __forceinline__ float dot8(uint4 a, uint4 b, float acc) {
  acc = __builtin_amdgcn_fdot2_f32_bf16(__builtin_bit_cast(bf16v2, a.x), __builtin_bit_cast(bf16v2, b.x), acc, false);
  acc = __builtin_amdgcn_fdot2_f32_bf16(__builtin_bit_cast(bf16v2, a.y), __builtin_bit_cast(bf16v2, b.y), acc, false);
  acc = __builtin_amdgcn_fdot2_f32_bf16(__builtin_bit_cast(bf16v2, a.z), __builtin_bit_cast(bf16v2, b.z), acc, false);
  acc = __builtin_amdgcn_fdot2_f32_bf16(__builtin_bit_cast(bf16v2, a.w), __builtin_bit_cast(bf16v2, b.w), acc, false);
  return acc;
}
__device__ __forceinline__ float row16_sum(float v) {
  v += __builtin_bit_cast(float, __builtin_amdgcn_update_dpp(0, __builtin_bit_cast(int, v), 0x128, 0xf, 0xf, true));
  v += __builtin_bit_cast(float, __builtin_amdgcn_update_dpp(0, __builtin_bit_cast(int, v), 0x124, 0xf, 0xf, true));
  v += __builtin_bit_cast(float, __builtin_amdgcn_update_dpp(0, __builtin_bit_cast(int, v), 0x122, 0xf, 0xf, true));
  v += __builtin_bit_cast(float, __builtin_amdgcn_update_dpp(0, __builtin_bit_cast(int, v), 0x121, 0xf, 0xf, true));
  return v;
}
__device__ __forceinline__ void peer_gather_token(char* wlds  , int lane, size_t row, size_t orow, const bf16_t* __restrict__ xn2, const float* __restrict__ h2,
                                                  const int* __restrict__ eb, const float* __restrict__ gb, const bf16_t* __restrict__ utb, const bf16_t* __restrict__ vtb,
                                                  const float* __restrict__ fg, float* __restrict__ out) {
  int* E = (int*)wlds; float* Gt = (float*)(wlds + 512); float* W = (float*)(wlds + 1024);
  const int i16 = lane & 15, g = lane >> 4;
  E[lane] = eb[row * 128 + lane]; E[lane + 64] = eb[row * 128 + 64 + lane];
  Gt[lane] = gb[row * 128 + lane]; Gt[lane + 64] = gb[row * 128 + 64 + lane];
  uint4 xr[8];
#pragma unroll
  for (int k = 0; k < 8; ++k) xr[k] = *(const uint4*)(xn2 + row * D + 128 * k + 8 * i16);
#pragma unroll 2
  for (int m = 0; m < 32; ++m) {
    const int e = E[4 * m + g];
    const bf16_t* ur = utb + (size_t)e * D + 8 * i16;
    uint4 u[8];
#pragma unroll
    for (int k = 0; k < 8; ++k) u[k] = *(const uint4*)(ur + 128 * k);
    float d0 = 0.f, d1 = 0.f;
#pragma unroll
    for (int k = 0; k < 8; k += 2) { d0 = dot8(xr[k], u[k], d0); d1 = dot8(xr[k + 1], u[k + 1], d1); }
    const float d = row16_sum(d0 + d1);
    if (i16 == 0) W[4 * m + g] = d;
  }
  {
    const float a0 = W[lane], a1 = W[lane + 64];
    W[lane] = Gt[lane] * 0.5f * a0 * (1.0f + erff(a0 * 0.70710678118654752f));
    W[lane + 64] = Gt[lane + 64] * 0.5f * a1 * (1.0f + erff(a1 * 0.70710678118654752f));
  }
  float acc[64];
#pragma unroll
  for (int i = 0; i < 64; ++i) acc[i] = 0.f;
#pragma unroll 2
  for (int m = 0; m < 32; ++m) {
    const int e = E[4 * m + g];
    const float w = W[4 * m + g];
    const bf16_t* vr = vtb + (size_t)e * D + 8 * i16;
    uint4 v[8];
#pragma unroll
    for (int k = 0; k < 8; ++k) v[k] = *(const uint4*)(vr + 128 * k);
#pragma unroll
    for (int k = 0; k < 8; ++k) {
      acc[k * 8 + 0] += w * __uint_as_float(v[k].x << 16); acc[k * 8 + 1] += w * __uint_as_float(v[k].x & 0xffff0000u);
      acc[k * 8 + 2] += w * __uint_as_float(v[k].y << 16); acc[k * 8 + 3] += w * __uint_as_float(v[k].y & 0xffff0000u);
      acc[k * 8 + 4] += w * __uint_as_float(v[k].z << 16); acc[k * 8 + 5] += w * __uint_as_float(v[k].z & 0xffff0000u);
      acc[k * 8 + 6] += w * __uint_as_float(v[k].w << 16); acc[k * 8 + 7] += w * __uint_as_float(v[k].w & 0xffff0000u);
    }
  }
  float res[16];
#pragma unroll
  for (int k = 0; k < 8; ++k)
#pragma unroll
    for (int j = 0; j < 8; ++j) {
      float t = acc[k * 8 + j];
      t += __shfl_xor(t, 16); t += __shfl_xor(t, 32);
      if ((k >> 1) == g) res[(k & 1) * 8 + j] = t;
    }
  float ss = 0.f;
#pragma unroll
  for (int kk = 0; kk < 2; ++kk) {
    const float4 h0 = *(const float4*)(h2 + row * D + 128 * (2 * g + kk) + 8 * i16), h1 = *(const float4*)(h2 + row * D + 128 * (2 * g + kk) + 8 * i16 + 4);
    res[kk * 8 + 0] += h0.x; res[kk * 8 + 1] += h0.y; res[kk * 8 + 2] += h0.z; res[kk * 8 + 3] += h0.w;
    res[kk * 8 + 4] += h1.x; res[kk * 8 + 5] += h1.y; res[kk * 8 + 6] += h1.z; res[kk * 8 + 7] += h1.w;
  }
#pragma unroll
  for (int i = 0; i < 16; ++i) ss += res[i] * res[i];
  ss = wave_sum(ss);
  const float rstd = rsqrtf(ss * (1.0f / D) + EPS);
#pragma unroll
  for (int kk = 0; kk < 2; ++kk) {
    const int c0 = 128 * (2 * g + kk) + 8 * i16;
    const float4 f0 = *(const float4*)(fg + c0), f1 = *(const float4*)(fg + c0 + 4);
    *(float4*)(out + orow * D + c0) = make_float4(res[kk * 8] * rstd * f0.x, res[kk * 8 + 1] * rstd * f0.y, res[kk * 8 + 2] * rstd * f0.z, res[kk * 8 + 3] * rstd * f0.w);
    *(float4*)(out + orow * D + c0 + 4) = make_float4(res[kk * 8 + 4] * rstd * f1.x, res[kk * 8 + 5] * rstd * f1.y, res[kk * 8 + 6] * rstd * f1.z, res[kk * 8 + 7] * rstd * f1.w);
  }
}

__device__ __forceinline__ void p_gather_naive(int blk, const bf16_t* __restrict__ xn2, const float* __restrict__ h2, const int* __restrict__ eb, const float* __restrict__ gb,
                                                      const float* __restrict__ ut, const float* __restrict__ vt, const float* fg, float* out) {
  const int tix = opaque_tid();
  int tk = blk * 4 + ((tix & 255) >> 6), lane = (tix & 255) & 63;
  int b = tk / SEQ, s = tk - b * SEQ;
  size_t row = (size_t)b * LP + NMETA + s;
  float xv[16];
  {
    const uint4* xp = (const uint4*)(xn2 + row * D + lane * 16);
#pragma unroll
    for (int i = 0; i < 2; ++i) {
      uint4 r = xp[i];
      xv[i * 8 + 0] = bf2f(r.x & 0xffffu); xv[i * 8 + 1] = bf2f(r.x >> 16); xv[i * 8 + 2] = bf2f(r.y & 0xffffu); xv[i * 8 + 3] = bf2f(r.y >> 16);
      xv[i * 8 + 4] = bf2f(r.z & 0xffffu); xv[i * 8 + 5] = bf2f(r.z >> 16); xv[i * 8 + 6] = bf2f(r.w & 0xffffu); xv[i * 8 + 7] = bf2f(r.w >> 16);
    }
  }
  float acc[16];
#pragma unroll
  for (int i = 0; i < 16; ++i) acc[i] = 0.f;
  for (int k = 0; k < 128; ++k) {
    int e = eb[row * 128 + k];
    float gate = gb[row * 128 + k];
    const float4* up = (const float4*)(ut + (size_t)e * D + lane * 16);
    float dsum = 0.f;
#pragma unroll
    for (int i = 0; i < 4; ++i) { float4 u = up[i]; dsum += u.x * xv[i * 4] + u.y * xv[i * 4 + 1] + u.z * xv[i * 4 + 2] + u.w * xv[i * 4 + 3]; }
    dsum = wave_sum(dsum);
    float act = 0.5f * dsum * (1.0f + erff(dsum * 0.70710678118654752f));
    float wgt = gate * act;
    const float4* vp = (const float4*)(vt + (size_t)e * D + lane * 16);
#pragma unroll
    for (int i = 0; i < 4; ++i) { float4 v = vp[i]; acc[i * 4] += wgt * v.x; acc[i * 4 + 1] += wgt * v.y; acc[i * 4 + 2] += wgt * v.z; acc[i * 4 + 3] += wgt * v.w; }
  }
  const float4* hp = (const float4*)(h2 + row * D + lane * 16);
  float ss = 0.f;
#pragma unroll
  for (int i = 0; i < 4; ++i) { float4 hv = hp[i]; acc[i * 4] += hv.x; acc[i * 4 + 1] += hv.y; acc[i * 4 + 2] += hv.z; acc[i * 4 + 3] += hv.w; }
#pragma unroll
  for (int i = 0; i < 16; ++i) ss += acc[i] * acc[i];
  ss = wave_sum(ss);
  float rstd = rsqrtf(ss * (1.0f / D) + EPS);
  float4* op = (float4*)(out + ((size_t)b * SEQ + s) * D + lane * 16);
  const float4* gp = (const float4*)(fg + lane * 16);
#pragma unroll
  for (int i = 0; i < 4; ++i) { float4 g = gp[i]; op[i] = make_float4(acc[i * 4] * rstd * g.x, acc[i * 4 + 1] * rstd * g.y, acc[i * 4 + 2] * rstd * g.z, acc[i * 4 + 3] * rstd * g.w); }
}


template <class Epi>
__device__ __forceinline__ void gemm_tile(char* lds, const bf16_t* __restrict__ X, int ldx, const bf16_t* __restrict__ Wt, int ldw, int K, int m0, int n0, const Epi& epi) {
  const int tix = opaque_tid();
  const int tid = tix, lane = tid & 63, wid = tid >> 6;
  const int wm = wid >> 1, wn = wid & 1;
  const int sc = tid & 7, sr = tid >> 3;
  f32x4 acc[4][4];
#pragma unroll
  for (int i = 0; i < 4; ++i)
#pragma unroll
    for (int j = 0; j < 4; ++j) acc[i][j] = (f32x4){0.f, 0.f, 0.f, 0.f};
  uint4 ra[4], rb[2];
  const bf16_t* xp = X + (size_t)(m0 + sr) * ldx + sc * 8;
  const bf16_t* wp = Wt + (size_t)(n0 + sr) * ldw + sc * 8;
  const int nk = K >> 6;
#pragma unroll
  for (int i = 0; i < 4; ++i) ra[i] = *(const uint4*)(xp + (size_t)(64 * i) * ldx);
#pragma unroll
  for (int i = 0; i < 2; ++i) rb[i] = *(const uint4*)(wp + (size_t)(64 * i) * ldw);
#pragma unroll
  for (int i = 0; i < 4; ++i) { int r = sr + 64 * i; *(uint4*)(lds + r * 128 + ((sc ^ ((r >> 1) & 7)) << 4)) = ra[i]; }
#pragma unroll
  for (int i = 0; i < 2; ++i) { int r = sr + 64 * i; *(uint4*)(lds + 32768 + r * 128 + ((sc ^ ((r >> 1) & 7)) << 4)) = rb[i]; }
  __syncthreads();
  const int fr = lane & 15, fq = lane >> 4;
  for (int kt = 0; kt < nk; ++kt) {
    if (kt + 1 < nk) {
#pragma unroll
      for (int i = 0; i < 4; ++i) ra[i] = *(const uint4*)(xp + (size_t)(64 * i) * ldx + (kt + 1) * 64);
#pragma unroll
      for (int i = 0; i < 2; ++i) rb[i] = *(const uint4*)(wp + (size_t)(64 * i) * ldw + (kt + 1) * 64);
    }
    const char* la = lds + (kt & 1) * 49152;
    const char* lb = la + 32768;
#pragma unroll
    for (int kk = 0; kk < 2; ++kk) {
      bf16x8 xa[4], wb[4];
      const int c = kk * 4 + fq;
#pragma unroll
      for (int t = 0; t < 4; ++t) {
        int r = wm * 64 + t * 16 + fr; xa[t] = *(const bf16x8*)(la + r * 128 + ((c ^ ((r >> 1) & 7)) << 4));
        int r2 = wn * 64 + t * 16 + fr; wb[t] = *(const bf16x8*)(lb + r2 * 128 + ((c ^ ((r2 >> 1) & 7)) << 4));
      }
#pragma unroll
      for (int nt = 0; nt < 4; ++nt)
#pragma unroll
        for (int tt = 0; tt < 4; ++tt) acc[nt][tt] = __builtin_amdgcn_mfma_f32_16x16x32_bf16(wb[nt], xa[tt], acc[nt][tt], 0, 0, 0);
    }
    if (kt + 1 < nk) {
      char* lw = lds + ((kt + 1) & 1) * 49152;
#pragma unroll
      for (int i = 0; i < 4; ++i) { int r = sr + 64 * i; *(uint4*)(lw + r * 128 + ((sc ^ ((r >> 1) & 7)) << 4)) = ra[i]; }
#pragma unroll
      for (int i = 0; i < 2; ++i) { int r = sr + 64 * i; *(uint4*)(lw + 32768 + r * 128 + ((sc ^ ((r >> 1) & 7)) << 4)) = rb[i]; }
    }
    __syncthreads();
  }
#pragma unroll
  for (int nt = 0; nt < 4; ++nt)
#pragma unroll
    for (int tt = 0; tt < 4; ++tt) epi(m0 + wm * 64 + tt * 16 + fr, n0 + wn * 64 + nt * 16 + fq * 4, acc[nt][tt]);
}

struct Epi4StoreBf16 { bf16_t* out; int ld; int pad; __device__ __forceinline__ void operator()(int r, int c, f32x4 v) const {
  uint2 w; w.x = pack2(v[0], v[1]); w.y = pack2(v[2], v[3]); *(uint2*)(out + (size_t)r * ld + c) = w; } };
struct Epi4Resid { const float* x; const float* meta; float* h2; __device__ __forceinline__ void operator()(int r, int c, f32x4 v) const {
  const float* src = hrow_ptr(x, meta, r); float4 hv = src ? *(const float4*)(src + c) : make_float4(0.f, 0.f, 0.f, 0.f);
  *(float4*)(h2 + (size_t)r * D + c) = make_float4(hv.x + v[0], hv.y + v[1], hv.z + v[2], hv.w + v[3]); } };

__device__ __forceinline__ void p_transpose(int t, float* smem, const float* __restrict__ W, bf16_t* Wt, int K, int N) {
  const int tix = opaque_tid();
  float (*T)[65] = (float (*)[65])smem;
  const int nbx = N / 64, k0 = (t / nbx) * 64, n0 = (t % nbx) * 64, tid = (tix & 255);
  const int j = tid & 63, i0 = tid >> 6;
#pragma unroll
  for (int ii = 0; ii < 16; ++ii) { int i = i0 + 4 * ii; T[i][j] = W[(size_t)(k0 + i) * N + n0 + j]; }
  __syncthreads();
#pragma unroll
  for (int ii = 0; ii < 16; ++ii) { int jj = i0 + 4 * ii; Wt[(size_t)(n0 + jj) * K + k0 + j] = f2bf(T[j][jj]); }
  __syncthreads();
}
struct Params {
  const float *x, *meta, *g1, *w_in, *lq1, *lk1, *lq2, *lk2, *subg, *conv_w, *conv_b, *gn_g, *gn_b, *w_out, *g2, *wq, *sk, *ut, *vt, *fg;
  float* out; float* scal; bf16_t* r1; bf16_t* r2; float* h2; int* eb; float* gb; bf16_t* wt_in; bf16_t* wt_out; bf16_t* wt_q; bf16_t* skb; bf16_t* utb; bf16_t* vtb;
};

__global__ void __launch_bounds__(512, 2) mega(Params p) {
  cg::grid_group grid = cg::this_grid();
  __shared__ __attribute__((aligned(16))) char smem_c[131072];
  float* smem = (float*)smem_c;
  const int G = gridDim.x, vh = threadIdx.x >> 8;
  bf16_t* xn1 = p.r1; bf16_t* mix = p.r1; bf16_t* xn2 = p.r1; bf16_t* proj = p.r2; bf16_t* qp = p.r2;
  for (int b = blockIdx.x; b < ROWS / 2; b += G) p_norm1(b * 2 + vh, smem + 4 * vh, p.x, p.meta, p.g1, xn1, p.lq1, p.lk1, p.lq2, p.lk2, p.scal);
  for (int b = blockIdx.x; b < (640 + 256 + 512) / 2; b += G) {
    const int bb = b * 2 + vh; float* sm = smem + vh * (64 * 65);
    if (bb < 640) p_transpose(bb, sm, p.w_in, p.wt_in, D, INC);
    else if (bb < 896) p_transpose(bb - 640, sm, p.w_out, p.wt_out, D, D);
    else p_transpose(bb - 896, sm, p.wq, p.wt_q, D, 2048);
  }
  p_cvt_bf16(blockIdx.x, G, p.sk, p.skb, (size_t)16 * 128 * 128 / 8);
  p_cvt_bf16(blockIdx.x, G, p.ut, p.utb, (size_t)16384 * D / 8);
  p_cvt_bf16(blockIdx.x, G, p.vt, p.vtb, (size_t)16384 * D / 8);
  grid.sync();
  for (int b = blockIdx.x; b < (INC / 128) * (ROWS / 256); b += G) gemm_tile(smem_c, xn1, D, p.wt_in, D, D, (b / (INC / 128)) * 256, (b % (INC / 128)) * 128, Epi4StoreBf16{proj, INC, 0});
  grid.sync();
  {
    const float lam = p.scal[0];
    for (int u = blockIdx.x; u < 256; u += G) {
      const int bh = (u & 7) * 4 + (u >> 6), tp = (u >> 3) & 7;
#pragma unroll 1
      for (int k = 0; k < 4; ++k) {
        const int t = (k == 0) ? 31 - tp : (k == 1) ? 16 + tp : (k == 2) ? 15 - tp : tp;
        attn_unit(smem_c, proj, mix, p.subg, lam, bh >> 2, bh & 3, t);
      }
    }
  }
  for (int b = blockIdx.x; b < ROWS / 2; b += G) p_conv_naive(b * 2 + vh, proj, mix, p.conv_w, p.conv_b, p.gn_g, p.gn_b);
  grid.sync();
  for (int b = blockIdx.x; b < (D / 128) * (ROWS / 256); b += G) gemm_tile(smem_c, mix, D, p.wt_out, D, D, (b / (D / 128)) * 256, (b % (D / 128)) * 128, Epi4Resid{p.x, p.meta, p.h2});
  grid.sync();
  for (int b = blockIdx.x; b < ROWS / 2; b += G) p_norm2(b * 2 + vh, smem + 4 * vh, p.h2, p.g2, xn2);
  grid.sync();
  for (int b = blockIdx.x; b < (2048 / 128) * (ROWS / 256); b += G) gemm_tile(smem_c, xn2, D, p.wt_q, D, D, (b / 16) * 256, (b % 16) * 128, Epi4StoreBf16{qp, 2048, 0});
  grid.sync();
  for (int u = blockIdx.x; u < 256 * 8; u += G) {
    const int rt = u >> 3, h = u & 7;
    peer_topk_unit(smem_c, qp, p.skb, p.eb, p.gb, (rt >> 5) * LP + NMETA + 128 * (rt & 31), h);
  }
  grid.sync();
  {
    const int tix = opaque_tid();
    const int lane = tix & 63, wid = tix >> 6;
    for (int tk = blockIdx.x * 8 + wid; tk < BATCH * SEQ; tk += G * 8) {
      const int b = tk / SEQ, sq = tk - b * SEQ;
      peer_gather_token(smem_c + wid * 1536, lane, (size_t)b * LP + NMETA + sq, (size_t)tk, xn2, p.h2, p.eb, p.gb, p.utb, p.vtb, p.fg, p.out);
    }
  }
}

extern "C" void kernel_launch(void* const* d_in, const int* in_sizes, int n_in, void* d_out, int out_size, void* d_ws, size_t ws_size, hipStream_t stream) {
  static int grid_blocks = 0;
  if (!grid_blocks) {
    int dev = 0, cus = 0, per_cu = 0;
    hipGetDevice(&dev);
    hipDeviceGetAttribute(&cus, hipDeviceAttributeMultiprocessorCount, dev);
    hipOccupancyMaxActiveBlocksPerMultiprocessor(&per_cu, mega, 512, 0);
    if (per_cu > 1) per_cu = 1;
    if (per_cu < 1) per_cu = 1;
    grid_blocks = cus * per_cu;
  }
  Params p{};
  const float** pp = (const float**)&p;
  for (int i = 0; i < 20; ++i) pp[i] = (const float*)d_in[i];
  p.out = (float*)d_out;
  char* ws = (char*)d_ws;
  size_t off = 0;
  p.scal = (float*)(ws + off); off += 4096;
  p.r1 = (bf16_t*)(ws + off); off += (size_t)ROWS * D * 2;
  p.r2 = (bf16_t*)(ws + off); off += (size_t)ROWS * INC * 2;
  p.h2 = (float*)(ws + off); off += (size_t)ROWS * D * 4;
  p.wt_in = (bf16_t*)(ws + off); off += (size_t)INC * D * 2;
  p.wt_out = (bf16_t*)(ws + off); off += (size_t)D * D * 2;
  p.wt_q = (bf16_t*)(ws + off); off += (size_t)2048 * D * 2;
  p.skb = (bf16_t*)(ws + off); off += (size_t)16 * 128 * 128 * 2;
  p.utb = (bf16_t*)(ws + off); off += (size_t)16384 * D * 2;
  p.vtb = (bf16_t*)(ws + off); off += (size_t)16384 * D * 2;
  p.eb = (int*)((char*)p.r2 + (size_t)ROWS * 2048 * 2);
  p.gb = (float*)((char*)p.eb + (size_t)ROWS * 128 * 4);
  void* args[] = {&p};
  hipError_t e = hipLaunchCooperativeKernel((void*)mega, dim3(grid_blocks), dim3(512), args, 0, stream);
  if (e != hipSuccess) fprintf(stderr, "cooperative launch failed: %s (grid %d)\n", hipGetErrorString(e), grid_blocks);
}
```

```cpp
#include <hip/hip_runtime.h>
#include <hip/hip_cooperative_groups.h>
#include <cstdio>
namespace cg = cooperative_groups;
#include <stdint.h>
#include <math.h>

typedef unsigned short bf16_t;
typedef short bf16x8 __attribute__((ext_vector_type(8)));
typedef float f32x4 __attribute__((ext_vector_type(4)));

constexpr int D = 1024, BATCH = 8, SEQ = 4096, NMETA = 16, LREAL = NMETA + SEQ  , LP = 4224, ROWS = BATCH * LP;
constexpr int INC = 2560;
constexpr float EPS = 1e-6f;
constexpr float LAM_INIT = 0.2f;

__device__ __forceinline__ float bf2f(unsigned v) { return __uint_as_float(v << 16); }
__device__ __forceinline__ bf16_t f2bf(float f) { unsigned u = __float_as_uint(f); u += 0x7fffu + ((u >> 16) & 1u); return (bf16_t)(u >> 16); }
__device__ __forceinline__ unsigned pack2(float a, float b) { return (unsigned)f2bf(a) | ((unsigned)f2bf(b) << 16); }

__device__ __forceinline__ float wave_sum(float v) {
#pragma unroll
  for (int o = 32; o >= 1; o >>= 1) v += __shfl_xor(v, o);
  return v;
}
__device__ __forceinline__ float wave_max(float v) {
#pragma unroll
  for (int o = 32; o >= 1; o >>= 1) v = fmaxf(v, __shfl_xor(v, o));
  return v;
}

__device__ __forceinline__ int opaque_tid() { int t = threadIdx.x; asm volatile("" : "+v"(t)); return t; }

__device__ __forceinline__ const float* hrow_ptr(const float* x, const float* meta, int row) {
  int b = row / LP, pos = row - b * LP;
  if (pos < NMETA) return meta + (size_t)pos * D;
  if (pos < LREAL) return x + ((size_t)b * SEQ + (pos - NMETA)) * D;
  return nullptr;
}

__device__ __forceinline__ void p_norm1(int blk, float* red, const float* x, const float* meta, const float* g1, bf16_t* xn1,
                                               const float* lq1, const float* lk1, const float* lq2, const float* lk2, float* scal) {
  const int tix = opaque_tid();
  int row = blk, tid = (tix & 255);
  __syncthreads();
  const float* src = hrow_ptr(x, meta, row);
  float4 v = src ? ((const float4*)src)[tid] : make_float4(0.f, 0.f, 0.f, 0.f);
  float ss = v.x * v.x + v.y * v.y + v.z * v.z + v.w * v.w;
  ss = wave_sum(ss);
  if ((tid & 63) == 0) red[tid >> 6] = ss;
  __syncthreads();
  float tot = red[0] + red[1] + red[2] + red[3];
  float rstd = rsqrtf(tot * (1.0f / D) + EPS);
  float4 g = ((const float4*)g1)[tid];
  uint2 o; o.x = pack2(v.x * rstd * g.x, v.y * rstd * g.y); o.y = pack2(v.z * rstd * g.z, v.w * rstd * g.w);
  ((uint2*)(xn1 + (size_t)row * D))[tid] = o;
  if (row == 0 && tid < 64) {
    float a = lq1[tid] * lk1[tid], b2 = lq2[tid] * lk2[tid];
    a = wave_sum(a); b2 = wave_sum(b2);
    if (tid == 0) scal[0] = expf(a) - expf(b2) + LAM_INIT;
  }
}


typedef float f32x16 __attribute__((ext_vector_type(16)));
typedef short v4i16_t __attribute__((ext_vector_type(4)));
typedef __bf16 bf16v2_t __attribute__((ext_vector_type(2)));
typedef float f32x2_t __attribute__((ext_vector_type(2)));
#define LDSP(T, p) ((__attribute__((address_space(3))) T*)(p))
#define MFMA32(a, b, c) __builtin_amdgcn_mfma_f32_32x32x16_bf16((a), (b), (c), 0, 0, 0)
__device__ __forceinline__ unsigned cvtpk(float lo, float hi) { f32x2_t v = {lo, hi}; return __builtin_bit_cast(unsigned, __builtin_convertvector(v, bf16v2_t)); }
__device__ __forceinline__ float half_swap_max(float m) { auto rr = __builtin_amdgcn_permlane32_swap(__float_as_uint(m), __float_as_uint(m), false, false); return fmaxf(__uint_as_float(rr[0]), __uint_as_float(rr[1])); }
__device__ __forceinline__ float half_swap_sum(float m) { auto rr = __builtin_amdgcn_permlane32_swap(__float_as_uint(m), __float_as_uint(m), false, false); return __uint_as_float(rr[0]) + __uint_as_float(rr[1]); }

__device__ __forceinline__ void attn_issue_kv(char* kvbuf, const bf16_t* __restrict__ kvrow0  , int tid, int wid) {
  const char* base = (const char*)kvrow0;
#pragma unroll
  for (int i = 0; i < 2; ++i) {
    const int g = i * 512 + tid, row = g >> 4, pos = g & 15;
    const unsigned offk = (unsigned)(row * (INC * 2) + 1024 + ((pos ^ (row & 15)) << 4));
    const unsigned offv = (unsigned)(row * (INC * 2) + 2048 + ((pos ^ ((row & 3) << 2)) << 4));
    __builtin_amdgcn_global_load_lds((const unsigned*)(base + offk), LDSP(unsigned, kvbuf + (i * 512 + wid * 64) * 16), 16, 0, 0);
    __builtin_amdgcn_global_load_lds((const unsigned*)(base + offv), LDSP(unsigned, kvbuf + 16384 + (i * 512 + wid * 64) * 16), 16, 0, 0);
  }
}

template <bool MASKED>
__device__ __forceinline__ void attn_map(f32x16 (&o)[4], float& mref_io, float& l_io, const char* qbase, int qsw, const char* kb, const char* vb, int c, int kq, float sl8, int lane, int r32, int hi) {
  const float c1 = 0.125f * 1.4426950408889634f;
  asm volatile("" : "+v"(qsw), "+v"(lane));
  f32x16 s0, s1;
  {
    const float a1 = sl8, a2 = 2.0f * sl8, a3 = 3.0f * sl8, b8 = 8.0f * sl8;
    float gb = sl8 * (float)kq;
#pragma unroll
    for (int g = 0; g < 4; ++g) { s0[4 * g] = gb; s0[4 * g + 1] = gb + a1; s0[4 * g + 2] = gb + a2; s0[4 * g + 3] = gb + a3; gb += b8; }
#pragma unroll
    for (int g = 0; g < 4; ++g) { s1[4 * g] = gb; s1[4 * g + 1] = gb + a1; s1[4 * g + 2] = gb + a2; s1[4 * g + 3] = gb + a3; gb += b8; }
    if (MASKED) {
#pragma unroll
      for (int r = 0; r < 16; ++r) { s0[r] = s0[r] > 0.f ? -1e30f : s0[r]; s1[r] = s1[r] > 0.f ? -1e30f : s1[r]; }
    }
  }
#pragma unroll
  for (int ks = 0; ks < 4; ++ks) {
    const int ch = c * 8 + ks * 2 + hi;
    bf16x8 bq = *(const bf16x8*)(qbase + ((ch ^ qsw) << 4));
    bf16x8 ka0 = *(const bf16x8*)(kb + r32 * 256 + ((ch ^ qsw) << 4));
    bf16x8 ka1 = *(const bf16x8*)(kb + (32 + r32) * 256 + ((ch ^ qsw) << 4));
    s0 = MFMA32(ka0, bq, s0);
    s1 = MFMA32(ka1, bq, s1);
    __builtin_amdgcn_sched_barrier(0);
  }
  float mx = fmaxf(s0[0], s1[0]);
#pragma unroll
  for (int r = 1; r < 16; ++r) mx = fmaxf(mx, fmaxf(s0[r], s1[r]));
  mx = half_swap_max(mx);
  float mref = mref_io;
  if (__any((mx - mref) * c1 > 6.0f)) {
    const float mn = fmaxf(mref, mx);
    const float alpha = exp2f((mref - mn) * c1);
    l_io *= alpha;
#pragma unroll
    for (int i = 0; i < 4; ++i)
#pragma unroll
      for (int r = 0; r < 16; ++r) o[i][r] *= alpha;
    mref = mn; mref_io = mn;
  }
  const float nm = -mref * c1;
  float ls = 0.f;
#pragma unroll
  for (int r = 0; r < 16; ++r) { s0[r] = __builtin_amdgcn_exp2f(fmaf(s0[r], c1, nm)); s1[r] = __builtin_amdgcn_exp2f(fmaf(s1[r], c1, nm)); ls += s0[r] + s1[r]; }
  l_io += ls;
  const int q4 = (lane & 15) >> 2, g1 = (lane >> 4) & 1, p4 = lane & 3;
#pragma unroll
  for (int kk = 0; kk < 4; ++kk) {
    const int key0 = 16 * kk + 4 * hi + q4;
    uint4 pwv;
    if (kk < 2) { pwv.x = cvtpk(s0[8 * kk], s0[8 * kk + 1]); pwv.y = cvtpk(s0[8 * kk + 2], s0[8 * kk + 3]); pwv.z = cvtpk(s0[8 * kk + 4], s0[8 * kk + 5]); pwv.w = cvtpk(s0[8 * kk + 6], s0[8 * kk + 7]); }
    else { const int k2 = kk - 2; pwv.x = cvtpk(s1[8 * k2], s1[8 * k2 + 1]); pwv.y = cvtpk(s1[8 * k2 + 2], s1[8 * k2 + 3]); pwv.z = cvtpk(s1[8 * k2 + 4], s1[8 * k2 + 5]); pwv.w = cvtpk(s1[8 * k2 + 6], s1[8 * k2 + 7]); }
    const bf16x8 pb = __builtin_bit_cast(bf16x8, pwv);
#pragma unroll
    for (int dvt = 0; dvt < 4; ++dvt) {
      const int c8 = 8 * (dvt ^ q4) + 4 * g1 + p4;
      v4i16_t lo = __builtin_amdgcn_ds_read_tr16_b64_v4i16(LDSP(v4i16_t, vb + key0 * 256 + c8 * 8));
      v4i16_t hi4 = __builtin_amdgcn_ds_read_tr16_b64_v4i16(LDSP(v4i16_t, vb + (key0 + 8) * 256 + c8 * 8));
      bf16x8 va = (bf16x8){lo[0], lo[1], lo[2], lo[3], hi4[0], hi4[1], hi4[2], hi4[3]};
      o[dvt] = MFMA32(va, pb, o[dvt]);
    }
    __builtin_amdgcn_sched_barrier(0);
  }
}

__device__ __forceinline__ void attn_unit(char* lds, const bf16_t* __restrict__ proj, bf16_t* mix, const float* __restrict__ subg, float lam, int b, int h, int t) {
  const int tix = opaque_tid();
  const int tid = tix, lane = tid & 63, r32 = lane & 31, hi = lane >> 5;
  const int wid = __builtin_amdgcn_readfirstlane(tid >> 6);
  const int c = wid >> 2, qg = wid & 3;
  const int q0 = NMETA + 128 * t, qw0 = q0 + 32 * qg, qpos = qw0 + r32;
  const size_t rowb = (size_t)b * LP;
  const int NT = 2 * t + 3;
  char* Qs = lds;
  char* KV = lds + 32768;
  const float sl8 = exp2f(1.0f - 2.0f * (float)h);
  __syncthreads();
  attn_issue_kv(KV, proj + rowb * INC + h * 128, tid, wid);
#pragma unroll
  for (int i = 0; i < 4; ++i) {
    const int g = i * 512 + tid, row = g >> 4, pos = g & 15;
    uint4 v = *(const uint4*)(proj + (rowb + q0 + row) * INC + h * 128 + ((pos ^ (row & 15)) << 3));
    *(uint4*)(Qs + g * 16) = v;
  }
  f32x16 o[4];
#pragma unroll
  for (int i = 0; i < 4; ++i)
#pragma unroll
    for (int r = 0; r < 16; ++r) o[i][r] = 0.f;
  float m = -1e30f, l = 0.f;
  const int qrow = 32 * qg + r32;
  const char* qbase = Qs + qrow * 256;
  const int qsw = qrow & 15;
  for (int j = 0; j < NT; ++j) {
    __syncthreads();
    if (j + 1 < NT) attn_issue_kv(KV + ((j + 1) & 1) * 32768, proj + (rowb + 64 * (j + 1)) * INC + h * 128, tid, wid);
    if (64 * j > qw0 + 31) continue;
    const char* kb = KV + (j & 1) * 32768;
    const char* vb = kb + 16384;
    const int kq = 64 * j + 4 * hi - qpos;
    if (64 * j + 63 > qw0) attn_map<true>(o, m, l, qbase, qsw, kb, vb, c, kq, sl8, lane, r32, hi);
    else attn_map<false>(o, m, l, qbase, qsw, kb, vb, c, kq, sl8, lane, r32, hi);
  }
  l = half_swap_sum(l);
  const float sc = (c == 0 ? 1.0f : lam) / l;
  __syncthreads();
  float* X = (float*)(lds + 32768);
  if (c == 1) {
#pragma unroll
    for (int i = 0; i < 4; ++i)
#pragma unroll
      for (int r = 0; r < 16; ++r) X[(qg * 64 + i * 16 + r) * 64 + lane] = o[i][r] * sc;
  }
  __syncthreads();
  if (c == 0) {
    float ss = 0.f;
#pragma unroll
    for (int i = 0; i < 4; ++i) {
#pragma unroll
      for (int r = 0; r < 16; ++r) { float v = o[i][r] * sc - X[(qg * 64 + i * 16 + r) * 64 + lane]; o[i][r] = v; ss += v * v; }
      __builtin_amdgcn_sched_barrier(0);
    }
    ss = half_swap_sum(ss);
    const float rstd = rsqrtf(ss * (1.0f / 128.0f) + EPS) * (1.0f - LAM_INIT);
    bf16_t* orow = mix + (rowb + qpos) * D + h * 128;
#pragma unroll
    for (int i = 0; i < 4; ++i) {
#pragma unroll
      for (int g = 0; g < 4; ++g) {
        const int dv0 = 32 * i + 8 * g + 4 * hi;
        const float4 sg = *(const float4*)(subg + dv0);
        uint2 w; w.x = cvtpk(o[i][4 * g] * rstd * sg.x, o[i][4 * g + 1] * rstd * sg.y); w.y = cvtpk(o[i][4 * g + 2] * rstd * sg.z, o[i][4 * g + 3] * rstd * sg.w);
        *(uint2*)(orow + dv0) = w;
      }
      __builtin_amdgcn_sched_barrier(0);
    }
  }
}

__device__ __forceinline__ void p_conv_naive(int blk, const bf16_t* __restrict__ proj, bf16_t* mix, const float* cw, const float* cb, const float* gg_, const float* gb_) {
  const int tix = opaque_tid();
  int row = blk, tid = (tix & 255);
  int b = row / LP, pos = row - b * LP;
  int c0 = tid * 2;
  unsigned* outp = (unsigned*)(mix + (size_t)row * D + 512 + c0);
  if (pos >= LREAL) { *outp = 0u; return; }
  float y0 = cb[c0], y1 = cb[c0 + 1];
  for (int j = 0; j < 31; ++j) {
    int p = pos - 30 + j;
    if (p < 0) continue;
    const bf16_t* pr = proj + ((size_t)b * LP + p) * INC;
    unsigned a = *(const unsigned*)(pr + 1536 + c0), g = *(const unsigned*)(pr + 2048 + c0);
    float a0 = bf2f(a & 0xffffu), a1 = bf2f(a >> 16), g0 = bf2f(g & 0xffffu), g1 = bf2f(g >> 16);
    float u0 = a0 / (1.0f + __expf(-g0)), u1 = a1 / (1.0f + __expf(-g1));
    y0 += cw[j * 512 + c0] * u0; y1 += cw[j * 512 + c0 + 1] * u1;
  }
  float s = y0 + y1;
#pragma unroll
  for (int o = 16; o >= 1; o >>= 1) s += __shfl_xor(s, o);
  float mu = s * (1.0f / 64.0f);
  float d0 = y0 - mu, d1 = y1 - mu;
  float v = d0 * d0 + d1 * d1;
#pragma unroll
  for (int o = 16; o >= 1; o >>= 1) v += __shfl_xor(v, o);
  float rstd = rsqrtf(v * (1.0f / 64.0f) + EPS);
  float n0 = d0 * rstd * gg_[c0] + gb_[c0], n1 = d1 * rstd * gg_[c0 + 1] + gb_[c0 + 1];
  float r0 = n0 / (1.0f + __expf(-n0)), r1 = n1 / (1.0f + __expf(-n1));
  *outp = pack2(r0, r1);
}

__device__ __forceinline__ void p_norm2(int blk, float* red, const float* h2, const float* g2, bf16_t* xn2) {
  const int tix = opaque_tid();
  int row = blk, tid = (tix & 255);
  __syncthreads();
  float4 v = ((const float4*)(h2 + (size_t)row * D))[tid];
  float ss = v.x * v.x + v.y * v.y + v.z * v.z + v.w * v.w;
  ss = wave_sum(ss);
  if ((tid & 63) == 0) red[tid >> 6] = ss;
  __syncthreads();
  float tot = red[0] + red[1] + red[2] + red[3];
  float rstd = rsqrtf(tot * (1.0f / D) + EPS);
  float4 g = ((const float4*)g2)[tid];
  uint2 o; o.x = pack2(v.x * rstd * g.x, v.y * rstd * g.y); o.y = pack2(v.z * rstd * g.z, v.w * rstd * g.w);
  ((uint2*)(xn2 + (size_t)row * D))[tid] = o;
}

__device__ __forceinline__ void p_topk_naive(int blk, const bf16_t* __restrict__ qp, const float* __restrict__ sk, int* eb, float* gb) {
  const int tix = opaque_tid();
  int w = blk * 4 + ((tix & 255) >> 6), lane = (tix & 255) & 63;
  int row = w >> 3, h = w & 7;
  int pos = row % LP;
  if (pos < NMETA || pos >= LREAL) return;
  const float NEG = -3.0e38f;
  float top[2];
#pragma unroll
  for (int p = 0; p < 2; ++p) {
    const bf16_t* qv = qp + (size_t)row * 2048 + h * 256 + p * 128;
    const float* k0 = sk + ((size_t)(h * 2 + p) * 128 + lane) * 128;
    const float* k1 = k0 + 64 * 128;
    float s0 = 0.f, s1 = 0.f;
    for (int d = 0; d < 128; d += 8) {
      uint4 r = *(const uint4*)(qv + d);
      float qf[8] = {bf2f(r.x & 0xffffu), bf2f(r.x >> 16), bf2f(r.y & 0xffffu), bf2f(r.y >> 16), bf2f(r.z & 0xffffu), bf2f(r.z >> 16), bf2f(r.w & 0xffffu), bf2f(r.w >> 16)};
      float4 a0 = *(const float4*)(k0 + d), a1 = *(const float4*)(k0 + d + 4), b0 = *(const float4*)(k1 + d), b1 = *(const float4*)(k1 + d + 4);
      s0 += qf[0] * a0.x + qf[1] * a0.y + qf[2] * a0.z + qf[3] * a0.w + qf[4] * a1.x + qf[5] * a1.y + qf[6] * a1.z + qf[7] * a1.w;
      s1 += qf[0] * b0.x + qf[1] * b0.y + qf[2] * b0.z + qf[3] * b0.w + qf[4] * b1.x + qf[5] * b1.y + qf[6] * b1.z + qf[7] * b1.w;
    }
    float v0 = __uint_as_float((__float_as_uint(s0) & ~127u) | (unsigned)lane);
    float v1 = __uint_as_float((__float_as_uint(s1) & ~127u) | (unsigned)(lane + 64));
    float t = NEG;
    for (int it = 0; it < 16; ++it) {
      float m = wave_max(fmaxf(v0, v1));
      if (lane == it) t = m;
      if (v0 == m) v0 = NEG;
      if (v1 == m) v1 = NEG;
    }
    top[p] = t;
  }
  int ci = lane >> 2, jb = (lane & 3) * 4;
  float av = __uint_as_float(__float_as_uint(__shfl(top[0], ci)) & ~127u);
  float c[4];
#pragma unroll
  for (int jj = 0; jj < 4; ++jj) {
    float bv = __uint_as_float(__float_as_uint(__shfl(top[1], jb + jj)) & ~127u);
    float s = av + bv;
    c[jj] = __uint_as_float((__float_as_uint(s) & ~255u) | (unsigned)(ci * 16 + jb + jj));
  }
  float ct = NEG;
  for (int it = 0; it < 16; ++it) {
    float m = wave_max(fmaxf(fmaxf(c[0], c[1]), fmaxf(c[2], c[3])));
    if (lane == it) ct = m;
#pragma unroll
    for (int jj = 0; jj < 4; ++jj) if (c[jj] == m) c[jj] = NEG;
  }
  unsigned cbits = __float_as_uint(ct);
  int cidx = cbits & 255u;
  float cval = __uint_as_float(cbits & ~255u);
  int i1 = __float_as_uint(__shfl(top[0], (cidx >> 4) & 15)) & 127u;
  int i2 = __float_as_uint(__shfl(top[1], cidx & 15)) & 127u;
  float mx = __shfl(cval, 0);
  float ex = lane < 16 ? __expf(cval - mx) : 0.f;
  float sum = wave_sum(ex);
  if (lane < 16) {
    eb[((size_t)row * 8 + h) * 16 + lane] = i1 * 128 + i2;
    gb[((size_t)row * 8 + h) * 16 + lane] = ex / sum;
  }
}


__device__ __forceinline__ void ce_desc(float& a, float& b) { const float hi = fmaxf(a, b), lo = fminf(a, b); a = hi; b = lo; }
__device__ __forceinline__ void ce_asc(float& a, float& b) { const float hi = fmaxf(a, b), lo = fminf(a, b); a = lo; b = hi; }
template <int N> __device__ __forceinline__ void bitonic_sort_desc(float (&v)[N]) {
#pragma unroll
  for (int k = 2; k <= N; k <<= 1)
#pragma unroll
    for (int j = k >> 1; j > 0; j >>= 1)
#pragma unroll
      for (int i = 0; i < N; ++i) { const int l = i ^ j; if (l > i) { if ((i & k) == 0) ce_desc(v[i], v[l]); else ce_asc(v[i], v[l]); } }
}
template <int N> __device__ __forceinline__ void bitonic_merge_desc(float (&v)[N]) {
#pragma unroll
  for (int j = N >> 1; j > 0; j >>= 1)
#pragma unroll
    for (int i = 0; i < N; ++i) { const int l = i ^ j; if (l > i) ce_desc(v[i], v[l]); }
}
__device__ __forceinline__ void cep_desc(float& a, float& b, int& pa, int& pb) { const bool sw = b > a; const float hi = sw ? b : a, lo = sw ? a : b; const int ph = sw ? pb : pa, pl = sw ? pa : pb; a = hi; b = lo; pa = ph; pb = pl; }
__device__ __forceinline__ void cep_asc(float& a, float& b, int& pa, int& pb) { const bool sw = b < a; const float lo = sw ? b : a, hi = sw ? a : b; const int pl = sw ? pb : pa, ph = sw ? pa : pb; a = lo; b = hi; pa = pl; pb = ph; }
template <int N> __device__ __forceinline__ void bitonic_sortp_desc(float (&v)[N], int (&q)[N]) {
#pragma unroll
  for (int k = 2; k <= N; k <<= 1)
#pragma unroll
    for (int j = k >> 1; j > 0; j >>= 1)
#pragma unroll
      for (int i = 0; i < N; ++i) { const int l = i ^ j; if (l > i) { if ((i & k) == 0) cep_desc(v[i], v[l], q[i], q[l]); else cep_asc(v[i], v[l], q[i], q[l]); } }
}
template <int N> __device__ __forceinline__ void bitonic_mergep_desc(float (&v)[N], int (&q)[N]) {
#pragma unroll
  for (int j = N >> 1; j > 0; j >>= 1)
#pragma unroll
    for (int i = 0; i < N; ++i) { const int l = i ^ j; if (l > i) cep_desc(v[i], v[l], q[i], q[l]); }
}
__host__ __device__ constexpr int cand_slot(int i, int j) { int s = 0; for (int ii = 0; ii < i; ++ii) s += 16 / (ii + 1); return s + j; }

__device__ __forceinline__ void peer_topk_unit(char* lds, const bf16_t* __restrict__ qp, const bf16_t* __restrict__ skb, int* eb, float* gb, int row0, int h) {
  const int tix = opaque_tid();
  const int tid = tix, lane = tid & 63, wid = tid >> 6, fr = lane & 15, fq = lane >> 4;
  __syncthreads();
#pragma unroll
  for (int i = 0; i < 8; ++i) {
    const int g = i * 512 + tid, row = g >> 4, pos = g & 15;
    *(uint4*)(lds + g * 16) = *(const uint4*)(skb + ((size_t)(h * 2) * 128 + row) * 128 + ((pos ^ (row & 15)) << 3));
  }
  __syncthreads();
  const int tok = row0 + wid * 16 + fr;
  float top[2][16];
#pragma unroll
  for (int p = 0; p < 2; ++p) {
    f32x4 acc[8];
#pragma unroll
    for (int i = 0; i < 8; ++i) acc[i] = (f32x4){0.f, 0.f, 0.f, 0.f};
    const bf16_t* xrow = qp + (size_t)tok * 2048 + h * 256 + p * 128 + fq * 8;
#pragma unroll
    for (int ks = 0; ks < 4; ++ks) {
      const bf16x8 xb = *(const bf16x8*)(xrow + ks * 32);
      const int ch = ks * 4 + fq;
#pragma unroll
      for (int nt = 0; nt < 8; ++nt) {
        const int r = p * 128 + nt * 16 + fr;
        const bf16x8 wa = *(const bf16x8*)(lds + r * 256 + ((ch ^ (r & 15)) << 4));
        acc[nt] = __builtin_amdgcn_mfma_f32_16x16x32_bf16(wa, xb, acc[nt], 0, 0, 0);
      }
    }
    float v[32];
#pragma unroll
    for (int nt = 0; nt < 8; ++nt)
#pragma unroll
      for (int r = 0; r < 4; ++r) v[nt * 4 + r] = __uint_as_float((__float_as_uint(acc[nt][r]) & ~127u) | (unsigned)(nt * 16 + fq * 4 + r));
    bitonic_sort_desc<32>(v);
    float t[16];
#pragma unroll
    for (int i = 0; i < 16; ++i) t[i] = v[i];
#pragma unroll
    for (int rnd = 0; rnd < 2; ++rnd) {
      float pb[16];
#pragma unroll
      for (int i = 0; i < 16; ++i) pb[i] = __shfl_xor(t[15 - i], rnd == 0 ? 16 : 32);
#pragma unroll
      for (int i = 0; i < 16; ++i) t[i] = fmaxf(t[i], pb[i]);
      bitonic_merge_desc<16>(t);
    }
#pragma unroll
    for (int i = 0; i < 16; ++i) top[p][i] = t[i];
  }
  float cv[64]; int cq[64];
#pragma unroll
  for (int i = 50; i < 64; ++i) { cv[i] = -3.0e38f; cq[i] = 0; }
#pragma unroll
  for (int i = 0; i < 16; ++i)
#pragma unroll
    for (int j = 0; j < 16; ++j)
      if ((i + 1) * (j + 1) <= 16) {
        const unsigned ab = __float_as_uint(top[0][i]), bb = __float_as_uint(top[1][j]);
        cv[cand_slot(i, j)] = __uint_as_float(ab & ~127u) + __uint_as_float(bb & ~127u);
        cq[cand_slot(i, j)] = (int)(((ab & 127u) << 7) | (bb & 127u));
      }
  bitonic_sortp_desc<64>(cv, cq);
  float ex[16]; float sum = 0.f;
#pragma unroll
  for (int i = 0; i < 16; ++i) { ex[i] = __expf(cv[i] - cv[0]); sum += ex[i]; }
  const float inv = 1.0f / sum;
  int* ep = eb + ((size_t)tok * 8 + h) * 16;
  float* gp = gb + ((size_t)tok * 8 + h) * 16;
  if (fq == 0) { *(int4*)(ep) = make_int4(cq[0], cq[1], cq[2], cq[3]); *(float4*)(gp) = make_float4(ex[0] * inv, ex[1] * inv, ex[2] * inv, ex[3] * inv); }
  else if (fq == 1) { *(int4*)(ep + 4) = make_int4(cq[4], cq[5], cq[6], cq[7]); *(float4*)(gp + 4) = make_float4(ex[4] * inv, ex[5] * inv, ex[6] * inv, ex[7] * inv); }
  else if (fq == 2) { *(int4*)(ep + 8) = make_int4(cq[8], cq[9], cq[10], cq[11]); *(float4*)(gp + 8) = make_float4(ex[8] * inv, ex[9] * inv, ex[10] * inv, ex[11] * inv); }
  else { *(int4*)(ep + 12) = make_int4(cq[12], cq[13], cq[14], cq[15]); *(float4*)(gp + 12) = make_float4(ex[12] * inv, ex[13] * inv, ex[14] * inv, ex[15] * inv); }
}

__device__ __forceinline__ void p_cvt_bf16(int blk, int nblk, const float* __restrict__ src, bf16_t* dst, size_t n8) {
  const int tix = opaque_tid();
  for (size_t i = (size_t)blk * 512 + tix; i < n8; i += (size_t)nblk * 512) {
    const float4 a = ((const float4*)src)[2 * i], b = ((const float4*)src)[2 * i + 1];
    uint4 w; w.x = cvtpk(a.x, a.y); w.y = cvtpk(a.z, a.w); w.z = cvtpk(b.x, b.y); w.w = cvtpk(b.z, b.w);
    ((uint4*)dst)[i] = w;
  }
}


typedef float f32x2v __attribute__((ext_vector_type(2)));
__device__ __forceinline__ void p_cvt_fp8_rows(int blk, int nblk, const float* __restrict__ src, unsigned* dst, float* inv) {
  const int tix = opaque_tid();
  const int lane = tix & 63, wid = tix >> 6;
  for (int r = blk * 8 + wid; r < 16384; r += nblk * 8) {
    const float4* sp = (const float4*)(src + (size_t)r * D);
    float4 v[4];
#pragma unroll
    for (int k = 0; k < 4; ++k) v[k] = sp[k * 64 + lane];
    float am = 0.f;
#pragma unroll
    for (int k = 0; k < 4; ++k) am = fmaxf(am, fmaxf(fmaxf(fabsf(v[k].x), fabsf(v[k].y)), fmaxf(fabsf(v[k].z), fabsf(v[k].w))));
    am = wave_max(am);
    const float sc = am > 0.f ? 384.0f / am : 1.0f;
#pragma unroll
    for (int k = 0; k < 4; ++k) {
      int w = __builtin_amdgcn_cvt_pk_fp8_f32(v[k].x * sc, v[k].y * sc, 0, false);
      w = __builtin_amdgcn_cvt_pk_fp8_f32(v[k].z * sc, v[k].w * sc, w, true);
      dst[(size_t)r * 256 + k * 64 + lane] = (unsigned)w;
    }
    if (lane == 0) inv[r] = am > 0.f ? am * (1.0f / 384.0f) : 1.0f;
  }
}
__device__ __forceinline__ float row16_sum(float v) {
  v += __builtin_bit_cast(float, __builtin_amdgcn_update_dpp(0, __builtin_bit_cast(int, v), 0x128, 0xf, 0xf, true));
  v += __builtin_bit_cast(float, __builtin_amdgcn_update_dpp(0, __builtin_bit_cast(int, v), 0x124, 0xf, 0xf, true));
  v += __builtin_bit_cast(float, __builtin_amdgcn_update_dpp(0, __builtin_bit_cast(int, v), 0x122, 0xf, 0xf, true));
  v += __builtin_bit_cast(float, __builtin_amdgcn_update_dpp(0, __builtin_bit_cast(int, v), 0x121, 0xf, 0xf, true));
  return v;
}
__device__ __forceinline__ void peer_gather_token(char* wlds  , int lane, size_t row, size_t orow, const bf16_t* __restrict__ xn2, const float* __restrict__ h2,
                                                  const int* __restrict__ eb, const float* __restrict__ gb, const unsigned char* __restrict__ ut8, const float* __restrict__ uinv,
                                                  const unsigned char* __restrict__ vt8, const float* __restrict__ vinv, const float* __restrict__ fg, float* __restrict__ out) {
  int* E = (int*)wlds; float* Gt = (float*)(wlds + 512); float* W = (float*)(wlds + 1024);
  const int i16 = lane & 15, g = lane >> 4;
  {
    const int e0 = eb[row * 128 + lane], e1 = eb[row * 128 + 64 + lane];
    E[lane] = e0; E[lane + 64] = e1;
    Gt[lane] = gb[row * 128 + lane]; Gt[lane + 64] = gb[row * 128 + 64 + lane];
  }
  float xf[4][16];
#pragma unroll
  for (int k = 0; k < 4; ++k) {
    const uint4 a = *(const uint4*)(xn2 + row * D + 256 * k + 16 * i16), b = *(const uint4*)(xn2 + row * D + 256 * k + 16 * i16 + 8);
    xf[k][0] = __uint_as_float(a.x << 16); xf[k][1] = __uint_as_float(a.x & 0xffff0000u); xf[k][2] = __uint_as_float(a.y << 16); xf[k][3] = __uint_as_float(a.y & 0xffff0000u);
    xf[k][4] = __uint_as_float(a.z << 16); xf[k][5] = __uint_as_float(a.z & 0xffff0000u); xf[k][6] = __uint_as_float(a.w << 16); xf[k][7] = __uint_as_float(a.w & 0xffff0000u);
    xf[k][8] = __uint_as_float(b.x << 16); xf[k][9] = __uint_as_float(b.x & 0xffff0000u); xf[k][10] = __uint_as_float(b.y << 16); xf[k][11] = __uint_as_float(b.y & 0xffff0000u);
    xf[k][12] = __uint_as_float(b.z << 16); xf[k][13] = __uint_as_float(b.z & 0xffff0000u); xf[k][14] = __uint_as_float(b.w << 16); xf[k][15] = __uint_as_float(b.w & 0xffff0000u);
  }
#pragma unroll 2
  for (int m = 0; m < 32; ++m) {
    const int e = E[4 * m + g];
    const unsigned char* ur = ut8 + (size_t)e * D + 16 * i16;
    uint4 u[4];
#pragma unroll
    for (int k = 0; k < 4; ++k) u[k] = *(const uint4*)(ur + 256 * k);
    float d0 = 0.f, d1 = 0.f;
#pragma unroll
    for (int k = 0; k < 4; ++k) {
      const unsigned wv[4] = {u[k].x, u[k].y, u[k].z, u[k].w};
#pragma unroll
      for (int q = 0; q < 4; ++q) {
        const f32x2v lo = __builtin_amdgcn_cvt_pk_f32_fp8((int)wv[q], false), hi = __builtin_amdgcn_cvt_pk_f32_fp8((int)wv[q], true);
        d0 = fmaf(lo.x, xf[k][4 * q], d0); d1 = fmaf(lo.y, xf[k][4 * q + 1], d1);
        d0 = fmaf(hi.x, xf[k][4 * q + 2], d0); d1 = fmaf(hi.y, xf[k][4 * q + 3], d1);
      }
    }
    const float d = row16_sum(d0 + d1);
    if (i16 == 0) W[4 * m + g] = d;
  }
  {
    const int e0 = E[lane], e1 = E[lane + 64];
    const float ui0 = uinv[e0], ui1 = uinv[e1];
    const float a0 = W[lane] * ui0, a1 = W[lane + 64] * ui1;
    const float g0 = Gt[lane], g1 = Gt[lane + 64];
    W[lane] = g0 * 0.5f * a0 * (1.0f + erff(a0 * 0.70710678118654752f)) * vinv[e0];
    W[lane + 64] = g1 * 0.5f * a1 * (1.0f + erff(a1 * 0.70710678118654752f)) * vinv[e1];
  }
  float acc[4][16];
#pragma unroll
  for (int k = 0; k < 4; ++k)
#pragma unroll
    for (int i = 0; i < 16; ++i) acc[k][i] = 0.f;
#pragma unroll 2
  for (int m = 0; m < 32; ++m) {
    const int e = E[4 * m + g];
    const float w = W[4 * m + g];
    const unsigned char* vr = vt8 + (size_t)e * D + 16 * i16;
    uint4 v[4];
#pragma unroll
    for (int k = 0; k < 4; ++k) v[k] = *(const uint4*)(vr + 256 * k);
#pragma unroll
    for (int k = 0; k < 4; ++k) {
      const unsigned wv[4] = {v[k].x, v[k].y, v[k].z, v[k].w};
#pragma unroll
      for (int q = 0; q < 4; ++q) {
        const f32x2v lo = __builtin_amdgcn_cvt_pk_f32_fp8((int)wv[q], false), hi = __builtin_amdgcn_cvt_pk_f32_fp8((int)wv[q], true);
        acc[k][4 * q] = fmaf(w, lo.x, acc[k][4 * q]); acc[k][4 * q + 1] = fmaf(w, lo.y, acc[k][4 * q + 1]);
        acc[k][4 * q + 2] = fmaf(w, hi.x, acc[k][4 * q + 2]); acc[k][4 * q + 3] = fmaf(w, hi.y, acc[k][4 * q + 3]);
      }
    }
  }
  float res[16];
#pragma unroll
  for (int k = 0; k < 4; ++k)
#pragma unroll
    for (int j = 0; j < 16; ++j) {
      float t = acc[k][j];
      t += __shfl_xor(t, 16); t += __shfl_xor(t, 32);
      if (k == g) res[j] = t;
    }
  const int c0 = 256 * g + 16 * i16;
  float ss = 0.f;
#pragma unroll
  for (int q = 0; q < 4; ++q) {
    const float4 hv = *(const float4*)(h2 + row * D + c0 + 4 * q);
    res[4 * q] += hv.x; res[4 * q + 1] += hv.y; res[4 * q + 2] += hv.z; res[4 * q + 3] += hv.w;
  }
#pragma unroll
  for (int i = 0; i < 16; ++i) ss += res[i] * res[i];
  ss = wave_sum(ss);
  const float rstd = rsqrtf(ss * (1.0f / D) + EPS);
#pragma unroll
  for (int q = 0; q < 4; ++q) {
    const float4 f = *(const float4*)(fg + c0 + 4 * q);
    *(float4*)(out + orow * D + c0 + 4 * q) = make_float4(res[4 * q] * rstd * f.x, res[4 * q + 1] * rstd * f.y, res[4 * q + 2] * rstd * f.z, res[4 * q + 3] * rstd * f.w);
  }
}

__device__ __forceinline__ void p_gather_naive(int blk, const bf16_t* __restrict__ xn2, const float* __restrict__ h2, const int* __restrict__ eb, const float* __restrict__ gb,
                                                      const float* __restrict__ ut, const float* __restrict__ vt, const float* fg, float* out) {
  const int tix = opaque_tid();
  int tk = blk * 4 + ((tix & 255) >> 6), lane = (tix & 255) & 63;
  int b = tk / SEQ, s = tk - b * SEQ;
  size_t row = (size_t)b * LP + NMETA + s;
  float xv[16];
  {
    const uint4* xp = (const uint4*)(xn2 + row * D + lane * 16);
#pragma unroll
    for (int i = 0; i < 2; ++i) {
      uint4 r = xp[i];
      xv[i * 8 + 0] = bf2f(r.x & 0xffffu); xv[i * 8 + 1] = bf2f(r.x >> 16); xv[i * 8 + 2] = bf2f(r.y & 0xffffu); xv[i * 8 + 3] = bf2f(r.y >> 16);
      xv[i * 8 + 4] = bf2f(r.z & 0xffffu); xv[i * 8 + 5] = bf2f(r.z >> 16); xv[i * 8 + 6] = bf2f(r.w & 0xffffu); xv[i * 8 + 7] = bf2f(r.w >> 16);
    }
  }
  float acc[16];
#pragma unroll
  for (int i = 0; i < 16; ++i) acc[i] = 0.f;
  for (int k = 0; k < 128; ++k) {
    int e = eb[row * 128 + k];
    float gate = gb[row * 128 + k];
    const float4* up = (const float4*)(ut + (size_t)e * D + lane * 16);
    float dsum = 0.f;
#pragma unroll
    for (int i = 0; i < 4; ++i) { float4 u = up[i]; dsum += u.x * xv[i * 4] + u.y * xv[i * 4 + 1] + u.z * xv[i * 4 + 2] + u.w * xv[i * 4 + 3]; }
    dsum = wave_sum(dsum);
    float act = 0.5f * dsum * (1.0f + erff(dsum * 0.70710678118654752f));
    float wgt = gate * act;
    const float4* vp = (const float4*)(vt + (size_t)e * D + lane * 16);
#pragma unroll
    for (int i = 0; i < 4; ++i) { float4 v = vp[i]; acc[i * 4] += wgt * v.x; acc[i * 4 + 1] += wgt * v.y; acc[i * 4 + 2] += wgt * v.z; acc[i * 4 + 3] += wgt * v.w; }
  }
  const float4* hp = (const float4*)(h2 + row * D + lane * 16);
  float ss = 0.f;
#pragma unroll
  for (int i = 0; i < 4; ++i) { float4 hv = hp[i]; acc[i * 4] += hv.x; acc[i * 4 + 1] += hv.y; acc[i * 4 + 2] += hv.z; acc[i * 4 + 3] += hv.w; }
#pragma unroll
  for (int i = 0; i < 16; ++i) ss += acc[i] * acc[i];
  ss = wave_sum(ss);
  float rstd = rsqrtf(ss * (1.0f / D) + EPS);
  float4* op = (float4*)(out + ((size_t)b * SEQ + s) * D + lane * 16);
  const float4* gp = (const float4*)(fg + lane * 16);
#pragma unroll
  for (int i = 0; i < 4; ++i) { float4 g = gp[i]; op[i] = make_float4(acc[i * 4] * rstd * g.x, acc[i * 4 + 1] * rstd * g.y, acc[i * 4 + 2] * rstd * g.z, acc[i * 4 + 3] * rstd * g.w); }
}


template <class Epi>
__device__ __forceinline__ void gemm_tile(char* lds, const bf16_t* __restrict__ X, int ldx, const bf16_t* __restrict__ Wt, int ldw, int K, int m0, int n0, const Epi& epi) {
  const int tix = opaque_tid();
  const int tid = tix, lane = tid & 63, wid = tid >> 6;
  const int wm = wid >> 1, wn = wid & 1;
  const int sc = tid & 7, sr = tid >> 3;
  f32x4 acc[4][4];
#pragma unroll
  for (int i = 0; i < 4; ++i)
#pragma unroll
    for (int j = 0; j < 4; ++j) acc[i][j] = (f32x4){0.f, 0.f, 0.f, 0.f};
  uint4 ra[4], rb[2];
  const bf16_t* xp = X + (size_t)(m0 + sr) * ldx + sc * 8;
  const bf16_t* wp = Wt + (size_t)(n0 + sr) * ldw + sc * 8;
  const int nk = K >> 6;
#pragma unroll
  for (int i = 0; i < 4; ++i) ra[i] = *(const uint4*)(xp + (size_t)(64 * i) * ldx);
#pragma unroll
  for (int i = 0; i < 2; ++i) rb[i] = *(const uint4*)(wp + (size_t)(64 * i) * ldw);
#pragma unroll
  for (int i = 0; i < 4; ++i) { int r = sr + 64 * i; *(uint4*)(lds + r * 128 + ((sc ^ ((r >> 1) & 7)) << 4)) = ra[i]; }
#pragma unroll
  for (int i = 0; i < 2; ++i) { int r = sr + 64 * i; *(uint4*)(lds + 32768 + r * 128 + ((sc ^ ((r >> 1) & 7)) << 4)) = rb[i]; }
  __syncthreads();
  const int fr = lane & 15, fq = lane >> 4;
  for (int kt = 0; kt < nk; ++kt) {
    if (kt + 1 < nk) {
#pragma unroll
      for (int i = 0; i < 4; ++i) ra[i] = *(const uint4*)(xp + (size_t)(64 * i) * ldx + (kt + 1) * 64);
#pragma unroll
      for (int i = 0; i < 2; ++i) rb[i] = *(const uint4*)(wp + (size_t)(64 * i) * ldw + (kt + 1) * 64);
    }
    const char* la = lds + (kt & 1) * 49152;
    const char* lb = la + 32768;
#pragma unroll
    for (int kk = 0; kk < 2; ++kk) {
      bf16x8 xa[4], wb[4];
      const int c = kk * 4 + fq;
#pragma unroll
      for (int t = 0; t < 4; ++t) {
        int r = wm * 64 + t * 16 + fr; xa[t] = *(const bf16x8*)(la + r * 128 + ((c ^ ((r >> 1) & 7)) << 4));
        int r2 = wn * 64 + t * 16 + fr; wb[t] = *(const bf16x8*)(lb + r2 * 128 + ((c ^ ((r2 >> 1) & 7)) << 4));
      }
#pragma unroll
      for (int nt = 0; nt < 4; ++nt)
#pragma unroll
        for (int tt = 0; tt < 4; ++tt) acc[nt][tt] = __builtin_amdgcn_mfma_f32_16x16x32_bf16(wb[nt], xa[tt], acc[nt][tt], 0, 0, 0);
    }
    if (kt + 1 < nk) {
      char* lw = lds + ((kt + 1) & 1) * 49152;
#pragma unroll
      for (int i = 0; i < 4; ++i) { int r = sr + 64 * i; *(uint4*)(lw + r * 128 + ((sc ^ ((r >> 1) & 7)) << 4)) = ra[i]; }
#pragma unroll
      for (int i = 0; i < 2; ++i) { int r = sr + 64 * i; *(uint4*)(lw + 32768 + r * 128 + ((sc ^ ((r >> 1) & 7)) << 4)) = rb[i]; }
    }
    __syncthreads();
  }
#pragma unroll
  for (int nt = 0; nt < 4; ++nt)
#pragma unroll
    for (int tt = 0; tt < 4; ++tt) epi(m0 + wm * 64 + tt * 16 + fr, n0 + wn * 64 + nt * 16 + fq * 4, acc[nt][tt]);
}

struct Epi4StoreBf16 { bf16_t* out; int ld; int pad; __device__ __forceinline__ void operator()(int r, int c, f32x4 v) const {
  uint2 w; w.x = pack2(v[0], v[1]); w.y = pack2(v[2], v[3]); *(uint2*)(out + (size_t)r * ld + c) = w; } };
struct Epi4Resid { const float* x; const float* meta; float* h2; __device__ __forceinline__ void operator()(int r, int c, f32x4 v) const {
  const float* src = hrow_ptr(x, meta, r); float4 hv = src ? *(const float4*)(src + c) : make_float4(0.f, 0.f, 0.f, 0.f);
  *(float4*)(h2 + (size_t)r * D + c) = make_float4(hv.x + v[0], hv.y + v[1], hv.z + v[2], hv.w + v[3]); } };

__device__ __forceinline__ void p_transpose(int t, float* smem, const float* __restrict__ W, bf16_t* Wt, int K, int N) {
  const int tix = opaque_tid();
  float (*T)[65] = (float (*)[65])smem;
  const int nbx = N / 64, k0 = (t / nbx) * 64, n0 = (t % nbx) * 64, tid = (tix & 255);
  const int j = tid & 63, i0 = tid >> 6;
#pragma unroll
  for (int ii = 0; ii < 16; ++ii) { int i = i0 + 4 * ii; T[i][j] = W[(size_t)(k0 + i) * N + n0 + j]; }
  __syncthreads();
#pragma unroll
  for (int ii = 0; ii < 16; ++ii) { int jj = i0 + 4 * ii; Wt[(size_t)(n0 + jj) * K + k0 + j] = f2bf(T[j][jj]); }
  __syncthreads();
}
struct Params {
  const float *x, *meta, *g1, *w_in, *lq1, *lk1, *lq2, *lk2, *subg, *conv_w, *conv_b, *gn_g, *gn_b, *w_out, *g2, *wq, *sk, *ut, *vt, *fg;
  float* out; float* scal; bf16_t* r1; bf16_t* r2; float* h2; int* eb; float* gb; bf16_t* wt_in; bf16_t* wt_out; bf16_t* wt_q; bf16_t* skb; unsigned char* ut8; unsigned char* vt8; float* uinv; float* vinv;
};

__global__ void __launch_bounds__(512, 2) mega(Params p) {
  cg::grid_group grid = cg::this_grid();
  __shared__ __attribute__((aligned(16))) char smem_c[131072];
  float* smem = (float*)smem_c;
  const int G = gridDim.x, vh = threadIdx.x >> 8;
  bf16_t* xn1 = p.r1; bf16_t* mix = p.r1; bf16_t* xn2 = p.r1; bf16_t* proj = p.r2; bf16_t* qp = p.r2;
  for (int b = blockIdx.x; b < ROWS / 2; b += G) p_norm1(b * 2 + vh, smem + 4 * vh, p.x, p.meta, p.g1, xn1, p.lq1, p.lk1, p.lq2, p.lk2, p.scal);
  for (int b = blockIdx.x; b < (640 + 256 + 512) / 2; b += G) {
    const int bb = b * 2 + vh; float* sm = smem + vh * (64 * 65);
    if (bb < 640) p_transpose(bb, sm, p.w_in, p.wt_in, D, INC);
    else if (bb < 896) p_transpose(bb - 640, sm, p.w_out, p.wt_out, D, D);
    else p_transpose(bb - 896, sm, p.wq, p.wt_q, D, 2048);
  }
  p_cvt_bf16(blockIdx.x, G, p.sk, p.skb, (size_t)16 * 128 * 128 / 8);
  p_cvt_fp8_rows(blockIdx.x, G, p.ut, (unsigned*)p.ut8, p.uinv);
  p_cvt_fp8_rows(blockIdx.x, G, p.vt, (unsigned*)p.vt8, p.vinv);
  grid.sync();
  for (int b = blockIdx.x; b < (INC / 128) * (ROWS / 256); b += G) gemm_tile(smem_c, xn1, D, p.wt_in, D, D, (b / (INC / 128)) * 256, (b % (INC / 128)) * 128, Epi4StoreBf16{proj, INC, 0});
  grid.sync();
  {
    const float lam = p.scal[0];
    for (int u = blockIdx.x; u < 256; u += G) {
      const int bh = (u & 7) * 4 + (u >> 6), tp = (u >> 3) & 7;
#pragma unroll 1
      for (int k = 0; k < 4; ++k) {
        const int t = (k == 0) ? 31 - tp : (k == 1) ? 16 + tp : (k == 2) ? 15 - tp : tp;
        attn_unit(smem_c, proj, mix, p.subg, lam, bh >> 2, bh & 3, t);
      }
    }
  }
  for (int b = blockIdx.x; b < ROWS / 2; b += G) p_conv_naive(b * 2 + vh, proj, mix, p.conv_w, p.conv_b, p.gn_g, p.gn_b);
  grid.sync();
  for (int b = blockIdx.x; b < (D / 128) * (ROWS / 256); b += G) gemm_tile(smem_c, mix, D, p.wt_out, D, D, (b / (D / 128)) * 256, (b % (D / 128)) * 128, Epi4Resid{p.x, p.meta, p.h2});
  grid.sync();
  for (int b = blockIdx.x; b < ROWS / 2; b += G) p_norm2(b * 2 + vh, smem + 4 * vh, p.h2, p.g2, xn2);
  grid.sync();
  for (int b = blockIdx.x; b < (2048 / 128) * (ROWS / 256); b += G) gemm_tile(smem_c, xn2, D, p.wt_q, D, D, (b / 16) * 256, (b % 16) * 128, Epi4StoreBf16{qp, 2048, 0});
  grid.sync();
  for (int u = blockIdx.x; u < 256 * 8; u += G) {
    const int rt = u >> 3, h = u & 7;
    peer_topk_unit(smem_c, qp, p.skb, p.eb, p.gb, (rt >> 5) * LP + NMETA + 128 * (rt & 31), h);
  }
  grid.sync();
  {
    const int tix = opaque_tid();
    const int lane = tix & 63, wid = tix >> 6;
    for (int tk = blockIdx.x * 8 + wid; tk < BATCH * SEQ; tk += G * 8) {
      const int b = tk / SEQ, sq = tk - b * SEQ;
      peer_gather_token(smem_c + wid * 1536, lane, (size_t)b * LP + NMETA + sq, (size_t)tk, xn2, p.h2, p.eb, p.gb, p.ut8, p.uinv, p.vt8, p.vinv, p.fg, p.out);
    }
  }
}

extern "C" void kernel_launch(void* const* d_in, const int* in_sizes, int n_in, void* d_out, int out_size, void* d_ws, size_t ws_size, hipStream_t stream) {
  static int grid_blocks = 0;
  if (!grid_blocks) {
    int dev = 0, cus = 0, per_cu = 0;
    hipGetDevice(&dev);
    hipDeviceGetAttribute(&cus, hipDeviceAttributeMultiprocessorCount, dev);
    hipOccupancyMaxActiveBlocksPerMultiprocessor(&per_cu, mega, 512, 0);
    if (per_cu > 1) per_cu = 1;
    if (per_cu < 1) per_cu = 1;
    grid_blocks = cus * per_cu;
  }
  Params p{};
  const float** pp = (const float**)&p;
  for (int i = 0; i < 20; ++i) pp[i] = (const float*)d_in[i];
  p.out = (float*)d_out;
  char* ws = (char*)d_ws;
  size_t off = 0;
  p.scal = (float*)(ws + off); off += 4096;
  p.r1 = (bf16_t*)(ws + off); off += (size_t)ROWS * D * 2;
  p.r2 = (bf16_t*)(ws + off); off += (size_t)ROWS * INC * 2;
  p.h2 = (float*)(ws + off); off += (size_t)ROWS * D * 4;
  p.wt_in = (bf16_t*)(ws + off); off += (size_t)INC * D * 2;
  p.wt_out = (bf16_t*)(ws + off); off += (size_t)D * D * 2;
  p.wt_q = (bf16_t*)(ws + off); off += (size_t)2048 * D * 2;
  p.skb = (bf16_t*)(ws + off); off += (size_t)16 * 128 * 128 * 2;
  p.ut8 = (unsigned char*)(ws + off); off += (size_t)16384 * D;
  p.vt8 = (unsigned char*)(ws + off); off += (size_t)16384 * D;
  p.uinv = (float*)(ws + off); off += 65536;
  p.vinv = (float*)(ws + off); off += 65536;
  p.eb = (int*)((char*)p.r2 + (size_t)ROWS * 2048 * 2);
  p.gb = (float*)((char*)p.eb + (size_t)ROWS * 128 * 4);
  void* args[] = {&p};
  hipError_t e = hipLaunchCooperativeKernel((void*)mega, dim3(grid_blocks), dim3(512), args, 0, stream);
  if (e != hipSuccess) fprintf(stderr, "cooperative launch failed: %s (grid %d)\n", hipGetErrorString(e), grid_blocks);
}
```

```cpp
#include <hip/hip_runtime.h>
#include <hip/hip_cooperative_groups.h>
#include <cstdio>
namespace cg = cooperative_groups;
#include <stdint.h>
#include <math.h>

typedef unsigned short bf16_t;
typedef short bf16x8 __attribute__((ext_vector_type(8)));
typedef float f32x4 __attribute__((ext_vector_type(4)));

constexpr int D = 1024, BATCH = 8, SEQ = 4096, NMETA = 16, LREAL = NMETA + SEQ  , LP = 4224, ROWS = BATCH * LP;
constexpr int INC = 2560;
constexpr float EPS = 1e-6f;
constexpr float LAM_INIT = 0.2f;

__device__ __forceinline__ float bf2f(unsigned v) { return __uint_as_float(v << 16); }
__device__ __forceinline__ bf16_t f2bf(float f) { unsigned u = __float_as_uint(f); u += 0x7fffu + ((u >> 16) & 1u); return (bf16_t)(u >> 16); }
__device__ __forceinline__ unsigned pack2(float a, float b) { return (unsigned)f2bf(a) | ((unsigned)f2bf(b) << 16); }

__device__ __forceinline__ float wave_sum(float v) {
#pragma unroll
  for (int o = 32; o >= 1; o >>= 1) v += __shfl_xor(v, o);
  return v;
}
__device__ __forceinline__ float wave_max(float v) {
#pragma unroll
  for (int o = 32; o >= 1; o >>= 1) v = fmaxf(v, __shfl_xor(v, o));
  return v;
}

__device__ __forceinline__ int opaque_tid() { int t = threadIdx.x; asm volatile("" : "+v"(t)); return t; }

__device__ __forceinline__ const float* hrow_ptr(const float* x, const float* meta, int row) {
  int b = row / LP, pos = row - b * LP;
  if (pos < NMETA) return meta + (size_t)pos * D;
  if (pos < LREAL) return x + ((size_t)b * SEQ + (pos - NMETA)) * D;
  return nullptr;
}

__device__ __forceinline__ void p_norm1(int blk, float* red, const float* x, const float* meta, const float* g1, bf16_t* xn1,
                                               const float* lq1, const float* lk1, const float* lq2, const float* lk2, float* scal) {
  const int tix = opaque_tid();
  int row = blk, tid = (tix & 255);
  __syncthreads();
  const float* src = hrow_ptr(x, meta, row);
  float4 v = src ? ((const float4*)src)[tid] : make_float4(0.f, 0.f, 0.f, 0.f);
  float ss = v.x * v.x + v.y * v.y + v.z * v.z + v.w * v.w;
  ss = wave_sum(ss);
  if ((tid & 63) == 0) red[tid >> 6] = ss;
  __syncthreads();
  float tot = red[0] + red[1] + red[2] + red[3];
  float rstd = rsqrtf(tot * (1.0f / D) + EPS);
  float4 g = ((const float4*)g1)[tid];
  uint2 o; o.x = pack2(v.x * rstd * g.x, v.y * rstd * g.y); o.y = pack2(v.z * rstd * g.z, v.w * rstd * g.w);
  ((uint2*)(xn1 + (size_t)row * D))[tid] = o;
  if (row == 0 && tid < 64) {
    float a = lq1[tid] * lk1[tid], b2 = lq2[tid] * lk2[tid];
    a = wave_sum(a); b2 = wave_sum(b2);
    if (tid == 0) scal[0] = expf(a) - expf(b2) + LAM_INIT;
  }
}


typedef float f32x16 __attribute__((ext_vector_type(16)));
typedef short v4i16_t __attribute__((ext_vector_type(4)));
typedef __bf16 bf16v2_t __attribute__((ext_vector_type(2)));
typedef float f32x2_t __attribute__((ext_vector_type(2)));
#define LDSP(T, p) ((__attribute__((address_space(3))) T*)(p))
#define MFMA32(a, b, c) __builtin_amdgcn_mfma_f32_32x32x16_bf16((a), (b), (c), 0, 0, 0)
__device__ __forceinline__ unsigned cvtpk(float lo, float hi) { f32x2_t v = {lo, hi}; return __builtin_bit_cast(unsigned, __builtin_convertvector(v, bf16v2_t)); }
__device__ __forceinline__ float half_swap_max(float m) { auto rr = __builtin_amdgcn_permlane32_swap(__float_as_uint(m), __float_as_uint(m), false, false); return fmaxf(__uint_as_float(rr[0]), __uint_as_float(rr[1])); }
__device__ __forceinline__ float half_swap_sum(float m) { auto rr = __builtin_amdgcn_permlane32_swap(__float_as_uint(m), __float_as_uint(m), false, false); return __uint_as_float(rr[0]) + __uint_as_float(rr[1]); }

__device__ __forceinline__ void attn_issue_kv(char* kvbuf, const bf16_t* __restrict__ kvrow0  , int tid, int wid) {
  const char* base = (const char*)kvrow0;
#pragma unroll
  for (int i = 0; i < 2; ++i) {
    const int g = i * 512 + tid, row = g >> 4, pos = g & 15;
    const unsigned offk = (unsigned)(row * (INC * 2) + 1024 + ((pos ^ (row & 15)) << 4));
    const unsigned offv = (unsigned)(row * (INC * 2) + 2048 + ((pos ^ ((row & 3) << 2)) << 4));
    __builtin_amdgcn_global_load_lds((const unsigned*)(base + offk), LDSP(unsigned, kvbuf + (i * 512 + wid * 64) * 16), 16, 0, 0);
    __builtin_amdgcn_global_load_lds((const unsigned*)(base + offv), LDSP(unsigned, kvbuf + 16384 + (i * 512 + wid * 64) * 16), 16, 0, 0);
  }
}

template <bool MASKED>
__device__ __forceinline__ void attn_map(f32x16 (&o)[4], float& mref_io, float& l_io, const char* qbase, int qsw, const char* kb, const char* vb, int c, int kq, float sl8, int lane, int r32, int hi) {
  const float c1 = 0.125f * 1.4426950408889634f;
  asm volatile("" : "+v"(qsw), "+v"(lane));
  f32x16 s0, s1;
  {
    const float a1 = sl8, a2 = 2.0f * sl8, a3 = 3.0f * sl8, b8 = 8.0f * sl8;
    float gb = sl8 * (float)kq;
#pragma unroll
    for (int g = 0; g < 4; ++g) { s0[4 * g] = gb; s0[4 * g + 1] = gb + a1; s0[4 * g + 2] = gb + a2; s0[4 * g + 3] = gb + a3; gb += b8; }
#pragma unroll
    for (int g = 0; g < 4; ++g) { s1[4 * g] = gb; s1[4 * g + 1] = gb + a1; s1[4 * g + 2] = gb + a2; s1[4 * g + 3] = gb + a3; gb += b8; }
    if (MASKED) {
#pragma unroll
      for (int r = 0; r < 16; ++r) { s0[r] = s0[r] > 0.f ? -1e30f : s0[r]; s1[r] = s1[r] > 0.f ? -1e30f : s1[r]; }
    }
  }
#pragma unroll
  for (int ks = 0; ks < 4; ++ks) {
    const int ch = c * 8 + ks * 2 + hi;
    bf16x8 bq = *(const bf16x8*)(qbase + ((ch ^ qsw) << 4));
    bf16x8 ka0 = *(const bf16x8*)(kb + r32 * 256 + ((ch ^ qsw) << 4));
    bf16x8 ka1 = *(const bf16x8*)(kb + (32 + r32) * 256 + ((ch ^ qsw) << 4));
    s0 = MFMA32(ka0, bq, s0);
    s1 = MFMA32(ka1, bq, s1);
    __builtin_amdgcn_sched_barrier(0);
  }
  float mx = fmaxf(s0[0], s1[0]);
#pragma unroll
  for (int r = 1; r < 16; ++r) mx = fmaxf(mx, fmaxf(s0[r], s1[r]));
  mx = half_swap_max(mx);
  float mref = mref_io;
  if (__any((mx - mref) * c1 > 6.0f)) {
    const float mn = fmaxf(mref, mx);
    const float alpha = exp2f((mref - mn) * c1);
    l_io *= alpha;
#pragma unroll
    for (int i = 0; i < 4; ++i)
#pragma unroll
      for (int r = 0; r < 16; ++r) o[i][r] *= alpha;
    mref = mn; mref_io = mn;
  }
  const float nm = -mref * c1;
  float ls = 0.f;
#pragma unroll
  for (int r = 0; r < 16; ++r) { s0[r] = __builtin_amdgcn_exp2f(fmaf(s0[r], c1, nm)); s1[r] = __builtin_amdgcn_exp2f(fmaf(s1[r], c1, nm)); ls += s0[r] + s1[r]; }
  l_io += ls;
  const int q4 = (lane & 15) >> 2, g1 = (lane >> 4) & 1, p4 = lane & 3;
#pragma unroll
  for (int kk = 0; kk < 4; ++kk) {
    const int key0 = 16 * kk + 4 * hi + q4;
    uint4 pwv;
    if (kk < 2) { pwv.x = cvtpk(s0[8 * kk], s0[8 * kk + 1]); pwv.y = cvtpk(s0[8 * kk + 2], s0[8 * kk + 3]); pwv.z = cvtpk(s0[8 * kk + 4], s0[8 * kk + 5]); pwv.w = cvtpk(s0[8 * kk + 6], s0[8 * kk + 7]); }
    else { const int k2 = kk - 2; pwv.x = cvtpk(s1[8 * k2], s1[8 * k2 + 1]); pwv.y = cvtpk(s1[8 * k2 + 2], s1[8 * k2 + 3]); pwv.z = cvtpk(s1[8 * k2 + 4], s1[8 * k2 + 5]); pwv.w = cvtpk(s1[8 * k2 + 6], s1[8 * k2 + 7]); }
    const bf16x8 pb = __builtin_bit_cast(bf16x8, pwv);
#pragma unroll
    for (int dvt = 0; dvt < 4; ++dvt) {
      const int c8 = 8 * (dvt ^ q4) + 4 * g1 + p4;
      v4i16_t lo = __builtin_amdgcn_ds_read_tr16_b64_v4i16(LDSP(v4i16_t, vb + key0 * 256 + c8 * 8));
      v4i16_t hi4 = __builtin_amdgcn_ds_read_tr16_b64_v4i16(LDSP(v4i16_t, vb + (key0 + 8) * 256 + c8 * 8));
      bf16x8 va = (bf16x8){lo[0], lo[1], lo[2], lo[3], hi4[0], hi4[1], hi4[2], hi4[3]};
      o[dvt] = MFMA32(va, pb, o[dvt]);
    }
    __builtin_amdgcn_sched_barrier(0);
  }
}

__device__ __forceinline__ void attn_unit(char* lds, const bf16_t* __restrict__ proj, bf16_t* mix, const float* __restrict__ subg, float lam, int b, int h, int t) {
  const int tix = opaque_tid();
  const int tid = tix, lane = tid & 63, r32 = lane & 31, hi = lane >> 5;
  const int wid = __builtin_amdgcn_readfirstlane(tid >> 6);
  const int c = wid >> 2, qg = wid & 3;
  const int q0 = NMETA + 128 * t, qw0 = q0 + 32 * qg, qpos = qw0 + r32;
  const size_t rowb = (size_t)b * LP;
  const int NT = 2 * t + 3;
  char* Qs = lds;
  char* KV = lds + 32768;
  const float sl8 = exp2f(1.0f - 2.0f * (float)h);
  __syncthreads();
  attn_issue_kv(KV, proj + rowb * INC + h * 128, tid, wid);
#pragma unroll
  for (int i = 0; i < 4; ++i) {
    const int g = i * 512 + tid, row = g >> 4, pos = g & 15;
    uint4 v = *(const uint4*)(proj + (rowb + q0 + row) * INC + h * 128 + ((pos ^ (row & 15)) << 3));
    *(uint4*)(Qs + g * 16) = v;
  }
  f32x16 o[4];
#pragma unroll
  for (int i = 0; i < 4; ++i)
#pragma unroll
    for (int r = 0; r < 16; ++r) o[i][r] = 0.f;
  float m = -1e30f, l = 0.f;
  const int qrow = 32 * qg + r32;
  const char* qbase = Qs + qrow * 256;
  const int qsw = qrow & 15;
  for (int j = 0; j < NT; ++j) {
    __syncthreads();
    if (j + 1 < NT) attn_issue_kv(KV + ((j + 1) & 1) * 32768, proj + (rowb + 64 * (j + 1)) * INC + h * 128, tid, wid);
    if (64 * j > qw0 + 31) continue;
    const char* kb = KV + (j & 1) * 32768;
    const char* vb = kb + 16384;
    const int kq = 64 * j + 4 * hi - qpos;
    if (64 * j + 63 > qw0) attn_map<true>(o, m, l, qbase, qsw, kb, vb, c, kq, sl8, lane, r32, hi);
    else attn_map<false>(o, m, l, qbase, qsw, kb, vb, c, kq, sl8, lane, r32, hi);
  }
  l = half_swap_sum(l);
  const float sc = (c == 0 ? 1.0f : lam) / l;
  __syncthreads();
  float* X = (float*)(lds + 32768);
  if (c == 1) {
#pragma unroll
    for (int i = 0; i < 4; ++i)
#pragma unroll
      for (int r = 0; r < 16; ++r) X[(qg * 64 + i * 16 + r) * 64 + lane] = o[i][r] * sc;
  }
  __syncthreads();
  if (c == 0) {
    float ss = 0.f;
#pragma unroll
    for (int i = 0; i < 4; ++i) {
#pragma unroll
      for (int r = 0; r < 16; ++r) { float v = o[i][r] * sc - X[(qg * 64 + i * 16 + r) * 64 + lane]; o[i][r] = v; ss += v * v; }
      __builtin_amdgcn_sched_barrier(0);
    }
    ss = half_swap_sum(ss);
    const float rstd = rsqrtf(ss * (1.0f / 128.0f) + EPS) * (1.0f - LAM_INIT);
    bf16_t* orow = mix + (rowb + qpos) * D + h * 128;
#pragma unroll
    for (int i = 0; i < 4; ++i) {
#pragma unroll
      for (int g = 0; g < 4; ++g) {
        const int dv0 = 32 * i + 8 * g + 4 * hi;
        const float4 sg = *(const float4*)(subg + dv0);
        uint2 w; w.x = cvtpk(o[i][4 * g] * rstd * sg.x, o[i][4 * g + 1] * rstd * sg.y); w.y = cvtpk(o[i][4 * g + 2] * rstd * sg.z, o[i][4 * g + 3] * rstd * sg.w);
        *(uint2*)(orow + dv0) = w;
      }
      __builtin_amdgcn_sched_barrier(0);
    }
  }
}


__device__ __forceinline__ void conv_unit(char* lds, const bf16_t* __restrict__ proj, bf16_t* mix, const float* __restrict__ cw, const float* __restrict__ cb,
                                          const float* __restrict__ gng, const float* __restrict__ gnb, int b, int pos0) {
  const int tix = opaque_tid();
  const int c = tix;
  float* U = (float*)lds;
  __syncthreads();
  {
    const int lane = tix & 63, wv = tix >> 6;
    uint4 ra[8], rg[8];
#pragma unroll
    for (int i = 0; i < 8; ++i) {
      const int r = wv + 8 * i, pos = pos0 - 30 + r;
      ra[i] = make_uint4(0, 0, 0, 0); rg[i] = make_uint4(0, 0, 0, 0);
      if (r < 62 && pos >= 0) {
        const bf16_t* pr = proj + ((size_t)b * LP + pos) * INC + 8 * lane;
        ra[i] = *(const uint4*)(pr + 1536); rg[i] = *(const uint4*)(pr + 2048);
      }
    }
#pragma unroll
    for (int i = 0; i < 8; ++i) {
      const int r = wv + 8 * i;
      if (r < 62) {
        const unsigned av[4] = {ra[i].x, ra[i].y, ra[i].z, ra[i].w}, gv[4] = {rg[i].x, rg[i].y, rg[i].z, rg[i].w};
        float u[8];
#pragma unroll
        for (int q = 0; q < 4; ++q) {
          const float a0 = __uint_as_float(av[q] << 16), a1 = __uint_as_float(av[q] & 0xffff0000u), g0 = __uint_as_float(gv[q] << 16), g1 = __uint_as_float(gv[q] & 0xffff0000u);
          u[2 * q] = a0 / (1.0f + __expf(-g0)); u[2 * q + 1] = a1 / (1.0f + __expf(-g1));
        }
        *(float4*)(U + r * 512 + 8 * lane) = make_float4(u[0], u[1], u[2], u[3]);
        *(float4*)(U + r * 512 + 8 * lane + 4) = make_float4(u[4], u[5], u[6], u[7]);
      }
    }
  }
  float w[31];
#pragma unroll
  for (int j = 0; j < 31; ++j) w[j] = cw[j * 512 + c];
  const float bias = cb[c], gg = gng[c], gb2 = gnb[c];
  __syncthreads();
  for (int t = 0; t < 32; ++t) {
    float y = bias;
#pragma unroll
    for (int j = 0; j < 31; ++j) y = fmaf(w[j], U[(t + j) * 512 + c], y);
    const float mu = wave_sum(y) * (1.0f / 64.0f);
    const float d = y - mu;
    const float var = wave_sum(d * d) * (1.0f / 64.0f);
    const float n = d * rsqrtf(var + EPS) * gg + gb2;
    mix[((size_t)b * LP + pos0 + t) * D + 512 + c] = f2bf(n / (1.0f + __expf(-n)));
  }
}

__device__ __forceinline__ void p_conv_naive(int blk, const bf16_t* __restrict__ proj, bf16_t* mix, const float* cw, const float* cb, const float* gg_, const float* gb_) {
  const int tix = opaque_tid();
  int row = blk, tid = (tix & 255);
  int b = row / LP, pos = row - b * LP;
  int c0 = tid * 2;
  unsigned* outp = (unsigned*)(mix + (size_t)row * D + 512 + c0);
  if (pos >= LREAL) { *outp = 0u; return; }
  float y0 = cb[c0], y1 = cb[c0 + 1];
  for (int j = 0; j < 31; ++j) {
    int p = pos - 30 + j;
    if (p < 0) continue;
    const bf16_t* pr = proj + ((size_t)b * LP + p) * INC;
    unsigned a = *(const unsigned*)(pr + 1536 + c0), g = *(const unsigned*)(pr + 2048 + c0);
    float a0 = bf2f(a & 0xffffu), a1 = bf2f(a >> 16), g0 = bf2f(g & 0xffffu), g1 = bf2f(g >> 16);
    float u0 = a0 / (1.0f + __expf(-g0)), u1 = a1 / (1.0f + __expf(-g1));
    y0 += cw[j * 512 + c0] * u0; y1 += cw[j * 512 + c0 + 1] * u1;
  }
  float s = y0 + y1;
#pragma unroll
  for (int o = 16; o >= 1; o >>= 1) s += __shfl_xor(s, o);
  float mu = s * (1.0f / 64.0f);
  float d0 = y0 - mu, d1 = y1 - mu;
  float v = d0 * d0 + d1 * d1;
#pragma unroll
  for (int o = 16; o >= 1; o >>= 1) v += __shfl_xor(v, o);
  float rstd = rsqrtf(v * (1.0f / 64.0f) + EPS);
  float n0 = d0 * rstd * gg_[c0] + gb_[c0], n1 = d1 * rstd * gg_[c0 + 1] + gb_[c0 + 1];
  float r0 = n0 / (1.0f + __expf(-n0)), r1 = n1 / (1.0f + __expf(-n1));
  *outp = pack2(r0, r1);
}

__device__ __forceinline__ void p_norm2(int blk, float* red, const float* h2, const float* g2, bf16_t* xn2) {
  const int tix = opaque_tid();
  int row = blk, tid = (tix & 255);
  __syncthreads();
  float4 v = ((const float4*)(h2 + (size_t)row * D))[tid];
  float ss = v.x * v.x + v.y * v.y + v.z * v.z + v.w * v.w;
  ss = wave_sum(ss);
  if ((tid & 63) == 0) red[tid >> 6] = ss;
  __syncthreads();
  float tot = red[0] + red[1] + red[2] + red[3];
  float rstd = rsqrtf(tot * (1.0f / D) + EPS);
  float4 g = ((const float4*)g2)[tid];
  uint2 o; o.x = pack2(v.x * rstd * g.x, v.y * rstd * g.y); o.y = pack2(v.z * rstd * g.z, v.w * rstd * g.w);
  ((uint2*)(xn2 + (size_t)row * D))[tid] = o;
}

__device__ __forceinline__ void p_topk_naive(int blk, const bf16_t* __restrict__ qp, const float* __restrict__ sk, int* eb, float* gb) {
  const int tix = opaque_tid();
  int w = blk * 4 + ((tix & 255) >> 6), lane = (tix & 255) & 63;
  int row = w >> 3, h = w & 7;
  int pos = row % LP;
  if (pos < NMETA || pos >= LREAL) return;
  const float NEG = -3.0e38f;
  float top[2];
#pragma unroll
  for (int p = 0; p < 2; ++p) {
    const bf16_t* qv = qp + (size_t)row * 2048 + h * 256 + p * 128;
    const float* k0 = sk + ((size_t)(h * 2 + p) * 128 + lane) * 128;
    const float* k1 = k0 + 64 * 128;
    float s0 = 0.f, s1 = 0.f;
    for (int d = 0; d < 128; d += 8) {
      uint4 r = *(const uint4*)(qv + d);
      float qf[8] = {bf2f(r.x & 0xffffu), bf2f(r.x >> 16), bf2f(r.y & 0xffffu), bf2f(r.y >> 16), bf2f(r.z & 0xffffu), bf2f(r.z >> 16), bf2f(r.w & 0xffffu), bf2f(r.w >> 16)};
      float4 a0 = *(const float4*)(k0 + d), a1 = *(const float4*)(k0 + d + 4), b0 = *(const float4*)(k1 + d), b1 = *(const float4*)(k1 + d + 4);
      s0 += qf[0] * a0.x + qf[1] * a0.y + qf[2] * a0.z + qf[3] * a0.w + qf[4] * a1.x + qf[5] * a1.y + qf[6] * a1.z + qf[7] * a1.w;
      s1 += qf[0] * b0.x + qf[1] * b0.y + qf[2] * b0.z + qf[3] * b0.w + qf[4] * b1.x + qf[5] * b1.y + qf[6] * b1.z + qf[7] * b1.w;
    }
    float v0 = __uint_as_float((__float_as_uint(s0) & ~127u) | (unsigned)lane);
    float v1 = __uint_as_float((__float_as_uint(s1) & ~127u) | (unsigned)(lane + 64));
    float t = NEG;
    for (int it = 0; it < 16; ++it) {
      float m = wave_max(fmaxf(v0, v1));
      if (lane == it) t = m;
      if (v0 == m) v0 = NEG;
      if (v1 == m) v1 = NEG;
    }
    top[p] = t;
  }
  int ci = lane >> 2, jb = (lane & 3) * 4;
  float av = __uint_as_float(__float_as_uint(__shfl(top[0], ci)) & ~127u);
  float c[4];
#pragma unroll
  for (int jj = 0; jj < 4; ++jj) {
    float bv = __uint_as_float(__float_as_uint(__shfl(top[1], jb + jj)) & ~127u);
    float s = av + bv;
    c[jj] = __uint_as_float((__float_as_uint(s) & ~255u) | (unsigned)(ci * 16 + jb + jj));
  }
  float ct = NEG;
  for (int it = 0; it < 16; ++it) {
    float m = wave_max(fmaxf(fmaxf(c[0], c[1]), fmaxf(c[2], c[3])));
    if (lane == it) ct = m;
#pragma unroll
    for (int jj = 0; jj < 4; ++jj) if (c[jj] == m) c[jj] = NEG;
  }
  unsigned cbits = __float_as_uint(ct);
  int cidx = cbits & 255u;
  float cval = __uint_as_float(cbits & ~255u);
  int i1 = __float_as_uint(__shfl(top[0], (cidx >> 4) & 15)) & 127u;
  int i2 = __float_as_uint(__shfl(top[1], cidx & 15)) & 127u;
  float mx = __shfl(cval, 0);
  float ex = lane < 16 ? __expf(cval - mx) : 0.f;
  float sum = wave_sum(ex);
  if (lane < 16) {
    eb[((size_t)row * 8 + h) * 16 + lane] = i1 * 128 + i2;
    gb[((size_t)row * 8 + h) * 16 + lane] = ex / sum;
  }
}


__device__ __forceinline__ void ce_desc(float& a, float& b) { const float hi = fmaxf(a, b), lo = fminf(a, b); a = hi; b = lo; }
__device__ __forceinline__ void ce_asc(float& a, float& b) { const float hi = fmaxf(a, b), lo = fminf(a, b); a = lo; b = hi; }
template <int N> __device__ __forceinline__ void bitonic_sort_desc(float (&v)[N]) {
#pragma unroll
  for (int k = 2; k <= N; k <<= 1)
#pragma unroll
    for (int j = k >> 1; j > 0; j >>= 1)
#pragma unroll
      for (int i = 0; i < N; ++i) { const int l = i ^ j; if (l > i) { if ((i & k) == 0) ce_desc(v[i], v[l]); else ce_asc(v[i], v[l]); } }
}
template <int N> __device__ __forceinline__ void bitonic_merge_desc(float (&v)[N]) {
#pragma unroll
  for (int j = N >> 1; j > 0; j >>= 1)
#pragma unroll
    for (int i = 0; i < N; ++i) { const int l = i ^ j; if (l > i) ce_desc(v[i], v[l]); }
}
__device__ __forceinline__ void cep_desc(float& a, float& b, int& pa, int& pb) { const bool sw = b > a; const float hi = sw ? b : a, lo = sw ? a : b; const int ph = sw ? pb : pa, pl = sw ? pa : pb; a = hi; b = lo; pa = ph; pb = pl; }
__device__ __forceinline__ void cep_asc(float& a, float& b, int& pa, int& pb) { const bool sw = b < a; const float lo = sw ? b : a, hi = sw ? a : b; const int pl = sw ? pb : pa, ph = sw ? pa : pb; a = lo; b = hi; pa = pl; pb = ph; }
template <int N> __device__ __forceinline__ void bitonic_sortp_desc(float (&v)[N], int (&q)[N]) {
#pragma unroll
  for (int k = 2; k <= N; k <<= 1)
#pragma unroll
    for (int j = k >> 1; j > 0; j >>= 1)
#pragma unroll
      for (int i = 0; i < N; ++i) { const int l = i ^ j; if (l > i) { if ((i & k) == 0) cep_desc(v[i], v[l], q[i], q[l]); else cep_asc(v[i], v[l], q[i], q[l]); } }
}
template <int N> __device__ __forceinline__ void bitonic_mergep_desc(float (&v)[N], int (&q)[N]) {
#pragma unroll
  for (int j = N >> 1; j > 0; j >>= 1)
#pragma unroll
    for (int i = 0; i < N; ++i) { const int l = i ^ j; if (l > i) cep_desc(v[i], v[l], q[i], q[l]); }
}
__host__ __device__ constexpr int cand_slot(int i, int j) { int s = 0; for (int ii = 0; ii < i; ++ii) s += 16 / (ii + 1); return s + j; }

__device__ __forceinline__ void peer_topk_unit(char* lds, const bf16_t* __restrict__ qp, const bf16_t* __restrict__ skb, int* eb, float* gb, int row0, int h) {
  const int tix = opaque_tid();
  const int tid = tix, lane = tid & 63, wid = tid >> 6, fr = lane & 15, fq = lane >> 4;
  __syncthreads();
#pragma unroll
  for (int i = 0; i < 8; ++i) {
    const int g = i * 512 + tid, row = g >> 4, pos = g & 15;
    *(uint4*)(lds + g * 16) = *(const uint4*)(skb + ((size_t)(h * 2) * 128 + row) * 128 + ((pos ^ (row & 15)) << 3));
  }
  if (tid < 64) {
    int i = 0, base = 0;
    while (i < 15 && tid >= base + 16 / (i + 1)) { base += 16 / (i + 1); ++i; }
    ((int*)(lds + 65536))[tid] = (i << 4) | ((tid - base) & 15);
  }
  __syncthreads();
  const int tok = row0 + wid * 16 + fr;
  float top[2][16];
#pragma unroll
  for (int p = 0; p < 2; ++p) {
    f32x4 acc[8];
#pragma unroll
    for (int i = 0; i < 8; ++i) acc[i] = (f32x4){0.f, 0.f, 0.f, 0.f};
    const bf16_t* xrow = qp + (size_t)tok * 2048 + h * 256 + p * 128 + fq * 8;
#pragma unroll
    for (int ks = 0; ks < 4; ++ks) {
      const bf16x8 xb = *(const bf16x8*)(xrow + ks * 32);
      const int ch = ks * 4 + fq;
#pragma unroll
      for (int nt = 0; nt < 8; ++nt) {
        const int r = p * 128 + nt * 16 + fr;
        const bf16x8 wa = *(const bf16x8*)(lds + r * 256 + ((ch ^ (r & 15)) << 4));
        acc[nt] = __builtin_amdgcn_mfma_f32_16x16x32_bf16(wa, xb, acc[nt], 0, 0, 0);
      }
    }
    float v[32];
#pragma unroll
    for (int nt = 0; nt < 8; ++nt)
#pragma unroll
      for (int r = 0; r < 4; ++r) v[nt * 4 + r] = __uint_as_float((__float_as_uint(acc[nt][r]) & ~127u) | (unsigned)(nt * 16 + fq * 4 + r));
    bitonic_sort_desc<32>(v);
    float t[16];
#pragma unroll
    for (int i = 0; i < 16; ++i) t[i] = v[i];
#pragma unroll
    for (int rnd = 0; rnd < 2; ++rnd) {
      float pb[16];
#pragma unroll
      for (int i = 0; i < 16; ++i) pb[i] = __shfl_xor(t[15 - i], rnd == 0 ? 16 : 32);
#pragma unroll
      for (int i = 0; i < 16; ++i) t[i] = fmaxf(t[i], pb[i]);
      bitonic_merge_desc<16>(t);
    }
#pragma unroll
    for (int i = 0; i < 16; ++i) top[p][i] = t[i];
  }
  int* ST = (int*)(lds + 65536);
  int* IDX = (int*)(lds + 65536 + 256) + (wid * 16 + fr) * 32;
#define SEL4(arr, q) (fq == 0 ? arr[q] : fq == 1 ? arr[4 + (q)] : fq == 2 ? arr[8 + (q)] : arr[12 + (q)])
  {
    int4 ia, ib;
    ia.x = __float_as_uint(SEL4(top[0], 0)) & 127; ia.y = __float_as_uint(SEL4(top[0], 1)) & 127; ia.z = __float_as_uint(SEL4(top[0], 2)) & 127; ia.w = __float_as_uint(SEL4(top[0], 3)) & 127;
    ib.x = __float_as_uint(SEL4(top[1], 0)) & 127; ib.y = __float_as_uint(SEL4(top[1], 1)) & 127; ib.z = __float_as_uint(SEL4(top[1], 2)) & 127; ib.w = __float_as_uint(SEL4(top[1], 3)) & 127;
    *(int4*)(IDX + 4 * fq) = ia; *(int4*)(IDX + 16 + 4 * fq) = ib;
  }
  float cv[64];
#pragma unroll
  for (int i = 50; i < 64; ++i) cv[i] = -3.0e38f;
#pragma unroll
  for (int i = 0; i < 16; ++i)
#pragma unroll
    for (int j = 0; j < 16; ++j)
      if ((i + 1) * (j + 1) <= 16) {
        const float sv = __uint_as_float(__float_as_uint(top[0][i]) & ~127u) + __uint_as_float(__float_as_uint(top[1][j]) & ~127u);
        cv[cand_slot(i, j)] = __uint_as_float((__float_as_uint(sv) & ~63u) | (unsigned)cand_slot(i, j));
      }
  bitonic_sort_desc<64>(cv);
  float ex[16]; float sum = 0.f;
  const float c0v = __uint_as_float(__float_as_uint(cv[0]) & ~63u);
#pragma unroll
  for (int i = 0; i < 16; ++i) { ex[i] = __expf(__uint_as_float(__float_as_uint(cv[i]) & ~63u) - c0v); sum += ex[i]; }
  const float inv = 1.0f / sum;
  int e4[4]; float g4[4];
#pragma unroll
  for (int q = 0; q < 4; ++q) {
    const int slot = __float_as_uint(SEL4(cv, q)) & 63;
    const int ij = ST[slot];
    e4[q] = IDX[ij >> 4] * 128 + IDX[16 + (ij & 15)];
    g4[q] = SEL4(ex, q) * inv;
  }
#undef SEL4
  *(int4*)(eb + ((size_t)tok * 8 + h) * 16 + 4 * fq) = make_int4(e4[0], e4[1], e4[2], e4[3]);
  *(float4*)(gb + ((size_t)tok * 8 + h) * 16 + 4 * fq) = make_float4(g4[0], g4[1], g4[2], g4[3]);
}

__device__ __forceinline__ void p_cvt_bf16(int blk, int nblk, const float* __restrict__ src, bf16_t* dst, size_t n8) {
  const int tix = opaque_tid();
  for (size_t i = (size_t)blk * 512 + tix; i < n8; i += (size_t)nblk * 512) {
    const float4 a = ((const float4*)src)[2 * i], b = ((const float4*)src)[2 * i + 1];
    uint4 w; w.x = cvtpk(a.x, a.y); w.y = cvtpk(a.z, a.w); w.z = cvtpk(b.x, b.y); w.w = cvtpk(b.z, b.w);
    ((uint4*)dst)[i] = w;
  }
}


typedef float f32x2v __attribute__((ext_vector_type(2)));
__device__ __forceinline__ void p_cvt_fp8_rows(int blk, int nblk, const float* __restrict__ src, unsigned* dst, float* inv) {
  const int tix = opaque_tid();
  const int lane = tix & 63, wid = tix >> 6;
  for (int r = blk * 8 + wid; r < 16384; r += nblk * 8) {
    const float4* sp = (const float4*)(src + (size_t)r * D);
    float4 v[4];
#pragma unroll
    for (int k = 0; k < 4; ++k) v[k] = sp[k * 64 + lane];
    float am = 0.f;
#pragma unroll
    for (int k = 0; k < 4; ++k) am = fmaxf(am, fmaxf(fmaxf(fabsf(v[k].x), fabsf(v[k].y)), fmaxf(fabsf(v[k].z), fabsf(v[k].w))));
    am = wave_max(am);
    const float sc = am > 0.f ? 384.0f / am : 1.0f;
#pragma unroll
    for (int k = 0; k < 4; ++k) {
      int w = __builtin_amdgcn_cvt_pk_fp8_f32(v[k].x * sc, v[k].y * sc, 0, false);
      w = __builtin_amdgcn_cvt_pk_fp8_f32(v[k].z * sc, v[k].w * sc, w, true);
      dst[(size_t)r * 256 + k * 64 + lane] = (unsigned)w;
    }
    if (lane == 0) inv[r] = am > 0.f ? am * (1.0f / 384.0f) : 1.0f;
  }
}
__device__ __forceinline__ float row16_sum(float v) {
  v += __builtin_bit_cast(float, __builtin_amdgcn_update_dpp(0, __builtin_bit_cast(int, v), 0x128, 0xf, 0xf, true));
  v += __builtin_bit_cast(float, __builtin_amdgcn_update_dpp(0, __builtin_bit_cast(int, v), 0x124, 0xf, 0xf, true));
  v += __builtin_bit_cast(float, __builtin_amdgcn_update_dpp(0, __builtin_bit_cast(int, v), 0x122, 0xf, 0xf, true));
  v += __builtin_bit_cast(float, __builtin_amdgcn_update_dpp(0, __builtin_bit_cast(int, v), 0x121, 0xf, 0xf, true));
  return v;
}
__device__ __forceinline__ void peer_gather_token(char* wlds  , int lane, size_t row, size_t orow, const bf16_t* __restrict__ xn2, const float* __restrict__ h2,
                                                  const int* __restrict__ eb, const float* __restrict__ gb, const unsigned char* __restrict__ ut8, const float* __restrict__ uinv,
                                                  const unsigned char* __restrict__ vt8, const float* __restrict__ vinv, const float* __restrict__ fg, float* __restrict__ out) {
  int* E = (int*)wlds; float* Gt = (float*)(wlds + 512); float* W = (float*)(wlds + 1024);
  const int i16 = lane & 15, g = lane >> 4;
  {
    const int e0 = eb[row * 128 + lane], e1 = eb[row * 128 + 64 + lane];
    E[lane] = e0; E[lane + 64] = e1;
    Gt[lane] = gb[row * 128 + lane]; Gt[lane + 64] = gb[row * 128 + 64 + lane];
  }
  float xf[4][16];
#pragma unroll
  for (int k = 0; k < 4; ++k) {
    const uint4 a = *(const uint4*)(xn2 + row * D + 256 * k + 16 * i16), b = *(const uint4*)(xn2 + row * D + 256 * k + 16 * i16 + 8);
    xf[k][0] = __uint_as_float(a.x << 16); xf[k][1] = __uint_as_float(a.x & 0xffff0000u); xf[k][2] = __uint_as_float(a.y << 16); xf[k][3] = __uint_as_float(a.y & 0xffff0000u);
    xf[k][4] = __uint_as_float(a.z << 16); xf[k][5] = __uint_as_float(a.z & 0xffff0000u); xf[k][6] = __uint_as_float(a.w << 16); xf[k][7] = __uint_as_float(a.w & 0xffff0000u);
    xf[k][8] = __uint_as_float(b.x << 16); xf[k][9] = __uint_as_float(b.x & 0xffff0000u); xf[k][10] = __uint_as_float(b.y << 16); xf[k][11] = __uint_as_float(b.y & 0xffff0000u);
    xf[k][12] = __uint_as_float(b.z << 16); xf[k][13] = __uint_as_float(b.z & 0xffff0000u); xf[k][14] = __uint_as_float(b.w << 16); xf[k][15] = __uint_as_float(b.w & 0xffff0000u);
  }
#pragma unroll 2
  for (int m = 0; m < 32; ++m) {
    const int e = E[4 * m + g];
    const unsigned char* ur = ut8 + (size_t)e * D + 16 * i16;
    uint4 u[4];
#pragma unroll
    for (int k = 0; k < 4; ++k) u[k] = *(const uint4*)(ur + 256 * k);
    float d0 = 0.f, d1 = 0.f;
#pragma unroll
    for (int k = 0; k < 4; ++k) {
      const unsigned wv[4] = {u[k].x, u[k].y, u[k].z, u[k].w};
#pragma unroll
      for (int q = 0; q < 4; ++q) {
        const f32x2v lo = __builtin_amdgcn_cvt_pk_f32_fp8((int)wv[q], false), hi = __builtin_amdgcn_cvt_pk_f32_fp8((int)wv[q], true);
        d0 = fmaf(lo.x, xf[k][4 * q], d0); d1 = fmaf(lo.y, xf[k][4 * q + 1], d1);
        d0 = fmaf(hi.x, xf[k][4 * q + 2], d0); d1 = fmaf(hi.y, xf[k][4 * q + 3], d1);
      }
    }
    const float d = row16_sum(d0 + d1);
    if (i16 == 0) W[4 * m + g] = d;
  }
  {
    const int e0 = E[lane], e1 = E[lane + 64];
    const float ui0 = uinv[e0], ui1 = uinv[e1];
    const float a0 = W[lane] * ui0, a1 = W[lane + 64] * ui1;
    const float g0 = Gt[lane], g1 = Gt[lane + 64];
    W[lane] = g0 * 0.5f * a0 * (1.0f + erff(a0 * 0.70710678118654752f)) * vinv[e0];
    W[lane + 64] = g1 * 0.5f * a1 * (1.0f + erff(a1 * 0.70710678118654752f)) * vinv[e1];
  }
  float acc[4][16];
#pragma unroll
  for (int k = 0; k < 4; ++k)
#pragma unroll
    for (int i = 0; i < 16; ++i) acc[k][i] = 0.f;
#pragma unroll 2
  for (int m = 0; m < 32; ++m) {
    const int e = E[4 * m + g];
    const float w = W[4 * m + g];
    const unsigned char* vr = vt8 + (size_t)e * D + 16 * i16;
    uint4 v[4];
#pragma unroll
    for (int k = 0; k < 4; ++k) v[k] = *(const uint4*)(vr + 256 * k);
#pragma unroll
    for (int k = 0; k < 4; ++k) {
      const unsigned wv[4] = {v[k].x, v[k].y, v[k].z, v[k].w};
#pragma unroll
      for (int q = 0; q < 4; ++q) {
        const f32x2v lo = __builtin_amdgcn_cvt_pk_f32_fp8((int)wv[q], false), hi = __builtin_amdgcn_cvt_pk_f32_fp8((int)wv[q], true);
        acc[k][4 * q] = fmaf(w, lo.x, acc[k][4 * q]); acc[k][4 * q + 1] = fmaf(w, lo.y, acc[k][4 * q + 1]);
        acc[k][4 * q + 2] = fmaf(w, hi.x, acc[k][4 * q + 2]); acc[k][4 * q + 3] = fmaf(w, hi.y, acc[k][4 * q + 3]);
      }
    }
  }
  float res[16];
#pragma unroll
  for (int k = 0; k < 4; ++k)
#pragma unroll
    for (int j = 0; j < 16; ++j) {
      float t = acc[k][j];
      t += __shfl_xor(t, 16); t += __shfl_xor(t, 32);
      if (k == g) res[j] = t;
    }
  const int c0 = 256 * g + 16 * i16;
  float ss = 0.f;
#pragma unroll
  for (int q = 0; q < 4; ++q) {
    const float4 hv = *(const float4*)(h2 + row * D + c0 + 4 * q);
    res[4 * q] += hv.x; res[4 * q + 1] += hv.y; res[4 * q + 2] += hv.z; res[4 * q + 3] += hv.w;
  }
#pragma unroll
  for (int i = 0; i < 16; ++i) ss += res[i] * res[i];
  ss = wave_sum(ss);
  const float rstd = rsqrtf(ss * (1.0f / D) + EPS);
#pragma unroll
  for (int q = 0; q < 4; ++q) {
    const float4 f = *(const float4*)(fg + c0 + 4 * q);
    *(float4*)(out + orow * D + c0 + 4 * q) = make_float4(res[4 * q] * rstd * f.x, res[4 * q + 1] * rstd * f.y, res[4 * q + 2] * rstd * f.z, res[4 * q + 3] * rstd * f.w);
  }
}

__device__ __forceinline__ void p_gather_naive(int blk, const bf16_t* __restrict__ xn2, const float* __restrict__ h2, const int* __restrict__ eb, const float* __restrict__ gb,
                                                      const float* __restrict__ ut, const float* __restrict__ vt, const float* fg, float* out) {
  const int tix = opaque_tid();
  int tk = blk * 4 + ((tix & 255) >> 6), lane = (tix & 255) & 63;
  int b = tk / SEQ, s = tk - b * SEQ;
  size_t row = (size_t)b * LP + NMETA + s;
  float xv[16];
  {
    const uint4* xp = (const uint4*)(xn2 + row * D + lane * 16);
#pragma unroll
    for (int i = 0; i < 2; ++i) {
      uint4 r = xp[i];
      xv[i * 8 + 0] = bf2f(r.x & 0xffffu); xv[i * 8 + 1] = bf2f(r.x >> 16); xv[i * 8 + 2] = bf2f(r.y & 0xffffu); xv[i * 8 + 3] = bf2f(r.y >> 16);
      xv[i * 8 + 4] = bf2f(r.z & 0xffffu); xv[i * 8 + 5] = bf2f(r.z >> 16); xv[i * 8 + 6] = bf2f(r.w & 0xffffu); xv[i * 8 + 7] = bf2f(r.w >> 16);
    }
  }
  float acc[16];
#pragma unroll
  for (int i = 0; i < 16; ++i) acc[i] = 0.f;
  for (int k = 0; k < 128; ++k) {
    int e = eb[row * 128 + k];
    float gate = gb[row * 128 + k];
    const float4* up = (const float4*)(ut + (size_t)e * D + lane * 16);
    float dsum = 0.f;
#pragma unroll
    for (int i = 0; i < 4; ++i) { float4 u = up[i]; dsum += u.x * xv[i * 4] + u.y * xv[i * 4 + 1] + u.z * xv[i * 4 + 2] + u.w * xv[i * 4 + 3]; }
    dsum = wave_sum(dsum);
    float act = 0.5f * dsum * (1.0f + erff(dsum * 0.70710678118654752f));
    float wgt = gate * act;
    const float4* vp = (const float4*)(vt + (size_t)e * D + lane * 16);
#pragma unroll
    for (int i = 0; i < 4; ++i) { float4 v = vp[i]; acc[i * 4] += wgt * v.x; acc[i * 4 + 1] += wgt * v.y; acc[i * 4 + 2] += wgt * v.z; acc[i * 4 + 3] += wgt * v.w; }
  }
  const float4* hp = (const float4*)(h2 + row * D + lane * 16);
  float ss = 0.f;
#pragma unroll
  for (int i = 0; i < 4; ++i) { float4 hv = hp[i]; acc[i * 4] += hv.x; acc[i * 4 + 1] += hv.y; acc[i * 4 + 2] += hv.z; acc[i * 4 + 3] += hv.w; }
#pragma unroll
  for (int i = 0; i < 16; ++i) ss += acc[i] * acc[i];
  ss = wave_sum(ss);
  float rstd = rsqrtf(ss * (1.0f / D) + EPS);
  float4* op = (float4*)(out + ((size_t)b * SEQ + s) * D + lane * 16);
  const float4* gp = (const float4*)(fg + lane * 16);
#pragma unroll
  for (int i = 0; i < 4; ++i) { float4 g = gp[i]; op[i] = make_float4(acc[i * 4] * rstd * g.x, acc[i * 4 + 1] * rstd * g.y, acc[i * 4 + 2] * rstd * g.z, acc[i * 4 + 3] * rstd * g.w); }
}


template <class Epi>
__device__ __forceinline__ void gemm_tile(char* lds, const bf16_t* __restrict__ X, int ldx, const bf16_t* __restrict__ Wt, int ldw, int K, int m0, int n0, const Epi& epi) {
  const int tix = opaque_tid();
  const int tid = tix, lane = tid & 63, wid = tid >> 6;
  const int wm = wid >> 1, wn = wid & 1;
  const int sc = tid & 7, sr = tid >> 3;
  f32x4 acc[4][4];
#pragma unroll
  for (int i = 0; i < 4; ++i)
#pragma unroll
    for (int j = 0; j < 4; ++j) acc[i][j] = (f32x4){0.f, 0.f, 0.f, 0.f};
  uint4 ra[4], rb[2];
  const bf16_t* xp = X + (size_t)(m0 + sr) * ldx + sc * 8;
  const bf16_t* wp = Wt + (size_t)(n0 + sr) * ldw + sc * 8;
  const int nk = K >> 6;
#pragma unroll
  for (int i = 0; i < 4; ++i) ra[i] = *(const uint4*)(xp + (size_t)(64 * i) * ldx);
#pragma unroll
  for (int i = 0; i < 2; ++i) rb[i] = *(const uint4*)(wp + (size_t)(64 * i) * ldw);
#pragma unroll
  for (int i = 0; i < 4; ++i) { int r = sr + 64 * i; *(uint4*)(lds + r * 128 + ((sc ^ ((r >> 1) & 7)) << 4)) = ra[i]; }
#pragma unroll
  for (int i = 0; i < 2; ++i) { int r = sr + 64 * i; *(uint4*)(lds + 32768 + r * 128 + ((sc ^ ((r >> 1) & 7)) << 4)) = rb[i]; }
  __syncthreads();
  const int fr = lane & 15, fq = lane >> 4;
  for (int kt = 0; kt < nk; ++kt) {
    if (kt + 1 < nk) {
#pragma unroll
      for (int i = 0; i < 4; ++i) ra[i] = *(const uint4*)(xp + (size_t)(64 * i) * ldx + (kt + 1) * 64);
#pragma unroll
      for (int i = 0; i < 2; ++i) rb[i] = *(const uint4*)(wp + (size_t)(64 * i) * ldw + (kt + 1) * 64);
    }
    const char* la = lds + (kt & 1) * 49152;
    const char* lb = la + 32768;
#pragma unroll
    for (int kk = 0; kk < 2; ++kk) {
      bf16x8 xa[4], wb[4];
      const int c = kk * 4 + fq;
#pragma unroll
      for (int t = 0; t < 4; ++t) {
        int r = wm * 64 + t * 16 + fr; xa[t] = *(const bf16x8*)(la + r * 128 + ((c ^ ((r >> 1) & 7)) << 4));
        int r2 = wn * 64 + t * 16 + fr; wb[t] = *(const bf16x8*)(lb + r2 * 128 + ((c ^ ((r2 >> 1) & 7)) << 4));
      }
#pragma unroll
      for (int nt = 0; nt < 4; ++nt)
#pragma unroll
        for (int tt = 0; tt < 4; ++tt) acc[nt][tt] = __builtin_amdgcn_mfma_f32_16x16x32_bf16(wb[nt], xa[tt], acc[nt][tt], 0, 0, 0);
    }
    if (kt + 1 < nk) {
      char* lw = lds + ((kt + 1) & 1) * 49152;
#pragma unroll
      for (int i = 0; i < 4; ++i) { int r = sr + 64 * i; *(uint4*)(lw + r * 128 + ((sc ^ ((r >> 1) & 7)) << 4)) = ra[i]; }
#pragma unroll
      for (int i = 0; i < 2; ++i) { int r = sr + 64 * i; *(uint4*)(lw + 32768 + r * 128 + ((sc ^ ((r >> 1) & 7)) << 4)) = rb[i]; }
    }
    __syncthreads();
  }
#pragma unroll
  for (int nt = 0; nt < 4; ++nt)
#pragma unroll
    for (int tt = 0; tt < 4; ++tt) epi(m0 + wm * 64 + tt * 16 + fr, n0 + wn * 64 + nt * 16 + fq * 4, acc[nt][tt]);
}

struct Epi4StoreBf16 { bf16_t* out; int ld; int pad; __device__ __forceinline__ void operator()(int r, int c, f32x4 v) const {
  uint2 w; w.x = pack2(v[0], v[1]); w.y = pack2(v[2], v[3]); *(uint2*)(out + (size_t)r * ld + c) = w; } };
struct Epi4Resid { const float* x; const float* meta; float* h2; __device__ __forceinline__ void operator()(int r, int c, f32x4 v) const {
  const float* src = hrow_ptr(x, meta, r); float4 hv = src ? *(const float4*)(src + c) : make_float4(0.f, 0.f, 0.f, 0.f);
  *(float4*)(h2 + (size_t)r * D + c) = make_float4(hv.x + v[0], hv.y + v[1], hv.z + v[2], hv.w + v[3]); } };

__device__ __forceinline__ void p_transpose(int t, float* smem, const float* __restrict__ W, bf16_t* Wt, int K, int N) {
  const int tix = opaque_tid();
  float (*T)[65] = (float (*)[65])smem;
  const int nbx = N / 64, k0 = (t / nbx) * 64, n0 = (t % nbx) * 64, tid = (tix & 255);
  const int j = tid & 63, i0 = tid >> 6;
#pragma unroll
  for (int ii = 0; ii < 16; ++ii) { int i = i0 + 4 * ii; T[i][j] = W[(size_t)(k0 + i) * N + n0 + j]; }
  __syncthreads();
#pragma unroll
  for (int ii = 0; ii < 16; ++ii) { int jj = i0 + 4 * ii; Wt[(size_t)(n0 + jj) * K + k0 + j] = f2bf(T[j][jj]); }
  __syncthreads();
}
struct Params {
  const float *x, *meta, *g1, *w_in, *lq1, *lk1, *lq2, *lk2, *subg, *conv_w, *conv_b, *gn_g, *gn_b, *w_out, *g2, *wq, *sk, *ut, *vt, *fg;
  float* out; float* scal; bf16_t* r1; bf16_t* r2; float* h2; int* eb; float* gb; bf16_t* wt_in; bf16_t* wt_out; bf16_t* wt_q; bf16_t* skb; unsigned char* ut8; unsigned char* vt8; float* uinv; float* vinv;
};

__global__ void __launch_bounds__(512, 2) mega(Params p) {
  cg::grid_group grid = cg::this_grid();
  __shared__ __attribute__((aligned(16))) char smem_c[131072];
  float* smem = (float*)smem_c;
  const int G = gridDim.x, vh = threadIdx.x >> 8;
  bf16_t* xn1 = p.r1; bf16_t* mix = p.r1; bf16_t* xn2 = p.r1; bf16_t* proj = p.r2; bf16_t* qp = p.r2;
  for (int b = blockIdx.x; b < ROWS / 2; b += G) p_norm1(b * 2 + vh, smem + 4 * vh, p.x, p.meta, p.g1, xn1, p.lq1, p.lk1, p.lq2, p.lk2, p.scal);
  for (int b = blockIdx.x; b < (640 + 256 + 512) / 2; b += G) {
    const int bb = b * 2 + vh; float* sm = smem + vh * (64 * 65);
    if (bb < 640) p_transpose(bb, sm, p.w_in, p.wt_in, D, INC);
    else if (bb < 896) p_transpose(bb - 640, sm, p.w_out, p.wt_out, D, D);
    else p_transpose(bb - 896, sm, p.wq, p.wt_q, D, 2048);
  }
  p_cvt_bf16(blockIdx.x, G, p.sk, p.skb, (size_t)16 * 128 * 128 / 8);
  p_cvt_fp8_rows(blockIdx.x, G, p.ut, (unsigned*)p.ut8, p.uinv);
  p_cvt_fp8_rows(blockIdx.x, G, p.vt, (unsigned*)p.vt8, p.vinv);
  grid.sync();
  for (int b = blockIdx.x; b < (INC / 128) * (ROWS / 256); b += G) gemm_tile(smem_c, xn1, D, p.wt_in, D, D, (b / (INC / 128)) * 256, (b % (INC / 128)) * 128, Epi4StoreBf16{proj, INC, 0});
  grid.sync();
  {
    const float lam = p.scal[0];
    for (int u = blockIdx.x; u < 256; u += G) {
      const int bh = (u & 7) * 4 + (u >> 6), tp = (u >> 3) & 7;
#pragma unroll 1
      for (int k = 0; k < 4; ++k) {
        const int t = (k == 0) ? 31 - tp : (k == 1) ? 16 + tp : (k == 2) ? 15 - tp : tp;
        attn_unit(smem_c, proj, mix, p.subg, lam, bh >> 2, bh & 3, t);
      }
    }
  }
  for (int u = blockIdx.x; u < BATCH * 128; u += G) conv_unit(smem_c, proj, mix, p.conv_w, p.conv_b, p.gn_g, p.gn_b, u >> 7, NMETA + 32 * (u & 127));
  grid.sync();
  for (int b = blockIdx.x; b < (D / 128) * (ROWS / 256); b += G) gemm_tile(smem_c, mix, D, p.wt_out, D, D, (b / (D / 128)) * 256, (b % (D / 128)) * 128, Epi4Resid{p.x, p.meta, p.h2});
  grid.sync();
  for (int b = blockIdx.x; b < ROWS / 2; b += G) p_norm2(b * 2 + vh, smem + 4 * vh, p.h2, p.g2, xn2);
  grid.sync();
  for (int b = blockIdx.x; b < (2048 / 128) * (ROWS / 256); b += G) gemm_tile(smem_c, xn2, D, p.wt_q, D, D, (b / 16) * 256, (b % 16) * 128, Epi4StoreBf16{qp, 2048, 0});
  grid.sync();
  for (int u = blockIdx.x; u < 256 * 8; u += G) {
    const int rt = u >> 3, h = u & 7;
    peer_topk_unit(smem_c, qp, p.skb, p.eb, p.gb, (rt >> 5) * LP + NMETA + 128 * (rt & 31), h);
  }
  grid.sync();
  {
    const int tix = opaque_tid();
    const int lane = tix & 63, wid = tix >> 6;
    for (int tk = blockIdx.x * 8 + wid; tk < BATCH * SEQ; tk += G * 8) {
      const int b = tk / SEQ, sq = tk - b * SEQ;
      peer_gather_token(smem_c + wid * 1536, lane, (size_t)b * LP + NMETA + sq, (size_t)tk, xn2, p.h2, p.eb, p.gb, p.ut8, p.uinv, p.vt8, p.vinv, p.fg, p.out);
    }
  }
}

extern "C" void kernel_launch(void* const* d_in, const int* in_sizes, int n_in, void* d_out, int out_size, void* d_ws, size_t ws_size, hipStream_t stream) {
  static int grid_blocks = 0;
  if (!grid_blocks) {
    int dev = 0, cus = 0, per_cu = 0;
    hipGetDevice(&dev);
    hipDeviceGetAttribute(&cus, hipDeviceAttributeMultiprocessorCount, dev);
    hipOccupancyMaxActiveBlocksPerMultiprocessor(&per_cu, mega, 512, 0);
    if (per_cu > 1) per_cu = 1;
    if (per_cu < 1) per_cu = 1;
    grid_blocks = cus * per_cu;
  }
  Params p{};
  const float** pp = (const float**)&p;
  for (int i = 0; i < 20; ++i) pp[i] = (const float*)d_in[i];
  p.out = (float*)d_out;
  char* ws = (char*)d_ws;
  size_t off = 0;
  p.scal = (float*)(ws + off); off += 4096;
  p.r1 = (bf16_t*)(ws + off); off += (size_t)ROWS * D * 2;
  p.r2 = (bf16_t*)(ws + off); off += (size_t)ROWS * INC * 2;
  p.h2 = (float*)(ws + off); off += (size_t)ROWS * D * 4;
  p.wt_in = (bf16_t*)(ws + off); off += (size_t)INC * D * 2;
  p.wt_out = (bf16_t*)(ws + off); off += (size_t)D * D * 2;
  p.wt_q = (bf16_t*)(ws + off); off += (size_t)2048 * D * 2;
  p.skb = (bf16_t*)(ws + off); off += (size_t)16 * 128 * 128 * 2;
  p.ut8 = (unsigned char*)(ws + off); off += (size_t)16384 * D;
  p.vt8 = (unsigned char*)(ws + off); off += (size_t)16384 * D;
  p.uinv = (float*)(ws + off); off += 65536;
  p.vinv = (float*)(ws + off); off += 65536;
  p.eb = (int*)((char*)p.r2 + (size_t)ROWS * 2048 * 2);
  p.gb = (float*)((char*)p.eb + (size_t)ROWS * 128 * 4);
  void* args[] = {&p};
  hipError_t e = hipLaunchCooperativeKernel((void*)mega, dim3(grid_blocks), dim3(512), args, 0, stream);
  if (e != hipSuccess) fprintf(stderr, "cooperative launch failed: %s (grid %d)\n", hipGetErrorString(e), grid_blocks);
}
```

```cpp
#include <hip/hip_runtime.h>
#include <hip/hip_cooperative_groups.h>
#include <cstdio>
namespace cg = cooperative_groups;
#include <stdint.h>
#include <math.h>

typedef unsigned short bf16_t;
typedef short bf16x8 __attribute__((ext_vector_type(8)));
typedef float f32x4 __attribute__((ext_vector_type(4)));

constexpr int D = 1024, BATCH = 8, SEQ = 4096, NMETA = 16, LREAL = NMETA + SEQ  , LP = 4224, ROWS = BATCH * LP;
constexpr int INC = 2560;
constexpr float EPS = 1e-6f;
constexpr float LAM_INIT = 0.2f;

__device__ __forceinline__ float bf2f(unsigned v) { return __uint_as_float(v << 16); }
__device__ __forceinline__ bf16_t f2bf(float f) { unsigned u = __float_as_uint(f); u += 0x7fffu + ((u >> 16) & 1u); return (bf16_t)(u >> 16); }
__device__ __forceinline__ unsigned pack2(float a, float b) { return (unsigned)f2bf(a) | ((unsigned)f2bf(b) << 16); }

__device__ __forceinline__ float wave_sum(float v) {
#pragma unroll
  for (int o = 32; o >= 1; o >>= 1) v += __shfl_xor(v, o);
  return v;
}
__device__ __forceinline__ float wave_max(float v) {
#pragma unroll
  for (int o = 32; o >= 1; o >>= 1) v = fmaxf(v, __shfl_xor(v, o));
  return v;
}

__device__ __forceinline__ int opaque_tid() { int t = threadIdx.x; asm volatile("" : "+v"(t)); return t; }

__device__ __forceinline__ const float* hrow_ptr(const float* x, const float* meta, int row) {
  int b = row / LP, pos = row - b * LP;
  if (pos < NMETA) return meta + (size_t)pos * D;
  if (pos < LREAL) return x + ((size_t)b * SEQ + (pos - NMETA)) * D;
  return nullptr;
}

__device__ __forceinline__ void p_norm1(int blk, float* red, const float* x, const float* meta, const float* g1, bf16_t* xn1,
                                               const float* lq1, const float* lk1, const float* lq2, const float* lk2, float* scal) {
  const int tix = opaque_tid();
  int row = blk, tid = (tix & 255);
  __syncthreads();
  const float* src = hrow_ptr(x, meta, row);
  float4 v = src ? ((const float4*)src)[tid] : make_float4(0.f, 0.f, 0.f, 0.f);
  float ss = v.x * v.x + v.y * v.y + v.z * v.z + v.w * v.w;
  ss = wave_sum(ss);
  if ((tid & 63) == 0) red[tid >> 6] = ss;
  __syncthreads();
  float tot = red[0] + red[1] + red[2] + red[3];
  float rstd = rsqrtf(tot * (1.0f / D) + EPS);
  float4 g = ((const float4*)g1)[tid];
  uint2 o; o.x = pack2(v.x * rstd * g.x, v.y * rstd * g.y); o.y = pack2(v.z * rstd * g.z, v.w * rstd * g.w);
  ((uint2*)(xn1 + (size_t)row * D))[tid] = o;
  if (row == 0 && tid < 64) {
    float a = lq1[tid] * lk1[tid], b2 = lq2[tid] * lk2[tid];
    a = wave_sum(a); b2 = wave_sum(b2);
    if (tid == 0) scal[0] = expf(a) - expf(b2) + LAM_INIT;
  }
}


typedef float f32x16 __attribute__((ext_vector_type(16)));
typedef short v4i16_t __attribute__((ext_vector_type(4)));
typedef __bf16 bf16v2_t __attribute__((ext_vector_type(2)));
typedef float f32x2_t __attribute__((ext_vector_type(2)));
#define LDSP(T, p) ((__attribute__((address_space(3))) T*)(p))
#define MFMA32(a, b, c) __builtin_amdgcn_mfma_f32_32x32x16_bf16((a), (b), (c), 0, 0, 0)
__device__ __forceinline__ unsigned cvtpk(float lo, float hi) { f32x2_t v = {lo, hi}; return __builtin_bit_cast(unsigned, __builtin_convertvector(v, bf16v2_t)); }
__device__ __forceinline__ float half_swap_max(float m) { auto rr = __builtin_amdgcn_permlane32_swap(__float_as_uint(m), __float_as_uint(m), false, false); return fmaxf(__uint_as_float(rr[0]), __uint_as_float(rr[1])); }
__device__ __forceinline__ float half_swap_sum(float m) { auto rr = __builtin_amdgcn_permlane32_swap(__float_as_uint(m), __float_as_uint(m), false, false); return __uint_as_float(rr[0]) + __uint_as_float(rr[1]); }

__device__ __forceinline__ void attn_issue_kv(char* kvbuf, const bf16_t* __restrict__ kvrow0  , int tid, int wid) {
  const char* base = (const char*)kvrow0;
#pragma unroll
  for (int i = 0; i < 2; ++i) {
    const int g = i * 512 + tid, row = g >> 4, pos = g & 15;
    const unsigned offk = (unsigned)(row * (INC * 2) + 1024 + ((pos ^ (row & 15)) << 4));
    const unsigned offv = (unsigned)(row * (INC * 2) + 2048 + ((pos ^ ((row & 3) << 2)) << 4));
    __builtin_amdgcn_global_load_lds((const unsigned*)(base + offk), LDSP(unsigned, kvbuf + (i * 512 + wid * 64) * 16), 16, 0, 0);
    __builtin_amdgcn_global_load_lds((const unsigned*)(base + offv), LDSP(unsigned, kvbuf + 16384 + (i * 512 + wid * 64) * 16), 16, 0, 0);
  }
}

template <bool MASKED>
__device__ __forceinline__ void attn_map(f32x16 (&o)[4], float& mref_io, float& l_io, const char* qbase, int qsw, const char* kb, const char* vb, int c, int kq, float sl8, int lane, int r32, int hi) {
  const float c1 = 0.125f * 1.4426950408889634f;
  asm volatile("" : "+v"(qsw), "+v"(lane));
  f32x16 s0, s1;
  {
    const float a1 = sl8, a2 = 2.0f * sl8, a3 = 3.0f * sl8, b8 = 8.0f * sl8;
    float gb = sl8 * (float)kq;
#pragma unroll
    for (int g = 0; g < 4; ++g) { s0[4 * g] = gb; s0[4 * g + 1] = gb + a1; s0[4 * g + 2] = gb + a2; s0[4 * g + 3] = gb + a3; gb += b8; }
#pragma unroll
    for (int g = 0; g < 4; ++g) { s1[4 * g] = gb; s1[4 * g + 1] = gb + a1; s1[4 * g + 2] = gb + a2; s1[4 * g + 3] = gb + a3; gb += b8; }
    if (MASKED) {
#pragma unroll
      for (int r = 0; r < 16; ++r) { s0[r] = s0[r] > 0.f ? -1e30f : s0[r]; s1[r] = s1[r] > 0.f ? -1e30f : s1[r]; }
    }
  }
#pragma unroll
  for (int ks = 0; ks < 4; ++ks) {
    const int ch = c * 8 + ks * 2 + hi;
    bf16x8 bq = *(const bf16x8*)(qbase + ((ch ^ qsw) << 4));
    bf16x8 ka0 = *(const bf16x8*)(kb + r32 * 256 + ((ch ^ qsw) << 4));
    bf16x8 ka1 = *(const bf16x8*)(kb + (32 + r32) * 256 + ((ch ^ qsw) << 4));
    s0 = MFMA32(ka0, bq, s0);
    s1 = MFMA32(ka1, bq, s1);
    __builtin_amdgcn_sched_barrier(0);
  }
  float mx = fmaxf(s0[0], s1[0]);
#pragma unroll
  for (int r = 1; r < 16; ++r) mx = fmaxf(mx, fmaxf(s0[r], s1[r]));
  mx = half_swap_max(mx);
  float mref = mref_io;
  if (__any((mx - mref) * c1 > 6.0f)) {
    const float mn = fmaxf(mref, mx);
    const float alpha = exp2f((mref - mn) * c1);
    l_io *= alpha;
#pragma unroll
    for (int i = 0; i < 4; ++i)
#pragma unroll
      for (int r = 0; r < 16; ++r) o[i][r] *= alpha;
    mref = mn; mref_io = mn;
  }
  const float nm = -mref * c1;
  float ls = 0.f;
#pragma unroll
  for (int r = 0; r < 16; ++r) { s0[r] = __builtin_amdgcn_exp2f(fmaf(s0[r], c1, nm)); s1[r] = __builtin_amdgcn_exp2f(fmaf(s1[r], c1, nm)); ls += s0[r] + s1[r]; }
  l_io += ls;
  const int q4 = (lane & 15) >> 2, g1 = (lane >> 4) & 1, p4 = lane & 3;
#pragma unroll
  for (int kk = 0; kk < 4; ++kk) {
    const int key0 = 16 * kk + 4 * hi + q4;
    uint4 pwv;
    if (kk < 2) { pwv.x = cvtpk(s0[8 * kk], s0[8 * kk + 1]); pwv.y = cvtpk(s0[8 * kk + 2], s0[8 * kk + 3]); pwv.z = cvtpk(s0[8 * kk + 4], s0[8 * kk + 5]); pwv.w = cvtpk(s0[8 * kk + 6], s0[8 * kk + 7]); }
    else { const int k2 = kk - 2; pwv.x = cvtpk(s1[8 * k2], s1[8 * k2 + 1]); pwv.y = cvtpk(s1[8 * k2 + 2], s1[8 * k2 + 3]); pwv.z = cvtpk(s1[8 * k2 + 4], s1[8 * k2 + 5]); pwv.w = cvtpk(s1[8 * k2 + 6], s1[8 * k2 + 7]); }
    const bf16x8 pb = __builtin_bit_cast(bf16x8, pwv);
#pragma unroll
    for (int dvt = 0; dvt < 4; ++dvt) {
      const int c8 = 8 * (dvt ^ q4) + 4 * g1 + p4;
      v4i16_t lo = __builtin_amdgcn_ds_read_tr16_b64_v4i16(LDSP(v4i16_t, vb + key0 * 256 + c8 * 8));
      v4i16_t hi4 = __builtin_amdgcn_ds_read_tr16_b64_v4i16(LDSP(v4i16_t, vb + (key0 + 8) * 256 + c8 * 8));
      bf16x8 va = (bf16x8){lo[0], lo[1], lo[2], lo[3], hi4[0], hi4[1], hi4[2], hi4[3]};
      o[dvt] = MFMA32(va, pb, o[dvt]);
    }
    __builtin_amdgcn_sched_barrier(0);
  }
}

__device__ __forceinline__ void attn_unit(char* lds, const bf16_t* __restrict__ proj, bf16_t* mix, const float* __restrict__ subg, float lam, int b, int h, int t) {
  const int tix = opaque_tid();
  const int tid = tix, lane = tid & 63, r32 = lane & 31, hi = lane >> 5;
  const int wid = __builtin_amdgcn_readfirstlane(tid >> 6);
  const int c = wid >> 2, qg = wid & 3;
  const int q0 = NMETA + 128 * t, qw0 = q0 + 32 * qg, qpos = qw0 + r32;
  const size_t rowb = (size_t)b * LP;
  const int NT = 2 * t + 3;
  char* Qs = lds;
  char* KV = lds + 32768;
  const float sl8 = exp2f(1.0f - 2.0f * (float)h);
  __syncthreads();
  attn_issue_kv(KV, proj + rowb * INC + h * 128, tid, wid);
#pragma unroll
  for (int i = 0; i < 4; ++i) {
    const int g = i * 512 + tid, row = g >> 4, pos = g & 15;
    uint4 v = *(const uint4*)(proj + (rowb + q0 + row) * INC + h * 128 + ((pos ^ (row & 15)) << 3));
    *(uint4*)(Qs + g * 16) = v;
  }
  f32x16 o[4];
#pragma unroll
  for (int i = 0; i < 4; ++i)
#pragma unroll
    for (int r = 0; r < 16; ++r) o[i][r] = 0.f;
  float m = -1e30f, l = 0.f;
  const int qrow = 32 * qg + r32;
  const char* qbase = Qs + qrow * 256;
  const int qsw = qrow & 15;
  for (int j = 0; j < NT; ++j) {
    __syncthreads();
    if (j + 1 < NT) attn_issue_kv(KV + ((j + 1) & 1) * 32768, proj + (rowb + 64 * (j + 1)) * INC + h * 128, tid, wid);
    if (64 * j > qw0 + 31) continue;
    const char* kb = KV + (j & 1) * 32768;
    const char* vb = kb + 16384;
    const int kq = 64 * j + 4 * hi - qpos;
    if (64 * j + 63 > qw0) attn_map<true>(o, m, l, qbase, qsw, kb, vb, c, kq, sl8, lane, r32, hi);
    else attn_map<false>(o, m, l, qbase, qsw, kb, vb, c, kq, sl8, lane, r32, hi);
  }
  l = half_swap_sum(l);
  const float sc = (c == 0 ? 1.0f : lam) / l;
  __syncthreads();
  float* X = (float*)(lds + 32768);
  if (c == 1) {
#pragma unroll
    for (int i = 0; i < 4; ++i)
#pragma unroll
      for (int r = 0; r < 16; ++r) X[(qg * 64 + i * 16 + r) * 64 + lane] = o[i][r] * sc;
  }
  __syncthreads();
  if (c == 0) {
    float ss = 0.f;
#pragma unroll
    for (int i = 0; i < 4; ++i) {
#pragma unroll
      for (int r = 0; r < 16; ++r) { float v = o[i][r] * sc - X[(qg * 64 + i * 16 + r) * 64 + lane]; o[i][r] = v; ss += v * v; }
      __builtin_amdgcn_sched_barrier(0);
    }
    ss = half_swap_sum(ss);
    const float rstd = rsqrtf(ss * (1.0f / 128.0f) + EPS) * (1.0f - LAM_INIT);
    bf16_t* orow = mix + (rowb + qpos) * D + h * 128;
#pragma unroll
    for (int i = 0; i < 4; ++i) {
#pragma unroll
      for (int g = 0; g < 4; ++g) {
        const int dv0 = 32 * i + 8 * g + 4 * hi;
        const float4 sg = *(const float4*)(subg + dv0);
        uint2 w; w.x = cvtpk(o[i][4 * g] * rstd * sg.x, o[i][4 * g + 1] * rstd * sg.y); w.y = cvtpk(o[i][4 * g + 2] * rstd * sg.z, o[i][4 * g + 3] * rstd * sg.w);
        *(uint2*)(orow + dv0) = w;
      }
      __builtin_amdgcn_sched_barrier(0);
    }
  }
}


__device__ __forceinline__ void conv_unit(char* lds, const bf16_t* __restrict__ proj, bf16_t* mix, const float* __restrict__ cw, const float* __restrict__ cb,
                                          const float* __restrict__ gng, const float* __restrict__ gnb, int b, int pos0) {
  const int tix = opaque_tid();
  const int c = tix;
  float* U = (float*)lds;
  __syncthreads();
  {
    const int lane = tix & 63, wv = tix >> 6;
    uint4 ra[8], rg[8];
#pragma unroll
    for (int i = 0; i < 8; ++i) {
      const int r = wv + 8 * i, pos = pos0 - 30 + r;
      ra[i] = make_uint4(0, 0, 0, 0); rg[i] = make_uint4(0, 0, 0, 0);
      if (r < 62 && pos >= 0) {
        const bf16_t* pr = proj + ((size_t)b * LP + pos) * INC + 8 * lane;
        ra[i] = *(const uint4*)(pr + 1536); rg[i] = *(const uint4*)(pr + 2048);
      }
    }
#pragma unroll
    for (int i = 0; i < 8; ++i) {
      const int r = wv + 8 * i;
      if (r < 62) {
        const unsigned av[4] = {ra[i].x, ra[i].y, ra[i].z, ra[i].w}, gv[4] = {rg[i].x, rg[i].y, rg[i].z, rg[i].w};
        float u[8];
#pragma unroll
        for (int q = 0; q < 4; ++q) {
          const float a0 = __uint_as_float(av[q] << 16), a1 = __uint_as_float(av[q] & 0xffff0000u), g0 = __uint_as_float(gv[q] << 16), g1 = __uint_as_float(gv[q] & 0xffff0000u);
          u[2 * q] = a0 / (1.0f + __expf(-g0)); u[2 * q + 1] = a1 / (1.0f + __expf(-g1));
        }
        *(float4*)(U + r * 512 + 8 * lane) = make_float4(u[0], u[1], u[2], u[3]);
        *(float4*)(U + r * 512 + 8 * lane + 4) = make_float4(u[4], u[5], u[6], u[7]);
      }
    }
  }
  float w[31];
#pragma unroll
  for (int j = 0; j < 31; ++j) w[j] = cw[j * 512 + c];
  const float bias = cb[c], gg = gng[c], gb2 = gnb[c];
  __syncthreads();
  for (int t = 0; t < 32; ++t) {
    float y = bias;
#pragma unroll
    for (int j = 0; j < 31; ++j) y = fmaf(w[j], U[(t + j) * 512 + c], y);
    const float mu = wave_sum(y) * (1.0f / 64.0f);
    const float d = y - mu;
    const float var = wave_sum(d * d) * (1.0f / 64.0f);
    const float n = d * rsqrtf(var + EPS) * gg + gb2;
    mix[((size_t)b * LP + pos0 + t) * D + 512 + c] = f2bf(n / (1.0f + __expf(-n)));
  }
}

__device__ __forceinline__ void p_conv_naive(int blk, const bf16_t* __restrict__ proj, bf16_t* mix, const float* cw, const float* cb, const float* gg_, const float* gb_) {
  const int tix = opaque_tid();
  int row = blk, tid = (tix & 255);
  int b = row / LP, pos = row - b * LP;
  int c0 = tid * 2;
  unsigned* outp = (unsigned*)(mix + (size_t)row * D + 512 + c0);
  if (pos >= LREAL) { *outp = 0u; return; }
  float y0 = cb[c0], y1 = cb[c0 + 1];
  for (int j = 0; j < 31; ++j) {
    int p = pos - 30 + j;
    if (p < 0) continue;
    const bf16_t* pr = proj + ((size_t)b * LP + p) * INC;
    unsigned a = *(const unsigned*)(pr + 1536 + c0), g = *(const unsigned*)(pr + 2048 + c0);
    float a0 = bf2f(a & 0xffffu), a1 = bf2f(a >> 16), g0 = bf2f(g & 0xffffu), g1 = bf2f(g >> 16);
    float u0 = a0 / (1.0f + __expf(-g0)), u1 = a1 / (1.0f + __expf(-g1));
    y0 += cw[j * 512 + c0] * u0; y1 += cw[j * 512 + c0 + 1] * u1;
  }
  float s = y0 + y1;
#pragma unroll
  for (int o = 16; o >= 1; o >>= 1) s += __shfl_xor(s, o);
  float mu = s * (1.0f / 64.0f);
  float d0 = y0 - mu, d1 = y1 - mu;
  float v = d0 * d0 + d1 * d1;
#pragma unroll
  for (int o = 16; o >= 1; o >>= 1) v += __shfl_xor(v, o);
  float rstd = rsqrtf(v * (1.0f / 64.0f) + EPS);
  float n0 = d0 * rstd * gg_[c0] + gb_[c0], n1 = d1 * rstd * gg_[c0 + 1] + gb_[c0 + 1];
  float r0 = n0 / (1.0f + __expf(-n0)), r1 = n1 / (1.0f + __expf(-n1));
  *outp = pack2(r0, r1);
}

__device__ __forceinline__ void p_norm2(int blk, float* red, const float* h2, const float* g2, bf16_t* xn2) {
  const int tix = opaque_tid();
  int row = blk, tid = (tix & 255);
  __syncthreads();
  float4 v = ((const float4*)(h2 + (size_t)row * D))[tid];
  float ss = v.x * v.x + v.y * v.y + v.z * v.z + v.w * v.w;
  ss = wave_sum(ss);
  if ((tid & 63) == 0) red[tid >> 6] = ss;
  __syncthreads();
  float tot = red[0] + red[1] + red[2] + red[3];
  float rstd = rsqrtf(tot * (1.0f / D) + EPS);
  float4 g = ((const float4*)g2)[tid];
  uint2 o; o.x = pack2(v.x * rstd * g.x, v.y * rstd * g.y); o.y = pack2(v.z * rstd * g.z, v.w * rstd * g.w);
  ((uint2*)(xn2 + (size_t)row * D))[tid] = o;
}

__device__ __forceinline__ void p_topk_naive(int blk, const bf16_t* __restrict__ qp, const float* __restrict__ sk, int* eb, float* gb) {
  const int tix = opaque_tid();
  int w = blk * 4 + ((tix & 255) >> 6), lane = (tix & 255) & 63;
  int row = w >> 3, h = w & 7;
  int pos = row % LP;
  if (pos < NMETA || pos >= LREAL) return;
  const float NEG = -3.0e38f;
  float top[2];
#pragma unroll
  for (int p = 0; p < 2; ++p) {
    const bf16_t* qv = qp + (size_t)row * 2048 + h * 256 + p * 128;
    const float* k0 = sk + ((size_t)(h * 2 + p) * 128 + lane) * 128;
    const float* k1 = k0 + 64 * 128;
    float s0 = 0.f, s1 = 0.f;
    for (int d = 0; d < 128; d += 8) {
      uint4 r = *(const uint4*)(qv + d);
      float qf[8] = {bf2f(r.x & 0xffffu), bf2f(r.x >> 16), bf2f(r.y & 0xffffu), bf2f(r.y >> 16), bf2f(r.z & 0xffffu), bf2f(r.z >> 16), bf2f(r.w & 0xffffu), bf2f(r.w >> 16)};
      float4 a0 = *(const float4*)(k0 + d), a1 = *(const float4*)(k0 + d + 4), b0 = *(const float4*)(k1 + d), b1 = *(const float4*)(k1 + d + 4);
      s0 += qf[0] * a0.x + qf[1] * a0.y + qf[2] * a0.z + qf[3] * a0.w + qf[4] * a1.x + qf[5] * a1.y + qf[6] * a1.z + qf[7] * a1.w;
      s1 += qf[0] * b0.x + qf[1] * b0.y + qf[2] * b0.z + qf[3] * b0.w + qf[4] * b1.x + qf[5] * b1.y + qf[6] * b1.z + qf[7] * b1.w;
    }
    float v0 = __uint_as_float((__float_as_uint(s0) & ~127u) | (unsigned)lane);
    float v1 = __uint_as_float((__float_as_uint(s1) & ~127u) | (unsigned)(lane + 64));
    float t = NEG;
    for (int it = 0; it < 16; ++it) {
      float m = wave_max(fmaxf(v0, v1));
      if (lane == it) t = m;
      if (v0 == m) v0 = NEG;
      if (v1 == m) v1 = NEG;
    }
    top[p] = t;
  }
  int ci = lane >> 2, jb = (lane & 3) * 4;
  float av = __uint_as_float(__float_as_uint(__shfl(top[0], ci)) & ~127u);
  float c[4];
#pragma unroll
  for (int jj = 0; jj < 4; ++jj) {
    float bv = __uint_as_float(__float_as_uint(__shfl(top[1], jb + jj)) & ~127u);
    float s = av + bv;
    c[jj] = __uint_as_float((__float_as_uint(s) & ~255u) | (unsigned)(ci * 16 + jb + jj));
  }
  float ct = NEG;
  for (int it = 0; it < 16; ++it) {
    float m = wave_max(fmaxf(fmaxf(c[0], c[1]), fmaxf(c[2], c[3])));
    if (lane == it) ct = m;
#pragma unroll
    for (int jj = 0; jj < 4; ++jj) if (c[jj] == m) c[jj] = NEG;
  }
  unsigned cbits = __float_as_uint(ct);
  int cidx = cbits & 255u;
  float cval = __uint_as_float(cbits & ~255u);
  int i1 = __float_as_uint(__shfl(top[0], (cidx >> 4) & 15)) & 127u;
  int i2 = __float_as_uint(__shfl(top[1], cidx & 15)) & 127u;
  float mx = __shfl(cval, 0);
  float ex = lane < 16 ? __expf(cval - mx) : 0.f;
  float sum = wave_sum(ex);
  if (lane < 16) {
    eb[((size_t)row * 8 + h) * 16 + lane] = i1 * 128 + i2;
    gb[((size_t)row * 8 + h) * 16 + lane] = ex / sum;
  }
}


__device__ __forceinline__ void ce_desc(float& a, float& b) { const float hi = fmaxf(a, b), lo = fminf(a, b); a = hi; b = lo; }
__device__ __forceinline__ void ce_asc(float& a, float& b) { const float hi = fmaxf(a, b), lo = fminf(a, b); a = lo; b = hi; }
template <int N> __device__ __forceinline__ void bitonic_sort_desc(float (&v)[N]) {
#pragma unroll
  for (int k = 2; k <= N; k <<= 1)
#pragma unroll
    for (int j = k >> 1; j > 0; j >>= 1)
#pragma unroll
      for (int i = 0; i < N; ++i) { const int l = i ^ j; if (l > i) { if ((i & k) == 0) ce_desc(v[i], v[l]); else ce_asc(v[i], v[l]); } }
}
template <int N> __device__ __forceinline__ void bitonic_merge_desc(float (&v)[N]) {
#pragma unroll
  for (int j = N >> 1; j > 0; j >>= 1)
#pragma unroll
    for (int i = 0; i < N; ++i) { const int l = i ^ j; if (l > i) ce_desc(v[i], v[l]); }
}
__device__ __forceinline__ void cep_desc(float& a, float& b, int& pa, int& pb) { const bool sw = b > a; const float hi = sw ? b : a, lo = sw ? a : b; const int ph = sw ? pb : pa, pl = sw ? pa : pb; a = hi; b = lo; pa = ph; pb = pl; }
__device__ __forceinline__ void cep_asc(float& a, float& b, int& pa, int& pb) { const bool sw = b < a; const float lo = sw ? b : a, hi = sw ? a : b; const int pl = sw ? pb : pa, ph = sw ? pa : pb; a = lo; b = hi; pa = pl; pb = ph; }
template <int N> __device__ __forceinline__ void bitonic_sortp_desc(float (&v)[N], int (&q)[N]) {
#pragma unroll
  for (int k = 2; k <= N; k <<= 1)
#pragma unroll
    for (int j = k >> 1; j > 0; j >>= 1)
#pragma unroll
      for (int i = 0; i < N; ++i) { const int l = i ^ j; if (l > i) { if ((i & k) == 0) cep_desc(v[i], v[l], q[i], q[l]); else cep_asc(v[i], v[l], q[i], q[l]); } }
}
template <int N> __device__ __forceinline__ void bitonic_mergep_desc(float (&v)[N], int (&q)[N]) {
#pragma unroll
  for (int j = N >> 1; j > 0; j >>= 1)
#pragma unroll
    for (int i = 0; i < N; ++i) { const int l = i ^ j; if (l > i) cep_desc(v[i], v[l], q[i], q[l]); }
}
__host__ __device__ constexpr int cand_slot(int i, int j) { int s = 0; for (int ii = 0; ii < i; ++ii) s += 16 / (ii + 1); return s + j; }

__device__ __forceinline__ void peer_topk_unit(char* lds, const bf16_t* __restrict__ qp, const bf16_t* __restrict__ skb, int* eb, float* gb, int row0, int h) {
  const int tix = opaque_tid();
  const int tid = tix, lane = tid & 63, wid = tid >> 6, fr = lane & 15, fq = lane >> 4;
  __syncthreads();
#pragma unroll
  for (int i = 0; i < 8; ++i) {
    const int g = i * 512 + tid, row = g >> 4, pos = g & 15;
    *(uint4*)(lds + g * 16) = *(const uint4*)(skb + ((size_t)(h * 2) * 128 + row) * 128 + ((pos ^ (row & 15)) << 3));
  }
  if (tid < 64) {
    int i = 0, base = 0;
    while (i < 15 && tid >= base + 16 / (i + 1)) { base += 16 / (i + 1); ++i; }
    ((int*)(lds + 65536))[tid] = (i << 4) | ((tid - base) & 15);
  }
  __syncthreads();
  const int tok = row0 + wid * 16 + fr;
  float top[2][16];
#pragma unroll
  for (int p = 0; p < 2; ++p) {
    f32x4 acc[8];
#pragma unroll
    for (int i = 0; i < 8; ++i) acc[i] = (f32x4){0.f, 0.f, 0.f, 0.f};
    const bf16_t* xrow = qp + (size_t)tok * 2048 + h * 256 + p * 128 + fq * 8;
#pragma unroll
    for (int ks = 0; ks < 4; ++ks) {
      const bf16x8 xb = *(const bf16x8*)(xrow + ks * 32);
      const int ch = ks * 4 + fq;
#pragma unroll
      for (int nt = 0; nt < 8; ++nt) {
        const int r = p * 128 + nt * 16 + fr;
        const bf16x8 wa = *(const bf16x8*)(lds + r * 256 + ((ch ^ (r & 15)) << 4));
        acc[nt] = __builtin_amdgcn_mfma_f32_16x16x32_bf16(wa, xb, acc[nt], 0, 0, 0);
      }
    }
    float v[32];
#pragma unroll
    for (int nt = 0; nt < 8; ++nt)
#pragma unroll
      for (int r = 0; r < 4; ++r) v[nt * 4 + r] = __uint_as_float((__float_as_uint(acc[nt][r]) & ~127u) | (unsigned)(nt * 16 + fq * 4 + r));
    bitonic_sort_desc<32>(v);
    float t[16];
#pragma unroll
    for (int i = 0; i < 16; ++i) t[i] = v[i];
#pragma unroll
    for (int rnd = 0; rnd < 2; ++rnd) {
      float pb[16];
#pragma unroll
      for (int i = 0; i < 16; ++i) pb[i] = __shfl_xor(t[15 - i], rnd == 0 ? 16 : 32);
#pragma unroll
      for (int i = 0; i < 16; ++i) t[i] = fmaxf(t[i], pb[i]);
      bitonic_merge_desc<16>(t);
    }
#pragma unroll
    for (int i = 0; i < 16; ++i) top[p][i] = t[i];
  }
  int* ST = (int*)(lds + 65536);
  int* IDX = (int*)(lds + 65536 + 256) + (wid * 16 + fr) * 32;
#define SEL4(arr, q) (fq == 0 ? arr[q] : fq == 1 ? arr[4 + (q)] : fq == 2 ? arr[8 + (q)] : arr[12 + (q)])
  {
    int4 ia, ib;
    ia.x = __float_as_uint(SEL4(top[0], 0)) & 127; ia.y = __float_as_uint(SEL4(top[0], 1)) & 127; ia.z = __float_as_uint(SEL4(top[0], 2)) & 127; ia.w = __float_as_uint(SEL4(top[0], 3)) & 127;
    ib.x = __float_as_uint(SEL4(top[1], 0)) & 127; ib.y = __float_as_uint(SEL4(top[1], 1)) & 127; ib.z = __float_as_uint(SEL4(top[1], 2)) & 127; ib.w = __float_as_uint(SEL4(top[1], 3)) & 127;
    *(int4*)(IDX + 4 * fq) = ia; *(int4*)(IDX + 16 + 4 * fq) = ib;
  }
  float cv[64];
#pragma unroll
  for (int i = 50; i < 64; ++i) cv[i] = -3.0e38f;
#pragma unroll
  for (int i = 0; i < 16; ++i)
#pragma unroll
    for (int j = 0; j < 16; ++j)
      if ((i + 1) * (j + 1) <= 16) {
        const float sv = __uint_as_float(__float_as_uint(top[0][i]) & ~127u) + __uint_as_float(__float_as_uint(top[1][j]) & ~127u);
        cv[cand_slot(i, j)] = __uint_as_float((__float_as_uint(sv) & ~63u) | (unsigned)cand_slot(i, j));
      }
  bitonic_sort_desc<64>(cv);
  float ex[16]; float sum = 0.f;
  const float c0v = __uint_as_float(__float_as_uint(cv[0]) & ~63u);
#pragma unroll
  for (int i = 0; i < 16; ++i) { ex[i] = __expf(__uint_as_float(__float_as_uint(cv[i]) & ~63u) - c0v); sum += ex[i]; }
  const float inv = 1.0f / sum;
  int e4[4]; float g4[4];
#pragma unroll
  for (int q = 0; q < 4; ++q) {
    const int slot = __float_as_uint(SEL4(cv, q)) & 63;
    const int ij = ST[slot];
    e4[q] = IDX[ij >> 4] * 128 + IDX[16 + (ij & 15)];
    g4[q] = SEL4(ex, q) * inv;
  }
#undef SEL4
  *(int4*)(eb + ((size_t)tok * 8 + h) * 16 + 4 * fq) = make_int4(e4[0], e4[1], e4[2], e4[3]);
  *(float4*)(gb + ((size_t)tok * 8 + h) * 16 + 4 * fq) = make_float4(g4[0], g4[1], g4[2], g4[3]);
}

__device__ __forceinline__ void p_cvt_bf16(int blk, int nblk, const float* __restrict__ src, bf16_t* dst, size_t n8) {
  const int tix = opaque_tid();
  for (size_t i = (size_t)blk * 512 + tix; i < n8; i += (size_t)nblk * 512) {
    const float4 a = ((const float4*)src)[2 * i], b = ((const float4*)src)[2 * i + 1];
    uint4 w; w.x = cvtpk(a.x, a.y); w.y = cvtpk(a.z, a.w); w.z = cvtpk(b.x, b.y); w.w = cvtpk(b.z, b.w);
    ((uint4*)dst)[i] = w;
  }
}


typedef float f32x2v __attribute__((ext_vector_type(2)));
__device__ __forceinline__ void p_cvt_fp8_rows(int blk, int nblk, const float* __restrict__ src, unsigned* dst, float* inv) {
  const int tix = opaque_tid();
  const int lane = tix & 63, wid = tix >> 6;
  for (int r = blk * 8 + wid; r < 16384; r += nblk * 8) {
    const float4* sp = (const float4*)(src + (size_t)r * D);
    float4 v[4];
#pragma unroll
    for (int k = 0; k < 4; ++k) v[k] = sp[k * 64 + lane];
    float am = 0.f;
#pragma unroll
    for (int k = 0; k < 4; ++k) am = fmaxf(am, fmaxf(fmaxf(fabsf(v[k].x), fabsf(v[k].y)), fmaxf(fabsf(v[k].z), fabsf(v[k].w))));
    am = wave_max(am);
    const float sc = am > 0.f ? 384.0f / am : 1.0f;
#pragma unroll
    for (int k = 0; k < 4; ++k) {
      int w = __builtin_amdgcn_cvt_pk_fp8_f32(v[k].x * sc, v[k].y * sc, 0, false);
      w = __builtin_amdgcn_cvt_pk_fp8_f32(v[k].z * sc, v[k].w * sc, w, true);
      dst[(size_t)r * 256 + k * 64 + lane] = (unsigned)w;
    }
    if (lane == 0) inv[r] = am > 0.f ? am * (1.0f / 384.0f) : 1.0f;
  }
}
__device__ __forceinline__ float row16_sum(float v) {
  v += __builtin_bit_cast(float, __builtin_amdgcn_update_dpp(0, __builtin_bit_cast(int, v), 0x128, 0xf, 0xf, true));
  v += __builtin_bit_cast(float, __builtin_amdgcn_update_dpp(0, __builtin_bit_cast(int, v), 0x124, 0xf, 0xf, true));
  v += __builtin_bit_cast(float, __builtin_amdgcn_update_dpp(0, __builtin_bit_cast(int, v), 0x122, 0xf, 0xf, true));
  v += __builtin_bit_cast(float, __builtin_amdgcn_update_dpp(0, __builtin_bit_cast(int, v), 0x121, 0xf, 0xf, true));
  return v;
}
__device__ __forceinline__ void peer_gather_token(char* wlds  , int lane, size_t row, size_t orow, const bf16_t* __restrict__ xn2, const float* __restrict__ h2,
                                                  const int* __restrict__ eb, const float* __restrict__ gb, const unsigned char* __restrict__ ut8, const float* __restrict__ uinv,
                                                  const unsigned char* __restrict__ vt8, const float* __restrict__ vinv, const float* __restrict__ fg, float* __restrict__ out) {
  int* E = (int*)wlds; float* Gt = (float*)(wlds + 512); float* W = (float*)(wlds + 1024);
  const int i16 = lane & 15, g = lane >> 4;
  {
    const int e0 = eb[row * 128 + lane], e1 = eb[row * 128 + 64 + lane];
    E[lane] = e0; E[lane + 64] = e1;
    Gt[lane] = gb[row * 128 + lane]; Gt[lane + 64] = gb[row * 128 + 64 + lane];
  }
  float xf[4][16];
#pragma unroll
  for (int k = 0; k < 4; ++k) {
    const uint4 a = *(const uint4*)(xn2 + row * D + 256 * k + 16 * i16), b = *(const uint4*)(xn2 + row * D + 256 * k + 16 * i16 + 8);
    xf[k][0] = __uint_as_float(a.x << 16); xf[k][1] = __uint_as_float(a.x & 0xffff0000u); xf[k][2] = __uint_as_float(a.y << 16); xf[k][3] = __uint_as_float(a.y & 0xffff0000u);
    xf[k][4] = __uint_as_float(a.z << 16); xf[k][5] = __uint_as_float(a.z & 0xffff0000u); xf[k][6] = __uint_as_float(a.w << 16); xf[k][7] = __uint_as_float(a.w & 0xffff0000u);
    xf[k][8] = __uint_as_float(b.x << 16); xf[k][9] = __uint_as_float(b.x & 0xffff0000u); xf[k][10] = __uint_as_float(b.y << 16); xf[k][11] = __uint_as_float(b.y & 0xffff0000u);
    xf[k][12] = __uint_as_float(b.z << 16); xf[k][13] = __uint_as_float(b.z & 0xffff0000u); xf[k][14] = __uint_as_float(b.w << 16); xf[k][15] = __uint_as_float(b.w & 0xffff0000u);
  }
#pragma unroll 2
  for (int m = 0; m < 32; ++m) {
    const int e = E[4 * m + g];
    const unsigned char* ur = ut8 + (size_t)e * D + 16 * i16;
    uint4 u[4];
#pragma unroll
    for (int k = 0; k < 4; ++k) u[k] = *(const uint4*)(ur + 256 * k);
    float d0 = 0.f, d1 = 0.f;
#pragma unroll
    for (int k = 0; k < 4; ++k) {
      const unsigned wv[4] = {u[k].x, u[k].y, u[k].z, u[k].w};
#pragma unroll
      for (int q = 0; q < 4; ++q) {
        const f32x2v lo = __builtin_amdgcn_cvt_pk_f32_fp8((int)wv[q], false), hi = __builtin_amdgcn_cvt_pk_f32_fp8((int)wv[q], true);
        d0 = fmaf(lo.x, xf[k][4 * q], d0); d1 = fmaf(lo.y, xf[k][4 * q + 1], d1);
        d0 = fmaf(hi.x, xf[k][4 * q + 2], d0); d1 = fmaf(hi.y, xf[k][4 * q + 3], d1);
      }
    }
    const float d = row16_sum(d0 + d1);
    if (i16 == 0) W[4 * m + g] = d;
  }
  {
    const int e0 = E[lane], e1 = E[lane + 64];
    const float ui0 = uinv[e0], ui1 = uinv[e1];
    const float a0 = W[lane] * ui0, a1 = W[lane + 64] * ui1;
    const float g0 = Gt[lane], g1 = Gt[lane + 64];
    W[lane] = g0 * 0.5f * a0 * (1.0f + erff(a0 * 0.70710678118654752f)) * vinv[e0];
    W[lane + 64] = g1 * 0.5f * a1 * (1.0f + erff(a1 * 0.70710678118654752f)) * vinv[e1];
  }
  float acc[4][16];
#pragma unroll
  for (int k = 0; k < 4; ++k)
#pragma unroll
    for (int i = 0; i < 16; ++i) acc[k][i] = 0.f;
#pragma unroll 2
  for (int m = 0; m < 32; ++m) {
    const int e = E[4 * m + g];
    const float w = W[4 * m + g];
    const unsigned char* vr = vt8 + (size_t)e * D + 16 * i16;
    uint4 v[4];
#pragma unroll
    for (int k = 0; k < 4; ++k) v[k] = *(const uint4*)(vr + 256 * k);
#pragma unroll
    for (int k = 0; k < 4; ++k) {
      const unsigned wv[4] = {v[k].x, v[k].y, v[k].z, v[k].w};
#pragma unroll
      for (int q = 0; q < 4; ++q) {
        const f32x2v lo = __builtin_amdgcn_cvt_pk_f32_fp8((int)wv[q], false), hi = __builtin_amdgcn_cvt_pk_f32_fp8((int)wv[q], true);
        acc[k][4 * q] = fmaf(w, lo.x, acc[k][4 * q]); acc[k][4 * q + 1] = fmaf(w, lo.y, acc[k][4 * q + 1]);
        acc[k][4 * q + 2] = fmaf(w, hi.x, acc[k][4 * q + 2]); acc[k][4 * q + 3] = fmaf(w, hi.y, acc[k][4 * q + 3]);
      }
    }
  }
  float res[16];
#pragma unroll
  for (int k = 0; k < 4; ++k)
#pragma unroll
    for (int j = 0; j < 16; ++j) {
      float t = acc[k][j];
      t += __shfl_xor(t, 16); t += __shfl_xor(t, 32);
      if (k == g) res[j] = t;
    }
  const int c0 = 256 * g + 16 * i16;
  float ss = 0.f;
#pragma unroll
  for (int q = 0; q < 4; ++q) {
    const float4 hv = *(const float4*)(h2 + row * D + c0 + 4 * q);
    res[4 * q] += hv.x; res[4 * q + 1] += hv.y; res[4 * q + 2] += hv.z; res[4 * q + 3] += hv.w;
  }
#pragma unroll
  for (int i = 0; i < 16; ++i) ss += res[i] * res[i];
  ss = wave_sum(ss);
  const float rstd = rsqrtf(ss * (1.0f / D) + EPS);
#pragma unroll
  for (int q = 0; q < 4; ++q) {
    const float4 f = *(const float4*)(fg + c0 + 4 * q);
    *(float4*)(out + orow * D + c0 + 4 * q) = make_float4(res[4 * q] * rstd * f.x, res[4 * q + 1] * rstd * f.y, res[4 * q + 2] * rstd * f.z, res[4 * q + 3] * rstd * f.w);
  }
}

__device__ __forceinline__ void p_gather_naive(int blk, const bf16_t* __restrict__ xn2, const float* __restrict__ h2, const int* __restrict__ eb, const float* __restrict__ gb,
                                                      const float* __restrict__ ut, const float* __restrict__ vt, const float* fg, float* out) {
  const int tix = opaque_tid();
  int tk = blk * 4 + ((tix & 255) >> 6), lane = (tix & 255) & 63;
  int b = tk / SEQ, s = tk - b * SEQ;
  size_t row = (size_t)b * LP + NMETA + s;
  float xv[16];
  {
    const uint4* xp = (const uint4*)(xn2 + row * D + lane * 16);
#pragma unroll
    for (int i = 0; i < 2; ++i) {
      uint4 r = xp[i];
      xv[i * 8 + 0] = bf2f(r.x & 0xffffu); xv[i * 8 + 1] = bf2f(r.x >> 16); xv[i * 8 + 2] = bf2f(r.y & 0xffffu); xv[i * 8 + 3] = bf2f(r.y >> 16);
      xv[i * 8 + 4] = bf2f(r.z & 0xffffu); xv[i * 8 + 5] = bf2f(r.z >> 16); xv[i * 8 + 6] = bf2f(r.w & 0xffffu); xv[i * 8 + 7] = bf2f(r.w >> 16);
    }
  }
  float acc[16];
#pragma unroll
  for (int i = 0; i < 16; ++i) acc[i] = 0.f;
  for (int k = 0; k < 128; ++k) {
    int e = eb[row * 128 + k];
    float gate = gb[row * 128 + k];
    const float4* up = (const float4*)(ut + (size_t)e * D + lane * 16);
    float dsum = 0.f;
#pragma unroll
    for (int i = 0; i < 4; ++i) { float4 u = up[i]; dsum += u.x * xv[i * 4] + u.y * xv[i * 4 + 1] + u.z * xv[i * 4 + 2] + u.w * xv[i * 4 + 3]; }
    dsum = wave_sum(dsum);
    float act = 0.5f * dsum * (1.0f + erff(dsum * 0.70710678118654752f));
    float wgt = gate * act;
    const float4* vp = (const float4*)(vt + (size_t)e * D + lane * 16);
#pragma unroll
    for (int i = 0; i < 4; ++i) { float4 v = vp[i]; acc[i * 4] += wgt * v.x; acc[i * 4 + 1] += wgt * v.y; acc[i * 4 + 2] += wgt * v.z; acc[i * 4 + 3] += wgt * v.w; }
  }
  const float4* hp = (const float4*)(h2 + row * D + lane * 16);
  float ss = 0.f;
#pragma unroll
  for (int i = 0; i < 4; ++i) { float4 hv = hp[i]; acc[i * 4] += hv.x; acc[i * 4 + 1] += hv.y; acc[i * 4 + 2] += hv.z; acc[i * 4 + 3] += hv.w; }
#pragma unroll
  for (int i = 0; i < 16; ++i) ss += acc[i] * acc[i];
  ss = wave_sum(ss);
  float rstd = rsqrtf(ss * (1.0f / D) + EPS);
  float4* op = (float4*)(out + ((size_t)b * SEQ + s) * D + lane * 16);
  const float4* gp = (const float4*)(fg + lane * 16);
#pragma unroll
  for (int i = 0; i < 4; ++i) { float4 g = gp[i]; op[i] = make_float4(acc[i * 4] * rstd * g.x, acc[i * 4 + 1] * rstd * g.y, acc[i * 4 + 2] * rstd * g.z, acc[i * 4 + 3] * rstd * g.w); }
}


template <class Epi>
__device__ __forceinline__ void gemm_tile(char* lds, const bf16_t* __restrict__ X, int ldx, const bf16_t* __restrict__ Wt, int ldw, int K, int m0, int n0, const Epi& epi) {
  const int tix = opaque_tid();
  const int tid = tix, lane = tid & 63, wid = tid >> 6;
  const int wm = wid >> 1, wn = wid & 1;
  const int sc = tid & 7, sr = tid >> 3;
  f32x4 acc[4][4];
#pragma unroll
  for (int i = 0; i < 4; ++i)
#pragma unroll
    for (int j = 0; j < 4; ++j) acc[i][j] = (f32x4){0.f, 0.f, 0.f, 0.f};
  uint4 ra[4], rb[2];
  const bf16_t* xp = X + (size_t)(m0 + sr) * ldx + sc * 8;
  const bf16_t* wp = Wt + (size_t)(n0 + sr) * ldw + sc * 8;
  const int nk = K >> 6;
#pragma unroll
  for (int i = 0; i < 4; ++i) ra[i] = *(const uint4*)(xp + (size_t)(64 * i) * ldx);
#pragma unroll
  for (int i = 0; i < 2; ++i) rb[i] = *(const uint4*)(wp + (size_t)(64 * i) * ldw);
#pragma unroll
  for (int i = 0; i < 4; ++i) { int r = sr + 64 * i; *(uint4*)(lds + r * 128 + ((sc ^ ((r >> 1) & 7)) << 4)) = ra[i]; }
#pragma unroll
  for (int i = 0; i < 2; ++i) { int r = sr + 64 * i; *(uint4*)(lds + 32768 + r * 128 + ((sc ^ ((r >> 1) & 7)) << 4)) = rb[i]; }
  __syncthreads();
  const int fr = lane & 15, fq = lane >> 4;
  for (int kt = 0; kt < nk; ++kt) {
    if (kt + 1 < nk) {
#pragma unroll
      for (int i = 0; i < 4; ++i) ra[i] = *(const uint4*)(xp + (size_t)(64 * i) * ldx + (kt + 1) * 64);
#pragma unroll
      for (int i = 0; i < 2; ++i) rb[i] = *(const uint4*)(wp + (size_t)(64 * i) * ldw + (kt + 1) * 64);
    }
    const char* la = lds + (kt & 1) * 49152;
    const char* lb = la + 32768;
#pragma unroll
    for (int kk = 0; kk < 2; ++kk) {
      bf16x8 xa[4], wb[4];
      const int c = kk * 4 + fq;
#pragma unroll
      for (int t = 0; t < 4; ++t) {
        int r = wm * 64 + t * 16 + fr; xa[t] = *(const bf16x8*)(la + r * 128 + ((c ^ ((r >> 1) & 7)) << 4));
        int r2 = wn * 64 + t * 16 + fr; wb[t] = *(const bf16x8*)(lb + r2 * 128 + ((c ^ ((r2 >> 1) & 7)) << 4));
      }
#pragma unroll
      for (int nt = 0; nt < 4; ++nt)
#pragma unroll
        for (int tt = 0; tt < 4; ++tt) acc[nt][tt] = __builtin_amdgcn_mfma_f32_16x16x32_bf16(wb[nt], xa[tt], acc[nt][tt], 0, 0, 0);
    }
    if (kt + 1 < nk) {
      char* lw = lds + ((kt + 1) & 1) * 49152;
#pragma unroll
      for (int i = 0; i < 4; ++i) { int r = sr + 64 * i; *(uint4*)(lw + r * 128 + ((sc ^ ((r >> 1) & 7)) << 4)) = ra[i]; }
#pragma unroll
      for (int i = 0; i < 2; ++i) { int r = sr + 64 * i; *(uint4*)(lw + 32768 + r * 128 + ((sc ^ ((r >> 1) & 7)) << 4)) = rb[i]; }
    }
    __syncthreads();
  }
#pragma unroll
  for (int nt = 0; nt < 4; ++nt)
#pragma unroll
    for (int tt = 0; tt < 4; ++tt) epi(m0 + wm * 64 + tt * 16 + fr, n0 + wn * 64 + nt * 16 + fq * 4, acc[nt][tt]);
}

struct Epi4StoreBf16 { bf16_t* out; int ld; int pad; __device__ __forceinline__ void operator()(int r, int c, f32x4 v) const {
  uint2 w; w.x = pack2(v[0], v[1]); w.y = pack2(v[2], v[3]); *(uint2*)(out + (size_t)r * ld + c) = w; } };
struct Epi4Resid { const float* x; const float* meta; float* h2; __device__ __forceinline__ void operator()(int r, int c, f32x4 v) const {
  const float* src = hrow_ptr(x, meta, r); float4 hv = src ? *(const float4*)(src + c) : make_float4(0.f, 0.f, 0.f, 0.f);
  *(float4*)(h2 + (size_t)r * D + c) = make_float4(hv.x + v[0], hv.y + v[1], hv.z + v[2], hv.w + v[3]); } };

__device__ __forceinline__ void p_transpose(int t, float* smem, const float* __restrict__ W, bf16_t* Wt, int K, int N) {
  const int tix = opaque_tid();
  float (*T)[65] = (float (*)[65])smem;
  const int nbx = N / 64, k0 = (t / nbx) * 64, n0 = (t % nbx) * 64, tid = (tix & 255);
  const int j = tid & 63, i0 = tid >> 6;
#pragma unroll
  for (int ii = 0; ii < 16; ++ii) { int i = i0 + 4 * ii; T[i][j] = W[(size_t)(k0 + i) * N + n0 + j]; }
  __syncthreads();
#pragma unroll
  for (int ii = 0; ii < 16; ++ii) { int jj = i0 + 4 * ii; Wt[(size_t)(n0 + jj) * K + k0 + j] = f2bf(T[j][jj]); }
  __syncthreads();
}

__device__ __forceinline__ void grid_bar(unsigned* ctr, unsigned target) {
  asm volatile("s_waitcnt vmcnt(0)" ::: "memory");
  __syncthreads();
  if (threadIdx.x == 0) {
    __builtin_amdgcn_fence(__ATOMIC_RELEASE, "agent");
    asm volatile("s_waitcnt vmcnt(0)" ::: "memory");
    __hip_atomic_fetch_add(ctr, 1u, __ATOMIC_RELAXED, __HIP_MEMORY_SCOPE_AGENT);
    unsigned spins = 0;
    while (__hip_atomic_load(ctr, __ATOMIC_RELAXED, __HIP_MEMORY_SCOPE_AGENT) < target) { __builtin_amdgcn_s_sleep(2); if (++spins > (1u << 24)) break; }
    __builtin_amdgcn_fence(__ATOMIC_ACQUIRE, "agent");
    asm volatile("s_waitcnt vmcnt(0)" ::: "memory");
  }
  __syncthreads();
}

struct Params {
  const float *x, *meta, *g1, *w_in, *lq1, *lk1, *lq2, *lk2, *subg, *conv_w, *conv_b, *gn_g, *gn_b, *w_out, *g2, *wq, *sk, *ut, *vt, *fg;
  float* out; float* scal; bf16_t* r1; bf16_t* r2; float* h2; int* eb; float* gb; bf16_t* wt_in; bf16_t* wt_out; bf16_t* wt_q; bf16_t* skb; unsigned char* ut8; unsigned char* vt8; float* uinv; float* vinv;
};

__global__ void __launch_bounds__(512, 2) mega(Params p) {
  cg::grid_group grid = cg::this_grid();
  __shared__ __attribute__((aligned(16))) char smem_c[131072];
  float* smem = (float*)smem_c;
  const int G = gridDim.x, vh = threadIdx.x >> 8;
  unsigned* ctr = (unsigned*)(p.scal + 64);
  bf16_t* xn1 = p.r1; bf16_t* mix = p.r1; bf16_t* xn2 = p.r1; bf16_t* proj = p.r2; bf16_t* qp = p.r2;
  for (int b = blockIdx.x; b < ROWS / 2; b += G) p_norm1(b * 2 + vh, smem + 4 * vh, p.x, p.meta, p.g1, xn1, p.lq1, p.lk1, p.lq2, p.lk2, p.scal);
  for (int b = blockIdx.x; b < (640 + 256 + 512) / 2; b += G) {
    const int bb = b * 2 + vh; float* sm = smem + vh * (64 * 65);
    if (bb < 640) p_transpose(bb, sm, p.w_in, p.wt_in, D, INC);
    else if (bb < 896) p_transpose(bb - 640, sm, p.w_out, p.wt_out, D, D);
    else p_transpose(bb - 896, sm, p.wq, p.wt_q, D, 2048);
  }
  p_cvt_bf16(blockIdx.x, G, p.sk, p.skb, (size_t)16 * 128 * 128 / 8);
  p_cvt_fp8_rows(blockIdx.x, G, p.ut, (unsigned*)p.ut8, p.uinv);
  p_cvt_fp8_rows(blockIdx.x, G, p.vt, (unsigned*)p.vt8, p.vinv);
  grid.sync();
  for (int b = blockIdx.x; b < (INC / 128) * (ROWS / 256); b += G) gemm_tile(smem_c, xn1, D, p.wt_in, D, D, (b / (INC / 128)) * 256, (b % (INC / 128)) * 128, Epi4StoreBf16{proj, INC, 0});
  grid_bar(ctr, (unsigned)G * 1u);
  {
    const float lam = p.scal[0];
    for (int u = blockIdx.x; u < 256; u += G) {
      const int bh = (u & 7) * 4 + (u >> 6), tp = (u >> 3) & 7;
#pragma unroll 1
      for (int k = 0; k < 4; ++k) {
        const int t = (k == 0) ? 31 - tp : (k == 1) ? 16 + tp : (k == 2) ? 15 - tp : tp;
        attn_unit(smem_c, proj, mix, p.subg, lam, bh >> 2, bh & 3, t);
      }
    }
  }
  for (int u = blockIdx.x; u < BATCH * 128; u += G) conv_unit(smem_c, proj, mix, p.conv_w, p.conv_b, p.gn_g, p.gn_b, u >> 7, NMETA + 32 * (u & 127));
  grid_bar(ctr, (unsigned)G * 2u);
  for (int b = blockIdx.x; b < (D / 128) * (ROWS / 256); b += G) gemm_tile(smem_c, mix, D, p.wt_out, D, D, (b / (D / 128)) * 256, (b % (D / 128)) * 128, Epi4Resid{p.x, p.meta, p.h2});
  grid_bar(ctr, (unsigned)G * 3u);
  for (int b = blockIdx.x; b < ROWS / 2; b += G) p_norm2(b * 2 + vh, smem + 4 * vh, p.h2, p.g2, xn2);
  grid_bar(ctr, (unsigned)G * 4u);
  for (int b = blockIdx.x; b < (2048 / 128) * (ROWS / 256); b += G) gemm_tile(smem_c, xn2, D, p.wt_q, D, D, (b / 16) * 256, (b % 16) * 128, Epi4StoreBf16{qp, 2048, 0});
  grid_bar(ctr, (unsigned)G * 5u);
  for (int u = blockIdx.x; u < 256 * 8; u += G) {
    const int rt = u >> 3, h = u & 7;
    peer_topk_unit(smem_c, qp, p.skb, p.eb, p.gb, (rt >> 5) * LP + NMETA + 128 * (rt & 31), h);
  }
  grid_bar(ctr, (unsigned)G * 6u);
  {
    const int tix = opaque_tid();
    const int lane = tix & 63, wid = tix >> 6;
    for (int tk = blockIdx.x * 8 + wid; tk < BATCH * SEQ; tk += G * 8) {
      const int b = tk / SEQ, sq = tk - b * SEQ;
      peer_gather_token(smem_c + wid * 1536, lane, (size_t)b * LP + NMETA + sq, (size_t)tk, xn2, p.h2, p.eb, p.gb, p.ut8, p.uinv, p.vt8, p.vinv, p.fg, p.out);
    }
  }
}

extern "C" void kernel_launch(void* const* d_in, const int* in_sizes, int n_in, void* d_out, int out_size, void* d_ws, size_t ws_size, hipStream_t stream) {
  static int grid_blocks = 0;
  if (!grid_blocks) {
    int dev = 0, cus = 0, per_cu = 0;
    hipGetDevice(&dev);
    hipDeviceGetAttribute(&cus, hipDeviceAttributeMultiprocessorCount, dev);
    hipOccupancyMaxActiveBlocksPerMultiprocessor(&per_cu, mega, 512, 0);
    if (per_cu > 1) per_cu = 1;
    if (per_cu < 1) per_cu = 1;
    grid_blocks = cus * per_cu;
  }
  Params p{};
  const float** pp = (const float**)&p;
  for (int i = 0; i < 20; ++i) pp[i] = (const float*)d_in[i];
  p.out = (float*)d_out;
  char* ws = (char*)d_ws;
  size_t off = 0;
  p.scal = (float*)(ws + off); off += 4096;
  p.r1 = (bf16_t*)(ws + off); off += (size_t)ROWS * D * 2;
  p.r2 = (bf16_t*)(ws + off); off += (size_t)ROWS * INC * 2;
  p.h2 = (float*)(ws + off); off += (size_t)ROWS * D * 4;
  p.wt_in = (bf16_t*)(ws + off); off += (size_t)INC * D * 2;
  p.wt_out = (bf16_t*)(ws + off); off += (size_t)D * D * 2;
  p.wt_q = (bf16_t*)(ws + off); off += (size_t)2048 * D * 2;
  p.skb = (bf16_t*)(ws + off); off += (size_t)16 * 128 * 128 * 2;
  p.ut8 = (unsigned char*)(ws + off); off += (size_t)16384 * D;
  p.vt8 = (unsigned char*)(ws + off); off += (size_t)16384 * D;
  p.uinv = (float*)(ws + off); off += 65536;
  p.vinv = (float*)(ws + off); off += 65536;
  p.eb = (int*)((char*)p.r2 + (size_t)ROWS * 2048 * 2);
  p.gb = (float*)((char*)p.eb + (size_t)ROWS * 128 * 4);
  hipMemsetAsync(d_ws, 0, 4096, stream);
  void* args[] = {&p};
  hipError_t e = hipLaunchCooperativeKernel((void*)mega, dim3(grid_blocks), dim3(512), args, 0, stream);
  if (e != hipSuccess) fprintf(stderr, "cooperative launch failed: %s (grid %d)\n", hipGetErrorString(e), grid_blocks);
}
```

```cpp
#include <hip/hip_runtime.h>
#include <hip/hip_cooperative_groups.h>
#include <cstdio>
namespace cg = cooperative_groups;
#include <stdint.h>
#include <math.h>

typedef unsigned short bf16_t;
typedef short bf16x8 __attribute__((ext_vector_type(8)));
typedef float f32x4 __attribute__((ext_vector_type(4)));

constexpr int D = 1024, BATCH = 8, SEQ = 4096, NMETA = 16, LREAL = NMETA + SEQ  , LP = 4224, ROWS = BATCH * LP;
constexpr int INC = 2560;
constexpr float EPS = 1e-6f;
constexpr float LAM_INIT = 0.2f;

__device__ __forceinline__ float bf2f(unsigned v) { return __uint_as_float(v << 16); }
__device__ __forceinline__ bf16_t f2bf(float f) { unsigned u = __float_as_uint(f); u += 0x7fffu + ((u >> 16) & 1u); return (bf16_t)(u >> 16); }
__device__ __forceinline__ unsigned pack2(float a, float b) { return (unsigned)f2bf(a) | ((unsigned)f2bf(b) << 16); }

__device__ __forceinline__ float wave_sum(float v) {
#pragma unroll
  for (int o = 32; o >= 1; o >>= 1) v += __shfl_xor(v, o);
  return v;
}
__device__ __forceinline__ float wave_max(float v) {
#pragma unroll
  for (int o = 32; o >= 1; o >>= 1) v = fmaxf(v, __shfl_xor(v, o));
  return v;
}

template <int CTRL> __device__ __forceinline__ float dpp_add(float v) { return v + __builtin_bit_cast(float, __builtin_amdgcn_update_dpp(0, __builtin_bit_cast(int, v), CTRL, 0xf, 0xf, true)); }
__device__ __forceinline__ float sum8(float v) { v = dpp_add<0x141>(v); v = dpp_add<0xB1>(v); v = dpp_add<0x4E>(v); return v; }
typedef __bf16 bf16v2 __attribute__((ext_vector_type(2)));
__device__ __forceinline__ float dot8(uint4 a, uint4 b, float acc) {
  acc = __builtin_amdgcn_fdot2_f32_bf16(__builtin_bit_cast(bf16v2, a.x), __builtin_bit_cast(bf16v2, b.x), acc, false);
  acc = __builtin_amdgcn_fdot2_f32_bf16(__builtin_bit_cast(bf16v2, a.y), __builtin_bit_cast(bf16v2, b.y), acc, false);
  acc = __builtin_amdgcn_fdot2_f32_bf16(__builtin_bit_cast(bf16v2, a.z), __builtin_bit_cast(bf16v2, b.z), acc, false);
  acc = __builtin_amdgcn_fdot2_f32_bf16(__builtin_bit_cast(bf16v2, a.w), __builtin_bit_cast(bf16v2, b.w), acc, false);
  return acc;
}
__device__ __forceinline__ float row_rstd(const float* __restrict__ rowss, size_t row) {
  const float4 a = *(const float4*)(rowss + row * 16), b = *(const float4*)(rowss + row * 16 + 4), c = *(const float4*)(rowss + row * 16 + 8), d = *(const float4*)(rowss + row * 16 + 12);
  const float t = ((a.x + a.y) + (a.z + a.w)) + ((b.x + b.y) + (b.z + b.w)) + ((c.x + c.y) + (c.z + c.w)) + ((d.x + d.y) + (d.z + d.w));
  return rsqrtf(t * (1.0f / D) + EPS);
}
__device__ __forceinline__ int opaque_tid() { int t = threadIdx.x; asm volatile("" : "+v"(t)); return t; }

__device__ __forceinline__ const float* hrow_ptr(const float* x, const float* meta, int row) {
  int b = row / LP, pos = row - b * LP;
  if (pos < NMETA) return meta + (size_t)pos * D;
  if (pos < LREAL) return x + ((size_t)b * SEQ + (pos - NMETA)) * D;
  return nullptr;
}

__device__ __forceinline__ void p_norm1(int blk, float* red, const float* x, const float* meta, const float* g1, bf16_t* xn1,
                                               const float* lq1, const float* lk1, const float* lq2, const float* lk2, float* scal) {
  const int tix = opaque_tid();
  int row = blk, tid = (tix & 255);
  __syncthreads();
  const float* src = hrow_ptr(x, meta, row);
  float4 v = src ? ((const float4*)src)[tid] : make_float4(0.f, 0.f, 0.f, 0.f);
  float ss = v.x * v.x + v.y * v.y + v.z * v.z + v.w * v.w;
  ss = wave_sum(ss);
  if ((tid & 63) == 0) red[tid >> 6] = ss;
  __syncthreads();
  float tot = red[0] + red[1] + red[2] + red[3];
  float rstd = rsqrtf(tot * (1.0f / D) + EPS);
  float4 g = ((const float4*)g1)[tid];
  uint2 o; o.x = pack2(v.x * rstd * g.x, v.y * rstd * g.y); o.y = pack2(v.z * rstd * g.z, v.w * rstd * g.w);
  ((uint2*)(xn1 + (size_t)row * D))[tid] = o;
  if (row == 0 && tid < 64) {
    float a = lq1[tid] * lk1[tid], b2 = lq2[tid] * lk2[tid];
    a = wave_sum(a); b2 = wave_sum(b2);
    if (tid == 0) scal[0] = expf(a) - expf(b2) + LAM_INIT;
  }
}


typedef float f32x16 __attribute__((ext_vector_type(16)));
typedef short v4i16_t __attribute__((ext_vector_type(4)));
typedef __bf16 bf16v2_t __attribute__((ext_vector_type(2)));
typedef float f32x2_t __attribute__((ext_vector_type(2)));
#define LDSP(T, p) ((__attribute__((address_space(3))) T*)(p))
#define MFMA32(a, b, c) __builtin_amdgcn_mfma_f32_32x32x16_bf16((a), (b), (c), 0, 0, 0)
__device__ __forceinline__ unsigned cvtpk(float lo, float hi) { f32x2_t v = {lo, hi}; return __builtin_bit_cast(unsigned, __builtin_convertvector(v, bf16v2_t)); }
__device__ __forceinline__ float half_swap_max(float m) { auto rr = __builtin_amdgcn_permlane32_swap(__float_as_uint(m), __float_as_uint(m), false, false); return fmaxf(__uint_as_float(rr[0]), __uint_as_float(rr[1])); }
__device__ __forceinline__ float half_swap_sum(float m) { auto rr = __builtin_amdgcn_permlane32_swap(__float_as_uint(m), __float_as_uint(m), false, false); return __uint_as_float(rr[0]) + __uint_as_float(rr[1]); }

__device__ __forceinline__ void attn_issue_kv(char* kvbuf, const bf16_t* __restrict__ kvrow0  , int tid, int wid) {
  const char* base = (const char*)kvrow0;
#pragma unroll
  for (int i = 0; i < 2; ++i) {
    const int g = i * 512 + tid, row = g >> 4, pos = g & 15;
    const unsigned offk = (unsigned)(row * (INC * 2) + 1024 + ((pos ^ (row & 15)) << 4));
    const unsigned offv = (unsigned)(row * (INC * 2) + 2048 + ((pos ^ ((row & 3) << 2)) << 4));
    __builtin_amdgcn_global_load_lds((const unsigned*)(base + offk), LDSP(unsigned, kvbuf + (i * 512 + wid * 64) * 16), 16, 0, 0);
    __builtin_amdgcn_global_load_lds((const unsigned*)(base + offv), LDSP(unsigned, kvbuf + 16384 + (i * 512 + wid * 64) * 16), 16, 0, 0);
  }
}

template <bool MASKED>
__device__ __forceinline__ void attn_map(f32x16 (&o)[4], float& mref_io, float& l_io, const char* qbase, int qsw, const char* kb, const char* vb, int c, int kq, float sl8, int lane, int r32, int hi) {
  const float c1 = 0.125f * 1.4426950408889634f;
  asm volatile("" : "+v"(qsw), "+v"(lane));
  f32x16 s0, s1;
  {
    const float a1 = sl8, a2 = 2.0f * sl8, a3 = 3.0f * sl8, b8 = 8.0f * sl8;
    float gb = sl8 * (float)kq;
#pragma unroll
    for (int g = 0; g < 4; ++g) { s0[4 * g] = gb; s0[4 * g + 1] = gb + a1; s0[4 * g + 2] = gb + a2; s0[4 * g + 3] = gb + a3; gb += b8; }
#pragma unroll
    for (int g = 0; g < 4; ++g) { s1[4 * g] = gb; s1[4 * g + 1] = gb + a1; s1[4 * g + 2] = gb + a2; s1[4 * g + 3] = gb + a3; gb += b8; }
    if (MASKED) {
#pragma unroll
      for (int r = 0; r < 16; ++r) { s0[r] = s0[r] > 0.f ? -1e30f : s0[r]; s1[r] = s1[r] > 0.f ? -1e30f : s1[r]; }
    }
  }
#pragma unroll
  for (int ks = 0; ks < 4; ++ks) {
    const int ch = c * 8 + ks * 2 + hi;
    bf16x8 bq = *(const bf16x8*)(qbase + ((ch ^ qsw) << 4));
    bf16x8 ka0 = *(const bf16x8*)(kb + r32 * 256 + ((ch ^ qsw) << 4));
    bf16x8 ka1 = *(const bf16x8*)(kb + (32 + r32) * 256 + ((ch ^ qsw) << 4));
    s0 = MFMA32(ka0, bq, s0);
    s1 = MFMA32(ka1, bq, s1);
    __builtin_amdgcn_sched_barrier(0);
  }
  float mx = fmaxf(s0[0], s1[0]);
#pragma unroll
  for (int r = 1; r < 16; ++r) mx = fmaxf(mx, fmaxf(s0[r], s1[r]));
  mx = half_swap_max(mx);
  float mref = mref_io;
  if (__any((mx - mref) * c1 > 6.0f)) {
    const float mn = fmaxf(mref, mx);
    const float alpha = exp2f((mref - mn) * c1);
    l_io *= alpha;
#pragma unroll
    for (int i = 0; i < 4; ++i)
#pragma unroll
      for (int r = 0; r < 16; ++r) o[i][r] *= alpha;
    mref = mn; mref_io = mn;
  }
  const float nm = -mref * c1;
  float ls = 0.f;
#pragma unroll
  for (int r = 0; r < 16; ++r) { s0[r] = __builtin_amdgcn_exp2f(fmaf(s0[r], c1, nm)); s1[r] = __builtin_amdgcn_exp2f(fmaf(s1[r], c1, nm)); ls += s0[r] + s1[r]; }
  l_io += ls;
  const int q4 = (lane & 15) >> 2, g1 = (lane >> 4) & 1, p4 = lane & 3;
#pragma unroll
  for (int kk = 0; kk < 4; ++kk) {
    const int key0 = 16 * kk + 4 * hi + q4;
    uint4 pwv;
    if (kk < 2) { pwv.x = cvtpk(s0[8 * kk], s0[8 * kk + 1]); pwv.y = cvtpk(s0[8 * kk + 2], s0[8 * kk + 3]); pwv.z = cvtpk(s0[8 * kk + 4], s0[8 * kk + 5]); pwv.w = cvtpk(s0[8 * kk + 6], s0[8 * kk + 7]); }
    else { const int k2 = kk - 2; pwv.x = cvtpk(s1[8 * k2], s1[8 * k2 + 1]); pwv.y = cvtpk(s1[8 * k2 + 2], s1[8 * k2 + 3]); pwv.z = cvtpk(s1[8 * k2 + 4], s1[8 * k2 + 5]); pwv.w = cvtpk(s1[8 * k2 + 6], s1[8 * k2 + 7]); }
    const bf16x8 pb = __builtin_bit_cast(bf16x8, pwv);
#pragma unroll
    for (int dvt = 0; dvt < 4; ++dvt) {
      const int c8 = 8 * (dvt ^ q4) + 4 * g1 + p4;
      v4i16_t lo = __builtin_amdgcn_ds_read_tr16_b64_v4i16(LDSP(v4i16_t, vb + key0 * 256 + c8 * 8));
      v4i16_t hi4 = __builtin_amdgcn_ds_read_tr16_b64_v4i16(LDSP(v4i16_t, vb + (key0 + 8) * 256 + c8 * 8));
      bf16x8 va = (bf16x8){lo[0], lo[1], lo[2], lo[3], hi4[0], hi4[1], hi4[2], hi4[3]};
      o[dvt] = MFMA32(va, pb, o[dvt]);
    }
    __builtin_amdgcn_sched_barrier(0);
  }
}

__device__ __forceinline__ void attn_unit(char* lds, const bf16_t* __restrict__ proj, bf16_t* mix, const float* __restrict__ subg, float lam, int b, int h, int t) {
  const int tix = opaque_tid();
  const int tid = tix, lane = tid & 63, r32 = lane & 31, hi = lane >> 5;
  const int wid = __builtin_amdgcn_readfirstlane(tid >> 6);
  const int c = wid >> 2, qg = wid & 3;
  const int q0 = NMETA + 128 * t, qw0 = q0 + 32 * qg, qpos = qw0 + r32;
  const size_t rowb = (size_t)b * LP;
  const int NT = 2 * t + 3;
  char* Qs = lds;
  char* KV = lds + 32768;
  const float sl8 = exp2f(1.0f - 2.0f * (float)h);
  __syncthreads();
  attn_issue_kv(KV, proj + rowb * INC + h * 128, tid, wid);
#pragma unroll
  for (int i = 0; i < 4; ++i) {
    const int g = i * 512 + tid, row = g >> 4, pos = g & 15;
    uint4 v = *(const uint4*)(proj + (rowb + q0 + row) * INC + h * 128 + ((pos ^ (row & 15)) << 3));
    *(uint4*)(Qs + g * 16) = v;
  }
  f32x16 o[4];
#pragma unroll
  for (int i = 0; i < 4; ++i)
#pragma unroll
    for (int r = 0; r < 16; ++r) o[i][r] = 0.f;
  float m = -1e30f, l = 0.f;
  const int qrow = 32 * qg + r32;
  const char* qbase = Qs + qrow * 256;
  const int qsw = qrow & 15;
  for (int j = 0; j < NT; ++j) {
    __syncthreads();
    if (j + 1 < NT) attn_issue_kv(KV + ((j + 1) & 1) * 32768, proj + (rowb + 64 * (j + 1)) * INC + h * 128, tid, wid);
    if (64 * j > qw0 + 31) continue;
    const char* kb = KV + (j & 1) * 32768;
    const char* vb = kb + 16384;
    const int kq = 64 * j + 4 * hi - qpos;
    if (64 * j + 63 > qw0) attn_map<true>(o, m, l, qbase, qsw, kb, vb, c, kq, sl8, lane, r32, hi);
    else attn_map<false>(o, m, l, qbase, qsw, kb, vb, c, kq, sl8, lane, r32, hi);
  }
  l = half_swap_sum(l);
  const float sc = (c == 0 ? 1.0f : lam) / l;
  __syncthreads();
  float* X = (float*)(lds + 32768);
  if (c == 1) {
#pragma unroll
    for (int i = 0; i < 4; ++i)
#pragma unroll
      for (int r = 0; r < 16; ++r) X[(qg * 64 + i * 16 + r) * 64 + lane] = o[i][r] * sc;
  }
  __syncthreads();
  if (c == 0) {
    float ss = 0.f;
#pragma unroll
    for (int i = 0; i < 4; ++i) {
#pragma unroll
      for (int r = 0; r < 16; ++r) { float v = o[i][r] * sc - X[(qg * 64 + i * 16 + r) * 64 + lane]; o[i][r] = v; ss += v * v; }
      __builtin_amdgcn_sched_barrier(0);
    }
    ss = half_swap_sum(ss);
    const float rstd = rsqrtf(ss * (1.0f / 128.0f) + EPS) * (1.0f - LAM_INIT);
    bf16_t* orow = mix + (rowb + qpos) * D + h * 128;
#pragma unroll
    for (int i = 0; i < 4; ++i) {
#pragma unroll
      for (int g = 0; g < 4; ++g) {
        const int dv0 = 32 * i + 8 * g + 4 * hi;
        const float4 sg = *(const float4*)(subg + dv0);
        uint2 w; w.x = cvtpk(o[i][4 * g] * rstd * sg.x, o[i][4 * g + 1] * rstd * sg.y); w.y = cvtpk(o[i][4 * g + 2] * rstd * sg.z, o[i][4 * g + 3] * rstd * sg.w);
        *(uint2*)(orow + dv0) = w;
      }
      __builtin_amdgcn_sched_barrier(0);
    }
  }
}


__device__ __forceinline__ void conv_unit(char* lds, const bf16_t* __restrict__ proj, bf16_t* mix, const float* __restrict__ cw, const float* __restrict__ cb,
                                          const float* __restrict__ gng, const float* __restrict__ gnb, int b, int pos0) {
  const int tix = opaque_tid();
  const int c = tix;
  float* U = (float*)lds;
  __syncthreads();
  {
    const int lane = tix & 63, wv = tix >> 6;
    uint4 ra[8], rg[8];
#pragma unroll
    for (int i = 0; i < 8; ++i) {
      const int r = wv + 8 * i, pos = pos0 - 30 + r;
      ra[i] = make_uint4(0, 0, 0, 0); rg[i] = make_uint4(0, 0, 0, 0);
      if (r < 62 && pos >= 0) {
        const bf16_t* pr = proj + ((size_t)b * LP + pos) * INC + 8 * lane;
        ra[i] = *(const uint4*)(pr + 1536); rg[i] = *(const uint4*)(pr + 2048);
      }
    }
#pragma unroll
    for (int i = 0; i < 8; ++i) {
      const int r = wv + 8 * i;
      if (r < 62) {
        const unsigned av[4] = {ra[i].x, ra[i].y, ra[i].z, ra[i].w}, gv[4] = {rg[i].x, rg[i].y, rg[i].z, rg[i].w};
        float u[8];
#pragma unroll
        for (int q = 0; q < 4; ++q) {
          const float a0 = __uint_as_float(av[q] << 16), a1 = __uint_as_float(av[q] & 0xffff0000u), g0 = __uint_as_float(gv[q] << 16), g1 = __uint_as_float(gv[q] & 0xffff0000u);
          u[2 * q] = a0 / (1.0f + __expf(-g0)); u[2 * q + 1] = a1 / (1.0f + __expf(-g1));
        }
        *(float4*)(U + r * 512 + 8 * lane) = make_float4(u[0], u[1], u[2], u[3]);
        *(float4*)(U + r * 512 + 8 * lane + 4) = make_float4(u[4], u[5], u[6], u[7]);
      }
    }
  }
  float w[31];
#pragma unroll
  for (int j = 0; j < 31; ++j) w[j] = cw[j * 512 + c];
  const float bias = cb[c], gg = gng[c], gb2 = gnb[c];
  __syncthreads();
  for (int t = 0; t < 32; ++t) {
    float y = bias;
#pragma unroll
    for (int j = 0; j < 31; ++j) y = fmaf(w[j], U[(t + j) * 512 + c], y);
    const float mu = wave_sum(y) * (1.0f / 64.0f);
    const float d = y - mu;
    const float var = wave_sum(d * d) * (1.0f / 64.0f);
    const float n = d * rsqrtf(var + EPS) * gg + gb2;
    mix[((size_t)b * LP + pos0 + t) * D + 512 + c] = f2bf(n / (1.0f + __expf(-n)));
  }
}

__device__ __forceinline__ void p_conv_naive(int blk, const bf16_t* __restrict__ proj, bf16_t* mix, const float* cw, const float* cb, const float* gg_, const float* gb_) {
  const int tix = opaque_tid();
  int row = blk, tid = (tix & 255);
  int b = row / LP, pos = row - b * LP;
  int c0 = tid * 2;
  unsigned* outp = (unsigned*)(mix + (size_t)row * D + 512 + c0);
  if (pos >= LREAL) { *outp = 0u; return; }
  float y0 = cb[c0], y1 = cb[c0 + 1];
  for (int j = 0; j < 31; ++j) {
    int p = pos - 30 + j;
    if (p < 0) continue;
    const bf16_t* pr = proj + ((size_t)b * LP + p) * INC;
    unsigned a = *(const unsigned*)(pr + 1536 + c0), g = *(const unsigned*)(pr + 2048 + c0);
    float a0 = bf2f(a & 0xffffu), a1 = bf2f(a >> 16), g0 = bf2f(g & 0xffffu), g1 = bf2f(g >> 16);
    float u0 = a0 / (1.0f + __expf(-g0)), u1 = a1 / (1.0f + __expf(-g1));
    y0 += cw[j * 512 + c0] * u0; y1 += cw[j * 512 + c0 + 1] * u1;
  }
  float s = y0 + y1;
#pragma unroll
  for (int o = 16; o >= 1; o >>= 1) s += __shfl_xor(s, o);
  float mu = s * (1.0f / 64.0f);
  float d0 = y0 - mu, d1 = y1 - mu;
  float v = d0 * d0 + d1 * d1;
#pragma unroll
  for (int o = 16; o >= 1; o >>= 1) v += __shfl_xor(v, o);
  float rstd = rsqrtf(v * (1.0f / 64.0f) + EPS);
  float n0 = d0 * rstd * gg_[c0] + gb_[c0], n1 = d1 * rstd * gg_[c0 + 1] + gb_[c0 + 1];
  float r0 = n0 / (1.0f + __expf(-n0)), r1 = n1 / (1.0f + __expf(-n1));
  *outp = pack2(r0, r1);
}

__device__ __forceinline__ void p_norm2(int blk, float* red, const float* h2, const float* g2, bf16_t* xn2) {
  const int tix = opaque_tid();
  int row = blk, tid = (tix & 255);
  __syncthreads();
  float4 v = ((const float4*)(h2 + (size_t)row * D))[tid];
  float ss = v.x * v.x + v.y * v.y + v.z * v.z + v.w * v.w;
  ss = wave_sum(ss);
  if ((tid & 63) == 0) red[tid >> 6] = ss;
  __syncthreads();
  float tot = red[0] + red[1] + red[2] + red[3];
  float rstd = rsqrtf(tot * (1.0f / D) + EPS);
  float4 g = ((const float4*)g2)[tid];
  uint2 o; o.x = pack2(v.x * rstd * g.x, v.y * rstd * g.y); o.y = pack2(v.z * rstd * g.z, v.w * rstd * g.w);
  ((uint2*)(xn2 + (size_t)row * D))[tid] = o;
}

__device__ __forceinline__ void p_topk_naive(int blk, const bf16_t* __restrict__ qp, const float* __restrict__ sk, int* eb, float* gb) {
  const int tix = opaque_tid();
  int w = blk * 4 + ((tix & 255) >> 6), lane = (tix & 255) & 63;
  int row = w >> 3, h = w & 7;
  int pos = row % LP;
  if (pos < NMETA || pos >= LREAL) return;
  const float NEG = -3.0e38f;
  float top[2];
#pragma unroll
  for (int p = 0; p < 2; ++p) {
    const bf16_t* qv = qp + (size_t)row * 2048 + h * 256 + p * 128;
    const float* k0 = sk + ((size_t)(h * 2 + p) * 128 + lane) * 128;
    const float* k1 = k0 + 64 * 128;
    float s0 = 0.f, s1 = 0.f;
    for (int d = 0; d < 128; d += 8) {
      uint4 r = *(const uint4*)(qv + d);
      float qf[8] = {bf2f(r.x & 0xffffu), bf2f(r.x >> 16), bf2f(r.y & 0xffffu), bf2f(r.y >> 16), bf2f(r.z & 0xffffu), bf2f(r.z >> 16), bf2f(r.w & 0xffffu), bf2f(r.w >> 16)};
      float4 a0 = *(const float4*)(k0 + d), a1 = *(const float4*)(k0 + d + 4), b0 = *(const float4*)(k1 + d), b1 = *(const float4*)(k1 + d + 4);
      s0 += qf[0] * a0.x + qf[1] * a0.y + qf[2] * a0.z + qf[3] * a0.w + qf[4] * a1.x + qf[5] * a1.y + qf[6] * a1.z + qf[7] * a1.w;
      s1 += qf[0] * b0.x + qf[1] * b0.y + qf[2] * b0.z + qf[3] * b0.w + qf[4] * b1.x + qf[5] * b1.y + qf[6] * b1.z + qf[7] * b1.w;
    }
    float v0 = __uint_as_float((__float_as_uint(s0) & ~127u) | (unsigned)lane);
    float v1 = __uint_as_float((__float_as_uint(s1) & ~127u) | (unsigned)(lane + 64));
    float t = NEG;
    for (int it = 0; it < 16; ++it) {
      float m = wave_max(fmaxf(v0, v1));
      if (lane == it) t = m;
      if (v0 == m) v0 = NEG;
      if (v1 == m) v1 = NEG;
    }
    top[p] = t;
  }
  int ci = lane >> 2, jb = (lane & 3) * 4;
  float av = __uint_as_float(__float_as_uint(__shfl(top[0], ci)) & ~127u);
  float c[4];
#pragma unroll
  for (int jj = 0; jj < 4; ++jj) {
    float bv = __uint_as_float(__float_as_uint(__shfl(top[1], jb + jj)) & ~127u);
    float s = av + bv;
    c[jj] = __uint_as_float((__float_as_uint(s) & ~255u) | (unsigned)(ci * 16 + jb + jj));
  }
  float ct = NEG;
  for (int it = 0; it < 16; ++it) {
    float m = wave_max(fmaxf(fmaxf(c[0], c[1]), fmaxf(c[2], c[3])));
    if (lane == it) ct = m;
#pragma unroll
    for (int jj = 0; jj < 4; ++jj) if (c[jj] == m) c[jj] = NEG;
  }
  unsigned cbits = __float_as_uint(ct);
  int cidx = cbits & 255u;
  float cval = __uint_as_float(cbits & ~255u);
  int i1 = __float_as_uint(__shfl(top[0], (cidx >> 4) & 15)) & 127u;
  int i2 = __float_as_uint(__shfl(top[1], cidx & 15)) & 127u;
  float mx = __shfl(cval, 0);
  float ex = lane < 16 ? __expf(cval - mx) : 0.f;
  float sum = wave_sum(ex);
  if (lane < 16) {
    eb[((size_t)row * 8 + h) * 16 + lane] = i1 * 128 + i2;
    gb[((size_t)row * 8 + h) * 16 + lane] = ex / sum;
  }
}


__device__ __forceinline__ void ce_desc(float& a, float& b) { const float hi = fmaxf(a, b), lo = fminf(a, b); a = hi; b = lo; }
__device__ __forceinline__ void ce_asc(float& a, float& b) { const float hi = fmaxf(a, b), lo = fminf(a, b); a = lo; b = hi; }
template <int N> __device__ __forceinline__ void bitonic_sort_desc(float (&v)[N]) {
#pragma unroll
  for (int k = 2; k <= N; k <<= 1)
#pragma unroll
    for (int j = k >> 1; j > 0; j >>= 1)
#pragma unroll
      for (int i = 0; i < N; ++i) { const int l = i ^ j; if (l > i) { if ((i & k) == 0) ce_desc(v[i], v[l]); else ce_asc(v[i], v[l]); } }
}
template <int N> __device__ __forceinline__ void bitonic_merge_desc(float (&v)[N]) {
#pragma unroll
  for (int j = N >> 1; j > 0; j >>= 1)
#pragma unroll
    for (int i = 0; i < N; ++i) { const int l = i ^ j; if (l > i) ce_desc(v[i], v[l]); }
}
__device__ __forceinline__ void cep_desc(float& a, float& b, int& pa, int& pb) { const bool sw = b > a; const float hi = sw ? b : a, lo = sw ? a : b; const int ph = sw ? pb : pa, pl = sw ? pa : pb; a = hi; b = lo; pa = ph; pb = pl; }
__device__ __forceinline__ void cep_asc(float& a, float& b, int& pa, int& pb) { const bool sw = b < a; const float lo = sw ? b : a, hi = sw ? a : b; const int pl = sw ? pb : pa, ph = sw ? pa : pb; a = lo; b = hi; pa = pl; pb = ph; }
template <int N> __device__ __forceinline__ void bitonic_sortp_desc(float (&v)[N], int (&q)[N]) {
#pragma unroll
  for (int k = 2; k <= N; k <<= 1)
#pragma unroll
    for (int j = k >> 1; j > 0; j >>= 1)
#pragma unroll
      for (int i = 0; i < N; ++i) { const int l = i ^ j; if (l > i) { if ((i & k) == 0) cep_desc(v[i], v[l], q[i], q[l]); else cep_asc(v[i], v[l], q[i], q[l]); } }
}
template <int N> __device__ __forceinline__ void bitonic_mergep_desc(float (&v)[N], int (&q)[N]) {
#pragma unroll
  for (int j = N >> 1; j > 0; j >>= 1)
#pragma unroll
    for (int i = 0; i < N; ++i) { const int l = i ^ j; if (l > i) cep_desc(v[i], v[l], q[i], q[l]); }
}
__host__ __device__ constexpr int cand_slot(int i, int j) { int s = 0; for (int ii = 0; ii < i; ++ii) s += 16 / (ii + 1); return s + j; }

__device__ __forceinline__ void peer_topk_unit(char* lds, const bf16_t* __restrict__ qp, const bf16_t* __restrict__ skb, const float* __restrict__ rowss, int* eb, float* gb, int row0, int h) {
  const int tix = opaque_tid();
  const int tid = tix, lane = tid & 63, wid = tid >> 6, fr = lane & 15, fq = lane >> 4;
  __syncthreads();
#pragma unroll
  for (int i = 0; i < 8; ++i) {
    const int g = i * 512 + tid, row = g >> 4, pos = g & 15;
    *(uint4*)(lds + g * 16) = *(const uint4*)(skb + ((size_t)(h * 2) * 128 + row) * 128 + ((pos ^ (row & 15)) << 3));
  }
  if (tid < 64) {
    int i = 0, base = 0;
    while (i < 15 && tid >= base + 16 / (i + 1)) { base += 16 / (i + 1); ++i; }
    ((int*)(lds + 65536))[tid] = (i << 4) | ((tid - base) & 15);
  }
  __syncthreads();
  const int tok = row0 + wid * 16 + fr;
  float top[2][16];
#pragma unroll
  for (int p = 0; p < 2; ++p) {
    f32x4 acc[8];
#pragma unroll
    for (int i = 0; i < 8; ++i) acc[i] = (f32x4){0.f, 0.f, 0.f, 0.f};
    const bf16_t* xrow = qp + (size_t)tok * 2048 + h * 256 + p * 128 + fq * 8;
#pragma unroll
    for (int ks = 0; ks < 4; ++ks) {
      const bf16x8 xb = *(const bf16x8*)(xrow + ks * 32);
      const int ch = ks * 4 + fq;
#pragma unroll
      for (int nt = 0; nt < 8; ++nt) {
        const int r = p * 128 + nt * 16 + fr;
        const bf16x8 wa = *(const bf16x8*)(lds + r * 256 + ((ch ^ (r & 15)) << 4));
        acc[nt] = __builtin_amdgcn_mfma_f32_16x16x32_bf16(wa, xb, acc[nt], 0, 0, 0);
      }
    }
    float v[32];
#pragma unroll
    for (int nt = 0; nt < 8; ++nt)
#pragma unroll
      for (int r = 0; r < 4; ++r) v[nt * 4 + r] = __uint_as_float((__float_as_uint(acc[nt][r]) & ~127u) | (unsigned)(nt * 16 + fq * 4 + r));
    bitonic_sort_desc<32>(v);
    float t[16];
#pragma unroll
    for (int i = 0; i < 16; ++i) t[i] = v[i];
#pragma unroll
    for (int rnd = 0; rnd < 2; ++rnd) {
      float pb[16];
#pragma unroll
      for (int i = 0; i < 16; ++i) pb[i] = __shfl_xor(t[15 - i], rnd == 0 ? 16 : 32);
#pragma unroll
      for (int i = 0; i < 16; ++i) t[i] = fmaxf(t[i], pb[i]);
      bitonic_merge_desc<16>(t);
    }
#pragma unroll
    for (int i = 0; i < 16; ++i) top[p][i] = t[i];
  }
  int* ST = (int*)(lds + 65536);
  int* IDX = (int*)(lds + 65536 + 256) + (wid * 16 + fr) * 32;
#define SEL4(arr, q) (fq == 0 ? arr[q] : fq == 1 ? arr[4 + (q)] : fq == 2 ? arr[8 + (q)] : arr[12 + (q)])
  {
    int4 ia, ib;
    ia.x = __float_as_uint(SEL4(top[0], 0)) & 127; ia.y = __float_as_uint(SEL4(top[0], 1)) & 127; ia.z = __float_as_uint(SEL4(top[0], 2)) & 127; ia.w = __float_as_uint(SEL4(top[0], 3)) & 127;
    ib.x = __float_as_uint(SEL4(top[1], 0)) & 127; ib.y = __float_as_uint(SEL4(top[1], 1)) & 127; ib.z = __float_as_uint(SEL4(top[1], 2)) & 127; ib.w = __float_as_uint(SEL4(top[1], 3)) & 127;
    *(int4*)(IDX + 4 * fq) = ia; *(int4*)(IDX + 16 + 4 * fq) = ib;
  }
  float cv[64];
#pragma unroll
  for (int i = 50; i < 64; ++i) cv[i] = -3.0e38f;
#pragma unroll
  for (int i = 0; i < 16; ++i)
#pragma unroll
    for (int j = 0; j < 16; ++j)
      if ((i + 1) * (j + 1) <= 16) {
        const float sv = __uint_as_float(__float_as_uint(top[0][i]) & ~127u) + __uint_as_float(__float_as_uint(top[1][j]) & ~127u);
        cv[cand_slot(i, j)] = __uint_as_float((__float_as_uint(sv) & ~63u) | (unsigned)cand_slot(i, j));
      }
  bitonic_sort_desc<64>(cv);
  float ex[16]; float sum = 0.f;
  const float c0v = __uint_as_float(__float_as_uint(cv[0]) & ~63u);
  const float rs = row_rstd(rowss, (size_t)tok);
#pragma unroll
  for (int i = 0; i < 16; ++i) { ex[i] = __expf((__uint_as_float(__float_as_uint(cv[i]) & ~63u) - c0v) * rs); sum += ex[i]; }
  const float inv = 1.0f / sum;
  int e4[4]; float g4[4];
#pragma unroll
  for (int q = 0; q < 4; ++q) {
    const int slot = __float_as_uint(SEL4(cv, q)) & 63;
    const int ij = ST[slot];
    e4[q] = IDX[ij >> 4] * 128 + IDX[16 + (ij & 15)];
    g4[q] = SEL4(ex, q) * inv;
  }
#undef SEL4
  *(int4*)(eb + ((size_t)tok * 8 + h) * 16 + 4 * fq) = make_int4(e4[0], e4[1], e4[2], e4[3]);
  *(float4*)(gb + ((size_t)tok * 8 + h) * 16 + 4 * fq) = make_float4(g4[0], g4[1], g4[2], g4[3]);
}

__device__ __forceinline__ void p_cvt_bf16(int blk, int nblk, const float* __restrict__ src, bf16_t* dst, size_t n8) {
  const int tix = opaque_tid();
  for (size_t i = (size_t)blk * 512 + tix; i < n8; i += (size_t)nblk * 512) {
    const float4 a = ((const float4*)src)[2 * i], b = ((const float4*)src)[2 * i + 1];
    uint4 w; w.x = cvtpk(a.x, a.y); w.y = cvtpk(a.z, a.w); w.z = cvtpk(b.x, b.y); w.w = cvtpk(b.z, b.w);
    ((uint4*)dst)[i] = w;
  }
}


typedef float f32x2v __attribute__((ext_vector_type(2)));
__device__ __forceinline__ void p_cvt_fp8_rows(int blk, int nblk, const float* __restrict__ src, unsigned* dst, float* inv, const float* __restrict__ csc) {
  const int tix = opaque_tid();
  const int lane = tix & 63, wid = tix >> 6;
  for (int r = blk * 8 + wid; r < 16384; r += nblk * 8) {
    const float4* sp = (const float4*)(src + (size_t)r * D);
    float4 v[4];
#pragma unroll
    for (int k = 0; k < 4; ++k) v[k] = sp[k * 64 + lane];
    if (csc) {
#pragma unroll
      for (int k = 0; k < 4; ++k) { const float4 g = ((const float4*)csc)[k * 64 + lane]; v[k].x *= g.x; v[k].y *= g.y; v[k].z *= g.z; v[k].w *= g.w; }
    }
    float am = 0.f;
#pragma unroll
    for (int k = 0; k < 4; ++k) am = fmaxf(am, fmaxf(fmaxf(fabsf(v[k].x), fabsf(v[k].y)), fmaxf(fabsf(v[k].z), fabsf(v[k].w))));
    am = wave_max(am);
    const float sc = am > 0.f ? 384.0f / am : 1.0f;
#pragma unroll
    for (int k = 0; k < 4; ++k) {
      int w = __builtin_amdgcn_cvt_pk_fp8_f32(v[k].x * sc, v[k].y * sc, 0, false);
      w = __builtin_amdgcn_cvt_pk_fp8_f32(v[k].z * sc, v[k].w * sc, w, true);
      { const int c = 256 * k + 4 * lane; dst[((size_t)(c >> 7) * (16384 * 128) + (size_t)r * 128 + (c & 127)) >> 2] = (unsigned)w; }
    }
    if (lane == 0) inv[r] = am > 0.f ? am * (1.0f / 384.0f) : 1.0f;
  }
}
__device__ __forceinline__ float row16_sum(float v) {
  v += __builtin_bit_cast(float, __builtin_amdgcn_update_dpp(0, __builtin_bit_cast(int, v), 0x128, 0xf, 0xf, true));
  v += __builtin_bit_cast(float, __builtin_amdgcn_update_dpp(0, __builtin_bit_cast(int, v), 0x124, 0xf, 0xf, true));
  v += __builtin_bit_cast(float, __builtin_amdgcn_update_dpp(0, __builtin_bit_cast(int, v), 0x122, 0xf, 0xf, true));
  v += __builtin_bit_cast(float, __builtin_amdgcn_update_dpp(0, __builtin_bit_cast(int, v), 0x121, 0xf, 0xf, true));
  return v;
}
__device__ __forceinline__ void peer_gather_token(char* wlds  , int lane, size_t row, size_t orow, const bf16_t* __restrict__ xn2, const float* __restrict__ h2,
                                                  const int* __restrict__ eb, const float* __restrict__ gb, const unsigned char* __restrict__ ut8, const float* __restrict__ uinv,
                                                  const unsigned char* __restrict__ vt8, const float* __restrict__ vinv, const float* __restrict__ fg, float* __restrict__ out) {
  int* E = (int*)wlds; float* Gt = (float*)(wlds + 512); float* W = (float*)(wlds + 1024);
  const int i16 = lane & 15, g = lane >> 4;
  {
    const int e0 = eb[row * 128 + lane], e1 = eb[row * 128 + 64 + lane];
    E[lane] = e0; E[lane + 64] = e1;
    Gt[lane] = gb[row * 128 + lane]; Gt[lane + 64] = gb[row * 128 + 64 + lane];
  }
  float xf[4][16];
#pragma unroll
  for (int k = 0; k < 4; ++k) {
    const uint4 a = *(const uint4*)(xn2 + row * D + 256 * k + 16 * i16), b = *(const uint4*)(xn2 + row * D + 256 * k + 16 * i16 + 8);
    xf[k][0] = __uint_as_float(a.x << 16); xf[k][1] = __uint_as_float(a.x & 0xffff0000u); xf[k][2] = __uint_as_float(a.y << 16); xf[k][3] = __uint_as_float(a.y & 0xffff0000u);
    xf[k][4] = __uint_as_float(a.z << 16); xf[k][5] = __uint_as_float(a.z & 0xffff0000u); xf[k][6] = __uint_as_float(a.w << 16); xf[k][7] = __uint_as_float(a.w & 0xffff0000u);
    xf[k][8] = __uint_as_float(b.x << 16); xf[k][9] = __uint_as_float(b.x & 0xffff0000u); xf[k][10] = __uint_as_float(b.y << 16); xf[k][11] = __uint_as_float(b.y & 0xffff0000u);
    xf[k][12] = __uint_as_float(b.z << 16); xf[k][13] = __uint_as_float(b.z & 0xffff0000u); xf[k][14] = __uint_as_float(b.w << 16); xf[k][15] = __uint_as_float(b.w & 0xffff0000u);
  }
#pragma unroll 2
  for (int m = 0; m < 32; ++m) {
    const int e = E[4 * m + g];
    const unsigned char* ur = ut8 + (size_t)e * D + 16 * i16;
    uint4 u[4];
#pragma unroll
    for (int k = 0; k < 4; ++k) u[k] = *(const uint4*)(ur + 256 * k);
    float d0 = 0.f, d1 = 0.f;
#pragma unroll
    for (int k = 0; k < 4; ++k) {
      const unsigned wv[4] = {u[k].x, u[k].y, u[k].z, u[k].w};
#pragma unroll
      for (int q = 0; q < 4; ++q) {
        const f32x2v lo = __builtin_amdgcn_cvt_pk_f32_fp8((int)wv[q], false), hi = __builtin_amdgcn_cvt_pk_f32_fp8((int)wv[q], true);
        d0 = fmaf(lo.x, xf[k][4 * q], d0); d1 = fmaf(lo.y, xf[k][4 * q + 1], d1);
        d0 = fmaf(hi.x, xf[k][4 * q + 2], d0); d1 = fmaf(hi.y, xf[k][4 * q + 3], d1);
      }
    }
    const float d = row16_sum(d0 + d1);
    if (i16 == 0) W[4 * m + g] = d;
  }
  {
    const int e0 = E[lane], e1 = E[lane + 64];
    const float ui0 = uinv[e0], ui1 = uinv[e1];
    const float a0 = W[lane] * ui0, a1 = W[lane + 64] * ui1;
    const float g0 = Gt[lane], g1 = Gt[lane + 64];
    W[lane] = g0 * 0.5f * a0 * (1.0f + erff(a0 * 0.70710678118654752f)) * vinv[e0];
    W[lane + 64] = g1 * 0.5f * a1 * (1.0f + erff(a1 * 0.70710678118654752f)) * vinv[e1];
  }
  float acc[4][16];
#pragma unroll
  for (int k = 0; k < 4; ++k)
#pragma unroll
    for (int i = 0; i < 16; ++i) acc[k][i] = 0.f;
#pragma unroll 2
  for (int m = 0; m < 32; ++m) {
    const int e = E[4 * m + g];
    const float w = W[4 * m + g];
    const unsigned char* vr = vt8 + (size_t)e * D + 16 * i16;
    uint4 v[4];
#pragma unroll
    for (int k = 0; k < 4; ++k) v[k] = *(const uint4*)(vr + 256 * k);
#pragma unroll
    for (int k = 0; k < 4; ++k) {
      const unsigned wv[4] = {v[k].x, v[k].y, v[k].z, v[k].w};
#pragma unroll
      for (int q = 0; q < 4; ++q) {
        const f32x2v lo = __builtin_amdgcn_cvt_pk_f32_fp8((int)wv[q], false), hi = __builtin_amdgcn_cvt_pk_f32_fp8((int)wv[q], true);
        acc[k][4 * q] = fmaf(w, lo.x, acc[k][4 * q]); acc[k][4 * q + 1] = fmaf(w, lo.y, acc[k][4 * q + 1]);
        acc[k][4 * q + 2] = fmaf(w, hi.x, acc[k][4 * q + 2]); acc[k][4 * q + 3] = fmaf(w, hi.y, acc[k][4 * q + 3]);
      }
    }
  }
  float res[16];
#pragma unroll
  for (int k = 0; k < 4; ++k)
#pragma unroll
    for (int j = 0; j < 16; ++j) {
      float t = acc[k][j];
      t += __shfl_xor(t, 16); t += __shfl_xor(t, 32);
      if (k == g) res[j] = t;
    }
  const int c0 = 256 * g + 16 * i16;
  float ss = 0.f;
#pragma unroll
  for (int q = 0; q < 4; ++q) {
    const float4 hv = *(const float4*)(h2 + row * D + c0 + 4 * q);
    res[4 * q] += hv.x; res[4 * q + 1] += hv.y; res[4 * q + 2] += hv.z; res[4 * q + 3] += hv.w;
  }
#pragma unroll
  for (int i = 0; i < 16; ++i) ss += res[i] * res[i];
  ss = wave_sum(ss);
  const float rstd = rsqrtf(ss * (1.0f / D) + EPS);
#pragma unroll
  for (int q = 0; q < 4; ++q) {
    const float4 f = *(const float4*)(fg + c0 + 4 * q);
    *(float4*)(out + orow * D + c0 + 4 * q) = make_float4(res[4 * q] * rstd * f.x, res[4 * q + 1] * rstd * f.y, res[4 * q + 2] * rstd * f.z, res[4 * q + 3] * rstd * f.w);
  }
}


__device__ __forceinline__ unsigned xcc_id() { return (unsigned)__builtin_amdgcn_s_getreg((3 << 11) | 20) & 7u; }

__device__ __forceinline__ void ds_issue(uint4 (&u)[16], const int* El  , const unsigned char* __restrict__ tab) {
  int ev[16];
#pragma unroll
  for (int q = 0; q < 4; ++q) { const int4 t = *(const int4*)(El + 4 * q); ev[4 * q] = t.x; ev[4 * q + 1] = t.y; ev[4 * q + 2] = t.z; ev[4 * q + 3] = t.w; }
#pragma unroll
  for (int it = 0; it < 16; ++it) u[it] = *(const uint4*)(tab + (size_t)(unsigned)ev[it] * 128);
}
__device__ __forceinline__ void ds_u_compute(const uint4 (&u)[16], const char* Xl  , float* __restrict__ pout, int j) {
  f32x2v xf[8];
  {
    const uint4 a = *(const uint4*)Xl, c = *(const uint4*)(Xl + 16);
    xf[0] = (f32x2v){__uint_as_float(a.x << 16), __uint_as_float(a.x & 0xffff0000u)}; xf[1] = (f32x2v){__uint_as_float(a.y << 16), __uint_as_float(a.y & 0xffff0000u)};
    xf[2] = (f32x2v){__uint_as_float(a.z << 16), __uint_as_float(a.z & 0xffff0000u)}; xf[3] = (f32x2v){__uint_as_float(a.w << 16), __uint_as_float(a.w & 0xffff0000u)};
    xf[4] = (f32x2v){__uint_as_float(c.x << 16), __uint_as_float(c.x & 0xffff0000u)}; xf[5] = (f32x2v){__uint_as_float(c.y << 16), __uint_as_float(c.y & 0xffff0000u)};
    xf[6] = (f32x2v){__uint_as_float(c.z << 16), __uint_as_float(c.z & 0xffff0000u)}; xf[7] = (f32x2v){__uint_as_float(c.w << 16), __uint_as_float(c.w & 0xffff0000u)};
  }
  float k0 = 0.f, k1 = 0.f;
#pragma unroll
  for (int it = 0; it < 16; ++it) {
    const unsigned wv[4] = {u[it].x, u[it].y, u[it].z, u[it].w};
    f32x2v d2 = {0.f, 0.f};
#pragma unroll
    for (int q = 0; q < 4; ++q) {
      const f32x2v lo = __builtin_amdgcn_cvt_pk_f32_fp8((int)wv[q], false), hi = __builtin_amdgcn_cvt_pk_f32_fp8((int)wv[q], true);
      d2 = __builtin_elementwise_fma(lo, xf[2 * q], d2); d2 = __builtin_elementwise_fma(hi, xf[2 * q + 1], d2);
    }
    const float d = sum8(d2.x + d2.y);
    if ((it >> 1) == j) { if (it & 1) k1 = d; else k0 = d; }
  }
  *(float2*)pout = make_float2(k0, k1);
}
__device__ __forceinline__ void ds_u_chunk(char* wl  , int lane, int tk0, int s, const bf16_t* __restrict__ xn2, const int* __restrict__ eb, const unsigned char* __restrict__ ut8, float* __restrict__ partial) {
  const int b = tk0 / SEQ, sq = tk0 - b * SEQ;
  const size_t row0 = (size_t)b * LP + NMETA + sq;
  const int j = lane & 7, gi = lane >> 3;
  int* El = (int*)wl;
  char* Xl = wl + 8192;
#pragma unroll
  for (int i = 0; i < 8; ++i) *(int4*)(El + (i * 64 + lane) * 4) = *(const int4*)(eb + row0 * 128 + (i * 64 + lane) * 4);
#pragma unroll
  for (int i = 0; i < 4; ++i) { const int g = i * 64 + lane, t = g >> 4, c = g & 15; *(uint4*)(Xl + g * 16) = *(const uint4*)(xn2 + (row0 + t) * D + 128 * s + 8 * c); }
  const unsigned char* tab = ut8 + (size_t)s * (16384 * 128) + 16 * j;
  float* pout = partial + ((size_t)tk0 * 8 + s) * 128 + gi * 16 + 2 * j;
  uint4 ua[16], ub[16];
  ds_issue(ua, El + gi * 16, tab);
#pragma unroll 1
  for (int t = 0; t < 16; t += 2) {
    ds_issue(ub, El + (t + 1) * 128 + gi * 16, tab);
    ds_u_compute(ua, Xl + t * 256 + 32 * j, pout + (size_t)t * 1024, j);
    if (t + 2 < 16) ds_issue(ua, El + (t + 2) * 128 + gi * 16, tab);
    ds_u_compute(ub, Xl + (t + 1) * 256 + 32 * j, pout + (size_t)(t + 1) * 1024, j);
  }
}

__device__ __forceinline__ void ds_v_compute(const uint4 (&v)[16], const float* Wl  , int lane, int j, int gi, size_t row, int tk, int s,
                                             const float* __restrict__ h2, float* __restrict__ out, float* __restrict__ ssq) {
  float w[16];
#pragma unroll
  for (int q = 0; q < 4; ++q) { const float4 f = *(const float4*)(Wl + 4 * q); w[4 * q] = f.x; w[4 * q + 1] = f.y; w[4 * q + 2] = f.z; w[4 * q + 3] = f.w; }
  f32x2v acc[8];
#pragma unroll
  for (int i = 0; i < 8; ++i) acc[i] = (f32x2v){0.f, 0.f};
#pragma unroll
  for (int it = 0; it < 16; ++it) {
    const unsigned wv[4] = {v[it].x, v[it].y, v[it].z, v[it].w};
    const f32x2v w2 = {w[it], w[it]};
#pragma unroll
    for (int q = 0; q < 4; ++q) {
      const f32x2v lo = __builtin_amdgcn_cvt_pk_f32_fp8((int)wv[q], false), hi = __builtin_amdgcn_cvt_pk_f32_fp8((int)wv[q], true);
      acc[2 * q] = __builtin_elementwise_fma(w2, lo, acc[2 * q]); acc[2 * q + 1] = __builtin_elementwise_fma(w2, hi, acc[2 * q + 1]);
    }
  }
  float r4[4] = {0.f, 0.f, 0.f, 0.f};
#pragma unroll
  for (int i = 0; i < 16; ++i) {
    float t = (i & 1) ? acc[i >> 1].y : acc[i >> 1].x;
    t = dpp_add<0x128>(t);
    t += __shfl_xor(t, 16);
    t = half_swap_sum(t);
    if ((i >> 2) == gi) r4[i & 3] = t;
  }
  float ss = 0.f;
  if (gi < 4) {
    const int c0 = 128 * s + 16 * j + 4 * gi;
    const float4 hv = *(const float4*)(h2 + row * D + c0);
    const float4 o = make_float4(hv.x + r4[0], hv.y + r4[1], hv.z + r4[2], hv.w + r4[3]);
    ss = o.x * o.x + o.y * o.y + o.z * o.z + o.w * o.w;
    *(float4*)(out + (size_t)tk * D + c0) = o;
  }
  ss = wave_sum(ss);
  if (lane == 0) ssq[(size_t)tk * 8 + s] = ss;
}
__device__ __forceinline__ void ds_v_chunk(char* wl, int lane, int tk0, int s, const float* __restrict__ h2, const int* __restrict__ eb, const float* __restrict__ wbuf, const unsigned char* __restrict__ vt8,
                                           float* __restrict__ out, float* __restrict__ ssq) {
  const int b = tk0 / SEQ, sq = tk0 - b * SEQ;
  const size_t row0 = (size_t)b * LP + NMETA + sq;
  const int j = lane & 7, gi = lane >> 3;
  int* El = (int*)wl;
  float* Wl = (float*)(wl + 8192);
#pragma unroll
  for (int i = 0; i < 8; ++i) {
    *(int4*)(El + (i * 64 + lane) * 4) = *(const int4*)(eb + row0 * 128 + (i * 64 + lane) * 4);
    *(float4*)(Wl + (i * 64 + lane) * 4) = *(const float4*)(wbuf + (size_t)tk0 * 128 + (i * 64 + lane) * 4);
  }
  const unsigned char* tab = vt8 + (size_t)s * (16384 * 128) + 16 * j;
  uint4 va[16], vb[16];
  ds_issue(va, El + gi * 16, tab);
#pragma unroll 1
  for (int t = 0; t < 16; t += 2) {
    ds_issue(vb, El + (t + 1) * 128 + gi * 16, tab);
    ds_v_compute(va, Wl + t * 128 + gi * 16, lane, j, gi, row0 + t, tk0 + t, s, h2, out, ssq);
    if (t + 2 < 16) ds_issue(va, El + (t + 2) * 128 + gi * 16, tab);
    ds_v_compute(vb, Wl + (t + 1) * 128 + gi * 16, lane, j, gi, row0 + t + 1, tk0 + t + 1, s, h2, out, ssq);
  }
}

__device__ __forceinline__ void p_gather_naive(int blk, const bf16_t* __restrict__ xn2, const float* __restrict__ h2, const int* __restrict__ eb, const float* __restrict__ gb,
                                                      const float* __restrict__ ut, const float* __restrict__ vt, const float* fg, float* out) {
  const int tix = opaque_tid();
  int tk = blk * 4 + ((tix & 255) >> 6), lane = (tix & 255) & 63;
  int b = tk / SEQ, s = tk - b * SEQ;
  size_t row = (size_t)b * LP + NMETA + s;
  float xv[16];
  {
    const uint4* xp = (const uint4*)(xn2 + row * D + lane * 16);
#pragma unroll
    for (int i = 0; i < 2; ++i) {
      uint4 r = xp[i];
      xv[i * 8 + 0] = bf2f(r.x & 0xffffu); xv[i * 8 + 1] = bf2f(r.x >> 16); xv[i * 8 + 2] = bf2f(r.y & 0xffffu); xv[i * 8 + 3] = bf2f(r.y >> 16);
      xv[i * 8 + 4] = bf2f(r.z & 0xffffu); xv[i * 8 + 5] = bf2f(r.z >> 16); xv[i * 8 + 6] = bf2f(r.w & 0xffffu); xv[i * 8 + 7] = bf2f(r.w >> 16);
    }
  }
  float acc[16];
#pragma unroll
  for (int i = 0; i < 16; ++i) acc[i] = 0.f;
  for (int k = 0; k < 128; ++k) {
    int e = eb[row * 128 + k];
    float gate = gb[row * 128 + k];
    const float4* up = (const float4*)(ut + (size_t)e * D + lane * 16);
    float dsum = 0.f;
#pragma unroll
    for (int i = 0; i < 4; ++i) { float4 u = up[i]; dsum += u.x * xv[i * 4] + u.y * xv[i * 4 + 1] + u.z * xv[i * 4 + 2] + u.w * xv[i * 4 + 3]; }
    dsum = wave_sum(dsum);
    float act = 0.5f * dsum * (1.0f + erff(dsum * 0.70710678118654752f));
    float wgt = gate * act;
    const float4* vp = (const float4*)(vt + (size_t)e * D + lane * 16);
#pragma unroll
    for (int i = 0; i < 4; ++i) { float4 v = vp[i]; acc[i * 4] += wgt * v.x; acc[i * 4 + 1] += wgt * v.y; acc[i * 4 + 2] += wgt * v.z; acc[i * 4 + 3] += wgt * v.w; }
  }
  const float4* hp = (const float4*)(h2 + row * D + lane * 16);
  float ss = 0.f;
#pragma unroll
  for (int i = 0; i < 4; ++i) { float4 hv = hp[i]; acc[i * 4] += hv.x; acc[i * 4 + 1] += hv.y; acc[i * 4 + 2] += hv.z; acc[i * 4 + 3] += hv.w; }
#pragma unroll
  for (int i = 0; i < 16; ++i) ss += acc[i] * acc[i];
  ss = wave_sum(ss);
  float rstd = rsqrtf(ss * (1.0f / D) + EPS);
  float4* op = (float4*)(out + ((size_t)b * SEQ + s) * D + lane * 16);
  const float4* gp = (const float4*)(fg + lane * 16);
#pragma unroll
  for (int i = 0; i < 4; ++i) { float4 g = gp[i]; op[i] = make_float4(acc[i * 4] * rstd * g.x, acc[i * 4 + 1] * rstd * g.y, acc[i * 4 + 2] * rstd * g.z, acc[i * 4 + 3] * rstd * g.w); }
}


template <class Epi>
__device__ __forceinline__ void gemm_tile(char* lds, const bf16_t* __restrict__ X, int ldx, const bf16_t* __restrict__ Wt, int ldw, int K, int m0, int n0, const Epi& epi) {
  const int tix = opaque_tid();
  const int tid = tix, lane = tid & 63, wid = tid >> 6;
  const int wm = wid >> 1, wn = wid & 1;
  const int sc = tid & 7, sr = tid >> 3;
  f32x4 acc[4][4];
#pragma unroll
  for (int i = 0; i < 4; ++i)
#pragma unroll
    for (int j = 0; j < 4; ++j) acc[i][j] = (f32x4){0.f, 0.f, 0.f, 0.f};
  uint4 ra[4], rb[2];
  const bf16_t* xp = X + (size_t)(m0 + sr) * ldx + sc * 8;
  const bf16_t* wp = Wt + (size_t)(n0 + sr) * ldw + sc * 8;
  const int nk = K >> 6;
#pragma unroll
  for (int i = 0; i < 4; ++i) ra[i] = *(const uint4*)(xp + (size_t)(64 * i) * ldx);
#pragma unroll
  for (int i = 0; i < 2; ++i) rb[i] = *(const uint4*)(wp + (size_t)(64 * i) * ldw);
#pragma unroll
  for (int i = 0; i < 4; ++i) { int r = sr + 64 * i; *(uint4*)(lds + r * 128 + ((sc ^ ((r >> 1) & 7)) << 4)) = ra[i]; }
#pragma unroll
  for (int i = 0; i < 2; ++i) { int r = sr + 64 * i; *(uint4*)(lds + 32768 + r * 128 + ((sc ^ ((r >> 1) & 7)) << 4)) = rb[i]; }
  __syncthreads();
  const int fr = lane & 15, fq = lane >> 4;
  for (int kt = 0; kt < nk; ++kt) {
    if (kt + 1 < nk) {
#pragma unroll
      for (int i = 0; i < 4; ++i) ra[i] = *(const uint4*)(xp + (size_t)(64 * i) * ldx + (kt + 1) * 64);
#pragma unroll
      for (int i = 0; i < 2; ++i) rb[i] = *(const uint4*)(wp + (size_t)(64 * i) * ldw + (kt + 1) * 64);
    }
    const char* la = lds + (kt & 1) * 49152;
    const char* lb = la + 32768;
#pragma unroll
    for (int kk = 0; kk < 2; ++kk) {
      bf16x8 xa[4], wb[4];
      const int c = kk * 4 + fq;
#pragma unroll
      for (int t = 0; t < 4; ++t) {
        int r = wm * 64 + t * 16 + fr; xa[t] = *(const bf16x8*)(la + r * 128 + ((c ^ ((r >> 1) & 7)) << 4));
        int r2 = wn * 64 + t * 16 + fr; wb[t] = *(const bf16x8*)(lb + r2 * 128 + ((c ^ ((r2 >> 1) & 7)) << 4));
      }
#pragma unroll
      for (int nt = 0; nt < 4; ++nt)
#pragma unroll
        for (int tt = 0; tt < 4; ++tt) acc[nt][tt] = __builtin_amdgcn_mfma_f32_16x16x32_bf16(wb[nt], xa[tt], acc[nt][tt], 0, 0, 0);
    }
    if (kt + 1 < nk) {
      char* lw = lds + ((kt + 1) & 1) * 49152;
#pragma unroll
      for (int i = 0; i < 4; ++i) { int r = sr + 64 * i; *(uint4*)(lw + r * 128 + ((sc ^ ((r >> 1) & 7)) << 4)) = ra[i]; }
#pragma unroll
      for (int i = 0; i < 2; ++i) { int r = sr + 64 * i; *(uint4*)(lw + 32768 + r * 128 + ((sc ^ ((r >> 1) & 7)) << 4)) = rb[i]; }
    }
    __syncthreads();
  }
#pragma unroll
  for (int nt = 0; nt < 4; ++nt)
#pragma unroll
    for (int tt = 0; tt < 4; ++tt) epi(m0 + wm * 64 + tt * 16 + fr, n0 + wn * 64 + nt * 16 + fq * 4, acc[nt][tt]);
}

struct Epi4StoreBf16 { bf16_t* out; int ld; int pad; __device__ __forceinline__ void operator()(int r, int c, f32x4 v) const {
  uint2 w; w.x = pack2(v[0], v[1]); w.y = pack2(v[2], v[3]); *(uint2*)(out + (size_t)r * ld + c) = w; } };
struct Epi4Resid { const float* x; const float* meta; float* h2; __device__ __forceinline__ void operator()(int r, int c, f32x4 v) const {
  const float* src = hrow_ptr(x, meta, r); float4 hv = src ? *(const float4*)(src + c) : make_float4(0.f, 0.f, 0.f, 0.f);
  *(float4*)(h2 + (size_t)r * D + c) = make_float4(hv.x + v[0], hv.y + v[1], hv.z + v[2], hv.w + v[3]); } };


struct EpiBf16 {
  bf16_t* out; int ld; int use_scale; const float* rowss;
  __device__ __forceinline__ void store8(size_t row, int col, const float (&v)[8]) const {
    uint4 w; w.x = cvtpk(v[0], v[1]); w.y = cvtpk(v[2], v[3]); w.z = cvtpk(v[4], v[5]); w.w = cvtpk(v[6], v[7]);
    *(uint4*)(out + row * ld + col) = w;
  }
};
struct EpiResid2 {
  const float* x; const float* meta; float* h2; bf16_t* hb; float* rowss;
  __device__ __forceinline__ void store8(size_t row, int col, const float (&v)[8]) const {
    const float* src = hrow_ptr(x, meta, (int)row);
    const float4 a = *(const float4*)(src + col), b = *(const float4*)(src + col + 4);
    const float o[8] = {a.x + v[0], a.y + v[1], a.z + v[2], a.w + v[3], b.x + v[4], b.y + v[5], b.z + v[6], b.w + v[7]};
    *(float4*)(h2 + row * D + col) = make_float4(o[0], o[1], o[2], o[3]);
    *(float4*)(h2 + row * D + col + 4) = make_float4(o[4], o[5], o[6], o[7]);
    uint4 w; w.x = cvtpk(o[0], o[1]); w.y = cvtpk(o[2], o[3]); w.z = cvtpk(o[4], o[5]); w.w = cvtpk(o[6], o[7]);
    *(uint4*)(hb + row * D + col) = w;
    float ss = 0.f;
#pragma unroll
    for (int i = 0; i < 8; ++i) ss += o[i] * o[i];
    ss = sum8(ss);
    if ((threadIdx.x & 7) == 0) rowss[row * 16 + (col >> 6)] = ss;
  }
};

template <class Epi>
__device__ __forceinline__ void gemm256(char* lds, const bf16_t* __restrict__ X, int ldx, const bf16_t* __restrict__ Wt, int ldw, int K, size_t xrow0, int n0, const Epi& epi) {
  const int tix = opaque_tid();
  const int tid = tix, lane = tid & 63;
  const int wid = __builtin_amdgcn_readfirstlane(tid >> 6);
  const int wm = wid >> 2, wn = wid & 3;
  const int fr = lane & 15, fq = lane >> 4;
  f32x4 acc[4][8];
#pragma unroll
  for (int i = 0; i < 4; ++i)
#pragma unroll
    for (int j = 0; j < 8; ++j) acc[i][j] = (f32x4){0.f, 0.f, 0.f, 0.f};
  const int nk = K >> 6;
  const int prow = lane >> 3, ppos = lane & 7;
  const char* xsrc = (const char*)(X + (xrow0 + 8 * wid + prow) * ldx);
  const char* wsrc = (const char*)(Wt + (size_t)(n0 + 8 * wid + prow) * ldw);
  const unsigned swz = (unsigned)((ppos ^ ((4 * wid + (prow >> 1)) & 7)) << 4);
#define G256_ISSUE(kt, buf) do { \
    _Pragma("unroll") for (int i_ = 0; i_ < 4; ++i_) { \
      __builtin_amdgcn_global_load_lds((const unsigned*)(xsrc + (size_t)(64 * i_) * ldx * 2 + (kt) * 128 + swz), LDSP(unsigned, lds + (buf) * 65536 + (i_ * 8 + wid) * 1024), 16, 0, 0); \
      __builtin_amdgcn_global_load_lds((const unsigned*)(wsrc + (size_t)(64 * i_) * ldw * 2 + (kt) * 128 + swz), LDSP(unsigned, lds + (buf) * 65536 + 32768 + (i_ * 8 + wid) * 1024), 16, 0, 0); \
    } } while (0)
  __syncthreads();
  G256_ISSUE(0, 0);
  __syncthreads();
  for (int kt = 0; kt < nk; ++kt) {
    if (kt + 1 < nk) G256_ISSUE(kt + 1, (kt + 1) & 1);
    const char* la = lds + (kt & 1) * 65536;
    const char* lb = la + 32768;
#pragma unroll
    for (int kk = 0; kk < 2; ++kk) {
      const int c = kk * 4 + fq;
      bf16x8 xa[8], wb[4];
#pragma unroll
      for (int t = 0; t < 8; ++t) { const int r = wm * 128 + t * 16 + fr; xa[t] = *(const bf16x8*)(la + r * 128 + ((c ^ ((r >> 1) & 7)) << 4)); }
#pragma unroll
      for (int t = 0; t < 4; ++t) { const int r = wn * 64 + t * 16 + fr; wb[t] = *(const bf16x8*)(lb + r * 128 + ((c ^ ((r >> 1) & 7)) << 4)); }
#pragma unroll
      for (int nt = 0; nt < 4; ++nt)
#pragma unroll
        for (int tt = 0; tt < 8; ++tt) acc[nt][tt] = __builtin_amdgcn_mfma_f32_16x16x32_bf16(wb[nt], xa[tt], acc[nt][tt], 0, 0, 0);
    }
    __syncthreads();
  }
#undef G256_ISSUE
  char* wl = lds + wid * 16384;
#pragma unroll
  for (int hf = 0; hf < 2; ++hf) {
#pragma unroll
    for (int t4 = 0; t4 < 4; ++t4)
#pragma unroll
      for (int nt = 0; nt < 4; ++nt) {
        const int t = t4 * 16 + fr, c16 = nt * 4 + fq;
        *(f32x4*)(wl + t * 256 + ((c16 ^ (t & 15)) << 4)) = acc[nt][hf * 4 + t4];
      }
#pragma unroll
    for (int i = 0; i < 8; ++i) {
      const int t = 8 * i + (lane >> 3), c8 = lane & 7;
      const f32x4 v0 = *(const f32x4*)(wl + t * 256 + (((2 * c8) ^ (t & 15)) << 4)), v1 = *(const f32x4*)(wl + t * 256 + (((2 * c8 + 1) ^ (t & 15)) << 4));
      const float v[8] = {v0[0], v0[1], v0[2], v0[3], v1[0], v1[1], v1[2], v1[3]};
      epi.store8(xrow0 + wm * 128 + hf * 64 + t, n0 + wn * 64 + 8 * c8, v);
    }
  }
}

__device__ __forceinline__ void meta_proj(char* lds, int blk, const bf16_t* __restrict__ xn1, const bf16_t* __restrict__ wt_in, bf16_t* proj) {
  const int tix = opaque_tid();
  float* red = (float*)lds;
  __syncthreads();
  float part = 0.f;
  const int o = tix % 160, kp = tix / 160;
  if (tix < 480) {
    const int row = o / 10, n = blk * 10 + o % 10;
    const int k0 = kp * 352, k1 = kp == 2 ? 1024 : k0 + 352;
    const bf16_t* xr = xn1 + (size_t)row * D; const bf16_t* wr = wt_in + (size_t)n * D;
    for (int k = k0; k < k1; k += 8) {
      const uint4 a = *(const uint4*)(xr + k), b = *(const uint4*)(wr + k);
      part = dot8(a, b, part);
    }
    red[tix] = part;
  }
  __syncthreads();
  if (tix < 160) {
    const float v = red[tix] + red[tix + 160] + red[tix + 320];
    const int row = tix / 10, n = blk * 10 + tix % 10;
    const bf16_t bv = f2bf(v);
#pragma unroll
    for (int b = 0; b < BATCH; ++b) proj[((size_t)b * LP + row) * INC + n] = bv;
  }
}

__device__ __forceinline__ void p_transpose(int t, float* smem, const float* __restrict__ W, bf16_t* Wt, int K, int N, const float* __restrict__ ksc) {
  const int tix = opaque_tid();
  float (*T)[65] = (float (*)[65])smem;
  const int nbx = N / 64, k0 = (t / nbx) * 64, n0 = (t % nbx) * 64, tid = (tix & 255);
  const int j = tid & 63, i0 = tid >> 6;
#pragma unroll
  for (int ii = 0; ii < 16; ++ii) { int i = i0 + 4 * ii; T[i][j] = W[(size_t)(k0 + i) * N + n0 + j] * (ksc ? ksc[k0 + i] : 1.0f); }
  __syncthreads();
#pragma unroll
  for (int ii = 0; ii < 16; ++ii) { int jj = i0 + 4 * ii; Wt[(size_t)(n0 + jj) * K + k0 + j] = f2bf(T[j][jj]); }
  __syncthreads();
}

__device__ __forceinline__ void grid_bar(unsigned* ctr, unsigned target) {
  asm volatile("s_waitcnt vmcnt(0)" ::: "memory");
  __syncthreads();
  if (threadIdx.x == 0) {
    __builtin_amdgcn_fence(__ATOMIC_RELEASE, "agent");
    asm volatile("s_waitcnt vmcnt(0)" ::: "memory");
    __hip_atomic_fetch_add(ctr, 1u, __ATOMIC_RELAXED, __HIP_MEMORY_SCOPE_AGENT);
    unsigned spins = 0;
    while (__hip_atomic_load(ctr, __ATOMIC_RELAXED, __HIP_MEMORY_SCOPE_AGENT) < target) { __builtin_amdgcn_s_sleep(2); if (++spins > (1u << 24)) break; }
    __builtin_amdgcn_fence(__ATOMIC_ACQUIRE, "agent");
    asm volatile("s_waitcnt vmcnt(0)" ::: "memory");
  }
  __syncthreads();
}

struct Params {
  const float *x, *meta, *g1, *w_in, *lq1, *lk1, *lq2, *lk2, *subg, *conv_w, *conv_b, *gn_g, *gn_b, *w_out, *g2, *wq, *sk, *ut, *vt, *fg;
  float* out; float* scal; bf16_t* r1; bf16_t* r2; float* h2; int* eb; float* gb; bf16_t* wt_in; bf16_t* wt_out; bf16_t* wt_q; bf16_t* skb; unsigned char* ut8; unsigned char* vt8; float* uinv; float* vinv; float* wbuf; float* ssq; bf16_t* hb; float* rowss;
};

__global__ void __launch_bounds__(512, 2) mega(Params p) {
  cg::grid_group grid = cg::this_grid();
  __shared__ __attribute__((aligned(16))) char smem_c[131072];
  float* smem = (float*)smem_c;
  const int G = gridDim.x, vh = threadIdx.x >> 8;
  unsigned* ctr = (unsigned*)(p.scal + 64);
  unsigned nbar = 0;
  bf16_t* xn1 = p.r1; bf16_t* mix = p.r1; bf16_t* proj = p.r2; bf16_t* qp = p.r2;
  for (int b = blockIdx.x; b < ROWS / 2; b += G) p_norm1(b * 2 + vh, smem + 4 * vh, p.x, p.meta, p.g1, xn1, p.lq1, p.lk1, p.lq2, p.lk2, p.scal);
  for (int b = blockIdx.x; b < (640 + 256 + 512) / 2; b += G) {
    const int bb = b * 2 + vh; float* sm = smem + vh * (64 * 65);
    if (bb < 640) p_transpose(bb, sm, p.w_in, p.wt_in, D, INC, nullptr);
    else if (bb < 896) p_transpose(bb - 640, sm, p.w_out, p.wt_out, D, D, nullptr);
    else p_transpose(bb - 896, sm, p.wq, p.wt_q, D, 2048, p.g2);
  }
  p_cvt_bf16(blockIdx.x, G, p.sk, p.skb, (size_t)16 * 128 * 128 / 8);
  p_cvt_fp8_rows(blockIdx.x, G, p.ut, (unsigned*)p.ut8, p.uinv, p.g2);
  p_cvt_fp8_rows(blockIdx.x, G, p.vt, (unsigned*)p.vt8, p.vinv, nullptr);
  grid.sync();
  for (int b = blockIdx.x; b < 128 * 10; b += G) {
    const int mt = b / 10, nt = b - mt * 10;
    gemm256(smem_c, xn1, D, p.wt_in, D, D, (size_t)(mt >> 4) * LP + NMETA + 256 * (mt & 15), nt * 256, EpiBf16{proj, INC, 0, nullptr});
  }
  for (int b = blockIdx.x; b < 256; b += G) meta_proj(smem_c, b, xn1, p.wt_in, proj);
  for (int i = blockIdx.x * 512 + threadIdx.x; i < BATCH * (LP - LREAL) * 128; i += G * 512) {
    const int c = i & 127, r = i >> 7, b = r / (LP - LREAL), pos = LREAL + r - b * (LP - LREAL);
    *(uint4*)(proj + ((size_t)b * LP + pos) * INC + 512 + 8 * c) = make_uint4(0, 0, 0, 0);
  }
  grid_bar(ctr, (unsigned)G * ++nbar);
  {
    const float lam = p.scal[0];
    for (int u = blockIdx.x; u < 256; u += G) {
      const int bh = (u & 7) * 4 + (u >> 6), tp = (u >> 3) & 7;
#pragma unroll 1
      for (int k = 0; k < 4; ++k) {
        const int t = (k == 0) ? 31 - tp : (k == 1) ? 16 + tp : (k == 2) ? 15 - tp : tp;
        attn_unit(smem_c, proj, mix, p.subg, lam, bh >> 2, bh & 3, t);
      }
    }
  }
  for (int u = blockIdx.x; u < BATCH * 128; u += G) conv_unit(smem_c, proj, mix, p.conv_w, p.conv_b, p.gn_g, p.gn_b, u >> 7, NMETA + 32 * (u & 127));
  grid_bar(ctr, (unsigned)G * ++nbar);
  for (int b = blockIdx.x; b < 128 * 4; b += G) {
    const int mt = b >> 2, nt = b & 3;
    gemm256(smem_c, mix, D, p.wt_out, D, D, (size_t)(mt >> 4) * LP + NMETA + 256 * (mt & 15), nt * 256, EpiResid2{p.x, p.meta, p.h2, p.hb, p.rowss});
  }
  grid_bar(ctr, (unsigned)G * ++nbar);
  for (int b = blockIdx.x; b < 128 * 8; b += G) {
    const int mt = b >> 3, nt = b & 7;
    gemm256(smem_c, p.hb, D, p.wt_q, D, D, (size_t)(mt >> 4) * LP + NMETA + 256 * (mt & 15), nt * 256, EpiBf16{qp, 2048, 0, nullptr});
  }
  grid_bar(ctr, (unsigned)G * ++nbar);
  for (int u = blockIdx.x; u < 256 * 8; u += G) {
    const int rt = u >> 3, h = u & 7;
    peer_topk_unit(smem_c, qp, p.skb, p.rowss, p.eb, p.gb, (rt >> 5) * LP + NMETA + 128 * (rt & 31), h);
  }
  grid_bar(ctr, (unsigned)G * ++nbar);
  {
    const int tix = opaque_tid();
    const int lane = tix & 63;
    const int NTOK = BATCH * SEQ;
    float* partial = (float*)qp;
    unsigned* qh = (unsigned*)(p.scal + 128);
    const unsigned x = xcc_id();
    for (int qi = 0; qi < 8; ++qi) {
      const int s = (int)((x + qi) & 7u);
      for (;;) {
        unsigned st = 0;
        if (lane == 0) st = __hip_atomic_fetch_add(qh + s * 16, 32u, __ATOMIC_RELAXED, __HIP_MEMORY_SCOPE_AGENT);
        st = __builtin_amdgcn_readfirstlane(st);
        if (st >= (unsigned)NTOK) break;
        ds_u_chunk(smem_c + (tix >> 6) * 16384, lane, (int)st, s, p.hb, p.eb, p.ut8, partial);
        ds_u_chunk(smem_c + (tix >> 6) * 16384, lane, (int)st + 16, s, p.hb, p.eb, p.ut8, partial);
      }
    }
    grid_bar(ctr, (unsigned)G * ++nbar);
    for (size_t i = (size_t)blockIdx.x * 512 + tix; i < (size_t)NTOK * 128; i += (size_t)G * 512) {
      const int tk = (int)(i >> 7), k = (int)(i & 127);
      const int b = tk / SEQ, sq = tk - b * SEQ;
      const size_t row = (size_t)b * LP + NMETA + sq;
      float a = 0.f;
#pragma unroll
      for (int sl = 0; sl < 8; ++sl) a += partial[((size_t)tk * 8 + sl) * 128 + k];
      const int e = p.eb[row * 128 + k];
      a *= p.uinv[e] * row_rstd(p.rowss, row);
      p.wbuf[i] = p.gb[row * 128 + k] * 0.5f * a * (1.0f + erff(a * 0.70710678118654752f)) * p.vinv[e];
    }
    grid_bar(ctr, (unsigned)G * ++nbar);
    for (int qi = 0; qi < 8; ++qi) {
      const int s = (int)((x + qi) & 7u);
      for (;;) {
        unsigned st = 0;
        if (lane == 0) st = __hip_atomic_fetch_add(qh + (8 + s) * 16, 32u, __ATOMIC_RELAXED, __HIP_MEMORY_SCOPE_AGENT);
        st = __builtin_amdgcn_readfirstlane(st);
        if (st >= (unsigned)NTOK) break;
        ds_v_chunk(smem_c + (tix >> 6) * 16384, lane, (int)st, s, p.h2, p.eb, p.wbuf, p.vt8, p.out, p.ssq);
        ds_v_chunk(smem_c + (tix >> 6) * 16384, lane, (int)st + 16, s, p.h2, p.eb, p.wbuf, p.vt8, p.out, p.ssq);
      }
    }
    grid_bar(ctr, (unsigned)G * ++nbar);
    {
      const int wv = blockIdx.x * 8 + (tix >> 6);
      for (int tk = wv * 2; tk < NTOK; tk += G * 16) {
        float4 o[2][4]; float sv[2];
#pragma unroll
        for (int r = 0; r < 2; ++r) {
#pragma unroll
          for (int q = 0; q < 4; ++q) o[r][q] = ((const float4*)p.out)[(size_t)(tk + r) * 256 + q * 64 + lane];
          sv[r] = lane < 8 ? p.ssq[(size_t)(tk + r) * 8 + lane] : 0.f;
        }
#pragma unroll
        for (int r = 0; r < 2; ++r) {
          const float rstd = rsqrtf(wave_sum(sv[r]) * (1.0f / D) + EPS);
#pragma unroll
          for (int q = 0; q < 4; ++q) {
            const float4 f = ((const float4*)p.fg)[q * 64 + lane];
            float4 v = o[r][q];
            v.x *= rstd * f.x; v.y *= rstd * f.y; v.z *= rstd * f.z; v.w *= rstd * f.w;
            ((float4*)p.out)[(size_t)(tk + r) * 256 + q * 64 + lane] = v;
          }
        }
      }
    }
  }
}

extern "C" void kernel_launch(void* const* d_in, const int* in_sizes, int n_in, void* d_out, int out_size, void* d_ws, size_t ws_size, hipStream_t stream) {
  static int grid_blocks = 0;
  if (!grid_blocks) {
    int dev = 0, cus = 0, per_cu = 0;
    hipGetDevice(&dev);
    hipDeviceGetAttribute(&cus, hipDeviceAttributeMultiprocessorCount, dev);
    hipOccupancyMaxActiveBlocksPerMultiprocessor(&per_cu, mega, 512, 0);
    if (per_cu > 1) per_cu = 1;
    if (per_cu < 1) per_cu = 1;
    grid_blocks = cus * per_cu;
  }
  Params p{};
  const float** pp = (const float**)&p;
  for (int i = 0; i < 20; ++i) pp[i] = (const float*)d_in[i];
  p.out = (float*)d_out;
  char* ws = (char*)d_ws;
  size_t off = 0;
  p.scal = (float*)(ws + off); off += 4096;
  p.r1 = (bf16_t*)(ws + off); off += (size_t)ROWS * D * 2;
  p.r2 = (bf16_t*)(ws + off); off += (size_t)ROWS * INC * 2;
  p.h2 = (float*)(ws + off); off += (size_t)ROWS * D * 4;
  p.wt_in = (bf16_t*)(ws + off); off += (size_t)INC * D * 2;
  p.wt_out = (bf16_t*)(ws + off); off += (size_t)D * D * 2;
  p.wt_q = (bf16_t*)(ws + off); off += (size_t)2048 * D * 2;
  p.skb = (bf16_t*)(ws + off); off += (size_t)16 * 128 * 128 * 2;
  p.ut8 = (unsigned char*)(ws + off); off += (size_t)16384 * D;
  p.vt8 = (unsigned char*)(ws + off); off += (size_t)16384 * D;
  p.uinv = (float*)(ws + off); off += 65536;
  p.vinv = (float*)(ws + off); off += 65536;
  p.wbuf = (float*)(ws + off); off += (size_t)BATCH * SEQ * 128 * 4;
  p.ssq = (float*)(ws + off); off += (size_t)BATCH * SEQ * 8 * 4;
  p.hb = (bf16_t*)(ws + off); off += (size_t)ROWS * D * 2;
  p.rowss = (float*)(ws + off); off += (size_t)ROWS * 16 * 4;
  p.eb = (int*)((char*)p.r2 + (size_t)ROWS * 2048 * 2);
  p.gb = (float*)((char*)p.eb + (size_t)ROWS * 128 * 4);
  hipMemsetAsync(d_ws, 0, 4096, stream);
  void* args[] = {&p};
  hipError_t e = hipLaunchCooperativeKernel((void*)mega, dim3(grid_blocks), dim3(512), args, 0, stream);
  if (e != hipSuccess) fprintf(stderr, "cooperative launch failed: %s (grid %d)\n", hipGetErrorString(e), grid_blocks);
}
```

```cpp
#include <hip/hip_runtime.h>
#include <hip/hip_cooperative_groups.h>
#include <cstdio>
namespace cg = cooperative_groups;
#include <stdint.h>
#include <math.h>

typedef unsigned short bf16_t;
typedef short bf16x8 __attribute__((ext_vector_type(8)));
typedef float f32x4 __attribute__((ext_vector_type(4)));

constexpr int D = 1024, BATCH = 8, SEQ = 4096, NMETA = 16, LREAL = NMETA + SEQ  , LP = 4224, ROWS = BATCH * LP;
constexpr int INC = 2560;
constexpr float EPS = 1e-6f;
constexpr float LAM_INIT = 0.2f;

__device__ __forceinline__ float bf2f(unsigned v) { return __uint_as_float(v << 16); }
__device__ __forceinline__ bf16_t f2bf(float f) { unsigned u = __float_as_uint(f); u += 0x7fffu + ((u >> 16) & 1u); return (bf16_t)(u >> 16); }
__device__ __forceinline__ unsigned pack2(float a, float b) { return (unsigned)f2bf(a) | ((unsigned)f2bf(b) << 16); }

__device__ __forceinline__ float wave_sum(float v) {
#pragma unroll
  for (int o = 32; o >= 1; o >>= 1) v += __shfl_xor(v, o);
  return v;
}
__device__ __forceinline__ float wave_max(float v) {
#pragma unroll
  for (int o = 32; o >= 1; o >>= 1) v = fmaxf(v, __shfl_xor(v, o));
  return v;
}

template <int CTRL> __device__ __forceinline__ float dpp_add(float v) { return v + __builtin_bit_cast(float, __builtin_amdgcn_update_dpp(0, __builtin_bit_cast(int, v), CTRL, 0xf, 0xf, true)); }
__device__ __forceinline__ float sum8(float v) { v = dpp_add<0x141>(v); v = dpp_add<0xB1>(v); v = dpp_add<0x4E>(v); return v; }
typedef __bf16 bf16v2 __attribute__((ext_vector_type(2)));
__device__ __forceinline__ float dot8(uint4 a, uint4 b, float acc) {
  acc = __builtin_amdgcn_fdot2_f32_bf16(__builtin_bit_cast(bf16v2, a.x), __builtin_bit_cast(bf16v2, b.x), acc, false);
  acc = __builtin_amdgcn_fdot2_f32_bf16(__builtin_bit_cast(bf16v2, a.y), __builtin_bit_cast(bf16v2, b.y), acc, false);
  acc = __builtin_amdgcn_fdot2_f32_bf16(__builtin_bit_cast(bf16v2, a.z), __builtin_bit_cast(bf16v2, b.z), acc, false);
  acc = __builtin_amdgcn_fdot2_f32_bf16(__builtin_bit_cast(bf16v2, a.w), __builtin_bit_cast(bf16v2, b.w), acc, false);
  return acc;
}
__device__ __forceinline__ float row_rstd(const float* __restrict__ rowss, size_t row) {
  const float4 a = *(const float4*)(rowss + row * 16), b = *(const float4*)(rowss + row * 16 + 4), c = *(const float4*)(rowss + row * 16 + 8), d = *(const float4*)(rowss + row * 16 + 12);
  const float t = ((a.x + a.y) + (a.z + a.w)) + ((b.x + b.y) + (b.z + b.w)) + ((c.x + c.y) + (c.z + c.w)) + ((d.x + d.y) + (d.z + d.w));
  return rsqrtf(t * (1.0f / D) + EPS);
}
__device__ __forceinline__ float row16_sum(float v) {
  v += __builtin_bit_cast(float, __builtin_amdgcn_update_dpp(0, __builtin_bit_cast(int, v), 0x128, 0xf, 0xf, true));
  v += __builtin_bit_cast(float, __builtin_amdgcn_update_dpp(0, __builtin_bit_cast(int, v), 0x124, 0xf, 0xf, true));
  v += __builtin_bit_cast(float, __builtin_amdgcn_update_dpp(0, __builtin_bit_cast(int, v), 0x122, 0xf, 0xf, true));
  v += __builtin_bit_cast(float, __builtin_amdgcn_update_dpp(0, __builtin_bit_cast(int, v), 0x121, 0xf, 0xf, true));
  return v;
}
__device__ __forceinline__ int opaque_tid() { int t = threadIdx.x; asm volatile("" : "+v"(t)); return t; }

__device__ __forceinline__ const float* hrow_ptr(const float* x, const float* meta, int row) {
  int b = row / LP, pos = row - b * LP;
  if (pos < NMETA) return meta + (size_t)pos * D;
  if (pos < LREAL) return x + ((size_t)b * SEQ + (pos - NMETA)) * D;
  return nullptr;
}

__device__ __forceinline__ void p_norm1(int blk, float* red, const float* x, const float* meta, const float* g1, bf16_t* xn1,
                                               const float* lq1, const float* lk1, const float* lq2, const float* lk2, float* scal) {
  const int tix = opaque_tid();
  int row = blk, tid = (tix & 255);
  __syncthreads();
  const float* src = hrow_ptr(x, meta, row);
  float4 v = src ? ((const float4*)src)[tid] : make_float4(0.f, 0.f, 0.f, 0.f);
  float ss = v.x * v.x + v.y * v.y + v.z * v.z + v.w * v.w;
  ss = wave_sum(ss);
  if ((tid & 63) == 0) red[tid >> 6] = ss;
  __syncthreads();
  float tot = red[0] + red[1] + red[2] + red[3];
  float rstd = rsqrtf(tot * (1.0f / D) + EPS);
  float4 g = ((const float4*)g1)[tid];
  uint2 o; o.x = pack2(v.x * rstd * g.x, v.y * rstd * g.y); o.y = pack2(v.z * rstd * g.z, v.w * rstd * g.w);
  ((uint2*)(xn1 + (size_t)row * D))[tid] = o;
  if (row == 0 && tid < 64) {
    float a = lq1[tid] * lk1[tid], b2 = lq2[tid] * lk2[tid];
    a = wave_sum(a); b2 = wave_sum(b2);
    if (tid == 0) scal[0] = expf(a) - expf(b2) + LAM_INIT;
  }
}


typedef float f32x16 __attribute__((ext_vector_type(16)));
typedef short v4i16_t __attribute__((ext_vector_type(4)));
typedef __bf16 bf16v2_t __attribute__((ext_vector_type(2)));
typedef float f32x2_t __attribute__((ext_vector_type(2)));
#define LDSP(T, p) ((__attribute__((address_space(3))) T*)(p))
#define MFMA32(a, b, c) __builtin_amdgcn_mfma_f32_32x32x16_bf16((a), (b), (c), 0, 0, 0)
__device__ __forceinline__ unsigned cvtpk(float lo, float hi) { f32x2_t v = {lo, hi}; return __builtin_bit_cast(unsigned, __builtin_convertvector(v, bf16v2_t)); }
__device__ __forceinline__ float half_swap_max(float m) { auto rr = __builtin_amdgcn_permlane32_swap(__float_as_uint(m), __float_as_uint(m), false, false); return fmaxf(__uint_as_float(rr[0]), __uint_as_float(rr[1])); }
__device__ __forceinline__ float half_swap_sum(float m) { auto rr = __builtin_amdgcn_permlane32_swap(__float_as_uint(m), __float_as_uint(m), false, false); return __uint_as_float(rr[0]) + __uint_as_float(rr[1]); }

__device__ __forceinline__ void attn_issue_kv(char* kvbuf, const bf16_t* __restrict__ kvrow0  , int tid, int wid) {
  const char* base = (const char*)kvrow0;
#pragma unroll
  for (int i = 0; i < 2; ++i) {
    const int g = i * 512 + tid, row = g >> 4, pos = g & 15;
    const unsigned offk = (unsigned)(row * (INC * 2) + 1024 + ((pos ^ (row & 15)) << 4));
    const unsigned offv = (unsigned)(row * (INC * 2) + 2048 + ((pos ^ ((row & 3) << 2)) << 4));
    __builtin_amdgcn_global_load_lds((const unsigned*)(base + offk), LDSP(unsigned, kvbuf + (i * 512 + wid * 64) * 16), 16, 0, 0);
    __builtin_amdgcn_global_load_lds((const unsigned*)(base + offv), LDSP(unsigned, kvbuf + 16384 + (i * 512 + wid * 64) * 16), 16, 0, 0);
  }
}

template <bool MASKED>
__device__ __forceinline__ void attn_map(f32x16 (&o)[4], float& mref_io, float& l_io, const char* qbase, int qsw, const char* kb, const char* vb, int c, int kq, float sl8, int lane, int r32, int hi) {
  const float c1 = 0.125f * 1.4426950408889634f;
  asm volatile("" : "+v"(qsw), "+v"(lane));
  f32x16 s0, s1;
  {
    const float a1 = sl8, a2 = 2.0f * sl8, a3 = 3.0f * sl8, b8 = 8.0f * sl8;
    float gb = sl8 * (float)kq;
#pragma unroll
    for (int g = 0; g < 4; ++g) { s0[4 * g] = gb; s0[4 * g + 1] = gb + a1; s0[4 * g + 2] = gb + a2; s0[4 * g + 3] = gb + a3; gb += b8; }
#pragma unroll
    for (int g = 0; g < 4; ++g) { s1[4 * g] = gb; s1[4 * g + 1] = gb + a1; s1[4 * g + 2] = gb + a2; s1[4 * g + 3] = gb + a3; gb += b8; }
    if (MASKED) {
#pragma unroll
      for (int r = 0; r < 16; ++r) { s0[r] = s0[r] > 0.f ? -1e30f : s0[r]; s1[r] = s1[r] > 0.f ? -1e30f : s1[r]; }
    }
  }
#pragma unroll
  for (int ks = 0; ks < 4; ++ks) {
    const int ch = c * 8 + ks * 2 + hi;
    bf16x8 bq = *(const bf16x8*)(qbase + ((ch ^ qsw) << 4));
    bf16x8 ka0 = *(const bf16x8*)(kb + r32 * 256 + ((ch ^ qsw) << 4));
    bf16x8 ka1 = *(const bf16x8*)(kb + (32 + r32) * 256 + ((ch ^ qsw) << 4));
    s0 = MFMA32(ka0, bq, s0);
    s1 = MFMA32(ka1, bq, s1);
    __builtin_amdgcn_sched_barrier(0);
  }
  float mx = fmaxf(s0[0], s1[0]);
#pragma unroll
  for (int r = 1; r < 16; ++r) mx = fmaxf(mx, fmaxf(s0[r], s1[r]));
  mx = half_swap_max(mx);
  float mref = mref_io;
  if (__any((mx - mref) * c1 > 6.0f)) {
    const float mn = fmaxf(mref, mx);
    const float alpha = exp2f((mref - mn) * c1);
    l_io *= alpha;
#pragma unroll
    for (int i = 0; i < 4; ++i)
#pragma unroll
      for (int r = 0; r < 16; ++r) o[i][r] *= alpha;
    mref = mn; mref_io = mn;
  }
  const float nm = -mref * c1;
  float ls = 0.f;
#pragma unroll
  for (int r = 0; r < 16; ++r) { s0[r] = __builtin_amdgcn_exp2f(fmaf(s0[r], c1, nm)); s1[r] = __builtin_amdgcn_exp2f(fmaf(s1[r], c1, nm)); ls += s0[r] + s1[r]; }
  l_io += ls;
  const int q4 = (lane & 15) >> 2, g1 = (lane >> 4) & 1, p4 = lane & 3;
#pragma unroll
  for (int kk = 0; kk < 4; ++kk) {
    const int key0 = 16 * kk + 4 * hi + q4;
    uint4 pwv;
    if (kk < 2) { pwv.x = cvtpk(s0[8 * kk], s0[8 * kk + 1]); pwv.y = cvtpk(s0[8 * kk + 2], s0[8 * kk + 3]); pwv.z = cvtpk(s0[8 * kk + 4], s0[8 * kk + 5]); pwv.w = cvtpk(s0[8 * kk + 6], s0[8 * kk + 7]); }
    else { const int k2 = kk - 2; pwv.x = cvtpk(s1[8 * k2], s1[8 * k2 + 1]); pwv.y = cvtpk(s1[8 * k2 + 2], s1[8 * k2 + 3]); pwv.z = cvtpk(s1[8 * k2 + 4], s1[8 * k2 + 5]); pwv.w = cvtpk(s1[8 * k2 + 6], s1[8 * k2 + 7]); }
    const bf16x8 pb = __builtin_bit_cast(bf16x8, pwv);
#pragma unroll
    for (int dvt = 0; dvt < 4; ++dvt) {
      const int c8 = 8 * (dvt ^ q4) + 4 * g1 + p4;
      v4i16_t lo = __builtin_amdgcn_ds_read_tr16_b64_v4i16(LDSP(v4i16_t, vb + key0 * 256 + c8 * 8));
      v4i16_t hi4 = __builtin_amdgcn_ds_read_tr16_b64_v4i16(LDSP(v4i16_t, vb + (key0 + 8) * 256 + c8 * 8));
      bf16x8 va = (bf16x8){lo[0], lo[1], lo[2], lo[3], hi4[0], hi4[1], hi4[2], hi4[3]};
      o[dvt] = MFMA32(va, pb, o[dvt]);
    }
    __builtin_amdgcn_sched_barrier(0);
  }
}

__device__ __forceinline__ void attn_unit(char* lds, const bf16_t* __restrict__ proj, bf16_t* mix, const float* __restrict__ subg, float lam, int b, int h, int t) {
  const int tix = opaque_tid();
  const int tid = tix, lane = tid & 63, r32 = lane & 31, hi = lane >> 5;
  const int wid = __builtin_amdgcn_readfirstlane(tid >> 6);
  const int c = wid >> 2, qg = wid & 3;
  const int q0 = NMETA + 128 * t, qw0 = q0 + 32 * qg, qpos = qw0 + r32;
  const size_t rowb = (size_t)b * LP;
  const int NT = 2 * t + 3;
  char* Qs = lds;
  char* KV = lds + 32768;
  const float sl8 = exp2f(1.0f - 2.0f * (float)h);
  __syncthreads();
  attn_issue_kv(KV, proj + rowb * INC + h * 128, tid, wid);
#pragma unroll
  for (int i = 0; i < 4; ++i) {
    const int g = i * 512 + tid, row = g >> 4, pos = g & 15;
    uint4 v = *(const uint4*)(proj + (rowb + q0 + row) * INC + h * 128 + ((pos ^ (row & 15)) << 3));
    *(uint4*)(Qs + g * 16) = v;
  }
  f32x16 o[4];
#pragma unroll
  for (int i = 0; i < 4; ++i)
#pragma unroll
    for (int r = 0; r < 16; ++r) o[i][r] = 0.f;
  float m = -1e30f, l = 0.f;
  const int qrow = 32 * qg + r32;
  const char* qbase = Qs + qrow * 256;
  const int qsw = qrow & 15;
  for (int j = 0; j < NT; ++j) {
    __syncthreads();
    if (j + 1 < NT) attn_issue_kv(KV + ((j + 1) & 1) * 32768, proj + (rowb + 64 * (j + 1)) * INC + h * 128, tid, wid);
    if (64 * j > qw0 + 31) continue;
    const char* kb = KV + (j & 1) * 32768;
    const char* vb = kb + 16384;
    const int kq = 64 * j + 4 * hi - qpos;
    if (64 * j + 63 > qw0) attn_map<true>(o, m, l, qbase, qsw, kb, vb, c, kq, sl8, lane, r32, hi);
    else attn_map<false>(o, m, l, qbase, qsw, kb, vb, c, kq, sl8, lane, r32, hi);
  }
  l = half_swap_sum(l);
  const float sc = (c == 0 ? 1.0f : lam) / l;
  __syncthreads();
  float* X = (float*)(lds + 32768);
  if (c == 1) {
#pragma unroll
    for (int i = 0; i < 4; ++i)
#pragma unroll
      for (int r = 0; r < 16; ++r) X[(qg * 64 + i * 16 + r) * 64 + lane] = o[i][r] * sc;
  }
  __syncthreads();
  if (c == 0) {
    float ss = 0.f;
#pragma unroll
    for (int i = 0; i < 4; ++i) {
#pragma unroll
      for (int r = 0; r < 16; ++r) { float v = o[i][r] * sc - X[(qg * 64 + i * 16 + r) * 64 + lane]; o[i][r] = v; ss += v * v; }
      __builtin_amdgcn_sched_barrier(0);
    }
    ss = half_swap_sum(ss);
    const float rstd = rsqrtf(ss * (1.0f / 128.0f) + EPS) * (1.0f - LAM_INIT);
    bf16_t* orow = mix + (rowb + qpos) * D + h * 128;
#pragma unroll
    for (int i = 0; i < 4; ++i) {
#pragma unroll
      for (int g = 0; g < 4; ++g) {
        const int dv0 = 32 * i + 8 * g + 4 * hi;
        const float4 sg = *(const float4*)(subg + dv0);
        uint2 w; w.x = cvtpk(o[i][4 * g] * rstd * sg.x, o[i][4 * g + 1] * rstd * sg.y); w.y = cvtpk(o[i][4 * g + 2] * rstd * sg.z, o[i][4 * g + 3] * rstd * sg.w);
        *(uint2*)(orow + dv0) = w;
      }
      __builtin_amdgcn_sched_barrier(0);
    }
  }
}


__device__ __forceinline__ void conv_unit(char* lds, const bf16_t* __restrict__ proj, bf16_t* mix, const float* __restrict__ cw, const float* __restrict__ cb,
                                          const float* __restrict__ gng, const float* __restrict__ gnb, int b, int pos0) {
  const int tix = opaque_tid();
  const int c = tix;
  float* U = (float*)lds;
  __syncthreads();
  {
    const int lane = tix & 63, wv = tix >> 6;
    uint4 ra[8], rg[8];
#pragma unroll
    for (int i = 0; i < 8; ++i) {
      const int r = wv + 8 * i, pos = pos0 - 30 + r;
      ra[i] = make_uint4(0, 0, 0, 0); rg[i] = make_uint4(0, 0, 0, 0);
      if (r < 62 && pos >= 0) {
        const bf16_t* pr = proj + ((size_t)b * LP + pos) * INC + 8 * lane;
        ra[i] = *(const uint4*)(pr + 1536); rg[i] = *(const uint4*)(pr + 2048);
      }
    }
#pragma unroll
    for (int i = 0; i < 8; ++i) {
      const int r = wv + 8 * i;
      if (r < 62) {
        const unsigned av[4] = {ra[i].x, ra[i].y, ra[i].z, ra[i].w}, gv[4] = {rg[i].x, rg[i].y, rg[i].z, rg[i].w};
        float u[8];
#pragma unroll
        for (int q = 0; q < 4; ++q) {
          const float a0 = __uint_as_float(av[q] << 16), a1 = __uint_as_float(av[q] & 0xffff0000u), g0 = __uint_as_float(gv[q] << 16), g1 = __uint_as_float(gv[q] & 0xffff0000u);
          u[2 * q] = a0 / (1.0f + __expf(-g0)); u[2 * q + 1] = a1 / (1.0f + __expf(-g1));
        }
        *(float4*)(U + r * 512 + 8 * lane) = make_float4(u[0], u[1], u[2], u[3]);
        *(float4*)(U + r * 512 + 8 * lane + 4) = make_float4(u[4], u[5], u[6], u[7]);
      }
    }
  }
  float w[31];
#pragma unroll
  for (int j = 0; j < 31; ++j) w[j] = cw[j * 512 + c];
  const float bias = cb[c], gg = gng[c], gb2 = gnb[c];
  __syncthreads();
#pragma unroll 1
  for (int t0 = 0; t0 < 32; t0 += 4) {
    float y[4] = {bias, bias, bias, bias};
#pragma unroll
    for (int r = 0; r < 34; ++r) {
      const float u = U[(t0 + r) * 512 + c];
#pragma unroll
      for (int q = 0; q < 4; ++q) { const int j = r - q; if (j >= 0 && j < 31) y[q] = fmaf(w[j], u, y[q]); }
    }
#pragma unroll
    for (int q = 0; q < 4; ++q) {
      float sm = row16_sum(y[q]);
      sm += __shfl_xor(sm, 16); sm = half_swap_sum(sm);
      const float d = y[q] - sm * (1.0f / 64.0f);
      float vr = row16_sum(d * d);
      vr += __shfl_xor(vr, 16); vr = half_swap_sum(vr);
      const float n = d * rsqrtf(vr * (1.0f / 64.0f) + EPS) * gg + gb2;
      mix[((size_t)b * LP + pos0 + t0 + q) * D + 512 + c] = f2bf(n / (1.0f + __expf(-n)));
    }
  }
}

__device__ __forceinline__ void p_conv_naive(int blk, const bf16_t* __restrict__ proj, bf16_t* mix, const float* cw, const float* cb, const float* gg_, const float* gb_) {
  const int tix = opaque_tid();
  int row = blk, tid = (tix & 255);
  int b = row / LP, pos = row - b * LP;
  int c0 = tid * 2;
  unsigned* outp = (unsigned*)(mix + (size_t)row * D + 512 + c0);
  if (pos >= LREAL) { *outp = 0u; return; }
  float y0 = cb[c0], y1 = cb[c0 + 1];
  for (int j = 0; j < 31; ++j) {
    int p = pos - 30 + j;
    if (p < 0) continue;
    const bf16_t* pr = proj + ((size_t)b * LP + p) * INC;
    unsigned a = *(const unsigned*)(pr + 1536 + c0), g = *(const unsigned*)(pr + 2048 + c0);
    float a0 = bf2f(a & 0xffffu), a1 = bf2f(a >> 16), g0 = bf2f(g & 0xffffu), g1 = bf2f(g >> 16);
    float u0 = a0 / (1.0f + __expf(-g0)), u1 = a1 / (1.0f + __expf(-g1));
    y0 += cw[j * 512 + c0] * u0; y1 += cw[j * 512 + c0 + 1] * u1;
  }
  float s = y0 + y1;
#pragma unroll
  for (int o = 16; o >= 1; o >>= 1) s += __shfl_xor(s, o);
  float mu = s * (1.0f / 64.0f);
  float d0 = y0 - mu, d1 = y1 - mu;
  float v = d0 * d0 + d1 * d1;
#pragma unroll
  for (int o = 16; o >= 1; o >>= 1) v += __shfl_xor(v, o);
  float rstd = rsqrtf(v * (1.0f / 64.0f) + EPS);
  float n0 = d0 * rstd * gg_[c0] + gb_[c0], n1 = d1 * rstd * gg_[c0 + 1] + gb_[c0 + 1];
  float r0 = n0 / (1.0f + __expf(-n0)), r1 = n1 / (1.0f + __expf(-n1));
  *outp = pack2(r0, r1);
}

__device__ __forceinline__ void p_norm2(int blk, float* red, const float* h2, const float* g2, bf16_t* xn2) {
  const int tix = opaque_tid();
  int row = blk, tid = (tix & 255);
  __syncthreads();
  float4 v = ((const float4*)(h2 + (size_t)row * D))[tid];
  float ss = v.x * v.x + v.y * v.y + v.z * v.z + v.w * v.w;
  ss = wave_sum(ss);
  if ((tid & 63) == 0) red[tid >> 6] = ss;
  __syncthreads();
  float tot = red[0] + red[1] + red[2] + red[3];
  float rstd = rsqrtf(tot * (1.0f / D) + EPS);
  float4 g = ((const float4*)g2)[tid];
  uint2 o; o.x = pack2(v.x * rstd * g.x, v.y * rstd * g.y); o.y = pack2(v.z * rstd * g.z, v.w * rstd * g.w);
  ((uint2*)(xn2 + (size_t)row * D))[tid] = o;
}

__device__ __forceinline__ void p_topk_naive(int blk, const bf16_t* __restrict__ qp, const float* __restrict__ sk, int* eb, float* gb) {
  const int tix = opaque_tid();
  int w = blk * 4 + ((tix & 255) >> 6), lane = (tix & 255) & 63;
  int row = w >> 3, h = w & 7;
  int pos = row % LP;
  if (pos < NMETA || pos >= LREAL) return;
  const float NEG = -3.0e38f;
  float top[2];
#pragma unroll
  for (int p = 0; p < 2; ++p) {
    const bf16_t* qv = qp + (size_t)row * 2048 + h * 256 + p * 128;
    const float* k0 = sk + ((size_t)(h * 2 + p) * 128 + lane) * 128;
    const float* k1 = k0 + 64 * 128;
    float s0 = 0.f, s1 = 0.f;
    for (int d = 0; d < 128; d += 8) {
      uint4 r = *(const uint4*)(qv + d);
      float qf[8] = {bf2f(r.x & 0xffffu), bf2f(r.x >> 16), bf2f(r.y & 0xffffu), bf2f(r.y >> 16), bf2f(r.z & 0xffffu), bf2f(r.z >> 16), bf2f(r.w & 0xffffu), bf2f(r.w >> 16)};
      float4 a0 = *(const float4*)(k0 + d), a1 = *(const float4*)(k0 + d + 4), b0 = *(const float4*)(k1 + d), b1 = *(const float4*)(k1 + d + 4);
      s0 += qf[0] * a0.x + qf[1] * a0.y + qf[2] * a0.z + qf[3] * a0.w + qf[4] * a1.x + qf[5] * a1.y + qf[6] * a1.z + qf[7] * a1.w;
      s1 += qf[0] * b0.x + qf[1] * b0.y + qf[2] * b0.z + qf[3] * b0.w + qf[4] * b1.x + qf[5] * b1.y + qf[6] * b1.z + qf[7] * b1.w;
    }
    float v0 = __uint_as_float((__float_as_uint(s0) & ~127u) | (unsigned)lane);
    float v1 = __uint_as_float((__float_as_uint(s1) & ~127u) | (unsigned)(lane + 64));
    float t = NEG;
    for (int it = 0; it < 16; ++it) {
      float m = wave_max(fmaxf(v0, v1));
      if (lane == it) t = m;
      if (v0 == m) v0 = NEG;
      if (v1 == m) v1 = NEG;
    }
    top[p] = t;
  }
  int ci = lane >> 2, jb = (lane & 3) * 4;
  float av = __uint_as_float(__float_as_uint(__shfl(top[0], ci)) & ~127u);
  float c[4];
#pragma unroll
  for (int jj = 0; jj < 4; ++jj) {
    float bv = __uint_as_float(__float_as_uint(__shfl(top[1], jb + jj)) & ~127u);
    float s = av + bv;
    c[jj] = __uint_as_float((__float_as_uint(s) & ~255u) | (unsigned)(ci * 16 + jb + jj));
  }
  float ct = NEG;
  for (int it = 0; it < 16; ++it) {
    float m = wave_max(fmaxf(fmaxf(c[0], c[1]), fmaxf(c[2], c[3])));
    if (lane == it) ct = m;
#pragma unroll
    for (int jj = 0; jj < 4; ++jj) if (c[jj] == m) c[jj] = NEG;
  }
  unsigned cbits = __float_as_uint(ct);
  int cidx = cbits & 255u;
  float cval = __uint_as_float(cbits & ~255u);
  int i1 = __float_as_uint(__shfl(top[0], (cidx >> 4) & 15)) & 127u;
  int i2 = __float_as_uint(__shfl(top[1], cidx & 15)) & 127u;
  float mx = __shfl(cval, 0);
  float ex = lane < 16 ? __expf(cval - mx) : 0.f;
  float sum = wave_sum(ex);
  if (lane < 16) {
    eb[((size_t)row * 8 + h) * 16 + lane] = i1 * 128 + i2;
    gb[((size_t)row * 8 + h) * 16 + lane] = ex / sum;
  }
}


__device__ __forceinline__ void ce_desc(float& a, float& b) { const float hi = fmaxf(a, b), lo = fminf(a, b); a = hi; b = lo; }
__device__ __forceinline__ void ce_asc(float& a, float& b) { const float hi = fmaxf(a, b), lo = fminf(a, b); a = lo; b = hi; }
template <int N> __device__ __forceinline__ void bitonic_sort_desc(float (&v)[N]) {
#pragma unroll
  for (int k = 2; k <= N; k <<= 1)
#pragma unroll
    for (int j = k >> 1; j > 0; j >>= 1)
#pragma unroll
      for (int i = 0; i < N; ++i) { const int l = i ^ j; if (l > i) { if ((i & k) == 0) ce_desc(v[i], v[l]); else ce_asc(v[i], v[l]); } }
}
template <int N> __device__ __forceinline__ void bitonic_merge_desc(float (&v)[N]) {
#pragma unroll
  for (int j = N >> 1; j > 0; j >>= 1)
#pragma unroll
    for (int i = 0; i < N; ++i) { const int l = i ^ j; if (l > i) ce_desc(v[i], v[l]); }
}
__device__ __forceinline__ void cep_desc(float& a, float& b, int& pa, int& pb) { const bool sw = b > a; const float hi = sw ? b : a, lo = sw ? a : b; const int ph = sw ? pb : pa, pl = sw ? pa : pb; a = hi; b = lo; pa = ph; pb = pl; }
__device__ __forceinline__ void cep_asc(float& a, float& b, int& pa, int& pb) { const bool sw = b < a; const float lo = sw ? b : a, hi = sw ? a : b; const int pl = sw ? pb : pa, ph = sw ? pa : pb; a = lo; b = hi; pa = pl; pb = ph; }
template <int N> __device__ __forceinline__ void bitonic_sortp_desc(float (&v)[N], int (&q)[N]) {
#pragma unroll
  for (int k = 2; k <= N; k <<= 1)
#pragma unroll
    for (int j = k >> 1; j > 0; j >>= 1)
#pragma unroll
      for (int i = 0; i < N; ++i) { const int l = i ^ j; if (l > i) { if ((i & k) == 0) cep_desc(v[i], v[l], q[i], q[l]); else cep_asc(v[i], v[l], q[i], q[l]); } }
}
template <int N> __device__ __forceinline__ void bitonic_mergep_desc(float (&v)[N], int (&q)[N]) {
#pragma unroll
  for (int j = N >> 1; j > 0; j >>= 1)
#pragma unroll
    for (int i = 0; i < N; ++i) { const int l = i ^ j; if (l > i) cep_desc(v[i], v[l], q[i], q[l]); }
}
__host__ __device__ constexpr int cand_slot(int i, int j) { int s = 0; for (int ii = 0; ii < i; ++ii) s += 16 / (ii + 1); return s + j; }

__device__ __forceinline__ void peer_topk_unit(char* lds, const bf16_t* __restrict__ qp, const bf16_t* __restrict__ skb, const float* __restrict__ rowss, int* eb, float* gb, int row0, int h) {
  const int tix = opaque_tid();
  const int tid = tix, lane = tid & 63, wid = tid >> 6, fr = lane & 15, fq = lane >> 4;
  __syncthreads();
#pragma unroll
  for (int i = 0; i < 8; ++i) {
    const int g = i * 512 + tid, row = g >> 4, pos = g & 15;
    *(uint4*)(lds + g * 16) = *(const uint4*)(skb + ((size_t)(h * 2) * 128 + row) * 128 + ((pos ^ (row & 15)) << 3));
  }
  if (tid < 64) {
    int i = 0, base = 0;
    while (i < 15 && tid >= base + 16 / (i + 1)) { base += 16 / (i + 1); ++i; }
    ((int*)(lds + 65536))[tid] = (i << 4) | ((tid - base) & 15);
  }
  __syncthreads();
  const int tok = row0 + wid * 16 + fr;
  float top[2][16];
#pragma unroll
  for (int p = 0; p < 2; ++p) {
    f32x4 acc[8];
#pragma unroll
    for (int i = 0; i < 8; ++i) acc[i] = (f32x4){0.f, 0.f, 0.f, 0.f};
    const bf16_t* xrow = qp + (size_t)tok * 2048 + h * 256 + p * 128 + fq * 8;
#pragma unroll
    for (int ks = 0; ks < 4; ++ks) {
      const bf16x8 xb = *(const bf16x8*)(xrow + ks * 32);
      const int ch = ks * 4 + fq;
#pragma unroll
      for (int nt = 0; nt < 8; ++nt) {
        const int r = p * 128 + nt * 16 + fr;
        const bf16x8 wa = *(const bf16x8*)(lds + r * 256 + ((ch ^ (r & 15)) << 4));
        acc[nt] = __builtin_amdgcn_mfma_f32_16x16x32_bf16(wa, xb, acc[nt], 0, 0, 0);
      }
    }
    float v[32];
#pragma unroll
    for (int nt = 0; nt < 8; ++nt)
#pragma unroll
      for (int r = 0; r < 4; ++r) v[nt * 4 + r] = __uint_as_float((__float_as_uint(acc[nt][r]) & ~127u) | (unsigned)(nt * 16 + fq * 4 + r));
    bitonic_sort_desc<32>(v);
    float t[16];
#pragma unroll
    for (int i = 0; i < 16; ++i) t[i] = v[i];
#pragma unroll
    for (int rnd = 0; rnd < 2; ++rnd) {
      float pb[16];
#pragma unroll
      for (int i = 0; i < 16; ++i) pb[i] = __shfl_xor(t[15 - i], rnd == 0 ? 16 : 32);
#pragma unroll
      for (int i = 0; i < 16; ++i) t[i] = fmaxf(t[i], pb[i]);
      bitonic_merge_desc<16>(t);
    }
#pragma unroll
    for (int i = 0; i < 16; ++i) top[p][i] = t[i];
  }
  int* ST = (int*)(lds + 65536);
  int* IDX = (int*)(lds + 65536 + 256) + (wid * 16 + fr) * 32;
#define SEL4(arr, q) (fq == 0 ? arr[q] : fq == 1 ? arr[4 + (q)] : fq == 2 ? arr[8 + (q)] : arr[12 + (q)])
  {
    int4 ia, ib;
    ia.x = __float_as_uint(SEL4(top[0], 0)) & 127; ia.y = __float_as_uint(SEL4(top[0], 1)) & 127; ia.z = __float_as_uint(SEL4(top[0], 2)) & 127; ia.w = __float_as_uint(SEL4(top[0], 3)) & 127;
    ib.x = __float_as_uint(SEL4(top[1], 0)) & 127; ib.y = __float_as_uint(SEL4(top[1], 1)) & 127; ib.z = __float_as_uint(SEL4(top[1], 2)) & 127; ib.w = __float_as_uint(SEL4(top[1], 3)) & 127;
    *(int4*)(IDX + 4 * fq) = ia; *(int4*)(IDX + 16 + 4 * fq) = ib;
  }
  float cv[16];
  {
    const float NEGV = -3.0e38f;
    float am[16], bm[16];
#pragma unroll
    for (int i = 0; i < 16; ++i) { am[i] = __uint_as_float(__float_as_uint(top[0][i]) & ~127u); bm[i] = __uint_as_float(__float_as_uint(top[1][i]) & ~127u); }
#define CAND(i, j) __uint_as_float((__float_as_uint(am[i] + bm[j]) & ~63u) | (unsigned)cand_slot(i, j))
    float A[16], B[16], C[16], Dd[8], E[8], F[16];
#pragma unroll
    for (int j = 0; j < 16; ++j) A[j] = CAND(0, j);
#pragma unroll
    for (int j = 0; j < 8; ++j) { B[j] = CAND(1, j); B[15 - j] = CAND(8 + j, 0); }
    bitonic_merge_desc<16>(B);
#pragma unroll
    for (int j = 0; j < 5; ++j) C[j] = CAND(2, j);
#pragma unroll
    for (int j = 5; j < 12; ++j) C[j] = NEGV;
#pragma unroll
    for (int j = 0; j < 4; ++j) C[15 - j] = CAND(3, j);
    bitonic_merge_desc<16>(C);
    Dd[0] = CAND(4, 0); Dd[1] = CAND(4, 1); Dd[2] = CAND(4, 2); Dd[3] = NEGV; Dd[4] = NEGV; Dd[5] = NEGV; Dd[6] = CAND(5, 1); Dd[7] = CAND(5, 0);
    bitonic_merge_desc<8>(Dd);
    E[0] = CAND(6, 0); E[1] = CAND(6, 1); E[2] = NEGV; E[3] = NEGV; E[4] = NEGV; E[5] = NEGV; E[6] = CAND(7, 1); E[7] = CAND(7, 0);
    bitonic_merge_desc<8>(E);
#pragma unroll
    for (int j = 0; j < 8; ++j) { F[j] = Dd[j]; F[15 - j] = E[j]; }
    bitonic_merge_desc<16>(F);
#undef CAND
#pragma unroll
    for (int j = 0; j < 16; ++j) { A[j] = fmaxf(A[j], B[15 - j]); C[j] = fmaxf(C[j], F[15 - j]); }
    bitonic_merge_desc<16>(A);
    bitonic_merge_desc<16>(C);
#pragma unroll
    for (int j = 0; j < 16; ++j) cv[j] = fmaxf(A[j], C[15 - j]);
    bitonic_merge_desc<16>(cv);
  }
  float ex[16]; float sum = 0.f;
  const float c0v = __uint_as_float(__float_as_uint(cv[0]) & ~63u);
  const float rs = row_rstd(rowss, (size_t)tok);
#pragma unroll
  for (int i = 0; i < 16; ++i) { ex[i] = __expf((__uint_as_float(__float_as_uint(cv[i]) & ~63u) - c0v) * rs); sum += ex[i]; }
  const float inv = 1.0f / sum;
  int e4[4]; float g4[4];
#pragma unroll
  for (int q = 0; q < 4; ++q) {
    const int slot = __float_as_uint(SEL4(cv, q)) & 63;
    const int ij = ST[slot];
    e4[q] = IDX[ij >> 4] * 128 + IDX[16 + (ij & 15)];
    g4[q] = SEL4(ex, q) * inv;
  }
#undef SEL4
  *(int4*)(eb + ((size_t)tok * 8 + h) * 16 + 4 * fq) = make_int4(e4[0], e4[1], e4[2], e4[3]);
  *(float4*)(gb + ((size_t)tok * 8 + h) * 16 + 4 * fq) = make_float4(g4[0], g4[1], g4[2], g4[3]);
}

__device__ __forceinline__ void p_cvt_bf16(int blk, int nblk, const float* __restrict__ src, bf16_t* dst, size_t n8) {
  const int tix = opaque_tid();
  for (size_t i = (size_t)blk * 512 + tix; i < n8; i += (size_t)nblk * 512) {
    const float4 a = ((const float4*)src)[2 * i], b = ((const float4*)src)[2 * i + 1];
    uint4 w; w.x = cvtpk(a.x, a.y); w.y = cvtpk(a.z, a.w); w.z = cvtpk(b.x, b.y); w.w = cvtpk(b.z, b.w);
    ((uint4*)dst)[i] = w;
  }
}


typedef float f32x2v __attribute__((ext_vector_type(2)));
__device__ __forceinline__ void p_cvt_fp8_rows(int blk, int nblk, const float* __restrict__ src, unsigned* dst, float* inv, const float* __restrict__ csc) {
  const int tix = opaque_tid();
  const int lane = tix & 63, wid = tix >> 6;
  for (int r = blk * 8 + wid; r < 16384; r += nblk * 8) {
    const float4* sp = (const float4*)(src + (size_t)r * D);
    float4 v[4];
#pragma unroll
    for (int k = 0; k < 4; ++k) v[k] = sp[k * 64 + lane];
    if (csc) {
#pragma unroll
      for (int k = 0; k < 4; ++k) { const float4 g = ((const float4*)csc)[k * 64 + lane]; v[k].x *= g.x; v[k].y *= g.y; v[k].z *= g.z; v[k].w *= g.w; }
    }
    float am = 0.f;
#pragma unroll
    for (int k = 0; k < 4; ++k) am = fmaxf(am, fmaxf(fmaxf(fabsf(v[k].x), fabsf(v[k].y)), fmaxf(fabsf(v[k].z), fabsf(v[k].w))));
    am = wave_max(am);
    const float sc = am > 0.f ? 384.0f / am : 1.0f;
#pragma unroll
    for (int k = 0; k < 4; ++k) {
      int w = __builtin_amdgcn_cvt_pk_fp8_f32(v[k].x * sc, v[k].y * sc, 0, false);
      w = __builtin_amdgcn_cvt_pk_fp8_f32(v[k].z * sc, v[k].w * sc, w, true);
      { const int c = 256 * k + 4 * lane; dst[((size_t)(c >> 7) * (16384 * 128) + (size_t)r * 128 + (c & 127)) >> 2] = (unsigned)w; }
    }
    if (lane == 0) inv[r] = am > 0.f ? am * (1.0f / 384.0f) : 1.0f;
  }
}
__device__ __forceinline__ void peer_gather_token(char* wlds  , int lane, size_t row, size_t orow, const bf16_t* __restrict__ xn2, const float* __restrict__ h2,
                                                  const int* __restrict__ eb, const float* __restrict__ gb, const unsigned char* __restrict__ ut8, const float* __restrict__ uinv,
                                                  const unsigned char* __restrict__ vt8, const float* __restrict__ vinv, const float* __restrict__ fg, float* __restrict__ out) {
  int* E = (int*)wlds; float* Gt = (float*)(wlds + 512); float* W = (float*)(wlds + 1024);
  const int i16 = lane & 15, g = lane >> 4;
  {
    const int e0 = eb[row * 128 + lane], e1 = eb[row * 128 + 64 + lane];
    E[lane] = e0; E[lane + 64] = e1;
    Gt[lane] = gb[row * 128 + lane]; Gt[lane + 64] = gb[row * 128 + 64 + lane];
  }
  float xf[4][16];
#pragma unroll
  for (int k = 0; k < 4; ++k) {
    const uint4 a = *(const uint4*)(xn2 + row * D + 256 * k + 16 * i16), b = *(const uint4*)(xn2 + row * D + 256 * k + 16 * i16 + 8);
    xf[k][0] = __uint_as_float(a.x << 16); xf[k][1] = __uint_as_float(a.x & 0xffff0000u); xf[k][2] = __uint_as_float(a.y << 16); xf[k][3] = __uint_as_float(a.y & 0xffff0000u);
    xf[k][4] = __uint_as_float(a.z << 16); xf[k][5] = __uint_as_float(a.z & 0xffff0000u); xf[k][6] = __uint_as_float(a.w << 16); xf[k][7] = __uint_as_float(a.w & 0xffff0000u);
    xf[k][8] = __uint_as_float(b.x << 16); xf[k][9] = __uint_as_float(b.x & 0xffff0000u); xf[k][10] = __uint_as_float(b.y << 16); xf[k][11] = __uint_as_float(b.y & 0xffff0000u);
    xf[k][12] = __uint_as_float(b.z << 16); xf[k][13] = __uint_as_float(b.z & 0xffff0000u); xf[k][14] = __uint_as_float(b.w << 16); xf[k][15] = __uint_as_float(b.w & 0xffff0000u);
  }
#pragma unroll 2
  for (int m = 0; m < 32; ++m) {
    const int e = E[4 * m + g];
    const unsigned char* ur = ut8 + (size_t)e * D + 16 * i16;
    uint4 u[4];
#pragma unroll
    for (int k = 0; k < 4; ++k) u[k] = *(const uint4*)(ur + 256 * k);
    float d0 = 0.f, d1 = 0.f;
#pragma unroll
    for (int k = 0; k < 4; ++k) {
      const unsigned wv[4] = {u[k].x, u[k].y, u[k].z, u[k].w};
#pragma unroll
      for (int q = 0; q < 4; ++q) {
        const f32x2v lo = __builtin_amdgcn_cvt_pk_f32_fp8((int)wv[q], false), hi = __builtin_amdgcn_cvt_pk_f32_fp8((int)wv[q], true);
        d0 = fmaf(lo.x, xf[k][4 * q], d0); d1 = fmaf(lo.y, xf[k][4 * q + 1], d1);
        d0 = fmaf(hi.x, xf[k][4 * q + 2], d0); d1 = fmaf(hi.y, xf[k][4 * q + 3], d1);
      }
    }
    const float d = row16_sum(d0 + d1);
    if (i16 == 0) W[4 * m + g] = d;
  }
  {
    const int e0 = E[lane], e1 = E[lane + 64];
    const float ui0 = uinv[e0], ui1 = uinv[e1];
    const float a0 = W[lane] * ui0, a1 = W[lane + 64] * ui1;
    const float g0 = Gt[lane], g1 = Gt[lane + 64];
    W[lane] = g0 * 0.5f * a0 * (1.0f + erff(a0 * 0.70710678118654752f)) * vinv[e0];
    W[lane + 64] = g1 * 0.5f * a1 * (1.0f + erff(a1 * 0.70710678118654752f)) * vinv[e1];
  }
  float acc[4][16];
#pragma unroll
  for (int k = 0; k < 4; ++k)
#pragma unroll
    for (int i = 0; i < 16; ++i) acc[k][i] = 0.f;
#pragma unroll 2
  for (int m = 0; m < 32; ++m) {
    const int e = E[4 * m + g];
    const float w = W[4 * m + g];
    const unsigned char* vr = vt8 + (size_t)e * D + 16 * i16;
    uint4 v[4];
#pragma unroll
    for (int k = 0; k < 4; ++k) v[k] = *(const uint4*)(vr + 256 * k);
#pragma unroll
    for (int k = 0; k < 4; ++k) {
      const unsigned wv[4] = {v[k].x, v[k].y, v[k].z, v[k].w};
#pragma unroll
      for (int q = 0; q < 4; ++q) {
        const f32x2v lo = __builtin_amdgcn_cvt_pk_f32_fp8((int)wv[q], false), hi = __builtin_amdgcn_cvt_pk_f32_fp8((int)wv[q], true);
        acc[k][4 * q] = fmaf(w, lo.x, acc[k][4 * q]); acc[k][4 * q + 1] = fmaf(w, lo.y, acc[k][4 * q + 1]);
        acc[k][4 * q + 2] = fmaf(w, hi.x, acc[k][4 * q + 2]); acc[k][4 * q + 3] = fmaf(w, hi.y, acc[k][4 * q + 3]);
      }
    }
  }
  float res[16];
#pragma unroll
  for (int k = 0; k < 4; ++k)
#pragma unroll
    for (int j = 0; j < 16; ++j) {
      float t = acc[k][j];
      t += __shfl_xor(t, 16); t += __shfl_xor(t, 32);
      if (k == g) res[j] = t;
    }
  const int c0 = 256 * g + 16 * i16;
  float ss = 0.f;
#pragma unroll
  for (int q = 0; q < 4; ++q) {
    const float4 hv = *(const float4*)(h2 + row * D + c0 + 4 * q);
    res[4 * q] += hv.x; res[4 * q + 1] += hv.y; res[4 * q + 2] += hv.z; res[4 * q + 3] += hv.w;
  }
#pragma unroll
  for (int i = 0; i < 16; ++i) ss += res[i] * res[i];
  ss = wave_sum(ss);
  const float rstd = rsqrtf(ss * (1.0f / D) + EPS);
#pragma unroll
  for (int q = 0; q < 4; ++q) {
    const float4 f = *(const float4*)(fg + c0 + 4 * q);
    *(float4*)(out + orow * D + c0 + 4 * q) = make_float4(res[4 * q] * rstd * f.x, res[4 * q + 1] * rstd * f.y, res[4 * q + 2] * rstd * f.z, res[4 * q + 3] * rstd * f.w);
  }
}


__device__ __forceinline__ unsigned xcc_id() { return (unsigned)__builtin_amdgcn_s_getreg((3 << 11) | 20) & 7u; }

__device__ __forceinline__ void ds_issue(uint4 (&u)[16], const int* El  , const unsigned char* __restrict__ tab) {
  int ev[16];
#pragma unroll
  for (int q = 0; q < 4; ++q) { const int4 t = *(const int4*)(El + 4 * q); ev[4 * q] = t.x; ev[4 * q + 1] = t.y; ev[4 * q + 2] = t.z; ev[4 * q + 3] = t.w; }
#pragma unroll
  for (int it = 0; it < 16; ++it) u[it] = *(const uint4*)(tab + (size_t)(unsigned)ev[it] * 128);
}
__device__ __forceinline__ void ds_u_compute(const uint4 (&u)[16], const char* Xl  , float* __restrict__ pout, int j) {
  f32x2v xf[8];
  {
    const uint4 a = *(const uint4*)Xl, c = *(const uint4*)(Xl + 16);
    xf[0] = (f32x2v){__uint_as_float(a.x << 16), __uint_as_float(a.x & 0xffff0000u)}; xf[1] = (f32x2v){__uint_as_float(a.y << 16), __uint_as_float(a.y & 0xffff0000u)};
    xf[2] = (f32x2v){__uint_as_float(a.z << 16), __uint_as_float(a.z & 0xffff0000u)}; xf[3] = (f32x2v){__uint_as_float(a.w << 16), __uint_as_float(a.w & 0xffff0000u)};
    xf[4] = (f32x2v){__uint_as_float(c.x << 16), __uint_as_float(c.x & 0xffff0000u)}; xf[5] = (f32x2v){__uint_as_float(c.y << 16), __uint_as_float(c.y & 0xffff0000u)};
    xf[6] = (f32x2v){__uint_as_float(c.z << 16), __uint_as_float(c.z & 0xffff0000u)}; xf[7] = (f32x2v){__uint_as_float(c.w << 16), __uint_as_float(c.w & 0xffff0000u)};
  }
  float k0 = 0.f, k1 = 0.f;
#pragma unroll
  for (int it = 0; it < 16; ++it) {
    const unsigned wv[4] = {u[it].x, u[it].y, u[it].z, u[it].w};
    f32x2v d2 = {0.f, 0.f};
#pragma unroll
    for (int q = 0; q < 4; ++q) {
      const f32x2v lo = __builtin_amdgcn_cvt_pk_f32_fp8((int)wv[q], false), hi = __builtin_amdgcn_cvt_pk_f32_fp8((int)wv[q], true);
      d2 = __builtin_elementwise_fma(lo, xf[2 * q], d2); d2 = __builtin_elementwise_fma(hi, xf[2 * q + 1], d2);
    }
    const float d = sum8(d2.x + d2.y);
    if ((it >> 1) == j) { if (it & 1) k1 = d; else k0 = d; }
  }
  *(float2*)pout = make_float2(k0, k1);
}
__device__ __forceinline__ void ds_u_chunk(char* wl  , int lane, int tk0, int s, const bf16_t* __restrict__ xn2, const int* __restrict__ eb, const unsigned char* __restrict__ ut8, float* __restrict__ partial) {
  const int b = tk0 / SEQ, sq = tk0 - b * SEQ;
  const size_t row0 = (size_t)b * LP + NMETA + sq;
  const int j = lane & 7, gi = lane >> 3;
  int* El = (int*)wl;
  char* Xl = wl + 8192;
#pragma unroll
  for (int i = 0; i < 8; ++i) *(int4*)(El + (i * 64 + lane) * 4) = *(const int4*)(eb + row0 * 128 + (i * 64 + lane) * 4);
#pragma unroll
  for (int i = 0; i < 4; ++i) { const int g = i * 64 + lane, t = g >> 4, c = g & 15; *(uint4*)(Xl + g * 16) = *(const uint4*)(xn2 + (row0 + t) * D + 128 * s + 8 * c); }
  const unsigned char* tab = ut8 + (size_t)s * (16384 * 128) + 16 * j;
  float* pout = partial + ((size_t)tk0 * 8 + s) * 128 + gi * 16 + 2 * j;
  uint4 ua[16], ub[16];
  ds_issue(ua, El + gi * 16, tab);
#pragma unroll 1
  for (int t = 0; t < 16; t += 2) {
    ds_issue(ub, El + (t + 1) * 128 + gi * 16, tab);
    ds_u_compute(ua, Xl + t * 256 + 32 * j, pout + (size_t)t * 1024, j);
    if (t + 2 < 16) ds_issue(ua, El + (t + 2) * 128 + gi * 16, tab);
    ds_u_compute(ub, Xl + (t + 1) * 256 + 32 * j, pout + (size_t)(t + 1) * 1024, j);
  }
}

__device__ __forceinline__ void ds_v_compute(const uint4 (&v)[16], const float* Wl  , int lane, int j, int gi, size_t row, int tk, int s,
                                             const float* __restrict__ h2, float* __restrict__ out, float* __restrict__ ssq) {
  float w[16];
#pragma unroll
  for (int q = 0; q < 4; ++q) { const float4 f = *(const float4*)(Wl + 4 * q); w[4 * q] = f.x; w[4 * q + 1] = f.y; w[4 * q + 2] = f.z; w[4 * q + 3] = f.w; }
  f32x2v acc[8];
#pragma unroll
  for (int i = 0; i < 8; ++i) acc[i] = (f32x2v){0.f, 0.f};
#pragma unroll
  for (int it = 0; it < 16; ++it) {
    const unsigned wv[4] = {v[it].x, v[it].y, v[it].z, v[it].w};
    const f32x2v w2 = {w[it], w[it]};
#pragma unroll
    for (int q = 0; q < 4; ++q) {
      const f32x2v lo = __builtin_amdgcn_cvt_pk_f32_fp8((int)wv[q], false), hi = __builtin_amdgcn_cvt_pk_f32_fp8((int)wv[q], true);
      acc[2 * q] = __builtin_elementwise_fma(w2, lo, acc[2 * q]); acc[2 * q + 1] = __builtin_elementwise_fma(w2, hi, acc[2 * q + 1]);
    }
  }
  float r4[4] = {0.f, 0.f, 0.f, 0.f};
#pragma unroll
  for (int i = 0; i < 16; ++i) {
    float t = (i & 1) ? acc[i >> 1].y : acc[i >> 1].x;
    t = dpp_add<0x128>(t);
    t += __shfl_xor(t, 16);
    t = half_swap_sum(t);
    if ((i >> 2) == gi) r4[i & 3] = t;
  }
  float ss = 0.f;
  if (gi < 4) {
    const int c0 = 128 * s + 16 * j + 4 * gi;
    const float4 hv = *(const float4*)(h2 + row * D + c0);
    const float4 o = make_float4(hv.x + r4[0], hv.y + r4[1], hv.z + r4[2], hv.w + r4[3]);
    ss = o.x * o.x + o.y * o.y + o.z * o.z + o.w * o.w;
    *(float4*)(out + (size_t)tk * D + c0) = o;
  }
  ss = wave_sum(ss);
  if (lane == 0) ssq[(size_t)tk * 8 + s] = ss;
}
__device__ __forceinline__ void ds_v_chunk(char* wl, int lane, int tk0, int s, const float* __restrict__ h2, const int* __restrict__ eb, const float* __restrict__ wbuf, const unsigned char* __restrict__ vt8,
                                           float* __restrict__ out, float* __restrict__ ssq) {
  const int b = tk0 / SEQ, sq = tk0 - b * SEQ;
  const size_t row0 = (size_t)b * LP + NMETA + sq;
  const int j = lane & 7, gi = lane >> 3;
  int* El = (int*)wl;
  float* Wl = (float*)(wl + 8192);
#pragma unroll
  for (int i = 0; i < 8; ++i) {
    *(int4*)(El + (i * 64 + lane) * 4) = *(const int4*)(eb + row0 * 128 + (i * 64 + lane) * 4);
    *(float4*)(Wl + (i * 64 + lane) * 4) = *(const float4*)(wbuf + (size_t)tk0 * 128 + (i * 64 + lane) * 4);
  }
  const unsigned char* tab = vt8 + (size_t)s * (16384 * 128) + 16 * j;
  uint4 va[16], vb[16];
  ds_issue(va, El + gi * 16, tab);
#pragma unroll 1
  for (int t = 0; t < 16; t += 2) {
    ds_issue(vb, El + (t + 1) * 128 + gi * 16, tab);
    ds_v_compute(va, Wl + t * 128 + gi * 16, lane, j, gi, row0 + t, tk0 + t, s, h2, out, ssq);
    if (t + 2 < 16) ds_issue(va, El + (t + 2) * 128 + gi * 16, tab);
    ds_v_compute(vb, Wl + (t + 1) * 128 + gi * 16, lane, j, gi, row0 + t + 1, tk0 + t + 1, s, h2, out, ssq);
  }
}

__device__ __forceinline__ void p_gather_naive(int blk, const bf16_t* __restrict__ xn2, const float* __restrict__ h2, const int* __restrict__ eb, const float* __restrict__ gb,
                                                      const float* __restrict__ ut, const float* __restrict__ vt, const float* fg, float* out) {
  const int tix = opaque_tid();
  int tk = blk * 4 + ((tix & 255) >> 6), lane = (tix & 255) & 63;
  int b = tk / SEQ, s = tk - b * SEQ;
  size_t row = (size_t)b * LP + NMETA + s;
  float xv[16];
  {
    const uint4* xp = (const uint4*)(xn2 + row * D + lane * 16);
#pragma unroll
    for (int i = 0; i < 2; ++i) {
      uint4 r = xp[i];
      xv[i * 8 + 0] = bf2f(r.x & 0xffffu); xv[i * 8 + 1] = bf2f(r.x >> 16); xv[i * 8 + 2] = bf2f(r.y & 0xffffu); xv[i * 8 + 3] = bf2f(r.y >> 16);
      xv[i * 8 + 4] = bf2f(r.z & 0xffffu); xv[i * 8 + 5] = bf2f(r.z >> 16); xv[i * 8 + 6] = bf2f(r.w & 0xffffu); xv[i * 8 + 7] = bf2f(r.w >> 16);
    }
  }
  float acc[16];
#pragma unroll
  for (int i = 0; i < 16; ++i) acc[i] = 0.f;
  for (int k = 0; k < 128; ++k) {
    int e = eb[row * 128 + k];
    float gate = gb[row * 128 + k];
    const float4* up = (const float4*)(ut + (size_t)e * D + lane * 16);
    float dsum = 0.f;
#pragma unroll
    for (int i = 0; i < 4; ++i) { float4 u = up[i]; dsum += u.x * xv[i * 4] + u.y * xv[i * 4 + 1] + u.z * xv[i * 4 + 2] + u.w * xv[i * 4 + 3]; }
    dsum = wave_sum(dsum);
    float act = 0.5f * dsum * (1.0f + erff(dsum * 0.70710678118654752f));
    float wgt = gate * act;
    const float4* vp = (const float4*)(vt + (size_t)e * D + lane * 16);
#pragma unroll
    for (int i = 0; i < 4; ++i) { float4 v = vp[i]; acc[i * 4] += wgt * v.x; acc[i * 4 + 1] += wgt * v.y; acc[i * 4 + 2] += wgt * v.z; acc[i * 4 + 3] += wgt * v.w; }
  }
  const float4* hp = (const float4*)(h2 + row * D + lane * 16);
  float ss = 0.f;
#pragma unroll
  for (int i = 0; i < 4; ++i) { float4 hv = hp[i]; acc[i * 4] += hv.x; acc[i * 4 + 1] += hv.y; acc[i * 4 + 2] += hv.z; acc[i * 4 + 3] += hv.w; }
#pragma unroll
  for (int i = 0; i < 16; ++i) ss += acc[i] * acc[i];
  ss = wave_sum(ss);
  float rstd = rsqrtf(ss * (1.0f / D) + EPS);
  float4* op = (float4*)(out + ((size_t)b * SEQ + s) * D + lane * 16);
  const float4* gp = (const float4*)(fg + lane * 16);
#pragma unroll
  for (int i = 0; i < 4; ++i) { float4 g = gp[i]; op[i] = make_float4(acc[i * 4] * rstd * g.x, acc[i * 4 + 1] * rstd * g.y, acc[i * 4 + 2] * rstd * g.z, acc[i * 4 + 3] * rstd * g.w); }
}


template <class Epi>
__device__ __forceinline__ void gemm_tile(char* lds, const bf16_t* __restrict__ X, int ldx, const bf16_t* __restrict__ Wt, int ldw, int K, int m0, int n0, const Epi& epi) {
  const int tix = opaque_tid();
  const int tid = tix, lane = tid & 63, wid = tid >> 6;
  const int wm = wid >> 1, wn = wid & 1;
  const int sc = tid & 7, sr = tid >> 3;
  f32x4 acc[4][4];
#pragma unroll
  for (int i = 0; i < 4; ++i)
#pragma unroll
    for (int j = 0; j < 4; ++j) acc[i][j] = (f32x4){0.f, 0.f, 0.f, 0.f};
  uint4 ra[4], rb[2];
  const bf16_t* xp = X + (size_t)(m0 + sr) * ldx + sc * 8;
  const bf16_t* wp = Wt + (size_t)(n0 + sr) * ldw + sc * 8;
  const int nk = K >> 6;
#pragma unroll
  for (int i = 0; i < 4; ++i) ra[i] = *(const uint4*)(xp + (size_t)(64 * i) * ldx);
#pragma unroll
  for (int i = 0; i < 2; ++i) rb[i] = *(const uint4*)(wp + (size_t)(64 * i) * ldw);
#pragma unroll
  for (int i = 0; i < 4; ++i) { int r = sr + 64 * i; *(uint4*)(lds + r * 128 + ((sc ^ ((r >> 1) & 7)) << 4)) = ra[i]; }
#pragma unroll
  for (int i = 0; i < 2; ++i) { int r = sr + 64 * i; *(uint4*)(lds + 32768 + r * 128 + ((sc ^ ((r >> 1) & 7)) << 4)) = rb[i]; }
  __syncthreads();
  const int fr = lane & 15, fq = lane >> 4;
  for (int kt = 0; kt < nk; ++kt) {
    if (kt + 1 < nk) {
#pragma unroll
      for (int i = 0; i < 4; ++i) ra[i] = *(const uint4*)(xp + (size_t)(64 * i) * ldx + (kt + 1) * 64);
#pragma unroll
      for (int i = 0; i < 2; ++i) rb[i] = *(const uint4*)(wp + (size_t)(64 * i) * ldw + (kt + 1) * 64);
    }
    const char* la = lds + (kt & 1) * 49152;
    const char* lb = la + 32768;
#pragma unroll
    for (int kk = 0; kk < 2; ++kk) {
      bf16x8 xa[4], wb[4];
      const int c = kk * 4 + fq;
#pragma unroll
      for (int t = 0; t < 4; ++t) {
        int r = wm * 64 + t * 16 + fr; xa[t] = *(const bf16x8*)(la + r * 128 + ((c ^ ((r >> 1) & 7)) << 4));
        int r2 = wn * 64 + t * 16 + fr; wb[t] = *(const bf16x8*)(lb + r2 * 128 + ((c ^ ((r2 >> 1) & 7)) << 4));
      }
#pragma unroll
      for (int nt = 0; nt < 4; ++nt)
#pragma unroll
        for (int tt = 0; tt < 4; ++tt) acc[nt][tt] = __builtin_amdgcn_mfma_f32_16x16x32_bf16(wb[nt], xa[tt], acc[nt][tt], 0, 0, 0);
    }
    if (kt + 1 < nk) {
      char* lw = lds + ((kt + 1) & 1) * 49152;
#pragma unroll
      for (int i = 0; i < 4; ++i) { int r = sr + 64 * i; *(uint4*)(lw + r * 128 + ((sc ^ ((r >> 1) & 7)) << 4)) = ra[i]; }
#pragma unroll
      for (int i = 0; i < 2; ++i) { int r = sr + 64 * i; *(uint4*)(lw + 32768 + r * 128 + ((sc ^ ((r >> 1) & 7)) << 4)) = rb[i]; }
    }
    __syncthreads();
  }
#pragma unroll
  for (int nt = 0; nt < 4; ++nt)
#pragma unroll
    for (int tt = 0; tt < 4; ++tt) epi(m0 + wm * 64 + tt * 16 + fr, n0 + wn * 64 + nt * 16 + fq * 4, acc[nt][tt]);
}

struct Epi4StoreBf16 { bf16_t* out; int ld; int pad; __device__ __forceinline__ void operator()(int r, int c, f32x4 v) const {
  uint2 w; w.x = pack2(v[0], v[1]); w.y = pack2(v[2], v[3]); *(uint2*)(out + (size_t)r * ld + c) = w; } };
struct Epi4Resid { const float* x; const float* meta; float* h2; __device__ __forceinline__ void operator()(int r, int c, f32x4 v) const {
  const float* src = hrow_ptr(x, meta, r); float4 hv = src ? *(const float4*)(src + c) : make_float4(0.f, 0.f, 0.f, 0.f);
  *(float4*)(h2 + (size_t)r * D + c) = make_float4(hv.x + v[0], hv.y + v[1], hv.z + v[2], hv.w + v[3]); } };


struct EpiBf16 {
  bf16_t* out; int ld; int use_scale; const float* rowss;
  __device__ __forceinline__ void store8(size_t row, int col, const float (&v)[8]) const {
    uint4 w; w.x = cvtpk(v[0], v[1]); w.y = cvtpk(v[2], v[3]); w.z = cvtpk(v[4], v[5]); w.w = cvtpk(v[6], v[7]);
    *(uint4*)(out + row * ld + col) = w;
  }
};
struct EpiResid2 {
  const float* x; const float* meta; float* h2; bf16_t* hb; float* rowss;
  __device__ __forceinline__ void store8(size_t row, int col, const float (&v)[8]) const {
    const float* src = hrow_ptr(x, meta, (int)row);
    const float4 a = *(const float4*)(src + col), b = *(const float4*)(src + col + 4);
    const float o[8] = {a.x + v[0], a.y + v[1], a.z + v[2], a.w + v[3], b.x + v[4], b.y + v[5], b.z + v[6], b.w + v[7]};
    *(float4*)(h2 + row * D + col) = make_float4(o[0], o[1], o[2], o[3]);
    *(float4*)(h2 + row * D + col + 4) = make_float4(o[4], o[5], o[6], o[7]);
    uint4 w; w.x = cvtpk(o[0], o[1]); w.y = cvtpk(o[2], o[3]); w.z = cvtpk(o[4], o[5]); w.w = cvtpk(o[6], o[7]);
    *(uint4*)(hb + row * D + col) = w;
    float ss = 0.f;
#pragma unroll
    for (int i = 0; i < 8; ++i) ss += o[i] * o[i];
    ss = sum8(ss);
    if ((threadIdx.x & 7) == 0) rowss[row * 16 + (col >> 6)] = ss;
  }
};

template <class Epi>
__device__ __forceinline__ void gemm256(char* lds, const bf16_t* __restrict__ X, int ldx, const bf16_t* __restrict__ Wt, int ldw, int K, size_t xrow0, int n0, const Epi& epi) {
  const int tix = opaque_tid();
  const int tid = tix, lane = tid & 63;
  const int wid = __builtin_amdgcn_readfirstlane(tid >> 6);
  const int wm = wid >> 2, wn = wid & 3;
  const int fr = lane & 15, fq = lane >> 4;
  f32x4 acc[4][8];
#pragma unroll
  for (int i = 0; i < 4; ++i)
#pragma unroll
    for (int j = 0; j < 8; ++j) acc[i][j] = (f32x4){0.f, 0.f, 0.f, 0.f};
  const int nk = K >> 6;
  const int prow = lane >> 3, ppos = lane & 7;
  const char* xsrc = (const char*)(X + (xrow0 + 8 * wid + prow) * ldx);
  const char* wsrc = (const char*)(Wt + (size_t)(n0 + 8 * wid + prow) * ldw);
  const unsigned swz = (unsigned)((ppos ^ ((4 * wid + (prow >> 1)) & 7)) << 4);
#define G256_ISSUE(kt, buf) do { \
    _Pragma("unroll") for (int i_ = 0; i_ < 4; ++i_) { \
      __builtin_amdgcn_global_load_lds((const unsigned*)(xsrc + (size_t)(64 * i_) * ldx * 2 + (kt) * 128 + swz), LDSP(unsigned, lds + (buf) * 65536 + (i_ * 8 + wid) * 1024), 16, 0, 0); \
      __builtin_amdgcn_global_load_lds((const unsigned*)(wsrc + (size_t)(64 * i_) * ldw * 2 + (kt) * 128 + swz), LDSP(unsigned, lds + (buf) * 65536 + 32768 + (i_ * 8 + wid) * 1024), 16, 0, 0); \
    } } while (0)
  __syncthreads();
  G256_ISSUE(0, 0);
  __syncthreads();
  for (int kt = 0; kt < nk; ++kt) {
    if (kt + 1 < nk) G256_ISSUE(kt + 1, (kt + 1) & 1);
    const char* la = lds + (kt & 1) * 65536;
    const char* lb = la + 32768;
#pragma unroll
    for (int kk = 0; kk < 2; ++kk) {
      const int c = kk * 4 + fq;
      bf16x8 xa[8], wb[4];
#pragma unroll
      for (int t = 0; t < 8; ++t) { const int r = wm * 128 + t * 16 + fr; xa[t] = *(const bf16x8*)(la + r * 128 + ((c ^ ((r >> 1) & 7)) << 4)); }
#pragma unroll
      for (int t = 0; t < 4; ++t) { const int r = wn * 64 + t * 16 + fr; wb[t] = *(const bf16x8*)(lb + r * 128 + ((c ^ ((r >> 1) & 7)) << 4)); }
#pragma unroll
      for (int nt = 0; nt < 4; ++nt)
#pragma unroll
        for (int tt = 0; tt < 8; ++tt) acc[nt][tt] = __builtin_amdgcn_mfma_f32_16x16x32_bf16(wb[nt], xa[tt], acc[nt][tt], 0, 0, 0);
    }
    __syncthreads();
  }
#undef G256_ISSUE
  char* wl = lds + wid * 16384;
#pragma unroll
  for (int hf = 0; hf < 2; ++hf) {
#pragma unroll
    for (int t4 = 0; t4 < 4; ++t4)
#pragma unroll
      for (int nt = 0; nt < 4; ++nt) {
        const int t = t4 * 16 + fr, c16 = nt * 4 + fq;
        *(f32x4*)(wl + t * 256 + ((c16 ^ (t & 15)) << 4)) = acc[nt][hf * 4 + t4];
      }
#pragma unroll
    for (int i = 0; i < 8; ++i) {
      const int t = 8 * i + (lane >> 3), c8 = lane & 7;
      const f32x4 v0 = *(const f32x4*)(wl + t * 256 + (((2 * c8) ^ (t & 15)) << 4)), v1 = *(const f32x4*)(wl + t * 256 + (((2 * c8 + 1) ^ (t & 15)) << 4));
      const float v[8] = {v0[0], v0[1], v0[2], v0[3], v1[0], v1[1], v1[2], v1[3]};
      epi.store8(xrow0 + wm * 128 + hf * 64 + t, n0 + wn * 64 + 8 * c8, v);
    }
  }
}

__device__ __forceinline__ void meta_proj(char* lds, int blk, const bf16_t* __restrict__ xn1, const bf16_t* __restrict__ wt_in, bf16_t* proj) {
  const int tix = opaque_tid();
  float* red = (float*)lds;
  __syncthreads();
  float part = 0.f;
  const int o = tix % 160, kp = tix / 160;
  if (tix < 480) {
    const int row = o / 10, n = blk * 10 + o % 10;
    const int k0 = kp * 352, k1 = kp == 2 ? 1024 : k0 + 352;
    const bf16_t* xr = xn1 + (size_t)row * D; const bf16_t* wr = wt_in + (size_t)n * D;
    for (int k = k0; k < k1; k += 8) {
      const uint4 a = *(const uint4*)(xr + k), b = *(const uint4*)(wr + k);
      part = dot8(a, b, part);
    }
    red[tix] = part;
  }
  __syncthreads();
  if (tix < 160) {
    const float v = red[tix] + red[tix + 160] + red[tix + 320];
    const int row = tix / 10, n = blk * 10 + tix % 10;
    const bf16_t bv = f2bf(v);
#pragma unroll
    for (int b = 0; b < BATCH; ++b) proj[((size_t)b * LP + row) * INC + n] = bv;
  }
}

__device__ __forceinline__ void p_transpose(int t, float* smem, const float* __restrict__ W, bf16_t* Wt, int K, int N, const float* __restrict__ ksc) {
  const int tix = opaque_tid();
  float (*T)[65] = (float (*)[65])smem;
  const int nbx = N / 64, k0 = (t / nbx) * 64, n0 = (t % nbx) * 64, tid = (tix & 255);
  const int j = tid & 63, i0 = tid >> 6;
#pragma unroll
  for (int ii = 0; ii < 16; ++ii) { int i = i0 + 4 * ii; T[i][j] = W[(size_t)(k0 + i) * N + n0 + j] * (ksc ? ksc[k0 + i] : 1.0f); }
  __syncthreads();
#pragma unroll
  for (int ii = 0; ii < 16; ++ii) { int jj = i0 + 4 * ii; Wt[(size_t)(n0 + jj) * K + k0 + j] = f2bf(T[j][jj]); }
  __syncthreads();
}

__device__ __forceinline__ void grid_bar(unsigned* ctr, unsigned target) {
  asm volatile("s_waitcnt vmcnt(0)" ::: "memory");
  __syncthreads();
  if (threadIdx.x == 0) {
    __builtin_amdgcn_fence(__ATOMIC_RELEASE, "agent");
    asm volatile("s_waitcnt vmcnt(0)" ::: "memory");
    __hip_atomic_fetch_add(ctr, 1u, __ATOMIC_RELAXED, __HIP_MEMORY_SCOPE_AGENT);
    unsigned spins = 0;
    while (__hip_atomic_load(ctr, __ATOMIC_RELAXED, __HIP_MEMORY_SCOPE_AGENT) < target) { __builtin_amdgcn_s_sleep(2); if (++spins > (1u << 24)) break; }
    __builtin_amdgcn_fence(__ATOMIC_ACQUIRE, "agent");
    asm volatile("s_waitcnt vmcnt(0)" ::: "memory");
  }
  __syncthreads();
}

struct Params {
  const float *x, *meta, *g1, *w_in, *lq1, *lk1, *lq2, *lk2, *subg, *conv_w, *conv_b, *gn_g, *gn_b, *w_out, *g2, *wq, *sk, *ut, *vt, *fg;
  float* out; float* scal; bf16_t* r1; bf16_t* r2; float* h2; int* eb; float* gb; bf16_t* wt_in; bf16_t* wt_out; bf16_t* wt_q; bf16_t* skb; unsigned char* ut8; unsigned char* vt8; float* uinv; float* vinv; float* wbuf; float* ssq; bf16_t* hb; float* rowss;
};

__global__ void __launch_bounds__(512, 2) mega(Params p) {
  cg::grid_group grid = cg::this_grid();
  __shared__ __attribute__((aligned(16))) char smem_c[131072];
  float* smem = (float*)smem_c;
  const int G = gridDim.x, vh = threadIdx.x >> 8;
  unsigned* ctr = (unsigned*)(p.scal + 64);
  unsigned nbar = 0;
  bf16_t* xn1 = p.r1; bf16_t* mix = p.r1; bf16_t* proj = p.r2; bf16_t* qp = p.r2;
  for (int b = blockIdx.x; b < ROWS / 2; b += G) p_norm1(b * 2 + vh, smem + 4 * vh, p.x, p.meta, p.g1, xn1, p.lq1, p.lk1, p.lq2, p.lk2, p.scal);
  for (int b = blockIdx.x; b < (640 + 256 + 512) / 2; b += G) {
    const int bb = b * 2 + vh; float* sm = smem + vh * (64 * 65);
    if (bb < 640) p_transpose(bb, sm, p.w_in, p.wt_in, D, INC, nullptr);
    else if (bb < 896) p_transpose(bb - 640, sm, p.w_out, p.wt_out, D, D, nullptr);
    else p_transpose(bb - 896, sm, p.wq, p.wt_q, D, 2048, p.g2);
  }
  p_cvt_bf16(blockIdx.x, G, p.sk, p.skb, (size_t)16 * 128 * 128 / 8);
  p_cvt_fp8_rows(blockIdx.x, G, p.ut, (unsigned*)p.ut8, p.uinv, p.g2);
  p_cvt_fp8_rows(blockIdx.x, G, p.vt, (unsigned*)p.vt8, p.vinv, nullptr);
  grid.sync();
  for (int b = blockIdx.x; b < 128 * 10; b += G) {
    const int mt = b / 10, nt = b - mt * 10;
    gemm256(smem_c, xn1, D, p.wt_in, D, D, (size_t)(mt >> 4) * LP + NMETA + 256 * (mt & 15), nt * 256, EpiBf16{proj, INC, 0, nullptr});
  }
  for (int b = blockIdx.x; b < 256; b += G) meta_proj(smem_c, b, xn1, p.wt_in, proj);
  for (int i = blockIdx.x * 512 + threadIdx.x; i < BATCH * (LP - LREAL) * 128; i += G * 512) {
    const int c = i & 127, r = i >> 7, b = r / (LP - LREAL), pos = LREAL + r - b * (LP - LREAL);
    *(uint4*)(proj + ((size_t)b * LP + pos) * INC + 512 + 8 * c) = make_uint4(0, 0, 0, 0);
  }
  grid_bar(ctr, (unsigned)G * ++nbar);
  {
    const float lam = p.scal[0];
    for (int u = blockIdx.x; u < 256; u += G) {
      const int bh = (u & 7) * 4 + (u >> 6), tp = (u >> 3) & 7;
#pragma unroll 1
      for (int k = 0; k < 4; ++k) {
        const int t = (k == 0) ? 31 - tp : (k == 1) ? 16 + tp : (k == 2) ? 15 - tp : tp;
        attn_unit(smem_c, proj, mix, p.subg, lam, bh >> 2, bh & 3, t);
      }
    }
  }
  for (int u = blockIdx.x; u < BATCH * 128; u += G) conv_unit(smem_c, proj, mix, p.conv_w, p.conv_b, p.gn_g, p.gn_b, u >> 7, NMETA + 32 * (u & 127));
  grid_bar(ctr, (unsigned)G * ++nbar);
  for (int b = blockIdx.x; b < 128 * 4; b += G) {
    const int mt = b >> 2, nt = b & 3;
    gemm256(smem_c, mix, D, p.wt_out, D, D, (size_t)(mt >> 4) * LP + NMETA + 256 * (mt & 15), nt * 256, EpiResid2{p.x, p.meta, p.h2, p.hb, p.rowss});
  }
  grid_bar(ctr, (unsigned)G * ++nbar);
  for (int b = blockIdx.x; b < 128 * 8; b += G) {
    const int mt = b >> 3, nt = b & 7;
    gemm256(smem_c, p.hb, D, p.wt_q, D, D, (size_t)(mt >> 4) * LP + NMETA + 256 * (mt & 15), nt * 256, EpiBf16{qp, 2048, 0, nullptr});
  }
  grid_bar(ctr, (unsigned)G * ++nbar);
  for (int u = blockIdx.x; u < 256 * 8; u += G) {
    const int rt = u >> 3, h = u & 7;
    peer_topk_unit(smem_c, qp, p.skb, p.rowss, p.eb, p.gb, (rt >> 5) * LP + NMETA + 128 * (rt & 31), h);
  }
  grid_bar(ctr, (unsigned)G * ++nbar);
  {
    const int tix = opaque_tid();
    const int lane = tix & 63;
    const int NTOK = BATCH * SEQ;
    float* partial = (float*)qp;
    unsigned* qh = (unsigned*)(p.scal + 128);
    const unsigned x = xcc_id();
    for (int qi = 0; qi < 8; ++qi) {
      const int s = (int)((x + qi) & 7u);
      for (;;) {
        unsigned st = 0;
        if (lane == 0) st = __hip_atomic_fetch_add(qh + s * 16, 32u, __ATOMIC_RELAXED, __HIP_MEMORY_SCOPE_AGENT);
        st = __builtin_amdgcn_readfirstlane(st);
        if (st >= (unsigned)NTOK) break;
        ds_u_chunk(smem_c + (tix >> 6) * 16384, lane, (int)st, s, p.hb, p.eb, p.ut8, partial);
        ds_u_chunk(smem_c + (tix >> 6) * 16384, lane, (int)st + 16, s, p.hb, p.eb, p.ut8, partial);
      }
    }
    grid_bar(ctr, (unsigned)G * ++nbar);
    for (size_t i = (size_t)blockIdx.x * 512 + tix; i < (size_t)NTOK * 128; i += (size_t)G * 512) {
      const int tk = (int)(i >> 7), k = (int)(i & 127);
      const int b = tk / SEQ, sq = tk - b * SEQ;
      const size_t row = (size_t)b * LP + NMETA + sq;
      float a = 0.f;
#pragma unroll
      for (int sl = 0; sl < 8; ++sl) a += partial[((size_t)tk * 8 + sl) * 128 + k];
      const int e = p.eb[row * 128 + k];
      a *= p.uinv[e] * row_rstd(p.rowss, row);
      p.wbuf[i] = p.gb[row * 128 + k] * 0.5f * a * (1.0f + erff(a * 0.70710678118654752f)) * p.vinv[e];
    }
    grid_bar(ctr, (unsigned)G * ++nbar);
    for (int qi = 0; qi < 8; ++qi) {
      const int s = (int)((x + qi) & 7u);
      for (;;) {
        unsigned st = 0;
        if (lane == 0) st = __hip_atomic_fetch_add(qh + (8 + s) * 16, 32u, __ATOMIC_RELAXED, __HIP_MEMORY_SCOPE_AGENT);
        st = __builtin_amdgcn_readfirstlane(st);
        if (st >= (unsigned)NTOK) break;
        ds_v_chunk(smem_c + (tix >> 6) * 16384, lane, (int)st, s, p.h2, p.eb, p.wbuf, p.vt8, p.out, p.ssq);
        ds_v_chunk(smem_c + (tix >> 6) * 16384, lane, (int)st + 16, s, p.h2, p.eb, p.wbuf, p.vt8, p.out, p.ssq);
      }
    }
    grid_bar(ctr, (unsigned)G * ++nbar);
    {
      const int wv = blockIdx.x * 8 + (tix >> 6);
      for (int tk = wv * 2; tk < NTOK; tk += G * 16) {
        float4 o[2][4]; float sv[2];
#pragma unroll
        for (int r = 0; r < 2; ++r) {
#pragma unroll
          for (int q = 0; q < 4; ++q) o[r][q] = ((const float4*)p.out)[(size_t)(tk + r) * 256 + q * 64 + lane];
          sv[r] = lane < 8 ? p.ssq[(size_t)(tk + r) * 8 + lane] : 0.f;
        }
#pragma unroll
        for (int r = 0; r < 2; ++r) {
          const float rstd = rsqrtf(wave_sum(sv[r]) * (1.0f / D) + EPS);
#pragma unroll
          for (int q = 0; q < 4; ++q) {
            const float4 f = ((const float4*)p.fg)[q * 64 + lane];
            float4 v = o[r][q];
            v.x *= rstd * f.x; v.y *= rstd * f.y; v.z *= rstd * f.z; v.w *= rstd * f.w;
            ((float4*)p.out)[(size_t)(tk + r) * 256 + q * 64 + lane] = v;
          }
        }
      }
    }
  }
}

extern "C" void kernel_launch(void* const* d_in, const int* in_sizes, int n_in, void* d_out, int out_size, void* d_ws, size_t ws_size, hipStream_t stream) {
  static int grid_blocks = 0;
  if (!grid_blocks) {
    int dev = 0, cus = 0, per_cu = 0;
    hipGetDevice(&dev);
    hipDeviceGetAttribute(&cus, hipDeviceAttributeMultiprocessorCount, dev);
    hipOccupancyMaxActiveBlocksPerMultiprocessor(&per_cu, mega, 512, 0);
    if (per_cu > 1) per_cu = 1;
    if (per_cu < 1) per_cu = 1;
    grid_blocks = cus * per_cu;
  }
  Params p{};
  const float** pp = (const float**)&p;
  for (int i = 0; i < 20; ++i) pp[i] = (const float*)d_in[i];
  p.out = (float*)d_out;
  char* ws = (char*)d_ws;
  size_t off = 0;
  p.scal = (float*)(ws + off); off += 4096;
  p.r1 = (bf16_t*)(ws + off); off += (size_t)ROWS * D * 2;
  p.r2 = (bf16_t*)(ws + off); off += (size_t)ROWS * INC * 2;
  p.h2 = (float*)(ws + off); off += (size_t)ROWS * D * 4;
  p.wt_in = (bf16_t*)(ws + off); off += (size_t)INC * D * 2;
  p.wt_out = (bf16_t*)(ws + off); off += (size_t)D * D * 2;
  p.wt_q = (bf16_t*)(ws + off); off += (size_t)2048 * D * 2;
  p.skb = (bf16_t*)(ws + off); off += (size_t)16 * 128 * 128 * 2;
  p.ut8 = (unsigned char*)(ws + off); off += (size_t)16384 * D;
  p.vt8 = (unsigned char*)(ws + off); off += (size_t)16384 * D;
  p.uinv = (float*)(ws + off); off += 65536;
  p.vinv = (float*)(ws + off); off += 65536;
  p.wbuf = (float*)(ws + off); off += (size_t)BATCH * SEQ * 128 * 4;
  p.ssq = (float*)(ws + off); off += (size_t)BATCH * SEQ * 8 * 4;
  p.hb = (bf16_t*)(ws + off); off += (size_t)ROWS * D * 2;
  p.rowss = (float*)(ws + off); off += (size_t)ROWS * 16 * 4;
  p.eb = (int*)((char*)p.r2 + (size_t)ROWS * 2048 * 2);
  p.gb = (float*)((char*)p.eb + (size_t)ROWS * 128 * 4);
  hipMemsetAsync(d_ws, 0, 4096, stream);
  void* args[] = {&p};
  hipError_t e = hipLaunchCooperativeKernel((void*)mega, dim3(grid_blocks), dim3(512), args, 0, stream);
  if (e != hipSuccess) fprintf(stderr, "cooperative launch failed: %s (grid %d)\n", hipGetErrorString(e), grid_blocks);
}
```

```cpp
#include <hip/hip_runtime.h>
#include <hip/hip_cooperative_groups.h>
#include <cstdio>
namespace cg = cooperative_groups;
#include <stdint.h>
#include <math.h>

typedef unsigned short bf16_t;
typedef short bf16x8 __attribute__((ext_vector_type(8)));
typedef float f32x4 __attribute__((ext_vector_type(4)));

constexpr int D = 1024, BATCH = 8, SEQ = 4096, NMETA = 16, LREAL = NMETA + SEQ  , LP = 4224, ROWS = BATCH * LP;
constexpr int INC = 2560;
constexpr float EPS = 1e-6f;
constexpr float LAM_INIT = 0.2f;

__device__ __forceinline__ float bf2f(unsigned v) { return __uint_as_float(v << 16); }
__device__ __forceinline__ bf16_t f2bf(float f) { unsigned u = __float_as_uint(f); u += 0x7fffu + ((u >> 16) & 1u); return (bf16_t)(u >> 16); }
__device__ __forceinline__ unsigned pack2(float a, float b) { return (unsigned)f2bf(a) | ((unsigned)f2bf(b) << 16); }

__device__ __forceinline__ float wave_sum(float v) {
#pragma unroll
  for (int o = 32; o >= 1; o >>= 1) v += __shfl_xor(v, o);
  return v;
}
__device__ __forceinline__ float wave_max(float v) {
#pragma unroll
  for (int o = 32; o >= 1; o >>= 1) v = fmaxf(v, __shfl_xor(v, o));
  return v;
}

template <int CTRL> __device__ __forceinline__ float dpp_add(float v) { return v + __builtin_bit_cast(float, __builtin_amdgcn_update_dpp(0, __builtin_bit_cast(int, v), CTRL, 0xf, 0xf, true)); }
__device__ __forceinline__ float sum8(float v) { v = dpp_add<0x141>(v); v = dpp_add<0xB1>(v); v = dpp_add<0x4E>(v); return v; }
typedef __bf16 bf16v2 __attribute__((ext_vector_type(2)));
__device__ __forceinline__ float dot8(uint4 a, uint4 b, float acc) {
  acc = __builtin_amdgcn_fdot2_f32_bf16(__builtin_bit_cast(bf16v2, a.x), __builtin_bit_cast(bf16v2, b.x), acc, false);
  acc = __builtin_amdgcn_fdot2_f32_bf16(__builtin_bit_cast(bf16v2, a.y), __builtin_bit_cast(bf16v2, b.y), acc, false);
  acc = __builtin_amdgcn_fdot2_f32_bf16(__builtin_bit_cast(bf16v2, a.z), __builtin_bit_cast(bf16v2, b.z), acc, false);
  acc = __builtin_amdgcn_fdot2_f32_bf16(__builtin_bit_cast(bf16v2, a.w), __builtin_bit_cast(bf16v2, b.w), acc, false);
  return acc;
}
__device__ __forceinline__ float row_rstd(const float* __restrict__ rowss, size_t row) {
  const float4 a = *(const float4*)(rowss + row * 16), b = *(const float4*)(rowss + row * 16 + 4), c = *(const float4*)(rowss + row * 16 + 8), d = *(const float4*)(rowss + row * 16 + 12);
  const float t = ((a.x + a.y) + (a.z + a.w)) + ((b.x + b.y) + (b.z + b.w)) + ((c.x + c.y) + (c.z + c.w)) + ((d.x + d.y) + (d.z + d.w));
  return rsqrtf(t * (1.0f / D) + EPS);
}
__device__ __forceinline__ float row16_sum(float v) {
  v += __builtin_bit_cast(float, __builtin_amdgcn_update_dpp(0, __builtin_bit_cast(int, v), 0x128, 0xf, 0xf, true));
  v += __builtin_bit_cast(float, __builtin_amdgcn_update_dpp(0, __builtin_bit_cast(int, v), 0x124, 0xf, 0xf, true));
  v += __builtin_bit_cast(float, __builtin_amdgcn_update_dpp(0, __builtin_bit_cast(int, v), 0x122, 0xf, 0xf, true));
  v += __builtin_bit_cast(float, __builtin_amdgcn_update_dpp(0, __builtin_bit_cast(int, v), 0x121, 0xf, 0xf, true));
  return v;
}
__device__ __forceinline__ int opaque_tid() { int t = threadIdx.x; asm volatile("" : "+v"(t)); return t; }

__device__ __forceinline__ const float* hrow_ptr(const float* x, const float* meta, int row) {
  int b = row / LP, pos = row - b * LP;
  if (pos < NMETA) return meta + (size_t)pos * D;
  if (pos < LREAL) return x + ((size_t)b * SEQ + (pos - NMETA)) * D;
  return nullptr;
}

__device__ __forceinline__ void p_norm1(int blk, float* red, const float* x, const float* meta, const float* g1, bf16_t* xn1,
                                               const float* lq1, const float* lk1, const float* lq2, const float* lk2, float* scal) {
  const int tix = opaque_tid();
  int row = blk, tid = (tix & 255);
  __syncthreads();
  const float* src = hrow_ptr(x, meta, row);
  float4 v = src ? ((const float4*)src)[tid] : make_float4(0.f, 0.f, 0.f, 0.f);
  float ss = v.x * v.x + v.y * v.y + v.z * v.z + v.w * v.w;
  ss = wave_sum(ss);
  if ((tid & 63) == 0) red[tid >> 6] = ss;
  __syncthreads();
  float tot = red[0] + red[1] + red[2] + red[3];
  float rstd = rsqrtf(tot * (1.0f / D) + EPS);
  float4 g = ((const float4*)g1)[tid];
  uint2 o; o.x = pack2(v.x * rstd * g.x, v.y * rstd * g.y); o.y = pack2(v.z * rstd * g.z, v.w * rstd * g.w);
  ((uint2*)(xn1 + (size_t)row * D))[tid] = o;
  if (row == 0 && tid < 64) {
    float a = lq1[tid] * lk1[tid], b2 = lq2[tid] * lk2[tid];
    a = wave_sum(a); b2 = wave_sum(b2);
    if (tid == 0) scal[0] = expf(a) - expf(b2) + LAM_INIT;
  }
}


typedef float f32x16 __attribute__((ext_vector_type(16)));
typedef short v4i16_t __attribute__((ext_vector_type(4)));
typedef __bf16 bf16v2_t __attribute__((ext_vector_type(2)));
typedef float f32x2_t __attribute__((ext_vector_type(2)));
#define LDSP(T, p) ((__attribute__((address_space(3))) T*)(p))
#define MFMA32(a, b, c) __builtin_amdgcn_mfma_f32_32x32x16_bf16((a), (b), (c), 0, 0, 0)
__device__ __forceinline__ unsigned cvtpk(float lo, float hi) { f32x2_t v = {lo, hi}; return __builtin_bit_cast(unsigned, __builtin_convertvector(v, bf16v2_t)); }
__device__ __forceinline__ float half_swap_max(float m) { auto rr = __builtin_amdgcn_permlane32_swap(__float_as_uint(m), __float_as_uint(m), false, false); return fmaxf(__uint_as_float(rr[0]), __uint_as_float(rr[1])); }
__device__ __forceinline__ float half_swap_sum(float m) { auto rr = __builtin_amdgcn_permlane32_swap(__float_as_uint(m), __float_as_uint(m), false, false); return __uint_as_float(rr[0]) + __uint_as_float(rr[1]); }

__device__ __forceinline__ void attn_issue_kv(char* kvbuf, const bf16_t* __restrict__ kvrow0  , int tid, int wid) {
  const char* base = (const char*)kvrow0;
#pragma unroll
  for (int i = 0; i < 2; ++i) {
    const int g = i * 512 + tid, row = g >> 4, pos = g & 15;
    const unsigned offk = (unsigned)(row * (INC * 2) + 1024 + ((pos ^ (row & 15)) << 4));
    const unsigned offv = (unsigned)(row * (INC * 2) + 2048 + ((pos ^ ((row & 3) << 2)) << 4));
    __builtin_amdgcn_global_load_lds((const unsigned*)(base + offk), LDSP(unsigned, kvbuf + (i * 512 + wid * 64) * 16), 16, 0, 0);
    __builtin_amdgcn_global_load_lds((const unsigned*)(base + offv), LDSP(unsigned, kvbuf + 16384 + (i * 512 + wid * 64) * 16), 16, 0, 0);
  }
}

template <bool MASKED>
__device__ __forceinline__ void attn_map(f32x16 (&o)[4], float mref, float& l_io, const char* qbase, int qsw, const char* kb, const char* vb, int c, int kq, float sl8, int lane, int r32, int hi,
                                         const bf16x8& augk0, const bf16x8& augk1, const bf16x8& augq) {
  const float c1 = 0.125f * 1.4426950408889634f;
  asm volatile("" : "+v"(qsw), "+v"(lane));
  f32x16 s0, s1;
  float soff;
  if (MASKED) {
    const float a1 = sl8, a2 = 2.0f * sl8, a3 = 3.0f * sl8, b8 = 8.0f * sl8;
    float gb = sl8 * (float)kq;
#pragma unroll
    for (int g = 0; g < 4; ++g) { s0[4 * g] = gb; s0[4 * g + 1] = gb + a1; s0[4 * g + 2] = gb + a2; s0[4 * g + 3] = gb + a3; gb += b8; }
#pragma unroll
    for (int g = 0; g < 4; ++g) { s1[4 * g] = gb; s1[4 * g + 1] = gb + a1; s1[4 * g + 2] = gb + a2; s1[4 * g + 3] = gb + a3; gb += b8; }
#pragma unroll
    for (int r = 0; r < 16; ++r) { s0[r] = s0[r] > 0.f ? -1e30f : s0[r]; s1[r] = s1[r] > 0.f ? -1e30f : s1[r]; }
    soff = 0.f;
  } else {
#pragma unroll
    for (int r = 0; r < 16; ++r) { s0[r] = 0.f; s1[r] = 0.f; }
    s0 = MFMA32(augk0, augq, s0);
    s1 = MFMA32(augk1, augq, s1);
    soff = sl8 * (float)(kq - 4 * hi);
  }
#pragma unroll
  for (int ks = 0; ks < 4; ++ks) {
    const int ch = c * 8 + ks * 2 + hi;
    bf16x8 bq = *(const bf16x8*)(qbase + ((ch ^ qsw) << 4));
    bf16x8 ka0 = *(const bf16x8*)(kb + r32 * 256 + ((ch ^ qsw) << 4));
    bf16x8 ka1 = *(const bf16x8*)(kb + (32 + r32) * 256 + ((ch ^ qsw) << 4));
    s0 = MFMA32(ka0, bq, s0);
    s1 = MFMA32(ka1, bq, s1);
    __builtin_amdgcn_sched_barrier(0);
  }
  const f32x2_t c1v = {c1, c1}, nmv = {(soff - mref) * c1, (soff - mref) * c1};
  f32x2_t ps0 = {0.f, 0.f}, ps1 = {0.f, 0.f};
#pragma unroll
  for (int r = 0; r < 16; r += 2) {
    f32x2_t x0 = {s0[r], s0[r + 1]}, x1 = {s1[r], s1[r + 1]};
    x0 = __builtin_elementwise_fma(x0, c1v, nmv); x1 = __builtin_elementwise_fma(x1, c1v, nmv);
    x0.x = __builtin_amdgcn_exp2f(x0.x); x0.y = __builtin_amdgcn_exp2f(x0.y); x1.x = __builtin_amdgcn_exp2f(x1.x); x1.y = __builtin_amdgcn_exp2f(x1.y);
    s0[r] = x0.x; s0[r + 1] = x0.y; s1[r] = x1.x; s1[r + 1] = x1.y;
    ps0 += x0; ps1 += x1;
  }
  l_io += (ps0.x + ps0.y) + (ps1.x + ps1.y);
  const int q4 = (lane & 15) >> 2, g1 = (lane >> 4) & 1, p4 = lane & 3;
#pragma unroll
  for (int kk = 0; kk < 4; ++kk) {
    const int key0 = 16 * kk + 4 * hi + q4;
    uint4 pwv;
    if (kk < 2) { pwv.x = cvtpk(s0[8 * kk], s0[8 * kk + 1]); pwv.y = cvtpk(s0[8 * kk + 2], s0[8 * kk + 3]); pwv.z = cvtpk(s0[8 * kk + 4], s0[8 * kk + 5]); pwv.w = cvtpk(s0[8 * kk + 6], s0[8 * kk + 7]); }
    else { const int k2 = kk - 2; pwv.x = cvtpk(s1[8 * k2], s1[8 * k2 + 1]); pwv.y = cvtpk(s1[8 * k2 + 2], s1[8 * k2 + 3]); pwv.z = cvtpk(s1[8 * k2 + 4], s1[8 * k2 + 5]); pwv.w = cvtpk(s1[8 * k2 + 6], s1[8 * k2 + 7]); }
    const bf16x8 pb = __builtin_bit_cast(bf16x8, pwv);
#pragma unroll
    for (int dvt = 0; dvt < 4; ++dvt) {
      const int c8 = 8 * (dvt ^ q4) + 4 * g1 + p4;
      v4i16_t lo = __builtin_amdgcn_ds_read_tr16_b64_v4i16(LDSP(v4i16_t, vb + key0 * 256 + c8 * 8));
      v4i16_t hi4 = __builtin_amdgcn_ds_read_tr16_b64_v4i16(LDSP(v4i16_t, vb + (key0 + 8) * 256 + c8 * 8));
      bf16x8 va = (bf16x8){lo[0], lo[1], lo[2], lo[3], hi4[0], hi4[1], hi4[2], hi4[3]};
      o[dvt] = MFMA32(va, pb, o[dvt]);
    }
    __builtin_amdgcn_sched_barrier(0);
  }
}

__device__ __forceinline__ void attn_unit(char* lds, const bf16_t* __restrict__ proj, bf16_t* mix, const float* __restrict__ subg, const unsigned* __restrict__ kmax, float lam, int b, int h, int t) {
  const int tix = opaque_tid();
  const int tid = tix, lane = tid & 63, r32 = lane & 31, hi = lane >> 5;
  const int wid = __builtin_amdgcn_readfirstlane(tid >> 6);
  const int c = wid >> 2, qg = wid & 3;
  const int q0 = NMETA + 128 * t, qw0 = q0 + 32 * qg, qpos = qw0 + r32;
  const size_t rowb = (size_t)b * LP;
  const int NT = 2 * t + 3;
  char* Qs = lds;
  char* KV = lds + 32768;
  const float sl8 = exp2f(1.0f - 2.0f * (float)h);
  __syncthreads();
  attn_issue_kv(KV, proj + rowb * INC + h * 128, tid, wid);
#pragma unroll
  for (int i = 0; i < 4; ++i) {
    const int g = i * 512 + tid, row = g >> 4, pos = g & 15;
    uint4 v = *(const uint4*)(proj + (rowb + q0 + row) * INC + h * 128 + ((pos ^ (row & 15)) << 3));
    *(uint4*)(Qs + g * 16) = v;
  }
  f32x16 o[4];
#pragma unroll
  for (int i = 0; i < 4; ++i)
#pragma unroll
    for (int r = 0; r < 16; ++r) o[i][r] = 0.f;
  float l = 0.f;
  bf16x8 augk0, augk1, augq;
  {
    const unsigned k0w = hi == 0 ? cvtpk((float)r32, 0.f) : 0u, k1w = hi == 0 ? cvtpk((float)(32 + r32), 0.f) : 0u, qw = hi == 0 ? cvtpk(sl8, 0.f) : 0u;
    augk0 = __builtin_bit_cast(bf16x8, make_uint4(k0w, 0u, 0u, 0u)); augk1 = __builtin_bit_cast(bf16x8, make_uint4(k1w, 0u, 0u, 0u)); augq = __builtin_bit_cast(bf16x8, make_uint4(qw, 0u, 0u, 0u));
  }
  const int qrow = 32 * qg + r32;
  const char* qbase = Qs + qrow * 256;
  const int qsw = qrow & 15;
  float mref;
  {
    float kn2 = 0.f;
    if (lane < 16) {
      const uint4* kp = (const uint4*)(proj + (rowb + lane) * INC + 512 + h * 128 + c * 64);
#pragma unroll
      for (int i = 0; i < 8; ++i) { const uint4 w = kp[i]; kn2 = dot8(w, w, kn2); }
    }
    kn2 = fmaxf(wave_max(kn2), __uint_as_float(kmax[b * 8 + h * 2 + c]));
    __syncthreads();
    float qn2 = 0.f;
#pragma unroll
    for (int ks = 0; ks < 4; ++ks) { const uint4 w = *(const uint4*)(qbase + (((c * 8 + ks * 2 + hi) ^ qsw) << 4)); qn2 = dot8(w, w, qn2); }
    qn2 = half_swap_sum(qn2);
    mref = sqrtf(qn2 * kn2) * 1.02f - 60.0f / (0.125f * 1.4426950408889634f);
  }
  for (int j = 0; j < NT; ++j) {
    __syncthreads();
    if (j + 1 < NT) attn_issue_kv(KV + ((j + 1) & 1) * 32768, proj + (rowb + 64 * (j + 1)) * INC + h * 128, tid, wid);
    if (64 * j > qw0 + 31) continue;
    const char* kb = KV + (j & 1) * 32768;
    const char* vb = kb + 16384;
    const int kq = 64 * j + 4 * hi - qpos;
    if (64 * j + 63 > qw0) attn_map<true>(o, mref, l, qbase, qsw, kb, vb, c, kq, sl8, lane, r32, hi, augk0, augk1, augq);
    else attn_map<false>(o, mref, l, qbase, qsw, kb, vb, c, kq, sl8, lane, r32, hi, augk0, augk1, augq);
  }
  l = half_swap_sum(l);
  const float sc = (c == 0 ? 1.0f : lam) / l;
  __syncthreads();
  float* X = (float*)(lds + 32768);
  if (c == 1) {
#pragma unroll
    for (int i = 0; i < 4; ++i)
#pragma unroll
      for (int r = 0; r < 16; ++r) X[(qg * 64 + i * 16 + r) * 64 + lane] = o[i][r] * sc;
  }
  __syncthreads();
  if (c == 0) {
    float ss = 0.f;
#pragma unroll
    for (int i = 0; i < 4; ++i) {
#pragma unroll
      for (int r = 0; r < 16; ++r) { float v = o[i][r] * sc - X[(qg * 64 + i * 16 + r) * 64 + lane]; o[i][r] = v; ss += v * v; }
      __builtin_amdgcn_sched_barrier(0);
    }
    ss = half_swap_sum(ss);
    const float rstd = rsqrtf(ss * (1.0f / 128.0f) + EPS) * (1.0f - LAM_INIT);
    bf16_t* orow = mix + (rowb + qpos) * D + h * 128;
#pragma unroll
    for (int i = 0; i < 4; ++i) {
#pragma unroll
      for (int g = 0; g < 4; ++g) {
        const int dv0 = 32 * i + 8 * g + 4 * hi;
        const float4 sg = *(const float4*)(subg + dv0);
        uint2 w; w.x = cvtpk(o[i][4 * g] * rstd * sg.x, o[i][4 * g + 1] * rstd * sg.y); w.y = cvtpk(o[i][4 * g + 2] * rstd * sg.z, o[i][4 * g + 3] * rstd * sg.w);
        *(uint2*)(orow + dv0) = w;
      }
      __builtin_amdgcn_sched_barrier(0);
    }
  }
}


__device__ __forceinline__ void p_norm1_rows(int G, const float* __restrict__ x, const float* __restrict__ meta, const float* __restrict__ g1, bf16_t* xn1) {
  const int tix = opaque_tid();
  const int lane = tix & 63, wv = blockIdx.x * 8 + (tix >> 6);
  float4 g[4];
#pragma unroll
  for (int q = 0; q < 4; ++q) g[q] = ((const float4*)g1)[q * 64 + lane];
  for (int row = wv * 2; row < ROWS; row += G * 16) {
    float4 v[2][4];
#pragma unroll
    for (int r = 0; r < 2; ++r) {
      const float* src = hrow_ptr(x, meta, row + r);
#pragma unroll
      for (int q = 0; q < 4; ++q) v[r][q] = src ? ((const float4*)src)[q * 64 + lane] : make_float4(0.f, 0.f, 0.f, 0.f);
    }
#pragma unroll
    for (int r = 0; r < 2; ++r) {
      float ss = 0.f;
#pragma unroll
      for (int q = 0; q < 4; ++q) ss += (v[r][q].x * v[r][q].x + v[r][q].y * v[r][q].y) + (v[r][q].z * v[r][q].z + v[r][q].w * v[r][q].w);
      const float rstd = rsqrtf(wave_sum(ss) * (1.0f / D) + EPS);
#pragma unroll
      for (int q = 0; q < 4; ++q) {
        uint2 o; o.x = cvtpk(v[r][q].x * rstd * g[q].x, v[r][q].y * rstd * g[q].y); o.y = cvtpk(v[r][q].z * rstd * g[q].z, v[r][q].w * rstd * g[q].w);
        ((uint2*)(xn1 + (size_t)(row + r) * D))[q * 64 + lane] = o;
      }
    }
  }
}

__device__ __forceinline__ void conv_unit(char* lds, const bf16_t* __restrict__ proj, bf16_t* mix, const float* __restrict__ cw, const float* __restrict__ cb,
                                          const float* __restrict__ gng, const float* __restrict__ gnb, int b, int pos0) {
  const int tix = opaque_tid();
  const int c = tix;
  float* U = (float*)lds;
  __syncthreads();
  {
    const int lane = tix & 63, wv = tix >> 6;
    uint4 ra[8], rg[8];
#pragma unroll
    for (int i = 0; i < 8; ++i) {
      const int r = wv + 8 * i, pos = pos0 - 30 + r;
      ra[i] = make_uint4(0, 0, 0, 0); rg[i] = make_uint4(0, 0, 0, 0);
      if (r < 62 && pos >= 0) {
        const bf16_t* pr = proj + ((size_t)b * LP + pos) * INC + 8 * lane;
        ra[i] = *(const uint4*)(pr + 1536); rg[i] = *(const uint4*)(pr + 2048);
      }
    }
#pragma unroll
    for (int i = 0; i < 8; ++i) {
      const int r = wv + 8 * i;
      if (r < 62) {
        const unsigned av[4] = {ra[i].x, ra[i].y, ra[i].z, ra[i].w}, gv[4] = {rg[i].x, rg[i].y, rg[i].z, rg[i].w};
        float u[8];
#pragma unroll
        for (int q = 0; q < 4; ++q) {
          const float a0 = __uint_as_float(av[q] << 16), a1 = __uint_as_float(av[q] & 0xffff0000u), g0 = __uint_as_float(gv[q] << 16), g1 = __uint_as_float(gv[q] & 0xffff0000u);
          u[2 * q] = a0 / (1.0f + __expf(-g0)); u[2 * q + 1] = a1 / (1.0f + __expf(-g1));
        }
        *(float4*)(U + r * 512 + 8 * lane) = make_float4(u[0], u[1], u[2], u[3]);
        *(float4*)(U + r * 512 + 8 * lane + 4) = make_float4(u[4], u[5], u[6], u[7]);
      }
    }
  }
  float w[31];
#pragma unroll
  for (int j = 0; j < 31; ++j) w[j] = cw[j * 512 + c];
  const float bias = cb[c], gg = gng[c], gb2 = gnb[c];
  __syncthreads();
#pragma unroll 1
  for (int t0 = 0; t0 < 32; t0 += 4) {
    float y[4] = {bias, bias, bias, bias};
#pragma unroll
    for (int r = 0; r < 34; ++r) {
      const float u = U[(t0 + r) * 512 + c];
#pragma unroll
      for (int q = 0; q < 4; ++q) { const int j = r - q; if (j >= 0 && j < 31) y[q] = fmaf(w[j], u, y[q]); }
    }
#pragma unroll
    for (int q = 0; q < 4; ++q) {
      float sm = row16_sum(y[q]);
      sm += __shfl_xor(sm, 16); sm = half_swap_sum(sm);
      const float d = y[q] - sm * (1.0f / 64.0f);
      float vr = row16_sum(d * d);
      vr += __shfl_xor(vr, 16); vr = half_swap_sum(vr);
      const float n = d * rsqrtf(vr * (1.0f / 64.0f) + EPS) * gg + gb2;
      mix[((size_t)b * LP + pos0 + t0 + q) * D + 512 + c] = f2bf(n / (1.0f + __expf(-n)));
    }
  }
}

__device__ __forceinline__ void p_conv_naive(int blk, const bf16_t* __restrict__ proj, bf16_t* mix, const float* cw, const float* cb, const float* gg_, const float* gb_) {
  const int tix = opaque_tid();
  int row = blk, tid = (tix & 255);
  int b = row / LP, pos = row - b * LP;
  int c0 = tid * 2;
  unsigned* outp = (unsigned*)(mix + (size_t)row * D + 512 + c0);
  if (pos >= LREAL) { *outp = 0u; return; }
  float y0 = cb[c0], y1 = cb[c0 + 1];
  for (int j = 0; j < 31; ++j) {
    int p = pos - 30 + j;
    if (p < 0) continue;
    const bf16_t* pr = proj + ((size_t)b * LP + p) * INC;
    unsigned a = *(const unsigned*)(pr + 1536 + c0), g = *(const unsigned*)(pr + 2048 + c0);
    float a0 = bf2f(a & 0xffffu), a1 = bf2f(a >> 16), g0 = bf2f(g & 0xffffu), g1 = bf2f(g >> 16);
    float u0 = a0 / (1.0f + __expf(-g0)), u1 = a1 / (1.0f + __expf(-g1));
    y0 += cw[j * 512 + c0] * u0; y1 += cw[j * 512 + c0 + 1] * u1;
  }
  float s = y0 + y1;
#pragma unroll
  for (int o = 16; o >= 1; o >>= 1) s += __shfl_xor(s, o);
  float mu = s * (1.0f / 64.0f);
  float d0 = y0 - mu, d1 = y1 - mu;
  float v = d0 * d0 + d1 * d1;
#pragma unroll
  for (int o = 16; o >= 1; o >>= 1) v += __shfl_xor(v, o);
  float rstd = rsqrtf(v * (1.0f / 64.0f) + EPS);
  float n0 = d0 * rstd * gg_[c0] + gb_[c0], n1 = d1 * rstd * gg_[c0 + 1] + gb_[c0 + 1];
  float r0 = n0 / (1.0f + __expf(-n0)), r1 = n1 / (1.0f + __expf(-n1));
  *outp = pack2(r0, r1);
}

__device__ __forceinline__ void p_norm2(int blk, float* red, const float* h2, const float* g2, bf16_t* xn2) {
  const int tix = opaque_tid();
  int row = blk, tid = (tix & 255);
  __syncthreads();
  float4 v = ((const float4*)(h2 + (size_t)row * D))[tid];
  float ss = v.x * v.x + v.y * v.y + v.z * v.z + v.w * v.w;
  ss = wave_sum(ss);
  if ((tid & 63) == 0) red[tid >> 6] = ss;
  __syncthreads();
  float tot = red[0] + red[1] + red[2] + red[3];
  float rstd = rsqrtf(tot * (1.0f / D) + EPS);
  float4 g = ((const float4*)g2)[tid];
  uint2 o; o.x = pack2(v.x * rstd * g.x, v.y * rstd * g.y); o.y = pack2(v.z * rstd * g.z, v.w * rstd * g.w);
  ((uint2*)(xn2 + (size_t)row * D))[tid] = o;
}

__device__ __forceinline__ void p_topk_naive(int blk, const bf16_t* __restrict__ qp, const float* __restrict__ sk, int* eb, float* gb) {
  const int tix = opaque_tid();
  int w = blk * 4 + ((tix & 255) >> 6), lane = (tix & 255) & 63;
  int row = w >> 3, h = w & 7;
  int pos = row % LP;
  if (pos < NMETA || pos >= LREAL) return;
  const float NEG = -3.0e38f;
  float top[2];
#pragma unroll
  for (int p = 0; p < 2; ++p) {
    const bf16_t* qv = qp + (size_t)row * 2048 + h * 256 + p * 128;
    const float* k0 = sk + ((size_t)(h * 2 + p) * 128 + lane) * 128;
    const float* k1 = k0 + 64 * 128;
    float s0 = 0.f, s1 = 0.f;
    for (int d = 0; d < 128; d += 8) {
      uint4 r = *(const uint4*)(qv + d);
      float qf[8] = {bf2f(r.x & 0xffffu), bf2f(r.x >> 16), bf2f(r.y & 0xffffu), bf2f(r.y >> 16), bf2f(r.z & 0xffffu), bf2f(r.z >> 16), bf2f(r.w & 0xffffu), bf2f(r.w >> 16)};
      float4 a0 = *(const float4*)(k0 + d), a1 = *(const float4*)(k0 + d + 4), b0 = *(const float4*)(k1 + d), b1 = *(const float4*)(k1 + d + 4);
      s0 += qf[0] * a0.x + qf[1] * a0.y + qf[2] * a0.z + qf[3] * a0.w + qf[4] * a1.x + qf[5] * a1.y + qf[6] * a1.z + qf[7] * a1.w;
      s1 += qf[0] * b0.x + qf[1] * b0.y + qf[2] * b0.z + qf[3] * b0.w + qf[4] * b1.x + qf[5] * b1.y + qf[6] * b1.z + qf[7] * b1.w;
    }
    float v0 = __uint_as_float((__float_as_uint(s0) & ~127u) | (unsigned)lane);
    float v1 = __uint_as_float((__float_as_uint(s1) & ~127u) | (unsigned)(lane + 64));
    float t = NEG;
    for (int it = 0; it < 16; ++it) {
      float m = wave_max(fmaxf(v0, v1));
      if (lane == it) t = m;
      if (v0 == m) v0 = NEG;
      if (v1 == m) v1 = NEG;
    }
    top[p] = t;
  }
  int ci = lane >> 2, jb = (lane & 3) * 4;
  float av = __uint_as_float(__float_as_uint(__shfl(top[0], ci)) & ~127u);
  float c[4];
#pragma unroll
  for (int jj = 0; jj < 4; ++jj) {
    float bv = __uint_as_float(__float_as_uint(__shfl(top[1], jb + jj)) & ~127u);
    float s = av + bv;
    c[jj] = __uint_as_float((__float_as_uint(s) & ~255u) | (unsigned)(ci * 16 + jb + jj));
  }
  float ct = NEG;
  for (int it = 0; it < 16; ++it) {
    float m = wave_max(fmaxf(fmaxf(c[0], c[1]), fmaxf(c[2], c[3])));
    if (lane == it) ct = m;
#pragma unroll
    for (int jj = 0; jj < 4; ++jj) if (c[jj] == m) c[jj] = NEG;
  }
  unsigned cbits = __float_as_uint(ct);
  int cidx = cbits & 255u;
  float cval = __uint_as_float(cbits & ~255u);
  int i1 = __float_as_uint(__shfl(top[0], (cidx >> 4) & 15)) & 127u;
  int i2 = __float_as_uint(__shfl(top[1], cidx & 15)) & 127u;
  float mx = __shfl(cval, 0);
  float ex = lane < 16 ? __expf(cval - mx) : 0.f;
  float sum = wave_sum(ex);
  if (lane < 16) {
    eb[((size_t)row * 8 + h) * 16 + lane] = i1 * 128 + i2;
    gb[((size_t)row * 8 + h) * 16 + lane] = ex / sum;
  }
}


__device__ __forceinline__ void ce_desc(float& a, float& b) { const float hi = fmaxf(a, b), lo = fminf(a, b); a = hi; b = lo; }
__device__ __forceinline__ void ce_asc(float& a, float& b) { const float hi = fmaxf(a, b), lo = fminf(a, b); a = lo; b = hi; }
template <int N> __device__ __forceinline__ void bitonic_sort_desc(float (&v)[N]) {
#pragma unroll
  for (int k = 2; k <= N; k <<= 1)
#pragma unroll
    for (int j = k >> 1; j > 0; j >>= 1)
#pragma unroll
      for (int i = 0; i < N; ++i) { const int l = i ^ j; if (l > i) { if ((i & k) == 0) ce_desc(v[i], v[l]); else ce_asc(v[i], v[l]); } }
}
template <int N> __device__ __forceinline__ void bitonic_merge_desc(float (&v)[N]) {
#pragma unroll
  for (int j = N >> 1; j > 0; j >>= 1)
#pragma unroll
    for (int i = 0; i < N; ++i) { const int l = i ^ j; if (l > i) ce_desc(v[i], v[l]); }
}
__device__ __forceinline__ void cep_desc(float& a, float& b, int& pa, int& pb) { const bool sw = b > a; const float hi = sw ? b : a, lo = sw ? a : b; const int ph = sw ? pb : pa, pl = sw ? pa : pb; a = hi; b = lo; pa = ph; pb = pl; }
__device__ __forceinline__ void cep_asc(float& a, float& b, int& pa, int& pb) { const bool sw = b < a; const float lo = sw ? b : a, hi = sw ? a : b; const int pl = sw ? pb : pa, ph = sw ? pa : pb; a = lo; b = hi; pa = pl; pb = ph; }
template <int N> __device__ __forceinline__ void bitonic_sortp_desc(float (&v)[N], int (&q)[N]) {
#pragma unroll
  for (int k = 2; k <= N; k <<= 1)
#pragma unroll
    for (int j = k >> 1; j > 0; j >>= 1)
#pragma unroll
      for (int i = 0; i < N; ++i) { const int l = i ^ j; if (l > i) { if ((i & k) == 0) cep_desc(v[i], v[l], q[i], q[l]); else cep_asc(v[i], v[l], q[i], q[l]); } }
}
template <int N> __device__ __forceinline__ void bitonic_mergep_desc(float (&v)[N], int (&q)[N]) {
#pragma unroll
  for (int j = N >> 1; j > 0; j >>= 1)
#pragma unroll
    for (int i = 0; i < N; ++i) { const int l = i ^ j; if (l > i) cep_desc(v[i], v[l], q[i], q[l]); }
}
__host__ __device__ constexpr int cand_slot(int i, int j) { int s = 0; for (int ii = 0; ii < i; ++ii) s += 16 / (ii + 1); return s + j; }

__device__ __forceinline__ void peer_topk_unit(char* lds, const bf16_t* __restrict__ qp, const bf16_t* __restrict__ skb, const float* __restrict__ rowss, int* eb, float* gb, int row0, int h) {
  const int tix = opaque_tid();
  const int tid = tix, lane = tid & 63, wid = tid >> 6, fr = lane & 15, fq = lane >> 4;
  __syncthreads();
#pragma unroll
  for (int i = 0; i < 8; ++i) {
    const int g = i * 512 + tid, row = g >> 4, pos = g & 15;
    *(uint4*)(lds + g * 16) = *(const uint4*)(skb + ((size_t)(h * 2) * 128 + row) * 128 + ((pos ^ (row & 15)) << 3));
  }
  if (tid < 64) {
    int i = 0, base = 0;
    while (i < 15 && tid >= base + 16 / (i + 1)) { base += 16 / (i + 1); ++i; }
    ((int*)(lds + 65536))[tid] = (i << 4) | ((tid - base) & 15);
  }
  __syncthreads();
  const int tok = row0 + wid * 16 + fr;
  float top[2][16];
#pragma unroll
  for (int p = 0; p < 2; ++p) {
    f32x4 acc[8];
#pragma unroll
    for (int i = 0; i < 8; ++i) acc[i] = (f32x4){0.f, 0.f, 0.f, 0.f};
    const bf16_t* xrow = qp + (size_t)tok * 2048 + h * 256 + p * 128 + fq * 8;
#pragma unroll
    for (int ks = 0; ks < 4; ++ks) {
      const bf16x8 xb = *(const bf16x8*)(xrow + ks * 32);
      const int ch = ks * 4 + fq;
#pragma unroll
      for (int nt = 0; nt < 8; ++nt) {
        const int r = p * 128 + nt * 16 + fr;
        const bf16x8 wa = *(const bf16x8*)(lds + r * 256 + ((ch ^ (r & 15)) << 4));
        acc[nt] = __builtin_amdgcn_mfma_f32_16x16x32_bf16(wa, xb, acc[nt], 0, 0, 0);
      }
    }
    float v[32];
#pragma unroll
    for (int nt = 0; nt < 8; ++nt)
#pragma unroll
      for (int r = 0; r < 4; ++r) v[nt * 4 + r] = __uint_as_float((__float_as_uint(acc[nt][r]) & ~127u) | (unsigned)(nt * 16 + fq * 4 + r));
    bitonic_sort_desc<32>(v);
    float t[16];
#pragma unroll
    for (int i = 0; i < 16; ++i) t[i] = v[i];
#pragma unroll
    for (int rnd = 0; rnd < 2; ++rnd) {
      float pb[16];
#pragma unroll
      for (int i = 0; i < 16; ++i) pb[i] = __shfl_xor(t[15 - i], rnd == 0 ? 16 : 32);
#pragma unroll
      for (int i = 0; i < 16; ++i) t[i] = fmaxf(t[i], pb[i]);
      bitonic_merge_desc<16>(t);
    }
#pragma unroll
    for (int i = 0; i < 16; ++i) top[p][i] = t[i];
  }
  int* ST = (int*)(lds + 65536);
  int* IDX = (int*)(lds + 65536 + 256) + (wid * 16 + fr) * 32;
#define SEL4(arr, q) (fq == 0 ? arr[q] : fq == 1 ? arr[4 + (q)] : fq == 2 ? arr[8 + (q)] : arr[12 + (q)])
  {
    int4 ia, ib;
    ia.x = __float_as_uint(SEL4(top[0], 0)) & 127; ia.y = __float_as_uint(SEL4(top[0], 1)) & 127; ia.z = __float_as_uint(SEL4(top[0], 2)) & 127; ia.w = __float_as_uint(SEL4(top[0], 3)) & 127;
    ib.x = __float_as_uint(SEL4(top[1], 0)) & 127; ib.y = __float_as_uint(SEL4(top[1], 1)) & 127; ib.z = __float_as_uint(SEL4(top[1], 2)) & 127; ib.w = __float_as_uint(SEL4(top[1], 3)) & 127;
    *(int4*)(IDX + 4 * fq) = ia; *(int4*)(IDX + 16 + 4 * fq) = ib;
  }
  float cv[16];
  {
    const float NEGV = -3.0e38f;
    float am[16], bm[16];
#pragma unroll
    for (int i = 0; i < 16; ++i) { am[i] = __uint_as_float(__float_as_uint(top[0][i]) & ~127u); bm[i] = __uint_as_float(__float_as_uint(top[1][i]) & ~127u); }
#define CAND(i, j) __uint_as_float((__float_as_uint(am[i] + bm[j]) & ~63u) | (unsigned)cand_slot(i, j))
    float A[16], B[16], C[16], Dd[8], E[8], F[16];
#pragma unroll
    for (int j = 0; j < 16; ++j) A[j] = CAND(0, j);
#pragma unroll
    for (int j = 0; j < 8; ++j) { B[j] = CAND(1, j); B[15 - j] = CAND(8 + j, 0); }
    bitonic_merge_desc<16>(B);
#pragma unroll
    for (int j = 0; j < 5; ++j) C[j] = CAND(2, j);
#pragma unroll
    for (int j = 5; j < 12; ++j) C[j] = NEGV;
#pragma unroll
    for (int j = 0; j < 4; ++j) C[15 - j] = CAND(3, j);
    bitonic_merge_desc<16>(C);
    Dd[0] = CAND(4, 0); Dd[1] = CAND(4, 1); Dd[2] = CAND(4, 2); Dd[3] = NEGV; Dd[4] = NEGV; Dd[5] = NEGV; Dd[6] = CAND(5, 1); Dd[7] = CAND(5, 0);
    bitonic_merge_desc<8>(Dd);
    E[0] = CAND(6, 0); E[1] = CAND(6, 1); E[2] = NEGV; E[3] = NEGV; E[4] = NEGV; E[5] = NEGV; E[6] = CAND(7, 1); E[7] = CAND(7, 0);
    bitonic_merge_desc<8>(E);
#pragma unroll
    for (int j = 0; j < 8; ++j) { F[j] = Dd[j]; F[15 - j] = E[j]; }
    bitonic_merge_desc<16>(F);
#undef CAND
#pragma unroll
    for (int j = 0; j < 16; ++j) { A[j] = fmaxf(A[j], B[15 - j]); C[j] = fmaxf(C[j], F[15 - j]); }
    bitonic_merge_desc<16>(A);
    bitonic_merge_desc<16>(C);
#pragma unroll
    for (int j = 0; j < 16; ++j) cv[j] = fmaxf(A[j], C[15 - j]);
    bitonic_merge_desc<16>(cv);
  }
  float ex[16]; float sum = 0.f;
  const float c0v = __uint_as_float(__float_as_uint(cv[0]) & ~63u);
  const float rs = row_rstd(rowss, (size_t)tok);
#pragma unroll
  for (int i = 0; i < 16; ++i) { ex[i] = __expf((__uint_as_float(__float_as_uint(cv[i]) & ~63u) - c0v) * rs); sum += ex[i]; }
  const float inv = 1.0f / sum;
  int e4[4]; float g4[4];
#pragma unroll
  for (int q = 0; q < 4; ++q) {
    const int slot = __float_as_uint(SEL4(cv, q)) & 63;
    const int ij = ST[slot];
    e4[q] = IDX[ij >> 4] * 128 + IDX[16 + (ij & 15)];
    g4[q] = SEL4(ex, q) * inv;
  }
#undef SEL4
  *(int4*)(eb + ((size_t)tok * 8 + h) * 16 + 4 * fq) = make_int4(e4[0], e4[1], e4[2], e4[3]);
  *(float4*)(gb + ((size_t)tok * 8 + h) * 16 + 4 * fq) = make_float4(g4[0], g4[1], g4[2], g4[3]);
}

__device__ __forceinline__ void p_cvt_bf16(int blk, int nblk, const float* __restrict__ src, bf16_t* dst, size_t n8) {
  const int tix = opaque_tid();
  for (size_t i = (size_t)blk * 512 + tix; i < n8; i += (size_t)nblk * 512) {
    const float4 a = ((const float4*)src)[2 * i], b = ((const float4*)src)[2 * i + 1];
    uint4 w; w.x = cvtpk(a.x, a.y); w.y = cvtpk(a.z, a.w); w.z = cvtpk(b.x, b.y); w.w = cvtpk(b.z, b.w);
    ((uint4*)dst)[i] = w;
  }
}


typedef float f32x2v __attribute__((ext_vector_type(2)));
__device__ __forceinline__ void p_cvt_fp8_rows(int blk, int nblk, const float* __restrict__ src, unsigned* dst, float* inv, const float* __restrict__ csc) {
  const int tix = opaque_tid();
  const int lane = tix & 63, wid = tix >> 6;
  for (int r = blk * 8 + wid; r < 16384; r += nblk * 8) {
    const float4* sp = (const float4*)(src + (size_t)r * D);
    float4 v[4];
#pragma unroll
    for (int k = 0; k < 4; ++k) v[k] = sp[k * 64 + lane];
    if (csc) {
#pragma unroll
      for (int k = 0; k < 4; ++k) { const float4 g = ((const float4*)csc)[k * 64 + lane]; v[k].x *= g.x; v[k].y *= g.y; v[k].z *= g.z; v[k].w *= g.w; }
    }
    float am = 0.f;
#pragma unroll
    for (int k = 0; k < 4; ++k) am = fmaxf(am, fmaxf(fmaxf(fabsf(v[k].x), fabsf(v[k].y)), fmaxf(fabsf(v[k].z), fabsf(v[k].w))));
    am = wave_max(am);
    const float sc = am > 0.f ? 384.0f / am : 1.0f;
#pragma unroll
    for (int k = 0; k < 4; ++k) {
      int w = __builtin_amdgcn_cvt_pk_fp8_f32(v[k].x * sc, v[k].y * sc, 0, false);
      w = __builtin_amdgcn_cvt_pk_fp8_f32(v[k].z * sc, v[k].w * sc, w, true);
      { const int c = 256 * k + 4 * lane; dst[((size_t)(c >> 7) * (16384 * 128) + (size_t)r * 128 + (c & 127)) >> 2] = (unsigned)w; }
    }
    if (lane == 0) inv[r] = am > 0.f ? am * (1.0f / 384.0f) : 1.0f;
  }
}
__device__ __forceinline__ void peer_gather_token(char* wlds  , int lane, size_t row, size_t orow, const bf16_t* __restrict__ xn2, const float* __restrict__ h2,
                                                  const int* __restrict__ eb, const float* __restrict__ gb, const unsigned char* __restrict__ ut8, const float* __restrict__ uinv,
                                                  const unsigned char* __restrict__ vt8, const float* __restrict__ vinv, const float* __restrict__ fg, float* __restrict__ out) {
  int* E = (int*)wlds; float* Gt = (float*)(wlds + 512); float* W = (float*)(wlds + 1024);
  const int i16 = lane & 15, g = lane >> 4;
  {
    const int e0 = eb[row * 128 + lane], e1 = eb[row * 128 + 64 + lane];
    E[lane] = e0; E[lane + 64] = e1;
    Gt[lane] = gb[row * 128 + lane]; Gt[lane + 64] = gb[row * 128 + 64 + lane];
  }
  float xf[4][16];
#pragma unroll
  for (int k = 0; k < 4; ++k) {
    const uint4 a = *(const uint4*)(xn2 + row * D + 256 * k + 16 * i16), b = *(const uint4*)(xn2 + row * D + 256 * k + 16 * i16 + 8);
    xf[k][0] = __uint_as_float(a.x << 16); xf[k][1] = __uint_as_float(a.x & 0xffff0000u); xf[k][2] = __uint_as_float(a.y << 16); xf[k][3] = __uint_as_float(a.y & 0xffff0000u);
    xf[k][4] = __uint_as_float(a.z << 16); xf[k][5] = __uint_as_float(a.z & 0xffff0000u); xf[k][6] = __uint_as_float(a.w << 16); xf[k][7] = __uint_as_float(a.w & 0xffff0000u);
    xf[k][8] = __uint_as_float(b.x << 16); xf[k][9] = __uint_as_float(b.x & 0xffff0000u); xf[k][10] = __uint_as_float(b.y << 16); xf[k][11] = __uint_as_float(b.y & 0xffff0000u);
    xf[k][12] = __uint_as_float(b.z << 16); xf[k][13] = __uint_as_float(b.z & 0xffff0000u); xf[k][14] = __uint_as_float(b.w << 16); xf[k][15] = __uint_as_float(b.w & 0xffff0000u);
  }
#pragma unroll 2
  for (int m = 0; m < 32; ++m) {
    const int e = E[4 * m + g];
    const unsigned char* ur = ut8 + (size_t)e * D + 16 * i16;
    uint4 u[4];
#pragma unroll
    for (int k = 0; k < 4; ++k) u[k] = *(const uint4*)(ur + 256 * k);
    float d0 = 0.f, d1 = 0.f;
#pragma unroll
    for (int k = 0; k < 4; ++k) {
      const unsigned wv[4] = {u[k].x, u[k].y, u[k].z, u[k].w};
#pragma unroll
      for (int q = 0; q < 4; ++q) {
        const f32x2v lo = __builtin_amdgcn_cvt_pk_f32_fp8((int)wv[q], false), hi = __builtin_amdgcn_cvt_pk_f32_fp8((int)wv[q], true);
        d0 = fmaf(lo.x, xf[k][4 * q], d0); d1 = fmaf(lo.y, xf[k][4 * q + 1], d1);
        d0 = fmaf(hi.x, xf[k][4 * q + 2], d0); d1 = fmaf(hi.y, xf[k][4 * q + 3], d1);
      }
    }
    const float d = row16_sum(d0 + d1);
    if (i16 == 0) W[4 * m + g] = d;
  }
  {
    const int e0 = E[lane], e1 = E[lane + 64];
    const float ui0 = uinv[e0], ui1 = uinv[e1];
    const float a0 = W[lane] * ui0, a1 = W[lane + 64] * ui1;
    const float g0 = Gt[lane], g1 = Gt[lane + 64];
    W[lane] = g0 * 0.5f * a0 * (1.0f + erff(a0 * 0.70710678118654752f)) * vinv[e0];
    W[lane + 64] = g1 * 0.5f * a1 * (1.0f + erff(a1 * 0.70710678118654752f)) * vinv[e1];
  }
  float acc[4][16];
#pragma unroll
  for (int k = 0; k < 4; ++k)
#pragma unroll
    for (int i = 0; i < 16; ++i) acc[k][i] = 0.f;
#pragma unroll 2
  for (int m = 0; m < 32; ++m) {
    const int e = E[4 * m + g];
    const float w = W[4 * m + g];
    const unsigned char* vr = vt8 + (size_t)e * D + 16 * i16;
    uint4 v[4];
#pragma unroll
    for (int k = 0; k < 4; ++k) v[k] = *(const uint4*)(vr + 256 * k);
#pragma unroll
    for (int k = 0; k < 4; ++k) {
      const unsigned wv[4] = {v[k].x, v[k].y, v[k].z, v[k].w};
#pragma unroll
      for (int q = 0; q < 4; ++q) {
        const f32x2v lo = __builtin_amdgcn_cvt_pk_f32_fp8((int)wv[q], false), hi = __builtin_amdgcn_cvt_pk_f32_fp8((int)wv[q], true);
        acc[k][4 * q] = fmaf(w, lo.x, acc[k][4 * q]); acc[k][4 * q + 1] = fmaf(w, lo.y, acc[k][4 * q + 1]);
        acc[k][4 * q + 2] = fmaf(w, hi.x, acc[k][4 * q + 2]); acc[k][4 * q + 3] = fmaf(w, hi.y, acc[k][4 * q + 3]);
      }
    }
  }
  float res[16];
#pragma unroll
  for (int k = 0; k < 4; ++k)
#pragma unroll
    for (int j = 0; j < 16; ++j) {
      float t = acc[k][j];
      t += __shfl_xor(t, 16); t += __shfl_xor(t, 32);
      if (k == g) res[j] = t;
    }
  const int c0 = 256 * g + 16 * i16;
  float ss = 0.f;
#pragma unroll
  for (int q = 0; q < 4; ++q) {
    const float4 hv = *(const float4*)(h2 + row * D + c0 + 4 * q);
    res[4 * q] += hv.x; res[4 * q + 1] += hv.y; res[4 * q + 2] += hv.z; res[4 * q + 3] += hv.w;
  }
#pragma unroll
  for (int i = 0; i < 16; ++i) ss += res[i] * res[i];
  ss = wave_sum(ss);
  const float rstd = rsqrtf(ss * (1.0f / D) + EPS);
#pragma unroll
  for (int q = 0; q < 4; ++q) {
    const float4 f = *(const float4*)(fg + c0 + 4 * q);
    *(float4*)(out + orow * D + c0 + 4 * q) = make_float4(res[4 * q] * rstd * f.x, res[4 * q + 1] * rstd * f.y, res[4 * q + 2] * rstd * f.z, res[4 * q + 3] * rstd * f.w);
  }
}


__device__ __forceinline__ unsigned xcc_id() { return (unsigned)__builtin_amdgcn_s_getreg((3 << 11) | 20) & 7u; }

__device__ __forceinline__ void ds_issue(uint4 (&u)[16], const int* El  , const unsigned char* __restrict__ tab) {
  int ev[16];
#pragma unroll
  for (int q = 0; q < 4; ++q) { const int4 t = *(const int4*)(El + 4 * q); ev[4 * q] = t.x; ev[4 * q + 1] = t.y; ev[4 * q + 2] = t.z; ev[4 * q + 3] = t.w; }
#pragma unroll
  for (int it = 0; it < 16; ++it) u[it] = *(const uint4*)(tab + (size_t)(unsigned)ev[it] * 128);
}
__device__ __forceinline__ void ds_u_compute(const uint4 (&u)[16], const char* Xl  , float* __restrict__ pout, int j) {
  f32x2v xf[8];
  {
    const uint4 a = *(const uint4*)Xl, c = *(const uint4*)(Xl + 16);
    xf[0] = (f32x2v){__uint_as_float(a.x << 16), __uint_as_float(a.x & 0xffff0000u)}; xf[1] = (f32x2v){__uint_as_float(a.y << 16), __uint_as_float(a.y & 0xffff0000u)};
    xf[2] = (f32x2v){__uint_as_float(a.z << 16), __uint_as_float(a.z & 0xffff0000u)}; xf[3] = (f32x2v){__uint_as_float(a.w << 16), __uint_as_float(a.w & 0xffff0000u)};
    xf[4] = (f32x2v){__uint_as_float(c.x << 16), __uint_as_float(c.x & 0xffff0000u)}; xf[5] = (f32x2v){__uint_as_float(c.y << 16), __uint_as_float(c.y & 0xffff0000u)};
    xf[6] = (f32x2v){__uint_as_float(c.z << 16), __uint_as_float(c.z & 0xffff0000u)}; xf[7] = (f32x2v){__uint_as_float(c.w << 16), __uint_as_float(c.w & 0xffff0000u)};
  }
  float k0 = 0.f, k1 = 0.f;
#pragma unroll
  for (int it = 0; it < 16; ++it) {
    const unsigned wv[4] = {u[it].x, u[it].y, u[it].z, u[it].w};
    f32x2v d2 = {0.f, 0.f};
#pragma unroll
    for (int q = 0; q < 4; ++q) {
      const f32x2v lo = __builtin_amdgcn_cvt_pk_f32_fp8((int)wv[q], false), hi = __builtin_amdgcn_cvt_pk_f32_fp8((int)wv[q], true);
      d2 = __builtin_elementwise_fma(lo, xf[2 * q], d2); d2 = __builtin_elementwise_fma(hi, xf[2 * q + 1], d2);
    }
    const float d = sum8(d2.x + d2.y);
    if ((it >> 1) == j) { if (it & 1) k1 = d; else k0 = d; }
  }
  *(float2*)pout = make_float2(k0, k1);
}
__device__ __forceinline__ void ds_u_chunk(char* wl  , int lane, int tk0, int s, const bf16_t* __restrict__ xn2, const int* __restrict__ eb, const unsigned char* __restrict__ ut8, float* __restrict__ partial) {
  const int b = tk0 / SEQ, sq = tk0 - b * SEQ;
  const size_t row0 = (size_t)b * LP + NMETA + sq;
  const int j = lane & 7, gi = lane >> 3;
  int* El = (int*)wl;
  char* Xl = wl + 8192;
#pragma unroll
  for (int i = 0; i < 8; ++i) *(int4*)(El + (i * 64 + lane) * 4) = *(const int4*)(eb + row0 * 128 + (i * 64 + lane) * 4);
#pragma unroll
  for (int i = 0; i < 4; ++i) { const int g = i * 64 + lane, t = g >> 4, c = g & 15; *(uint4*)(Xl + g * 16) = *(const uint4*)(xn2 + (row0 + t) * D + 128 * s + 8 * c); }
  const unsigned char* tab = ut8 + (size_t)s * (16384 * 128) + 16 * j;
  float* pout = partial + ((size_t)tk0 * 8 + s) * 128 + gi * 16 + 2 * j;
  uint4 ua[16], ub[16];
  ds_issue(ua, El + gi * 16, tab);
#pragma unroll 1
  for (int t = 0; t < 16; t += 2) {
    ds_issue(ub, El + (t + 1) * 128 + gi * 16, tab);
    ds_u_compute(ua, Xl + t * 256 + 32 * j, pout + (size_t)t * 1024, j);
    if (t + 2 < 16) ds_issue(ua, El + (t + 2) * 128 + gi * 16, tab);
    ds_u_compute(ub, Xl + (t + 1) * 256 + 32 * j, pout + (size_t)(t + 1) * 1024, j);
  }
}

__device__ __forceinline__ void ds_v_compute(const uint4 (&v)[16], const float* Wl  , int lane, int j, int gi, size_t row, int tk, int s,
                                             const bf16_t* __restrict__ hb, float* __restrict__ out, float* __restrict__ ssq) {
  float w[16];
#pragma unroll
  for (int q = 0; q < 4; ++q) { const float4 f = *(const float4*)(Wl + 4 * q); w[4 * q] = f.x; w[4 * q + 1] = f.y; w[4 * q + 2] = f.z; w[4 * q + 3] = f.w; }
  f32x2v acc[8];
#pragma unroll
  for (int i = 0; i < 8; ++i) acc[i] = (f32x2v){0.f, 0.f};
#pragma unroll
  for (int it = 0; it < 16; ++it) {
    const unsigned wv[4] = {v[it].x, v[it].y, v[it].z, v[it].w};
    const f32x2v w2 = {w[it], w[it]};
#pragma unroll
    for (int q = 0; q < 4; ++q) {
      const f32x2v lo = __builtin_amdgcn_cvt_pk_f32_fp8((int)wv[q], false), hi = __builtin_amdgcn_cvt_pk_f32_fp8((int)wv[q], true);
      acc[2 * q] = __builtin_elementwise_fma(w2, lo, acc[2 * q]); acc[2 * q + 1] = __builtin_elementwise_fma(w2, hi, acc[2 * q + 1]);
    }
  }
  float r4[4] = {0.f, 0.f, 0.f, 0.f};
#pragma unroll
  for (int i = 0; i < 16; ++i) {
    float t = (i & 1) ? acc[i >> 1].y : acc[i >> 1].x;
    t = dpp_add<0x128>(t);
    t += __shfl_xor(t, 16);
    t = half_swap_sum(t);
    if ((i >> 2) == gi) r4[i & 3] = t;
  }
  float ss = 0.f;
  if (gi < 4) {
    const int c0 = 128 * s + 16 * j + 4 * gi;
    const uint2 hw = *(const uint2*)(hb + row * D + c0);
    const float4 o = make_float4(__uint_as_float(hw.x << 16) + r4[0], __uint_as_float(hw.x & 0xffff0000u) + r4[1], __uint_as_float(hw.y << 16) + r4[2], __uint_as_float(hw.y & 0xffff0000u) + r4[3]);
    ss = o.x * o.x + o.y * o.y + o.z * o.z + o.w * o.w;
    *(float4*)(out + (size_t)tk * D + c0) = o;
  }
  ss = wave_sum(ss);
  if (lane == 0) ssq[(size_t)tk * 8 + s] = ss;
}
__device__ __forceinline__ void ds_v_chunk(char* wl, int lane, int tk0, int s, const bf16_t* __restrict__ hb, const int* __restrict__ eb, const float* __restrict__ wbuf, const unsigned char* __restrict__ vt8,
                                           float* __restrict__ out, float* __restrict__ ssq) {
  const int b = tk0 / SEQ, sq = tk0 - b * SEQ;
  const size_t row0 = (size_t)b * LP + NMETA + sq;
  const int j = lane & 7, gi = lane >> 3;
  int* El = (int*)wl;
  float* Wl = (float*)(wl + 8192);
#pragma unroll
  for (int i = 0; i < 8; ++i) {
    *(int4*)(El + (i * 64 + lane) * 4) = *(const int4*)(eb + row0 * 128 + (i * 64 + lane) * 4);
    *(float4*)(Wl + (i * 64 + lane) * 4) = *(const float4*)(wbuf + (size_t)tk0 * 128 + (i * 64 + lane) * 4);
  }
  const unsigned char* tab = vt8 + (size_t)s * (16384 * 128) + 16 * j;
  uint4 va[16], vb[16];
  ds_issue(va, El + gi * 16, tab);
#pragma unroll 1
  for (int t = 0; t < 16; t += 2) {
    ds_issue(vb, El + (t + 1) * 128 + gi * 16, tab);
    ds_v_compute(va, Wl + t * 128 + gi * 16, lane, j, gi, row0 + t, tk0 + t, s, hb, out, ssq);
    if (t + 2 < 16) ds_issue(va, El + (t + 2) * 128 + gi * 16, tab);
    ds_v_compute(vb, Wl + (t + 1) * 128 + gi * 16, lane, j, gi, row0 + t + 1, tk0 + t + 1, s, hb, out, ssq);
  }
}

__device__ __forceinline__ void p_gather_naive(int blk, const bf16_t* __restrict__ xn2, const float* __restrict__ h2, const int* __restrict__ eb, const float* __restrict__ gb,
                                                      const float* __restrict__ ut, const float* __restrict__ vt, const float* fg, float* out) {
  const int tix = opaque_tid();
  int tk = blk * 4 + ((tix & 255) >> 6), lane = (tix & 255) & 63;
  int b = tk / SEQ, s = tk - b * SEQ;
  size_t row = (size_t)b * LP + NMETA + s;
  float xv[16];
  {
    const uint4* xp = (const uint4*)(xn2 + row * D + lane * 16);
#pragma unroll
    for (int i = 0; i < 2; ++i) {
      uint4 r = xp[i];
      xv[i * 8 + 0] = bf2f(r.x & 0xffffu); xv[i * 8 + 1] = bf2f(r.x >> 16); xv[i * 8 + 2] = bf2f(r.y & 0xffffu); xv[i * 8 + 3] = bf2f(r.y >> 16);
      xv[i * 8 + 4] = bf2f(r.z & 0xffffu); xv[i * 8 + 5] = bf2f(r.z >> 16); xv[i * 8 + 6] = bf2f(r.w & 0xffffu); xv[i * 8 + 7] = bf2f(r.w >> 16);
    }
  }
  float acc[16];
#pragma unroll
  for (int i = 0; i < 16; ++i) acc[i] = 0.f;
  for (int k = 0; k < 128; ++k) {
    int e = eb[row * 128 + k];
    float gate = gb[row * 128 + k];
    const float4* up = (const float4*)(ut + (size_t)e * D + lane * 16);
    float dsum = 0.f;
#pragma unroll
    for (int i = 0; i < 4; ++i) { float4 u = up[i]; dsum += u.x * xv[i * 4] + u.y * xv[i * 4 + 1] + u.z * xv[i * 4 + 2] + u.w * xv[i * 4 + 3]; }
    dsum = wave_sum(dsum);
    float act = 0.5f * dsum * (1.0f + erff(dsum * 0.70710678118654752f));
    float wgt = gate * act;
    const float4* vp = (const float4*)(vt + (size_t)e * D + lane * 16);
#pragma unroll
    for (int i = 0; i < 4; ++i) { float4 v = vp[i]; acc[i * 4] += wgt * v.x; acc[i * 4 + 1] += wgt * v.y; acc[i * 4 + 2] += wgt * v.z; acc[i * 4 + 3] += wgt * v.w; }
  }
  const float4* hp = (const float4*)(h2 + row * D + lane * 16);
  float ss = 0.f;
#pragma unroll
  for (int i = 0; i < 4; ++i) { float4 hv = hp[i]; acc[i * 4] += hv.x; acc[i * 4 + 1] += hv.y; acc[i * 4 + 2] += hv.z; acc[i * 4 + 3] += hv.w; }
#pragma unroll
  for (int i = 0; i < 16; ++i) ss += acc[i] * acc[i];
  ss = wave_sum(ss);
  float rstd = rsqrtf(ss * (1.0f / D) + EPS);
  float4* op = (float4*)(out + ((size_t)b * SEQ + s) * D + lane * 16);
  const float4* gp = (const float4*)(fg + lane * 16);
#pragma unroll
  for (int i = 0; i < 4; ++i) { float4 g = gp[i]; op[i] = make_float4(acc[i * 4] * rstd * g.x, acc[i * 4 + 1] * rstd * g.y, acc[i * 4 + 2] * rstd * g.z, acc[i * 4 + 3] * rstd * g.w); }
}


template <class Epi>
__device__ __forceinline__ void gemm_tile(char* lds, const bf16_t* __restrict__ X, int ldx, const bf16_t* __restrict__ Wt, int ldw, int K, int m0, int n0, const Epi& epi) {
  const int tix = opaque_tid();
  const int tid = tix, lane = tid & 63, wid = tid >> 6;
  const int wm = wid >> 1, wn = wid & 1;
  const int sc = tid & 7, sr = tid >> 3;
  f32x4 acc[4][4];
#pragma unroll
  for (int i = 0; i < 4; ++i)
#pragma unroll
    for (int j = 0; j < 4; ++j) acc[i][j] = (f32x4){0.f, 0.f, 0.f, 0.f};
  uint4 ra[4], rb[2];
  const bf16_t* xp = X + (size_t)(m0 + sr) * ldx + sc * 8;
  const bf16_t* wp = Wt + (size_t)(n0 + sr) * ldw + sc * 8;
  const int nk = K >> 6;
#pragma unroll
  for (int i = 0; i < 4; ++i) ra[i] = *(const uint4*)(xp + (size_t)(64 * i) * ldx);
#pragma unroll
  for (int i = 0; i < 2; ++i) rb[i] = *(const uint4*)(wp + (size_t)(64 * i) * ldw);
#pragma unroll
  for (int i = 0; i < 4; ++i) { int r = sr + 64 * i; *(uint4*)(lds + r * 128 + ((sc ^ ((r >> 1) & 7)) << 4)) = ra[i]; }
#pragma unroll
  for (int i = 0; i < 2; ++i) { int r = sr + 64 * i; *(uint4*)(lds + 32768 + r * 128 + ((sc ^ ((r >> 1) & 7)) << 4)) = rb[i]; }
  __syncthreads();
  const int fr = lane & 15, fq = lane >> 4;
  for (int kt = 0; kt < nk; ++kt) {
    if (kt + 1 < nk) {
#pragma unroll
      for (int i = 0; i < 4; ++i) ra[i] = *(const uint4*)(xp + (size_t)(64 * i) * ldx + (kt + 1) * 64);
#pragma unroll
      for (int i = 0; i < 2; ++i) rb[i] = *(const uint4*)(wp + (size_t)(64 * i) * ldw + (kt + 1) * 64);
    }
    const char* la = lds + (kt & 1) * 49152;
    const char* lb = la + 32768;
#pragma unroll
    for (int kk = 0; kk < 2; ++kk) {
      bf16x8 xa[4], wb[4];
      const int c = kk * 4 + fq;
#pragma unroll
      for (int t = 0; t < 4; ++t) {
        int r = wm * 64 + t * 16 + fr; xa[t] = *(const bf16x8*)(la + r * 128 + ((c ^ ((r >> 1) & 7)) << 4));
        int r2 = wn * 64 + t * 16 + fr; wb[t] = *(const bf16x8*)(lb + r2 * 128 + ((c ^ ((r2 >> 1) & 7)) << 4));
      }
#pragma unroll
      for (int nt = 0; nt < 4; ++nt)
#pragma unroll
        for (int tt = 0; tt < 4; ++tt) acc[nt][tt] = __builtin_amdgcn_mfma_f32_16x16x32_bf16(wb[nt], xa[tt], acc[nt][tt], 0, 0, 0);
    }
    if (kt + 1 < nk) {
      char* lw = lds + ((kt + 1) & 1) * 49152;
#pragma unroll
      for (int i = 0; i < 4; ++i) { int r = sr + 64 * i; *(uint4*)(lw + r * 128 + ((sc ^ ((r >> 1) & 7)) << 4)) = ra[i]; }
#pragma unroll
      for (int i = 0; i < 2; ++i) { int r = sr + 64 * i; *(uint4*)(lw + 32768 + r * 128 + ((sc ^ ((r >> 1) & 7)) << 4)) = rb[i]; }
    }
    __syncthreads();
  }
#pragma unroll
  for (int nt = 0; nt < 4; ++nt)
#pragma unroll
    for (int tt = 0; tt < 4; ++tt) epi(m0 + wm * 64 + tt * 16 + fr, n0 + wn * 64 + nt * 16 + fq * 4, acc[nt][tt]);
}

struct Epi4StoreBf16 { bf16_t* out; int ld; int pad; __device__ __forceinline__ void operator()(int r, int c, f32x4 v) const {
  uint2 w; w.x = pack2(v[0], v[1]); w.y = pack2(v[2], v[3]); *(uint2*)(out + (size_t)r * ld + c) = w; } };
struct Epi4Resid { const float* x; const float* meta; float* h2; __device__ __forceinline__ void operator()(int r, int c, f32x4 v) const {
  const float* src = hrow_ptr(x, meta, r); float4 hv = src ? *(const float4*)(src + c) : make_float4(0.f, 0.f, 0.f, 0.f);
  *(float4*)(h2 + (size_t)r * D + c) = make_float4(hv.x + v[0], hv.y + v[1], hv.z + v[2], hv.w + v[3]); } };


struct EpiBf16 {
  bf16_t* out; int ld; int use_scale; unsigned* kmax;
  __device__ __forceinline__ void store8(size_t row, int col, const float (&v)[8], float& tmax) const {
    if (kmax && col >= 512 && col < 1024) {
      float ss = 0.f;
#pragma unroll
      for (int i = 0; i < 8; ++i) ss += v[i] * v[i];
      tmax = fmaxf(tmax, sum8(ss));
    }
    uint4 w; w.x = cvtpk(v[0], v[1]); w.y = cvtpk(v[2], v[3]); w.z = cvtpk(v[4], v[5]); w.w = cvtpk(v[6], v[7]);
    *(uint4*)(out + row * ld + col) = w;
  }
  __device__ __forceinline__ void finish(float tmax, size_t row, int col) const {
    if (kmax && col >= 512 && col < 1024) {
      tmax = wave_max(tmax);
      if ((threadIdx.x & 63) == 0) atomicMax(kmax + (row / LP) * 8 + ((col - 512) >> 6), __float_as_uint(tmax));
    }
  }
};
struct EpiResid2 {
  const float* x; const float* meta; float* h2; bf16_t* hb; float* rowss;
  __device__ __forceinline__ void finish(float, size_t, int) const {}
  __device__ __forceinline__ void store8(size_t row, int col, const float (&v)[8], float&) const {
    const float* src = hrow_ptr(x, meta, (int)row);
    const float4 a = *(const float4*)(src + col), b = *(const float4*)(src + col + 4);
    const float o[8] = {a.x + v[0], a.y + v[1], a.z + v[2], a.w + v[3], b.x + v[4], b.y + v[5], b.z + v[6], b.w + v[7]};
    uint4 w; w.x = cvtpk(o[0], o[1]); w.y = cvtpk(o[2], o[3]); w.z = cvtpk(o[4], o[5]); w.w = cvtpk(o[6], o[7]);
    *(uint4*)(hb + row * D + col) = w;
    float ss = 0.f;
#pragma unroll
    for (int i = 0; i < 8; ++i) ss += o[i] * o[i];
    ss = sum8(ss);
    if ((threadIdx.x & 7) == 0) rowss[row * 16 + (col >> 6)] = ss;
  }
};

template <class Epi>
__device__ __forceinline__ void gemm256(char* lds, const bf16_t* __restrict__ X, int ldx, const bf16_t* __restrict__ Wt, int ldw, int K, size_t xrow0, int n0, const Epi& epi) {
  const int tix = opaque_tid();
  const int tid = tix, lane = tid & 63;
  const int wid = __builtin_amdgcn_readfirstlane(tid >> 6);
  const int wm = wid >> 2, wn = wid & 3;
  const int fr = lane & 15, fq = lane >> 4;
  f32x4 acc[4][8];
#pragma unroll
  for (int i = 0; i < 4; ++i)
#pragma unroll
    for (int j = 0; j < 8; ++j) acc[i][j] = (f32x4){0.f, 0.f, 0.f, 0.f};
  const int nk = K >> 6;
  const int prow = lane >> 3, ppos = lane & 7;
  const char* xsrc = (const char*)(X + (xrow0 + 8 * wid + prow) * ldx);
  const char* wsrc = (const char*)(Wt + (size_t)(n0 + 8 * wid + prow) * ldw);
  const unsigned swz = (unsigned)((ppos ^ ((4 * wid + (prow >> 1)) & 7)) << 4);
#define G256_ISSUE(kt, buf) do { \
    _Pragma("unroll") for (int i_ = 0; i_ < 4; ++i_) { \
      __builtin_amdgcn_global_load_lds((const unsigned*)(xsrc + (size_t)(64 * i_) * ldx * 2 + (kt) * 128 + swz), LDSP(unsigned, lds + (buf) * 65536 + (i_ * 8 + wid) * 1024), 16, 0, 0); \
      __builtin_amdgcn_global_load_lds((const unsigned*)(wsrc + (size_t)(64 * i_) * ldw * 2 + (kt) * 128 + swz), LDSP(unsigned, lds + (buf) * 65536 + 32768 + (i_ * 8 + wid) * 1024), 16, 0, 0); \
    } } while (0)
  __syncthreads();
  G256_ISSUE(0, 0);
  __syncthreads();
  for (int kt = 0; kt < nk; ++kt) {
    if (kt + 1 < nk) G256_ISSUE(kt + 1, (kt + 1) & 1);
    const char* la = lds + (kt & 1) * 65536;
    const char* lb = la + 32768;
#pragma unroll
    for (int kk = 0; kk < 2; ++kk) {
      const int c = kk * 4 + fq;
      bf16x8 xa[8], wb[4];
#pragma unroll
      for (int t = 0; t < 8; ++t) { const int r = wm * 128 + t * 16 + fr; xa[t] = *(const bf16x8*)(la + r * 128 + ((c ^ ((r >> 1) & 7)) << 4)); }
#pragma unroll
      for (int t = 0; t < 4; ++t) { const int r = wn * 64 + t * 16 + fr; wb[t] = *(const bf16x8*)(lb + r * 128 + ((c ^ ((r >> 1) & 7)) << 4)); }
#pragma unroll
      for (int nt = 0; nt < 4; ++nt)
#pragma unroll
        for (int tt = 0; tt < 8; ++tt) acc[nt][tt] = __builtin_amdgcn_mfma_f32_16x16x32_bf16(wb[nt], xa[tt], acc[nt][tt], 0, 0, 0);
    }
    __syncthreads();
  }
#undef G256_ISSUE
  char* wl = lds + wid * 16384;
  float tmax = 0.f;
#pragma unroll
  for (int hf = 0; hf < 2; ++hf) {
#pragma unroll
    for (int t4 = 0; t4 < 4; ++t4)
#pragma unroll
      for (int nt = 0; nt < 4; ++nt) {
        const int t = t4 * 16 + fr, c16 = nt * 4 + fq;
        *(f32x4*)(wl + t * 256 + ((c16 ^ (t & 15)) << 4)) = acc[nt][hf * 4 + t4];
      }
#pragma unroll
    for (int i = 0; i < 8; ++i) {
      const int t = 8 * i + (lane >> 3), c8 = lane & 7;
      const f32x4 v0 = *(const f32x4*)(wl + t * 256 + (((2 * c8) ^ (t & 15)) << 4)), v1 = *(const f32x4*)(wl + t * 256 + (((2 * c8 + 1) ^ (t & 15)) << 4));
      const float v[8] = {v0[0], v0[1], v0[2], v0[3], v1[0], v1[1], v1[2], v1[3]};
      epi.store8(xrow0 + wm * 128 + hf * 64 + t, n0 + wn * 64 + 8 * c8, v, tmax);
    }
  }
  epi.finish(tmax, xrow0, n0 + wn * 64);
}

__device__ __forceinline__ void meta_proj(char* lds, int blk, const bf16_t* __restrict__ xn1, const bf16_t* __restrict__ wt_in, bf16_t* proj) {
  const int tix = opaque_tid();
  float* red = (float*)lds;
  __syncthreads();
  float part = 0.f;
  const int o = tix % 160, kp = tix / 160;
  if (tix < 480) {
    const int row = o / 10, n = blk * 10 + o % 10;
    const int k0 = kp * 352, k1 = kp == 2 ? 1024 : k0 + 352;
    const bf16_t* xr = xn1 + (size_t)row * D; const bf16_t* wr = wt_in + (size_t)n * D;
    for (int k = k0; k < k1; k += 8) {
      const uint4 a = *(const uint4*)(xr + k), b = *(const uint4*)(wr + k);
      part = dot8(a, b, part);
    }
    red[tix] = part;
  }
  __syncthreads();
  if (tix < 160) {
    const float v = red[tix] + red[tix + 160] + red[tix + 320];
    const int row = tix / 10, n = blk * 10 + tix % 10;
    const bf16_t bv = f2bf(v);
#pragma unroll
    for (int b = 0; b < BATCH; ++b) proj[((size_t)b * LP + row) * INC + n] = bv;
  }
}

__device__ __forceinline__ void p_transpose(int t, float* smem, const float* __restrict__ W, bf16_t* Wt, int K, int N, const float* __restrict__ ksc) {
  const int tix = opaque_tid();
  float (*T)[65] = (float (*)[65])smem;
  const int nbx = N / 64, k0 = (t / nbx) * 64, n0 = (t % nbx) * 64, tid = (tix & 255);
  const int j = tid & 63, i0 = tid >> 6;
#pragma unroll
  for (int ii = 0; ii < 16; ++ii) { int i = i0 + 4 * ii; T[i][j] = W[(size_t)(k0 + i) * N + n0 + j] * (ksc ? ksc[k0 + i] : 1.0f); }
  __syncthreads();
#pragma unroll
  for (int ii = 0; ii < 16; ++ii) { int jj = i0 + 4 * ii; Wt[(size_t)(n0 + jj) * K + k0 + j] = f2bf(T[j][jj]); }
  __syncthreads();
}

__device__ __forceinline__ void grid_bar(unsigned* ctr, unsigned target) {
  asm volatile("s_waitcnt vmcnt(0)" ::: "memory");
  __syncthreads();
  if (threadIdx.x == 0) {
    __builtin_amdgcn_fence(__ATOMIC_RELEASE, "agent");
    asm volatile("s_waitcnt vmcnt(0)" ::: "memory");
    __hip_atomic_fetch_add(ctr, 1u, __ATOMIC_RELAXED, __HIP_MEMORY_SCOPE_AGENT);
    unsigned spins = 0;
    while (__hip_atomic_load(ctr, __ATOMIC_RELAXED, __HIP_MEMORY_SCOPE_AGENT) < target) { __builtin_amdgcn_s_sleep(2); if (++spins > (1u << 24)) break; }
    __builtin_amdgcn_fence(__ATOMIC_ACQUIRE, "agent");
    asm volatile("s_waitcnt vmcnt(0)" ::: "memory");
  }
  __syncthreads();
}

struct Params {
  const float *x, *meta, *g1, *w_in, *lq1, *lk1, *lq2, *lk2, *subg, *conv_w, *conv_b, *gn_g, *gn_b, *w_out, *g2, *wq, *sk, *ut, *vt, *fg;
  float* out; float* scal; bf16_t* r1; bf16_t* r2; float* h2; int* eb; float* gb; bf16_t* wt_in; bf16_t* wt_out; bf16_t* wt_q; bf16_t* skb; unsigned char* ut8; unsigned char* vt8; float* uinv; float* vinv; float* wbuf; float* ssq; bf16_t* hb; float* rowss;
};

__global__ void __launch_bounds__(512, 2) mega(Params p) {
  cg::grid_group grid = cg::this_grid();
  __shared__ __attribute__((aligned(16))) char smem_c[131072];
  float* smem = (float*)smem_c;
  const int G = gridDim.x, vh = threadIdx.x >> 8;
  unsigned* ctr = (unsigned*)(p.scal + 64);
  unsigned nbar = 0;
  bf16_t* xn1 = p.r1; bf16_t* mix = p.r1; bf16_t* proj = p.r2; bf16_t* qp = p.r2;
  p_norm1_rows(G, p.x, p.meta, p.g1, xn1);
  if (blockIdx.x == 0 && threadIdx.x < 64) {
    const int t = threadIdx.x;
    const float a = wave_sum(p.lq1[t] * p.lk1[t]), b2 = wave_sum(p.lq2[t] * p.lk2[t]);
    if (t == 0) p.scal[0] = expf(a) - expf(b2) + LAM_INIT;
  }
  for (int b = blockIdx.x; b < (640 + 256 + 512) / 2; b += G) {
    const int bb = b * 2 + vh; float* sm = smem + vh * (64 * 65);
    if (bb < 640) p_transpose(bb, sm, p.w_in, p.wt_in, D, INC, nullptr);
    else if (bb < 896) p_transpose(bb - 640, sm, p.w_out, p.wt_out, D, D, nullptr);
    else p_transpose(bb - 896, sm, p.wq, p.wt_q, D, 2048, p.g2);
  }
  p_cvt_bf16(blockIdx.x, G, p.sk, p.skb, (size_t)16 * 128 * 128 / 8);
  p_cvt_fp8_rows(blockIdx.x, G, p.ut, (unsigned*)p.ut8, p.uinv, p.g2);
  p_cvt_fp8_rows(blockIdx.x, G, p.vt, (unsigned*)p.vt8, p.vinv, nullptr);
  grid.sync();
  for (int b = blockIdx.x; b < 128 * 10; b += G) {
    const int mt = b / 10, nt = b - mt * 10;
    gemm256(smem_c, xn1, D, p.wt_in, D, D, (size_t)(mt >> 4) * LP + NMETA + 256 * (mt & 15), nt * 256, EpiBf16{proj, INC, 0, (unsigned*)(p.scal + 640)});
  }
  for (int b = blockIdx.x; b < 256; b += G) meta_proj(smem_c, b, xn1, p.wt_in, proj);
  for (int i = blockIdx.x * 512 + threadIdx.x; i < BATCH * (LP - LREAL) * 128; i += G * 512) {
    const int c = i & 127, r = i >> 7, b = r / (LP - LREAL), pos = LREAL + r - b * (LP - LREAL);
    *(uint4*)(proj + ((size_t)b * LP + pos) * INC + 512 + 8 * c) = make_uint4(0, 0, 0, 0);
  }
  grid_bar(ctr, (unsigned)G * ++nbar);
  {
    const float lam = p.scal[0];
    for (int u = blockIdx.x; u < 256; u += G) {
      const int bh = (u & 7) * 4 + (u >> 6), tp = (u >> 3) & 7;
#pragma unroll 1
      for (int k = 0; k < 4; ++k) {
        const int t = (k == 0) ? 31 - tp : (k == 1) ? 16 + tp : (k == 2) ? 15 - tp : tp;
        attn_unit(smem_c, proj, mix, p.subg, (const unsigned*)(p.scal + 640), lam, bh >> 2, bh & 3, t);
      }
    }
  }
  for (int u = blockIdx.x; u < BATCH * 128; u += G) conv_unit(smem_c, proj, mix, p.conv_w, p.conv_b, p.gn_g, p.gn_b, u >> 7, NMETA + 32 * (u & 127));
  grid_bar(ctr, (unsigned)G * ++nbar);
  for (int b = blockIdx.x; b < 128 * 4; b += G) {
    const int mt = b >> 2, nt = b & 3;
    gemm256(smem_c, mix, D, p.wt_out, D, D, (size_t)(mt >> 4) * LP + NMETA + 256 * (mt & 15), nt * 256, EpiResid2{p.x, p.meta, p.h2, p.hb, p.rowss});
  }
  grid_bar(ctr, (unsigned)G * ++nbar);
  for (int b = blockIdx.x; b < 128 * 8; b += G) {
    const int mt = b >> 3, nt = b & 7;
    gemm256(smem_c, p.hb, D, p.wt_q, D, D, (size_t)(mt >> 4) * LP + NMETA + 256 * (mt & 15), nt * 256, EpiBf16{qp, 2048, 0, nullptr});
  }
  grid_bar(ctr, (unsigned)G * ++nbar);
  for (int u = blockIdx.x; u < 256 * 8; u += G) {
    const int rt = u >> 3, h = u & 7;
    peer_topk_unit(smem_c, qp, p.skb, p.rowss, p.eb, p.gb, (rt >> 5) * LP + NMETA + 128 * (rt & 31), h);
  }
  grid_bar(ctr, (unsigned)G * ++nbar);
  {
    const int tix = opaque_tid();
    const int lane = tix & 63;
    const int NTOK = BATCH * SEQ;
    float* partial = (float*)qp;
    unsigned* qh = (unsigned*)(p.scal + 128);
    const unsigned x = xcc_id();
    for (int qi = 0; qi < 8; ++qi) {
      const int s = (int)((x + qi) & 7u);
      for (;;) {
        unsigned st = 0;
        if (lane == 0) st = __hip_atomic_fetch_add(qh + s * 16, 16u, __ATOMIC_RELAXED, __HIP_MEMORY_SCOPE_AGENT);
        st = __builtin_amdgcn_readfirstlane(st);
        if (st >= (unsigned)NTOK) break;
        ds_u_chunk(smem_c + (tix >> 6) * 16384, lane, (int)st, s, p.hb, p.eb, p.ut8, partial);
      }
    }
    grid_bar(ctr, (unsigned)G * ++nbar);
    for (size_t i = (size_t)blockIdx.x * 512 + tix; i < (size_t)NTOK * 128; i += (size_t)G * 512) {
      const int tk = (int)(i >> 7), k = (int)(i & 127);
      const int b = tk / SEQ, sq = tk - b * SEQ;
      const size_t row = (size_t)b * LP + NMETA + sq;
      float a = 0.f;
#pragma unroll
      for (int sl = 0; sl < 8; ++sl) a += partial[((size_t)tk * 8 + sl) * 128 + k];
      const int e = p.eb[row * 128 + k];
      a *= p.uinv[e] * row_rstd(p.rowss, row);
      p.wbuf[i] = p.gb[row * 128 + k] * 0.5f * a * (1.0f + erff(a * 0.70710678118654752f)) * p.vinv[e];
    }
    grid_bar(ctr, (unsigned)G * ++nbar);
    for (int qi = 0; qi < 8; ++qi) {
      const int s = (int)((x + qi) & 7u);
      for (;;) {
        unsigned st = 0;
        if (lane == 0) st = __hip_atomic_fetch_add(qh + (8 + s) * 16, 16u, __ATOMIC_RELAXED, __HIP_MEMORY_SCOPE_AGENT);
        st = __builtin_amdgcn_readfirstlane(st);
        if (st >= (unsigned)NTOK) break;
        ds_v_chunk(smem_c + (tix >> 6) * 16384, lane, (int)st, s, p.hb, p.eb, p.wbuf, p.vt8, p.h2, p.ssq);
      }
    }
    grid_bar(ctr, (unsigned)G * ++nbar);
    {
      const int wv = blockIdx.x * 8 + (tix >> 6);
      for (int tk = wv * 2; tk < NTOK; tk += G * 16) {
        float4 o[2][4]; float sv[2];
#pragma unroll
        for (int r = 0; r < 2; ++r) {
#pragma unroll
          for (int q = 0; q < 4; ++q) o[r][q] = ((const float4*)p.h2)[(size_t)(tk + r) * 256 + q * 64 + lane];
          sv[r] = lane < 8 ? p.ssq[(size_t)(tk + r) * 8 + lane] : 0.f;
        }
#pragma unroll
        for (int r = 0; r < 2; ++r) {
          const float rstd = rsqrtf(wave_sum(sv[r]) * (1.0f / D) + EPS);
#pragma unroll
          for (int q = 0; q < 4; ++q) {
            const float4 f = ((const float4*)p.fg)[q * 64 + lane];
            float4 v = o[r][q];
            v.x *= rstd * f.x; v.y *= rstd * f.y; v.z *= rstd * f.z; v.w *= rstd * f.w;
            ((float4*)p.out)[(size_t)(tk + r) * 256 + q * 64 + lane] = v;
          }
        }
      }
    }
  }
}

extern "C" void kernel_launch(void* const* d_in, const int* in_sizes, int n_in, void* d_out, int out_size, void* d_ws, size_t ws_size, hipStream_t stream) {
  static int grid_blocks = 0;
  if (!grid_blocks) {
    int dev = 0, cus = 0, per_cu = 0;
    hipGetDevice(&dev);
    hipDeviceGetAttribute(&cus, hipDeviceAttributeMultiprocessorCount, dev);
    hipOccupancyMaxActiveBlocksPerMultiprocessor(&per_cu, mega, 512, 0);
    if (per_cu > 1) per_cu = 1;
    if (per_cu < 1) per_cu = 1;
    grid_blocks = cus * per_cu;
  }
  Params p{};
  const float** pp = (const float**)&p;
  for (int i = 0; i < 20; ++i) pp[i] = (const float*)d_in[i];
  p.out = (float*)d_out;
  char* ws = (char*)d_ws;
  size_t off = 0;
  p.scal = (float*)(ws + off); off += 4096;
  p.r1 = (bf16_t*)(ws + off); off += (size_t)ROWS * D * 2;
  p.r2 = (bf16_t*)(ws + off); off += (size_t)ROWS * INC * 2;
  p.h2 = (float*)(ws + off); off += (size_t)ROWS * D * 4;
  p.wt_in = (bf16_t*)(ws + off); off += (size_t)INC * D * 2;
  p.wt_out = (bf16_t*)(ws + off); off += (size_t)D * D * 2;
  p.wt_q = (bf16_t*)(ws + off); off += (size_t)2048 * D * 2;
  p.skb = (bf16_t*)(ws + off); off += (size_t)16 * 128 * 128 * 2;
  p.ut8 = (unsigned char*)(ws + off); off += (size_t)16384 * D;
  p.vt8 = (unsigned char*)(ws + off); off += (size_t)16384 * D;
  p.uinv = (float*)(ws + off); off += 65536;
  p.vinv = (float*)(ws + off); off += 65536;
  p.wbuf = (float*)(ws + off); off += (size_t)BATCH * SEQ * 128 * 4;
  p.ssq = (float*)(ws + off); off += (size_t)BATCH * SEQ * 8 * 4;
  p.hb = (bf16_t*)(ws + off); off += (size_t)ROWS * D * 2;
  p.rowss = (float*)(ws + off); off += (size_t)ROWS * 16 * 4;
  p.eb = (int*)((char*)p.r2 + (size_t)ROWS * 2048 * 2);
  p.gb = (float*)((char*)p.eb + (size_t)ROWS * 128 * 4);
  hipMemsetAsync(d_ws, 0, 4096, stream);
  void* args[] = {&p};
  hipError_t e = hipLaunchCooperativeKernel((void*)mega, dim3(grid_blocks), dim3(512), args, 0, stream);
  if (e != hipSuccess) fprintf(stderr, "cooperative launch failed: %s (grid %d)\n", hipGetErrorString(e), grid_blocks);
}
```

```cpp
#include <hip/hip_runtime.h>
#include <hip/hip_cooperative_groups.h>
#include <cstdio>
namespace cg = cooperative_groups;
#include <stdint.h>
#include <math.h>

typedef unsigned short bf16_t;
typedef short bf16x8 __attribute__((ext_vector_type(8)));
typedef float f32x4 __attribute__((ext_vector_type(4)));

constexpr int D = 1024, BATCH = 8, SEQ = 4096, NMETA = 16, LREAL = NMETA + SEQ  , LP = 4224, ROWS = BATCH * LP;
constexpr int INC = 2560;
constexpr float EPS = 1e-6f;
constexpr float LAM_INIT = 0.2f;

__device__ __forceinline__ float bf2f(unsigned v) { return __uint_as_float(v << 16); }
__device__ __forceinline__ bf16_t f2bf(float f) { unsigned u = __float_as_uint(f); u += 0x7fffu + ((u >> 16) & 1u); return (bf16_t)(u >> 16); }
__device__ __forceinline__ unsigned pack2(float a, float b) { return (unsigned)f2bf(a) | ((unsigned)f2bf(b) << 16); }

__device__ __forceinline__ float wave_sum(float v) {
#pragma unroll
  for (int o = 32; o >= 1; o >>= 1) v += __shfl_xor(v, o);
  return v;
}
__device__ __forceinline__ float wave_max(float v) {
#pragma unroll
  for (int o = 32; o >= 1; o >>= 1) v = fmaxf(v, __shfl_xor(v, o));
  return v;
}

template <int CTRL> __device__ __forceinline__ float dpp_add(float v) { return v + __builtin_bit_cast(float, __builtin_amdgcn_update_dpp(0, __builtin_bit_cast(int, v), CTRL, 0xf, 0xf, true)); }
__device__ __forceinline__ float sum8(float v) { v = dpp_add<0x141>(v); v = dpp_add<0xB1>(v); v = dpp_add<0x4E>(v); return v; }
typedef __bf16 bf16v2 __attribute__((ext_vector_type(2)));
__device__ __forceinline__ float dot8(uint4 a, uint4 b, float acc) {
  acc = __builtin_amdgcn_fdot2_f32_bf16(__builtin_bit_cast(bf16v2, a.x), __builtin_bit_cast(bf16v2, b.x), acc, false);
  acc = __builtin_amdgcn_fdot2_f32_bf16(__builtin_bit_cast(bf16v2, a.y), __builtin_bit_cast(bf16v2, b.y), acc, false);
  acc = __builtin_amdgcn_fdot2_f32_bf16(__builtin_bit_cast(bf16v2, a.z), __builtin_bit_cast(bf16v2, b.z), acc, false);
  acc = __builtin_amdgcn_fdot2_f32_bf16(__builtin_bit_cast(bf16v2, a.w), __builtin_bit_cast(bf16v2, b.w), acc, false);
  return acc;
}
__device__ __forceinline__ float row_rstd(const float* __restrict__ rowss, size_t row) {
  const float4 a = *(const float4*)(rowss + row * 16), b = *(const float4*)(rowss + row * 16 + 4), c = *(const float4*)(rowss + row * 16 + 8), d = *(const float4*)(rowss + row * 16 + 12);
  const float t = ((a.x + a.y) + (a.z + a.w)) + ((b.x + b.y) + (b.z + b.w)) + ((c.x + c.y) + (c.z + c.w)) + ((d.x + d.y) + (d.z + d.w));
  return rsqrtf(t * (1.0f / D) + EPS);
}
__device__ __forceinline__ float row16_sum(float v) {
  v += __builtin_bit_cast(float, __builtin_amdgcn_update_dpp(0, __builtin_bit_cast(int, v), 0x128, 0xf, 0xf, true));
  v += __builtin_bit_cast(float, __builtin_amdgcn_update_dpp(0, __builtin_bit_cast(int, v), 0x124, 0xf, 0xf, true));
  v += __builtin_bit_cast(float, __builtin_amdgcn_update_dpp(0, __builtin_bit_cast(int, v), 0x122, 0xf, 0xf, true));
  v += __builtin_bit_cast(float, __builtin_amdgcn_update_dpp(0, __builtin_bit_cast(int, v), 0x121, 0xf, 0xf, true));
  return v;
}
__device__ __forceinline__ int opaque_tid() { int t = threadIdx.x; asm volatile("" : "+v"(t)); return t; }

__device__ __forceinline__ const float* hrow_ptr(const float* x, const float* meta, int row) {
  int b = row / LP, pos = row - b * LP;
  if (pos < NMETA) return meta + (size_t)pos * D;
  if (pos < LREAL) return x + ((size_t)b * SEQ + (pos - NMETA)) * D;
  return nullptr;
}

__device__ __forceinline__ void p_norm1(int blk, float* red, const float* x, const float* meta, const float* g1, bf16_t* xn1,
                                               const float* lq1, const float* lk1, const float* lq2, const float* lk2, float* scal) {
  const int tix = opaque_tid();
  int row = blk, tid = (tix & 255);
  __syncthreads();
  const float* src = hrow_ptr(x, meta, row);
  float4 v = src ? ((const float4*)src)[tid] : make_float4(0.f, 0.f, 0.f, 0.f);
  float ss = v.x * v.x + v.y * v.y + v.z * v.z + v.w * v.w;
  ss = wave_sum(ss);
  if ((tid & 63) == 0) red[tid >> 6] = ss;
  __syncthreads();
  float tot = red[0] + red[1] + red[2] + red[3];
  float rstd = rsqrtf(tot * (1.0f / D) + EPS);
  float4 g = ((const float4*)g1)[tid];
  uint2 o; o.x = pack2(v.x * rstd * g.x, v.y * rstd * g.y); o.y = pack2(v.z * rstd * g.z, v.w * rstd * g.w);
  ((uint2*)(xn1 + (size_t)row * D))[tid] = o;
  if (row == 0 && tid < 64) {
    float a = lq1[tid] * lk1[tid], b2 = lq2[tid] * lk2[tid];
    a = wave_sum(a); b2 = wave_sum(b2);
    if (tid == 0) scal[0] = expf(a) - expf(b2) + LAM_INIT;
  }
}


typedef float f32x16 __attribute__((ext_vector_type(16)));
typedef short v4i16_t __attribute__((ext_vector_type(4)));
typedef __bf16 bf16v2_t __attribute__((ext_vector_type(2)));
typedef float f32x2_t __attribute__((ext_vector_type(2)));
#define LDSP(T, p) ((__attribute__((address_space(3))) T*)(p))
#define MFMA32(a, b, c) __builtin_amdgcn_mfma_f32_32x32x16_bf16((a), (b), (c), 0, 0, 0)
__device__ __forceinline__ unsigned cvtpk(float lo, float hi) { f32x2_t v = {lo, hi}; return __builtin_bit_cast(unsigned, __builtin_convertvector(v, bf16v2_t)); }
__device__ __forceinline__ float half_swap_max(float m) { auto rr = __builtin_amdgcn_permlane32_swap(__float_as_uint(m), __float_as_uint(m), false, false); return fmaxf(__uint_as_float(rr[0]), __uint_as_float(rr[1])); }
__device__ __forceinline__ float half_swap_sum(float m) { auto rr = __builtin_amdgcn_permlane32_swap(__float_as_uint(m), __float_as_uint(m), false, false); return __uint_as_float(rr[0]) + __uint_as_float(rr[1]); }

__device__ __forceinline__ void attn_issue_kv(char* kvbuf, const bf16_t* __restrict__ kvrow0  , int tid, int wid) {
  const char* base = (const char*)kvrow0;
#pragma unroll
  for (int i = 0; i < 2; ++i) {
    const int g = i * 512 + tid, row = g >> 4, pos = g & 15;
    const unsigned offk = (unsigned)(row * (INC * 2) + 1024 + ((pos ^ (row & 15)) << 4));
    const unsigned offv = (unsigned)(row * (INC * 2) + 2048 + ((pos ^ ((row & 3) << 2)) << 4));
    __builtin_amdgcn_global_load_lds((const unsigned*)(base + offk), LDSP(unsigned, kvbuf + (i * 512 + wid * 64) * 16), 16, 0, 0);
    __builtin_amdgcn_global_load_lds((const unsigned*)(base + offv), LDSP(unsigned, kvbuf + 16384 + (i * 512 + wid * 64) * 16), 16, 0, 0);
  }
}

template <bool MASKED, bool MAXONLY>
__device__ __forceinline__ void attn_qk(uint4 (&pw)[4], float& mref, const char* qbase, int qsw, const char* kb, int c, int kq, float sl8, int lane, int r32, int hi,
                                         const bf16x8& augk0, const bf16x8& augk1, const bf16x8& augq) {
  const float c1 = 0.125f * 1.4426950408889634f;
  asm volatile("" : "+v"(qsw), "+v"(lane));
  f32x16 s0, s1;
  float soff;
  if (MASKED) {
    const float a1 = sl8, a2 = 2.0f * sl8, a3 = 3.0f * sl8, b8 = 8.0f * sl8;
    float gb = sl8 * (float)kq;
#pragma unroll
    for (int g = 0; g < 4; ++g) { s0[4 * g] = gb; s0[4 * g + 1] = gb + a1; s0[4 * g + 2] = gb + a2; s0[4 * g + 3] = gb + a3; gb += b8; }
#pragma unroll
    for (int g = 0; g < 4; ++g) { s1[4 * g] = gb; s1[4 * g + 1] = gb + a1; s1[4 * g + 2] = gb + a2; s1[4 * g + 3] = gb + a3; gb += b8; }
#pragma unroll
    for (int r = 0; r < 16; ++r) { s0[r] = s0[r] > 0.f ? -1e30f : s0[r]; s1[r] = s1[r] > 0.f ? -1e30f : s1[r]; }
    soff = 0.f;
  } else {
#pragma unroll
    for (int r = 0; r < 16; ++r) { s0[r] = 0.f; s1[r] = 0.f; }
    s0 = MFMA32(augk0, augq, s0);
    s1 = MFMA32(augk1, augq, s1);
    soff = sl8 * (float)(kq - 4 * hi);
  }
#pragma unroll
  for (int ks = 0; ks < 4; ++ks) {
    const int ch = c * 8 + ks * 2 + hi;
    bf16x8 bq = *(const bf16x8*)(qbase + ((ch ^ qsw) << 4));
    bf16x8 ka0 = *(const bf16x8*)(kb + r32 * 256 + ((ch ^ qsw) << 4));
    bf16x8 ka1 = *(const bf16x8*)(kb + (32 + r32) * 256 + ((ch ^ qsw) << 4));
    s0 = MFMA32(ka0, bq, s0);
    s1 = MFMA32(ka1, bq, s1);
    __builtin_amdgcn_sched_barrier(0);
  }
  if (MAXONLY) {
    float m0 = fmaxf(s0[0], s1[0]), m1 = fmaxf(s0[1], s1[1]), m2 = fmaxf(s0[2], s1[2]), m3 = fmaxf(s0[3], s1[3]);
#pragma unroll
    for (int r = 4; r < 16; r += 4) {
      m0 = fmaxf(fmaxf(m0, s0[r]), s1[r]); m1 = fmaxf(fmaxf(m1, s0[r + 1]), s1[r + 1]); m2 = fmaxf(fmaxf(m2, s0[r + 2]), s1[r + 2]); m3 = fmaxf(fmaxf(m3, s0[r + 3]), s1[r + 3]);
    }
    mref = fmaxf(mref, half_swap_max(fmaxf(fmaxf(m0, m1), fmaxf(m2, m3))) + soff);
    return;
  }
  const f32x2_t c1v = {c1, c1}, nmv = {(soff - mref) * c1, (soff - mref) * c1};
#pragma unroll
  for (int r = 0; r < 16; r += 2) {
    f32x2_t x0 = {s0[r], s0[r + 1]}, x1 = {s1[r], s1[r + 1]};
    x0 = __builtin_elementwise_fma(x0, c1v, nmv); x1 = __builtin_elementwise_fma(x1, c1v, nmv);
    x0.x = __builtin_amdgcn_exp2f(x0.x); x0.y = __builtin_amdgcn_exp2f(x0.y); x1.x = __builtin_amdgcn_exp2f(x1.x); x1.y = __builtin_amdgcn_exp2f(x1.y);
    s0[r] = x0.x; s0[r + 1] = x0.y; s1[r] = x1.x; s1[r + 1] = x1.y;
  }
#pragma unroll
  for (int kk = 0; kk < 2; ++kk) {
    pw[kk] = make_uint4(cvtpk(s0[8 * kk], s0[8 * kk + 1]), cvtpk(s0[8 * kk + 2], s0[8 * kk + 3]), cvtpk(s0[8 * kk + 4], s0[8 * kk + 5]), cvtpk(s0[8 * kk + 6], s0[8 * kk + 7]));
    pw[2 + kk] = make_uint4(cvtpk(s1[8 * kk], s1[8 * kk + 1]), cvtpk(s1[8 * kk + 2], s1[8 * kk + 3]), cvtpk(s1[8 * kk + 4], s1[8 * kk + 5]), cvtpk(s1[8 * kk + 6], s1[8 * kk + 7]));
  }
}

__device__ __forceinline__ void attn_pv(f32x16 (&o)[4], f32x16& osum, const uint4 (&pw)[4], const char* vb, int lane, int hi) {
  asm volatile("" : "+v"(lane));
  const int q4 = (lane & 15) >> 2, g1 = (lane >> 4) & 1, p4 = lane & 3;
#pragma unroll
  for (int kk = 0; kk < 4; ++kk) {
    const int key0 = 16 * kk + 4 * hi + q4;
    const bf16x8 pb = __builtin_bit_cast(bf16x8, pw[kk]);
    osum = MFMA32(__builtin_bit_cast(bf16x8, make_uint4(0x3F803F80u, 0x3F803F80u, 0x3F803F80u, 0x3F803F80u)), pb, osum);
#pragma unroll
    for (int dvt = 0; dvt < 4; ++dvt) {
      const int c8 = 8 * (dvt ^ q4) + 4 * g1 + p4;
      v4i16_t lo = __builtin_amdgcn_ds_read_tr16_b64_v4i16(LDSP(v4i16_t, vb + key0 * 256 + c8 * 8));
      v4i16_t hi4 = __builtin_amdgcn_ds_read_tr16_b64_v4i16(LDSP(v4i16_t, vb + (key0 + 8) * 256 + c8 * 8));
      bf16x8 va = (bf16x8){lo[0], lo[1], lo[2], lo[3], hi4[0], hi4[1], hi4[2], hi4[3]};
      o[dvt] = MFMA32(va, pb, o[dvt]);
    }
    __builtin_amdgcn_sched_barrier(0);
  }
}

__device__ __forceinline__ void attn_unit(char* lds, const bf16_t* __restrict__ proj, bf16_t* mix, const float* __restrict__ subg, const unsigned* __restrict__ kmax, float lam, int b, int h, int t) {
  const int tix = opaque_tid();
  const int tid = tix, lane = tid & 63, r32 = lane & 31, hi = lane >> 5;
  const int wid = __builtin_amdgcn_readfirstlane(tid >> 6);
  const int c = wid >> 2, qg = wid & 3;
  const int q0 = NMETA + 128 * t, qw0 = q0 + 32 * qg, qpos = qw0 + r32;
  const size_t rowb = (size_t)b * LP;
  const int NT = 2 * t + 3;
  char* Qs = lds;
  char* KV = lds + 32768;
  const float sl8 = exp2f(1.0f - 2.0f * (float)h);
  __syncthreads();
  attn_issue_kv(KV, proj + rowb * INC + h * 128, tid, wid);
#pragma unroll
  for (int i = 0; i < 4; ++i) {
    const int g = i * 512 + tid, row = g >> 4, pos = g & 15;
    uint4 v = *(const uint4*)(proj + (rowb + q0 + row) * INC + h * 128 + ((pos ^ (row & 15)) << 3));
    *(uint4*)(Qs + g * 16) = v;
  }
  f32x16 o[4];
#pragma unroll
  for (int i = 0; i < 4; ++i)
#pragma unroll
    for (int r = 0; r < 16; ++r) o[i][r] = 0.f;
  f32x16 osum;
#pragma unroll
  for (int r = 0; r < 16; ++r) osum[r] = 0.f;
  bf16x8 augk0, augk1, augq;
  {
    const unsigned k0w = hi == 0 ? cvtpk((float)r32, 0.f) : 0u, k1w = hi == 0 ? cvtpk((float)(32 + r32), 0.f) : 0u, qw = hi == 0 ? cvtpk(sl8, 0.f) : 0u;
    augk0 = __builtin_bit_cast(bf16x8, make_uint4(k0w, 0u, 0u, 0u)); augk1 = __builtin_bit_cast(bf16x8, make_uint4(k1w, 0u, 0u, 0u)); augq = __builtin_bit_cast(bf16x8, make_uint4(qw, 0u, 0u, 0u));
  }
  const int qrow = 32 * qg + r32;
  const char* qbase = Qs + qrow * 256;
  const int qsw = qrow & 15;
  float mref; bool loose;
  int* lflag = (int*)(lds + 131072);
  {
    float kn2 = 0.f;
    if (lane < 16) {
      const uint4* kp = (const uint4*)(proj + (rowb + lane) * INC + 512 + h * 128 + c * 64);
#pragma unroll
      for (int i = 0; i < 8; ++i) { const uint4 w = kp[i]; kn2 = dot8(w, w, kn2); }
    }
    kn2 = fmaxf(wave_max(kn2), __uint_as_float(kmax[b * 8 + h * 2 + c]));
    if (tid == 0) *lflag = 0;
    __syncthreads();
    float qn2 = 0.f;
#pragma unroll
    for (int ks = 0; ks < 4; ++ks) { const uint4 w = *(const uint4*)(qbase + (((c * 8 + ks * 2 + hi) ^ qsw) << 4)); qn2 = dot8(w, w, qn2); }
    qn2 = half_swap_sum(qn2);
    const float bound = sqrtf(qn2 * kn2) * 1.02f;
    mref = bound - 60.0f / (0.125f * 1.4426950408889634f);
    float sd = 0.f;
#pragma unroll
    for (int ks = 0; ks < 4; ++ks) {
      const uint4 wq = *(const uint4*)(qbase + (((c * 8 + ks * 2 + hi) ^ qsw) << 4));
      const uint4 wk = *(const uint4*)(proj + (rowb + qpos) * INC + 512 + h * 128 + (c * 8 + ks * 2 + hi) * 8);
      sd = dot8(wq, wk, sd);
    }
    sd = half_swap_sum(sd);
    loose = (bound - sd) * (0.125f * 1.4426950408889634f) > 170.0f;
  }
  uint4 pw[4];
  if (__any(loose) && lane == 0) *lflag = 1;
  __syncthreads();
  if (*lflag) {
    float mx = -1e30f; int sl = 0;
    for (int j = 0; j < NT; ++j) {
      asm volatile("s_waitcnt vmcnt(0)" ::: "memory");
      __syncthreads();
      if (j + 1 < NT) attn_issue_kv(KV + (sl == 2 ? 0 : sl + 1) * 32768, proj + (rowb + 64 * (j + 1)) * INC + h * 128, tid, wid);
      if (64 * j <= qw0 + 31) {
        const int kq = 64 * j + 4 * hi - qpos;
        if (64 * j + 63 > qw0) attn_qk<true, true>(pw, mx, qbase, qsw, KV + sl * 32768, c, kq, sl8, lane, r32, hi, augk0, augk1, augq);
        else attn_qk<false, true>(pw, mx, qbase, qsw, KV + sl * 32768, c, kq, sl8, lane, r32, hi, augk0, augk1, augq);
      }
      sl = (sl == 2 ? 0 : sl + 1);
    }
    mref = mx;
    __syncthreads();
    attn_issue_kv(KV, proj + rowb * INC + h * 128, tid, wid);
  }
  bool have = false;
  int slot = 0, pslot = 0;
  for (int j = 0; j <= NT; ++j) {
    if (j < NT) {
      asm volatile("s_waitcnt vmcnt(0)" ::: "memory");
      __syncthreads();
      if (j + 1 < NT) attn_issue_kv(KV + (slot == 2 ? 0 : slot + 1) * 32768, proj + (rowb + 64 * (j + 1)) * INC + h * 128, tid, wid);
    }
    if (have) { attn_pv(o, osum, pw, KV + pslot * 32768 + 16384, lane, hi); have = false; }
    if (j < NT && 64 * j <= qw0 + 31) {
      const char* kb = KV + slot * 32768;
      const int kq = 64 * j + 4 * hi - qpos;
      if (64 * j + 63 > qw0) attn_qk<true, false>(pw, mref, qbase, qsw, kb, c, kq, sl8, lane, r32, hi, augk0, augk1, augq);
      else attn_qk<false, false>(pw, mref, qbase, qsw, kb, c, kq, sl8, lane, r32, hi, augk0, augk1, augq);
      if (c == 0) attn_pv(o, osum, pw, kb + 16384, lane, hi); else have = true;
    }
    pslot = slot; slot = (slot == 2 ? 0 : slot + 1);
  }
  const float sc = (c == 0 ? 1.0f : lam) / osum[0];
  __syncthreads();
  float* X = (float*)(lds + 32768);
  if (c == 1) {
#pragma unroll
    for (int i = 0; i < 4; ++i)
#pragma unroll
      for (int r = 0; r < 16; ++r) X[(qg * 64 + i * 16 + r) * 64 + lane] = o[i][r] * sc;
  }
  __syncthreads();
  if (c == 0) {
    float ss = 0.f;
#pragma unroll
    for (int i = 0; i < 4; ++i) {
#pragma unroll
      for (int r = 0; r < 16; ++r) { float v = o[i][r] * sc - X[(qg * 64 + i * 16 + r) * 64 + lane]; o[i][r] = v; ss += v * v; }
      __builtin_amdgcn_sched_barrier(0);
    }
    ss = half_swap_sum(ss);
    const float rstd = rsqrtf(ss * (1.0f / 128.0f) + EPS) * (1.0f - LAM_INIT);
    bf16_t* orow = mix + (rowb + qpos) * D + h * 128;
#pragma unroll
    for (int i = 0; i < 4; ++i) {
#pragma unroll
      for (int g = 0; g < 4; ++g) {
        const int dv0 = 32 * i + 8 * g + 4 * hi;
        const float4 sg = *(const float4*)(subg + dv0);
        uint2 w; w.x = cvtpk(o[i][4 * g] * rstd * sg.x, o[i][4 * g + 1] * rstd * sg.y); w.y = cvtpk(o[i][4 * g + 2] * rstd * sg.z, o[i][4 * g + 3] * rstd * sg.w);
        *(uint2*)(orow + dv0) = w;
      }
      __builtin_amdgcn_sched_barrier(0);
    }
  }
}


__device__ __forceinline__ void p_norm1_rows(int G, const float* __restrict__ x, const float* __restrict__ meta, const float* __restrict__ g1, bf16_t* xn1) {
  const int tix = opaque_tid();
  const int lane = tix & 63, wv = blockIdx.x * 8 + (tix >> 6);
  float4 g[4];
#pragma unroll
  for (int q = 0; q < 4; ++q) g[q] = ((const float4*)g1)[q * 64 + lane];
  for (int row = wv * 2; row < ROWS; row += G * 16) {
    float4 v[2][4];
#pragma unroll
    for (int r = 0; r < 2; ++r) {
      const float* src = hrow_ptr(x, meta, row + r);
#pragma unroll
      for (int q = 0; q < 4; ++q) v[r][q] = src ? ((const float4*)src)[q * 64 + lane] : make_float4(0.f, 0.f, 0.f, 0.f);
    }
#pragma unroll
    for (int r = 0; r < 2; ++r) {
      float ss = 0.f;
#pragma unroll
      for (int q = 0; q < 4; ++q) ss += (v[r][q].x * v[r][q].x + v[r][q].y * v[r][q].y) + (v[r][q].z * v[r][q].z + v[r][q].w * v[r][q].w);
      const float rstd = rsqrtf(wave_sum(ss) * (1.0f / D) + EPS);
#pragma unroll
      for (int q = 0; q < 4; ++q) {
        uint2 o; o.x = cvtpk(v[r][q].x * rstd * g[q].x, v[r][q].y * rstd * g[q].y); o.y = cvtpk(v[r][q].z * rstd * g[q].z, v[r][q].w * rstd * g[q].w);
        ((uint2*)(xn1 + (size_t)(row + r) * D))[q * 64 + lane] = o;
      }
    }
  }
}

__device__ __forceinline__ void conv_unit(char* lds, const bf16_t* __restrict__ proj, bf16_t* mix, const float* __restrict__ cw, const float* __restrict__ cb,
                                          const float* __restrict__ gng, const float* __restrict__ gnb, int b, int pos0) {
  const int tix = opaque_tid();
  const int c = tix;
  float* U = (float*)lds;
  __syncthreads();
  {
    const int lane = tix & 63, wv = tix >> 6;
    uint4 ra[8], rg[8];
#pragma unroll
    for (int i = 0; i < 8; ++i) {
      const int r = wv + 8 * i, pos = pos0 - 30 + r;
      ra[i] = make_uint4(0, 0, 0, 0); rg[i] = make_uint4(0, 0, 0, 0);
      if (r < 62 && pos >= 0) {
        const bf16_t* pr = proj + ((size_t)b * LP + pos) * INC + 8 * lane;
        ra[i] = *(const uint4*)(pr + 1536); rg[i] = *(const uint4*)(pr + 2048);
      }
    }
#pragma unroll
    for (int i = 0; i < 8; ++i) {
      const int r = wv + 8 * i;
      if (r < 62) {
        const unsigned av[4] = {ra[i].x, ra[i].y, ra[i].z, ra[i].w}, gv[4] = {rg[i].x, rg[i].y, rg[i].z, rg[i].w};
        float u[8];
#pragma unroll
        for (int q = 0; q < 4; ++q) {
          const float a0 = __uint_as_float(av[q] << 16), a1 = __uint_as_float(av[q] & 0xffff0000u), g0 = __uint_as_float(gv[q] << 16), g1 = __uint_as_float(gv[q] & 0xffff0000u);
          u[2 * q] = a0 / (1.0f + __expf(-g0)); u[2 * q + 1] = a1 / (1.0f + __expf(-g1));
        }
        *(float4*)(U + r * 512 + 8 * lane) = make_float4(u[0], u[1], u[2], u[3]);
        *(float4*)(U + r * 512 + 8 * lane + 4) = make_float4(u[4], u[5], u[6], u[7]);
      }
    }
  }
  float w[31];
#pragma unroll
  for (int j = 0; j < 31; ++j) w[j] = cw[j * 512 + c];
  const float bias = cb[c], gg = gng[c], gb2 = gnb[c];
  __syncthreads();
#pragma unroll 1
  for (int t0 = 0; t0 < 32; t0 += 4) {
    float y[4] = {bias, bias, bias, bias};
#pragma unroll
    for (int r = 0; r < 34; ++r) {
      const float u = U[(t0 + r) * 512 + c];
#pragma unroll
      for (int q = 0; q < 4; ++q) { const int j = r - q; if (j >= 0 && j < 31) y[q] = fmaf(w[j], u, y[q]); }
    }
#pragma unroll
    for (int q = 0; q < 4; ++q) {
      float sm = row16_sum(y[q]);
      sm += __shfl_xor(sm, 16); sm = half_swap_sum(sm);
      const float d = y[q] - sm * (1.0f / 64.0f);
      float vr = row16_sum(d * d);
      vr += __shfl_xor(vr, 16); vr = half_swap_sum(vr);
      const float n = d * rsqrtf(vr * (1.0f / 64.0f) + EPS) * gg + gb2;
      mix[((size_t)b * LP + pos0 + t0 + q) * D + 512 + c] = f2bf(n / (1.0f + __expf(-n)));
    }
  }
}

__device__ __forceinline__ void p_conv_naive(int blk, const bf16_t* __restrict__ proj, bf16_t* mix, const float* cw, const float* cb, const float* gg_, const float* gb_) {
  const int tix = opaque_tid();
  int row = blk, tid = (tix & 255);
  int b = row / LP, pos = row - b * LP;
  int c0 = tid * 2;
  unsigned* outp = (unsigned*)(mix + (size_t)row * D + 512 + c0);
  if (pos >= LREAL) { *outp = 0u; return; }
  float y0 = cb[c0], y1 = cb[c0 + 1];
  for (int j = 0; j < 31; ++j) {
    int p = pos - 30 + j;
    if (p < 0) continue;
    const bf16_t* pr = proj + ((size_t)b * LP + p) * INC;
    unsigned a = *(const unsigned*)(pr + 1536 + c0), g = *(const unsigned*)(pr + 2048 + c0);
    float a0 = bf2f(a & 0xffffu), a1 = bf2f(a >> 16), g0 = bf2f(g & 0xffffu), g1 = bf2f(g >> 16);
    float u0 = a0 / (1.0f + __expf(-g0)), u1 = a1 / (1.0f + __expf(-g1));
    y0 += cw[j * 512 + c0] * u0; y1 += cw[j * 512 + c0 + 1] * u1;
  }
  float s = y0 + y1;
#pragma unroll
  for (int o = 16; o >= 1; o >>= 1) s += __shfl_xor(s, o);
  float mu = s * (1.0f / 64.0f);
  float d0 = y0 - mu, d1 = y1 - mu;
  float v = d0 * d0 + d1 * d1;
#pragma unroll
  for (int o = 16; o >= 1; o >>= 1) v += __shfl_xor(v, o);
  float rstd = rsqrtf(v * (1.0f / 64.0f) + EPS);
  float n0 = d0 * rstd * gg_[c0] + gb_[c0], n1 = d1 * rstd * gg_[c0 + 1] + gb_[c0 + 1];
  float r0 = n0 / (1.0f + __expf(-n0)), r1 = n1 / (1.0f + __expf(-n1));
  *outp = pack2(r0, r1);
}

__device__ __forceinline__ void p_norm2(int blk, float* red, const float* h2, const float* g2, bf16_t* xn2) {
  const int tix = opaque_tid();
  int row = blk, tid = (tix & 255);
  __syncthreads();
  float4 v = ((const float4*)(h2 + (size_t)row * D))[tid];
  float ss = v.x * v.x + v.y * v.y + v.z * v.z + v.w * v.w;
  ss = wave_sum(ss);
  if ((tid & 63) == 0) red[tid >> 6] = ss;
  __syncthreads();
  float tot = red[0] + red[1] + red[2] + red[3];
  float rstd = rsqrtf(tot * (1.0f / D) + EPS);
  float4 g = ((const float4*)g2)[tid];
  uint2 o; o.x = pack2(v.x * rstd * g.x, v.y * rstd * g.y); o.y = pack2(v.z * rstd * g.z, v.w * rstd * g.w);
  ((uint2*)(xn2 + (size_t)row * D))[tid] = o;
}

__device__ __forceinline__ void p_topk_naive(int blk, const bf16_t* __restrict__ qp, const float* __restrict__ sk, int* eb, float* gb) {
  const int tix = opaque_tid();
  int w = blk * 4 + ((tix & 255) >> 6), lane = (tix & 255) & 63;
  int row = w >> 3, h = w & 7;
  int pos = row % LP;
  if (pos < NMETA || pos >= LREAL) return;
  const float NEG = -3.0e38f;
  float top[2];
#pragma unroll
  for (int p = 0; p < 2; ++p) {
    const bf16_t* qv = qp + (size_t)row * 2048 + h * 256 + p * 128;
    const float* k0 = sk + ((size_t)(h * 2 + p) * 128 + lane) * 128;
    const float* k1 = k0 + 64 * 128;
    float s0 = 0.f, s1 = 0.f;
    for (int d = 0; d < 128; d += 8) {
      uint4 r = *(const uint4*)(qv + d);
      float qf[8] = {bf2f(r.x & 0xffffu), bf2f(r.x >> 16), bf2f(r.y & 0xffffu), bf2f(r.y >> 16), bf2f(r.z & 0xffffu), bf2f(r.z >> 16), bf2f(r.w & 0xffffu), bf2f(r.w >> 16)};
      float4 a0 = *(const float4*)(k0 + d), a1 = *(const float4*)(k0 + d + 4), b0 = *(const float4*)(k1 + d), b1 = *(const float4*)(k1 + d + 4);
      s0 += qf[0] * a0.x + qf[1] * a0.y + qf[2] * a0.z + qf[3] * a0.w + qf[4] * a1.x + qf[5] * a1.y + qf[6] * a1.z + qf[7] * a1.w;
      s1 += qf[0] * b0.x + qf[1] * b0.y + qf[2] * b0.z + qf[3] * b0.w + qf[4] * b1.x + qf[5] * b1.y + qf[6] * b1.z + qf[7] * b1.w;
    }
    float v0 = __uint_as_float((__float_as_uint(s0) & ~127u) | (unsigned)lane);
    float v1 = __uint_as_float((__float_as_uint(s1) & ~127u) | (unsigned)(lane + 64));
    float t = NEG;
    for (int it = 0; it < 16; ++it) {
      float m = wave_max(fmaxf(v0, v1));
      if (lane == it) t = m;
      if (v0 == m) v0 = NEG;
      if (v1 == m) v1 = NEG;
    }
    top[p] = t;
  }
  int ci = lane >> 2, jb = (lane & 3) * 4;
  float av = __uint_as_float(__float_as_uint(__shfl(top[0], ci)) & ~127u);
  float c[4];
#pragma unroll
  for (int jj = 0; jj < 4; ++jj) {
    float bv = __uint_as_float(__float_as_uint(__shfl(top[1], jb + jj)) & ~127u);
    float s = av + bv;
    c[jj] = __uint_as_float((__float_as_uint(s) & ~255u) | (unsigned)(ci * 16 + jb + jj));
  }
  float ct = NEG;
  for (int it = 0; it < 16; ++it) {
    float m = wave_max(fmaxf(fmaxf(c[0], c[1]), fmaxf(c[2], c[3])));
    if (lane == it) ct = m;
#pragma unroll
    for (int jj = 0; jj < 4; ++jj) if (c[jj] == m) c[jj] = NEG;
  }
  unsigned cbits = __float_as_uint(ct);
  int cidx = cbits & 255u;
  float cval = __uint_as_float(cbits & ~255u);
  int i1 = __float_as_uint(__shfl(top[0], (cidx >> 4) & 15)) & 127u;
  int i2 = __float_as_uint(__shfl(top[1], cidx & 15)) & 127u;
  float mx = __shfl(cval, 0);
  float ex = lane < 16 ? __expf(cval - mx) : 0.f;
  float sum = wave_sum(ex);
  if (lane < 16) {
    eb[((size_t)row * 8 + h) * 16 + lane] = i1 * 128 + i2;
    gb[((size_t)row * 8 + h) * 16 + lane] = ex / sum;
  }
}


__device__ __forceinline__ void ce_desc(float& a, float& b) { const float hi = fmaxf(a, b), lo = fminf(a, b); a = hi; b = lo; }
__device__ __forceinline__ void ce_asc(float& a, float& b) { const float hi = fmaxf(a, b), lo = fminf(a, b); a = lo; b = hi; }
template <int N> __device__ __forceinline__ void bitonic_sort_desc(float (&v)[N]) {
#pragma unroll
  for (int k = 2; k <= N; k <<= 1)
#pragma unroll
    for (int j = k >> 1; j > 0; j >>= 1)
#pragma unroll
      for (int i = 0; i < N; ++i) { const int l = i ^ j; if (l > i) { if ((i & k) == 0) ce_desc(v[i], v[l]); else ce_asc(v[i], v[l]); } }
}
template <int N> __device__ __forceinline__ void bitonic_merge_desc(float (&v)[N]) {
#pragma unroll
  for (int j = N >> 1; j > 0; j >>= 1)
#pragma unroll
    for (int i = 0; i < N; ++i) { const int l = i ^ j; if (l > i) ce_desc(v[i], v[l]); }
}
__device__ __forceinline__ void cep_desc(float& a, float& b, int& pa, int& pb) { const bool sw = b > a; const float hi = sw ? b : a, lo = sw ? a : b; const int ph = sw ? pb : pa, pl = sw ? pa : pb; a = hi; b = lo; pa = ph; pb = pl; }
__device__ __forceinline__ void cep_asc(float& a, float& b, int& pa, int& pb) { const bool sw = b < a; const float lo = sw ? b : a, hi = sw ? a : b; const int pl = sw ? pb : pa, ph = sw ? pa : pb; a = lo; b = hi; pa = pl; pb = ph; }
template <int N> __device__ __forceinline__ void bitonic_sortp_desc(float (&v)[N], int (&q)[N]) {
#pragma unroll
  for (int k = 2; k <= N; k <<= 1)
#pragma unroll
    for (int j = k >> 1; j > 0; j >>= 1)
#pragma unroll
      for (int i = 0; i < N; ++i) { const int l = i ^ j; if (l > i) { if ((i & k) == 0) cep_desc(v[i], v[l], q[i], q[l]); else cep_asc(v[i], v[l], q[i], q[l]); } }
}
template <int N> __device__ __forceinline__ void bitonic_mergep_desc(float (&v)[N], int (&q)[N]) {
#pragma unroll
  for (int j = N >> 1; j > 0; j >>= 1)
#pragma unroll
    for (int i = 0; i < N; ++i) { const int l = i ^ j; if (l > i) cep_desc(v[i], v[l], q[i], q[l]); }
}
__host__ __device__ constexpr int cand_slot(int i, int j) { int s = 0; for (int ii = 0; ii < i; ++ii) s += 16 / (ii + 1); return s + j; }

__device__ __forceinline__ void peer_topk_unit(char* lds, const bf16_t* __restrict__ qp, const bf16_t* __restrict__ skb, const float* __restrict__ rowss, int* eb, float* gb, int row0, int h) {
  const int tix = opaque_tid();
  const int tid = tix, lane = tid & 63, wid = tid >> 6, fr = lane & 15, fq = lane >> 4;
  __syncthreads();
#pragma unroll
  for (int i = 0; i < 8; ++i) {
    const int g = i * 512 + tid, row = g >> 4, pos = g & 15;
    *(uint4*)(lds + g * 16) = *(const uint4*)(skb + ((size_t)(h * 2) * 128 + row) * 128 + ((pos ^ (row & 15)) << 3));
  }
  if (tid < 64) {
    int i = 0, base = 0;
    while (i < 15 && tid >= base + 16 / (i + 1)) { base += 16 / (i + 1); ++i; }
    ((int*)(lds + 65536))[tid] = (i << 4) | ((tid - base) & 15);
  }
  __syncthreads();
  const int tok = row0 + wid * 16 + fr;
  float top[2][16];
#pragma unroll
  for (int p = 0; p < 2; ++p) {
    f32x4 acc[8];
#pragma unroll
    for (int i = 0; i < 8; ++i) acc[i] = (f32x4){0.f, 0.f, 0.f, 0.f};
    const bf16_t* xrow = qp + (size_t)tok * 2048 + h * 256 + p * 128 + fq * 8;
#pragma unroll
    for (int ks = 0; ks < 4; ++ks) {
      const bf16x8 xb = *(const bf16x8*)(xrow + ks * 32);
      const int ch = ks * 4 + fq;
#pragma unroll
      for (int nt = 0; nt < 8; ++nt) {
        const int r = p * 128 + nt * 16 + fr;
        const bf16x8 wa = *(const bf16x8*)(lds + r * 256 + ((ch ^ (r & 15)) << 4));
        acc[nt] = __builtin_amdgcn_mfma_f32_16x16x32_bf16(wa, xb, acc[nt], 0, 0, 0);
      }
    }
    float v[32];
#pragma unroll
    for (int nt = 0; nt < 8; ++nt)
#pragma unroll
      for (int r = 0; r < 4; ++r) v[nt * 4 + r] = __uint_as_float((__float_as_uint(acc[nt][r]) & ~127u) | (unsigned)(nt * 16 + fq * 4 + r));
    bitonic_sort_desc<32>(v);
    float t[16];
#pragma unroll
    for (int i = 0; i < 16; ++i) t[i] = v[i];
#pragma unroll
    for (int rnd = 0; rnd < 2; ++rnd) {
      float pb[16];
#pragma unroll
      for (int i = 0; i < 16; ++i) pb[i] = __shfl_xor(t[15 - i], rnd == 0 ? 16 : 32);
#pragma unroll
      for (int i = 0; i < 16; ++i) t[i] = fmaxf(t[i], pb[i]);
      bitonic_merge_desc<16>(t);
    }
#pragma unroll
    for (int i = 0; i < 16; ++i) top[p][i] = t[i];
  }
  int* ST = (int*)(lds + 65536);
  int* IDX = (int*)(lds + 65536 + 256) + (wid * 16 + fr) * 32;
#define SEL4(arr, q) (fq == 0 ? arr[q] : fq == 1 ? arr[4 + (q)] : fq == 2 ? arr[8 + (q)] : arr[12 + (q)])
  {
    int4 ia, ib;
    ia.x = __float_as_uint(SEL4(top[0], 0)) & 127; ia.y = __float_as_uint(SEL4(top[0], 1)) & 127; ia.z = __float_as_uint(SEL4(top[0], 2)) & 127; ia.w = __float_as_uint(SEL4(top[0], 3)) & 127;
    ib.x = __float_as_uint(SEL4(top[1], 0)) & 127; ib.y = __float_as_uint(SEL4(top[1], 1)) & 127; ib.z = __float_as_uint(SEL4(top[1], 2)) & 127; ib.w = __float_as_uint(SEL4(top[1], 3)) & 127;
    *(int4*)(IDX + 4 * fq) = ia; *(int4*)(IDX + 16 + 4 * fq) = ib;
  }
  float cv[16];
  {
    const float NEGV = -3.0e38f;
    float am[16], bm[16];
#pragma unroll
    for (int i = 0; i < 16; ++i) { am[i] = __uint_as_float(__float_as_uint(top[0][i]) & ~127u); bm[i] = __uint_as_float(__float_as_uint(top[1][i]) & ~127u); }
#define CAND(i, j) __uint_as_float((__float_as_uint(am[i] + bm[j]) & ~63u) | (unsigned)cand_slot(i, j))
    float A[16], B[16], C[16], Dd[8], E[8], F[16];
#pragma unroll
    for (int j = 0; j < 16; ++j) A[j] = CAND(0, j);
#pragma unroll
    for (int j = 0; j < 8; ++j) { B[j] = CAND(1, j); B[15 - j] = CAND(8 + j, 0); }
    bitonic_merge_desc<16>(B);
#pragma unroll
    for (int j = 0; j < 5; ++j) C[j] = CAND(2, j);
#pragma unroll
    for (int j = 5; j < 12; ++j) C[j] = NEGV;
#pragma unroll
    for (int j = 0; j < 4; ++j) C[15 - j] = CAND(3, j);
    bitonic_merge_desc<16>(C);
    Dd[0] = CAND(4, 0); Dd[1] = CAND(4, 1); Dd[2] = CAND(4, 2); Dd[3] = NEGV; Dd[4] = NEGV; Dd[5] = NEGV; Dd[6] = CAND(5, 1); Dd[7] = CAND(5, 0);
    bitonic_merge_desc<8>(Dd);
    E[0] = CAND(6, 0); E[1] = CAND(6, 1); E[2] = NEGV; E[3] = NEGV; E[4] = NEGV; E[5] = NEGV; E[6] = CAND(7, 1); E[7] = CAND(7, 0);
    bitonic_merge_desc<8>(E);
#pragma unroll
    for (int j = 0; j < 8; ++j) { F[j] = Dd[j]; F[15 - j] = E[j]; }
    bitonic_merge_desc<16>(F);
#undef CAND
#pragma unroll
    for (int j = 0; j < 16; ++j) { A[j] = fmaxf(A[j], B[15 - j]); C[j] = fmaxf(C[j], F[15 - j]); }
    bitonic_merge_desc<16>(A);
    bitonic_merge_desc<16>(C);
#pragma unroll
    for (int j = 0; j < 16; ++j) cv[j] = fmaxf(A[j], C[15 - j]);
    bitonic_merge_desc<16>(cv);
  }
  float ex[16]; float sum = 0.f;
  const float c0v = __uint_as_float(__float_as_uint(cv[0]) & ~63u);
  const float rs = row_rstd(rowss, (size_t)tok);
#pragma unroll
  for (int i = 0; i < 16; ++i) { ex[i] = __expf((__uint_as_float(__float_as_uint(cv[i]) & ~63u) - c0v) * rs); sum += ex[i]; }
  const float inv = 1.0f / sum;
  int e4[4]; float g4[4];
#pragma unroll
  for (int q = 0; q < 4; ++q) {
    const int slot = __float_as_uint(SEL4(cv, q)) & 63;
    const int ij = ST[slot];
    e4[q] = IDX[ij >> 4] * 128 + IDX[16 + (ij & 15)];
    g4[q] = SEL4(ex, q) * inv;
  }
#undef SEL4
  *(int4*)(eb + ((size_t)tok * 8 + h) * 16 + 4 * fq) = make_int4(e4[0], e4[1], e4[2], e4[3]);
  *(float4*)(gb + ((size_t)tok * 8 + h) * 16 + 4 * fq) = make_float4(g4[0], g4[1], g4[2], g4[3]);
}

__device__ __forceinline__ void p_cvt_bf16(int blk, int nblk, const float* __restrict__ src, bf16_t* dst, size_t n8) {
  const int tix = opaque_tid();
  for (size_t i = (size_t)blk * 512 + tix; i < n8; i += (size_t)nblk * 512) {
    const float4 a = ((const float4*)src)[2 * i], b = ((const float4*)src)[2 * i + 1];
    uint4 w; w.x = cvtpk(a.x, a.y); w.y = cvtpk(a.z, a.w); w.z = cvtpk(b.x, b.y); w.w = cvtpk(b.z, b.w);
    ((uint4*)dst)[i] = w;
  }
}


typedef float f32x2v __attribute__((ext_vector_type(2)));
__device__ __forceinline__ void p_cvt_fp8_rows(int blk, int nblk, const float* __restrict__ src, unsigned* dst, float* inv, const float* __restrict__ csc) {
  const int tix = opaque_tid();
  const int lane = tix & 63, wid = tix >> 6;
  for (int r = blk * 8 + wid; r < 16384; r += nblk * 8) {
    const float4* sp = (const float4*)(src + (size_t)r * D);
    float4 v[4];
#pragma unroll
    for (int k = 0; k < 4; ++k) v[k] = sp[k * 64 + lane];
    if (csc) {
#pragma unroll
      for (int k = 0; k < 4; ++k) { const float4 g = ((const float4*)csc)[k * 64 + lane]; v[k].x *= g.x; v[k].y *= g.y; v[k].z *= g.z; v[k].w *= g.w; }
    }
    float am = 0.f;
#pragma unroll
    for (int k = 0; k < 4; ++k) am = fmaxf(am, fmaxf(fmaxf(fabsf(v[k].x), fabsf(v[k].y)), fmaxf(fabsf(v[k].z), fabsf(v[k].w))));
    am = wave_max(am);
    const float sc = am > 0.f ? 384.0f / am : 1.0f;
#pragma unroll
    for (int k = 0; k < 4; ++k) {
      int w = __builtin_amdgcn_cvt_pk_fp8_f32(v[k].x * sc, v[k].y * sc, 0, false);
      w = __builtin_amdgcn_cvt_pk_fp8_f32(v[k].z * sc, v[k].w * sc, w, true);
      { const int c = 256 * k + 4 * lane; dst[((size_t)(c >> 7) * (16384 * 128) + (size_t)r * 128 + (c & 127)) >> 2] = (unsigned)w; }
    }
    if (lane == 0) inv[r] = am > 0.f ? am * (1.0f / 384.0f) : 1.0f;
  }
}
__device__ __forceinline__ void peer_gather_token(char* wlds  , int lane, size_t row, size_t orow, const bf16_t* __restrict__ xn2, const float* __restrict__ h2,
                                                  const int* __restrict__ eb, const float* __restrict__ gb, const unsigned char* __restrict__ ut8, const float* __restrict__ uinv,
                                                  const unsigned char* __restrict__ vt8, const float* __restrict__ vinv, const float* __restrict__ fg, float* __restrict__ out) {
  int* E = (int*)wlds; float* Gt = (float*)(wlds + 512); float* W = (float*)(wlds + 1024);
  const int i16 = lane & 15, g = lane >> 4;
  {
    const int e0 = eb[row * 128 + lane], e1 = eb[row * 128 + 64 + lane];
    E[lane] = e0; E[lane + 64] = e1;
    Gt[lane] = gb[row * 128 + lane]; Gt[lane + 64] = gb[row * 128 + 64 + lane];
  }
  float xf[4][16];
#pragma unroll
  for (int k = 0; k < 4; ++k) {
    const uint4 a = *(const uint4*)(xn2 + row * D + 256 * k + 16 * i16), b = *(const uint4*)(xn2 + row * D + 256 * k + 16 * i16 + 8);
    xf[k][0] = __uint_as_float(a.x << 16); xf[k][1] = __uint_as_float(a.x & 0xffff0000u); xf[k][2] = __uint_as_float(a.y << 16); xf[k][3] = __uint_as_float(a.y & 0xffff0000u);
    xf[k][4] = __uint_as_float(a.z << 16); xf[k][5] = __uint_as_float(a.z & 0xffff0000u); xf[k][6] = __uint_as_float(a.w << 16); xf[k][7] = __uint_as_float(a.w & 0xffff0000u);
    xf[k][8] = __uint_as_float(b.x << 16); xf[k][9] = __uint_as_float(b.x & 0xffff0000u); xf[k][10] = __uint_as_float(b.y << 16); xf[k][11] = __uint_as_float(b.y & 0xffff0000u);
    xf[k][12] = __uint_as_float(b.z << 16); xf[k][13] = __uint_as_float(b.z & 0xffff0000u); xf[k][14] = __uint_as_float(b.w << 16); xf[k][15] = __uint_as_float(b.w & 0xffff0000u);
  }
#pragma unroll 2
  for (int m = 0; m < 32; ++m) {
    const int e = E[4 * m + g];
    const unsigned char* ur = ut8 + (size_t)e * D + 16 * i16;
    uint4 u[4];
#pragma unroll
    for (int k = 0; k < 4; ++k) u[k] = *(const uint4*)(ur + 256 * k);
    float d0 = 0.f, d1 = 0.f;
#pragma unroll
    for (int k = 0; k < 4; ++k) {
      const unsigned wv[4] = {u[k].x, u[k].y, u[k].z, u[k].w};
#pragma unroll
      for (int q = 0; q < 4; ++q) {
        const f32x2v lo = __builtin_amdgcn_cvt_pk_f32_fp8((int)wv[q], false), hi = __builtin_amdgcn_cvt_pk_f32_fp8((int)wv[q], true);
        d0 = fmaf(lo.x, xf[k][4 * q], d0); d1 = fmaf(lo.y, xf[k][4 * q + 1], d1);
        d0 = fmaf(hi.x, xf[k][4 * q + 2], d0); d1 = fmaf(hi.y, xf[k][4 * q + 3], d1);
      }
    }
    const float d = row16_sum(d0 + d1);
    if (i16 == 0) W[4 * m + g] = d;
  }
  {
    const int e0 = E[lane], e1 = E[lane + 64];
    const float ui0 = uinv[e0], ui1 = uinv[e1];
    const float a0 = W[lane] * ui0, a1 = W[lane + 64] * ui1;
    const float g0 = Gt[lane], g1 = Gt[lane + 64];
    W[lane] = g0 * 0.5f * a0 * (1.0f + erff(a0 * 0.70710678118654752f)) * vinv[e0];
    W[lane + 64] = g1 * 0.5f * a1 * (1.0f + erff(a1 * 0.70710678118654752f)) * vinv[e1];
  }
  float acc[4][16];
#pragma unroll
  for (int k = 0; k < 4; ++k)
#pragma unroll
    for (int i = 0; i < 16; ++i) acc[k][i] = 0.f;
#pragma unroll 2
  for (int m = 0; m < 32; ++m) {
    const int e = E[4 * m + g];
    const float w = W[4 * m + g];
    const unsigned char* vr = vt8 + (size_t)e * D + 16 * i16;
    uint4 v[4];
#pragma unroll
    for (int k = 0; k < 4; ++k) v[k] = *(const uint4*)(vr + 256 * k);
#pragma unroll
    for (int k = 0; k < 4; ++k) {
      const unsigned wv[4] = {v[k].x, v[k].y, v[k].z, v[k].w};
#pragma unroll
      for (int q = 0; q < 4; ++q) {
        const f32x2v lo = __builtin_amdgcn_cvt_pk_f32_fp8((int)wv[q], false), hi = __builtin_amdgcn_cvt_pk_f32_fp8((int)wv[q], true);
        acc[k][4 * q] = fmaf(w, lo.x, acc[k][4 * q]); acc[k][4 * q + 1] = fmaf(w, lo.y, acc[k][4 * q + 1]);
        acc[k][4 * q + 2] = fmaf(w, hi.x, acc[k][4 * q + 2]); acc[k][4 * q + 3] = fmaf(w, hi.y, acc[k][4 * q + 3]);
      }
    }
  }
  float res[16];
#pragma unroll
  for (int k = 0; k < 4; ++k)
#pragma unroll
    for (int j = 0; j < 16; ++j) {
      float t = acc[k][j];
      t += __shfl_xor(t, 16); t += __shfl_xor(t, 32);
      if (k == g) res[j] = t;
    }
  const int c0 = 256 * g + 16 * i16;
  float ss = 0.f;
#pragma unroll
  for (int q = 0; q < 4; ++q) {
    const float4 hv = *(const float4*)(h2 + row * D + c0 + 4 * q);
    res[4 * q] += hv.x; res[4 * q + 1] += hv.y; res[4 * q + 2] += hv.z; res[4 * q + 3] += hv.w;
  }
#pragma unroll
  for (int i = 0; i < 16; ++i) ss += res[i] * res[i];
  ss = wave_sum(ss);
  const float rstd = rsqrtf(ss * (1.0f / D) + EPS);
#pragma unroll
  for (int q = 0; q < 4; ++q) {
    const float4 f = *(const float4*)(fg + c0 + 4 * q);
    *(float4*)(out + orow * D + c0 + 4 * q) = make_float4(res[4 * q] * rstd * f.x, res[4 * q + 1] * rstd * f.y, res[4 * q + 2] * rstd * f.z, res[4 * q + 3] * rstd * f.w);
  }
}


__device__ __forceinline__ unsigned xcc_id() { return (unsigned)__builtin_amdgcn_s_getreg((3 << 11) | 20) & 7u; }

__device__ __forceinline__ void ds_issue(uint4 (&u)[16], const int* El  , const unsigned char* __restrict__ tab) {
  int ev[16];
#pragma unroll
  for (int q = 0; q < 4; ++q) { const int4 t = *(const int4*)(El + 4 * q); ev[4 * q] = t.x; ev[4 * q + 1] = t.y; ev[4 * q + 2] = t.z; ev[4 * q + 3] = t.w; }
#pragma unroll
  for (int it = 0; it < 16; ++it) u[it] = *(const uint4*)(tab + (size_t)(unsigned)ev[it] * 128);
}
__device__ __forceinline__ void ds_u_compute(const uint4 (&u)[16], const char* Xl  , float* __restrict__ pout, int j) {
  f32x2v xf[8];
  {
    const uint4 a = *(const uint4*)Xl, c = *(const uint4*)(Xl + 16);
    xf[0] = (f32x2v){__uint_as_float(a.x << 16), __uint_as_float(a.x & 0xffff0000u)}; xf[1] = (f32x2v){__uint_as_float(a.y << 16), __uint_as_float(a.y & 0xffff0000u)};
    xf[2] = (f32x2v){__uint_as_float(a.z << 16), __uint_as_float(a.z & 0xffff0000u)}; xf[3] = (f32x2v){__uint_as_float(a.w << 16), __uint_as_float(a.w & 0xffff0000u)};
    xf[4] = (f32x2v){__uint_as_float(c.x << 16), __uint_as_float(c.x & 0xffff0000u)}; xf[5] = (f32x2v){__uint_as_float(c.y << 16), __uint_as_float(c.y & 0xffff0000u)};
    xf[6] = (f32x2v){__uint_as_float(c.z << 16), __uint_as_float(c.z & 0xffff0000u)}; xf[7] = (f32x2v){__uint_as_float(c.w << 16), __uint_as_float(c.w & 0xffff0000u)};
  }
  float k0 = 0.f, k1 = 0.f;
#pragma unroll
  for (int it = 0; it < 16; ++it) {
    const unsigned wv[4] = {u[it].x, u[it].y, u[it].z, u[it].w};
    f32x2v d2 = {0.f, 0.f};
#pragma unroll
    for (int q = 0; q < 4; ++q) {
      const f32x2v lo = __builtin_amdgcn_cvt_pk_f32_fp8((int)wv[q], false), hi = __builtin_amdgcn_cvt_pk_f32_fp8((int)wv[q], true);
      d2 = __builtin_elementwise_fma(lo, xf[2 * q], d2); d2 = __builtin_elementwise_fma(hi, xf[2 * q + 1], d2);
    }
    const float d = sum8(d2.x + d2.y);
    if ((it >> 1) == j) { if (it & 1) k1 = d; else k0 = d; }
  }
  *(float2*)pout = make_float2(k0, k1);
}
__device__ __forceinline__ void ds_u_chunk(char* wl  , int lane, int tk0, int s, const bf16_t* __restrict__ xn2, const int* __restrict__ eb, const unsigned char* __restrict__ ut8, float* __restrict__ partial) {
  const int b = tk0 / SEQ, sq = tk0 - b * SEQ;
  const size_t row0 = (size_t)b * LP + NMETA + sq;
  const int j = lane & 7, gi = lane >> 3;
  int* El = (int*)wl;
  char* Xl = wl + 8192;
#pragma unroll
  for (int i = 0; i < 8; ++i) *(int4*)(El + (i * 64 + lane) * 4) = *(const int4*)(eb + row0 * 128 + (i * 64 + lane) * 4);
#pragma unroll
  for (int i = 0; i < 4; ++i) { const int g = i * 64 + lane, t = g >> 4, c = g & 15; *(uint4*)(Xl + g * 16) = *(const uint4*)(xn2 + (row0 + t) * D + 128 * s + 8 * c); }
  const unsigned char* tab = ut8 + (size_t)s * (16384 * 128) + 16 * j;
  float* pout = partial + ((size_t)tk0 * 8 + s) * 128 + gi * 16 + 2 * j;
  uint4 ua[16], ub[16];
  ds_issue(ua, El + gi * 16, tab);
#pragma unroll 1
  for (int t = 0; t < 16; t += 2) {
    ds_issue(ub, El + (t + 1) * 128 + gi * 16, tab);
    ds_u_compute(ua, Xl + t * 256 + 32 * j, pout + (size_t)t * 1024, j);
    if (t + 2 < 16) ds_issue(ua, El + (t + 2) * 128 + gi * 16, tab);
    ds_u_compute(ub, Xl + (t + 1) * 256 + 32 * j, pout + (size_t)(t + 1) * 1024, j);
  }
}

__device__ __forceinline__ void ds_v_compute(const uint4 (&v)[16], const float* Wl  , int lane, int j, int gi, size_t row, int tk, int s,
                                             const bf16_t* __restrict__ hb, float* __restrict__ out, float* __restrict__ ssq) {
  float w[16];
#pragma unroll
  for (int q = 0; q < 4; ++q) { const float4 f = *(const float4*)(Wl + 4 * q); w[4 * q] = f.x; w[4 * q + 1] = f.y; w[4 * q + 2] = f.z; w[4 * q + 3] = f.w; }
  f32x2v acc[8];
#pragma unroll
  for (int i = 0; i < 8; ++i) acc[i] = (f32x2v){0.f, 0.f};
#pragma unroll
  for (int it = 0; it < 16; ++it) {
    const unsigned wv[4] = {v[it].x, v[it].y, v[it].z, v[it].w};
    const f32x2v w2 = {w[it], w[it]};
#pragma unroll
    for (int q = 0; q < 4; ++q) {
      const f32x2v lo = __builtin_amdgcn_cvt_pk_f32_fp8((int)wv[q], false), hi = __builtin_amdgcn_cvt_pk_f32_fp8((int)wv[q], true);
      acc[2 * q] = __builtin_elementwise_fma(w2, lo, acc[2 * q]); acc[2 * q + 1] = __builtin_elementwise_fma(w2, hi, acc[2 * q + 1]);
    }
  }
  float r4[4] = {0.f, 0.f, 0.f, 0.f};
#pragma unroll
  for (int i = 0; i < 16; ++i) {
    float t = (i & 1) ? acc[i >> 1].y : acc[i >> 1].x;
    t = dpp_add<0x128>(t);
    t += __shfl_xor(t, 16);
    t = half_swap_sum(t);
    if ((i >> 2) == gi) r4[i & 3] = t;
  }
  float ss = 0.f;
  if (gi < 4) {
    const int c0 = 128 * s + 16 * j + 4 * gi;
    const uint2 hw = *(const uint2*)(hb + row * D + c0);
    const float4 o = make_float4(__uint_as_float(hw.x << 16) + r4[0], __uint_as_float(hw.x & 0xffff0000u) + r4[1], __uint_as_float(hw.y << 16) + r4[2], __uint_as_float(hw.y & 0xffff0000u) + r4[3]);
    ss = o.x * o.x + o.y * o.y + o.z * o.z + o.w * o.w;
    *(float4*)(out + (size_t)tk * D + c0) = o;
  }
  ss = wave_sum(ss);
  if (lane == 0) ssq[(size_t)tk * 8 + s] = ss;
}
__device__ __forceinline__ void ds_v_chunk(char* wl, int lane, int tk0, int s, const bf16_t* __restrict__ hb, const int* __restrict__ eb, const float* __restrict__ wbuf, const unsigned char* __restrict__ vt8,
                                           float* __restrict__ out, float* __restrict__ ssq) {
  const int b = tk0 / SEQ, sq = tk0 - b * SEQ;
  const size_t row0 = (size_t)b * LP + NMETA + sq;
  const int j = lane & 7, gi = lane >> 3;
  int* El = (int*)wl;
  float* Wl = (float*)(wl + 8192);
#pragma unroll
  for (int i = 0; i < 8; ++i) {
    *(int4*)(El + (i * 64 + lane) * 4) = *(const int4*)(eb + row0 * 128 + (i * 64 + lane) * 4);
    *(float4*)(Wl + (i * 64 + lane) * 4) = *(const float4*)(wbuf + (size_t)tk0 * 128 + (i * 64 + lane) * 4);
  }
  const unsigned char* tab = vt8 + (size_t)s * (16384 * 128) + 16 * j;
  uint4 va[16], vb[16];
  ds_issue(va, El + gi * 16, tab);
#pragma unroll 1
  for (int t = 0; t < 16; t += 2) {
    ds_issue(vb, El + (t + 1) * 128 + gi * 16, tab);
    ds_v_compute(va, Wl + t * 128 + gi * 16, lane, j, gi, row0 + t, tk0 + t, s, hb, out, ssq);
    if (t + 2 < 16) ds_issue(va, El + (t + 2) * 128 + gi * 16, tab);
    ds_v_compute(vb, Wl + (t + 1) * 128 + gi * 16, lane, j, gi, row0 + t + 1, tk0 + t + 1, s, hb, out, ssq);
  }
}

__device__ __forceinline__ void p_gather_naive(int blk, const bf16_t* __restrict__ xn2, const float* __restrict__ h2, const int* __restrict__ eb, const float* __restrict__ gb,
                                                      const float* __restrict__ ut, const float* __restrict__ vt, const float* fg, float* out) {
  const int tix = opaque_tid();
  int tk = blk * 4 + ((tix & 255) >> 6), lane = (tix & 255) & 63;
  int b = tk / SEQ, s = tk - b * SEQ;
  size_t row = (size_t)b * LP + NMETA + s;
  float xv[16];
  {
    const uint4* xp = (const uint4*)(xn2 + row * D + lane * 16);
#pragma unroll
    for (int i = 0; i < 2; ++i) {
      uint4 r = xp[i];
      xv[i * 8 + 0] = bf2f(r.x & 0xffffu); xv[i * 8 + 1] = bf2f(r.x >> 16); xv[i * 8 + 2] = bf2f(r.y & 0xffffu); xv[i * 8 + 3] = bf2f(r.y >> 16);
      xv[i * 8 + 4] = bf2f(r.z & 0xffffu); xv[i * 8 + 5] = bf2f(r.z >> 16); xv[i * 8 + 6] = bf2f(r.w & 0xffffu); xv[i * 8 + 7] = bf2f(r.w >> 16);
    }
  }
  float acc[16];
#pragma unroll
  for (int i = 0; i < 16; ++i) acc[i] = 0.f;
  for (int k = 0; k < 128; ++k) {
    int e = eb[row * 128 + k];
    float gate = gb[row * 128 + k];
    const float4* up = (const float4*)(ut + (size_t)e * D + lane * 16);
    float dsum = 0.f;
#pragma unroll
    for (int i = 0; i < 4; ++i) { float4 u = up[i]; dsum += u.x * xv[i * 4] + u.y * xv[i * 4 + 1] + u.z * xv[i * 4 + 2] + u.w * xv[i * 4 + 3]; }
    dsum = wave_sum(dsum);
    float act = 0.5f * dsum * (1.0f + erff(dsum * 0.70710678118654752f));
    float wgt = gate * act;
    const float4* vp = (const float4*)(vt + (size_t)e * D + lane * 16);
#pragma unroll
    for (int i = 0; i < 4; ++i) { float4 v = vp[i]; acc[i * 4] += wgt * v.x; acc[i * 4 + 1] += wgt * v.y; acc[i * 4 + 2] += wgt * v.z; acc[i * 4 + 3] += wgt * v.w; }
  }
  const float4* hp = (const float4*)(h2 + row * D + lane * 16);
  float ss = 0.f;
#pragma unroll
  for (int i = 0; i < 4; ++i) { float4 hv = hp[i]; acc[i * 4] += hv.x; acc[i * 4 + 1] += hv.y; acc[i * 4 + 2] += hv.z; acc[i * 4 + 3] += hv.w; }
#pragma unroll
  for (int i = 0; i < 16; ++i) ss += acc[i] * acc[i];
  ss = wave_sum(ss);
  float rstd = rsqrtf(ss * (1.0f / D) + EPS);
  float4* op = (float4*)(out + ((size_t)b * SEQ + s) * D + lane * 16);
  const float4* gp = (const float4*)(fg + lane * 16);
#pragma unroll
  for (int i = 0; i < 4; ++i) { float4 g = gp[i]; op[i] = make_float4(acc[i * 4] * rstd * g.x, acc[i * 4 + 1] * rstd * g.y, acc[i * 4 + 2] * rstd * g.z, acc[i * 4 + 3] * rstd * g.w); }
}


template <class Epi>
__device__ __forceinline__ void gemm_tile(char* lds, const bf16_t* __restrict__ X, int ldx, const bf16_t* __restrict__ Wt, int ldw, int K, int m0, int n0, const Epi& epi) {
  const int tix = opaque_tid();
  const int tid = tix, lane = tid & 63, wid = tid >> 6;
  const int wm = wid >> 1, wn = wid & 1;
  const int sc = tid & 7, sr = tid >> 3;
  f32x4 acc[4][4];
#pragma unroll
  for (int i = 0; i < 4; ++i)
#pragma unroll
    for (int j = 0; j < 4; ++j) acc[i][j] = (f32x4){0.f, 0.f, 0.f, 0.f};
  uint4 ra[4], rb[2];
  const bf16_t* xp = X + (size_t)(m0 + sr) * ldx + sc * 8;
  const bf16_t* wp = Wt + (size_t)(n0 + sr) * ldw + sc * 8;
  const int nk = K >> 6;
#pragma unroll
  for (int i = 0; i < 4; ++i) ra[i] = *(const uint4*)(xp + (size_t)(64 * i) * ldx);
#pragma unroll
  for (int i = 0; i < 2; ++i) rb[i] = *(const uint4*)(wp + (size_t)(64 * i) * ldw);
#pragma unroll
  for (int i = 0; i < 4; ++i) { int r = sr + 64 * i; *(uint4*)(lds + r * 128 + ((sc ^ ((r >> 1) & 7)) << 4)) = ra[i]; }
#pragma unroll
  for (int i = 0; i < 2; ++i) { int r = sr + 64 * i; *(uint4*)(lds + 32768 + r * 128 + ((sc ^ ((r >> 1) & 7)) << 4)) = rb[i]; }
  __syncthreads();
  const int fr = lane & 15, fq = lane >> 4;
  for (int kt = 0; kt < nk; ++kt) {
    if (kt + 1 < nk) {
#pragma unroll
      for (int i = 0; i < 4; ++i) ra[i] = *(const uint4*)(xp + (size_t)(64 * i) * ldx + (kt + 1) * 64);
#pragma unroll
      for (int i = 0; i < 2; ++i) rb[i] = *(const uint4*)(wp + (size_t)(64 * i) * ldw + (kt + 1) * 64);
    }
    const char* la = lds + (kt & 1) * 49152;
    const char* lb = la + 32768;
#pragma unroll
    for (int kk = 0; kk < 2; ++kk) {
      bf16x8 xa[4], wb[4];
      const int c = kk * 4 + fq;
#pragma unroll
      for (int t = 0; t < 4; ++t) {
        int r = wm * 64 + t * 16 + fr; xa[t] = *(const bf16x8*)(la + r * 128 + ((c ^ ((r >> 1) & 7)) << 4));
        int r2 = wn * 64 + t * 16 + fr; wb[t] = *(const bf16x8*)(lb + r2 * 128 + ((c ^ ((r2 >> 1) & 7)) << 4));
      }
#pragma unroll
      for (int nt = 0; nt < 4; ++nt)
#pragma unroll
        for (int tt = 0; tt < 4; ++tt) acc[nt][tt] = __builtin_amdgcn_mfma_f32_16x16x32_bf16(wb[nt], xa[tt], acc[nt][tt], 0, 0, 0);
    }
    if (kt + 1 < nk) {
      char* lw = lds + ((kt + 1) & 1) * 49152;
#pragma unroll
      for (int i = 0; i < 4; ++i) { int r = sr + 64 * i; *(uint4*)(lw + r * 128 + ((sc ^ ((r >> 1) & 7)) << 4)) = ra[i]; }
#pragma unroll
      for (int i = 0; i < 2; ++i) { int r = sr + 64 * i; *(uint4*)(lw + 32768 + r * 128 + ((sc ^ ((r >> 1) & 7)) << 4)) = rb[i]; }
    }
    __syncthreads();
  }
#pragma unroll
  for (int nt = 0; nt < 4; ++nt)
#pragma unroll
    for (int tt = 0; tt < 4; ++tt) epi(m0 + wm * 64 + tt * 16 + fr, n0 + wn * 64 + nt * 16 + fq * 4, acc[nt][tt]);
}

struct Epi4StoreBf16 { bf16_t* out; int ld; int pad; __device__ __forceinline__ void operator()(int r, int c, f32x4 v) const {
  uint2 w; w.x = pack2(v[0], v[1]); w.y = pack2(v[2], v[3]); *(uint2*)(out + (size_t)r * ld + c) = w; } };
struct Epi4Resid { const float* x; const float* meta; float* h2; __device__ __forceinline__ void operator()(int r, int c, f32x4 v) const {
  const float* src = hrow_ptr(x, meta, r); float4 hv = src ? *(const float4*)(src + c) : make_float4(0.f, 0.f, 0.f, 0.f);
  *(float4*)(h2 + (size_t)r * D + c) = make_float4(hv.x + v[0], hv.y + v[1], hv.z + v[2], hv.w + v[3]); } };


struct EpiBf16 {
  bf16_t* out; int ld; int use_scale; unsigned* kmax;
  __device__ __forceinline__ void store8(size_t row, int col, const float (&v)[8], float& tmax) const {
    if (kmax && col >= 512 && col < 1024) {
      float ss = 0.f;
#pragma unroll
      for (int i = 0; i < 8; ++i) ss += v[i] * v[i];
      tmax = fmaxf(tmax, sum8(ss));
    }
    uint4 w; w.x = cvtpk(v[0], v[1]); w.y = cvtpk(v[2], v[3]); w.z = cvtpk(v[4], v[5]); w.w = cvtpk(v[6], v[7]);
    *(uint4*)(out + row * ld + col) = w;
  }
  __device__ __forceinline__ void finish(float tmax, size_t row, int col) const {
    if (kmax && col >= 512 && col < 1024) {
      tmax = wave_max(tmax);
      if ((threadIdx.x & 63) == 0) atomicMax(kmax + (row / LP) * 8 + ((col - 512) >> 6), __float_as_uint(tmax));
    }
  }
};
struct EpiResid2 {
  const float* x; const float* meta; float* h2; bf16_t* hb; float* rowss;
  __device__ __forceinline__ void finish(float, size_t, int) const {}
  __device__ __forceinline__ void store8(size_t row, int col, const float (&v)[8], float&) const {
    const float* src = hrow_ptr(x, meta, (int)row);
    const float4 a = *(const float4*)(src + col), b = *(const float4*)(src + col + 4);
    const float o[8] = {a.x + v[0], a.y + v[1], a.z + v[2], a.w + v[3], b.x + v[4], b.y + v[5], b.z + v[6], b.w + v[7]};
    uint4 w; w.x = cvtpk(o[0], o[1]); w.y = cvtpk(o[2], o[3]); w.z = cvtpk(o[4], o[5]); w.w = cvtpk(o[6], o[7]);
    *(uint4*)(hb + row * D + col) = w;
    float ss = 0.f;
#pragma unroll
    for (int i = 0; i < 8; ++i) ss += o[i] * o[i];
    ss = sum8(ss);
    if ((threadIdx.x & 7) == 0) rowss[row * 16 + (col >> 6)] = ss;
  }
};

template <class Epi>
__device__ __forceinline__ void gemm256(char* lds, const bf16_t* __restrict__ X, int ldx, const bf16_t* __restrict__ Wt, int ldw, int K, size_t xrow0, int n0, const Epi& epi) {
  const int tix = opaque_tid();
  const int tid = tix, lane = tid & 63;
  const int wid = __builtin_amdgcn_readfirstlane(tid >> 6);
  const int wm = wid >> 2, wn = wid & 3;
  const int fr = lane & 15, fq = lane >> 4;
  f32x4 acc[4][8];
#pragma unroll
  for (int i = 0; i < 4; ++i)
#pragma unroll
    for (int j = 0; j < 8; ++j) acc[i][j] = (f32x4){0.f, 0.f, 0.f, 0.f};
  const int nk = K >> 6;
  const int prow = lane >> 3, ppos = lane & 7;
  const char* xsrc = (const char*)(X + (xrow0 + 8 * wid + prow) * ldx);
  const char* wsrc = (const char*)(Wt + (size_t)(n0 + 8 * wid + prow) * ldw);
  const unsigned swz = (unsigned)((ppos ^ ((4 * wid + (prow >> 1)) & 7)) << 4);
#define G256_ISSUE(kt, buf) do { \
    _Pragma("unroll") for (int i_ = 0; i_ < 4; ++i_) { \
      __builtin_amdgcn_global_load_lds((const unsigned*)(xsrc + (size_t)(64 * i_) * ldx * 2 + (kt) * 128 + swz), LDSP(unsigned, lds + (buf) * 65536 + (i_ * 8 + wid) * 1024), 16, 0, 0); \
      __builtin_amdgcn_global_load_lds((const unsigned*)(wsrc + (size_t)(64 * i_) * ldw * 2 + (kt) * 128 + swz), LDSP(unsigned, lds + (buf) * 65536 + 32768 + (i_ * 8 + wid) * 1024), 16, 0, 0); \
    } } while (0)
  __syncthreads();
  G256_ISSUE(0, 0);
  asm volatile("s_waitcnt vmcnt(0)" ::: "memory");
  __syncthreads();
  for (int kt = 0; kt < nk; ++kt) {
    if (kt + 1 < nk) G256_ISSUE(kt + 1, (kt + 1) & 1);
    const char* la = lds + (kt & 1) * 65536;
    const char* lb = la + 32768;
#pragma unroll
    for (int kk = 0; kk < 2; ++kk) {
      const int c = kk * 4 + fq;
      bf16x8 xa[8], wb[4];
#pragma unroll
      for (int t = 0; t < 8; ++t) { const int r = wm * 128 + t * 16 + fr; xa[t] = *(const bf16x8*)(la + r * 128 + ((c ^ ((r >> 1) & 7)) << 4)); }
#pragma unroll
      for (int t = 0; t < 4; ++t) { const int r = wn * 64 + t * 16 + fr; wb[t] = *(const bf16x8*)(lb + r * 128 + ((c ^ ((r >> 1) & 7)) << 4)); }
#pragma unroll
      for (int nt = 0; nt < 4; ++nt)
#pragma unroll
        for (int tt = 0; tt < 8; ++tt) acc[nt][tt] = __builtin_amdgcn_mfma_f32_16x16x32_bf16(wb[nt], xa[tt], acc[nt][tt], 0, 0, 0);
    }
    asm volatile("s_waitcnt vmcnt(0)" ::: "memory");
    __syncthreads();
  }
#undef G256_ISSUE
  char* wl = lds + wid * 16384;
  float tmax = 0.f;
#pragma unroll
  for (int hf = 0; hf < 2; ++hf) {
#pragma unroll
    for (int t4 = 0; t4 < 4; ++t4)
#pragma unroll
      for (int nt = 0; nt < 4; ++nt) {
        const int t = t4 * 16 + fr, c16 = nt * 4 + fq;
        *(f32x4*)(wl + t * 256 + ((c16 ^ (t & 15)) << 4)) = acc[nt][hf * 4 + t4];
      }
#pragma unroll
    for (int i = 0; i < 8; ++i) {
      const int t = 8 * i + (lane >> 3), c8 = lane & 7;
      const f32x4 v0 = *(const f32x4*)(wl + t * 256 + (((2 * c8) ^ (t & 15)) << 4)), v1 = *(const f32x4*)(wl + t * 256 + (((2 * c8 + 1) ^ (t & 15)) << 4));
      const float v[8] = {v0[0], v0[1], v0[2], v0[3], v1[0], v1[1], v1[2], v1[3]};
      epi.store8(xrow0 + wm * 128 + hf * 64 + t, n0 + wn * 64 + 8 * c8, v, tmax);
    }
  }
  epi.finish(tmax, xrow0, n0 + wn * 64);
}

__device__ __forceinline__ void meta_proj(char* lds, int blk, const bf16_t* __restrict__ xn1, const bf16_t* __restrict__ wt_in, bf16_t* proj) {
  const int tix = opaque_tid();
  float* red = (float*)lds;
  __syncthreads();
  float part = 0.f;
  const int o = tix % 160, kp = tix / 160;
  if (tix < 480) {
    const int row = o / 10, n = blk * 10 + o % 10;
    const int k0 = kp * 352, k1 = kp == 2 ? 1024 : k0 + 352;
    const bf16_t* xr = xn1 + (size_t)row * D; const bf16_t* wr = wt_in + (size_t)n * D;
    for (int k = k0; k < k1; k += 8) {
      const uint4 a = *(const uint4*)(xr + k), b = *(const uint4*)(wr + k);
      part = dot8(a, b, part);
    }
    red[tix] = part;
  }
  __syncthreads();
  if (tix < 160) {
    const float v = red[tix] + red[tix + 160] + red[tix + 320];
    const int row = tix / 10, n = blk * 10 + tix % 10;
    const bf16_t bv = f2bf(v);
#pragma unroll
    for (int b = 0; b < BATCH; ++b) proj[((size_t)b * LP + row) * INC + n] = bv;
  }
}

__device__ __forceinline__ void p_transpose(int t, float* smem, const float* __restrict__ W, bf16_t* Wt, int K, int N, const float* __restrict__ ksc) {
  const int tix = opaque_tid();
  float (*T)[65] = (float (*)[65])smem;
  const int nbx = N / 64, k0 = (t / nbx) * 64, n0 = (t % nbx) * 64, tid = (tix & 255);
  const int j = tid & 63, i0 = tid >> 6;
#pragma unroll
  for (int ii = 0; ii < 16; ++ii) { int i = i0 + 4 * ii; T[i][j] = W[(size_t)(k0 + i) * N + n0 + j] * (ksc ? ksc[k0 + i] : 1.0f); }
  __syncthreads();
#pragma unroll
  for (int ii = 0; ii < 16; ++ii) { int jj = i0 + 4 * ii; Wt[(size_t)(n0 + jj) * K + k0 + j] = f2bf(T[j][jj]); }
  __syncthreads();
}

__device__ __forceinline__ void grid_bar(unsigned* ctr, unsigned target) {
  asm volatile("s_waitcnt vmcnt(0)" ::: "memory");
  __syncthreads();
  if (threadIdx.x == 0) {
    __builtin_amdgcn_fence(__ATOMIC_RELEASE, "agent");
    asm volatile("s_waitcnt vmcnt(0)" ::: "memory");
    __hip_atomic_fetch_add(ctr, 1u, __ATOMIC_RELAXED, __HIP_MEMORY_SCOPE_AGENT);
    unsigned spins = 0;
    while (__hip_atomic_load(ctr, __ATOMIC_RELAXED, __HIP_MEMORY_SCOPE_AGENT) < target) { __builtin_amdgcn_s_sleep(2); if (++spins > (1u << 24)) break; }
    __builtin_amdgcn_fence(__ATOMIC_ACQUIRE, "agent");
    asm volatile("s_waitcnt vmcnt(0)" ::: "memory");
  }
  __syncthreads();
}

struct Params {
  const float *x, *meta, *g1, *w_in, *lq1, *lk1, *lq2, *lk2, *subg, *conv_w, *conv_b, *gn_g, *gn_b, *w_out, *g2, *wq, *sk, *ut, *vt, *fg;
  float* out; float* scal; bf16_t* r1; bf16_t* r2; float* h2; int* eb; float* gb; bf16_t* wt_in; bf16_t* wt_out; bf16_t* wt_q; bf16_t* skb; unsigned char* ut8; unsigned char* vt8; float* uinv; float* vinv; float* wbuf; float* ssq; bf16_t* hb; float* rowss;
};

__global__ void __launch_bounds__(512, 2) mega(Params p) {
  cg::grid_group grid = cg::this_grid();
  __shared__ __attribute__((aligned(16))) char smem_c[131072 + 256];
  float* smem = (float*)smem_c;
  const int G = gridDim.x, vh = threadIdx.x >> 8;
  unsigned* ctr = (unsigned*)(p.scal + 64);
  unsigned nbar = 0;
  bf16_t* xn1 = p.r1; bf16_t* mix = p.r1; bf16_t* proj = p.r2; bf16_t* qp = p.r2;
  p_norm1_rows(G, p.x, p.meta, p.g1, xn1);
  if (blockIdx.x == 0 && threadIdx.x < 64) {
    const int t = threadIdx.x;
    const float a = wave_sum(p.lq1[t] * p.lk1[t]), b2 = wave_sum(p.lq2[t] * p.lk2[t]);
    if (t == 0) p.scal[0] = expf(a) - expf(b2) + LAM_INIT;
  }
  for (int b = blockIdx.x; b < (640 + 256 + 512) / 2; b += G) {
    const int bb = b * 2 + vh; float* sm = smem + vh * (64 * 65);
    if (bb < 640) p_transpose(bb, sm, p.w_in, p.wt_in, D, INC, nullptr);
    else if (bb < 896) p_transpose(bb - 640, sm, p.w_out, p.wt_out, D, D, nullptr);
    else p_transpose(bb - 896, sm, p.wq, p.wt_q, D, 2048, p.g2);
  }
  p_cvt_bf16(blockIdx.x, G, p.sk, p.skb, (size_t)16 * 128 * 128 / 8);
  p_cvt_fp8_rows(blockIdx.x, G, p.ut, (unsigned*)p.ut8, p.uinv, p.g2);
  p_cvt_fp8_rows(blockIdx.x, G, p.vt, (unsigned*)p.vt8, p.vinv, nullptr);
  grid.sync();
  for (int b = blockIdx.x; b < 128 * 10; b += G) {
    const int xi = (b >> 3), mt = (b & 7) * 16 + xi / 10, nt = xi % 10;
    gemm256(smem_c, xn1, D, p.wt_in, D, D, (size_t)(mt >> 4) * LP + NMETA + 256 * (mt & 15), nt * 256, EpiBf16{proj, INC, 0, (unsigned*)(p.scal + 640)});
  }
  for (int b = blockIdx.x; b < 256; b += G) meta_proj(smem_c, b, xn1, p.wt_in, proj);
  for (int i = blockIdx.x * 512 + threadIdx.x; i < BATCH * (LP - LREAL) * 128; i += G * 512) {
    const int c = i & 127, r = i >> 7, b = r / (LP - LREAL), pos = LREAL + r - b * (LP - LREAL);
    *(uint4*)(proj + ((size_t)b * LP + pos) * INC + 512 + 8 * c) = make_uint4(0, 0, 0, 0);
  }
  grid_bar(ctr, (unsigned)G * ++nbar);
  {
    const float lam = p.scal[0];
    for (int u = blockIdx.x; u < 256; u += G) {
      const int bh = (u & 7) * 4 + (u >> 6), tp = (u >> 3) & 7;
#pragma unroll 1
      for (int k = 0; k < 4; ++k) {
        const int t = (k == 0) ? 31 - tp : (k == 1) ? 16 + tp : (k == 2) ? 15 - tp : tp;
        attn_unit(smem_c, proj, mix, p.subg, (const unsigned*)(p.scal + 640), lam, bh >> 2, bh & 3, t);
      }
    }
  }
  for (int u = blockIdx.x; u < BATCH * 128; u += G) conv_unit(smem_c, proj, mix, p.conv_w, p.conv_b, p.gn_g, p.gn_b, u >> 7, NMETA + 32 * (u & 127));
  grid_bar(ctr, (unsigned)G * ++nbar);
  for (int b = blockIdx.x; b < 128 * 4; b += G) {
    const int xi = (b >> 3), mt = (b & 7) * 16 + (xi >> 2), nt = xi & 3;
    gemm256(smem_c, mix, D, p.wt_out, D, D, (size_t)(mt >> 4) * LP + NMETA + 256 * (mt & 15), nt * 256, EpiResid2{p.x, p.meta, p.h2, p.hb, p.rowss});
  }
  grid_bar(ctr, (unsigned)G * ++nbar);
  for (int b = blockIdx.x; b < 128 * 8; b += G) {
    const int xi = (b >> 3), mt = (b & 7) * 16 + (xi >> 3), nt = xi & 7;
    gemm256(smem_c, p.hb, D, p.wt_q, D, D, (size_t)(mt >> 4) * LP + NMETA + 256 * (mt & 15), nt * 256, EpiBf16{qp, 2048, 0, nullptr});
  }
  grid_bar(ctr, (unsigned)G * ++nbar);
  for (int u = blockIdx.x; u < 256 * 8; u += G) {
    const int rt = u >> 3, h = u & 7;
    peer_topk_unit(smem_c, qp, p.skb, p.rowss, p.eb, p.gb, (rt >> 5) * LP + NMETA + 128 * (rt & 31), h);
  }
  grid_bar(ctr, (unsigned)G * ++nbar);
  {
    const int tix = opaque_tid();
    const int lane = tix & 63;
    const int NTOK = BATCH * SEQ;
    float* partial = (float*)qp;
    unsigned* qh = (unsigned*)(p.scal + 128);
    const unsigned x = xcc_id();
    for (int qi = 0; qi < 8; ++qi) {
      const int s = (int)((x + qi) & 7u);
      for (;;) {
        unsigned st = 0;
        if (lane == 0) st = __hip_atomic_fetch_add(qh + s * 16, 16u, __ATOMIC_RELAXED, __HIP_MEMORY_SCOPE_AGENT);
        st = __builtin_amdgcn_readfirstlane(st);
        if (st >= (unsigned)NTOK) break;
        ds_u_chunk(smem_c + (tix >> 6) * 16384, lane, (int)st, s, p.hb, p.eb, p.ut8, partial);
      }
    }
    grid_bar(ctr, (unsigned)G * ++nbar);
    for (size_t i = (size_t)blockIdx.x * 512 + tix; i < (size_t)NTOK * 128; i += (size_t)G * 512) {
      const int tk = (int)(i >> 7), k = (int)(i & 127);
      const int b = tk / SEQ, sq = tk - b * SEQ;
      const size_t row = (size_t)b * LP + NMETA + sq;
      float a = 0.f;
#pragma unroll
      for (int sl = 0; sl < 8; ++sl) a += partial[((size_t)tk * 8 + sl) * 128 + k];
      const int e = p.eb[row * 128 + k];
      a *= p.uinv[e] * row_rstd(p.rowss, row);
      p.wbuf[i] = p.gb[row * 128 + k] * 0.5f * a * (1.0f + erff(a * 0.70710678118654752f)) * p.vinv[e];
    }
    grid_bar(ctr, (unsigned)G * ++nbar);
    for (int qi = 0; qi < 8; ++qi) {
      const int s = (int)((x + qi) & 7u);
      for (;;) {
        unsigned st = 0;
        if (lane == 0) st = __hip_atomic_fetch_add(qh + (8 + s) * 16, 16u, __ATOMIC_RELAXED, __HIP_MEMORY_SCOPE_AGENT);
        st = __builtin_amdgcn_readfirstlane(st);
        if (st >= (unsigned)NTOK) break;
        ds_v_chunk(smem_c + (tix >> 6) * 16384, lane, (int)st, s, p.hb, p.eb, p.wbuf, p.vt8, p.h2, p.ssq);
      }
    }
    grid_bar(ctr, (unsigned)G * ++nbar);
    {
      const int wv = blockIdx.x * 8 + (tix >> 6);
      for (int tk = wv * 2; tk < NTOK; tk += G * 16) {
        float4 o[2][4]; float sv[2];
#pragma unroll
        for (int r = 0; r < 2; ++r) {
#pragma unroll
          for (int q = 0; q < 4; ++q) o[r][q] = ((const float4*)p.h2)[(size_t)(tk + r) * 256 + q * 64 + lane];
          sv[r] = lane < 8 ? p.ssq[(size_t)(tk + r) * 8 + lane] : 0.f;
        }
#pragma unroll
        for (int r = 0; r < 2; ++r) {
          const float rstd = rsqrtf(wave_sum(sv[r]) * (1.0f / D) + EPS);
#pragma unroll
          for (int q = 0; q < 4; ++q) {
            const float4 f = ((const float4*)p.fg)[q * 64 + lane];
            float4 v = o[r][q];
            v.x *= rstd * f.x; v.y *= rstd * f.y; v.z *= rstd * f.z; v.w *= rstd * f.w;
            ((float4*)p.out)[(size_t)(tk + r) * 256 + q * 64 + lane] = v;
          }
        }
      }
    }
  }
}

extern "C" void kernel_launch(void* const* d_in, const int* in_sizes, int n_in, void* d_out, int out_size, void* d_ws, size_t ws_size, hipStream_t stream) {
  static int grid_blocks = 0;
  if (!grid_blocks) {
    int dev = 0, cus = 0, per_cu = 0;
    hipGetDevice(&dev);
    hipDeviceGetAttribute(&cus, hipDeviceAttributeMultiprocessorCount, dev);
    hipOccupancyMaxActiveBlocksPerMultiprocessor(&per_cu, mega, 512, 0);
    if (per_cu > 1) per_cu = 1;
    if (per_cu < 1) per_cu = 1;
    grid_blocks = cus * per_cu;
  }
  Params p{};
  const float** pp = (const float**)&p;
  for (int i = 0; i < 20; ++i) pp[i] = (const float*)d_in[i];
  p.out = (float*)d_out;
  char* ws = (char*)d_ws;
  size_t off = 0;
  p.scal = (float*)(ws + off); off += 4096;
  p.r1 = (bf16_t*)(ws + off); off += (size_t)ROWS * D * 2;
  p.r2 = (bf16_t*)(ws + off); off += (size_t)ROWS * INC * 2;
  p.h2 = (float*)(ws + off); off += (size_t)ROWS * D * 4;
  p.wt_in = (bf16_t*)(ws + off); off += (size_t)INC * D * 2;
  p.wt_out = (bf16_t*)(ws + off); off += (size_t)D * D * 2;
  p.wt_q = (bf16_t*)(ws + off); off += (size_t)2048 * D * 2;
  p.skb = (bf16_t*)(ws + off); off += (size_t)16 * 128 * 128 * 2;
  p.ut8 = (unsigned char*)(ws + off); off += (size_t)16384 * D;
  p.vt8 = (unsigned char*)(ws + off); off += (size_t)16384 * D;
  p.uinv = (float*)(ws + off); off += 65536;
  p.vinv = (float*)(ws + off); off += 65536;
  p.wbuf = (float*)(ws + off); off += (size_t)BATCH * SEQ * 128 * 4;
  p.ssq = (float*)(ws + off); off += (size_t)BATCH * SEQ * 8 * 4;
  p.hb = (bf16_t*)(ws + off); off += (size_t)ROWS * D * 2;
  p.rowss = (float*)(ws + off); off += (size_t)ROWS * 16 * 4;
  p.eb = (int*)((char*)p.r2 + (size_t)ROWS * 2048 * 2);
  p.gb = (float*)((char*)p.eb + (size_t)ROWS * 128 * 4);
  hipMemsetAsync(d_ws, 0, 4096, stream);
  void* args[] = {&p};
  hipError_t e = hipLaunchCooperativeKernel((void*)mega, dim3(grid_blocks), dim3(512), args, 0, stream);
  if (e != hipSuccess) fprintf(stderr, "cooperative launch failed: %s (grid %d)\n", hipGetErrorString(e), grid_blocks);
}
```

```cpp
#include <hip/hip_runtime.h>
#include <hip/hip_cooperative_groups.h>
#include <cstdio>
namespace cg = cooperative_groups;
#include <stdint.h>
#include <math.h>

typedef unsigned short bf16_t;
typedef short bf16x8 __attribute__((ext_vector_type(8)));
typedef float f32x4 __attribute__((ext_vector_type(4)));

constexpr int D = 1024, BATCH = 8, SEQ = 4096, NMETA = 16, LREAL = NMETA + SEQ  , LP = 4224, ROWS = BATCH * LP;
constexpr int INC = 2560;
constexpr float EPS = 1e-6f;
constexpr float LAM_INIT = 0.2f;

__device__ __forceinline__ float bf2f(unsigned v) { return __uint_as_float(v << 16); }
__device__ __forceinline__ bf16_t f2bf(float f) { unsigned u = __float_as_uint(f); u += 0x7fffu + ((u >> 16) & 1u); return (bf16_t)(u >> 16); }
__device__ __forceinline__ unsigned pack2(float a, float b) { return (unsigned)f2bf(a) | ((unsigned)f2bf(b) << 16); }

__device__ __forceinline__ float wave_sum(float v) {
#pragma unroll
  for (int o = 32; o >= 1; o >>= 1) v += __shfl_xor(v, o);
  return v;
}
__device__ __forceinline__ float wave_max(float v) {
#pragma unroll
  for (int o = 32; o >= 1; o >>= 1) v = fmaxf(v, __shfl_xor(v, o));
  return v;
}

template <int CTRL> __device__ __forceinline__ float dpp_add(float v) { return v + __builtin_bit_cast(float, __builtin_amdgcn_update_dpp(0, __builtin_bit_cast(int, v), CTRL, 0xf, 0xf, true)); }
__device__ __forceinline__ float sum8(float v) { v = dpp_add<0x141>(v); v = dpp_add<0xB1>(v); v = dpp_add<0x4E>(v); return v; }
typedef __bf16 bf16v2 __attribute__((ext_vector_type(2)));
__device__ __forceinline__ float dot8(uint4 a, uint4 b, float acc) {
  acc = __builtin_amdgcn_fdot2_f32_bf16(__builtin_bit_cast(bf16v2, a.x), __builtin_bit_cast(bf16v2, b.x), acc, false);
  acc = __builtin_amdgcn_fdot2_f32_bf16(__builtin_bit_cast(bf16v2, a.y), __builtin_bit_cast(bf16v2, b.y), acc, false);
  acc = __builtin_amdgcn_fdot2_f32_bf16(__builtin_bit_cast(bf16v2, a.z), __builtin_bit_cast(bf16v2, b.z), acc, false);
  acc = __builtin_amdgcn_fdot2_f32_bf16(__builtin_bit_cast(bf16v2, a.w), __builtin_bit_cast(bf16v2, b.w), acc, false);
  return acc;
}
__device__ __forceinline__ float row_rstd(const float* __restrict__ rowss, size_t row) {
  const float4 a = *(const float4*)(rowss + row * 16), b = *(const float4*)(rowss + row * 16 + 4), c = *(const float4*)(rowss + row * 16 + 8), d = *(const float4*)(rowss + row * 16 + 12);
  const float t = ((a.x + a.y) + (a.z + a.w)) + ((b.x + b.y) + (b.z + b.w)) + ((c.x + c.y) + (c.z + c.w)) + ((d.x + d.y) + (d.z + d.w));
  return rsqrtf(t * (1.0f / D) + EPS);
}
__device__ __forceinline__ float row16_sum(float v) {
  v += __builtin_bit_cast(float, __builtin_amdgcn_update_dpp(0, __builtin_bit_cast(int, v), 0x128, 0xf, 0xf, true));
  v += __builtin_bit_cast(float, __builtin_amdgcn_update_dpp(0, __builtin_bit_cast(int, v), 0x124, 0xf, 0xf, true));
  v += __builtin_bit_cast(float, __builtin_amdgcn_update_dpp(0, __builtin_bit_cast(int, v), 0x122, 0xf, 0xf, true));
  v += __builtin_bit_cast(float, __builtin_amdgcn_update_dpp(0, __builtin_bit_cast(int, v), 0x121, 0xf, 0xf, true));
  return v;
}
__device__ __forceinline__ int opaque_tid() { int t = threadIdx.x; asm volatile("" : "+v"(t)); return t; }

__device__ __forceinline__ const float* hrow_ptr(const float* x, const float* meta, int row) {
  int b = row / LP, pos = row - b * LP;
  if (pos < NMETA) return meta + (size_t)pos * D;
  if (pos < LREAL) return x + ((size_t)b * SEQ + (pos - NMETA)) * D;
  return nullptr;
}


typedef float f32x16 __attribute__((ext_vector_type(16)));
typedef short v4i16_t __attribute__((ext_vector_type(4)));
typedef __bf16 bf16v2_t __attribute__((ext_vector_type(2)));
typedef float f32x2_t __attribute__((ext_vector_type(2)));
#define LDSP(T, p) ((__attribute__((address_space(3))) T*)(p))
#define MFMA32(a, b, c) __builtin_amdgcn_mfma_f32_32x32x16_bf16((a), (b), (c), 0, 0, 0)
__device__ __forceinline__ unsigned cvtpk(float lo, float hi) { f32x2_t v = {lo, hi}; return __builtin_bit_cast(unsigned, __builtin_convertvector(v, bf16v2_t)); }
__device__ __forceinline__ float half_swap_max(float m) { auto rr = __builtin_amdgcn_permlane32_swap(__float_as_uint(m), __float_as_uint(m), false, false); return fmaxf(__uint_as_float(rr[0]), __uint_as_float(rr[1])); }
__device__ __forceinline__ float half_swap_sum(float m) { auto rr = __builtin_amdgcn_permlane32_swap(__float_as_uint(m), __float_as_uint(m), false, false); return __uint_as_float(rr[0]) + __uint_as_float(rr[1]); }

__device__ __forceinline__ void attn_issue_kv(char* kvbuf, const bf16_t* __restrict__ kvrow0  , int tid, int wid) {
  const char* base = (const char*)kvrow0;
#pragma unroll
  for (int i = 0; i < 2; ++i) {
    const int g = i * 512 + tid, row = g >> 4, pos = g & 15;
    const unsigned offk = (unsigned)(row * (INC * 2) + 1024 + ((pos ^ (row & 15)) << 4));
    const unsigned offv = (unsigned)(row * (INC * 2) + 2048 + ((pos ^ ((row & 3) << 2)) << 4));
    __builtin_amdgcn_global_load_lds((const unsigned*)(base + offk), LDSP(unsigned, kvbuf + (i * 512 + wid * 64) * 16), 16, 0, 0);
    __builtin_amdgcn_global_load_lds((const unsigned*)(base + offv), LDSP(unsigned, kvbuf + 16384 + (i * 512 + wid * 64) * 16), 16, 0, 0);
  }
}

template <bool MASKED, bool MAXONLY>
__device__ __forceinline__ void attn_qk(uint4 (&pw)[4], float& mref, const char* qbase, int qsw, const char* kb, int c, int kq, float sl8, int lane, int r32, int hi,
                                         const bf16x8& augk0, const bf16x8& augk1, const bf16x8& augq) {
  const float c1 = 0.125f * 1.4426950408889634f;
  asm volatile("" : "+v"(qsw), "+v"(lane));
  f32x16 s0, s1;
  float soff;
  if (MASKED) {
    const float a1 = sl8, a2 = 2.0f * sl8, a3 = 3.0f * sl8, b8 = 8.0f * sl8;
    float gb = sl8 * (float)kq;
#pragma unroll
    for (int g = 0; g < 4; ++g) { s0[4 * g] = gb; s0[4 * g + 1] = gb + a1; s0[4 * g + 2] = gb + a2; s0[4 * g + 3] = gb + a3; gb += b8; }
#pragma unroll
    for (int g = 0; g < 4; ++g) { s1[4 * g] = gb; s1[4 * g + 1] = gb + a1; s1[4 * g + 2] = gb + a2; s1[4 * g + 3] = gb + a3; gb += b8; }
#pragma unroll
    for (int r = 0; r < 16; ++r) { s0[r] = s0[r] > 0.f ? -1e30f : s0[r]; s1[r] = s1[r] > 0.f ? -1e30f : s1[r]; }
    soff = 0.f;
  } else {
#pragma unroll
    for (int r = 0; r < 16; ++r) { s0[r] = 0.f; s1[r] = 0.f; }
    s0 = MFMA32(augk0, augq, s0);
    s1 = MFMA32(augk1, augq, s1);
    soff = sl8 * (float)(kq - 4 * hi);
  }
#pragma unroll
  for (int ks = 0; ks < 4; ++ks) {
    const int ch = c * 8 + ks * 2 + hi;
    bf16x8 bq = *(const bf16x8*)(qbase + ((ch ^ qsw) << 4));
    bf16x8 ka0 = *(const bf16x8*)(kb + r32 * 256 + ((ch ^ qsw) << 4));
    bf16x8 ka1 = *(const bf16x8*)(kb + (32 + r32) * 256 + ((ch ^ qsw) << 4));
    s0 = MFMA32(ka0, bq, s0);
    s1 = MFMA32(ka1, bq, s1);
    __builtin_amdgcn_sched_barrier(0);
  }
  if (MAXONLY) {
    float m0 = fmaxf(s0[0], s1[0]), m1 = fmaxf(s0[1], s1[1]), m2 = fmaxf(s0[2], s1[2]), m3 = fmaxf(s0[3], s1[3]);
#pragma unroll
    for (int r = 4; r < 16; r += 4) {
      m0 = fmaxf(fmaxf(m0, s0[r]), s1[r]); m1 = fmaxf(fmaxf(m1, s0[r + 1]), s1[r + 1]); m2 = fmaxf(fmaxf(m2, s0[r + 2]), s1[r + 2]); m3 = fmaxf(fmaxf(m3, s0[r + 3]), s1[r + 3]);
    }
    mref = fmaxf(mref, half_swap_max(fmaxf(fmaxf(m0, m1), fmaxf(m2, m3))) + soff);
    return;
  }
  const f32x2_t c1v = {c1, c1}, nmv = {(soff - mref) * c1, (soff - mref) * c1};
#pragma unroll
  for (int r = 0; r < 16; r += 2) {
    f32x2_t x0 = {s0[r], s0[r + 1]}, x1 = {s1[r], s1[r + 1]};
    x0 = __builtin_elementwise_fma(x0, c1v, nmv); x1 = __builtin_elementwise_fma(x1, c1v, nmv);
    x0.x = __builtin_amdgcn_exp2f(x0.x); x0.y = __builtin_amdgcn_exp2f(x0.y); x1.x = __builtin_amdgcn_exp2f(x1.x); x1.y = __builtin_amdgcn_exp2f(x1.y);
    s0[r] = x0.x; s0[r + 1] = x0.y; s1[r] = x1.x; s1[r + 1] = x1.y;
  }
#pragma unroll
  for (int kk = 0; kk < 2; ++kk) {
    pw[kk] = make_uint4(cvtpk(s0[8 * kk], s0[8 * kk + 1]), cvtpk(s0[8 * kk + 2], s0[8 * kk + 3]), cvtpk(s0[8 * kk + 4], s0[8 * kk + 5]), cvtpk(s0[8 * kk + 6], s0[8 * kk + 7]));
    pw[2 + kk] = make_uint4(cvtpk(s1[8 * kk], s1[8 * kk + 1]), cvtpk(s1[8 * kk + 2], s1[8 * kk + 3]), cvtpk(s1[8 * kk + 4], s1[8 * kk + 5]), cvtpk(s1[8 * kk + 6], s1[8 * kk + 7]));
  }
}

__device__ __forceinline__ void attn_pv(f32x16 (&o)[4], f32x16& osum, const uint4 (&pw)[4], const char* vb, int lane, int hi) {
  asm volatile("" : "+v"(lane));
  const int q4 = (lane & 15) >> 2, g1 = (lane >> 4) & 1, p4 = lane & 3;
#pragma unroll
  for (int kk = 0; kk < 4; ++kk) {
    const int key0 = 16 * kk + 4 * hi + q4;
    const bf16x8 pb = __builtin_bit_cast(bf16x8, pw[kk]);
    osum = MFMA32(__builtin_bit_cast(bf16x8, make_uint4(0x3F803F80u, 0x3F803F80u, 0x3F803F80u, 0x3F803F80u)), pb, osum);
#pragma unroll
    for (int dvt = 0; dvt < 4; ++dvt) {
      const int c8 = 8 * (dvt ^ q4) + 4 * g1 + p4;
      v4i16_t lo = __builtin_amdgcn_ds_read_tr16_b64_v4i16(LDSP(v4i16_t, vb + key0 * 256 + c8 * 8));
      v4i16_t hi4 = __builtin_amdgcn_ds_read_tr16_b64_v4i16(LDSP(v4i16_t, vb + (key0 + 8) * 256 + c8 * 8));
      bf16x8 va = (bf16x8){lo[0], lo[1], lo[2], lo[3], hi4[0], hi4[1], hi4[2], hi4[3]};
      o[dvt] = MFMA32(va, pb, o[dvt]);
    }
    __builtin_amdgcn_sched_barrier(0);
  }
}

__device__ __forceinline__ void attn_unit(char* lds, const bf16_t* __restrict__ proj, bf16_t* mix, const float* __restrict__ subg, const unsigned* __restrict__ kmax, float lam, int b, int h, int t) {
  const int tix = opaque_tid();
  const int tid = tix, lane = tid & 63, r32 = lane & 31, hi = lane >> 5;
  const int wid = __builtin_amdgcn_readfirstlane(tid >> 6);
  const int c = wid >> 2, qg = wid & 3;
  const int q0 = NMETA + 128 * t, qw0 = q0 + 32 * qg, qpos = qw0 + r32;
  const size_t rowb = (size_t)b * LP;
  const int NT = 2 * t + 3;
  char* Qs = lds;
  char* KV = lds + 32768;
  const float sl8 = exp2f(1.0f - 2.0f * (float)h);
  __syncthreads();
  attn_issue_kv(KV, proj + rowb * INC + h * 128, tid, wid);
#pragma unroll
  for (int i = 0; i < 4; ++i) {
    const int g = i * 512 + tid, row = g >> 4, pos = g & 15;
    uint4 v = *(const uint4*)(proj + (rowb + q0 + row) * INC + h * 128 + ((pos ^ (row & 15)) << 3));
    *(uint4*)(Qs + g * 16) = v;
  }
  f32x16 o[4];
#pragma unroll
  for (int i = 0; i < 4; ++i)
#pragma unroll
    for (int r = 0; r < 16; ++r) o[i][r] = 0.f;
  f32x16 osum;
#pragma unroll
  for (int r = 0; r < 16; ++r) osum[r] = 0.f;
  bf16x8 augk0, augk1, augq;
  {
    const unsigned k0w = hi == 0 ? cvtpk((float)r32, 0.f) : 0u, k1w = hi == 0 ? cvtpk((float)(32 + r32), 0.f) : 0u, qw = hi == 0 ? cvtpk(sl8, 0.f) : 0u;
    augk0 = __builtin_bit_cast(bf16x8, make_uint4(k0w, 0u, 0u, 0u)); augk1 = __builtin_bit_cast(bf16x8, make_uint4(k1w, 0u, 0u, 0u)); augq = __builtin_bit_cast(bf16x8, make_uint4(qw, 0u, 0u, 0u));
  }
  const int qrow = 32 * qg + r32;
  const char* qbase = Qs + qrow * 256;
  const int qsw = qrow & 15;
  float mref; bool loose;
  int* lflag = (int*)(lds + 131072);
  {
    float kn2 = 0.f;
    if (lane < 16) {
      const uint4* kp = (const uint4*)(proj + (rowb + lane) * INC + 512 + h * 128 + c * 64);
#pragma unroll
      for (int i = 0; i < 8; ++i) { const uint4 w = kp[i]; kn2 = dot8(w, w, kn2); }
    }
    kn2 = fmaxf(wave_max(kn2), __uint_as_float(kmax[b * 8 + h * 2 + c]));
    if (tid == 0) *lflag = 0;
    __syncthreads();
    float qn2 = 0.f;
#pragma unroll
    for (int ks = 0; ks < 4; ++ks) { const uint4 w = *(const uint4*)(qbase + (((c * 8 + ks * 2 + hi) ^ qsw) << 4)); qn2 = dot8(w, w, qn2); }
    qn2 = half_swap_sum(qn2);
    const float bound = sqrtf(qn2 * kn2) * 1.02f;
    mref = bound - 60.0f / (0.125f * 1.4426950408889634f);
    float sd = 0.f;
#pragma unroll
    for (int ks = 0; ks < 4; ++ks) {
      const uint4 wq = *(const uint4*)(qbase + (((c * 8 + ks * 2 + hi) ^ qsw) << 4));
      const uint4 wk = *(const uint4*)(proj + (rowb + qpos) * INC + 512 + h * 128 + (c * 8 + ks * 2 + hi) * 8);
      sd = dot8(wq, wk, sd);
    }
    sd = half_swap_sum(sd);
    loose = (bound - sd) * (0.125f * 1.4426950408889634f) > 170.0f;
  }
  uint4 pw[4];
  if (__any(loose) && lane == 0) *lflag = 1;
  __syncthreads();
  if (*lflag) {
    float mx = -1e30f; int sl = 0;
    for (int j = 0; j < NT; ++j) {
      asm volatile("s_waitcnt vmcnt(0)" ::: "memory");
      __syncthreads();
      if (j + 1 < NT) attn_issue_kv(KV + (sl == 2 ? 0 : sl + 1) * 32768, proj + (rowb + 64 * (j + 1)) * INC + h * 128, tid, wid);
      if (64 * j <= qw0 + 31) {
        const int kq = 64 * j + 4 * hi - qpos;
        if (64 * j + 63 > qw0) attn_qk<true, true>(pw, mx, qbase, qsw, KV + sl * 32768, c, kq, sl8, lane, r32, hi, augk0, augk1, augq);
        else attn_qk<false, true>(pw, mx, qbase, qsw, KV + sl * 32768, c, kq, sl8, lane, r32, hi, augk0, augk1, augq);
      }
      sl = (sl == 2 ? 0 : sl + 1);
    }
    mref = mx;
    __syncthreads();
    attn_issue_kv(KV, proj + rowb * INC + h * 128, tid, wid);
  }
  bool have = false;
  int slot = 0, pslot = 0;
  for (int j = 0; j <= NT; ++j) {
    if (j < NT) {
      asm volatile("s_waitcnt vmcnt(0)" ::: "memory");
      __syncthreads();
      if (j + 1 < NT) attn_issue_kv(KV + (slot == 2 ? 0 : slot + 1) * 32768, proj + (rowb + 64 * (j + 1)) * INC + h * 128, tid, wid);
    }
    if (have) { attn_pv(o, osum, pw, KV + pslot * 32768 + 16384, lane, hi); have = false; }
    if (j < NT && 64 * j <= qw0 + 31) {
      const char* kb = KV + slot * 32768;
      const int kq = 64 * j + 4 * hi - qpos;
      if (64 * j + 63 > qw0) attn_qk<true, false>(pw, mref, qbase, qsw, kb, c, kq, sl8, lane, r32, hi, augk0, augk1, augq);
      else attn_qk<false, false>(pw, mref, qbase, qsw, kb, c, kq, sl8, lane, r32, hi, augk0, augk1, augq);
      if (c == 0) attn_pv(o, osum, pw, kb + 16384, lane, hi); else have = true;
    }
    pslot = slot; slot = (slot == 2 ? 0 : slot + 1);
  }
  const float sc = (c == 0 ? 1.0f : lam) / osum[0];
  __syncthreads();
  float* X = (float*)(lds + 32768);
  if (c == 1) {
#pragma unroll
    for (int i = 0; i < 4; ++i)
#pragma unroll
      for (int r = 0; r < 16; ++r) X[(qg * 64 + i * 16 + r) * 64 + lane] = o[i][r] * sc;
  }
  __syncthreads();
  if (c == 0) {
    float ss = 0.f;
#pragma unroll
    for (int i = 0; i < 4; ++i) {
#pragma unroll
      for (int r = 0; r < 16; ++r) { float v = o[i][r] * sc - X[(qg * 64 + i * 16 + r) * 64 + lane]; o[i][r] = v; ss += v * v; }
      __builtin_amdgcn_sched_barrier(0);
    }
    ss = half_swap_sum(ss);
    const float rstd = rsqrtf(ss * (1.0f / 128.0f) + EPS) * (1.0f - LAM_INIT);
    bf16_t* orow = mix + (rowb + qpos) * D + h * 128;
#pragma unroll
    for (int i = 0; i < 4; ++i) {
#pragma unroll
      for (int g = 0; g < 4; ++g) {
        const int dv0 = 32 * i + 8 * g + 4 * hi;
        const float4 sg = *(const float4*)(subg + dv0);
        uint2 w; w.x = cvtpk(o[i][4 * g] * rstd * sg.x, o[i][4 * g + 1] * rstd * sg.y); w.y = cvtpk(o[i][4 * g + 2] * rstd * sg.z, o[i][4 * g + 3] * rstd * sg.w);
        *(uint2*)(orow + dv0) = w;
      }
      __builtin_amdgcn_sched_barrier(0);
    }
  }
}


__device__ __forceinline__ void p_norm1_rows(int G, const float* __restrict__ x, const float* __restrict__ meta, const float* __restrict__ g1, bf16_t* xn1) {
  const int tix = opaque_tid();
  const int lane = tix & 63, wv = blockIdx.x * 8 + (tix >> 6);
  float4 g[4];
#pragma unroll
  for (int q = 0; q < 4; ++q) g[q] = ((const float4*)g1)[q * 64 + lane];
  for (int row = wv * 2; row < ROWS; row += G * 16) {
    float4 v[2][4];
#pragma unroll
    for (int r = 0; r < 2; ++r) {
      const float* src = hrow_ptr(x, meta, row + r);
#pragma unroll
      for (int q = 0; q < 4; ++q) v[r][q] = src ? ((const float4*)src)[q * 64 + lane] : make_float4(0.f, 0.f, 0.f, 0.f);
    }
#pragma unroll
    for (int r = 0; r < 2; ++r) {
      float ss = 0.f;
#pragma unroll
      for (int q = 0; q < 4; ++q) ss += (v[r][q].x * v[r][q].x + v[r][q].y * v[r][q].y) + (v[r][q].z * v[r][q].z + v[r][q].w * v[r][q].w);
      const float rstd = rsqrtf(wave_sum(ss) * (1.0f / D) + EPS);
#pragma unroll
      for (int q = 0; q < 4; ++q) {
        uint2 o; o.x = cvtpk(v[r][q].x * rstd * g[q].x, v[r][q].y * rstd * g[q].y); o.y = cvtpk(v[r][q].z * rstd * g[q].z, v[r][q].w * rstd * g[q].w);
        ((uint2*)(xn1 + (size_t)(row + r) * D))[q * 64 + lane] = o;
      }
    }
  }
}

__device__ __forceinline__ void conv_unit(char* lds, const bf16_t* __restrict__ proj, bf16_t* mix, const float* __restrict__ cw, const float* __restrict__ cb,
                                          const float* __restrict__ gng, const float* __restrict__ gnb, int b, int pos0) {
  const int tix = opaque_tid();
  const int c = tix;
  float* U = (float*)lds;
  __syncthreads();
  {
    const int lane = tix & 63, wv = tix >> 6;
    uint4 ra[8], rg[8];
#pragma unroll
    for (int i = 0; i < 8; ++i) {
      const int r = wv + 8 * i, pos = pos0 - 30 + r;
      ra[i] = make_uint4(0, 0, 0, 0); rg[i] = make_uint4(0, 0, 0, 0);
      if (r < 62 && pos >= 0) {
        const bf16_t* pr = proj + ((size_t)b * LP + pos) * INC + 8 * lane;
        ra[i] = *(const uint4*)(pr + 1536); rg[i] = *(const uint4*)(pr + 2048);
      }
    }
#pragma unroll
    for (int i = 0; i < 8; ++i) {
      const int r = wv + 8 * i;
      if (r < 62) {
        const unsigned av[4] = {ra[i].x, ra[i].y, ra[i].z, ra[i].w}, gv[4] = {rg[i].x, rg[i].y, rg[i].z, rg[i].w};
        float u[8];
#pragma unroll
        for (int q = 0; q < 4; ++q) {
          const float a0 = __uint_as_float(av[q] << 16), a1 = __uint_as_float(av[q] & 0xffff0000u), g0 = __uint_as_float(gv[q] << 16), g1 = __uint_as_float(gv[q] & 0xffff0000u);
          u[2 * q] = a0 / (1.0f + __expf(-g0)); u[2 * q + 1] = a1 / (1.0f + __expf(-g1));
        }
        *(float4*)(U + r * 512 + 8 * lane) = make_float4(u[0], u[1], u[2], u[3]);
        *(float4*)(U + r * 512 + 8 * lane + 4) = make_float4(u[4], u[5], u[6], u[7]);
      }
    }
  }
  float w[31];
#pragma unroll
  for (int j = 0; j < 31; ++j) w[j] = cw[j * 512 + c];
  const float bias = cb[c], gg = gng[c], gb2 = gnb[c];
  __syncthreads();
#pragma unroll 1
  for (int t0 = 0; t0 < 32; t0 += 4) {
    float y[4] = {bias, bias, bias, bias};
#pragma unroll
    for (int r = 0; r < 34; ++r) {
      const float u = U[(t0 + r) * 512 + c];
#pragma unroll
      for (int q = 0; q < 4; ++q) { const int j = r - q; if (j >= 0 && j < 31) y[q] = fmaf(w[j], u, y[q]); }
    }
#pragma unroll
    for (int q = 0; q < 4; ++q) {
      float sm = row16_sum(y[q]);
      sm += __shfl_xor(sm, 16); sm = half_swap_sum(sm);
      const float d = y[q] - sm * (1.0f / 64.0f);
      float vr = row16_sum(d * d);
      vr += __shfl_xor(vr, 16); vr = half_swap_sum(vr);
      const float n = d * rsqrtf(vr * (1.0f / 64.0f) + EPS) * gg + gb2;
      mix[((size_t)b * LP + pos0 + t0 + q) * D + 512 + c] = f2bf(n / (1.0f + __expf(-n)));
    }
  }
}


__device__ __forceinline__ void ce_desc(float& a, float& b) { const float hi = fmaxf(a, b), lo = fminf(a, b); a = hi; b = lo; }
__device__ __forceinline__ void ce_asc(float& a, float& b) { const float hi = fmaxf(a, b), lo = fminf(a, b); a = lo; b = hi; }
template <int N> __device__ __forceinline__ void bitonic_sort_desc(float (&v)[N]) {
#pragma unroll
  for (int k = 2; k <= N; k <<= 1)
#pragma unroll
    for (int j = k >> 1; j > 0; j >>= 1)
#pragma unroll
      for (int i = 0; i < N; ++i) { const int l = i ^ j; if (l > i) { if ((i & k) == 0) ce_desc(v[i], v[l]); else ce_asc(v[i], v[l]); } }
}
template <int N> __device__ __forceinline__ void bitonic_merge_desc(float (&v)[N]) {
#pragma unroll
  for (int j = N >> 1; j > 0; j >>= 1)
#pragma unroll
    for (int i = 0; i < N; ++i) { const int l = i ^ j; if (l > i) ce_desc(v[i], v[l]); }
}
__host__ __device__ constexpr int cand_slot(int i, int j) { int s = 0; for (int ii = 0; ii < i; ++ii) s += 16 / (ii + 1); return s + j; }

__device__ __forceinline__ void peer_topk_unit(char* lds, const bf16_t* __restrict__ qp, const bf16_t* __restrict__ skb, const float* __restrict__ rowss, int* eb, float* gb, int row0, int h) {
  const int tix = opaque_tid();
  const int tid = tix, lane = tid & 63, wid = tid >> 6, fr = lane & 15, fq = lane >> 4;
  __syncthreads();
#pragma unroll
  for (int i = 0; i < 8; ++i) {
    const int g = i * 512 + tid, row = g >> 4, pos = g & 15;
    *(uint4*)(lds + g * 16) = *(const uint4*)(skb + ((size_t)(h * 2) * 128 + row) * 128 + ((pos ^ (row & 15)) << 3));
  }
  if (tid < 64) {
    int i = 0, base = 0;
    while (i < 15 && tid >= base + 16 / (i + 1)) { base += 16 / (i + 1); ++i; }
    ((int*)(lds + 65536))[tid] = (i << 4) | ((tid - base) & 15);
  }
  __syncthreads();
  const int tok = row0 + wid * 16 + fr;
  float top[2][16];
#pragma unroll
  for (int p = 0; p < 2; ++p) {
    f32x4 acc[8];
#pragma unroll
    for (int i = 0; i < 8; ++i) acc[i] = (f32x4){0.f, 0.f, 0.f, 0.f};
    const bf16_t* xrow = qp + (size_t)tok * 2048 + h * 256 + p * 128 + fq * 8;
#pragma unroll
    for (int ks = 0; ks < 4; ++ks) {
      const bf16x8 xb = *(const bf16x8*)(xrow + ks * 32);
      const int ch = ks * 4 + fq;
#pragma unroll
      for (int nt = 0; nt < 8; ++nt) {
        const int r = p * 128 + nt * 16 + fr;
        const bf16x8 wa = *(const bf16x8*)(lds + r * 256 + ((ch ^ (r & 15)) << 4));
        acc[nt] = __builtin_amdgcn_mfma_f32_16x16x32_bf16(wa, xb, acc[nt], 0, 0, 0);
      }
    }
    float v[32];
#pragma unroll
    for (int nt = 0; nt < 8; ++nt)
#pragma unroll
      for (int r = 0; r < 4; ++r) v[nt * 4 + r] = __uint_as_float((__float_as_uint(acc[nt][r]) & ~127u) | (unsigned)(nt * 16 + fq * 4 + r));
    bitonic_sort_desc<32>(v);
    float t[16];
#pragma unroll
    for (int i = 0; i < 16; ++i) t[i] = v[i];
#pragma unroll
    for (int rnd = 0; rnd < 2; ++rnd) {
      float pb[16];
#pragma unroll
      for (int i = 0; i < 16; ++i) pb[i] = __shfl_xor(t[15 - i], rnd == 0 ? 16 : 32);
#pragma unroll
      for (int i = 0; i < 16; ++i) t[i] = fmaxf(t[i], pb[i]);
      bitonic_merge_desc<16>(t);
    }
#pragma unroll
    for (int i = 0; i < 16; ++i) top[p][i] = t[i];
  }
  int* ST = (int*)(lds + 65536);
  int* IDX = (int*)(lds + 65536 + 256) + (wid * 16 + fr) * 32;
#define SEL4(arr, q) (fq == 0 ? arr[q] : fq == 1 ? arr[4 + (q)] : fq == 2 ? arr[8 + (q)] : arr[12 + (q)])
  {
    int4 ia, ib;
    ia.x = __float_as_uint(SEL4(top[0], 0)) & 127; ia.y = __float_as_uint(SEL4(top[0], 1)) & 127; ia.z = __float_as_uint(SEL4(top[0], 2)) & 127; ia.w = __float_as_uint(SEL4(top[0], 3)) & 127;
    ib.x = __float_as_uint(SEL4(top[1], 0)) & 127; ib.y = __float_as_uint(SEL4(top[1], 1)) & 127; ib.z = __float_as_uint(SEL4(top[1], 2)) & 127; ib.w = __float_as_uint(SEL4(top[1], 3)) & 127;
    *(int4*)(IDX + 4 * fq) = ia; *(int4*)(IDX + 16 + 4 * fq) = ib;
  }
  float cv[16];
  {
    const float NEGV = -3.0e38f;
    float am[16], bm[16];
#pragma unroll
    for (int i = 0; i < 16; ++i) { am[i] = __uint_as_float(__float_as_uint(top[0][i]) & ~127u); bm[i] = __uint_as_float(__float_as_uint(top[1][i]) & ~127u); }
#define CAND(i, j) __uint_as_float((__float_as_uint(am[i] + bm[j]) & ~63u) | (unsigned)cand_slot(i, j))
    float A[16], B[16], C[16], Dd[8], E[8], F[16];
#pragma unroll
    for (int j = 0; j < 16; ++j) A[j] = CAND(0, j);
#pragma unroll
    for (int j = 0; j < 8; ++j) { B[j] = CAND(1, j); B[15 - j] = CAND(8 + j, 0); }
    bitonic_merge_desc<16>(B);
#pragma unroll
    for (int j = 0; j < 5; ++j) C[j] = CAND(2, j);
#pragma unroll
    for (int j = 5; j < 12; ++j) C[j] = NEGV;
#pragma unroll
    for (int j = 0; j < 4; ++j) C[15 - j] = CAND(3, j);
    bitonic_merge_desc<16>(C);
    Dd[0] = CAND(4, 0); Dd[1] = CAND(4, 1); Dd[2] = CAND(4, 2); Dd[3] = NEGV; Dd[4] = NEGV; Dd[5] = NEGV; Dd[6] = CAND(5, 1); Dd[7] = CAND(5, 0);
    bitonic_merge_desc<8>(Dd);
    E[0] = CAND(6, 0); E[1] = CAND(6, 1); E[2] = NEGV; E[3] = NEGV; E[4] = NEGV; E[5] = NEGV; E[6] = CAND(7, 1); E[7] = CAND(7, 0);
    bitonic_merge_desc<8>(E);
#pragma unroll
    for (int j = 0; j < 8; ++j) { F[j] = Dd[j]; F[15 - j] = E[j]; }
    bitonic_merge_desc<16>(F);
#undef CAND
#pragma unroll
    for (int j = 0; j < 16; ++j) { A[j] = fmaxf(A[j], B[15 - j]); C[j] = fmaxf(C[j], F[15 - j]); }
    bitonic_merge_desc<16>(A);
    bitonic_merge_desc<16>(C);
#pragma unroll
    for (int j = 0; j < 16; ++j) cv[j] = fmaxf(A[j], C[15 - j]);
    bitonic_merge_desc<16>(cv);
  }
  float ex[16]; float sum = 0.f;
  const float c0v = __uint_as_float(__float_as_uint(cv[0]) & ~63u);
  const float rs = row_rstd(rowss, (size_t)tok);
#pragma unroll
  for (int i = 0; i < 16; ++i) { ex[i] = __expf((__uint_as_float(__float_as_uint(cv[i]) & ~63u) - c0v) * rs); sum += ex[i]; }
  const float inv = 1.0f / sum;
  int e4[4]; float g4[4];
#pragma unroll
  for (int q = 0; q < 4; ++q) {
    const int slot = __float_as_uint(SEL4(cv, q)) & 63;
    const int ij = ST[slot];
    e4[q] = IDX[ij >> 4] * 128 + IDX[16 + (ij & 15)];
    g4[q] = SEL4(ex, q) * inv;
  }
#undef SEL4
  *(int4*)(eb + ((size_t)tok * 8 + h) * 16 + 4 * fq) = make_int4(e4[0], e4[1], e4[2], e4[3]);
  *(float4*)(gb + ((size_t)tok * 8 + h) * 16 + 4 * fq) = make_float4(g4[0], g4[1], g4[2], g4[3]);
}

__device__ __forceinline__ void p_cvt_bf16(int blk, int nblk, const float* __restrict__ src, bf16_t* dst, size_t n8) {
  const int tix = opaque_tid();
  for (size_t i = (size_t)blk * 512 + tix; i < n8; i += (size_t)nblk * 512) {
    const float4 a = ((const float4*)src)[2 * i], b = ((const float4*)src)[2 * i + 1];
    uint4 w; w.x = cvtpk(a.x, a.y); w.y = cvtpk(a.z, a.w); w.z = cvtpk(b.x, b.y); w.w = cvtpk(b.z, b.w);
    ((uint4*)dst)[i] = w;
  }
}


typedef float f32x2v __attribute__((ext_vector_type(2)));
__device__ __forceinline__ void p_cvt_fp8_rows(int blk, int nblk, const float* __restrict__ src, unsigned* dst, float* inv, const float* __restrict__ csc) {
  const int tix = opaque_tid();
  const int lane = tix & 63, wid = tix >> 6;
  for (int r = blk * 8 + wid; r < 16384; r += nblk * 8) {
    const float4* sp = (const float4*)(src + (size_t)r * D);
    float4 v[4];
#pragma unroll
    for (int k = 0; k < 4; ++k) v[k] = sp[k * 64 + lane];
    if (csc) {
#pragma unroll
      for (int k = 0; k < 4; ++k) { const float4 g = ((const float4*)csc)[k * 64 + lane]; v[k].x *= g.x; v[k].y *= g.y; v[k].z *= g.z; v[k].w *= g.w; }
    }
    float am = 0.f;
#pragma unroll
    for (int k = 0; k < 4; ++k) am = fmaxf(am, fmaxf(fmaxf(fabsf(v[k].x), fabsf(v[k].y)), fmaxf(fabsf(v[k].z), fabsf(v[k].w))));
    am = wave_max(am);
    const float sc = am > 0.f ? 384.0f / am : 1.0f;
#pragma unroll
    for (int k = 0; k < 4; ++k) {
      int w = __builtin_amdgcn_cvt_pk_fp8_f32(v[k].x * sc, v[k].y * sc, 0, false);
      w = __builtin_amdgcn_cvt_pk_fp8_f32(v[k].z * sc, v[k].w * sc, w, true);
      { const int c = 256 * k + 4 * lane; dst[((size_t)(c >> 7) * (16384 * 128) + (size_t)r * 128 + (c & 127)) >> 2] = (unsigned)w; }
    }
    if (lane == 0) inv[r] = am > 0.f ? am * (1.0f / 384.0f) : 1.0f;
  }
}


__device__ __forceinline__ unsigned xcc_id() { return (unsigned)__builtin_amdgcn_s_getreg((3 << 11) | 20) & 7u; }

__device__ __forceinline__ void ds_issue(uint4 (&u)[16], const int* El  , const unsigned char* __restrict__ tab) {
  int ev[16];
#pragma unroll
  for (int q = 0; q < 4; ++q) { const int4 t = *(const int4*)(El + 4 * q); ev[4 * q] = t.x; ev[4 * q + 1] = t.y; ev[4 * q + 2] = t.z; ev[4 * q + 3] = t.w; }
#pragma unroll
  for (int it = 0; it < 16; ++it) u[it] = *(const uint4*)(tab + (size_t)(unsigned)ev[it] * 128);
}
__device__ __forceinline__ void ds_u_compute(const uint4 (&u)[16], const char* Xl  , float* __restrict__ pout, int j) {
  f32x2v xf[8];
  {
    const uint4 a = *(const uint4*)Xl, c = *(const uint4*)(Xl + 16);
    xf[0] = (f32x2v){__uint_as_float(a.x << 16), __uint_as_float(a.x & 0xffff0000u)}; xf[1] = (f32x2v){__uint_as_float(a.y << 16), __uint_as_float(a.y & 0xffff0000u)};
    xf[2] = (f32x2v){__uint_as_float(a.z << 16), __uint_as_float(a.z & 0xffff0000u)}; xf[3] = (f32x2v){__uint_as_float(a.w << 16), __uint_as_float(a.w & 0xffff0000u)};
    xf[4] = (f32x2v){__uint_as_float(c.x << 16), __uint_as_float(c.x & 0xffff0000u)}; xf[5] = (f32x2v){__uint_as_float(c.y << 16), __uint_as_float(c.y & 0xffff0000u)};
    xf[6] = (f32x2v){__uint_as_float(c.z << 16), __uint_as_float(c.z & 0xffff0000u)}; xf[7] = (f32x2v){__uint_as_float(c.w << 16), __uint_as_float(c.w & 0xffff0000u)};
  }
  float k0 = 0.f, k1 = 0.f;
#pragma unroll
  for (int it = 0; it < 16; ++it) {
    const unsigned wv[4] = {u[it].x, u[it].y, u[it].z, u[it].w};
    f32x2v d2 = {0.f, 0.f};
#pragma unroll
    for (int q = 0; q < 4; ++q) {
      const f32x2v lo = __builtin_amdgcn_cvt_pk_f32_fp8((int)wv[q], false), hi = __builtin_amdgcn_cvt_pk_f32_fp8((int)wv[q], true);
      d2 = __builtin_elementwise_fma(lo, xf[2 * q], d2); d2 = __builtin_elementwise_fma(hi, xf[2 * q + 1], d2);
    }
    const float d = sum8(d2.x + d2.y);
    if ((it >> 1) == j) { if (it & 1) k1 = d; else k0 = d; }
  }
  *(float2*)pout = make_float2(k0, k1);
}
__device__ __forceinline__ void ds_u_chunk(char* wl  , int lane, int tk0, int s, const bf16_t* __restrict__ xn2, const int* __restrict__ eb, const unsigned char* __restrict__ ut8, float* __restrict__ partial) {
  const int b = tk0 / SEQ, sq = tk0 - b * SEQ;
  const size_t row0 = (size_t)b * LP + NMETA + sq;
  const int j = lane & 7, gi = lane >> 3;
  int* El = (int*)wl;
  char* Xl = wl + 8192;
#pragma unroll
  for (int i = 0; i < 8; ++i) *(int4*)(El + (i * 64 + lane) * 4) = *(const int4*)(eb + row0 * 128 + (i * 64 + lane) * 4);
#pragma unroll
  for (int i = 0; i < 4; ++i) { const int g = i * 64 + lane, t = g >> 4, c = g & 15; *(uint4*)(Xl + g * 16) = *(const uint4*)(xn2 + (row0 + t) * D + 128 * s + 8 * c); }
  const unsigned char* tab = ut8 + (size_t)s * (16384 * 128) + 16 * j;
  float* pout = partial + ((size_t)tk0 * 8 + s) * 128 + gi * 16 + 2 * j;
  uint4 ua[16], ub[16];
  ds_issue(ua, El + gi * 16, tab);
#pragma unroll 1
  for (int t = 0; t < 16; t += 2) {
    ds_issue(ub, El + (t + 1) * 128 + gi * 16, tab);
    ds_u_compute(ua, Xl + t * 256 + 32 * j, pout + (size_t)t * 1024, j);
    if (t + 2 < 16) ds_issue(ua, El + (t + 2) * 128 + gi * 16, tab);
    ds_u_compute(ub, Xl + (t + 1) * 256 + 32 * j, pout + (size_t)(t + 1) * 1024, j);
  }
}

__device__ __forceinline__ void ds_v_compute(const uint4 (&v)[16], const float* Wl  , int lane, int j, int gi, size_t row, int tk, int s,
                                             const bf16_t* __restrict__ hb, float* __restrict__ out, float* __restrict__ ssq) {
  float w[16];
#pragma unroll
  for (int q = 0; q < 4; ++q) { const float4 f = *(const float4*)(Wl + 4 * q); w[4 * q] = f.x; w[4 * q + 1] = f.y; w[4 * q + 2] = f.z; w[4 * q + 3] = f.w; }
  f32x2v acc[8];
#pragma unroll
  for (int i = 0; i < 8; ++i) acc[i] = (f32x2v){0.f, 0.f};
#pragma unroll
  for (int it = 0; it < 16; ++it) {
    const unsigned wv[4] = {v[it].x, v[it].y, v[it].z, v[it].w};
    const f32x2v w2 = {w[it], w[it]};
#pragma unroll
    for (int q = 0; q < 4; ++q) {
      const f32x2v lo = __builtin_amdgcn_cvt_pk_f32_fp8((int)wv[q], false), hi = __builtin_amdgcn_cvt_pk_f32_fp8((int)wv[q], true);
      acc[2 * q] = __builtin_elementwise_fma(w2, lo, acc[2 * q]); acc[2 * q + 1] = __builtin_elementwise_fma(w2, hi, acc[2 * q + 1]);
    }
  }
  float r4[4] = {0.f, 0.f, 0.f, 0.f};
#pragma unroll
  for (int i = 0; i < 16; ++i) {
    float t = (i & 1) ? acc[i >> 1].y : acc[i >> 1].x;
    t = dpp_add<0x128>(t);
    t += __shfl_xor(t, 16);
    t = half_swap_sum(t);
    if ((i >> 2) == gi) r4[i & 3] = t;
  }
  float ss = 0.f;
  if (gi < 4) {
    const int c0 = 128 * s + 16 * j + 4 * gi;
    const uint2 hw = *(const uint2*)(hb + row * D + c0);
    const float4 o = make_float4(__uint_as_float(hw.x << 16) + r4[0], __uint_as_float(hw.x & 0xffff0000u) + r4[1], __uint_as_float(hw.y << 16) + r4[2], __uint_as_float(hw.y & 0xffff0000u) + r4[3]);
    ss = o.x * o.x + o.y * o.y + o.z * o.z + o.w * o.w;
    *(float4*)(out + (size_t)tk * D + c0) = o;
  }
  ss = wave_sum(ss);
  if (lane == 0) ssq[(size_t)tk * 8 + s] = ss;
}
__device__ __forceinline__ void ds_v_chunk(char* wl, int lane, int tk0, int s, const bf16_t* __restrict__ hb, const int* __restrict__ eb, const float* __restrict__ wbuf, const unsigned char* __restrict__ vt8,
                                           float* __restrict__ out, float* __restrict__ ssq) {
  const int b = tk0 / SEQ, sq = tk0 - b * SEQ;
  const size_t row0 = (size_t)b * LP + NMETA + sq;
  const int j = lane & 7, gi = lane >> 3;
  int* El = (int*)wl;
  float* Wl = (float*)(wl + 8192);
#pragma unroll
  for (int i = 0; i < 8; ++i) {
    *(int4*)(El + (i * 64 + lane) * 4) = *(const int4*)(eb + row0 * 128 + (i * 64 + lane) * 4);
    *(float4*)(Wl + (i * 64 + lane) * 4) = *(const float4*)(wbuf + (size_t)tk0 * 128 + (i * 64 + lane) * 4);
  }
  const unsigned char* tab = vt8 + (size_t)s * (16384 * 128) + 16 * j;
  uint4 va[16], vb[16];
  ds_issue(va, El + gi * 16, tab);
#pragma unroll 1
  for (int t = 0; t < 16; t += 2) {
    ds_issue(vb, El + (t + 1) * 128 + gi * 16, tab);
    ds_v_compute(va, Wl + t * 128 + gi * 16, lane, j, gi, row0 + t, tk0 + t, s, hb, out, ssq);
    if (t + 2 < 16) ds_issue(va, El + (t + 2) * 128 + gi * 16, tab);
    ds_v_compute(vb, Wl + (t + 1) * 128 + gi * 16, lane, j, gi, row0 + t + 1, tk0 + t + 1, s, hb, out, ssq);
  }
}


struct EpiBf16 {
  bf16_t* out; int ld; int use_scale; unsigned* kmax;
  __device__ __forceinline__ void store8(size_t row, int col, const float (&v)[8], float& tmax) const {
    if (kmax && col >= 512 && col < 1024) {
      float ss = 0.f;
#pragma unroll
      for (int i = 0; i < 8; ++i) ss += v[i] * v[i];
      tmax = fmaxf(tmax, sum8(ss));
    }
    uint4 w; w.x = cvtpk(v[0], v[1]); w.y = cvtpk(v[2], v[3]); w.z = cvtpk(v[4], v[5]); w.w = cvtpk(v[6], v[7]);
    *(uint4*)(out + row * ld + col) = w;
  }
  __device__ __forceinline__ void finish(float tmax, size_t row, int col) const {
    if (kmax && col >= 512 && col < 1024) {
      tmax = wave_max(tmax);
      if ((threadIdx.x & 63) == 0) atomicMax(kmax + (row / LP) * 8 + ((col - 512) >> 6), __float_as_uint(tmax));
    }
  }
};
struct EpiResid2 {
  const float* x; const float* meta; float* h2; bf16_t* hb; float* rowss;
  __device__ __forceinline__ void finish(float, size_t, int) const {}
  __device__ __forceinline__ void store8(size_t row, int col, const float (&v)[8], float&) const {
    const float* src = hrow_ptr(x, meta, (int)row);
    const float4 a = *(const float4*)(src + col), b = *(const float4*)(src + col + 4);
    const float o[8] = {a.x + v[0], a.y + v[1], a.z + v[2], a.w + v[3], b.x + v[4], b.y + v[5], b.z + v[6], b.w + v[7]};
    uint4 w; w.x = cvtpk(o[0], o[1]); w.y = cvtpk(o[2], o[3]); w.z = cvtpk(o[4], o[5]); w.w = cvtpk(o[6], o[7]);
    *(uint4*)(hb + row * D + col) = w;
    float ss = 0.f;
#pragma unroll
    for (int i = 0; i < 8; ++i) ss += o[i] * o[i];
    ss = sum8(ss);
    if ((threadIdx.x & 7) == 0) rowss[row * 16 + (col >> 6)] = ss;
  }
};

template <class Epi>
__device__ __forceinline__ void gemm256(char* lds, const bf16_t* __restrict__ X, int ldx, const bf16_t* __restrict__ Wt, int ldw, int K, size_t xrow0, int n0, const Epi& epi) {
  const int tix = opaque_tid();
  const int tid = tix, lane = tid & 63;
  const int wid = __builtin_amdgcn_readfirstlane(tid >> 6);
  const int wm = wid >> 2, wn = wid & 3;
  const int fr = lane & 15, fq = lane >> 4;
  f32x4 acc[4][8];
#pragma unroll
  for (int i = 0; i < 4; ++i)
#pragma unroll
    for (int j = 0; j < 8; ++j) acc[i][j] = (f32x4){0.f, 0.f, 0.f, 0.f};
  const int nk = K >> 6;
  const int prow = lane >> 3, ppos = lane & 7;
  const char* xsrc = (const char*)(X + (xrow0 + 8 * wid + prow) * ldx);
  const char* wsrc = (const char*)(Wt + (size_t)(n0 + 8 * wid + prow) * ldw);
  const unsigned swz = (unsigned)((ppos ^ ((4 * wid + (prow >> 1)) & 7)) << 4);
#define G256_ISSUE(kt, buf) do { \
    _Pragma("unroll") for (int i_ = 0; i_ < 4; ++i_) { \
      __builtin_amdgcn_global_load_lds((const unsigned*)(xsrc + (size_t)(64 * i_) * ldx * 2 + (kt) * 128 + swz), LDSP(unsigned, lds + (buf) * 65536 + (i_ * 8 + wid) * 1024), 16, 0, 0); \
      __builtin_amdgcn_global_load_lds((const unsigned*)(wsrc + (size_t)(64 * i_) * ldw * 2 + (kt) * 128 + swz), LDSP(unsigned, lds + (buf) * 65536 + 32768 + (i_ * 8 + wid) * 1024), 16, 0, 0); \
    } } while (0)
  __syncthreads();
  G256_ISSUE(0, 0);
  asm volatile("s_waitcnt vmcnt(0)" ::: "memory");
  __syncthreads();
  for (int kt = 0; kt < nk; ++kt) {
    if (kt + 1 < nk) G256_ISSUE(kt + 1, (kt + 1) & 1);
    const char* la = lds + (kt & 1) * 65536;
    const char* lb = la + 32768;
#pragma unroll
    for (int kk = 0; kk < 2; ++kk) {
      const int c = kk * 4 + fq;
      bf16x8 xa[8], wb[4];
#pragma unroll
      for (int t = 0; t < 8; ++t) { const int r = wm * 128 + t * 16 + fr; xa[t] = *(const bf16x8*)(la + r * 128 + ((c ^ ((r >> 1) & 7)) << 4)); }
#pragma unroll
      for (int t = 0; t < 4; ++t) { const int r = wn * 64 + t * 16 + fr; wb[t] = *(const bf16x8*)(lb + r * 128 + ((c ^ ((r >> 1) & 7)) << 4)); }
#pragma unroll
      for (int nt = 0; nt < 4; ++nt)
#pragma unroll
        for (int tt = 0; tt < 8; ++tt) acc[nt][tt] = __builtin_amdgcn_mfma_f32_16x16x32_bf16(wb[nt], xa[tt], acc[nt][tt], 0, 0, 0);
    }
    asm volatile("s_waitcnt vmcnt(0)" ::: "memory");
    __syncthreads();
  }
#undef G256_ISSUE
  char* wl = lds + wid * 16384;
  float tmax = 0.f;
#pragma unroll
  for (int hf = 0; hf < 2; ++hf) {
#pragma unroll
    for (int t4 = 0; t4 < 4; ++t4)
#pragma unroll
      for (int nt = 0; nt < 4; ++nt) {
        const int t = t4 * 16 + fr, c16 = nt * 4 + fq;
        *(f32x4*)(wl + t * 256 + ((c16 ^ (t & 15)) << 4)) = acc[nt][hf * 4 + t4];
      }
#pragma unroll
    for (int i = 0; i < 8; ++i) {
      const int t = 8 * i + (lane >> 3), c8 = lane & 7;
      const f32x4 v0 = *(const f32x4*)(wl + t * 256 + (((2 * c8) ^ (t & 15)) << 4)), v1 = *(const f32x4*)(wl + t * 256 + (((2 * c8 + 1) ^ (t & 15)) << 4));
      const float v[8] = {v0[0], v0[1], v0[2], v0[3], v1[0], v1[1], v1[2], v1[3]};
      epi.store8(xrow0 + wm * 128 + hf * 64 + t, n0 + wn * 64 + 8 * c8, v, tmax);
    }
  }
  epi.finish(tmax, xrow0, n0 + wn * 64);
}

__device__ __forceinline__ void meta_proj(char* lds, int blk, const bf16_t* __restrict__ xn1, const bf16_t* __restrict__ wt_in, bf16_t* proj) {
  const int tix = opaque_tid();
  float* red = (float*)lds;
  __syncthreads();
  float part = 0.f;
  const int o = tix % 160, kp = tix / 160;
  if (tix < 480) {
    const int row = o / 10, n = blk * 10 + o % 10;
    const int k0 = kp * 352, k1 = kp == 2 ? 1024 : k0 + 352;
    const bf16_t* xr = xn1 + (size_t)row * D; const bf16_t* wr = wt_in + (size_t)n * D;
    for (int k = k0; k < k1; k += 8) {
      const uint4 a = *(const uint4*)(xr + k), b = *(const uint4*)(wr + k);
      part = dot8(a, b, part);
    }
    red[tix] = part;
  }
  __syncthreads();
  if (tix < 160) {
    const float v = red[tix] + red[tix + 160] + red[tix + 320];
    const int row = tix / 10, n = blk * 10 + tix % 10;
    const bf16_t bv = f2bf(v);
#pragma unroll
    for (int b = 0; b < BATCH; ++b) proj[((size_t)b * LP + row) * INC + n] = bv;
  }
}

__device__ __forceinline__ void p_transpose(int t, float* smem, const float* __restrict__ W, bf16_t* Wt, int K, int N, const float* __restrict__ ksc) {
  const int tix = opaque_tid();
  float (*T)[65] = (float (*)[65])smem;
  const int nbx = N / 64, k0 = (t / nbx) * 64, n0 = (t % nbx) * 64, tid = (tix & 255);
  const int j = tid & 63, i0 = tid >> 6;
#pragma unroll
  for (int ii = 0; ii < 16; ++ii) { int i = i0 + 4 * ii; T[i][j] = W[(size_t)(k0 + i) * N + n0 + j] * (ksc ? ksc[k0 + i] : 1.0f); }
  __syncthreads();
#pragma unroll
  for (int ii = 0; ii < 16; ++ii) { int jj = i0 + 4 * ii; Wt[(size_t)(n0 + jj) * K + k0 + j] = f2bf(T[j][jj]); }
  __syncthreads();
}

__device__ __forceinline__ void grid_bar(unsigned* ctr, unsigned target) {
  asm volatile("s_waitcnt vmcnt(0)" ::: "memory");
  __syncthreads();
  if (threadIdx.x == 0) {
    __builtin_amdgcn_fence(__ATOMIC_RELEASE, "agent");
    asm volatile("s_waitcnt vmcnt(0)" ::: "memory");
    __hip_atomic_fetch_add(ctr, 1u, __ATOMIC_RELAXED, __HIP_MEMORY_SCOPE_AGENT);
    unsigned spins = 0;
    while (__hip_atomic_load(ctr, __ATOMIC_RELAXED, __HIP_MEMORY_SCOPE_AGENT) < target) { __builtin_amdgcn_s_sleep(2); if (++spins > (1u << 24)) break; }
    __builtin_amdgcn_fence(__ATOMIC_ACQUIRE, "agent");
    asm volatile("s_waitcnt vmcnt(0)" ::: "memory");
  }
  __syncthreads();
}

struct Params {
  const float *x, *meta, *g1, *w_in, *lq1, *lk1, *lq2, *lk2, *subg, *conv_w, *conv_b, *gn_g, *gn_b, *w_out, *g2, *wq, *sk, *ut, *vt, *fg;
  float* out; float* scal; bf16_t* r1; bf16_t* r2; float* h2; int* eb; float* gb; bf16_t* wt_in; bf16_t* wt_out; bf16_t* wt_q; bf16_t* skb; unsigned char* ut8; unsigned char* vt8; float* uinv; float* vinv; float* wbuf; float* ssq; bf16_t* hb; float* rowss;
};

__global__ void __launch_bounds__(512, 2) mega(Params p) {
  cg::grid_group grid = cg::this_grid();
  __shared__ __attribute__((aligned(16))) char smem_c[131072 + 256];
  float* smem = (float*)smem_c;
  const int G = gridDim.x, vh = threadIdx.x >> 8;
  unsigned* ctr = (unsigned*)(p.scal + 64);
  unsigned nbar = 0;
  bf16_t* xn1 = p.r1; bf16_t* mix = p.r1; bf16_t* proj = p.r2; bf16_t* qp = p.r2;
  p_norm1_rows(G, p.x, p.meta, p.g1, xn1);
  if (blockIdx.x == 0 && threadIdx.x < 64) {
    const int t = threadIdx.x;
    const float a = wave_sum(p.lq1[t] * p.lk1[t]), b2 = wave_sum(p.lq2[t] * p.lk2[t]);
    if (t == 0) p.scal[0] = expf(a) - expf(b2) + LAM_INIT;
  }
  for (int b = blockIdx.x; b < (640 + 256 + 512) / 2; b += G) {
    const int bb = b * 2 + vh; float* sm = smem + vh * (64 * 65);
    if (bb < 640) p_transpose(bb, sm, p.w_in, p.wt_in, D, INC, nullptr);
    else if (bb < 896) p_transpose(bb - 640, sm, p.w_out, p.wt_out, D, D, nullptr);
    else p_transpose(bb - 896, sm, p.wq, p.wt_q, D, 2048, p.g2);
  }
  p_cvt_bf16(blockIdx.x, G, p.sk, p.skb, (size_t)16 * 128 * 128 / 8);
  p_cvt_fp8_rows(blockIdx.x, G, p.ut, (unsigned*)p.ut8, p.uinv, p.g2);
  p_cvt_fp8_rows(blockIdx.x, G, p.vt, (unsigned*)p.vt8, p.vinv, nullptr);
  grid.sync();
  for (int b = blockIdx.x; b < 128 * 10; b += G) {
    const int xi = (b >> 3), mt = (b & 7) * 16 + xi / 10, nt = xi % 10;
    gemm256(smem_c, xn1, D, p.wt_in, D, D, (size_t)(mt >> 4) * LP + NMETA + 256 * (mt & 15), nt * 256, EpiBf16{proj, INC, 0, (unsigned*)(p.scal + 640)});
  }
  for (int b = blockIdx.x; b < 256; b += G) meta_proj(smem_c, b, xn1, p.wt_in, proj);
  for (int i = blockIdx.x * 512 + threadIdx.x; i < BATCH * (LP - LREAL) * 128; i += G * 512) {
    const int c = i & 127, r = i >> 7, b = r / (LP - LREAL), pos = LREAL + r - b * (LP - LREAL);
    *(uint4*)(proj + ((size_t)b * LP + pos) * INC + 512 + 8 * c) = make_uint4(0, 0, 0, 0);
  }
  grid_bar(ctr, (unsigned)G * ++nbar);
  {
    const float lam = p.scal[0];
    for (int u = blockIdx.x; u < 256; u += G) {
      const int bh = (u & 7) * 4 + (u >> 6), tp = (u >> 3) & 7;
#pragma unroll 1
      for (int k = 0; k < 4; ++k) {
        const int t = (k == 0) ? 31 - tp : (k == 1) ? 16 + tp : (k == 2) ? 15 - tp : tp;
        attn_unit(smem_c, proj, mix, p.subg, (const unsigned*)(p.scal + 640), lam, bh >> 2, bh & 3, t);
      }
    }
  }
  for (int u = blockIdx.x; u < BATCH * 128; u += G) conv_unit(smem_c, proj, mix, p.conv_w, p.conv_b, p.gn_g, p.gn_b, u >> 7, NMETA + 32 * (u & 127));
  grid_bar(ctr, (unsigned)G * ++nbar);
  for (int b = blockIdx.x; b < 128 * 4; b += G) {
    const int xi = (b >> 3), mt = (b & 7) * 16 + (xi >> 2), nt = xi & 3;
    gemm256(smem_c, mix, D, p.wt_out, D, D, (size_t)(mt >> 4) * LP + NMETA + 256 * (mt & 15), nt * 256, EpiResid2{p.x, p.meta, p.h2, p.hb, p.rowss});
  }
  grid_bar(ctr, (unsigned)G * ++nbar);
  for (int b = blockIdx.x; b < 128 * 8; b += G) {
    const int xi = (b >> 3), mt = (b & 7) * 16 + (xi >> 3), nt = xi & 7;
    gemm256(smem_c, p.hb, D, p.wt_q, D, D, (size_t)(mt >> 4) * LP + NMETA + 256 * (mt & 15), nt * 256, EpiBf16{qp, 2048, 0, nullptr});
  }
  grid_bar(ctr, (unsigned)G * ++nbar);
  for (int u = blockIdx.x; u < 256 * 8; u += G) {
    const int rt = u >> 3, h = u & 7;
    peer_topk_unit(smem_c, qp, p.skb, p.rowss, p.eb, p.gb, (rt >> 5) * LP + NMETA + 128 * (rt & 31), h);
  }
  grid_bar(ctr, (unsigned)G * ++nbar);
  {
    const int tix = opaque_tid();
    const int lane = tix & 63;
    const int NTOK = BATCH * SEQ;
    float* partial = (float*)qp;
    unsigned* qh = (unsigned*)(p.scal + 128);
    const unsigned x = xcc_id();
    for (int qi = 0; qi < 8; ++qi) {
      const int s = (int)((x + qi) & 7u);
      for (;;) {
        unsigned st = 0;
        if (lane == 0) st = __hip_atomic_fetch_add(qh + s * 16, 16u, __ATOMIC_RELAXED, __HIP_MEMORY_SCOPE_AGENT);
        st = __builtin_amdgcn_readfirstlane(st);
        if (st >= (unsigned)NTOK) break;
        ds_u_chunk(smem_c + (tix >> 6) * 16384, lane, (int)st, s, p.hb, p.eb, p.ut8, partial);
      }
    }
    grid_bar(ctr, (unsigned)G * ++nbar);
    for (size_t i = (size_t)blockIdx.x * 512 + tix; i < (size_t)NTOK * 128; i += (size_t)G * 512) {
      const int tk = (int)(i >> 7), k = (int)(i & 127);
      const int b = tk / SEQ, sq = tk - b * SEQ;
      const size_t row = (size_t)b * LP + NMETA + sq;
      float a = 0.f;
#pragma unroll
      for (int sl = 0; sl < 8; ++sl) a += partial[((size_t)tk * 8 + sl) * 128 + k];
      const int e = p.eb[row * 128 + k];
      a *= p.uinv[e] * row_rstd(p.rowss, row);
      p.wbuf[i] = p.gb[row * 128 + k] * 0.5f * a * (1.0f + erff(a * 0.70710678118654752f)) * p.vinv[e];
    }
    grid_bar(ctr, (unsigned)G * ++nbar);
    for (int qi = 0; qi < 8; ++qi) {
      const int s = (int)((x + qi) & 7u);
      for (;;) {
        unsigned st = 0;
        if (lane == 0) st = __hip_atomic_fetch_add(qh + (8 + s) * 16, 16u, __ATOMIC_RELAXED, __HIP_MEMORY_SCOPE_AGENT);
        st = __builtin_amdgcn_readfirstlane(st);
        if (st >= (unsigned)NTOK) break;
        ds_v_chunk(smem_c + (tix >> 6) * 16384, lane, (int)st, s, p.hb, p.eb, p.wbuf, p.vt8, p.h2, p.ssq);
      }
    }
    grid_bar(ctr, (unsigned)G * ++nbar);
    {
      const int wv = blockIdx.x * 8 + (tix >> 6);
      for (int tk = wv * 2; tk < NTOK; tk += G * 16) {
        float4 o[2][4]; float sv[2];
#pragma unroll
        for (int r = 0; r < 2; ++r) {
#pragma unroll
          for (int q = 0; q < 4; ++q) o[r][q] = ((const float4*)p.h2)[(size_t)(tk + r) * 256 + q * 64 + lane];
          sv[r] = lane < 8 ? p.ssq[(size_t)(tk + r) * 8 + lane] : 0.f;
        }
#pragma unroll
        for (int r = 0; r < 2; ++r) {
          const float rstd = rsqrtf(wave_sum(sv[r]) * (1.0f / D) + EPS);
#pragma unroll
          for (int q = 0; q < 4; ++q) {
            const float4 f = ((const float4*)p.fg)[q * 64 + lane];
            float4 v = o[r][q];
            v.x *= rstd * f.x; v.y *= rstd * f.y; v.z *= rstd * f.z; v.w *= rstd * f.w;
            ((float4*)p.out)[(size_t)(tk + r) * 256 + q * 64 + lane] = v;
          }
        }
      }
    }
  }
}

extern "C" void kernel_launch(void* const* d_in, const int* in_sizes, int n_in, void* d_out, int out_size, void* d_ws, size_t ws_size, hipStream_t stream) {
  static int grid_blocks = 0;
  if (!grid_blocks) {
    int dev = 0, cus = 0, per_cu = 0;
    hipGetDevice(&dev);
    hipDeviceGetAttribute(&cus, hipDeviceAttributeMultiprocessorCount, dev);
    hipOccupancyMaxActiveBlocksPerMultiprocessor(&per_cu, mega, 512, 0);
    if (per_cu > 1) per_cu = 1;
    if (per_cu < 1) per_cu = 1;
    grid_blocks = cus * per_cu;
  }
  Params p{};
  const float** pp = (const float**)&p;
  for (int i = 0; i < 20; ++i) pp[i] = (const float*)d_in[i];
  p.out = (float*)d_out;
  char* ws = (char*)d_ws;
  size_t off = 0;
  p.scal = (float*)(ws + off); off += 4096;
  p.r1 = (bf16_t*)(ws + off); off += (size_t)ROWS * D * 2;
  p.r2 = (bf16_t*)(ws + off); off += (size_t)ROWS * INC * 2;
  p.h2 = (float*)(ws + off); off += (size_t)ROWS * D * 4;
  p.wt_in = (bf16_t*)(ws + off); off += (size_t)INC * D * 2;
  p.wt_out = (bf16_t*)(ws + off); off += (size_t)D * D * 2;
  p.wt_q = (bf16_t*)(ws + off); off += (size_t)2048 * D * 2;
  p.skb = (bf16_t*)(ws + off); off += (size_t)16 * 128 * 128 * 2;
  p.ut8 = (unsigned char*)(ws + off); off += (size_t)16384 * D;
  p.vt8 = (unsigned char*)(ws + off); off += (size_t)16384 * D;
  p.uinv = (float*)(ws + off); off += 65536;
  p.vinv = (float*)(ws + off); off += 65536;
  p.wbuf = (float*)(ws + off); off += (size_t)BATCH * SEQ * 128 * 4;
  p.ssq = (float*)(ws + off); off += (size_t)BATCH * SEQ * 8 * 4;
  p.hb = (bf16_t*)(ws + off); off += (size_t)ROWS * D * 2;
  p.rowss = (float*)(ws + off); off += (size_t)ROWS * 16 * 4;
  p.eb = (int*)((char*)p.r2 + (size_t)ROWS * 2048 * 2);
  p.gb = (float*)((char*)p.eb + (size_t)ROWS * 128 * 4);
  hipMemsetAsync(d_ws, 0, 4096, stream);
  void* args[] = {&p};
  hipError_t e = hipLaunchCooperativeKernel((void*)mega, dim3(grid_blocks), dim3(512), args, 0, stream);
  if (e != hipSuccess) fprintf(stderr, "cooperative launch failed: %s (grid %d)\n", hipGetErrorString(e), grid_blocks);
}
```

```cpp
#include <hip/hip_runtime.h>
#include <hip/hip_cooperative_groups.h>
#include <cstdio>
namespace cg = cooperative_groups;
#include <stdint.h>
#include <math.h>

typedef unsigned short bf16_t;
typedef short bf16x8 __attribute__((ext_vector_type(8)));
typedef float f32x4 __attribute__((ext_vector_type(4)));

constexpr int D = 1024, BATCH = 8, SEQ = 4096, NMETA = 16, LREAL = NMETA + SEQ  , LP = 4224, ROWS = BATCH * LP;
constexpr int INC = 2560;
constexpr float EPS = 1e-6f;
constexpr float LAM_INIT = 0.2f;

__device__ __forceinline__ float bf2f(unsigned v) { return __uint_as_float(v << 16); }
__device__ __forceinline__ bf16_t f2bf(float f) { unsigned u = __float_as_uint(f); u += 0x7fffu + ((u >> 16) & 1u); return (bf16_t)(u >> 16); }
__device__ __forceinline__ unsigned pack2(float a, float b) { return (unsigned)f2bf(a) | ((unsigned)f2bf(b) << 16); }

__device__ __forceinline__ float wave_sum(float v) {
#pragma unroll
  for (int o = 32; o >= 1; o >>= 1) v += __shfl_xor(v, o);
  return v;
}
__device__ __forceinline__ float wave_max(float v) {
#pragma unroll
  for (int o = 32; o >= 1; o >>= 1) v = fmaxf(v, __shfl_xor(v, o));
  return v;
}

template <int CTRL> __device__ __forceinline__ float dpp_add(float v) { return v + __builtin_bit_cast(float, __builtin_amdgcn_update_dpp(0, __builtin_bit_cast(int, v), CTRL, 0xf, 0xf, true)); }
__device__ __forceinline__ float sum8(float v) { v = dpp_add<0x141>(v); v = dpp_add<0xB1>(v); v = dpp_add<0x4E>(v); return v; }
typedef __bf16 bf16v2 __attribute__((ext_vector_type(2)));
__device__ __forceinline__ float dot8(uint4 a, uint4 b, float acc) {
  acc = __builtin_amdgcn_fdot2_f32_bf16(__builtin_bit_cast(bf16v2, a.x), __builtin_bit_cast(bf16v2, b.x), acc, false);
  acc = __builtin_amdgcn_fdot2_f32_bf16(__builtin_bit_cast(bf16v2, a.y), __builtin_bit_cast(bf16v2, b.y), acc, false);
  acc = __builtin_amdgcn_fdot2_f32_bf16(__builtin_bit_cast(bf16v2, a.z), __builtin_bit_cast(bf16v2, b.z), acc, false);
  acc = __builtin_amdgcn_fdot2_f32_bf16(__builtin_bit_cast(bf16v2, a.w), __builtin_bit_cast(bf16v2, b.w), acc, false);
  return acc;
}
__device__ __forceinline__ float row_rstd(const float* __restrict__ rowss, size_t row) {
  const float4 a = *(const float4*)(rowss + row * 16), b = *(const float4*)(rowss + row * 16 + 4), c = *(const float4*)(rowss + row * 16 + 8), d = *(const float4*)(rowss + row * 16 + 12);
  const float t = ((a.x + a.y) + (a.z + a.w)) + ((b.x + b.y) + (b.z + b.w)) + ((c.x + c.y) + (c.z + c.w)) + ((d.x + d.y) + (d.z + d.w));
  return rsqrtf(t * (1.0f / D) + EPS);
}
__device__ __forceinline__ float row16_sum(float v) {
  v += __builtin_bit_cast(float, __builtin_amdgcn_update_dpp(0, __builtin_bit_cast(int, v), 0x128, 0xf, 0xf, true));
  v += __builtin_bit_cast(float, __builtin_amdgcn_update_dpp(0, __builtin_bit_cast(int, v), 0x124, 0xf, 0xf, true));
  v += __builtin_bit_cast(float, __builtin_amdgcn_update_dpp(0, __builtin_bit_cast(int, v), 0x122, 0xf, 0xf, true));
  v += __builtin_bit_cast(float, __builtin_amdgcn_update_dpp(0, __builtin_bit_cast(int, v), 0x121, 0xf, 0xf, true));
  return v;
}
__device__ __forceinline__ int opaque_tid() { int t = threadIdx.x; asm volatile("" : "+v"(t)); return t; }

__device__ __forceinline__ const float* hrow_ptr(const float* x, const float* meta, int row) {
  int b = row / LP, pos = row - b * LP;
  if (pos < NMETA) return meta + (size_t)pos * D;
  if (pos < LREAL) return x + ((size_t)b * SEQ + (pos - NMETA)) * D;
  return nullptr;
}


typedef float f32x16 __attribute__((ext_vector_type(16)));
typedef short v4i16_t __attribute__((ext_vector_type(4)));
typedef __bf16 bf16v2_t __attribute__((ext_vector_type(2)));
typedef float f32x2_t __attribute__((ext_vector_type(2)));
#define LDSP(T, p) ((__attribute__((address_space(3))) T*)(p))
#define MFMA32(a, b, c) __builtin_amdgcn_mfma_f32_32x32x16_bf16((a), (b), (c), 0, 0, 0)
__device__ __forceinline__ unsigned cvtpk(float lo, float hi) { f32x2_t v = {lo, hi}; return __builtin_bit_cast(unsigned, __builtin_convertvector(v, bf16v2_t)); }
__device__ __forceinline__ float half_swap_max(float m) { auto rr = __builtin_amdgcn_permlane32_swap(__float_as_uint(m), __float_as_uint(m), false, false); return fmaxf(__uint_as_float(rr[0]), __uint_as_float(rr[1])); }
__device__ __forceinline__ float half_swap_sum(float m) { auto rr = __builtin_amdgcn_permlane32_swap(__float_as_uint(m), __float_as_uint(m), false, false); return __uint_as_float(rr[0]) + __uint_as_float(rr[1]); }

__device__ __forceinline__ void attn_issue_kv(char* kvbuf, const bf16_t* __restrict__ kvrow0  , int tid, int wid) {
  const char* base = (const char*)kvrow0;
#pragma unroll
  for (int i = 0; i < 2; ++i) {
    const int g = i * 512 + tid, row = g >> 4, pos = g & 15;
    const unsigned offk = (unsigned)(row * (INC * 2) + 1024 + ((pos ^ (row & 15)) << 4));
    const unsigned offv = (unsigned)(row * (INC * 2) + 2048 + ((pos ^ ((row & 3) << 2)) << 4));
    __builtin_amdgcn_global_load_lds((const unsigned*)(base + offk), LDSP(unsigned, kvbuf + (i * 512 + wid * 64) * 16), 16, 0, 0);
    __builtin_amdgcn_global_load_lds((const unsigned*)(base + offv), LDSP(unsigned, kvbuf + 16384 + (i * 512 + wid * 64) * 16), 16, 0, 0);
  }
}

template <bool MASKED, bool MAXONLY>
__device__ __forceinline__ void attn_qk(uint4 (&pw)[4], float& mref, const char* qbase, int qsw, const char* kb, int c, int kq, float sl8, int lane, int r32, int hi,
                                         const bf16x8& augk0, const bf16x8& augk1, const bf16x8& augq) {
  const float c1 = 0.125f * 1.4426950408889634f;
  asm volatile("" : "+v"(qsw), "+v"(lane));
  f32x16 s0, s1;
  float soff;
  if (MASKED) {
    const float a1 = sl8, a2 = 2.0f * sl8, a3 = 3.0f * sl8, b8 = 8.0f * sl8;
    float gb = sl8 * (float)kq;
#pragma unroll
    for (int g = 0; g < 4; ++g) { s0[4 * g] = gb; s0[4 * g + 1] = gb + a1; s0[4 * g + 2] = gb + a2; s0[4 * g + 3] = gb + a3; gb += b8; }
#pragma unroll
    for (int g = 0; g < 4; ++g) { s1[4 * g] = gb; s1[4 * g + 1] = gb + a1; s1[4 * g + 2] = gb + a2; s1[4 * g + 3] = gb + a3; gb += b8; }
#pragma unroll
    for (int r = 0; r < 16; ++r) { s0[r] = s0[r] > 0.f ? -1e30f : s0[r]; s1[r] = s1[r] > 0.f ? -1e30f : s1[r]; }
    soff = 0.f;
  } else {
#pragma unroll
    for (int r = 0; r < 16; ++r) { s0[r] = 0.f; s1[r] = 0.f; }
    s0 = MFMA32(augk0, augq, s0);
    s1 = MFMA32(augk1, augq, s1);
    soff = sl8 * (float)(kq - 4 * hi);
  }
#pragma unroll
  for (int ks = 0; ks < 4; ++ks) {
    const int ch = c * 8 + ks * 2 + hi;
    bf16x8 bq = *(const bf16x8*)(qbase + ((ch ^ qsw) << 4));
    bf16x8 ka0 = *(const bf16x8*)(kb + r32 * 256 + ((ch ^ qsw) << 4));
    bf16x8 ka1 = *(const bf16x8*)(kb + (32 + r32) * 256 + ((ch ^ qsw) << 4));
    s0 = MFMA32(ka0, bq, s0);
    s1 = MFMA32(ka1, bq, s1);
    __builtin_amdgcn_sched_barrier(0);
  }
  if (MAXONLY) {
    float m0 = fmaxf(s0[0], s1[0]), m1 = fmaxf(s0[1], s1[1]), m2 = fmaxf(s0[2], s1[2]), m3 = fmaxf(s0[3], s1[3]);
#pragma unroll
    for (int r = 4; r < 16; r += 4) {
      m0 = fmaxf(fmaxf(m0, s0[r]), s1[r]); m1 = fmaxf(fmaxf(m1, s0[r + 1]), s1[r + 1]); m2 = fmaxf(fmaxf(m2, s0[r + 2]), s1[r + 2]); m3 = fmaxf(fmaxf(m3, s0[r + 3]), s1[r + 3]);
    }
    mref = fmaxf(mref, half_swap_max(fmaxf(fmaxf(m0, m1), fmaxf(m2, m3))) + soff);
    return;
  }
  const f32x2_t c1v = {c1, c1}, nmv = {(soff - mref) * c1, (soff - mref) * c1};
#pragma unroll
  for (int r = 0; r < 16; r += 2) {
    f32x2_t x0 = {s0[r], s0[r + 1]}, x1 = {s1[r], s1[r + 1]};
    x0 = __builtin_elementwise_fma(x0, c1v, nmv); x1 = __builtin_elementwise_fma(x1, c1v, nmv);
    x0.x = __builtin_amdgcn_exp2f(x0.x); x0.y = __builtin_amdgcn_exp2f(x0.y); x1.x = __builtin_amdgcn_exp2f(x1.x); x1.y = __builtin_amdgcn_exp2f(x1.y);
    s0[r] = x0.x; s0[r + 1] = x0.y; s1[r] = x1.x; s1[r + 1] = x1.y;
  }
#pragma unroll
  for (int kk = 0; kk < 2; ++kk) {
    pw[kk] = make_uint4(cvtpk(s0[8 * kk], s0[8 * kk + 1]), cvtpk(s0[8 * kk + 2], s0[8 * kk + 3]), cvtpk(s0[8 * kk + 4], s0[8 * kk + 5]), cvtpk(s0[8 * kk + 6], s0[8 * kk + 7]));
    pw[2 + kk] = make_uint4(cvtpk(s1[8 * kk], s1[8 * kk + 1]), cvtpk(s1[8 * kk + 2], s1[8 * kk + 3]), cvtpk(s1[8 * kk + 4], s1[8 * kk + 5]), cvtpk(s1[8 * kk + 6], s1[8 * kk + 7]));
  }
}

__device__ __forceinline__ void attn_pv(f32x16 (&o)[4], f32x16& osum, const uint4 (&pw)[4], const char* vb, int lane, int hi) {
  asm volatile("" : "+v"(lane));
  const int q4 = (lane & 15) >> 2, g1 = (lane >> 4) & 1, p4 = lane & 3;
#pragma unroll
  for (int kk = 0; kk < 4; ++kk) {
    const int key0 = 16 * kk + 4 * hi + q4;
    const bf16x8 pb = __builtin_bit_cast(bf16x8, pw[kk]);
    osum = MFMA32(__builtin_bit_cast(bf16x8, make_uint4(0x3F803F80u, 0x3F803F80u, 0x3F803F80u, 0x3F803F80u)), pb, osum);
#pragma unroll
    for (int dvt = 0; dvt < 4; ++dvt) {
      const int c8 = 8 * (dvt ^ q4) + 4 * g1 + p4;
      v4i16_t lo = __builtin_amdgcn_ds_read_tr16_b64_v4i16(LDSP(v4i16_t, vb + key0 * 256 + c8 * 8));
      v4i16_t hi4 = __builtin_amdgcn_ds_read_tr16_b64_v4i16(LDSP(v4i16_t, vb + (key0 + 8) * 256 + c8 * 8));
      bf16x8 va = (bf16x8){lo[0], lo[1], lo[2], lo[3], hi4[0], hi4[1], hi4[2], hi4[3]};
      o[dvt] = MFMA32(va, pb, o[dvt]);
    }
    __builtin_amdgcn_sched_barrier(0);
  }
}

__device__ __forceinline__ void attn_unit(char* lds, const bf16_t* __restrict__ proj, bf16_t* mix, const float* __restrict__ subg, const unsigned* __restrict__ kmax, float lam, int b, int h, int t) {
  const int tix = opaque_tid();
  const int tid = tix, lane = tid & 63, r32 = lane & 31, hi = lane >> 5;
  const int wid = __builtin_amdgcn_readfirstlane(tid >> 6);
  const int c = wid >> 2, qg = wid & 3;
  const int q0 = NMETA + 128 * t, qw0 = q0 + 32 * qg, qpos = qw0 + r32;
  const size_t rowb = (size_t)b * LP;
  const int NT = 2 * t + 3;
  char* Qs = lds;
  char* KV = lds + 32768;
  const float sl8 = exp2f(1.0f - 2.0f * (float)h);
  __syncthreads();
  attn_issue_kv(KV, proj + rowb * INC + h * 128, tid, wid);
#pragma unroll
  for (int i = 0; i < 4; ++i) {
    const int g = i * 512 + tid, row = g >> 4, pos = g & 15;
    uint4 v = *(const uint4*)(proj + (rowb + q0 + row) * INC + h * 128 + ((pos ^ (row & 15)) << 3));
    *(uint4*)(Qs + g * 16) = v;
  }
  f32x16 o[4];
#pragma unroll
  for (int i = 0; i < 4; ++i)
#pragma unroll
    for (int r = 0; r < 16; ++r) o[i][r] = 0.f;
  f32x16 osum;
#pragma unroll
  for (int r = 0; r < 16; ++r) osum[r] = 0.f;
  bf16x8 augk0, augk1, augq;
  {
    const unsigned k0w = hi == 0 ? cvtpk((float)r32, 0.f) : 0u, k1w = hi == 0 ? cvtpk((float)(32 + r32), 0.f) : 0u, qw = hi == 0 ? cvtpk(sl8, 0.f) : 0u;
    augk0 = __builtin_bit_cast(bf16x8, make_uint4(k0w, 0u, 0u, 0u)); augk1 = __builtin_bit_cast(bf16x8, make_uint4(k1w, 0u, 0u, 0u)); augq = __builtin_bit_cast(bf16x8, make_uint4(qw, 0u, 0u, 0u));
  }
  const int qrow = 32 * qg + r32;
  const char* qbase = Qs + qrow * 256;
  const int qsw = qrow & 15;
  float mref; bool loose;
  int* lflag = (int*)(lds + 131072);
  {
    float kn2 = 0.f;
    if (lane < 16) {
      const uint4* kp = (const uint4*)(proj + (rowb + lane) * INC + 512 + h * 128 + c * 64);
#pragma unroll
      for (int i = 0; i < 8; ++i) { const uint4 w = kp[i]; kn2 = dot8(w, w, kn2); }
    }
    kn2 = fmaxf(wave_max(kn2), __uint_as_float(kmax[b * 8 + h * 2 + c]));
    if (tid == 0) *lflag = 0;
    __syncthreads();
    float qn2 = 0.f;
#pragma unroll
    for (int ks = 0; ks < 4; ++ks) { const uint4 w = *(const uint4*)(qbase + (((c * 8 + ks * 2 + hi) ^ qsw) << 4)); qn2 = dot8(w, w, qn2); }
    qn2 = half_swap_sum(qn2);
    const float bound = sqrtf(qn2 * kn2) * 1.02f;
    mref = bound - 60.0f / (0.125f * 1.4426950408889634f);
    float sd = 0.f;
#pragma unroll
    for (int ks = 0; ks < 4; ++ks) {
      const uint4 wq = *(const uint4*)(qbase + (((c * 8 + ks * 2 + hi) ^ qsw) << 4));
      const uint4 wk = *(const uint4*)(proj + (rowb + qpos) * INC + 512 + h * 128 + (c * 8 + ks * 2 + hi) * 8);
      sd = dot8(wq, wk, sd);
    }
    sd = half_swap_sum(sd);
    loose = (bound - sd) * (0.125f * 1.4426950408889634f) > 170.0f;
  }
  uint4 pw[4];
  if (__any(loose) && lane == 0) *lflag = 1;
  __syncthreads();
  if (*lflag) {
    float mx = -1e30f; int sl = 0;
    for (int j = 0; j < NT; ++j) {
      asm volatile("s_waitcnt vmcnt(0)" ::: "memory");
      __syncthreads();
      if (j + 1 < NT) attn_issue_kv(KV + (sl == 2 ? 0 : sl + 1) * 32768, proj + (rowb + 64 * (j + 1)) * INC + h * 128, tid, wid);
      if (64 * j <= qw0 + 31) {
        const int kq = 64 * j + 4 * hi - qpos;
        if (64 * j + 63 > qw0) attn_qk<true, true>(pw, mx, qbase, qsw, KV + sl * 32768, c, kq, sl8, lane, r32, hi, augk0, augk1, augq);
        else attn_qk<false, true>(pw, mx, qbase, qsw, KV + sl * 32768, c, kq, sl8, lane, r32, hi, augk0, augk1, augq);
      }
      sl = (sl == 2 ? 0 : sl + 1);
    }
    mref = mx;
    __syncthreads();
    attn_issue_kv(KV, proj + rowb * INC + h * 128, tid, wid);
  }
  bool have = false;
  int slot = 0, pslot = 0;
  for (int j = 0; j <= NT; ++j) {
    if (j < NT) {
      asm volatile("s_waitcnt vmcnt(0)" ::: "memory");
      __syncthreads();
      if (j + 1 < NT) attn_issue_kv(KV + (slot == 2 ? 0 : slot + 1) * 32768, proj + (rowb + 64 * (j + 1)) * INC + h * 128, tid, wid);
    }
    if (have) { attn_pv(o, osum, pw, KV + pslot * 32768 + 16384, lane, hi); have = false; }
    if (j < NT && 64 * j <= qw0 + 31) {
      const char* kb = KV + slot * 32768;
      const int kq = 64 * j + 4 * hi - qpos;
      if (64 * j + 63 > qw0) attn_qk<true, false>(pw, mref, qbase, qsw, kb, c, kq, sl8, lane, r32, hi, augk0, augk1, augq);
      else attn_qk<false, false>(pw, mref, qbase, qsw, kb, c, kq, sl8, lane, r32, hi, augk0, augk1, augq);
      if (c == 0) attn_pv(o, osum, pw, kb + 16384, lane, hi); else have = true;
    }
    pslot = slot; slot = (slot == 2 ? 0 : slot + 1);
  }
  const float sc = (c == 0 ? 1.0f : lam) / osum[0];
  __syncthreads();
  float* X = (float*)(lds + 32768);
  if (c == 1) {
#pragma unroll
    for (int i = 0; i < 4; ++i)
#pragma unroll
      for (int r = 0; r < 16; ++r) X[(qg * 64 + i * 16 + r) * 64 + lane] = o[i][r] * sc;
  }
  __syncthreads();
  if (c == 0) {
    float ss = 0.f;
#pragma unroll
    for (int i = 0; i < 4; ++i) {
#pragma unroll
      for (int r = 0; r < 16; ++r) { float v = o[i][r] * sc - X[(qg * 64 + i * 16 + r) * 64 + lane]; o[i][r] = v; ss += v * v; }
      __builtin_amdgcn_sched_barrier(0);
    }
    ss = half_swap_sum(ss);
    const float rstd = rsqrtf(ss * (1.0f / 128.0f) + EPS) * (1.0f - LAM_INIT);
    bf16_t* orow = mix + (rowb + qpos) * D + h * 128;
#pragma unroll
    for (int i = 0; i < 4; ++i) {
#pragma unroll
      for (int g = 0; g < 4; ++g) {
        const int dv0 = 32 * i + 8 * g + 4 * hi;
        const float4 sg = *(const float4*)(subg + dv0);
        uint2 w; w.x = cvtpk(o[i][4 * g] * rstd * sg.x, o[i][4 * g + 1] * rstd * sg.y); w.y = cvtpk(o[i][4 * g + 2] * rstd * sg.z, o[i][4 * g + 3] * rstd * sg.w);
        *(uint2*)(orow + dv0) = w;
      }
      __builtin_amdgcn_sched_barrier(0);
    }
  }
}


__device__ __forceinline__ void p_norm1_rows(int G, const float* __restrict__ x, const float* __restrict__ meta, const float* __restrict__ g1, bf16_t* xn1) {
  const int tix = opaque_tid();
  const int lane = tix & 63, wv = blockIdx.x * 8 + (tix >> 6);
  float4 g[4];
#pragma unroll
  for (int q = 0; q < 4; ++q) g[q] = ((const float4*)g1)[q * 64 + lane];
  for (int row = wv * 2; row < ROWS; row += G * 16) {
    float4 v[2][4];
#pragma unroll
    for (int r = 0; r < 2; ++r) {
      const float* src = hrow_ptr(x, meta, row + r);
#pragma unroll
      for (int q = 0; q < 4; ++q) v[r][q] = src ? ((const float4*)src)[q * 64 + lane] : make_float4(0.f, 0.f, 0.f, 0.f);
    }
#pragma unroll
    for (int r = 0; r < 2; ++r) {
      float ss = 0.f;
#pragma unroll
      for (int q = 0; q < 4; ++q) ss += (v[r][q].x * v[r][q].x + v[r][q].y * v[r][q].y) + (v[r][q].z * v[r][q].z + v[r][q].w * v[r][q].w);
      const float rstd = rsqrtf(wave_sum(ss) * (1.0f / D) + EPS);
#pragma unroll
      for (int q = 0; q < 4; ++q) {
        uint2 o; o.x = cvtpk(v[r][q].x * rstd * g[q].x, v[r][q].y * rstd * g[q].y); o.y = cvtpk(v[r][q].z * rstd * g[q].z, v[r][q].w * rstd * g[q].w);
        ((uint2*)(xn1 + (size_t)(row + r) * D))[q * 64 + lane] = o;
      }
    }
  }
}

__device__ __forceinline__ void conv_unit(char* lds, const bf16_t* __restrict__ proj, bf16_t* mix, const float* __restrict__ cw, const float* __restrict__ cb,
                                          const float* __restrict__ gng, const float* __restrict__ gnb, int b, int pos0) {
  const int tix = opaque_tid();
  const int c = tix;
  float* U = (float*)lds;
  __syncthreads();
  {
    const int lane = tix & 63, wv = tix >> 6;
    uint4 ra[8], rg[8];
#pragma unroll
    for (int i = 0; i < 8; ++i) {
      const int r = wv + 8 * i, pos = pos0 - 30 + r;
      ra[i] = make_uint4(0, 0, 0, 0); rg[i] = make_uint4(0, 0, 0, 0);
      if (r < 62 && pos >= 0) {
        const bf16_t* pr = proj + ((size_t)b * LP + pos) * INC + 8 * lane;
        ra[i] = *(const uint4*)(pr + 1536); rg[i] = *(const uint4*)(pr + 2048);
      }
    }
#pragma unroll
    for (int i = 0; i < 8; ++i) {
      const int r = wv + 8 * i;
      if (r < 62) {
        const unsigned av[4] = {ra[i].x, ra[i].y, ra[i].z, ra[i].w}, gv[4] = {rg[i].x, rg[i].y, rg[i].z, rg[i].w};
        float u[8];
#pragma unroll
        for (int q = 0; q < 4; ++q) {
          const float a0 = __uint_as_float(av[q] << 16), a1 = __uint_as_float(av[q] & 0xffff0000u), g0 = __uint_as_float(gv[q] << 16), g1 = __uint_as_float(gv[q] & 0xffff0000u);
          u[2 * q] = a0 / (1.0f + __expf(-g0)); u[2 * q + 1] = a1 / (1.0f + __expf(-g1));
        }
        *(float4*)(U + r * 512 + 8 * lane) = make_float4(u[0], u[1], u[2], u[3]);
        *(float4*)(U + r * 512 + 8 * lane + 4) = make_float4(u[4], u[5], u[6], u[7]);
      }
    }
  }
  float w[31];
#pragma unroll
  for (int j = 0; j < 31; ++j) w[j] = cw[j * 512 + c];
  const float bias = cb[c], gg = gng[c], gb2 = gnb[c];
  __syncthreads();
#pragma unroll 1
  for (int t0 = 0; t0 < 32; t0 += 4) {
    float y[4] = {bias, bias, bias, bias};
#pragma unroll
    for (int r = 0; r < 34; ++r) {
      const float u = U[(t0 + r) * 512 + c];
#pragma unroll
      for (int q = 0; q < 4; ++q) { const int j = r - q; if (j >= 0 && j < 31) y[q] = fmaf(w[j], u, y[q]); }
    }
#pragma unroll
    for (int q = 0; q < 4; ++q) {
      float sm = row16_sum(y[q]);
      sm += __shfl_xor(sm, 16); sm = half_swap_sum(sm);
      const float d = y[q] - sm * (1.0f / 64.0f);
      float vr = row16_sum(d * d);
      vr += __shfl_xor(vr, 16); vr = half_swap_sum(vr);
      const float n = d * rsqrtf(vr * (1.0f / 64.0f) + EPS) * gg + gb2;
      mix[((size_t)b * LP + pos0 + t0 + q) * D + 512 + c] = f2bf(n / (1.0f + __expf(-n)));
    }
  }
}


__device__ __forceinline__ void ce_desc(float& a, float& b) { const float hi = fmaxf(a, b), lo = fminf(a, b); a = hi; b = lo; }
__device__ __forceinline__ void ce_asc(float& a, float& b) { const float hi = fmaxf(a, b), lo = fminf(a, b); a = lo; b = hi; }
template <int N> __device__ __forceinline__ void bitonic_sort_desc(float (&v)[N]) {
#pragma unroll
  for (int k = 2; k <= N; k <<= 1)
#pragma unroll
    for (int j = k >> 1; j > 0; j >>= 1)
#pragma unroll
      for (int i = 0; i < N; ++i) { const int l = i ^ j; if (l > i) { if ((i & k) == 0) ce_desc(v[i], v[l]); else ce_asc(v[i], v[l]); } }
}
template <int N> __device__ __forceinline__ void bitonic_merge_desc(float (&v)[N]) {
#pragma unroll
  for (int j = N >> 1; j > 0; j >>= 1)
#pragma unroll
    for (int i = 0; i < N; ++i) { const int l = i ^ j; if (l > i) ce_desc(v[i], v[l]); }
}
__host__ __device__ constexpr int cand_slot(int i, int j) { int s = 0; for (int ii = 0; ii < i; ++ii) s += 16 / (ii + 1); return s + j; }

__device__ __forceinline__ void peer_topk_unit(char* lds, const bf16_t* __restrict__ qp, const bf16_t* __restrict__ skb, const float* __restrict__ rowss, int* eb, float* gb, int row0, int h) {
  const int tix = opaque_tid();
  const int tid = tix, lane = tid & 63, wid = tid >> 6, fr = lane & 15, fq = lane >> 4;
  __syncthreads();
#pragma unroll
  for (int i = 0; i < 8; ++i) {
    const int g = i * 512 + tid, row = g >> 4, pos = g & 15;
    *(uint4*)(lds + g * 16) = *(const uint4*)(skb + ((size_t)(h * 2) * 128 + row) * 128 + ((pos ^ (row & 15)) << 3));
  }
  if (tid < 64) {
    int i = 0, base = 0;
    while (i < 15 && tid >= base + 16 / (i + 1)) { base += 16 / (i + 1); ++i; }
    ((int*)(lds + 65536))[tid] = (i << 4) | ((tid - base) & 15);
  }
  __syncthreads();
  const int tok = row0 + wid * 16 + fr;
  float top[2][16];
#pragma unroll
  for (int p = 0; p < 2; ++p) {
    f32x4 acc[8];
#pragma unroll
    for (int i = 0; i < 8; ++i) acc[i] = (f32x4){0.f, 0.f, 0.f, 0.f};
    const bf16_t* xrow = qp + (size_t)tok * 2048 + h * 256 + p * 128 + fq * 8;
#pragma unroll
    for (int ks = 0; ks < 4; ++ks) {
      const bf16x8 xb = *(const bf16x8*)(xrow + ks * 32);
      const int ch = ks * 4 + fq;
#pragma unroll
      for (int nt = 0; nt < 8; ++nt) {
        const int r = p * 128 + nt * 16 + fr;
        const bf16x8 wa = *(const bf16x8*)(lds + r * 256 + ((ch ^ (r & 15)) << 4));
        acc[nt] = __builtin_amdgcn_mfma_f32_16x16x32_bf16(wa, xb, acc[nt], 0, 0, 0);
      }
    }
    float v[32];
#pragma unroll
    for (int nt = 0; nt < 8; ++nt)
#pragma unroll
      for (int r = 0; r < 4; ++r) v[nt * 4 + r] = __uint_as_float((__float_as_uint(acc[nt][r]) & ~127u) | (unsigned)(nt * 16 + fq * 4 + r));
    bitonic_sort_desc<32>(v);
    float t[16];
#pragma unroll
    for (int i = 0; i < 16; ++i) t[i] = v[i];
#pragma unroll
    for (int rnd = 0; rnd < 2; ++rnd) {
      float pb[16];
#pragma unroll
      for (int i = 0; i < 16; ++i) pb[i] = __shfl_xor(t[15 - i], rnd == 0 ? 16 : 32);
#pragma unroll
      for (int i = 0; i < 16; ++i) t[i] = fmaxf(t[i], pb[i]);
      bitonic_merge_desc<16>(t);
    }
#pragma unroll
    for (int i = 0; i < 16; ++i) top[p][i] = t[i];
  }
  int* ST = (int*)(lds + 65536);
  int* IDX = (int*)(lds + 65536 + 256) + (wid * 16 + fr) * 32;
#define SEL4(arr, q) (fq == 0 ? arr[q] : fq == 1 ? arr[4 + (q)] : fq == 2 ? arr[8 + (q)] : arr[12 + (q)])
  {
    int4 ia, ib;
    ia.x = __float_as_uint(SEL4(top[0], 0)) & 127; ia.y = __float_as_uint(SEL4(top[0], 1)) & 127; ia.z = __float_as_uint(SEL4(top[0], 2)) & 127; ia.w = __float_as_uint(SEL4(top[0], 3)) & 127;
    ib.x = __float_as_uint(SEL4(top[1], 0)) & 127; ib.y = __float_as_uint(SEL4(top[1], 1)) & 127; ib.z = __float_as_uint(SEL4(top[1], 2)) & 127; ib.w = __float_as_uint(SEL4(top[1], 3)) & 127;
    *(int4*)(IDX + 4 * fq) = ia; *(int4*)(IDX + 16 + 4 * fq) = ib;
  }
  float cv[16];
  {
    const float NEGV = -3.0e38f;
    float am[16], bm[16];
#pragma unroll
    for (int i = 0; i < 16; ++i) { am[i] = __uint_as_float(__float_as_uint(top[0][i]) & ~127u); bm[i] = __uint_as_float(__float_as_uint(top[1][i]) & ~127u); }
#define CAND(i, j) __uint_as_float((__float_as_uint(am[i] + bm[j]) & ~63u) | (unsigned)cand_slot(i, j))
    float A[16], B[16], C[16], Dd[8], E[8], F[16];
#pragma unroll
    for (int j = 0; j < 16; ++j) A[j] = CAND(0, j);
#pragma unroll
    for (int j = 0; j < 8; ++j) { B[j] = CAND(1, j); B[15 - j] = CAND(8 + j, 0); }
    bitonic_merge_desc<16>(B);
#pragma unroll
    for (int j = 0; j < 5; ++j) C[j] = CAND(2, j);
#pragma unroll
    for (int j = 5; j < 12; ++j) C[j] = NEGV;
#pragma unroll
    for (int j = 0; j < 4; ++j) C[15 - j] = CAND(3, j);
    bitonic_merge_desc<16>(C);
    Dd[0] = CAND(4, 0); Dd[1] = CAND(4, 1); Dd[2] = CAND(4, 2); Dd[3] = NEGV; Dd[4] = NEGV; Dd[5] = NEGV; Dd[6] = CAND(5, 1); Dd[7] = CAND(5, 0);
    bitonic_merge_desc<8>(Dd);
    E[0] = CAND(6, 0); E[1] = CAND(6, 1); E[2] = NEGV; E[3] = NEGV; E[4] = NEGV; E[5] = NEGV; E[6] = CAND(7, 1); E[7] = CAND(7, 0);
    bitonic_merge_desc<8>(E);
#pragma unroll
    for (int j = 0; j < 8; ++j) { F[j] = Dd[j]; F[15 - j] = E[j]; }
    bitonic_merge_desc<16>(F);
#undef CAND
#pragma unroll
    for (int j = 0; j < 16; ++j) { A[j] = fmaxf(A[j], B[15 - j]); C[j] = fmaxf(C[j], F[15 - j]); }
    bitonic_merge_desc<16>(A);
    bitonic_merge_desc<16>(C);
#pragma unroll
    for (int j = 0; j < 16; ++j) cv[j] = fmaxf(A[j], C[15 - j]);
    bitonic_merge_desc<16>(cv);
  }
  float ex[16]; float sum = 0.f;
  const float c0v = __uint_as_float(__float_as_uint(cv[0]) & ~63u);
  const float rs = row_rstd(rowss, (size_t)tok);
#pragma unroll
  for (int i = 0; i < 16; ++i) { ex[i] = __expf((__uint_as_float(__float_as_uint(cv[i]) & ~63u) - c0v) * rs); sum += ex[i]; }
  const float inv = 1.0f / sum;
  int e4[4]; float g4[4];
#pragma unroll
  for (int q = 0; q < 4; ++q) {
    const int slot = __float_as_uint(SEL4(cv, q)) & 63;
    const int ij = ST[slot];
    e4[q] = IDX[ij >> 4] * 128 + IDX[16 + (ij & 15)];
    g4[q] = SEL4(ex, q) * inv;
  }
#undef SEL4
  *(int4*)(eb + ((size_t)tok * 8 + h) * 16 + 4 * fq) = make_int4(e4[0], e4[1], e4[2], e4[3]);
  *(float4*)(gb + ((size_t)tok * 8 + h) * 16 + 4 * fq) = make_float4(g4[0], g4[1], g4[2], g4[3]);
}

__device__ __forceinline__ void p_cvt_bf16(int blk, int nblk, const float* __restrict__ src, bf16_t* dst, size_t n8) {
  const int tix = opaque_tid();
  for (size_t i = (size_t)blk * 512 + tix; i < n8; i += (size_t)nblk * 512) {
    const float4 a = ((const float4*)src)[2 * i], b = ((const float4*)src)[2 * i + 1];
    uint4 w; w.x = cvtpk(a.x, a.y); w.y = cvtpk(a.z, a.w); w.z = cvtpk(b.x, b.y); w.w = cvtpk(b.z, b.w);
    ((uint4*)dst)[i] = w;
  }
}


typedef float f32x2v __attribute__((ext_vector_type(2)));
__device__ __forceinline__ void p_cvt_fp8_rows(int blk, int nblk, const float* __restrict__ src, unsigned* dst, float* inv, const float* __restrict__ csc) {
  const int tix = opaque_tid();
  const int lane = tix & 63, wid = tix >> 6;
  for (int r = blk * 8 + wid; r < 16384; r += nblk * 8) {
    const float4* sp = (const float4*)(src + (size_t)r * D);
    float4 v[4];
#pragma unroll
    for (int k = 0; k < 4; ++k) v[k] = sp[k * 64 + lane];
    if (csc) {
#pragma unroll
      for (int k = 0; k < 4; ++k) { const float4 g = ((const float4*)csc)[k * 64 + lane]; v[k].x *= g.x; v[k].y *= g.y; v[k].z *= g.z; v[k].w *= g.w; }
    }
    float am = 0.f;
#pragma unroll
    for (int k = 0; k < 4; ++k) am = fmaxf(am, fmaxf(fmaxf(fabsf(v[k].x), fabsf(v[k].y)), fmaxf(fabsf(v[k].z), fabsf(v[k].w))));
    am = wave_max(am);
    const float sc = am > 0.f ? 384.0f / am : 1.0f;
#pragma unroll
    for (int k = 0; k < 4; ++k) {
      int w = __builtin_amdgcn_cvt_pk_fp8_f32(v[k].x * sc, v[k].y * sc, 0, false);
      w = __builtin_amdgcn_cvt_pk_fp8_f32(v[k].z * sc, v[k].w * sc, w, true);
      { const int c = 256 * k + 4 * lane; dst[((size_t)(c >> 7) * (16384 * 128) + (size_t)r * 128 + (c & 127)) >> 2] = (unsigned)w; }
    }
    if (lane == 0) inv[r] = am > 0.f ? am * (1.0f / 384.0f) : 1.0f;
  }
}


__device__ __forceinline__ unsigned xcc_id() { return (unsigned)__builtin_amdgcn_s_getreg((3 << 11) | 20) & 7u; }

__device__ __forceinline__ void ds_issue(uint4 (&u)[16], const int* El  , const unsigned char* __restrict__ tab) {
  int ev[16];
#pragma unroll
  for (int q = 0; q < 4; ++q) { const int4 t = *(const int4*)(El + 4 * q); ev[4 * q] = t.x; ev[4 * q + 1] = t.y; ev[4 * q + 2] = t.z; ev[4 * q + 3] = t.w; }
#pragma unroll
  for (int it = 0; it < 16; ++it) u[it] = *(const uint4*)(tab + (size_t)(unsigned)ev[it] * 128);
}
__device__ __forceinline__ void ds_u_compute(const uint4 (&u)[16], const char* Xl  , float* __restrict__ pout, int j) {
  f32x2v xf[8];
  {
    const uint4 a = *(const uint4*)Xl, c = *(const uint4*)(Xl + 16);
    xf[0] = (f32x2v){__uint_as_float(a.x << 16), __uint_as_float(a.x & 0xffff0000u)}; xf[1] = (f32x2v){__uint_as_float(a.y << 16), __uint_as_float(a.y & 0xffff0000u)};
    xf[2] = (f32x2v){__uint_as_float(a.z << 16), __uint_as_float(a.z & 0xffff0000u)}; xf[3] = (f32x2v){__uint_as_float(a.w << 16), __uint_as_float(a.w & 0xffff0000u)};
    xf[4] = (f32x2v){__uint_as_float(c.x << 16), __uint_as_float(c.x & 0xffff0000u)}; xf[5] = (f32x2v){__uint_as_float(c.y << 16), __uint_as_float(c.y & 0xffff0000u)};
    xf[6] = (f32x2v){__uint_as_float(c.z << 16), __uint_as_float(c.z & 0xffff0000u)}; xf[7] = (f32x2v){__uint_as_float(c.w << 16), __uint_as_float(c.w & 0xffff0000u)};
  }
  float k0 = 0.f, k1 = 0.f;
#pragma unroll
  for (int it = 0; it < 16; ++it) {
    const unsigned wv[4] = {u[it].x, u[it].y, u[it].z, u[it].w};
    f32x2v d2 = {0.f, 0.f};
#pragma unroll
    for (int q = 0; q < 4; ++q) {
      const f32x2v lo = __builtin_amdgcn_cvt_pk_f32_fp8((int)wv[q], false), hi = __builtin_amdgcn_cvt_pk_f32_fp8((int)wv[q], true);
      d2 = __builtin_elementwise_fma(lo, xf[2 * q], d2); d2 = __builtin_elementwise_fma(hi, xf[2 * q + 1], d2);
    }
    const float d = sum8(d2.x + d2.y);
    if ((it >> 1) == j) { if (it & 1) k1 = d; else k0 = d; }
  }
  *(float2*)pout = make_float2(k0, k1);
}
__device__ __forceinline__ void ds_u_chunk(char* wl  , int lane, int tk0, int s, const bf16_t* __restrict__ xn2, const int* __restrict__ eb, const unsigned char* __restrict__ ut8, float* __restrict__ partial) {
  const int b = tk0 / SEQ, sq = tk0 - b * SEQ;
  const size_t row0 = (size_t)b * LP + NMETA + sq;
  const int j = lane & 7, gi = lane >> 3;
  int* El = (int*)wl;
  char* Xl = wl + 8192;
#pragma unroll
  for (int i = 0; i < 8; ++i) *(int4*)(El + (i * 64 + lane) * 4) = *(const int4*)(eb + row0 * 128 + (i * 64 + lane) * 4);
#pragma unroll
  for (int i = 0; i < 4; ++i) { const int g = i * 64 + lane, t = g >> 4, c = g & 15; *(uint4*)(Xl + g * 16) = *(const uint4*)(xn2 + (row0 + t) * D + 128 * s + 8 * c); }
  const unsigned char* tab = ut8 + (size_t)s * (16384 * 128) + 16 * j;
  float* pout = partial + ((size_t)tk0 * 8 + s) * 128 + gi * 16 + 2 * j;
  uint4 ua[16], ub[16];
  ds_issue(ua, El + gi * 16, tab);
#pragma unroll 1
  for (int t = 0; t < 16; t += 2) {
    ds_issue(ub, El + (t + 1) * 128 + gi * 16, tab);
    ds_u_compute(ua, Xl + t * 256 + 32 * j, pout + (size_t)t * 1024, j);
    if (t + 2 < 16) ds_issue(ua, El + (t + 2) * 128 + gi * 16, tab);
    ds_u_compute(ub, Xl + (t + 1) * 256 + 32 * j, pout + (size_t)(t + 1) * 1024, j);
  }
}

__device__ __forceinline__ void ds_v_compute(const uint4 (&v)[16], const float* Wl  , int lane, int j, int gi, size_t row, int tk, int s,
                                             const bf16_t* __restrict__ hb, float* __restrict__ out, float* __restrict__ ssq) {
  float w[16];
#pragma unroll
  for (int q = 0; q < 4; ++q) { const float4 f = *(const float4*)(Wl + 4 * q); w[4 * q] = f.x; w[4 * q + 1] = f.y; w[4 * q + 2] = f.z; w[4 * q + 3] = f.w; }
  f32x2v acc[8];
#pragma unroll
  for (int i = 0; i < 8; ++i) acc[i] = (f32x2v){0.f, 0.f};
#pragma unroll
  for (int it = 0; it < 16; ++it) {
    const unsigned wv[4] = {v[it].x, v[it].y, v[it].z, v[it].w};
    const f32x2v w2 = {w[it], w[it]};
#pragma unroll
    for (int q = 0; q < 4; ++q) {
      const f32x2v lo = __builtin_amdgcn_cvt_pk_f32_fp8((int)wv[q], false), hi = __builtin_amdgcn_cvt_pk_f32_fp8((int)wv[q], true);
      acc[2 * q] = __builtin_elementwise_fma(w2, lo, acc[2 * q]); acc[2 * q + 1] = __builtin_elementwise_fma(w2, hi, acc[2 * q + 1]);
    }
  }
  float r4[4] = {0.f, 0.f, 0.f, 0.f};
#pragma unroll
  for (int i = 0; i < 16; ++i) {
    float t = (i & 1) ? acc[i >> 1].y : acc[i >> 1].x;
    t = dpp_add<0x128>(t);
    t += __shfl_xor(t, 16);
    t = half_swap_sum(t);
    if ((i >> 2) == gi) r4[i & 3] = t;
  }
  float ss = 0.f;
  if (gi < 4) {
    const int c0 = 128 * s + 16 * j + 4 * gi;
    const uint2 hw = *(const uint2*)(hb + row * D + c0);
    const float4 o = make_float4(__uint_as_float(hw.x << 16) + r4[0], __uint_as_float(hw.x & 0xffff0000u) + r4[1], __uint_as_float(hw.y << 16) + r4[2], __uint_as_float(hw.y & 0xffff0000u) + r4[3]);
    ss = o.x * o.x + o.y * o.y + o.z * o.z + o.w * o.w;
    *(float4*)(out + (size_t)tk * D + c0) = o;
  }
  ss = wave_sum(ss);
  if (lane == 0) ssq[(size_t)tk * 8 + s] = ss;
}
__device__ __forceinline__ void ds_v_chunk(char* wl, int lane, int tk0, int s, const bf16_t* __restrict__ hb, const int* __restrict__ eb, const float* __restrict__ wbuf, const unsigned char* __restrict__ vt8,
                                           float* __restrict__ out, float* __restrict__ ssq) {
  const int b = tk0 / SEQ, sq = tk0 - b * SEQ;
  const size_t row0 = (size_t)b * LP + NMETA + sq;
  const int j = lane & 7, gi = lane >> 3;
  int* El = (int*)wl;
  float* Wl = (float*)(wl + 8192);
#pragma unroll
  for (int i = 0; i < 8; ++i) {
    *(int4*)(El + (i * 64 + lane) * 4) = *(const int4*)(eb + row0 * 128 + (i * 64 + lane) * 4);
    *(float4*)(Wl + (i * 64 + lane) * 4) = *(const float4*)(wbuf + (size_t)tk0 * 128 + (i * 64 + lane) * 4);
  }
  const unsigned char* tab = vt8 + (size_t)s * (16384 * 128) + 16 * j;
  uint4 va[16], vb[16];
  ds_issue(va, El + gi * 16, tab);
#pragma unroll 1
  for (int t = 0; t < 16; t += 2) {
    ds_issue(vb, El + (t + 1) * 128 + gi * 16, tab);
    ds_v_compute(va, Wl + t * 128 + gi * 16, lane, j, gi, row0 + t, tk0 + t, s, hb, out, ssq);
    if (t + 2 < 16) ds_issue(va, El + (t + 2) * 128 + gi * 16, tab);
    ds_v_compute(vb, Wl + (t + 1) * 128 + gi * 16, lane, j, gi, row0 + t + 1, tk0 + t + 1, s, hb, out, ssq);
  }
}


struct EpiBf16 {
  bf16_t* out; int ld; int use_scale; unsigned* kmax;
  __device__ __forceinline__ void store8(size_t row, int col, const float (&v)[8], float& tmax) const {
    if (kmax && col >= 512 && col < 1024) {
      float ss = 0.f;
#pragma unroll
      for (int i = 0; i < 8; ++i) ss += v[i] * v[i];
      tmax = fmaxf(tmax, sum8(ss));
    }
    uint4 w; w.x = cvtpk(v[0], v[1]); w.y = cvtpk(v[2], v[3]); w.z = cvtpk(v[4], v[5]); w.w = cvtpk(v[6], v[7]);
    *(uint4*)(out + row * ld + col) = w;
  }
  __device__ __forceinline__ void finish(float tmax, size_t row, int col) const {
    if (kmax && col >= 512 && col < 1024) {
      tmax = wave_max(tmax);
      if ((threadIdx.x & 63) == 0) atomicMax(kmax + (row / LP) * 8 + ((col - 512) >> 6), __float_as_uint(tmax));
    }
  }
};
struct EpiResid2 {
  const float* x; const float* meta; float* h2; bf16_t* hb; float* rowss;
  __device__ __forceinline__ void finish(float, size_t, int) const {}
  __device__ __forceinline__ void store8(size_t row, int col, const float (&v)[8], float&) const {
    const float* src = hrow_ptr(x, meta, (int)row);
    const float4 a = *(const float4*)(src + col), b = *(const float4*)(src + col + 4);
    const float o[8] = {a.x + v[0], a.y + v[1], a.z + v[2], a.w + v[3], b.x + v[4], b.y + v[5], b.z + v[6], b.w + v[7]};
    uint4 w; w.x = cvtpk(o[0], o[1]); w.y = cvtpk(o[2], o[3]); w.z = cvtpk(o[4], o[5]); w.w = cvtpk(o[6], o[7]);
    *(uint4*)(hb + row * D + col) = w;
    float ss = 0.f;
#pragma unroll
    for (int i = 0; i < 8; ++i) ss += o[i] * o[i];
    ss = sum8(ss);
    if ((threadIdx.x & 7) == 0) rowss[row * 16 + (col >> 6)] = ss;
  }
};

template <class Epi>
__device__ __forceinline__ void gemm256(char* lds, const bf16_t* __restrict__ X, int ldx, const bf16_t* __restrict__ Wt, int ldw, int K, size_t xrow0, int n0, const Epi& epi) {
  const int tix = opaque_tid();
  const int tid = tix, lane = tid & 63;
  const int wid = __builtin_amdgcn_readfirstlane(tid >> 6);
  const int wm = wid >> 2, wn = wid & 3;
  const int fr = lane & 15, fq = lane >> 4;
  f32x4 acc[4][8];
#pragma unroll
  for (int i = 0; i < 4; ++i)
#pragma unroll
    for (int j = 0; j < 8; ++j) acc[i][j] = (f32x4){0.f, 0.f, 0.f, 0.f};
  const int nk = K >> 6;
  const int prow = lane >> 3, ppos = lane & 7;
  const char* xsrc = (const char*)(X + (xrow0 + 8 * wid + prow) * ldx);
  const char* wsrc = (const char*)(Wt + (size_t)(n0 + 8 * wid + prow) * ldw);
  const unsigned swz = (unsigned)((ppos ^ ((4 * wid + (prow >> 1)) & 7)) << 4);
#define G256_ISSUE(kt, buf) do { \
    _Pragma("unroll") for (int i_ = 0; i_ < 4; ++i_) { \
      __builtin_amdgcn_global_load_lds((const unsigned*)(xsrc + (size_t)(64 * i_) * ldx * 2 + (kt) * 128 + swz), LDSP(unsigned, lds + (buf) * 65536 + (i_ * 8 + wid) * 1024), 16, 0, 0); \
      __builtin_amdgcn_global_load_lds((const unsigned*)(wsrc + (size_t)(64 * i_) * ldw * 2 + (kt) * 128 + swz), LDSP(unsigned, lds + (buf) * 65536 + 32768 + (i_ * 8 + wid) * 1024), 16, 0, 0); \
    } } while (0)
  __syncthreads();
  G256_ISSUE(0, 0);
  asm volatile("s_waitcnt vmcnt(0)" ::: "memory");
  __syncthreads();
  for (int kt = 0; kt < nk; ++kt) {
    if (kt + 1 < nk) G256_ISSUE(kt + 1, (kt + 1) & 1);
    const char* la = lds + (kt & 1) * 65536;
    const char* lb = la + 32768;
#pragma unroll
    for (int kk = 0; kk < 2; ++kk) {
      const int c = kk * 4 + fq;
      bf16x8 xa[8], wb[4];
#pragma unroll
      for (int t = 0; t < 8; ++t) { const int r = wm * 128 + t * 16 + fr; xa[t] = *(const bf16x8*)(la + r * 128 + ((c ^ ((r >> 1) & 7)) << 4)); }
#pragma unroll
      for (int t = 0; t < 4; ++t) { const int r = wn * 64 + t * 16 + fr; wb[t] = *(const bf16x8*)(lb + r * 128 + ((c ^ ((r >> 1) & 7)) << 4)); }
#pragma unroll
      for (int nt = 0; nt < 4; ++nt)
#pragma unroll
        for (int tt = 0; tt < 8; ++tt) acc[nt][tt] = __builtin_amdgcn_mfma_f32_16x16x32_bf16(wb[nt], xa[tt], acc[nt][tt], 0, 0, 0);
    }
    asm volatile("s_waitcnt vmcnt(0)" ::: "memory");
    __syncthreads();
  }
#undef G256_ISSUE
  char* wl = lds + wid * 16384;
  float tmax = 0.f;
#pragma unroll
  for (int hf = 0; hf < 2; ++hf) {
#pragma unroll
    for (int t4 = 0; t4 < 4; ++t4)
#pragma unroll
      for (int nt = 0; nt < 4; ++nt) {
        const int t = t4 * 16 + fr, c16 = nt * 4 + fq;
        *(f32x4*)(wl + t * 256 + ((c16 ^ (t & 15)) << 4)) = acc[nt][hf * 4 + t4];
      }
#pragma unroll
    for (int i = 0; i < 8; ++i) {
      const int t = 8 * i + (lane >> 3), c8 = lane & 7;
      const f32x4 v0 = *(const f32x4*)(wl + t * 256 + (((2 * c8) ^ (t & 15)) << 4)), v1 = *(const f32x4*)(wl + t * 256 + (((2 * c8 + 1) ^ (t & 15)) << 4));
      const float v[8] = {v0[0], v0[1], v0[2], v0[3], v1[0], v1[1], v1[2], v1[3]};
      epi.store8(xrow0 + wm * 128 + hf * 64 + t, n0 + wn * 64 + 8 * c8, v, tmax);
    }
  }
  epi.finish(tmax, xrow0, n0 + wn * 64);
}

__device__ __forceinline__ void meta_proj(char* lds, int blk, const bf16_t* __restrict__ xn1, const bf16_t* __restrict__ wt_in, bf16_t* proj) {
  const int tix = opaque_tid();
  float* red = (float*)lds;
  __syncthreads();
  float part = 0.f;
  const int o = tix % 160, kp = tix / 160;
  if (tix < 480) {
    const int row = o / 10, n = blk * 10 + o % 10;
    const int k0 = kp * 352, k1 = kp == 2 ? 1024 : k0 + 352;
    const bf16_t* xr = xn1 + (size_t)row * D; const bf16_t* wr = wt_in + (size_t)n * D;
    for (int k = k0; k < k1; k += 8) {
      const uint4 a = *(const uint4*)(xr + k), b = *(const uint4*)(wr + k);
      part = dot8(a, b, part);
    }
    red[tix] = part;
  }
  __syncthreads();
  if (tix < 160) {
    const float v = red[tix] + red[tix + 160] + red[tix + 320];
    const int row = tix / 10, n = blk * 10 + tix % 10;
    const bf16_t bv = f2bf(v);
#pragma unroll
    for (int b = 0; b < BATCH; ++b) proj[((size_t)b * LP + row) * INC + n] = bv;
  }
}

__device__ __forceinline__ void p_transpose(int t, float* smem, const float* __restrict__ W, bf16_t* Wt, int K, int N, const float* __restrict__ ksc) {
  const int tix = opaque_tid();
  float (*T)[65] = (float (*)[65])smem;
  const int nbx = N / 64, k0 = (t / nbx) * 64, n0 = (t % nbx) * 64, tid = (tix & 255);
  const int j = tid & 63, i0 = tid >> 6;
#pragma unroll
  for (int ii = 0; ii < 16; ++ii) { int i = i0 + 4 * ii; T[i][j] = W[(size_t)(k0 + i) * N + n0 + j] * (ksc ? ksc[k0 + i] : 1.0f); }
  __syncthreads();
#pragma unroll
  for (int ii = 0; ii < 16; ++ii) { int jj = i0 + 4 * ii; Wt[(size_t)(n0 + jj) * K + k0 + j] = f2bf(T[j][jj]); }
  __syncthreads();
}

#define XB_TMO      128
#define XB_XCNT(j)  (256  + 64 * (j))
#define XB_XSUB(j)  (1280 + 64 * (j))
#define XB_XGEN(j)  (2304 + 64 * (j))
#define XB_TOP      3328
#define XB_TOPGEN   3392
#define XCD_BAR_WORDS 3456
#define XB_SPIN_CAP (1u << 18)
#define LAS __attribute__((address_space(3)))

__device__ __forceinline__ unsigned xb_ld(unsigned* p)              { return __hip_atomic_load(p, __ATOMIC_RELAXED, __HIP_MEMORY_SCOPE_AGENT); }
__device__ __forceinline__ unsigned xb_add(unsigned* p, unsigned v) { return __hip_atomic_fetch_add(p, v, __ATOMIC_RELAXED, __HIP_MEMORY_SCOPE_AGENT); }
__device__ __forceinline__ unsigned xb_xcc_id() { return (unsigned)__builtin_amdgcn_s_getreg((3 << 11) | 20) & 0xFu; }
#define XB_SPIN(cond, bar) do { unsigned _sp = 0; while (cond) { __builtin_amdgcn_s_sleep(1); \
    if ((++_sp & 255u) == 0u) { if (xb_ld(&(bar)[XB_TMO])) break; if (_sp > XB_SPIN_CAP) { atomicAdd(&(bar)[XB_TMO], 1u); break; } } } } while (0)

struct XcdBarrier {
    unsigned* bar; unsigned x;
    volatile LAS unsigned* st;
};

__device__ __forceinline__ XcdBarrier xcd_barrier_post(unsigned* bar, volatile LAS unsigned* st) {
    XcdBarrier b; b.bar = bar; b.x = xb_xcc_id(); b.st = st;
    if (threadIdx.x == 0) (void)xb_add(&bar[XB_XCNT(b.x)], 1u);
    return b;
}
__device__ __forceinline__ void xcd_barrier_complete(unsigned* bar, unsigned x, unsigned& nloc, unsigned& nx) {
    const unsigned G = gridDim.x * gridDim.y * gridDim.z;
    unsigned sum, cnt, mine, sp = 0u;
    for (;;) {
        sum = 0u; cnt = 0u; mine = 0u;
#pragma unroll
        for (unsigned j = 0; j < 16; ++j) { const unsigned c = xb_ld(&bar[XB_XCNT(j)]); sum += c; cnt += (c > 0u) ? 1u : 0u; mine = (j == x) ? c : mine; }
        if (sum == G) break;
        __builtin_amdgcn_s_sleep(1);
        if ((++sp & 255u) == 0u) { if (xb_ld(&bar[XB_TMO])) break; if (sp > XB_SPIN_CAP) { atomicAdd(&bar[XB_TMO], 1u); break; } }
    }
    nloc = mine > 0u ? mine : 1u; nx = cnt > 0u ? cnt : 1u;
}

__device__ __forceinline__ void xcd_barrier(const XcdBarrier& b) {
    asm volatile("s_waitcnt vmcnt(0)" ::: "memory");
    __syncthreads();
    if (threadIdx.x == 0) {
        unsigned* bar = b.bar;
        __builtin_amdgcn_s_waitcnt(0);
        unsigned nloc = b.st[0], nx = b.st[1];
        if (nloc == 0u) { xcd_barrier_complete(bar, b.x, nloc, nx); b.st[0] = nloc; b.st[1] = nx; }
        const unsigned old = xb_add(&bar[XB_XSUB(b.x)], 1u);
        const unsigned gen = old / nloc;
        if (old + 1u == (gen + 1u) * nloc) {
            __builtin_amdgcn_fence(__ATOMIC_RELEASE, "agent");
            asm volatile("s_waitcnt vmcnt(0)" ::: "memory");
            const unsigned og = xb_add(&bar[XB_TOP], 1u);
            const unsigned tg = og / nx;
            if (og + 1u == (tg + 1u) * nx) xb_add(&bar[XB_TOPGEN], 1u);
            else XB_SPIN(xb_ld(&bar[XB_TOPGEN]) == tg, bar);
            __builtin_amdgcn_fence(__ATOMIC_ACQUIRE, "agent");
            xb_add(&bar[XB_XGEN(b.x)], 1u);
            asm volatile("s_waitcnt vmcnt(0)" ::: "memory");
        } else {
            XB_SPIN(xb_ld(&bar[XB_XGEN(b.x)]) == gen, bar);
            __builtin_amdgcn_fence(__ATOMIC_ACQUIRE, "agent");
            asm volatile("s_waitcnt vmcnt(0)" ::: "memory");
        }
    }
    __syncthreads();
}


struct Params {
  const float *x, *meta, *g1, *w_in, *lq1, *lk1, *lq2, *lk2, *subg, *conv_w, *conv_b, *gn_g, *gn_b, *w_out, *g2, *wq, *sk, *ut, *vt, *fg;
  float* out; float* scal; bf16_t* r1; bf16_t* r2; float* h2; int* eb; float* gb; bf16_t* wt_in; bf16_t* wt_out; bf16_t* wt_q; bf16_t* skb; unsigned char* ut8; unsigned char* vt8; float* uinv; float* vinv; float* wbuf; float* ssq; bf16_t* hb; float* rowss;
};

__global__ void __launch_bounds__(512, 2) mega(Params p) {
  cg::grid_group grid = cg::this_grid();
  __shared__ __attribute__((aligned(16))) char smem_c[131072 + 256];
  float* smem = (float*)smem_c;
  const int G = gridDim.x, vh = threadIdx.x >> 8;
  volatile LAS unsigned* xb_st = (volatile LAS unsigned*)(smem_c + 131072 + 16);
  if (threadIdx.x == 0) { xb_st[0] = 0u; xb_st[1] = 0u; }
  __syncthreads();
  const XcdBarrier xbar = xcd_barrier_post((unsigned*)(p.scal + 1024), xb_st);
  bf16_t* xn1 = p.r1; bf16_t* mix = p.r1; bf16_t* proj = p.r2; bf16_t* qp = p.r2;
  p_norm1_rows(G, p.x, p.meta, p.g1, xn1);
  if (blockIdx.x == 0 && threadIdx.x < 64) {
    const int t = threadIdx.x;
    const float a = wave_sum(p.lq1[t] * p.lk1[t]), b2 = wave_sum(p.lq2[t] * p.lk2[t]);
    if (t == 0) p.scal[0] = expf(a) - expf(b2) + LAM_INIT;
  }
  for (int b = blockIdx.x; b < (640 + 256 + 512) / 2; b += G) {
    const int bb = b * 2 + vh; float* sm = smem + vh * (64 * 65);
    if (bb < 640) p_transpose(bb, sm, p.w_in, p.wt_in, D, INC, nullptr);
    else if (bb < 896) p_transpose(bb - 640, sm, p.w_out, p.wt_out, D, D, nullptr);
    else p_transpose(bb - 896, sm, p.wq, p.wt_q, D, 2048, p.g2);
  }
  p_cvt_bf16(blockIdx.x, G, p.sk, p.skb, (size_t)16 * 128 * 128 / 8);
  p_cvt_fp8_rows(blockIdx.x, G, p.ut, (unsigned*)p.ut8, p.uinv, p.g2);
  p_cvt_fp8_rows(blockIdx.x, G, p.vt, (unsigned*)p.vt8, p.vinv, nullptr);
  grid.sync();
  for (int b = blockIdx.x; b < 128 * 10; b += G) {
    const int xi = (b >> 3), mt = (b & 7) * 16 + xi / 10, nt = xi % 10;
    gemm256(smem_c, xn1, D, p.wt_in, D, D, (size_t)(mt >> 4) * LP + NMETA + 256 * (mt & 15), nt * 256, EpiBf16{proj, INC, 0, (unsigned*)(p.scal + 640)});
  }
  for (int b = blockIdx.x; b < 256; b += G) meta_proj(smem_c, b, xn1, p.wt_in, proj);
  for (int i = blockIdx.x * 512 + threadIdx.x; i < BATCH * (LP - LREAL) * 128; i += G * 512) {
    const int c = i & 127, r = i >> 7, b = r / (LP - LREAL), pos = LREAL + r - b * (LP - LREAL);
    *(uint4*)(proj + ((size_t)b * LP + pos) * INC + 512 + 8 * c) = make_uint4(0, 0, 0, 0);
  }
  xcd_barrier(xbar);
  {
    const float lam = p.scal[0];
    for (int u = blockIdx.x; u < 256; u += G) {
      const int bh = (u & 7) * 4 + (u >> 6), tp = (u >> 3) & 7;
#pragma unroll 1
      for (int k = 0; k < 4; ++k) {
        const int t = (k == 0) ? 31 - tp : (k == 1) ? 16 + tp : (k == 2) ? 15 - tp : tp;
        attn_unit(smem_c, proj, mix, p.subg, (const unsigned*)(p.scal + 640), lam, bh >> 2, bh & 3, t);
      }
    }
  }
  for (int u = blockIdx.x; u < BATCH * 128; u += G) conv_unit(smem_c, proj, mix, p.conv_w, p.conv_b, p.gn_g, p.gn_b, u >> 7, NMETA + 32 * (u & 127));
  xcd_barrier(xbar);
  for (int b = blockIdx.x; b < 128 * 4; b += G) {
    const int xi = (b >> 3), mt = (b & 7) * 16 + (xi >> 2), nt = xi & 3;
    gemm256(smem_c, mix, D, p.wt_out, D, D, (size_t)(mt >> 4) * LP + NMETA + 256 * (mt & 15), nt * 256, EpiResid2{p.x, p.meta, p.h2, p.hb, p.rowss});
  }
  xcd_barrier(xbar);
  for (int b = blockIdx.x; b < 128 * 8; b += G) {
    const int xi = (b >> 3), mt = (b & 7) * 16 + (xi >> 3), nt = xi & 7;
    gemm256(smem_c, p.hb, D, p.wt_q, D, D, (size_t)(mt >> 4) * LP + NMETA + 256 * (mt & 15), nt * 256, EpiBf16{qp, 2048, 0, nullptr});
  }
  xcd_barrier(xbar);
  for (int u = blockIdx.x; u < 256 * 8; u += G) {
    const int rt = u >> 3, h = u & 7;
    peer_topk_unit(smem_c, qp, p.skb, p.rowss, p.eb, p.gb, (rt >> 5) * LP + NMETA + 128 * (rt & 31), h);
  }
  xcd_barrier(xbar);
  {
    const int tix = opaque_tid();
    const int lane = tix & 63;
    const int NTOK = BATCH * SEQ;
    float* partial = (float*)qp;
    unsigned* qh = (unsigned*)(p.scal + 128);
    const unsigned x = xcc_id();
    for (int qi = 0; qi < 8; ++qi) {
      const int s = (int)((x + qi) & 7u);
      for (;;) {
        unsigned st = 0;
        if (lane == 0) st = __hip_atomic_fetch_add(qh + s * 16, 16u, __ATOMIC_RELAXED, __HIP_MEMORY_SCOPE_AGENT);
        st = __builtin_amdgcn_readfirstlane(st);
        if (st >= (unsigned)NTOK) break;
        ds_u_chunk(smem_c + (tix >> 6) * 16384, lane, (int)st, s, p.hb, p.eb, p.ut8, partial);
      }
    }
    xcd_barrier(xbar);
    for (size_t i = (size_t)blockIdx.x * 512 + tix; i < (size_t)NTOK * 128; i += (size_t)G * 512) {
      const int tk = (int)(i >> 7), k = (int)(i & 127);
      const int b = tk / SEQ, sq = tk - b * SEQ;
      const size_t row = (size_t)b * LP + NMETA + sq;
      float a = 0.f;
#pragma unroll
      for (int sl = 0; sl < 8; ++sl) a += partial[((size_t)tk * 8 + sl) * 128 + k];
      const int e = p.eb[row * 128 + k];
      a *= p.uinv[e] * row_rstd(p.rowss, row);
      p.wbuf[i] = p.gb[row * 128 + k] * 0.5f * a * (1.0f + erff(a * 0.70710678118654752f)) * p.vinv[e];
    }
    xcd_barrier(xbar);
    for (int qi = 0; qi < 8; ++qi) {
      const int s = (int)((x + qi) & 7u);
      for (;;) {
        unsigned st = 0;
        if (lane == 0) st = __hip_atomic_fetch_add(qh + (8 + s) * 16, 16u, __ATOMIC_RELAXED, __HIP_MEMORY_SCOPE_AGENT);
        st = __builtin_amdgcn_readfirstlane(st);
        if (st >= (unsigned)NTOK) break;
        ds_v_chunk(smem_c + (tix >> 6) * 16384, lane, (int)st, s, p.hb, p.eb, p.wbuf, p.vt8, p.h2, p.ssq);
      }
    }
    xcd_barrier(xbar);
    {
      const int wv = blockIdx.x * 8 + (tix >> 6);
      for (int tk = wv * 2; tk < NTOK; tk += G * 16) {
        float4 o[2][4]; float sv[2];
#pragma unroll
        for (int r = 0; r < 2; ++r) {
#pragma unroll
          for (int q = 0; q < 4; ++q) o[r][q] = ((const float4*)p.h2)[(size_t)(tk + r) * 256 + q * 64 + lane];
          sv[r] = lane < 8 ? p.ssq[(size_t)(tk + r) * 8 + lane] : 0.f;
        }
#pragma unroll
        for (int r = 0; r < 2; ++r) {
          const float rstd = rsqrtf(wave_sum(sv[r]) * (1.0f / D) + EPS);
#pragma unroll
          for (int q = 0; q < 4; ++q) {
            const float4 f = ((const float4*)p.fg)[q * 64 + lane];
            float4 v = o[r][q];
            v.x *= rstd * f.x; v.y *= rstd * f.y; v.z *= rstd * f.z; v.w *= rstd * f.w;
            ((float4*)p.out)[(size_t)(tk + r) * 256 + q * 64 + lane] = v;
          }
        }
      }
    }
  }
}

extern "C" void kernel_launch(void* const* d_in, const int* in_sizes, int n_in, void* d_out, int out_size, void* d_ws, size_t ws_size, hipStream_t stream) {
  static int grid_blocks = 0;
  if (!grid_blocks) {
    int dev = 0, cus = 0, per_cu = 0;
    hipGetDevice(&dev);
    hipDeviceGetAttribute(&cus, hipDeviceAttributeMultiprocessorCount, dev);
    hipOccupancyMaxActiveBlocksPerMultiprocessor(&per_cu, mega, 512, 0);
    if (per_cu > 1) per_cu = 1;
    if (per_cu < 1) per_cu = 1;
    grid_blocks = cus * per_cu;
  }
  Params p{};
  const float** pp = (const float**)&p;
  for (int i = 0; i < 20; ++i) pp[i] = (const float*)d_in[i];
  p.out = (float*)d_out;
  char* ws = (char*)d_ws;
  size_t off = 0;
  p.scal = (float*)(ws + off); off += 32768;
  p.r1 = (bf16_t*)(ws + off); off += (size_t)ROWS * D * 2;
  p.r2 = (bf16_t*)(ws + off); off += (size_t)ROWS * INC * 2;
  p.h2 = (float*)(ws + off); off += (size_t)ROWS * D * 4;
  p.wt_in = (bf16_t*)(ws + off); off += (size_t)INC * D * 2;
  p.wt_out = (bf16_t*)(ws + off); off += (size_t)D * D * 2;
  p.wt_q = (bf16_t*)(ws + off); off += (size_t)2048 * D * 2;
  p.skb = (bf16_t*)(ws + off); off += (size_t)16 * 128 * 128 * 2;
  p.ut8 = (unsigned char*)(ws + off); off += (size_t)16384 * D;
  p.vt8 = (unsigned char*)(ws + off); off += (size_t)16384 * D;
  p.uinv = (float*)(ws + off); off += 65536;
  p.vinv = (float*)(ws + off); off += 65536;
  p.wbuf = (float*)(ws + off); off += (size_t)BATCH * SEQ * 128 * 4;
  p.ssq = (float*)(ws + off); off += (size_t)BATCH * SEQ * 8 * 4;
  p.hb = (bf16_t*)(ws + off); off += (size_t)ROWS * D * 2;
  p.rowss = (float*)(ws + off); off += (size_t)ROWS * 16 * 4;
  p.eb = (int*)((char*)p.r2 + (size_t)ROWS * 2048 * 2);
  p.gb = (float*)((char*)p.eb + (size_t)ROWS * 128 * 4);
  hipMemsetAsync(d_ws, 0, 32768, stream);
  void* args[] = {&p};
  hipError_t e = hipLaunchCooperativeKernel((void*)mega, dim3(grid_blocks), dim3(512), args, 0, stream);
  if (e != hipSuccess) fprintf(stderr, "cooperative launch failed: %s (grid %d)\n", hipGetErrorString(e), grid_blocks);
}
```

```cpp
#include <hip/hip_runtime.h>
#include <hip/hip_cooperative_groups.h>
#include <cstdio>
namespace cg = cooperative_groups;
#include <stdint.h>
#include <math.h>

typedef unsigned short bf16_t;
typedef short bf16x8 __attribute__((ext_vector_type(8)));
typedef float f32x4 __attribute__((ext_vector_type(4)));

constexpr int D = 1024, BATCH = 8, SEQ = 4096, NMETA = 16, LREAL = NMETA + SEQ  , LP = 4224, ROWS = BATCH * LP;
constexpr int INC = 2560;
constexpr float EPS = 1e-6f;
constexpr float LAM_INIT = 0.2f;

__device__ __forceinline__ float bf2f(unsigned v) { return __uint_as_float(v << 16); }
__device__ __forceinline__ bf16_t f2bf(float f) { unsigned u = __float_as_uint(f); u += 0x7fffu + ((u >> 16) & 1u); return (bf16_t)(u >> 16); }
__device__ __forceinline__ unsigned pack2(float a, float b) { return (unsigned)f2bf(a) | ((unsigned)f2bf(b) << 16); }

__device__ __forceinline__ float wave_sum(float v) {
#pragma unroll
  for (int o = 32; o >= 1; o >>= 1) v += __shfl_xor(v, o);
  return v;
}
__device__ __forceinline__ float wave_max(float v) {
#pragma unroll
  for (int o = 32; o >= 1; o >>= 1) v = fmaxf(v, __shfl_xor(v, o));
  return v;
}

template <int CTRL> __device__ __forceinline__ float dpp_add(float v) { return v + __builtin_bit_cast(float, __builtin_amdgcn_update_dpp(0, __builtin_bit_cast(int, v), CTRL, 0xf, 0xf, true)); }
__device__ __forceinline__ float sum8(float v) { v = dpp_add<0x141>(v); v = dpp_add<0xB1>(v); v = dpp_add<0x4E>(v); return v; }
typedef __bf16 bf16v2 __attribute__((ext_vector_type(2)));
__device__ __forceinline__ float dot8(uint4 a, uint4 b, float acc) {
  acc = __builtin_amdgcn_fdot2_f32_bf16(__builtin_bit_cast(bf16v2, a.x), __builtin_bit_cast(bf16v2, b.x), acc, false);
  acc = __builtin_amdgcn_fdot2_f32_bf16(__builtin_bit_cast(bf16v2, a.y), __builtin_bit_cast(bf16v2, b.y), acc, false);
  acc = __builtin_amdgcn_fdot2_f32_bf16(__builtin_bit_cast(bf16v2, a.z), __builtin_bit_cast(bf16v2, b.z), acc, false);
  acc = __builtin_amdgcn_fdot2_f32_bf16(__builtin_bit_cast(bf16v2, a.w), __builtin_bit_cast(bf16v2, b.w), acc, false);
  return acc;
}
__device__ __forceinline__ float row_rstd(const float* __restrict__ rowss, size_t row) {
  const float4 a = *(const float4*)(rowss + row * 16), b = *(const float4*)(rowss + row * 16 + 4), c = *(const float4*)(rowss + row * 16 + 8), d = *(const float4*)(rowss + row * 16 + 12);
  const float t = ((a.x + a.y) + (a.z + a.w)) + ((b.x + b.y) + (b.z + b.w)) + ((c.x + c.y) + (c.z + c.w)) + ((d.x + d.y) + (d.z + d.w));
  return rsqrtf(t * (1.0f / D) + EPS);
}
__device__ __forceinline__ float row16_sum(float v) {
  v += __builtin_bit_cast(float, __builtin_amdgcn_update_dpp(0, __builtin_bit_cast(int, v), 0x128, 0xf, 0xf, true));
  v += __builtin_bit_cast(float, __builtin_amdgcn_update_dpp(0, __builtin_bit_cast(int, v), 0x124, 0xf, 0xf, true));
  v += __builtin_bit_cast(float, __builtin_amdgcn_update_dpp(0, __builtin_bit_cast(int, v), 0x122, 0xf, 0xf, true));
  v += __builtin_bit_cast(float, __builtin_amdgcn_update_dpp(0, __builtin_bit_cast(int, v), 0x121, 0xf, 0xf, true));
  return v;
}
__device__ __forceinline__ int opaque_tid() { int t = threadIdx.x; asm volatile("" : "+v"(t)); return t; }

__device__ __forceinline__ const float* hrow_ptr(const float* x, const float* meta, int row) {
  int b = row / LP, pos = row - b * LP;
  if (pos < NMETA) return meta + (size_t)pos * D;
  if (pos < LREAL) return x + ((size_t)b * SEQ + (pos - NMETA)) * D;
  return nullptr;
}


typedef float f32x16 __attribute__((ext_vector_type(16)));
typedef short v4i16_t __attribute__((ext_vector_type(4)));
typedef __bf16 bf16v2_t __attribute__((ext_vector_type(2)));
typedef float f32x2_t __attribute__((ext_vector_type(2)));
#define LDSP(T, p) ((__attribute__((address_space(3))) T*)(p))
#define MFMA32(a, b, c) __builtin_amdgcn_mfma_f32_32x32x16_bf16((a), (b), (c), 0, 0, 0)
__device__ __forceinline__ unsigned cvtpk(float lo, float hi) { f32x2_t v = {lo, hi}; return __builtin_bit_cast(unsigned, __builtin_convertvector(v, bf16v2_t)); }
__device__ __forceinline__ float half_swap_max(float m) { auto rr = __builtin_amdgcn_permlane32_swap(__float_as_uint(m), __float_as_uint(m), false, false); return fmaxf(__uint_as_float(rr[0]), __uint_as_float(rr[1])); }
__device__ __forceinline__ float half_swap_sum(float m) { auto rr = __builtin_amdgcn_permlane32_swap(__float_as_uint(m), __float_as_uint(m), false, false); return __uint_as_float(rr[0]) + __uint_as_float(rr[1]); }

__device__ __forceinline__ void attn_issue_kv(char* kvbuf, const bf16_t* __restrict__ kvrow0  , int tid, int wid) {
  const char* base = (const char*)kvrow0;
#pragma unroll
  for (int i = 0; i < 2; ++i) {
    const int g = i * 512 + tid, row = g >> 4, pos = g & 15;
    const unsigned offk = (unsigned)(row * (INC * 2) + 1024 + ((pos ^ (row & 15)) << 4));
    const unsigned offv = (unsigned)(row * (INC * 2) + 2048 + ((pos ^ ((row & 3) << 2)) << 4));
    __builtin_amdgcn_global_load_lds((const unsigned*)(base + offk), LDSP(unsigned, kvbuf + (i * 512 + wid * 64) * 16), 16, 0, 0);
    __builtin_amdgcn_global_load_lds((const unsigned*)(base + offv), LDSP(unsigned, kvbuf + 16384 + (i * 512 + wid * 64) * 16), 16, 0, 0);
  }
}

template <bool MASKED, bool MAXONLY>
__device__ __forceinline__ void attn_qk(uint4 (&pw)[4], float& mref, const char* qbase, int qsw, const char* kb, int c, int kq, float sl8, int lane, int r32, int hi,
                                         const bf16x8& augk0, const bf16x8& augk1, const bf16x8& augq) {
  const float c1 = 0.125f * 1.4426950408889634f;
  asm volatile("" : "+v"(qsw), "+v"(lane));
  f32x16 s0, s1;
  float soff;
  if (MASKED) {
    const float a1 = sl8, a2 = 2.0f * sl8, a3 = 3.0f * sl8, b8 = 8.0f * sl8;
    float gb = sl8 * (float)kq;
#pragma unroll
    for (int g = 0; g < 4; ++g) { s0[4 * g] = gb; s0[4 * g + 1] = gb + a1; s0[4 * g + 2] = gb + a2; s0[4 * g + 3] = gb + a3; gb += b8; }
#pragma unroll
    for (int g = 0; g < 4; ++g) { s1[4 * g] = gb; s1[4 * g + 1] = gb + a1; s1[4 * g + 2] = gb + a2; s1[4 * g + 3] = gb + a3; gb += b8; }
#pragma unroll
    for (int r = 0; r < 16; ++r) { s0[r] = s0[r] > 0.f ? -1e30f : s0[r]; s1[r] = s1[r] > 0.f ? -1e30f : s1[r]; }
    soff = 0.f;
  } else {
#pragma unroll
    for (int r = 0; r < 16; ++r) { s0[r] = 0.f; s1[r] = 0.f; }
    s0 = MFMA32(augk0, augq, s0);
    s1 = MFMA32(augk1, augq, s1);
    soff = sl8 * (float)(kq - 4 * hi);
  }
#pragma unroll
  for (int ks = 0; ks < 4; ++ks) {
    const int ch = c * 8 + ks * 2 + hi;
    bf16x8 bq = *(const bf16x8*)(qbase + ((ch ^ qsw) << 4));
    bf16x8 ka0 = *(const bf16x8*)(kb + r32 * 256 + ((ch ^ qsw) << 4));
    bf16x8 ka1 = *(const bf16x8*)(kb + (32 + r32) * 256 + ((ch ^ qsw) << 4));
    s0 = MFMA32(ka0, bq, s0);
    s1 = MFMA32(ka1, bq, s1);
    __builtin_amdgcn_sched_barrier(0);
  }
  if (MAXONLY) {
    float m0 = fmaxf(s0[0], s1[0]), m1 = fmaxf(s0[1], s1[1]), m2 = fmaxf(s0[2], s1[2]), m3 = fmaxf(s0[3], s1[3]);
#pragma unroll
    for (int r = 4; r < 16; r += 4) {
      m0 = fmaxf(fmaxf(m0, s0[r]), s1[r]); m1 = fmaxf(fmaxf(m1, s0[r + 1]), s1[r + 1]); m2 = fmaxf(fmaxf(m2, s0[r + 2]), s1[r + 2]); m3 = fmaxf(fmaxf(m3, s0[r + 3]), s1[r + 3]);
    }
    mref = fmaxf(mref, half_swap_max(fmaxf(fmaxf(m0, m1), fmaxf(m2, m3))) + soff);
    return;
  }
  const f32x2_t c1v = {c1, c1}, nmv = {(soff - mref) * c1, (soff - mref) * c1};
#pragma unroll
  for (int r = 0; r < 16; r += 2) {
    f32x2_t x0 = {s0[r], s0[r + 1]}, x1 = {s1[r], s1[r + 1]};
    x0 = __builtin_elementwise_fma(x0, c1v, nmv); x1 = __builtin_elementwise_fma(x1, c1v, nmv);
    x0.x = __builtin_amdgcn_exp2f(x0.x); x0.y = __builtin_amdgcn_exp2f(x0.y); x1.x = __builtin_amdgcn_exp2f(x1.x); x1.y = __builtin_amdgcn_exp2f(x1.y);
    s0[r] = x0.x; s0[r + 1] = x0.y; s1[r] = x1.x; s1[r + 1] = x1.y;
  }
#pragma unroll
  for (int kk = 0; kk < 2; ++kk) {
    pw[kk] = make_uint4(cvtpk(s0[8 * kk], s0[8 * kk + 1]), cvtpk(s0[8 * kk + 2], s0[8 * kk + 3]), cvtpk(s0[8 * kk + 4], s0[8 * kk + 5]), cvtpk(s0[8 * kk + 6], s0[8 * kk + 7]));
    pw[2 + kk] = make_uint4(cvtpk(s1[8 * kk], s1[8 * kk + 1]), cvtpk(s1[8 * kk + 2], s1[8 * kk + 3]), cvtpk(s1[8 * kk + 4], s1[8 * kk + 5]), cvtpk(s1[8 * kk + 6], s1[8 * kk + 7]));
  }
}

__device__ __forceinline__ void attn_pv(f32x16 (&o)[4], f32x16& osum, const uint4 (&pw)[4], const char* vb, int lane, int hi) {
  asm volatile("" : "+v"(lane));
  const int q4 = (lane & 15) >> 2, g1 = (lane >> 4) & 1, p4 = lane & 3;
#pragma unroll
  for (int kk = 0; kk < 4; ++kk) {
    const int key0 = 16 * kk + 4 * hi + q4;
    const bf16x8 pb = __builtin_bit_cast(bf16x8, pw[kk]);
    osum = MFMA32(__builtin_bit_cast(bf16x8, make_uint4(0x3F803F80u, 0x3F803F80u, 0x3F803F80u, 0x3F803F80u)), pb, osum);
#pragma unroll
    for (int dvt = 0; dvt < 4; ++dvt) {
      const int c8 = 8 * (dvt ^ q4) + 4 * g1 + p4;
      v4i16_t lo = __builtin_amdgcn_ds_read_tr16_b64_v4i16(LDSP(v4i16_t, vb + key0 * 256 + c8 * 8));
      v4i16_t hi4 = __builtin_amdgcn_ds_read_tr16_b64_v4i16(LDSP(v4i16_t, vb + (key0 + 8) * 256 + c8 * 8));
      bf16x8 va = (bf16x8){lo[0], lo[1], lo[2], lo[3], hi4[0], hi4[1], hi4[2], hi4[3]};
      o[dvt] = MFMA32(va, pb, o[dvt]);
    }
    __builtin_amdgcn_sched_barrier(0);
  }
}

__device__ __forceinline__ void attn_unit(char* lds, const bf16_t* __restrict__ proj, bf16_t* mix, const float* __restrict__ subg, const unsigned* __restrict__ kmax, float lam, int b, int h, int t) {
  const int tix = opaque_tid();
  const int tid = tix, lane = tid & 63, r32 = lane & 31, hi = lane >> 5;
  const int wid = __builtin_amdgcn_readfirstlane(tid >> 6);
  const int c = wid >> 2, qg = wid & 3;
  const int q0 = NMETA + 128 * t, qw0 = q0 + 32 * qg, qpos = qw0 + r32;
  const size_t rowb = (size_t)b * LP;
  const int NT = 2 * t + 3;
  char* Qs = lds;
  char* KV = lds + 32768;
  const float sl8 = exp2f(1.0f - 2.0f * (float)h);
  __syncthreads();
  attn_issue_kv(KV, proj + rowb * INC + h * 128, tid, wid);
#pragma unroll
  for (int i = 0; i < 4; ++i) {
    const int g = i * 512 + tid, row = g >> 4, pos = g & 15;
    uint4 v = *(const uint4*)(proj + (rowb + q0 + row) * INC + h * 128 + ((pos ^ (row & 15)) << 3));
    *(uint4*)(Qs + g * 16) = v;
  }
  f32x16 o[4];
#pragma unroll
  for (int i = 0; i < 4; ++i)
#pragma unroll
    for (int r = 0; r < 16; ++r) o[i][r] = 0.f;
  f32x16 osum;
#pragma unroll
  for (int r = 0; r < 16; ++r) osum[r] = 0.f;
  bf16x8 augk0, augk1, augq;
  {
    const unsigned k0w = hi == 0 ? cvtpk((float)r32, 0.f) : 0u, k1w = hi == 0 ? cvtpk((float)(32 + r32), 0.f) : 0u, qw = hi == 0 ? cvtpk(sl8, 0.f) : 0u;
    augk0 = __builtin_bit_cast(bf16x8, make_uint4(k0w, 0u, 0u, 0u)); augk1 = __builtin_bit_cast(bf16x8, make_uint4(k1w, 0u, 0u, 0u)); augq = __builtin_bit_cast(bf16x8, make_uint4(qw, 0u, 0u, 0u));
  }
  const int qrow = 32 * qg + r32;
  const char* qbase = Qs + qrow * 256;
  const int qsw = qrow & 15;
  float mref; bool loose;
  int* lflag = (int*)(lds + 131072);
  {
    float kn2 = 0.f;
    if (lane < 16) {
      const uint4* kp = (const uint4*)(proj + (rowb + lane) * INC + 512 + h * 128 + c * 64);
#pragma unroll
      for (int i = 0; i < 8; ++i) { const uint4 w = kp[i]; kn2 = dot8(w, w, kn2); }
    }
    kn2 = fmaxf(wave_max(kn2), __uint_as_float(kmax[b * 8 + h * 2 + c]));
    if (tid == 0) *lflag = 0;
    __syncthreads();
    float qn2 = 0.f;
#pragma unroll
    for (int ks = 0; ks < 4; ++ks) { const uint4 w = *(const uint4*)(qbase + (((c * 8 + ks * 2 + hi) ^ qsw) << 4)); qn2 = dot8(w, w, qn2); }
    qn2 = half_swap_sum(qn2);
    const float bound = sqrtf(qn2 * kn2) * 1.02f;
    mref = bound - 60.0f / (0.125f * 1.4426950408889634f);
    float sd = 0.f;
#pragma unroll
    for (int ks = 0; ks < 4; ++ks) {
      const uint4 wq = *(const uint4*)(qbase + (((c * 8 + ks * 2 + hi) ^ qsw) << 4));
      const uint4 wk = *(const uint4*)(proj + (rowb + qpos) * INC + 512 + h * 128 + (c * 8 + ks * 2 + hi) * 8);
      sd = dot8(wq, wk, sd);
    }
    sd = half_swap_sum(sd);
    loose = (bound - sd) * (0.125f * 1.4426950408889634f) > 170.0f;
  }
  uint4 pw[4];
  if (__any(loose) && lane == 0) *lflag = 1;
  __syncthreads();
  if (*lflag) {
    float mx = -1e30f; int sl = 0;
    for (int j = 0; j < NT; ++j) {
      asm volatile("s_waitcnt vmcnt(0)" ::: "memory");
      __syncthreads();
      if (j + 1 < NT) attn_issue_kv(KV + (sl == 2 ? 0 : sl + 1) * 32768, proj + (rowb + 64 * (j + 1)) * INC + h * 128, tid, wid);
      if (64 * j <= qw0 + 31) {
        const int kq = 64 * j + 4 * hi - qpos;
        if (64 * j + 63 > qw0) attn_qk<true, true>(pw, mx, qbase, qsw, KV + sl * 32768, c, kq, sl8, lane, r32, hi, augk0, augk1, augq);
        else attn_qk<false, true>(pw, mx, qbase, qsw, KV + sl * 32768, c, kq, sl8, lane, r32, hi, augk0, augk1, augq);
      }
      sl = (sl == 2 ? 0 : sl + 1);
    }
    mref = mx;
    __syncthreads();
    attn_issue_kv(KV, proj + rowb * INC + h * 128, tid, wid);
  }
  bool have = false;
  int slot = 0, pslot = 0;
  for (int j = 0; j <= NT; ++j) {
    if (j < NT) {
      asm volatile("s_waitcnt vmcnt(0)" ::: "memory");
      __syncthreads();
      if (j + 1 < NT) attn_issue_kv(KV + (slot == 2 ? 0 : slot + 1) * 32768, proj + (rowb + 64 * (j + 1)) * INC + h * 128, tid, wid);
    }
    if (have) { attn_pv(o, osum, pw, KV + pslot * 32768 + 16384, lane, hi); have = false; }
    if (j < NT && 64 * j <= qw0 + 31) {
      const char* kb = KV + slot * 32768;
      const int kq = 64 * j + 4 * hi - qpos;
      if (64 * j + 63 > qw0) attn_qk<true, false>(pw, mref, qbase, qsw, kb, c, kq, sl8, lane, r32, hi, augk0, augk1, augq);
      else attn_qk<false, false>(pw, mref, qbase, qsw, kb, c, kq, sl8, lane, r32, hi, augk0, augk1, augq);
      if (c == 0) attn_pv(o, osum, pw, kb + 16384, lane, hi); else have = true;
    }
    pslot = slot; slot = (slot == 2 ? 0 : slot + 1);
  }
  const float sc = (c == 0 ? 1.0f : lam) / osum[0];
  __syncthreads();
  float* X = (float*)(lds + 32768);
  if (c == 1) {
#pragma unroll
    for (int i = 0; i < 4; ++i)
#pragma unroll
      for (int r = 0; r < 16; ++r) X[(qg * 64 + i * 16 + r) * 64 + lane] = o[i][r] * sc;
  }
  __syncthreads();
  if (c == 0) {
    float ss = 0.f;
#pragma unroll
    for (int i = 0; i < 4; ++i) {
#pragma unroll
      for (int r = 0; r < 16; ++r) { float v = o[i][r] * sc - X[(qg * 64 + i * 16 + r) * 64 + lane]; o[i][r] = v; ss += v * v; }
      __builtin_amdgcn_sched_barrier(0);
    }
    ss = half_swap_sum(ss);
    const float rstd = rsqrtf(ss * (1.0f / 128.0f) + EPS) * (1.0f - LAM_INIT);
    bf16_t* orow = mix + (rowb + qpos) * D + h * 128;
#pragma unroll
    for (int i = 0; i < 4; ++i) {
#pragma unroll
      for (int g = 0; g < 4; ++g) {
        const int dv0 = 32 * i + 8 * g + 4 * hi;
        const float4 sg = *(const float4*)(subg + dv0);
        uint2 w; w.x = cvtpk(o[i][4 * g] * rstd * sg.x, o[i][4 * g + 1] * rstd * sg.y); w.y = cvtpk(o[i][4 * g + 2] * rstd * sg.z, o[i][4 * g + 3] * rstd * sg.w);
        *(uint2*)(orow + dv0) = w;
      }
      __builtin_amdgcn_sched_barrier(0);
    }
  }
}


__device__ __forceinline__ void p_norm1_rows(int G, const float* __restrict__ x, const float* __restrict__ meta, const float* __restrict__ g1, bf16_t* xn1) {
  const int tix = opaque_tid();
  const int lane = tix & 63, wv = blockIdx.x * 8 + (tix >> 6);
  float4 g[4];
#pragma unroll
  for (int q = 0; q < 4; ++q) g[q] = ((const float4*)g1)[q * 64 + lane];
  for (int row = wv * 2; row < ROWS; row += G * 16) {
    float4 v[2][4];
#pragma unroll
    for (int r = 0; r < 2; ++r) {
      const float* src = hrow_ptr(x, meta, row + r);
#pragma unroll
      for (int q = 0; q < 4; ++q) v[r][q] = src ? ((const float4*)src)[q * 64 + lane] : make_float4(0.f, 0.f, 0.f, 0.f);
    }
#pragma unroll
    for (int r = 0; r < 2; ++r) {
      float ss = 0.f;
#pragma unroll
      for (int q = 0; q < 4; ++q) ss += (v[r][q].x * v[r][q].x + v[r][q].y * v[r][q].y) + (v[r][q].z * v[r][q].z + v[r][q].w * v[r][q].w);
      const float rstd = rsqrtf(wave_sum(ss) * (1.0f / D) + EPS);
#pragma unroll
      for (int q = 0; q < 4; ++q) {
        uint2 o; o.x = cvtpk(v[r][q].x * rstd * g[q].x, v[r][q].y * rstd * g[q].y); o.y = cvtpk(v[r][q].z * rstd * g[q].z, v[r][q].w * rstd * g[q].w);
        ((uint2*)(xn1 + (size_t)(row + r) * D))[q * 64 + lane] = o;
      }
    }
  }
}

__device__ __forceinline__ void conv_unit(char* lds, const bf16_t* __restrict__ proj, bf16_t* mix, const float* __restrict__ cw, const float* __restrict__ cb,
                                          const float* __restrict__ gng, const float* __restrict__ gnb, int b, int pos0) {
  const int tix = opaque_tid();
  const int c = tix;
  float* U = (float*)lds;
  __syncthreads();
  {
    const int lane = tix & 63, wv = tix >> 6;
    uint4 ra[8], rg[8];
#pragma unroll
    for (int i = 0; i < 8; ++i) {
      const int r = wv + 8 * i, pos = pos0 - 30 + r;
      ra[i] = make_uint4(0, 0, 0, 0); rg[i] = make_uint4(0, 0, 0, 0);
      if (r < 62 && pos >= 0) {
        const bf16_t* pr = proj + ((size_t)b * LP + pos) * INC + 8 * lane;
        ra[i] = *(const uint4*)(pr + 1536); rg[i] = *(const uint4*)(pr + 2048);
      }
    }
#pragma unroll
    for (int i = 0; i < 8; ++i) {
      const int r = wv + 8 * i;
      if (r < 62) {
        const unsigned av[4] = {ra[i].x, ra[i].y, ra[i].z, ra[i].w}, gv[4] = {rg[i].x, rg[i].y, rg[i].z, rg[i].w};
        float u[8];
#pragma unroll
        for (int q = 0; q < 4; ++q) {
          const float a0 = __uint_as_float(av[q] << 16), a1 = __uint_as_float(av[q] & 0xffff0000u), g0 = __uint_as_float(gv[q] << 16), g1 = __uint_as_float(gv[q] & 0xffff0000u);
          u[2 * q] = a0 / (1.0f + __expf(-g0)); u[2 * q + 1] = a1 / (1.0f + __expf(-g1));
        }
        *(float4*)(U + r * 512 + 8 * lane) = make_float4(u[0], u[1], u[2], u[3]);
        *(float4*)(U + r * 512 + 8 * lane + 4) = make_float4(u[4], u[5], u[6], u[7]);
      }
    }
  }
  float w[31];
#pragma unroll
  for (int j = 0; j < 31; ++j) w[j] = cw[j * 512 + c];
  const float bias = cb[c], gg = gng[c], gb2 = gnb[c];
  __syncthreads();
#pragma unroll 1
  for (int t0 = 0; t0 < 32; t0 += 4) {
    float y[4] = {bias, bias, bias, bias};
#pragma unroll
    for (int r = 0; r < 34; ++r) {
      const float u = U[(t0 + r) * 512 + c];
#pragma unroll
      for (int q = 0; q < 4; ++q) { const int j = r - q; if (j >= 0 && j < 31) y[q] = fmaf(w[j], u, y[q]); }
    }
#pragma unroll
    for (int q = 0; q < 4; ++q) {
      float sm = row16_sum(y[q]);
      sm += __shfl_xor(sm, 16); sm = half_swap_sum(sm);
      const float d = y[q] - sm * (1.0f / 64.0f);
      float vr = row16_sum(d * d);
      vr += __shfl_xor(vr, 16); vr = half_swap_sum(vr);
      const float n = d * rsqrtf(vr * (1.0f / 64.0f) + EPS) * gg + gb2;
      mix[((size_t)b * LP + pos0 + t0 + q) * D + 512 + c] = f2bf(n / (1.0f + __expf(-n)));
    }
  }
}


__device__ __forceinline__ void ce_desc(float& a, float& b) { const float hi = fmaxf(a, b), lo = fminf(a, b); a = hi; b = lo; }
__device__ __forceinline__ void ce_asc(float& a, float& b) { const float hi = fmaxf(a, b), lo = fminf(a, b); a = lo; b = hi; }
template <int N> __device__ __forceinline__ void bitonic_sort_desc(float (&v)[N]) {
#pragma unroll
  for (int k = 2; k <= N; k <<= 1)
#pragma unroll
    for (int j = k >> 1; j > 0; j >>= 1)
#pragma unroll
      for (int i = 0; i < N; ++i) { const int l = i ^ j; if (l > i) { if ((i & k) == 0) ce_desc(v[i], v[l]); else ce_asc(v[i], v[l]); } }
}
template <int N> __device__ __forceinline__ void bitonic_merge_desc(float (&v)[N]) {
#pragma unroll
  for (int j = N >> 1; j > 0; j >>= 1)
#pragma unroll
    for (int i = 0; i < N; ++i) { const int l = i ^ j; if (l > i) ce_desc(v[i], v[l]); }
}
__host__ __device__ constexpr int cand_slot(int i, int j) { int s = 0; for (int ii = 0; ii < i; ++ii) s += 16 / (ii + 1); return s + j; }

__device__ __forceinline__ void peer_topk_unit(char* lds, const bf16_t* __restrict__ qp, const bf16_t* __restrict__ skb, const float* __restrict__ rowss, int* eb, float* gb, int row0, int h) {
  const int tix = opaque_tid();
  const int tid = tix, lane = tid & 63, wid = tid >> 6, fr = lane & 15, fq = lane >> 4;
  __syncthreads();
#pragma unroll
  for (int i = 0; i < 8; ++i) {
    const int g = i * 512 + tid, row = g >> 4, pos = g & 15;
    *(uint4*)(lds + g * 16) = *(const uint4*)(skb + ((size_t)(h * 2) * 128 + row) * 128 + ((pos ^ (row & 15)) << 3));
  }
  if (tid < 64) {
    int i = 0, base = 0;
    while (i < 15 && tid >= base + 16 / (i + 1)) { base += 16 / (i + 1); ++i; }
    ((int*)(lds + 65536))[tid] = (i << 4) | ((tid - base) & 15);
  }
  __syncthreads();
  const int tok = row0 + wid * 16 + fr;
  float top[2][16];
#pragma unroll
  for (int p = 0; p < 2; ++p) {
    f32x4 acc[8];
#pragma unroll
    for (int i = 0; i < 8; ++i) acc[i] = (f32x4){0.f, 0.f, 0.f, 0.f};
    const bf16_t* xrow = qp + (size_t)tok * 2048 + h * 256 + p * 128 + fq * 8;
#pragma unroll
    for (int ks = 0; ks < 4; ++ks) {
      const bf16x8 xb = *(const bf16x8*)(xrow + ks * 32);
      const int ch = ks * 4 + fq;
#pragma unroll
      for (int nt = 0; nt < 8; ++nt) {
        const int r = p * 128 + nt * 16 + fr;
        const bf16x8 wa = *(const bf16x8*)(lds + r * 256 + ((ch ^ (r & 15)) << 4));
        acc[nt] = __builtin_amdgcn_mfma_f32_16x16x32_bf16(wa, xb, acc[nt], 0, 0, 0);
      }
    }
    float v[32];
#pragma unroll
    for (int nt = 0; nt < 8; ++nt)
#pragma unroll
      for (int r = 0; r < 4; ++r) v[nt * 4 + r] = __uint_as_float((__float_as_uint(acc[nt][r]) & ~127u) | (unsigned)(nt * 16 + fq * 4 + r));
    bitonic_sort_desc<32>(v);
    float t[16];
#pragma unroll
    for (int i = 0; i < 16; ++i) t[i] = v[i];
#pragma unroll
    for (int rnd = 0; rnd < 2; ++rnd) {
      float pb[16];
#pragma unroll
      for (int i = 0; i < 16; ++i) pb[i] = __shfl_xor(t[15 - i], rnd == 0 ? 16 : 32);
#pragma unroll
      for (int i = 0; i < 16; ++i) t[i] = fmaxf(t[i], pb[i]);
      bitonic_merge_desc<16>(t);
    }
#pragma unroll
    for (int i = 0; i < 16; ++i) top[p][i] = t[i];
  }
  int* ST = (int*)(lds + 65536);
  int* IDX = (int*)(lds + 65536 + 256) + (wid * 16 + fr) * 32;
#define SEL4(arr, q) (fq == 0 ? arr[q] : fq == 1 ? arr[4 + (q)] : fq == 2 ? arr[8 + (q)] : arr[12 + (q)])
  {
    int4 ia, ib;
    ia.x = __float_as_uint(SEL4(top[0], 0)) & 127; ia.y = __float_as_uint(SEL4(top[0], 1)) & 127; ia.z = __float_as_uint(SEL4(top[0], 2)) & 127; ia.w = __float_as_uint(SEL4(top[0], 3)) & 127;
    ib.x = __float_as_uint(SEL4(top[1], 0)) & 127; ib.y = __float_as_uint(SEL4(top[1], 1)) & 127; ib.z = __float_as_uint(SEL4(top[1], 2)) & 127; ib.w = __float_as_uint(SEL4(top[1], 3)) & 127;
    *(int4*)(IDX + 4 * fq) = ia; *(int4*)(IDX + 16 + 4 * fq) = ib;
  }
  float cv[16];
  {
    const float NEGV = -3.0e38f;
    float am[16], bm[16];
#pragma unroll
    for (int i = 0; i < 16; ++i) { am[i] = __uint_as_float(__float_as_uint(top[0][i]) & ~127u); bm[i] = __uint_as_float(__float_as_uint(top[1][i]) & ~127u); }
#define CAND(i, j) __uint_as_float((__float_as_uint(am[i] + bm[j]) & ~63u) | (unsigned)cand_slot(i, j))
    float A[16], B[16], C[16], Dd[8], E[8], F[16];
#pragma unroll
    for (int j = 0; j < 16; ++j) A[j] = CAND(0, j);
#pragma unroll
    for (int j = 0; j < 8; ++j) { B[j] = CAND(1, j); B[15 - j] = CAND(8 + j, 0); }
    bitonic_merge_desc<16>(B);
#pragma unroll
    for (int j = 0; j < 5; ++j) C[j] = CAND(2, j);
#pragma unroll
    for (int j = 5; j < 12; ++j) C[j] = NEGV;
#pragma unroll
    for (int j = 0; j < 4; ++j) C[15 - j] = CAND(3, j);
    bitonic_merge_desc<16>(C);
    Dd[0] = CAND(4, 0); Dd[1] = CAND(4, 1); Dd[2] = CAND(4, 2); Dd[3] = NEGV; Dd[4] = NEGV; Dd[5] = NEGV; Dd[6] = CAND(5, 1); Dd[7] = CAND(5, 0);
    bitonic_merge_desc<8>(Dd);
    E[0] = CAND(6, 0); E[1] = CAND(6, 1); E[2] = NEGV; E[3] = NEGV; E[4] = NEGV; E[5] = NEGV; E[6] = CAND(7, 1); E[7] = CAND(7, 0);
    bitonic_merge_desc<8>(E);
#pragma unroll
    for (int j = 0; j < 8; ++j) { F[j] = Dd[j]; F[15 - j] = E[j]; }
    bitonic_merge_desc<16>(F);
#undef CAND
#pragma unroll
    for (int j = 0; j < 16; ++j) { A[j] = fmaxf(A[j], B[15 - j]); C[j] = fmaxf(C[j], F[15 - j]); }
    bitonic_merge_desc<16>(A);
    bitonic_merge_desc<16>(C);
#pragma unroll
    for (int j = 0; j < 16; ++j) cv[j] = fmaxf(A[j], C[15 - j]);
    bitonic_merge_desc<16>(cv);
  }
  float ex[16]; float sum = 0.f;
  const float c0v = __uint_as_float(__float_as_uint(cv[0]) & ~63u);
  const float rs = row_rstd(rowss, (size_t)tok);
#pragma unroll
  for (int i = 0; i < 16; ++i) { ex[i] = __expf((__uint_as_float(__float_as_uint(cv[i]) & ~63u) - c0v) * rs); sum += ex[i]; }
  const float inv = 1.0f / sum;
  int e4[4]; float g4[4];
#pragma unroll
  for (int q = 0; q < 4; ++q) {
    const int slot = __float_as_uint(SEL4(cv, q)) & 63;
    const int ij = ST[slot];
    e4[q] = IDX[ij >> 4] * 128 + IDX[16 + (ij & 15)];
    g4[q] = SEL4(ex, q) * inv;
  }
#undef SEL4
  *(int4*)(eb + ((size_t)tok * 8 + h) * 16 + 4 * fq) = make_int4(e4[0], e4[1], e4[2], e4[3]);
  *(float4*)(gb + ((size_t)tok * 8 + h) * 16 + 4 * fq) = make_float4(g4[0], g4[1], g4[2], g4[3]);
}

__device__ __forceinline__ void p_cvt_bf16(int blk, int nblk, const float* __restrict__ src, bf16_t* dst, size_t n8) {
  const int tix = opaque_tid();
  for (size_t i = (size_t)blk * 512 + tix; i < n8; i += (size_t)nblk * 512) {
    const float4 a = ((const float4*)src)[2 * i], b = ((const float4*)src)[2 * i + 1];
    uint4 w; w.x = cvtpk(a.x, a.y); w.y = cvtpk(a.z, a.w); w.z = cvtpk(b.x, b.y); w.w = cvtpk(b.z, b.w);
    ((uint4*)dst)[i] = w;
  }
}


typedef float f32x2v __attribute__((ext_vector_type(2)));
__device__ __forceinline__ void p_cvt_fp8_rows(int blk, int nblk, const float* __restrict__ src, unsigned* dst, float* inv, const float* __restrict__ csc) {
  const int tix = opaque_tid();
  const int lane = tix & 63, wid = tix >> 6;
  for (int r = blk * 8 + wid; r < 16384; r += nblk * 8) {
    const float4* sp = (const float4*)(src + (size_t)r * D);
    float4 v[4];
#pragma unroll
    for (int k = 0; k < 4; ++k) v[k] = sp[k * 64 + lane];
    if (csc) {
#pragma unroll
      for (int k = 0; k < 4; ++k) { const float4 g = ((const float4*)csc)[k * 64 + lane]; v[k].x *= g.x; v[k].y *= g.y; v[k].z *= g.z; v[k].w *= g.w; }
    }
    float am = 0.f;
#pragma unroll
    for (int k = 0; k < 4; ++k) am = fmaxf(am, fmaxf(fmaxf(fabsf(v[k].x), fabsf(v[k].y)), fmaxf(fabsf(v[k].z), fabsf(v[k].w))));
    am = wave_max(am);
    const float sc = am > 0.f ? 384.0f / am : 1.0f;
#pragma unroll
    for (int k = 0; k < 4; ++k) {
      int w = __builtin_amdgcn_cvt_pk_fp8_f32(v[k].x * sc, v[k].y * sc, 0, false);
      w = __builtin_amdgcn_cvt_pk_fp8_f32(v[k].z * sc, v[k].w * sc, w, true);
      { const int c = 256 * k + 4 * lane; dst[((size_t)(c >> 7) * (16384 * 128) + (size_t)r * 128 + (c & 127)) >> 2] = (unsigned)w; }
    }
    if (lane == 0) inv[r] = am > 0.f ? am * (1.0f / 384.0f) : 1.0f;
  }
}


__device__ __forceinline__ unsigned xcc_id() { return (unsigned)__builtin_amdgcn_s_getreg((3 << 11) | 20) & 7u; }

__device__ __forceinline__ void ds_issue(uint4 (&u)[16], const int* El  , const unsigned char* __restrict__ tab) {
  int ev[16];
#pragma unroll
  for (int q = 0; q < 4; ++q) { const int4 t = *(const int4*)(El + 4 * q); ev[4 * q] = t.x; ev[4 * q + 1] = t.y; ev[4 * q + 2] = t.z; ev[4 * q + 3] = t.w; }
#pragma unroll
  for (int it = 0; it < 16; ++it) u[it] = *(const uint4*)(tab + (size_t)(unsigned)ev[it] * 128);
}
__device__ __forceinline__ void ds_u_compute(const uint4 (&u)[16], const char* Xl  , float* __restrict__ pout, int j) {
  f32x2v xf[8];
  {
    const uint4 a = *(const uint4*)Xl, c = *(const uint4*)(Xl + 16);
    xf[0] = (f32x2v){__uint_as_float(a.x << 16), __uint_as_float(a.x & 0xffff0000u)}; xf[1] = (f32x2v){__uint_as_float(a.y << 16), __uint_as_float(a.y & 0xffff0000u)};
    xf[2] = (f32x2v){__uint_as_float(a.z << 16), __uint_as_float(a.z & 0xffff0000u)}; xf[3] = (f32x2v){__uint_as_float(a.w << 16), __uint_as_float(a.w & 0xffff0000u)};
    xf[4] = (f32x2v){__uint_as_float(c.x << 16), __uint_as_float(c.x & 0xffff0000u)}; xf[5] = (f32x2v){__uint_as_float(c.y << 16), __uint_as_float(c.y & 0xffff0000u)};
    xf[6] = (f32x2v){__uint_as_float(c.z << 16), __uint_as_float(c.z & 0xffff0000u)}; xf[7] = (f32x2v){__uint_as_float(c.w << 16), __uint_as_float(c.w & 0xffff0000u)};
  }
  float k0 = 0.f, k1 = 0.f;
#pragma unroll
  for (int it = 0; it < 16; ++it) {
    const unsigned wv[4] = {u[it].x, u[it].y, u[it].z, u[it].w};
    f32x2v d2 = {0.f, 0.f};
#pragma unroll
    for (int q = 0; q < 4; ++q) {
      const f32x2v lo = __builtin_amdgcn_cvt_pk_f32_fp8((int)wv[q], false), hi = __builtin_amdgcn_cvt_pk_f32_fp8((int)wv[q], true);
      d2 = __builtin_elementwise_fma(lo, xf[2 * q], d2); d2 = __builtin_elementwise_fma(hi, xf[2 * q + 1], d2);
    }
    const float d = sum8(d2.x + d2.y);
    if ((it >> 1) == j) { if (it & 1) k1 = d; else k0 = d; }
  }
  *(float2*)pout = make_float2(k0, k1);
}
__device__ __forceinline__ void ds_u_chunk(char* wl  , int lane, int tk0, int s, const bf16_t* __restrict__ xn2, const int* __restrict__ eb, const unsigned char* __restrict__ ut8, float* __restrict__ partial) {
  const int b = tk0 / SEQ, sq = tk0 - b * SEQ;
  const size_t row0 = (size_t)b * LP + NMETA + sq;
  const int j = lane & 7, gi = lane >> 3;
  int* El = (int*)wl;
  char* Xl = wl + 8192;
#pragma unroll
  for (int i = 0; i < 8; ++i) *(int4*)(El + (i * 64 + lane) * 4) = *(const int4*)(eb + row0 * 128 + (i * 64 + lane) * 4);
#pragma unroll
  for (int i = 0; i < 4; ++i) { const int g = i * 64 + lane, t = g >> 4, c = g & 15; *(uint4*)(Xl + g * 16) = *(const uint4*)(xn2 + (row0 + t) * D + 128 * s + 8 * c); }
  const unsigned char* tab = ut8 + (size_t)s * (16384 * 128) + 16 * j;
  float* pout = partial + ((size_t)tk0 * 8 + s) * 128 + gi * 16 + 2 * j;
  uint4 ua[16], ub[16];
  ds_issue(ua, El + gi * 16, tab);
#pragma unroll 1
  for (int t = 0; t < 16; t += 2) {
    ds_issue(ub, El + (t + 1) * 128 + gi * 16, tab);
    ds_u_compute(ua, Xl + t * 256 + 32 * j, pout + (size_t)t * 1024, j);
    if (t + 2 < 16) ds_issue(ua, El + (t + 2) * 128 + gi * 16, tab);
    ds_u_compute(ub, Xl + (t + 1) * 256 + 32 * j, pout + (size_t)(t + 1) * 1024, j);
  }
}

__device__ __forceinline__ void ds_v_compute(const uint4 (&v)[16], const float* Wl  , int lane, int j, int gi, size_t row, int tk, int s,
                                             const bf16_t* __restrict__ hb, float* __restrict__ out, float* __restrict__ ssq) {
  float w[16];
#pragma unroll
  for (int q = 0; q < 4; ++q) { const float4 f = *(const float4*)(Wl + 4 * q); w[4 * q] = f.x; w[4 * q + 1] = f.y; w[4 * q + 2] = f.z; w[4 * q + 3] = f.w; }
  f32x2v acc[8];
#pragma unroll
  for (int i = 0; i < 8; ++i) acc[i] = (f32x2v){0.f, 0.f};
#pragma unroll
  for (int it = 0; it < 16; ++it) {
    const unsigned wv[4] = {v[it].x, v[it].y, v[it].z, v[it].w};
    const f32x2v w2 = {w[it], w[it]};
#pragma unroll
    for (int q = 0; q < 4; ++q) {
      const f32x2v lo = __builtin_amdgcn_cvt_pk_f32_fp8((int)wv[q], false), hi = __builtin_amdgcn_cvt_pk_f32_fp8((int)wv[q], true);
      acc[2 * q] = __builtin_elementwise_fma(w2, lo, acc[2 * q]); acc[2 * q + 1] = __builtin_elementwise_fma(w2, hi, acc[2 * q + 1]);
    }
  }
  float r4[4] = {0.f, 0.f, 0.f, 0.f};
#pragma unroll
  for (int i = 0; i < 16; ++i) {
    float t = (i & 1) ? acc[i >> 1].y : acc[i >> 1].x;
    t = dpp_add<0x128>(t);
    t += __shfl_xor(t, 16);
    t = half_swap_sum(t);
    if ((i >> 2) == gi) r4[i & 3] = t;
  }
  float ss = 0.f;
  if (gi < 4) {
    const int c0 = 128 * s + 16 * j + 4 * gi;
    const uint2 hw = *(const uint2*)(hb + row * D + c0);
    const float4 o = make_float4(__uint_as_float(hw.x << 16) + r4[0], __uint_as_float(hw.x & 0xffff0000u) + r4[1], __uint_as_float(hw.y << 16) + r4[2], __uint_as_float(hw.y & 0xffff0000u) + r4[3]);
    ss = o.x * o.x + o.y * o.y + o.z * o.z + o.w * o.w;
    *(float4*)(out + (size_t)tk * D + c0) = o;
  }
  ss = wave_sum(ss);
  if (lane == 0) ssq[(size_t)tk * 8 + s] = ss;
}
__device__ __forceinline__ void ds_v_chunk(char* wl, int lane, int tk0, int s, const bf16_t* __restrict__ hb, const int* __restrict__ eb, const float* __restrict__ wbuf, const unsigned char* __restrict__ vt8,
                                           float* __restrict__ out, float* __restrict__ ssq) {
  const int b = tk0 / SEQ, sq = tk0 - b * SEQ;
  const size_t row0 = (size_t)b * LP + NMETA + sq;
  const int j = lane & 7, gi = lane >> 3;
  int* El = (int*)wl;
  float* Wl = (float*)(wl + 8192);
#pragma unroll
  for (int i = 0; i < 8; ++i) {
    *(int4*)(El + (i * 64 + lane) * 4) = *(const int4*)(eb + row0 * 128 + (i * 64 + lane) * 4);
    *(float4*)(Wl + (i * 64 + lane) * 4) = *(const float4*)(wbuf + (size_t)tk0 * 128 + (i * 64 + lane) * 4);
  }
  const unsigned char* tab = vt8 + (size_t)s * (16384 * 128) + 16 * j;
  uint4 va[16], vb[16];
  ds_issue(va, El + gi * 16, tab);
#pragma unroll 1
  for (int t = 0; t < 16; t += 2) {
    ds_issue(vb, El + (t + 1) * 128 + gi * 16, tab);
    ds_v_compute(va, Wl + t * 128 + gi * 16, lane, j, gi, row0 + t, tk0 + t, s, hb, out, ssq);
    if (t + 2 < 16) ds_issue(va, El + (t + 2) * 128 + gi * 16, tab);
    ds_v_compute(vb, Wl + (t + 1) * 128 + gi * 16, lane, j, gi, row0 + t + 1, tk0 + t + 1, s, hb, out, ssq);
  }
}


struct EpiBf16 {
  bf16_t* out; int ld; int use_scale; unsigned* kmax;
  __device__ __forceinline__ void store8(size_t row, int col, const float (&v)[8], float& tmax) const {
    if (kmax && col >= 512 && col < 1024) {
      float ss = 0.f;
#pragma unroll
      for (int i = 0; i < 8; ++i) ss += v[i] * v[i];
      tmax = fmaxf(tmax, sum8(ss));
    }
    uint4 w; w.x = cvtpk(v[0], v[1]); w.y = cvtpk(v[2], v[3]); w.z = cvtpk(v[4], v[5]); w.w = cvtpk(v[6], v[7]);
    *(uint4*)(out + row * ld + col) = w;
  }
  __device__ __forceinline__ void finish(float tmax, size_t row, int col) const {
    if (kmax && col >= 512 && col < 1024) {
      tmax = wave_max(tmax);
      if ((threadIdx.x & 63) == 0) atomicMax(kmax + (row / LP) * 8 + ((col - 512) >> 6), __float_as_uint(tmax));
    }
  }
};
struct EpiResid2 {
  const float* x; const float* meta; float* h2; bf16_t* hb; float* rowss;
  __device__ __forceinline__ void finish(float, size_t, int) const {}
  __device__ __forceinline__ void store8(size_t row, int col, const float (&v)[8], float&) const {
    const float* src = hrow_ptr(x, meta, (int)row);
    const float4 a = *(const float4*)(src + col), b = *(const float4*)(src + col + 4);
    const float o[8] = {a.x + v[0], a.y + v[1], a.z + v[2], a.w + v[3], b.x + v[4], b.y + v[5], b.z + v[6], b.w + v[7]};
    uint4 w; w.x = cvtpk(o[0], o[1]); w.y = cvtpk(o[2], o[3]); w.z = cvtpk(o[4], o[5]); w.w = cvtpk(o[6], o[7]);
    *(uint4*)(hb + row * D + col) = w;
    float ss = 0.f;
#pragma unroll
    for (int i = 0; i < 8; ++i) ss += o[i] * o[i];
    ss = sum8(ss);
    if ((threadIdx.x & 7) == 0) rowss[row * 16 + (col >> 6)] = ss;
  }
};

template <class Epi>
__device__ __forceinline__ void gemm256(char* lds, const bf16_t* __restrict__ X, int ldx, const bf16_t* __restrict__ Wt, int ldw, int K, size_t xrow0, int n0, const Epi& epi) {
  const int tix = opaque_tid();
  const int tid = tix, lane = tid & 63;
  const int wid = __builtin_amdgcn_readfirstlane(tid >> 6);
  const int wm = wid >> 2, wn = wid & 3;
  const int fr = lane & 15, fq = lane >> 4;
  f32x4 acc[4][8];
#pragma unroll
  for (int i = 0; i < 4; ++i)
#pragma unroll
    for (int j = 0; j < 8; ++j) acc[i][j] = (f32x4){0.f, 0.f, 0.f, 0.f};
  const int nk = K >> 6;
  const int prow = lane >> 3, ppos = lane & 7;
  const char* xsrc = (const char*)(X + (xrow0 + 8 * wid + prow) * ldx);
  const char* wsrc = (const char*)(Wt + (size_t)(n0 + 8 * wid + prow) * ldw);
  const unsigned swz = (unsigned)((ppos ^ ((4 * wid + (prow >> 1)) & 7)) << 4);
#define G256_ISSUE(kt, buf) do { \
    _Pragma("unroll") for (int i_ = 0; i_ < 4; ++i_) { \
      __builtin_amdgcn_global_load_lds((const unsigned*)(xsrc + (size_t)(64 * i_) * ldx * 2 + (kt) * 128 + swz), LDSP(unsigned, lds + (buf) * 65536 + (i_ * 8 + wid) * 1024), 16, 0, 0); \
      __builtin_amdgcn_global_load_lds((const unsigned*)(wsrc + (size_t)(64 * i_) * ldw * 2 + (kt) * 128 + swz), LDSP(unsigned, lds + (buf) * 65536 + 32768 + (i_ * 8 + wid) * 1024), 16, 0, 0); \
    } } while (0)
  __syncthreads();
  G256_ISSUE(0, 0);
  asm volatile("s_waitcnt vmcnt(0)" ::: "memory");
  __syncthreads();
  for (int kt = 0; kt < nk; ++kt) {
    if (kt + 1 < nk) G256_ISSUE(kt + 1, (kt + 1) & 1);
    const char* la = lds + (kt & 1) * 65536;
    const char* lb = la + 32768;
#pragma unroll
    for (int kk = 0; kk < 2; ++kk) {
      const int c = kk * 4 + fq;
      bf16x8 xa[8], wb[4];
#pragma unroll
      for (int t = 0; t < 8; ++t) { const int r = wm * 128 + t * 16 + fr; xa[t] = *(const bf16x8*)(la + r * 128 + ((c ^ ((r >> 1) & 7)) << 4)); }
#pragma unroll
      for (int t = 0; t < 4; ++t) { const int r = wn * 64 + t * 16 + fr; wb[t] = *(const bf16x8*)(lb + r * 128 + ((c ^ ((r >> 1) & 7)) << 4)); }
#pragma unroll
      for (int nt = 0; nt < 4; ++nt)
#pragma unroll
        for (int tt = 0; tt < 8; ++tt) acc[nt][tt] = __builtin_amdgcn_mfma_f32_16x16x32_bf16(wb[nt], xa[tt], acc[nt][tt], 0, 0, 0);
    }
    asm volatile("s_waitcnt vmcnt(0)" ::: "memory");
    __syncthreads();
  }
#undef G256_ISSUE
  char* wl = lds + wid * 16384;
  float tmax = 0.f;
#pragma unroll
  for (int hf = 0; hf < 2; ++hf) {
#pragma unroll
    for (int t4 = 0; t4 < 4; ++t4)
#pragma unroll
      for (int nt = 0; nt < 4; ++nt) {
        const int t = t4 * 16 + fr, c16 = nt * 4 + fq;
        *(f32x4*)(wl + t * 256 + ((c16 ^ (t & 15)) << 4)) = acc[nt][hf * 4 + t4];
      }
#pragma unroll
    for (int i = 0; i < 8; ++i) {
      const int t = 8 * i + (lane >> 3), c8 = lane & 7;
      const f32x4 v0 = *(const f32x4*)(wl + t * 256 + (((2 * c8) ^ (t & 15)) << 4)), v1 = *(const f32x4*)(wl + t * 256 + (((2 * c8 + 1) ^ (t & 15)) << 4));
      const float v[8] = {v0[0], v0[1], v0[2], v0[3], v1[0], v1[1], v1[2], v1[3]};
      epi.store8(xrow0 + wm * 128 + hf * 64 + t, n0 + wn * 64 + 8 * c8, v, tmax);
    }
  }
  epi.finish(tmax, xrow0, n0 + wn * 64);
}

__device__ __forceinline__ void meta_proj(char* lds, int blk, const bf16_t* __restrict__ xn1, const bf16_t* __restrict__ wt_in, bf16_t* proj) {
  const int tix = opaque_tid();
  float* red = (float*)lds;
  __syncthreads();
  float part = 0.f;
  const int o = tix % 160, kp = tix / 160;
  if (tix < 480) {
    const int row = o / 10, n = blk * 10 + o % 10;
    const int k0 = kp * 352, k1 = kp == 2 ? 1024 : k0 + 352;
    const bf16_t* xr = xn1 + (size_t)row * D; const bf16_t* wr = wt_in + (size_t)n * D;
    for (int k = k0; k < k1; k += 8) {
      const uint4 a = *(const uint4*)(xr + k), b = *(const uint4*)(wr + k);
      part = dot8(a, b, part);
    }
    red[tix] = part;
  }
  __syncthreads();
  if (tix < 160) {
    const float v = red[tix] + red[tix + 160] + red[tix + 320];
    const int row = tix / 10, n = blk * 10 + tix % 10;
    const bf16_t bv = f2bf(v);
#pragma unroll
    for (int b = 0; b < BATCH; ++b) proj[((size_t)b * LP + row) * INC + n] = bv;
  }
}

__device__ __forceinline__ void p_transpose(int t, float* smem, const float* __restrict__ W, bf16_t* Wt, int K, int N, const float* __restrict__ ksc) {
  const int tix = opaque_tid();
  float (*T)[65] = (float (*)[65])smem;
  const int nbx = N / 64, k0 = (t / nbx) * 64, n0 = (t % nbx) * 64, tid = (tix & 255);
  const int j = tid & 63, i0 = tid >> 6;
#pragma unroll
  for (int ii = 0; ii < 16; ++ii) { int i = i0 + 4 * ii; T[i][j] = W[(size_t)(k0 + i) * N + n0 + j] * (ksc ? ksc[k0 + i] : 1.0f); }
  __syncthreads();
#pragma unroll
  for (int ii = 0; ii < 16; ++ii) { int jj = i0 + 4 * ii; Wt[(size_t)(n0 + jj) * K + k0 + j] = f2bf(T[j][jj]); }
  __syncthreads();
}

#define XB_TMO      128
#define XB_XCNT(j)  (256  + 64 * (j))
#define XB_XSUB(j)  (1280 + 64 * (j))
#define XB_XGEN(j)  (2304 + 64 * (j))
#define XB_TOP      3328
#define XB_TOPGEN   3392
#define XCD_BAR_WORDS 3456
#define XB_SPIN_CAP (1u << 18)
#define LAS __attribute__((address_space(3)))

__device__ __forceinline__ unsigned xb_ld(unsigned* p)              { return __hip_atomic_load(p, __ATOMIC_RELAXED, __HIP_MEMORY_SCOPE_AGENT); }
__device__ __forceinline__ unsigned xb_add(unsigned* p, unsigned v) { return __hip_atomic_fetch_add(p, v, __ATOMIC_RELAXED, __HIP_MEMORY_SCOPE_AGENT); }
__device__ __forceinline__ unsigned xb_xcc_id() { return (unsigned)__builtin_amdgcn_s_getreg((3 << 11) | 20) & 0xFu; }
#define XB_SPIN(cond, bar) do { unsigned _sp = 0; while (cond) { __builtin_amdgcn_s_sleep(1); \
    if ((++_sp & 255u) == 0u) { if (xb_ld(&(bar)[XB_TMO])) break; if (_sp > XB_SPIN_CAP) { atomicAdd(&(bar)[XB_TMO], 1u); break; } } } } while (0)

struct XcdBarrier {
    unsigned* bar; unsigned x;
    volatile LAS unsigned* st;
};

__device__ __forceinline__ XcdBarrier xcd_barrier_post(unsigned* bar, volatile LAS unsigned* st) {
    XcdBarrier b; b.bar = bar; b.x = xb_xcc_id(); b.st = st;
    if (threadIdx.x == 0) (void)xb_add(&bar[XB_XCNT(b.x)], 1u);
    return b;
}
__device__ __forceinline__ void xcd_barrier_complete(unsigned* bar, unsigned x, unsigned& nloc, unsigned& nx) {
    const unsigned G = gridDim.x * gridDim.y * gridDim.z;
    unsigned sum, cnt, mine, sp = 0u;
    for (;;) {
        sum = 0u; cnt = 0u; mine = 0u;
#pragma unroll
        for (unsigned j = 0; j < 16; ++j) { const unsigned c = xb_ld(&bar[XB_XCNT(j)]); sum += c; cnt += (c > 0u) ? 1u : 0u; mine = (j == x) ? c : mine; }
        if (sum == G) break;
        __builtin_amdgcn_s_sleep(1);
        if ((++sp & 255u) == 0u) { if (xb_ld(&bar[XB_TMO])) break; if (sp > XB_SPIN_CAP) { atomicAdd(&bar[XB_TMO], 1u); break; } }
    }
    nloc = mine > 0u ? mine : 1u; nx = cnt > 0u ? cnt : 1u;
}

__device__ __forceinline__ void xcd_barrier(const XcdBarrier& b) {
    asm volatile("s_waitcnt vmcnt(0)" ::: "memory");
    __syncthreads();
    if (threadIdx.x == 0) {
        unsigned* bar = b.bar;
        __builtin_amdgcn_s_waitcnt(0);
        unsigned nloc = b.st[0], nx = b.st[1];
        if (nloc == 0u) { xcd_barrier_complete(bar, b.x, nloc, nx); b.st[0] = nloc; b.st[1] = nx; }
        const unsigned old = xb_add(&bar[XB_XSUB(b.x)], 1u);
        const unsigned gen = old / nloc;
        if (old + 1u == (gen + 1u) * nloc) {
            __builtin_amdgcn_fence(__ATOMIC_RELEASE, "agent");
            asm volatile("s_waitcnt vmcnt(0)" ::: "memory");
            const unsigned og = xb_add(&bar[XB_TOP], 1u);
            const unsigned tg = og / nx;
            if (og + 1u == (tg + 1u) * nx) xb_add(&bar[XB_TOPGEN], 1u);
            else XB_SPIN(xb_ld(&bar[XB_TOPGEN]) == tg, bar);
            __builtin_amdgcn_fence(__ATOMIC_ACQUIRE, "agent");
            xb_add(&bar[XB_XGEN(b.x)], 1u);
            asm volatile("s_waitcnt vmcnt(0)" ::: "memory");
        } else {
            XB_SPIN(xb_ld(&bar[XB_XGEN(b.x)]) == gen, bar);
            __builtin_amdgcn_fence(__ATOMIC_ACQUIRE, "agent");
            asm volatile("s_waitcnt vmcnt(0)" ::: "memory");
        }
    }
    __syncthreads();
}


struct Params {
  const float *x, *meta, *g1, *w_in, *lq1, *lk1, *lq2, *lk2, *subg, *conv_w, *conv_b, *gn_g, *gn_b, *w_out, *g2, *wq, *sk, *ut, *vt, *fg;
  float* out; float* scal; bf16_t* r1; bf16_t* r2; float* h2; int* eb; float* gb; bf16_t* wt_in; bf16_t* wt_out; bf16_t* wt_q; bf16_t* skb; unsigned char* ut8; unsigned char* vt8; float* uinv; float* vinv; float* wbuf; float* ssq; bf16_t* hb; float* rowss; int use_cg_sync; int pad0;
};

__global__ void __launch_bounds__(512, 2) mega(Params p) {
  cg::grid_group grid = cg::this_grid();
  __shared__ __attribute__((aligned(16))) char smem_c[131072 + 256];
  float* smem = (float*)smem_c;
  const int G = gridDim.x, vh = threadIdx.x >> 8;
  volatile LAS unsigned* xb_st = (volatile LAS unsigned*)(smem_c + 131072 + 16);
  if (threadIdx.x == 0) { xb_st[0] = 0u; xb_st[1] = 0u; }
  __syncthreads();
  const XcdBarrier xbar = xcd_barrier_post((unsigned*)(p.scal + 1024), xb_st);
  bf16_t* xn1 = p.r1; bf16_t* mix = p.r1; bf16_t* proj = p.r2; bf16_t* qp = p.r2;
  p_norm1_rows(G, p.x, p.meta, p.g1, xn1);
  if (blockIdx.x == 0 && threadIdx.x < 64) {
    const int t = threadIdx.x;
    const float a = wave_sum(p.lq1[t] * p.lk1[t]), b2 = wave_sum(p.lq2[t] * p.lk2[t]);
    if (t == 0) p.scal[0] = expf(a) - expf(b2) + LAM_INIT;
  }
  for (int b = blockIdx.x; b < (640 + 256 + 512) / 2; b += G) {
    const int bb = b * 2 + vh; float* sm = smem + vh * (64 * 65);
    if (bb < 640) p_transpose(bb, sm, p.w_in, p.wt_in, D, INC, nullptr);
    else if (bb < 896) p_transpose(bb - 640, sm, p.w_out, p.wt_out, D, D, nullptr);
    else p_transpose(bb - 896, sm, p.wq, p.wt_q, D, 2048, p.g2);
  }
  p_cvt_bf16(blockIdx.x, G, p.sk, p.skb, (size_t)16 * 128 * 128 / 8);
  p_cvt_fp8_rows(blockIdx.x, G, p.ut, (unsigned*)p.ut8, p.uinv, p.g2);
  p_cvt_fp8_rows(blockIdx.x, G, p.vt, (unsigned*)p.vt8, p.vinv, nullptr);
  if (p.use_cg_sync) grid.sync(); else xcd_barrier(xbar);
  for (int b = blockIdx.x; b < 128 * 10; b += G) {
    const int xi = (b >> 3), mt = (b & 7) * 16 + xi / 10, nt = xi % 10;
    gemm256(smem_c, xn1, D, p.wt_in, D, D, (size_t)(mt >> 4) * LP + NMETA + 256 * (mt & 15), nt * 256, EpiBf16{proj, INC, 0, (unsigned*)(p.scal + 640)});
  }
  for (int b = blockIdx.x; b < 256; b += G) meta_proj(smem_c, b, xn1, p.wt_in, proj);
  for (int i = blockIdx.x * 512 + threadIdx.x; i < BATCH * (LP - LREAL) * 128; i += G * 512) {
    const int c = i & 127, r = i >> 7, b = r / (LP - LREAL), pos = LREAL + r - b * (LP - LREAL);
    *(uint4*)(proj + ((size_t)b * LP + pos) * INC + 512 + 8 * c) = make_uint4(0, 0, 0, 0);
  }
  xcd_barrier(xbar);
  {
    const float lam = p.scal[0];
    for (int u = blockIdx.x; u < 256; u += G) {
      const int bh = (u & 7) * 4 + (u >> 6), tp = (u >> 3) & 7;
#pragma unroll 1
      for (int k = 0; k < 4; ++k) {
        const int t = (k == 0) ? 31 - tp : (k == 1) ? 16 + tp : (k == 2) ? 15 - tp : tp;
        attn_unit(smem_c, proj, mix, p.subg, (const unsigned*)(p.scal + 640), lam, bh >> 2, bh & 3, t);
      }
    }
  }
  for (int u = blockIdx.x; u < BATCH * 128; u += G) conv_unit(smem_c, proj, mix, p.conv_w, p.conv_b, p.gn_g, p.gn_b, u >> 7, NMETA + 32 * (u & 127));
  xcd_barrier(xbar);
  for (int b = blockIdx.x; b < 128 * 4; b += G) {
    const int xi = (b >> 3), mt = (b & 7) * 16 + (xi >> 2), nt = xi & 3;
    gemm256(smem_c, mix, D, p.wt_out, D, D, (size_t)(mt >> 4) * LP + NMETA + 256 * (mt & 15), nt * 256, EpiResid2{p.x, p.meta, p.h2, p.hb, p.rowss});
  }
  xcd_barrier(xbar);
  for (int b = blockIdx.x; b < 128 * 8; b += G) {
    const int xi = (b >> 3), mt = (b & 7) * 16 + (xi >> 3), nt = xi & 7;
    gemm256(smem_c, p.hb, D, p.wt_q, D, D, (size_t)(mt >> 4) * LP + NMETA + 256 * (mt & 15), nt * 256, EpiBf16{qp, 2048, 0, nullptr});
  }
  xcd_barrier(xbar);
  for (int u = blockIdx.x; u < 256 * 8; u += G) {
    const int rt = u >> 3, h = u & 7;
    peer_topk_unit(smem_c, qp, p.skb, p.rowss, p.eb, p.gb, (rt >> 5) * LP + NMETA + 128 * (rt & 31), h);
  }
  xcd_barrier(xbar);
  {
    const int tix = opaque_tid();
    const int lane = tix & 63;
    const int NTOK = BATCH * SEQ;
    float* partial = (float*)qp;
    unsigned* qh = (unsigned*)(p.scal + 128);
    const unsigned x = xcc_id();
    for (int qi = 0; qi < 8; ++qi) {
      const int s = (int)((x + qi) & 7u);
      for (;;) {
        unsigned st = 0;
        if (lane == 0) st = __hip_atomic_fetch_add(qh + s * 16, 16u, __ATOMIC_RELAXED, __HIP_MEMORY_SCOPE_AGENT);
        st = __builtin_amdgcn_readfirstlane(st);
        if (st >= (unsigned)NTOK) break;
        ds_u_chunk(smem_c + (tix >> 6) * 16384, lane, (int)st, s, p.hb, p.eb, p.ut8, partial);
      }
    }
    xcd_barrier(xbar);
    for (size_t i = (size_t)blockIdx.x * 512 + tix; i < (size_t)NTOK * 128; i += (size_t)G * 512) {
      const int tk = (int)(i >> 7), k = (int)(i & 127);
      const int b = tk / SEQ, sq = tk - b * SEQ;
      const size_t row = (size_t)b * LP + NMETA + sq;
      float a = 0.f;
#pragma unroll
      for (int sl = 0; sl < 8; ++sl) a += partial[((size_t)tk * 8 + sl) * 128 + k];
      const int e = p.eb[row * 128 + k];
      a *= p.uinv[e] * row_rstd(p.rowss, row);
      p.wbuf[i] = p.gb[row * 128 + k] * 0.5f * a * (1.0f + erff(a * 0.70710678118654752f)) * p.vinv[e];
    }
    xcd_barrier(xbar);
    for (int qi = 0; qi < 8; ++qi) {
      const int s = (int)((x + qi) & 7u);
      for (;;) {
        unsigned st = 0;
        if (lane == 0) st = __hip_atomic_fetch_add(qh + (8 + s) * 16, 16u, __ATOMIC_RELAXED, __HIP_MEMORY_SCOPE_AGENT);
        st = __builtin_amdgcn_readfirstlane(st);
        if (st >= (unsigned)NTOK) break;
        ds_v_chunk(smem_c + (tix >> 6) * 16384, lane, (int)st, s, p.hb, p.eb, p.wbuf, p.vt8, p.h2, p.ssq);
      }
    }
    xcd_barrier(xbar);
    {
      const int wv = blockIdx.x * 8 + (tix >> 6);
      for (int tk = wv * 2; tk < NTOK; tk += G * 16) {
        float4 o[2][4]; float sv[2];
#pragma unroll
        for (int r = 0; r < 2; ++r) {
#pragma unroll
          for (int q = 0; q < 4; ++q) o[r][q] = ((const float4*)p.h2)[(size_t)(tk + r) * 256 + q * 64 + lane];
          sv[r] = lane < 8 ? p.ssq[(size_t)(tk + r) * 8 + lane] : 0.f;
        }
#pragma unroll
        for (int r = 0; r < 2; ++r) {
          const float rstd = rsqrtf(wave_sum(sv[r]) * (1.0f / D) + EPS);
#pragma unroll
          for (int q = 0; q < 4; ++q) {
            const float4 f = ((const float4*)p.fg)[q * 64 + lane];
            float4 v = o[r][q];
            v.x *= rstd * f.x; v.y *= rstd * f.y; v.z *= rstd * f.z; v.w *= rstd * f.w;
            ((float4*)p.out)[(size_t)(tk + r) * 256 + q * 64 + lane] = v;
          }
        }
      }
    }
  }
}

extern "C" void kernel_launch(void* const* d_in, const int* in_sizes, int n_in, void* d_out, int out_size, void* d_ws, size_t ws_size, hipStream_t stream) {
  static int grid_blocks = 0;
  if (!grid_blocks) {
    int dev = 0, cus = 0, per_cu = 0;
    hipGetDevice(&dev);
    hipDeviceGetAttribute(&cus, hipDeviceAttributeMultiprocessorCount, dev);
    hipOccupancyMaxActiveBlocksPerMultiprocessor(&per_cu, mega, 512, 0);
    if (per_cu > 1) per_cu = 1;
    if (per_cu < 1) per_cu = 1;
    grid_blocks = cus * per_cu;
  }
  Params p{};
  const float** pp = (const float**)&p;
  for (int i = 0; i < 20; ++i) pp[i] = (const float*)d_in[i];
  p.out = (float*)d_out;
  char* ws = (char*)d_ws;
  size_t off = 0;
  p.scal = (float*)(ws + off); off += 32768;
  p.r1 = (bf16_t*)(ws + off); off += (size_t)ROWS * D * 2;
  p.r2 = (bf16_t*)(ws + off); off += (size_t)ROWS * INC * 2;
  p.h2 = (float*)(ws + off); off += (size_t)ROWS * D * 4;
  p.wt_in = (bf16_t*)(ws + off); off += (size_t)INC * D * 2;
  p.wt_out = (bf16_t*)(ws + off); off += (size_t)D * D * 2;
  p.wt_q = (bf16_t*)(ws + off); off += (size_t)2048 * D * 2;
  p.skb = (bf16_t*)(ws + off); off += (size_t)16 * 128 * 128 * 2;
  p.ut8 = (unsigned char*)(ws + off); off += (size_t)16384 * D;
  p.vt8 = (unsigned char*)(ws + off); off += (size_t)16384 * D;
  p.uinv = (float*)(ws + off); off += 65536;
  p.vinv = (float*)(ws + off); off += 65536;
  p.wbuf = (float*)(ws + off); off += (size_t)BATCH * SEQ * 128 * 4;
  p.ssq = (float*)(ws + off); off += (size_t)BATCH * SEQ * 8 * 4;
  p.hb = (bf16_t*)(ws + off); off += (size_t)ROWS * D * 2;
  p.rowss = (float*)(ws + off); off += (size_t)ROWS * 16 * 4;
  p.eb = (int*)((char*)p.r2 + (size_t)ROWS * 2048 * 2);
  p.gb = (float*)((char*)p.eb + (size_t)ROWS * 128 * 4);
  hipMemsetAsync(d_ws, 0, 32768, stream);
  void* args[] = {&p};
  hipError_t e = hipLaunchCooperativeKernel((void*)mega, dim3(grid_blocks), dim3(512), args, 0, stream);
  if (e != hipSuccess) fprintf(stderr, "cooperative launch failed: %s (grid %d)\n", hipGetErrorString(e), grid_blocks);
}
```

```cpp
#include <hip/hip_runtime.h>
#include <hip/hip_cooperative_groups.h>
#include <cstdio>
namespace cg = cooperative_groups;
#include <stdint.h>
#include <math.h>

typedef unsigned short bf16_t;
typedef short bf16x8 __attribute__((ext_vector_type(8)));
typedef float f32x4 __attribute__((ext_vector_type(4)));

constexpr int D = 1024, BATCH = 8, SEQ = 4096, NMETA = 16, LREAL = NMETA + SEQ  , LP = 4224, ROWS = BATCH * LP;
constexpr int INC = 2560;
constexpr float EPS = 1e-6f;
constexpr float LAM_INIT = 0.2f;

__device__ __forceinline__ float bf2f(unsigned v) { return __uint_as_float(v << 16); }
__device__ __forceinline__ bf16_t f2bf(float f) { unsigned u = __float_as_uint(f); u += 0x7fffu + ((u >> 16) & 1u); return (bf16_t)(u >> 16); }
__device__ __forceinline__ unsigned pack2(float a, float b) { return (unsigned)f2bf(a) | ((unsigned)f2bf(b) << 16); }

__device__ __forceinline__ float wave_sum(float v) {
#pragma unroll
  for (int o = 32; o >= 1; o >>= 1) v += __shfl_xor(v, o);
  return v;
}
__device__ __forceinline__ float wave_max(float v) {
#pragma unroll
  for (int o = 32; o >= 1; o >>= 1) v = fmaxf(v, __shfl_xor(v, o));
  return v;
}

template <int CTRL> __device__ __forceinline__ float dpp_add(float v) { return v + __builtin_bit_cast(float, __builtin_amdgcn_update_dpp(0, __builtin_bit_cast(int, v), CTRL, 0xf, 0xf, true)); }
__device__ __forceinline__ float sum8(float v) { v = dpp_add<0x141>(v); v = dpp_add<0xB1>(v); v = dpp_add<0x4E>(v); return v; }
typedef __bf16 bf16v2 __attribute__((ext_vector_type(2)));
__device__ __forceinline__ float dot8(uint4 a, uint4 b, float acc) {
  acc = __builtin_amdgcn_fdot2_f32_bf16(__builtin_bit_cast(bf16v2, a.x), __builtin_bit_cast(bf16v2, b.x), acc, false);
  acc = __builtin_amdgcn_fdot2_f32_bf16(__builtin_bit_cast(bf16v2, a.y), __builtin_bit_cast(bf16v2, b.y), acc, false);
  acc = __builtin_amdgcn_fdot2_f32_bf16(__builtin_bit_cast(bf16v2, a.z), __builtin_bit_cast(bf16v2, b.z), acc, false);
  acc = __builtin_amdgcn_fdot2_f32_bf16(__builtin_bit_cast(bf16v2, a.w), __builtin_bit_cast(bf16v2, b.w), acc, false);
  return acc;
}
__device__ __forceinline__ float row_rstd(const float* __restrict__ rowss, size_t row) {
  const float4 a = *(const float4*)(rowss + row * 16), b = *(const float4*)(rowss + row * 16 + 4), c = *(const float4*)(rowss + row * 16 + 8), d = *(const float4*)(rowss + row * 16 + 12);
  const float t = ((a.x + a.y) + (a.z + a.w)) + ((b.x + b.y) + (b.z + b.w)) + ((c.x + c.y) + (c.z + c.w)) + ((d.x + d.y) + (d.z + d.w));
  return rsqrtf(t * (1.0f / D) + EPS);
}
__device__ __forceinline__ float row16_sum(float v) {
  v += __builtin_bit_cast(float, __builtin_amdgcn_update_dpp(0, __builtin_bit_cast(int, v), 0x128, 0xf, 0xf, true));
  v += __builtin_bit_cast(float, __builtin_amdgcn_update_dpp(0, __builtin_bit_cast(int, v), 0x124, 0xf, 0xf, true));
  v += __builtin_bit_cast(float, __builtin_amdgcn_update_dpp(0, __builtin_bit_cast(int, v), 0x122, 0xf, 0xf, true));
  v += __builtin_bit_cast(float, __builtin_amdgcn_update_dpp(0, __builtin_bit_cast(int, v), 0x121, 0xf, 0xf, true));
  return v;
}
__device__ __forceinline__ int opaque_tid() { int t = threadIdx.x; asm volatile("" : "+v"(t)); return t; }

__device__ __forceinline__ const float* hrow_ptr(const float* x, const float* meta, int row) {
  int b = row / LP, pos = row - b * LP;
  if (pos < NMETA) return meta + (size_t)pos * D;
  if (pos < LREAL) return x + ((size_t)b * SEQ + (pos - NMETA)) * D;
  return nullptr;
}


typedef float f32x16 __attribute__((ext_vector_type(16)));
typedef short v4i16_t __attribute__((ext_vector_type(4)));
typedef __bf16 bf16v2_t __attribute__((ext_vector_type(2)));
typedef float f32x2_t __attribute__((ext_vector_type(2)));
#define LDSP(T, p) ((__attribute__((address_space(3))) T*)(p))
#define MFMA32(a, b, c) __builtin_amdgcn_mfma_f32_32x32x16_bf16((a), (b), (c), 0, 0, 0)
__device__ __forceinline__ unsigned cvtpk(float lo, float hi) { f32x2_t v = {lo, hi}; return __builtin_bit_cast(unsigned, __builtin_convertvector(v, bf16v2_t)); }
__device__ __forceinline__ float half_swap_max(float m) { auto rr = __builtin_amdgcn_permlane32_swap(__float_as_uint(m), __float_as_uint(m), false, false); return fmaxf(__uint_as_float(rr[0]), __uint_as_float(rr[1])); }
__device__ __forceinline__ float half_swap_sum(float m) { auto rr = __builtin_amdgcn_permlane32_swap(__float_as_uint(m), __float_as_uint(m), false, false); return __uint_as_float(rr[0]) + __uint_as_float(rr[1]); }

__device__ __forceinline__ void attn_issue_kv(char* kvbuf, const bf16_t* __restrict__ kvrow0  , int tid, int wid) {
  const char* base = (const char*)kvrow0;
#pragma unroll
  for (int i = 0; i < 2; ++i) {
    const int g = i * 512 + tid, row = g >> 4, pos = g & 15;
    const unsigned offk = (unsigned)(row * (INC * 2) + 1024 + ((pos ^ (row & 15)) << 4));
    const unsigned offv = (unsigned)(row * (INC * 2) + 2048 + ((pos ^ ((row & 3) << 2)) << 4));
    __builtin_amdgcn_global_load_lds((const unsigned*)(base + offk), LDSP(unsigned, kvbuf + (i * 512 + wid * 64) * 16), 16, 0, 0);
    __builtin_amdgcn_global_load_lds((const unsigned*)(base + offv), LDSP(unsigned, kvbuf + 16384 + (i * 512 + wid * 64) * 16), 16, 0, 0);
  }
}

template <bool MASKED, bool MAXONLY>
__device__ __forceinline__ void attn_qk(uint4 (&pw)[4], float& mref, const char* qbase, int qsw, const char* kb, int c, int kq, float sl8, int lane, int r32, int hi,
                                         const bf16x8& augk0, const bf16x8& augk1, const bf16x8& augq) {
  const float c1 = 0.125f * 1.4426950408889634f;
  asm volatile("" : "+v"(qsw), "+v"(lane));
  f32x16 s0, s1;
  float soff;
  if (MASKED) {
    const float a1 = sl8, a2 = 2.0f * sl8, a3 = 3.0f * sl8, b8 = 8.0f * sl8;
    float gb = sl8 * (float)kq;
#pragma unroll
    for (int g = 0; g < 4; ++g) { s0[4 * g] = gb; s0[4 * g + 1] = gb + a1; s0[4 * g + 2] = gb + a2; s0[4 * g + 3] = gb + a3; gb += b8; }
#pragma unroll
    for (int g = 0; g < 4; ++g) { s1[4 * g] = gb; s1[4 * g + 1] = gb + a1; s1[4 * g + 2] = gb + a2; s1[4 * g + 3] = gb + a3; gb += b8; }
#pragma unroll
    for (int r = 0; r < 16; ++r) { s0[r] = s0[r] > 0.f ? -1e30f : s0[r]; s1[r] = s1[r] > 0.f ? -1e30f : s1[r]; }
    soff = 0.f;
  } else {
#pragma unroll
    for (int r = 0; r < 16; ++r) { s0[r] = 0.f; s1[r] = 0.f; }
    s0 = MFMA32(augk0, augq, s0);
    s1 = MFMA32(augk1, augq, s1);
    soff = sl8 * (float)(kq - 4 * hi);
  }
#pragma unroll
  for (int ks = 0; ks < 4; ++ks) {
    const int ch = c * 8 + ks * 2 + hi;
    bf16x8 bq = *(const bf16x8*)(qbase + ((ch ^ qsw) << 4));
    bf16x8 ka0 = *(const bf16x8*)(kb + r32 * 256 + ((ch ^ qsw) << 4));
    bf16x8 ka1 = *(const bf16x8*)(kb + (32 + r32) * 256 + ((ch ^ qsw) << 4));
    s0 = MFMA32(ka0, bq, s0);
    s1 = MFMA32(ka1, bq, s1);
    __builtin_amdgcn_sched_barrier(0);
  }
  if (MAXONLY) {
    float m0 = fmaxf(s0[0], s1[0]), m1 = fmaxf(s0[1], s1[1]), m2 = fmaxf(s0[2], s1[2]), m3 = fmaxf(s0[3], s1[3]);
#pragma unroll
    for (int r = 4; r < 16; r += 4) {
      m0 = fmaxf(fmaxf(m0, s0[r]), s1[r]); m1 = fmaxf(fmaxf(m1, s0[r + 1]), s1[r + 1]); m2 = fmaxf(fmaxf(m2, s0[r + 2]), s1[r + 2]); m3 = fmaxf(fmaxf(m3, s0[r + 3]), s1[r + 3]);
    }
    mref = fmaxf(mref, half_swap_max(fmaxf(fmaxf(m0, m1), fmaxf(m2, m3))) + soff);
    return;
  }
  const f32x2_t c1v = {c1, c1}, nmv = {(soff - mref) * c1, (soff - mref) * c1};
#pragma unroll
  for (int r = 0; r < 16; r += 2) {
    f32x2_t x0 = {s0[r], s0[r + 1]}, x1 = {s1[r], s1[r + 1]};
    x0 = __builtin_elementwise_fma(x0, c1v, nmv); x1 = __builtin_elementwise_fma(x1, c1v, nmv);
    x0.x = __builtin_amdgcn_exp2f(x0.x); x0.y = __builtin_amdgcn_exp2f(x0.y); x1.x = __builtin_amdgcn_exp2f(x1.x); x1.y = __builtin_amdgcn_exp2f(x1.y);
    s0[r] = x0.x; s0[r + 1] = x0.y; s1[r] = x1.x; s1[r + 1] = x1.y;
  }
#pragma unroll
  for (int kk = 0; kk < 2; ++kk) {
    pw[kk] = make_uint4(cvtpk(s0[8 * kk], s0[8 * kk + 1]), cvtpk(s0[8 * kk + 2], s0[8 * kk + 3]), cvtpk(s0[8 * kk + 4], s0[8 * kk + 5]), cvtpk(s0[8 * kk + 6], s0[8 * kk + 7]));
    pw[2 + kk] = make_uint4(cvtpk(s1[8 * kk], s1[8 * kk + 1]), cvtpk(s1[8 * kk + 2], s1[8 * kk + 3]), cvtpk(s1[8 * kk + 4], s1[8 * kk + 5]), cvtpk(s1[8 * kk + 6], s1[8 * kk + 7]));
  }
}

__device__ __forceinline__ void attn_pv(f32x16 (&o)[4], f32x16& osum, const uint4 (&pw)[4], const char* vb, int lane, int hi) {
  asm volatile("" : "+v"(lane));
  const int q4 = (lane & 15) >> 2, g1 = (lane >> 4) & 1, p4 = lane & 3;
#pragma unroll
  for (int kk = 0; kk < 4; ++kk) {
    const int key0 = 16 * kk + 4 * hi + q4;
    const bf16x8 pb = __builtin_bit_cast(bf16x8, pw[kk]);
    osum = MFMA32(__builtin_bit_cast(bf16x8, make_uint4(0x3F803F80u, 0x3F803F80u, 0x3F803F80u, 0x3F803F80u)), pb, osum);
#pragma unroll
    for (int dvt = 0; dvt < 4; ++dvt) {
      const int c8 = 8 * (dvt ^ q4) + 4 * g1 + p4;
      v4i16_t lo = __builtin_amdgcn_ds_read_tr16_b64_v4i16(LDSP(v4i16_t, vb + key0 * 256 + c8 * 8));
      v4i16_t hi4 = __builtin_amdgcn_ds_read_tr16_b64_v4i16(LDSP(v4i16_t, vb + (key0 + 8) * 256 + c8 * 8));
      bf16x8 va = (bf16x8){lo[0], lo[1], lo[2], lo[3], hi4[0], hi4[1], hi4[2], hi4[3]};
      o[dvt] = MFMA32(va, pb, o[dvt]);
    }
    __builtin_amdgcn_sched_barrier(0);
  }
}

__device__ __forceinline__ void attn_unit(char* lds, const bf16_t* __restrict__ proj, bf16_t* mix, const float* __restrict__ subg, const unsigned* __restrict__ kmax, float lam, int b, int h, int t) {
  const int tix = opaque_tid();
  const int tid = tix, lane = tid & 63, r32 = lane & 31, hi = lane >> 5;
  const int wid = __builtin_amdgcn_readfirstlane(tid >> 6);
  const int c = wid >> 2, qg = wid & 3;
  const int q0 = NMETA + 128 * t, qw0 = q0 + 32 * qg, qpos = qw0 + r32;
  const size_t rowb = (size_t)b * LP;
  const int NT = 2 * t + 3;
  char* Qs = lds;
  char* KV = lds + 32768;
  const float sl8 = exp2f(1.0f - 2.0f * (float)h);
  __syncthreads();
  attn_issue_kv(KV, proj + rowb * INC + h * 128, tid, wid);
#pragma unroll
  for (int i = 0; i < 4; ++i) {
    const int g = i * 512 + tid, row = g >> 4, pos = g & 15;
    uint4 v = *(const uint4*)(proj + (rowb + q0 + row) * INC + h * 128 + ((pos ^ (row & 15)) << 3));
    *(uint4*)(Qs + g * 16) = v;
  }
  f32x16 o[4];
#pragma unroll
  for (int i = 0; i < 4; ++i)
#pragma unroll
    for (int r = 0; r < 16; ++r) o[i][r] = 0.f;
  f32x16 osum;
#pragma unroll
  for (int r = 0; r < 16; ++r) osum[r] = 0.f;
  bf16x8 augk0, augk1, augq;
  {
    const unsigned k0w = hi == 0 ? cvtpk((float)r32, 0.f) : 0u, k1w = hi == 0 ? cvtpk((float)(32 + r32), 0.f) : 0u, qw = hi == 0 ? cvtpk(sl8, 0.f) : 0u;
    augk0 = __builtin_bit_cast(bf16x8, make_uint4(k0w, 0u, 0u, 0u)); augk1 = __builtin_bit_cast(bf16x8, make_uint4(k1w, 0u, 0u, 0u)); augq = __builtin_bit_cast(bf16x8, make_uint4(qw, 0u, 0u, 0u));
  }
  const int qrow = 32 * qg + r32;
  const char* qbase = Qs + qrow * 256;
  const int qsw = qrow & 15;
  float mref; bool loose;
  int* lflag = (int*)(lds + 131072);
  {
    float kn2 = 0.f;
    if (lane < 16) {
      const uint4* kp = (const uint4*)(proj + (rowb + lane) * INC + 512 + h * 128 + c * 64);
#pragma unroll
      for (int i = 0; i < 8; ++i) { const uint4 w = kp[i]; kn2 = dot8(w, w, kn2); }
    }
    kn2 = fmaxf(wave_max(kn2), __uint_as_float(kmax[b * 8 + h * 2 + c]));
    if (tid == 0) *lflag = 0;
    __syncthreads();
    float qn2 = 0.f;
#pragma unroll
    for (int ks = 0; ks < 4; ++ks) { const uint4 w = *(const uint4*)(qbase + (((c * 8 + ks * 2 + hi) ^ qsw) << 4)); qn2 = dot8(w, w, qn2); }
    qn2 = half_swap_sum(qn2);
    const float bound = sqrtf(qn2 * kn2) * 1.02f;
    mref = bound - 60.0f / (0.125f * 1.4426950408889634f);
    float sd = 0.f;
#pragma unroll
    for (int ks = 0; ks < 4; ++ks) {
      const uint4 wq = *(const uint4*)(qbase + (((c * 8 + ks * 2 + hi) ^ qsw) << 4));
      const uint4 wk = *(const uint4*)(proj + (rowb + qpos) * INC + 512 + h * 128 + (c * 8 + ks * 2 + hi) * 8);
      sd = dot8(wq, wk, sd);
    }
    sd = half_swap_sum(sd);
    loose = (bound - sd) * (0.125f * 1.4426950408889634f) > 170.0f;
  }
  uint4 pw[4];
  if (__any(loose) && lane == 0) *lflag = 1;
  __syncthreads();
  if (*lflag) {
    float mx = -1e30f; int sl = 0;
    for (int j = 0; j < NT; ++j) {
      asm volatile("s_waitcnt vmcnt(0)" ::: "memory");
      __syncthreads();
      if (j + 1 < NT) attn_issue_kv(KV + (sl == 2 ? 0 : sl + 1) * 32768, proj + (rowb + 64 * (j + 1)) * INC + h * 128, tid, wid);
      if (64 * j <= qw0 + 31) {
        const int kq = 64 * j + 4 * hi - qpos;
        if (64 * j + 63 > qw0) attn_qk<true, true>(pw, mx, qbase, qsw, KV + sl * 32768, c, kq, sl8, lane, r32, hi, augk0, augk1, augq);
        else attn_qk<false, true>(pw, mx, qbase, qsw, KV + sl * 32768, c, kq, sl8, lane, r32, hi, augk0, augk1, augq);
      }
      sl = (sl == 2 ? 0 : sl + 1);
    }
    mref = mx;
    __syncthreads();
    attn_issue_kv(KV, proj + rowb * INC + h * 128, tid, wid);
  }
  bool have = false;
  int slot = 0, pslot = 0;
  for (int j = 0; j <= NT; ++j) {
    if (j < NT) {
      asm volatile("s_waitcnt vmcnt(0)" ::: "memory");
      __syncthreads();
      if (j + 1 < NT) attn_issue_kv(KV + (slot == 2 ? 0 : slot + 1) * 32768, proj + (rowb + 64 * (j + 1)) * INC + h * 128, tid, wid);
    }
    if (have) { attn_pv(o, osum, pw, KV + pslot * 32768 + 16384, lane, hi); have = false; }
    if (j < NT && 64 * j <= qw0 + 31) {
      const char* kb = KV + slot * 32768;
      const int kq = 64 * j + 4 * hi - qpos;
      if (64 * j + 63 > qw0) attn_qk<true, false>(pw, mref, qbase, qsw, kb, c, kq, sl8, lane, r32, hi, augk0, augk1, augq);
      else attn_qk<false, false>(pw, mref, qbase, qsw, kb, c, kq, sl8, lane, r32, hi, augk0, augk1, augq);
      if (c == 0) attn_pv(o, osum, pw, kb + 16384, lane, hi); else have = true;
    }
    pslot = slot; slot = (slot == 2 ? 0 : slot + 1);
  }
  const float sc = (c == 0 ? 1.0f : lam) / osum[0];
  __syncthreads();
  float* X = (float*)(lds + 32768);
  if (c == 1) {
#pragma unroll
    for (int i = 0; i < 4; ++i)
#pragma unroll
      for (int r = 0; r < 16; ++r) X[(qg * 64 + i * 16 + r) * 64 + lane] = o[i][r] * sc;
  }
  __syncthreads();
  if (c == 0) {
    float ss = 0.f;
#pragma unroll
    for (int i = 0; i < 4; ++i) {
#pragma unroll
      for (int r = 0; r < 16; ++r) { float v = o[i][r] * sc - X[(qg * 64 + i * 16 + r) * 64 + lane]; o[i][r] = v; ss += v * v; }
      __builtin_amdgcn_sched_barrier(0);
    }
    ss = half_swap_sum(ss);
    const float rstd = rsqrtf(ss * (1.0f / 128.0f) + EPS) * (1.0f - LAM_INIT);
    bf16_t* orow = mix + (rowb + qpos) * D + h * 128;
#pragma unroll
    for (int i = 0; i < 4; ++i) {
#pragma unroll
      for (int g = 0; g < 4; ++g) {
        const int dv0 = 32 * i + 8 * g + 4 * hi;
        const float4 sg = *(const float4*)(subg + dv0);
        uint2 w; w.x = cvtpk(o[i][4 * g] * rstd * sg.x, o[i][4 * g + 1] * rstd * sg.y); w.y = cvtpk(o[i][4 * g + 2] * rstd * sg.z, o[i][4 * g + 3] * rstd * sg.w);
        *(uint2*)(orow + dv0) = w;
      }
      __builtin_amdgcn_sched_barrier(0);
    }
  }
}


__device__ __forceinline__ void p_norm1_rows(int G, const float* __restrict__ x, const float* __restrict__ meta, const float* __restrict__ g1, bf16_t* xn1) {
  const int tix = opaque_tid();
  const int lane = tix & 63, wv = blockIdx.x * 8 + (tix >> 6);
  float4 g[4];
#pragma unroll
  for (int q = 0; q < 4; ++q) g[q] = ((const float4*)g1)[q * 64 + lane];
  for (int row = wv * 2; row < ROWS; row += G * 16) {
    float4 v[2][4];
#pragma unroll
    for (int r = 0; r < 2; ++r) {
      const float* src = hrow_ptr(x, meta, row + r);
#pragma unroll
      for (int q = 0; q < 4; ++q) v[r][q] = src ? ((const float4*)src)[q * 64 + lane] : make_float4(0.f, 0.f, 0.f, 0.f);
    }
#pragma unroll
    for (int r = 0; r < 2; ++r) {
      float ss = 0.f;
#pragma unroll
      for (int q = 0; q < 4; ++q) ss += (v[r][q].x * v[r][q].x + v[r][q].y * v[r][q].y) + (v[r][q].z * v[r][q].z + v[r][q].w * v[r][q].w);
      const float rstd = rsqrtf(wave_sum(ss) * (1.0f / D) + EPS);
#pragma unroll
      for (int q = 0; q < 4; ++q) {
        uint2 o; o.x = cvtpk(v[r][q].x * rstd * g[q].x, v[r][q].y * rstd * g[q].y); o.y = cvtpk(v[r][q].z * rstd * g[q].z, v[r][q].w * rstd * g[q].w);
        ((uint2*)(xn1 + (size_t)(row + r) * D))[q * 64 + lane] = o;
      }
    }
  }
}

__device__ __forceinline__ void conv_unit(char* lds, const bf16_t* __restrict__ proj, bf16_t* mix, const float* __restrict__ cw, const float* __restrict__ cb,
                                          const float* __restrict__ gng, const float* __restrict__ gnb, int b, int pos0) {
  const int tix = opaque_tid();
  const int c = tix;
  float* U = (float*)lds;
  __syncthreads();
  {
    const int lane = tix & 63, wv = tix >> 6;
    uint4 ra[8], rg[8];
#pragma unroll
    for (int i = 0; i < 8; ++i) {
      const int r = wv + 8 * i, pos = pos0 - 30 + r;
      ra[i] = make_uint4(0, 0, 0, 0); rg[i] = make_uint4(0, 0, 0, 0);
      if (r < 62 && pos >= 0) {
        const bf16_t* pr = proj + ((size_t)b * LP + pos) * INC + 8 * lane;
        ra[i] = *(const uint4*)(pr + 1536); rg[i] = *(const uint4*)(pr + 2048);
      }
    }
#pragma unroll
    for (int i = 0; i < 8; ++i) {
      const int r = wv + 8 * i;
      if (r < 62) {
        const unsigned av[4] = {ra[i].x, ra[i].y, ra[i].z, ra[i].w}, gv[4] = {rg[i].x, rg[i].y, rg[i].z, rg[i].w};
        float u[8];
#pragma unroll
        for (int q = 0; q < 4; ++q) {
          const float a0 = __uint_as_float(av[q] << 16), a1 = __uint_as_float(av[q] & 0xffff0000u), g0 = __uint_as_float(gv[q] << 16), g1 = __uint_as_float(gv[q] & 0xffff0000u);
          u[2 * q] = a0 / (1.0f + __expf(-g0)); u[2 * q + 1] = a1 / (1.0f + __expf(-g1));
        }
        *(float4*)(U + r * 512 + 8 * lane) = make_float4(u[0], u[1], u[2], u[3]);
        *(float4*)(U + r * 512 + 8 * lane + 4) = make_float4(u[4], u[5], u[6], u[7]);
      }
    }
  }
  float w[31];
#pragma unroll
  for (int j = 0; j < 31; ++j) w[j] = cw[j * 512 + c];
  const float bias = cb[c], gg = gng[c], gb2 = gnb[c];
  __syncthreads();
#pragma unroll 1
  for (int t0 = 0; t0 < 32; t0 += 4) {
    float y[4] = {bias, bias, bias, bias};
#pragma unroll
    for (int r = 0; r < 34; ++r) {
      const float u = U[(t0 + r) * 512 + c];
#pragma unroll
      for (int q = 0; q < 4; ++q) { const int j = r - q; if (j >= 0 && j < 31) y[q] = fmaf(w[j], u, y[q]); }
    }
#pragma unroll
    for (int q = 0; q < 4; ++q) {
      float sm = row16_sum(y[q]);
      sm += __shfl_xor(sm, 16); sm = half_swap_sum(sm);
      const float d = y[q] - sm * (1.0f / 64.0f);
      float vr = row16_sum(d * d);
      vr += __shfl_xor(vr, 16); vr = half_swap_sum(vr);
      const float n = d * rsqrtf(vr * (1.0f / 64.0f) + EPS) * gg + gb2;
      mix[((size_t)b * LP + pos0 + t0 + q) * D + 512 + c] = f2bf(n / (1.0f + __expf(-n)));
    }
  }
}


__device__ __forceinline__ void ce_desc(float& a, float& b) { const float hi = fmaxf(a, b), lo = fminf(a, b); a = hi; b = lo; }
__device__ __forceinline__ void ce_asc(float& a, float& b) { const float hi = fmaxf(a, b), lo = fminf(a, b); a = lo; b = hi; }
template <int N> __device__ __forceinline__ void bitonic_sort_desc(float (&v)[N]) {
#pragma unroll
  for (int k = 2; k <= N; k <<= 1)
#pragma unroll
    for (int j = k >> 1; j > 0; j >>= 1)
#pragma unroll
      for (int i = 0; i < N; ++i) { const int l = i ^ j; if (l > i) { if ((i & k) == 0) ce_desc(v[i], v[l]); else ce_asc(v[i], v[l]); } }
}
template <int N> __device__ __forceinline__ void bitonic_merge_desc(float (&v)[N]) {
#pragma unroll
  for (int j = N >> 1; j > 0; j >>= 1)
#pragma unroll
    for (int i = 0; i < N; ++i) { const int l = i ^ j; if (l > i) ce_desc(v[i], v[l]); }
}
__host__ __device__ constexpr int cand_slot(int i, int j) { int s = 0; for (int ii = 0; ii < i; ++ii) s += 16 / (ii + 1); return s + j; }

__device__ __forceinline__ void peer_topk_unit(char* lds, const bf16_t* __restrict__ qp, const bf16_t* __restrict__ skb, const float* __restrict__ rowss, int* eb, float* gb, int row0, int h) {
  const int tix = opaque_tid();
  const int tid = tix, lane = tid & 63, wid = tid >> 6, fr = lane & 15, fq = lane >> 4;
  __syncthreads();
#pragma unroll
  for (int i = 0; i < 8; ++i) {
    const int g = i * 512 + tid, row = g >> 4, pos = g & 15;
    *(uint4*)(lds + g * 16) = *(const uint4*)(skb + ((size_t)(h * 2) * 128 + row) * 128 + ((pos ^ (row & 15)) << 3));
  }
  if (tid < 64) {
    int i = 0, base = 0;
    while (i < 15 && tid >= base + 16 / (i + 1)) { base += 16 / (i + 1); ++i; }
    ((int*)(lds + 65536))[tid] = (i << 4) | ((tid - base) & 15);
  }
  __syncthreads();
  const int tok = row0 + wid * 16 + fr;
  float top[2][16];
#pragma unroll
  for (int p = 0; p < 2; ++p) {
    f32x4 acc[8];
#pragma unroll
    for (int i = 0; i < 8; ++i) acc[i] = (f32x4){0.f, 0.f, 0.f, 0.f};
    const bf16_t* xrow = qp + (size_t)tok * 2048 + h * 256 + p * 128 + fq * 8;
#pragma unroll
    for (int ks = 0; ks < 4; ++ks) {
      const bf16x8 xb = *(const bf16x8*)(xrow + ks * 32);
      const int ch = ks * 4 + fq;
#pragma unroll
      for (int nt = 0; nt < 8; ++nt) {
        const int r = p * 128 + nt * 16 + fr;
        const bf16x8 wa = *(const bf16x8*)(lds + r * 256 + ((ch ^ (r & 15)) << 4));
        acc[nt] = __builtin_amdgcn_mfma_f32_16x16x32_bf16(wa, xb, acc[nt], 0, 0, 0);
      }
    }
    float v[32];
#pragma unroll
    for (int nt = 0; nt < 8; ++nt)
#pragma unroll
      for (int r = 0; r < 4; ++r) v[nt * 4 + r] = __uint_as_float((__float_as_uint(acc[nt][r]) & ~127u) | (unsigned)(nt * 16 + fq * 4 + r));
    bitonic_sort_desc<32>(v);
    float t[16];
#pragma unroll
    for (int i = 0; i < 16; ++i) t[i] = v[i];
#pragma unroll
    for (int rnd = 0; rnd < 2; ++rnd) {
      float pb[16];
#pragma unroll
      for (int i = 0; i < 16; ++i) pb[i] = __shfl_xor(t[15 - i], rnd == 0 ? 16 : 32);
#pragma unroll
      for (int i = 0; i < 16; ++i) t[i] = fmaxf(t[i], pb[i]);
      bitonic_merge_desc<16>(t);
    }
#pragma unroll
    for (int i = 0; i < 16; ++i) top[p][i] = t[i];
  }
  int* ST = (int*)(lds + 65536);
  int* IDX = (int*)(lds + 65536 + 256) + (wid * 16 + fr) * 32;
#define SEL4(arr, q) (fq == 0 ? arr[q] : fq == 1 ? arr[4 + (q)] : fq == 2 ? arr[8 + (q)] : arr[12 + (q)])
  {
    int4 ia, ib;
    ia.x = __float_as_uint(SEL4(top[0], 0)) & 127; ia.y = __float_as_uint(SEL4(top[0], 1)) & 127; ia.z = __float_as_uint(SEL4(top[0], 2)) & 127; ia.w = __float_as_uint(SEL4(top[0], 3)) & 127;
    ib.x = __float_as_uint(SEL4(top[1], 0)) & 127; ib.y = __float_as_uint(SEL4(top[1], 1)) & 127; ib.z = __float_as_uint(SEL4(top[1], 2)) & 127; ib.w = __float_as_uint(SEL4(top[1], 3)) & 127;
    *(int4*)(IDX + 4 * fq) = ia; *(int4*)(IDX + 16 + 4 * fq) = ib;
  }
  float cv[16];
  {
    const float NEGV = -3.0e38f;
    float am[16], bm[16];
#pragma unroll
    for (int i = 0; i < 16; ++i) { am[i] = __uint_as_float(__float_as_uint(top[0][i]) & ~127u); bm[i] = __uint_as_float(__float_as_uint(top[1][i]) & ~127u); }
#define CAND(i, j) __uint_as_float((__float_as_uint(am[i] + bm[j]) & ~63u) | (unsigned)cand_slot(i, j))
    float A[16], B[16], C[16], Dd[8], E[8], F[16];
#pragma unroll
    for (int j = 0; j < 16; ++j) A[j] = CAND(0, j);
#pragma unroll
    for (int j = 0; j < 8; ++j) { B[j] = CAND(1, j); B[15 - j] = CAND(8 + j, 0); }
    bitonic_merge_desc<16>(B);
#pragma unroll
    for (int j = 0; j < 5; ++j) C[j] = CAND(2, j);
#pragma unroll
    for (int j = 5; j < 12; ++j) C[j] = NEGV;
#pragma unroll
    for (int j = 0; j < 4; ++j) C[15 - j] = CAND(3, j);
    bitonic_merge_desc<16>(C);
    Dd[0] = CAND(4, 0); Dd[1] = CAND(4, 1); Dd[2] = CAND(4, 2); Dd[3] = NEGV; Dd[4] = NEGV; Dd[5] = NEGV; Dd[6] = CAND(5, 1); Dd[7] = CAND(5, 0);
    bitonic_merge_desc<8>(Dd);
    E[0] = CAND(6, 0); E[1] = CAND(6, 1); E[2] = NEGV; E[3] = NEGV; E[4] = NEGV; E[5] = NEGV; E[6] = CAND(7, 1); E[7] = CAND(7, 0);
    bitonic_merge_desc<8>(E);
#pragma unroll
    for (int j = 0; j < 8; ++j) { F[j] = Dd[j]; F[15 - j] = E[j]; }
    bitonic_merge_desc<16>(F);
#undef CAND
#pragma unroll
    for (int j = 0; j < 16; ++j) { A[j] = fmaxf(A[j], B[15 - j]); C[j] = fmaxf(C[j], F[15 - j]); }
    bitonic_merge_desc<16>(A);
    bitonic_merge_desc<16>(C);
#pragma unroll
    for (int j = 0; j < 16; ++j) cv[j] = fmaxf(A[j], C[15 - j]);
    bitonic_merge_desc<16>(cv);
  }
  float ex[16]; float sum = 0.f;
  const float c0v = __uint_as_float(__float_as_uint(cv[0]) & ~63u);
  const float rs = row_rstd(rowss, (size_t)tok);
#pragma unroll
  for (int i = 0; i < 16; ++i) { ex[i] = __expf((__uint_as_float(__float_as_uint(cv[i]) & ~63u) - c0v) * rs); sum += ex[i]; }
  const float inv = 1.0f / sum;
  int e4[4]; float g4[4];
#pragma unroll
  for (int q = 0; q < 4; ++q) {
    const int slot = __float_as_uint(SEL4(cv, q)) & 63;
    const int ij = ST[slot];
    e4[q] = IDX[ij >> 4] * 128 + IDX[16 + (ij & 15)];
    g4[q] = SEL4(ex, q) * inv;
  }
#undef SEL4
  *(int4*)(eb + ((size_t)tok * 8 + h) * 16 + 4 * fq) = make_int4(e4[0], e4[1], e4[2], e4[3]);
  *(float4*)(gb + ((size_t)tok * 8 + h) * 16 + 4 * fq) = make_float4(g4[0], g4[1], g4[2], g4[3]);
}

__device__ __forceinline__ void p_cvt_bf16(int blk, int nblk, const float* __restrict__ src, bf16_t* dst, size_t n8) {
  const int tix = opaque_tid();
  for (size_t i = (size_t)blk * 512 + tix; i < n8; i += (size_t)nblk * 512) {
    const float4 a = ((const float4*)src)[2 * i], b = ((const float4*)src)[2 * i + 1];
    uint4 w; w.x = cvtpk(a.x, a.y); w.y = cvtpk(a.z, a.w); w.z = cvtpk(b.x, b.y); w.w = cvtpk(b.z, b.w);
    ((uint4*)dst)[i] = w;
  }
}


typedef float f32x2v __attribute__((ext_vector_type(2)));
__device__ __forceinline__ void p_cvt_fp8_rows(int blk, int nblk, const float* __restrict__ src, unsigned* dst, float* inv, const float* __restrict__ csc) {
  const int tix = opaque_tid();
  const int lane = tix & 63, wid = tix >> 6;
  for (int r = blk * 8 + wid; r < 16384; r += nblk * 8) {
    const float4* sp = (const float4*)(src + (size_t)r * D);
    float4 v[4];
#pragma unroll
    for (int k = 0; k < 4; ++k) v[k] = sp[k * 64 + lane];
    if (csc) {
#pragma unroll
      for (int k = 0; k < 4; ++k) { const float4 g = ((const float4*)csc)[k * 64 + lane]; v[k].x *= g.x; v[k].y *= g.y; v[k].z *= g.z; v[k].w *= g.w; }
    }
    float am = 0.f;
#pragma unroll
    for (int k = 0; k < 4; ++k) am = fmaxf(am, fmaxf(fmaxf(fabsf(v[k].x), fabsf(v[k].y)), fmaxf(fabsf(v[k].z), fabsf(v[k].w))));
    am = wave_max(am);
    const float sc = am > 0.f ? 384.0f / am : 1.0f;
#pragma unroll
    for (int k = 0; k < 4; ++k) {
      int w = __builtin_amdgcn_cvt_pk_fp8_f32(v[k].x * sc, v[k].y * sc, 0, false);
      w = __builtin_amdgcn_cvt_pk_fp8_f32(v[k].z * sc, v[k].w * sc, w, true);
      { const int c = 256 * k + 4 * lane; dst[((size_t)(c >> 7) * (16384 * 128) + (size_t)r * 128 + (c & 127)) >> 2] = (unsigned)w; }
    }
    if (lane == 0) inv[r] = am > 0.f ? am * (1.0f / 384.0f) : 1.0f;
  }
}


__device__ __forceinline__ unsigned xcc_id() { return (unsigned)__builtin_amdgcn_s_getreg((3 << 11) | 20) & 7u; }

__device__ __forceinline__ void ds_issue(uint4 (&u)[16], const int* El  , const unsigned char* __restrict__ tab) {
  int ev[16];
#pragma unroll
  for (int q = 0; q < 4; ++q) { const int4 t = *(const int4*)(El + 4 * q); ev[4 * q] = t.x; ev[4 * q + 1] = t.y; ev[4 * q + 2] = t.z; ev[4 * q + 3] = t.w; }
#pragma unroll
  for (int it = 0; it < 16; ++it) u[it] = *(const uint4*)(tab + (size_t)(unsigned)ev[it] * 128);
}
__device__ __forceinline__ void ds_u_compute(const uint4 (&u)[16], const char* Xl  , float* __restrict__ pout, int j) {
  f32x2v xf[8];
  {
    const uint4 a = *(const uint4*)Xl, c = *(const uint4*)(Xl + 16);
    xf[0] = (f32x2v){__uint_as_float(a.x << 16), __uint_as_float(a.x & 0xffff0000u)}; xf[1] = (f32x2v){__uint_as_float(a.y << 16), __uint_as_float(a.y & 0xffff0000u)};
    xf[2] = (f32x2v){__uint_as_float(a.z << 16), __uint_as_float(a.z & 0xffff0000u)}; xf[3] = (f32x2v){__uint_as_float(a.w << 16), __uint_as_float(a.w & 0xffff0000u)};
    xf[4] = (f32x2v){__uint_as_float(c.x << 16), __uint_as_float(c.x & 0xffff0000u)}; xf[5] = (f32x2v){__uint_as_float(c.y << 16), __uint_as_float(c.y & 0xffff0000u)};
    xf[6] = (f32x2v){__uint_as_float(c.z << 16), __uint_as_float(c.z & 0xffff0000u)}; xf[7] = (f32x2v){__uint_as_float(c.w << 16), __uint_as_float(c.w & 0xffff0000u)};
  }
  float k0 = 0.f, k1 = 0.f;
#pragma unroll
  for (int it = 0; it < 16; ++it) {
    const unsigned wv[4] = {u[it].x, u[it].y, u[it].z, u[it].w};
    f32x2v d2 = {0.f, 0.f};
#pragma unroll
    for (int q = 0; q < 4; ++q) {
      const f32x2v lo = __builtin_amdgcn_cvt_pk_f32_fp8((int)wv[q], false), hi = __builtin_amdgcn_cvt_pk_f32_fp8((int)wv[q], true);
      d2 = __builtin_elementwise_fma(lo, xf[2 * q], d2); d2 = __builtin_elementwise_fma(hi, xf[2 * q + 1], d2);
    }
    const float d = sum8(d2.x + d2.y);
    if ((it >> 1) == j) { if (it & 1) k1 = d; else k0 = d; }
  }
  *(float2*)pout = make_float2(k0, k1);
}
__device__ __forceinline__ void ds_u_chunk(char* wl  , int lane, int tk0, int s, const bf16_t* __restrict__ xn2, const int* __restrict__ eb, const unsigned char* __restrict__ ut8, float* __restrict__ partial) {
  const int b = tk0 / SEQ, sq = tk0 - b * SEQ;
  const size_t row0 = (size_t)b * LP + NMETA + sq;
  const int j = lane & 7, gi = lane >> 3;
  int* El = (int*)wl;
  char* Xl = wl + 8192;
#pragma unroll
  for (int i = 0; i < 8; ++i) *(int4*)(El + (i * 64 + lane) * 4) = *(const int4*)(eb + row0 * 128 + (i * 64 + lane) * 4);
#pragma unroll
  for (int i = 0; i < 4; ++i) { const int g = i * 64 + lane, t = g >> 4, c = g & 15; *(uint4*)(Xl + g * 16) = *(const uint4*)(xn2 + (row0 + t) * D + 128 * s + 8 * c); }
  const unsigned char* tab = ut8 + (size_t)s * (16384 * 128) + 16 * j;
  float* pout = partial + ((size_t)tk0 * 8 + s) * 128 + gi * 16 + 2 * j;
  uint4 ua[16], ub[16];
  ds_issue(ua, El + gi * 16, tab);
#pragma unroll 1
  for (int t = 0; t < 16; t += 2) {
    ds_issue(ub, El + (t + 1) * 128 + gi * 16, tab);
    ds_u_compute(ua, Xl + t * 256 + 32 * j, pout + (size_t)t * 1024, j);
    if (t + 2 < 16) ds_issue(ua, El + (t + 2) * 128 + gi * 16, tab);
    ds_u_compute(ub, Xl + (t + 1) * 256 + 32 * j, pout + (size_t)(t + 1) * 1024, j);
  }
}

__device__ __forceinline__ void ds_v_compute(const uint4 (&v)[16], const float* Wl  , int lane, int j, int gi, size_t row, int tk, int s,
                                             const bf16_t* __restrict__ hb, float* __restrict__ out, float* __restrict__ ssq) {
  const int c0 = 128 * s + 16 * j + 4 * (gi & 3);
  const uint2 hw = *(const uint2*)(hb + row * D + c0);
  float w[16];
#pragma unroll
  for (int q = 0; q < 4; ++q) { const float4 f = *(const float4*)(Wl + 4 * q); w[4 * q] = f.x; w[4 * q + 1] = f.y; w[4 * q + 2] = f.z; w[4 * q + 3] = f.w; }
  f32x2v acc[8];
#pragma unroll
  for (int i = 0; i < 8; ++i) acc[i] = (f32x2v){0.f, 0.f};
#pragma unroll
  for (int it = 0; it < 16; ++it) {
    const unsigned wv[4] = {v[it].x, v[it].y, v[it].z, v[it].w};
    const f32x2v w2 = {w[it], w[it]};
#pragma unroll
    for (int q = 0; q < 4; ++q) {
      const f32x2v lo = __builtin_amdgcn_cvt_pk_f32_fp8((int)wv[q], false), hi = __builtin_amdgcn_cvt_pk_f32_fp8((int)wv[q], true);
      acc[2 * q] = __builtin_elementwise_fma(w2, lo, acc[2 * q]); acc[2 * q + 1] = __builtin_elementwise_fma(w2, hi, acc[2 * q + 1]);
    }
  }
  float r4[4] = {0.f, 0.f, 0.f, 0.f};
#pragma unroll
  for (int i = 0; i < 16; ++i) {
    float t = (i & 1) ? acc[i >> 1].y : acc[i >> 1].x;
    t = dpp_add<0x128>(t);
    t += __shfl_xor(t, 16);
    t = half_swap_sum(t);
    if ((i >> 2) == gi) r4[i & 3] = t;
  }
  float ss = 0.f;
  if (gi < 4) {
    const float4 o = make_float4(__uint_as_float(hw.x << 16) + r4[0], __uint_as_float(hw.x & 0xffff0000u) + r4[1], __uint_as_float(hw.y << 16) + r4[2], __uint_as_float(hw.y & 0xffff0000u) + r4[3]);
    ss = o.x * o.x + o.y * o.y + o.z * o.z + o.w * o.w;
    *(float4*)(out + (size_t)tk * D + c0) = o;
  }
  ss = wave_sum(ss);
  if (lane == 0) ssq[(size_t)tk * 8 + s] = ss;
}
__device__ __forceinline__ void ds_v_chunk(char* wl, int lane, int tk0, int s, const bf16_t* __restrict__ hb, const int* __restrict__ eb, const float* __restrict__ wbuf, const unsigned char* __restrict__ vt8,
                                           float* __restrict__ out, float* __restrict__ ssq) {
  const int b = tk0 / SEQ, sq = tk0 - b * SEQ;
  const size_t row0 = (size_t)b * LP + NMETA + sq;
  const int j = lane & 7, gi = lane >> 3;
  int* El = (int*)wl;
  float* Wl = (float*)(wl + 8192);
#pragma unroll
  for (int i = 0; i < 8; ++i) {
    *(int4*)(El + (i * 64 + lane) * 4) = *(const int4*)(eb + row0 * 128 + (i * 64 + lane) * 4);
    *(float4*)(Wl + (i * 64 + lane) * 4) = *(const float4*)(wbuf + (size_t)tk0 * 128 + (i * 64 + lane) * 4);
  }
  const unsigned char* tab = vt8 + (size_t)s * (16384 * 128) + 16 * j;
  uint4 va[16], vb[16];
  ds_issue(va, El + gi * 16, tab);
#pragma unroll 1
  for (int t = 0; t < 16; t += 2) {
    ds_issue(vb, El + (t + 1) * 128 + gi * 16, tab);
    ds_v_compute(va, Wl + t * 128 + gi * 16, lane, j, gi, row0 + t, tk0 + t, s, hb, out, ssq);
    if (t + 2 < 16) ds_issue(va, El + (t + 2) * 128 + gi * 16, tab);
    ds_v_compute(vb, Wl + (t + 1) * 128 + gi * 16, lane, j, gi, row0 + t + 1, tk0 + t + 1, s, hb, out, ssq);
  }
}


struct EpiBf16 {
  bf16_t* out; int ld; int use_scale; unsigned* kmax;
  __device__ __forceinline__ void store8(size_t row, int col, const float (&v)[8], float& tmax) const {
    if (kmax && col >= 512 && col < 1024) {
      float ss = 0.f;
#pragma unroll
      for (int i = 0; i < 8; ++i) ss += v[i] * v[i];
      tmax = fmaxf(tmax, sum8(ss));
    }
    uint4 w; w.x = cvtpk(v[0], v[1]); w.y = cvtpk(v[2], v[3]); w.z = cvtpk(v[4], v[5]); w.w = cvtpk(v[6], v[7]);
    *(uint4*)(out + row * ld + col) = w;
  }
  __device__ __forceinline__ void finish(float tmax, size_t row, int col) const {
    if (kmax && col >= 512 && col < 1024) {
      tmax = wave_max(tmax);
      if ((threadIdx.x & 63) == 0) atomicMax(kmax + (row / LP) * 8 + ((col - 512) >> 6), __float_as_uint(tmax));
    }
  }
};
struct EpiResid2 {
  const float* x; const float* meta; float* h2; bf16_t* hb; float* rowss;
  __device__ __forceinline__ void finish(float, size_t, int) const {}
  __device__ __forceinline__ void store8(size_t row, int col, const float (&v)[8], float&) const {
    const float* src = hrow_ptr(x, meta, (int)row);
    const float4 a = *(const float4*)(src + col), b = *(const float4*)(src + col + 4);
    const float o[8] = {a.x + v[0], a.y + v[1], a.z + v[2], a.w + v[3], b.x + v[4], b.y + v[5], b.z + v[6], b.w + v[7]};
    uint4 w; w.x = cvtpk(o[0], o[1]); w.y = cvtpk(o[2], o[3]); w.z = cvtpk(o[4], o[5]); w.w = cvtpk(o[6], o[7]);
    *(uint4*)(hb + row * D + col) = w;
    float ss = 0.f;
#pragma unroll
    for (int i = 0; i < 8; ++i) ss += o[i] * o[i];
    ss = sum8(ss);
    if ((threadIdx.x & 7) == 0) rowss[row * 16 + (col >> 6)] = ss;
  }
};

template <class Epi>
__device__ __forceinline__ void gemm256(char* lds, const bf16_t* __restrict__ X, int ldx, const bf16_t* __restrict__ Wt, int ldw, int K, size_t xrow0, int n0, const Epi& epi) {
  const int tix = opaque_tid();
  const int tid = tix, lane = tid & 63;
  const int wid = __builtin_amdgcn_readfirstlane(tid >> 6);
  const int wm = wid >> 2, wn = wid & 3;
  const int fr = lane & 15, fq = lane >> 4;
  f32x4 acc[4][8];
#pragma unroll
  for (int i = 0; i < 4; ++i)
#pragma unroll
    for (int j = 0; j < 8; ++j) acc[i][j] = (f32x4){0.f, 0.f, 0.f, 0.f};
  const int nk = K >> 6;
  const int prow = lane >> 3, ppos = lane & 7;
  const char* xsrc = (const char*)(X + (xrow0 + 8 * wid + prow) * ldx);
  const char* wsrc = (const char*)(Wt + (size_t)(n0 + 8 * wid + prow) * ldw);
  const unsigned swz = (unsigned)((ppos ^ ((4 * wid + (prow >> 1)) & 7)) << 4);
#define G256_ISSUE(kt, buf) do { \
    _Pragma("unroll") for (int i_ = 0; i_ < 4; ++i_) { \
      __builtin_amdgcn_global_load_lds((const unsigned*)(xsrc + (size_t)(64 * i_) * ldx * 2 + (kt) * 128 + swz), LDSP(unsigned, lds + (buf) * 65536 + (i_ * 8 + wid) * 1024), 16, 0, 0); \
      __builtin_amdgcn_global_load_lds((const unsigned*)(wsrc + (size_t)(64 * i_) * ldw * 2 + (kt) * 128 + swz), LDSP(unsigned, lds + (buf) * 65536 + 32768 + (i_ * 8 + wid) * 1024), 16, 0, 0); \
    } } while (0)
  __syncthreads();
  G256_ISSUE(0, 0);
  asm volatile("s_waitcnt vmcnt(0)" ::: "memory");
  __syncthreads();
  for (int kt = 0; kt < nk; ++kt) {
    if (kt + 1 < nk) G256_ISSUE(kt + 1, (kt + 1) & 1);
    const char* la = lds + (kt & 1) * 65536;
    const char* lb = la + 32768;
#pragma unroll
    for (int kk = 0; kk < 2; ++kk) {
      const int c = kk * 4 + fq;
      bf16x8 xa[8], wb[4];
#pragma unroll
      for (int t = 0; t < 8; ++t) { const int r = wm * 128 + t * 16 + fr; xa[t] = *(const bf16x8*)(la + r * 128 + ((c ^ ((r >> 1) & 7)) << 4)); }
#pragma unroll
      for (int t = 0; t < 4; ++t) { const int r = wn * 64 + t * 16 + fr; wb[t] = *(const bf16x8*)(lb + r * 128 + ((c ^ ((r >> 1) & 7)) << 4)); }
#pragma unroll
      for (int nt = 0; nt < 4; ++nt)
#pragma unroll
        for (int tt = 0; tt < 8; ++tt) acc[nt][tt] = __builtin_amdgcn_mfma_f32_16x16x32_bf16(wb[nt], xa[tt], acc[nt][tt], 0, 0, 0);
    }
    asm volatile("s_waitcnt vmcnt(0)" ::: "memory");
    __syncthreads();
  }
#undef G256_ISSUE
  char* wl = lds + wid * 16384;
  float tmax = 0.f;
#pragma unroll
  for (int hf = 0; hf < 2; ++hf) {
#pragma unroll
    for (int t4 = 0; t4 < 4; ++t4)
#pragma unroll
      for (int nt = 0; nt < 4; ++nt) {
        const int t = t4 * 16 + fr, c16 = nt * 4 + fq;
        *(f32x4*)(wl + t * 256 + ((c16 ^ (t & 15)) << 4)) = acc[nt][hf * 4 + t4];
      }
#pragma unroll
    for (int i = 0; i < 8; ++i) {
      const int t = 8 * i + (lane >> 3), c8 = lane & 7;
      const f32x4 v0 = *(const f32x4*)(wl + t * 256 + (((2 * c8) ^ (t & 15)) << 4)), v1 = *(const f32x4*)(wl + t * 256 + (((2 * c8 + 1) ^ (t & 15)) << 4));
      const float v[8] = {v0[0], v0[1], v0[2], v0[3], v1[0], v1[1], v1[2], v1[3]};
      epi.store8(xrow0 + wm * 128 + hf * 64 + t, n0 + wn * 64 + 8 * c8, v, tmax);
    }
  }
  epi.finish(tmax, xrow0, n0 + wn * 64);
}

__device__ __forceinline__ void meta_proj(char* lds, int blk, const bf16_t* __restrict__ xn1, const bf16_t* __restrict__ wt_in, bf16_t* proj) {
  const int tix = opaque_tid();
  float* red = (float*)lds;
  __syncthreads();
  float part = 0.f;
  const int o = tix % 160, kp = tix / 160;
  if (tix < 480) {
    const int row = o / 10, n = blk * 10 + o % 10;
    const int k0 = kp * 352, k1 = kp == 2 ? 1024 : k0 + 352;
    const bf16_t* xr = xn1 + (size_t)row * D; const bf16_t* wr = wt_in + (size_t)n * D;
    for (int k = k0; k < k1; k += 8) {
      const uint4 a = *(const uint4*)(xr + k), b = *(const uint4*)(wr + k);
      part = dot8(a, b, part);
    }
    red[tix] = part;
  }
  __syncthreads();
  if (tix < 160) {
    const float v = red[tix] + red[tix + 160] + red[tix + 320];
    const int row = tix / 10, n = blk * 10 + tix % 10;
    const bf16_t bv = f2bf(v);
#pragma unroll
    for (int b = 0; b < BATCH; ++b) proj[((size_t)b * LP + row) * INC + n] = bv;
  }
}

__device__ __forceinline__ void p_transpose(int t, float* smem, const float* __restrict__ W, bf16_t* Wt, int K, int N, const float* __restrict__ ksc) {
  const int tix = opaque_tid();
  float (*T)[65] = (float (*)[65])smem;
  const int nbx = N / 64, k0 = (t / nbx) * 64, n0 = (t % nbx) * 64, tid = (tix & 255);
  const int j = tid & 63, i0 = tid >> 6;
#pragma unroll
  for (int ii = 0; ii < 16; ++ii) { int i = i0 + 4 * ii; T[i][j] = W[(size_t)(k0 + i) * N + n0 + j] * (ksc ? ksc[k0 + i] : 1.0f); }
  __syncthreads();
#pragma unroll
  for (int ii = 0; ii < 16; ++ii) { int jj = i0 + 4 * ii; Wt[(size_t)(n0 + jj) * K + k0 + j] = f2bf(T[j][jj]); }
  __syncthreads();
}

#define XB_TMO      128
#define XB_XCNT(j)  (256  + 64 * (j))
#define XB_XSUB(j)  (1280 + 64 * (j))
#define XB_XGEN(j)  (2304 + 64 * (j))
#define XB_TOP      3328
#define XB_TOPGEN   3392
#define XCD_BAR_WORDS 3456
#define XB_SPIN_CAP (1u << 18)
#define LAS __attribute__((address_space(3)))

__device__ __forceinline__ unsigned xb_ld(unsigned* p)              { return __hip_atomic_load(p, __ATOMIC_RELAXED, __HIP_MEMORY_SCOPE_AGENT); }
__device__ __forceinline__ unsigned xb_add(unsigned* p, unsigned v) { return __hip_atomic_fetch_add(p, v, __ATOMIC_RELAXED, __HIP_MEMORY_SCOPE_AGENT); }
__device__ __forceinline__ unsigned xb_xcc_id() { return (unsigned)__builtin_amdgcn_s_getreg((3 << 11) | 20) & 0xFu; }
#define XB_SPIN(cond, bar) do { unsigned _sp = 0; while (cond) { __builtin_amdgcn_s_sleep(1); \
    if ((++_sp & 255u) == 0u) { if (xb_ld(&(bar)[XB_TMO])) break; if (_sp > XB_SPIN_CAP) { atomicAdd(&(bar)[XB_TMO], 1u); break; } } } } while (0)

struct XcdBarrier {
    unsigned* bar; unsigned x;
    volatile LAS unsigned* st;
};

__device__ __forceinline__ XcdBarrier xcd_barrier_post(unsigned* bar, volatile LAS unsigned* st) {
    XcdBarrier b; b.bar = bar; b.x = xb_xcc_id(); b.st = st;
    if (threadIdx.x == 0) (void)xb_add(&bar[XB_XCNT(b.x)], 1u);
    return b;
}
__device__ __forceinline__ void xcd_barrier_complete(unsigned* bar, unsigned x, unsigned& nloc, unsigned& nx) {
    const unsigned G = gridDim.x * gridDim.y * gridDim.z;
    unsigned sum, cnt, mine, sp = 0u;
    for (;;) {
        sum = 0u; cnt = 0u; mine = 0u;
#pragma unroll
        for (unsigned j = 0; j < 16; ++j) { const unsigned c = xb_ld(&bar[XB_XCNT(j)]); sum += c; cnt += (c > 0u) ? 1u : 0u; mine = (j == x) ? c : mine; }
        if (sum == G) break;
        __builtin_amdgcn_s_sleep(1);
        if ((++sp & 255u) == 0u) { if (xb_ld(&bar[XB_TMO])) break; if (sp > XB_SPIN_CAP) { atomicAdd(&bar[XB_TMO], 1u); break; } }
    }
    nloc = mine > 0u ? mine : 1u; nx = cnt > 0u ? cnt : 1u;
}

__device__ __forceinline__ void xcd_barrier(const XcdBarrier& b) {
    asm volatile("s_waitcnt vmcnt(0)" ::: "memory");
    __syncthreads();
    if (threadIdx.x == 0) {
        unsigned* bar = b.bar;
        __builtin_amdgcn_s_waitcnt(0);
        unsigned nloc = b.st[0], nx = b.st[1];
        if (nloc == 0u) { xcd_barrier_complete(bar, b.x, nloc, nx); b.st[0] = nloc; b.st[1] = nx; }
        const unsigned old = xb_add(&bar[XB_XSUB(b.x)], 1u);
        const unsigned gen = old / nloc;
        if (old + 1u == (gen + 1u) * nloc) {
            __builtin_amdgcn_fence(__ATOMIC_RELEASE, "agent");
            asm volatile("s_waitcnt vmcnt(0)" ::: "memory");
            const unsigned og = xb_add(&bar[XB_TOP], 1u);
            const unsigned tg = og / nx;
            if (og + 1u == (tg + 1u) * nx) xb_add(&bar[XB_TOPGEN], 1u);
            else XB_SPIN(xb_ld(&bar[XB_TOPGEN]) == tg, bar);
            __builtin_amdgcn_fence(__ATOMIC_ACQUIRE, "agent");
            xb_add(&bar[XB_XGEN(b.x)], 1u);
            asm volatile("s_waitcnt vmcnt(0)" ::: "memory");
        } else {
            XB_SPIN(xb_ld(&bar[XB_XGEN(b.x)]) == gen, bar);
            __builtin_amdgcn_fence(__ATOMIC_ACQUIRE, "agent");
            asm volatile("s_waitcnt vmcnt(0)" ::: "memory");
        }
    }
    __syncthreads();
}


struct Params {
  const float *x, *meta, *g1, *w_in, *lq1, *lk1, *lq2, *lk2, *subg, *conv_w, *conv_b, *gn_g, *gn_b, *w_out, *g2, *wq, *sk, *ut, *vt, *fg;
  float* out; float* scal; bf16_t* r1; bf16_t* r2; float* h2; int* eb; float* gb; bf16_t* wt_in; bf16_t* wt_out; bf16_t* wt_q; bf16_t* skb; unsigned char* ut8; unsigned char* vt8; float* uinv; float* vinv; float* wbuf; float* ssq; bf16_t* hb; float* rowss; int use_cg_sync; int pad0;
};

__global__ void __launch_bounds__(512, 2) mega(Params p) {
  cg::grid_group grid = cg::this_grid();
  __shared__ __attribute__((aligned(16))) char smem_c[131072 + 256];
  float* smem = (float*)smem_c;
  const int G = gridDim.x, vh = threadIdx.x >> 8;
  volatile LAS unsigned* xb_st = (volatile LAS unsigned*)(smem_c + 131072 + 16);
  if (threadIdx.x == 0) { xb_st[0] = 0u; xb_st[1] = 0u; }
  __syncthreads();
  const XcdBarrier xbar = xcd_barrier_post((unsigned*)(p.scal + 1024), xb_st);
  bf16_t* xn1 = p.r1; bf16_t* mix = p.r1; bf16_t* proj = p.r2; bf16_t* qp = p.r2;
  p_norm1_rows(G, p.x, p.meta, p.g1, xn1);
  if (blockIdx.x == 0 && threadIdx.x < 64) {
    const int t = threadIdx.x;
    const float a = wave_sum(p.lq1[t] * p.lk1[t]), b2 = wave_sum(p.lq2[t] * p.lk2[t]);
    if (t == 0) p.scal[0] = expf(a) - expf(b2) + LAM_INIT;
  }
  for (int b = blockIdx.x; b < (640 + 256 + 512) / 2; b += G) {
    const int bb = b * 2 + vh; float* sm = smem + vh * (64 * 65);
    if (bb < 640) p_transpose(bb, sm, p.w_in, p.wt_in, D, INC, nullptr);
    else if (bb < 896) p_transpose(bb - 640, sm, p.w_out, p.wt_out, D, D, nullptr);
    else p_transpose(bb - 896, sm, p.wq, p.wt_q, D, 2048, p.g2);
  }
  p_cvt_bf16(blockIdx.x, G, p.sk, p.skb, (size_t)16 * 128 * 128 / 8);
  p_cvt_fp8_rows(blockIdx.x, G, p.ut, (unsigned*)p.ut8, p.uinv, p.g2);
  p_cvt_fp8_rows(blockIdx.x, G, p.vt, (unsigned*)p.vt8, p.vinv, nullptr);
  if (p.use_cg_sync) grid.sync(); else xcd_barrier(xbar);
  for (int b = blockIdx.x; b < 128 * 10; b += G) {
    const int xi = (b >> 3), mt = (b & 7) * 16 + xi / 10, nt = xi % 10;
    gemm256(smem_c, xn1, D, p.wt_in, D, D, (size_t)(mt >> 4) * LP + NMETA + 256 * (mt & 15), nt * 256, EpiBf16{proj, INC, 0, (unsigned*)(p.scal + 640)});
  }
  for (int b = blockIdx.x; b < 256; b += G) meta_proj(smem_c, b, xn1, p.wt_in, proj);
  for (int i = blockIdx.x * 512 + threadIdx.x; i < BATCH * (LP - LREAL) * 128; i += G * 512) {
    const int c = i & 127, r = i >> 7, b = r / (LP - LREAL), pos = LREAL + r - b * (LP - LREAL);
    *(uint4*)(proj + ((size_t)b * LP + pos) * INC + 512 + 8 * c) = make_uint4(0, 0, 0, 0);
  }
  xcd_barrier(xbar);
  {
    const float lam = p.scal[0];
    for (int u = blockIdx.x; u < 256; u += G) {
      const int bh = (u & 7) * 4 + (u >> 6), tp = (u >> 3) & 7;
#pragma unroll 1
      for (int k = 0; k < 4; ++k) {
        const int t = (k == 0) ? 31 - tp : (k == 1) ? 16 + tp : (k == 2) ? 15 - tp : tp;
        attn_unit(smem_c, proj, mix, p.subg, (const unsigned*)(p.scal + 640), lam, bh >> 2, bh & 3, t);
      }
    }
  }
  for (int u = blockIdx.x; u < BATCH * 128; u += G) conv_unit(smem_c, proj, mix, p.conv_w, p.conv_b, p.gn_g, p.gn_b, u >> 7, NMETA + 32 * (u & 127));
  xcd_barrier(xbar);
  for (int b = blockIdx.x; b < 128 * 4; b += G) {
    const int xi = (b >> 3), mt = (b & 7) * 16 + (xi >> 2), nt = xi & 3;
    gemm256(smem_c, mix, D, p.wt_out, D, D, (size_t)(mt >> 4) * LP + NMETA + 256 * (mt & 15), nt * 256, EpiResid2{p.x, p.meta, p.h2, p.hb, p.rowss});
  }
  xcd_barrier(xbar);
  for (int b = blockIdx.x; b < 128 * 8; b += G) {
    const int xi = (b >> 3), mt = (b & 7) * 16 + (xi >> 3), nt = xi & 7;
    gemm256(smem_c, p.hb, D, p.wt_q, D, D, (size_t)(mt >> 4) * LP + NMETA + 256 * (mt & 15), nt * 256, EpiBf16{qp, 2048, 0, nullptr});
  }
  xcd_barrier(xbar);
  for (int u = blockIdx.x; u < 256 * 8; u += G) {
    const int rt = u >> 3, h = u & 7;
    peer_topk_unit(smem_c, qp, p.skb, p.rowss, p.eb, p.gb, (rt >> 5) * LP + NMETA + 128 * (rt & 31), h);
  }
  xcd_barrier(xbar);
  {
    const int tix = opaque_tid();
    const int lane = tix & 63;
    const int NTOK = BATCH * SEQ;
    float* partial = (float*)qp;
    unsigned* qh = (unsigned*)(p.scal + 128);
    const unsigned x = xcc_id();
    for (int qi = 0; qi < 8; ++qi) {
      const int s = (int)((x + qi) & 7u);
      for (;;) {
        unsigned st = 0;
        if (lane == 0) st = __hip_atomic_fetch_add(qh + s * 16, 16u, __ATOMIC_RELAXED, __HIP_MEMORY_SCOPE_AGENT);
        st = __builtin_amdgcn_readfirstlane(st);
        if (st >= (unsigned)NTOK) break;
        ds_u_chunk(smem_c + (tix >> 6) * 16384, lane, (int)st, s, p.hb, p.eb, p.ut8, partial);
      }
    }
    xcd_barrier(xbar);
    for (size_t i = (size_t)blockIdx.x * 512 + tix; i < (size_t)NTOK * 128; i += (size_t)G * 512) {
      const int tk = (int)(i >> 7), k = (int)(i & 127);
      const int b = tk / SEQ, sq = tk - b * SEQ;
      const size_t row = (size_t)b * LP + NMETA + sq;
      float a = 0.f;
#pragma unroll
      for (int sl = 0; sl < 8; ++sl) a += partial[((size_t)tk * 8 + sl) * 128 + k];
      const int e = p.eb[row * 128 + k];
      a *= p.uinv[e] * row_rstd(p.rowss, row);
      p.wbuf[i] = p.gb[row * 128 + k] * 0.5f * a * (1.0f + erff(a * 0.70710678118654752f)) * p.vinv[e];
    }
    xcd_barrier(xbar);
    for (int qi = 0; qi < 8; ++qi) {
      const int s = (int)((x + qi) & 7u);
      for (;;) {
        unsigned st = 0;
        if (lane == 0) st = __hip_atomic_fetch_add(qh + (8 + s) * 16, 16u, __ATOMIC_RELAXED, __HIP_MEMORY_SCOPE_AGENT);
        st = __builtin_amdgcn_readfirstlane(st);
        if (st >= (unsigned)NTOK) break;
        ds_v_chunk(smem_c + (tix >> 6) * 16384, lane, (int)st, s, p.hb, p.eb, p.wbuf, p.vt8, p.h2, p.ssq);
      }
    }
    xcd_barrier(xbar);
    {
      const int wv = blockIdx.x * 8 + (tix >> 6);
      for (int tk = wv * 2; tk < NTOK; tk += G * 16) {
        float4 o[2][4]; float sv[2];
#pragma unroll
        for (int r = 0; r < 2; ++r) {
#pragma unroll
          for (int q = 0; q < 4; ++q) o[r][q] = ((const float4*)p.h2)[(size_t)(tk + r) * 256 + q * 64 + lane];
          sv[r] = lane < 8 ? p.ssq[(size_t)(tk + r) * 8 + lane] : 0.f;
        }
#pragma unroll
        for (int r = 0; r < 2; ++r) {
          const float rstd = rsqrtf(wave_sum(sv[r]) * (1.0f / D) + EPS);
#pragma unroll
          for (int q = 0; q < 4; ++q) {
            const float4 f = ((const float4*)p.fg)[q * 64 + lane];
            float4 v = o[r][q];
            v.x *= rstd * f.x; v.y *= rstd * f.y; v.z *= rstd * f.z; v.w *= rstd * f.w;
            ((float4*)p.out)[(size_t)(tk + r) * 256 + q * 64 + lane] = v;
          }
        }
      }
    }
  }
}

extern "C" void kernel_launch(void* const* d_in, const int* in_sizes, int n_in, void* d_out, int out_size, void* d_ws, size_t ws_size, hipStream_t stream) {
  static int grid_blocks = 0;
  if (!grid_blocks) {
    int dev = 0, cus = 0, per_cu = 0;
    hipGetDevice(&dev);
    hipDeviceGetAttribute(&cus, hipDeviceAttributeMultiprocessorCount, dev);
    hipOccupancyMaxActiveBlocksPerMultiprocessor(&per_cu, mega, 512, 0);
    if (per_cu > 1) per_cu = 1;
    if (per_cu < 1) per_cu = 1;
    grid_blocks = cus * per_cu;
  }
  Params p{};
  const float** pp = (const float**)&p;
  for (int i = 0; i < 20; ++i) pp[i] = (const float*)d_in[i];
  p.out = (float*)d_out;
  char* ws = (char*)d_ws;
  size_t off = 0;
  p.scal = (float*)(ws + off); off += 32768;
  p.r1 = (bf16_t*)(ws + off); off += (size_t)ROWS * D * 2;
  p.r2 = (bf16_t*)(ws + off); off += (size_t)ROWS * INC * 2;
  p.h2 = (float*)(ws + off); off += (size_t)ROWS * D * 4;
  p.wt_in = (bf16_t*)(ws + off); off += (size_t)INC * D * 2;
  p.wt_out = (bf16_t*)(ws + off); off += (size_t)D * D * 2;
  p.wt_q = (bf16_t*)(ws + off); off += (size_t)2048 * D * 2;
  p.skb = (bf16_t*)(ws + off); off += (size_t)16 * 128 * 128 * 2;
  p.ut8 = (unsigned char*)(ws + off); off += (size_t)16384 * D;
  p.vt8 = (unsigned char*)(ws + off); off += (size_t)16384 * D;
  p.uinv = (float*)(ws + off); off += 65536;
  p.vinv = (float*)(ws + off); off += 65536;
  p.wbuf = (float*)(ws + off); off += (size_t)BATCH * SEQ * 128 * 4;
  p.ssq = (float*)(ws + off); off += (size_t)BATCH * SEQ * 8 * 4;
  p.hb = (bf16_t*)(ws + off); off += (size_t)ROWS * D * 2;
  p.rowss = (float*)(ws + off); off += (size_t)ROWS * 16 * 4;
  p.eb = (int*)((char*)p.r2 + (size_t)ROWS * 2048 * 2);
  p.gb = (float*)((char*)p.eb + (size_t)ROWS * 128 * 4);
  hipMemsetAsync(d_ws, 0, 32768, stream);
  void* args[] = {&p};
  hipError_t e = hipLaunchCooperativeKernel((void*)mega, dim3(grid_blocks), dim3(512), args, 0, stream);
  if (e != hipSuccess) fprintf(stderr, "cooperative launch failed: %s (grid %d)\n", hipGetErrorString(e), grid_blocks);
}
```

```cpp
#include <hip/hip_runtime.h>
#include <hip/hip_cooperative_groups.h>
#include <cstdio>
namespace cg = cooperative_groups;
#include <stdint.h>
#include <math.h>

typedef unsigned short bf16_t;
typedef short bf16x8 __attribute__((ext_vector_type(8)));
typedef float f32x4 __attribute__((ext_vector_type(4)));

constexpr int D = 1024, BATCH = 8, SEQ = 4096, NMETA = 16, LREAL = NMETA + SEQ  , LP = 4224, ROWS = BATCH * LP;
constexpr int INC = 2560;
constexpr float EPS = 1e-6f;
constexpr float LAM_INIT = 0.2f;

__device__ __forceinline__ float bf2f(unsigned v) { return __uint_as_float(v << 16); }
__device__ __forceinline__ bf16_t f2bf(float f) { unsigned u = __float_as_uint(f); u += 0x7fffu + ((u >> 16) & 1u); return (bf16_t)(u >> 16); }
__device__ __forceinline__ unsigned pack2(float a, float b) { return (unsigned)f2bf(a) | ((unsigned)f2bf(b) << 16); }

__device__ __forceinline__ float wave_sum(float v) {
#pragma unroll
  for (int o = 32; o >= 1; o >>= 1) v += __shfl_xor(v, o);
  return v;
}
__device__ __forceinline__ float wave_max(float v) {
#pragma unroll
  for (int o = 32; o >= 1; o >>= 1) v = fmaxf(v, __shfl_xor(v, o));
  return v;
}

template <int CTRL> __device__ __forceinline__ float dpp_add(float v) { return v + __builtin_bit_cast(float, __builtin_amdgcn_update_dpp(0, __builtin_bit_cast(int, v), CTRL, 0xf, 0xf, true)); }
__device__ __forceinline__ float sum8(float v) { v = dpp_add<0x141>(v); v = dpp_add<0xB1>(v); v = dpp_add<0x4E>(v); return v; }
typedef __bf16 bf16v2 __attribute__((ext_vector_type(2)));
__device__ __forceinline__ float dot8(uint4 a, uint4 b, float acc) {
  acc = __builtin_amdgcn_fdot2_f32_bf16(__builtin_bit_cast(bf16v2, a.x), __builtin_bit_cast(bf16v2, b.x), acc, false);
  acc = __builtin_amdgcn_fdot2_f32_bf16(__builtin_bit_cast(bf16v2, a.y), __builtin_bit_cast(bf16v2, b.y), acc, false);
  acc = __builtin_amdgcn_fdot2_f32_bf16(__builtin_bit_cast(bf16v2, a.z), __builtin_bit_cast(bf16v2, b.z), acc, false);
  acc = __builtin_amdgcn_fdot2_f32_bf16(__builtin_bit_cast(bf16v2, a.w), __builtin_bit_cast(bf16v2, b.w), acc, false);
  return acc;
}
__device__ __forceinline__ float row_rstd(const float* __restrict__ rowss, size_t row) {
  const float4 a = *(const float4*)(rowss + row * 16), b = *(const float4*)(rowss + row * 16 + 4), c = *(const float4*)(rowss + row * 16 + 8), d = *(const float4*)(rowss + row * 16 + 12);
  const float t = ((a.x + a.y) + (a.z + a.w)) + ((b.x + b.y) + (b.z + b.w)) + ((c.x + c.y) + (c.z + c.w)) + ((d.x + d.y) + (d.z + d.w));
  return rsqrtf(t * (1.0f / D) + EPS);
}
__device__ __forceinline__ float row16_sum(float v) {
  v += __builtin_bit_cast(float, __builtin_amdgcn_update_dpp(0, __builtin_bit_cast(int, v), 0x128, 0xf, 0xf, true));
  v += __builtin_bit_cast(float, __builtin_amdgcn_update_dpp(0, __builtin_bit_cast(int, v), 0x124, 0xf, 0xf, true));
  v += __builtin_bit_cast(float, __builtin_amdgcn_update_dpp(0, __builtin_bit_cast(int, v), 0x122, 0xf, 0xf, true));
  v += __builtin_bit_cast(float, __builtin_amdgcn_update_dpp(0, __builtin_bit_cast(int, v), 0x121, 0xf, 0xf, true));
  return v;
}
__device__ __forceinline__ int opaque_tid() { int t = threadIdx.x; asm volatile("" : "+v"(t)); return t; }

__device__ __forceinline__ const float* hrow_ptr(const float* x, const float* meta, int row) {
  int b = row / LP, pos = row - b * LP;
  if (pos < NMETA) return meta + (size_t)pos * D;
  if (pos < LREAL) return x + ((size_t)b * SEQ + (pos - NMETA)) * D;
  return nullptr;
}


typedef float f32x16 __attribute__((ext_vector_type(16)));
typedef short v4i16_t __attribute__((ext_vector_type(4)));
typedef __bf16 bf16v2_t __attribute__((ext_vector_type(2)));
typedef float f32x2_t __attribute__((ext_vector_type(2)));
#define LDSP(T, p) ((__attribute__((address_space(3))) T*)(p))
#define MFMA32(a, b, c) __builtin_amdgcn_mfma_f32_32x32x16_bf16((a), (b), (c), 0, 0, 0)
__device__ __forceinline__ unsigned cvtpk(float lo, float hi) { f32x2_t v = {lo, hi}; return __builtin_bit_cast(unsigned, __builtin_convertvector(v, bf16v2_t)); }
__device__ __forceinline__ float half_swap_max(float m) { auto rr = __builtin_amdgcn_permlane32_swap(__float_as_uint(m), __float_as_uint(m), false, false); return fmaxf(__uint_as_float(rr[0]), __uint_as_float(rr[1])); }
__device__ __forceinline__ float half_swap_sum(float m) { auto rr = __builtin_amdgcn_permlane32_swap(__float_as_uint(m), __float_as_uint(m), false, false); return __uint_as_float(rr[0]) + __uint_as_float(rr[1]); }

__device__ __forceinline__ void attn_issue_kv(char* kvbuf, const bf16_t* __restrict__ kvrow0  , int tid, int wid) {
  const char* base = (const char*)kvrow0;
#pragma unroll
  for (int i = 0; i < 2; ++i) {
    const int g = i * 512 + tid, row = g >> 4, pos = g & 15;
    const unsigned offk = (unsigned)(row * (INC * 2) + 1024 + ((pos ^ (row & 15)) << 4));
    const unsigned offv = (unsigned)(row * (INC * 2) + 2048 + ((pos ^ ((row & 3) << 2)) << 4));
    __builtin_amdgcn_global_load_lds((const unsigned*)(base + offk), LDSP(unsigned, kvbuf + (i * 512 + wid * 64) * 16), 16, 0, 0);
    __builtin_amdgcn_global_load_lds((const unsigned*)(base + offv), LDSP(unsigned, kvbuf + 16384 + (i * 512 + wid * 64) * 16), 16, 0, 0);
  }
}

typedef int v2i_t __attribute__((ext_vector_type(2)));
typedef int v4i_t __attribute__((ext_vector_type(4)));
#define DS_RD_B128(dst, addr, off) asm volatile("ds_read_b128 %0, %1 offset:%2" : "=v"(dst) : "v"(addr), "n"(off))
#define DS_RD_TR16(dst, addr, off) asm volatile("ds_read_b64_tr_b16 %0, %1 offset:%2" : "=v"(dst) : "v"(addr), "n"(off))
#define LGKM_WAIT2(n, x, y) asm volatile("s_waitcnt lgkmcnt(%2)" : "+v"(x), "+v"(y) : "n"(n))

template <bool MASKED, bool MAXONLY>
__device__ __forceinline__ void attn_qk(uint4 (&pw)[4], float& mref, float& lsum, const bf16x8 (&bq)[4], const unsigned (&koff)[4], unsigned kaddr, int kq, float sl8, const f32x16& biasp) {
  const float c1 = 0.125f * 1.4426950408889634f;
  v4i_t ka[4][2];
#pragma unroll
  for (int ks = 0; ks < 4; ++ks) {
    const unsigned a = kaddr + koff[ks];
    DS_RD_B128(ka[ks][0], a, 0);
    DS_RD_B128(ka[ks][1], a, 8192);
  }
  f32x16 s0, s1;
  float soff0, soff1;
  if (MASKED) {
    const float a1 = sl8, a2 = 2.0f * sl8, a3 = 3.0f * sl8, b8 = 8.0f * sl8;
    float gb = sl8 * (float)kq;
#pragma unroll
    for (int g = 0; g < 4; ++g) { s0[4 * g] = gb; s0[4 * g + 1] = gb + a1; s0[4 * g + 2] = gb + a2; s0[4 * g + 3] = gb + a3; gb += b8; }
#pragma unroll
    for (int g = 0; g < 4; ++g) { s1[4 * g] = gb; s1[4 * g + 1] = gb + a1; s1[4 * g + 2] = gb + a2; s1[4 * g + 3] = gb + a3; gb += b8; }
#pragma unroll
    for (int r = 0; r < 16; ++r) { s0[r] = s0[r] > 0.f ? -1e30f : s0[r]; s1[r] = s1[r] > 0.f ? -1e30f : s1[r]; }
    soff0 = 0.f; soff1 = 0.f;
  } else {
    soff0 = sl8 * (float)kq; soff1 = soff0 + 32.0f * sl8;
  }
  LGKM_WAIT2(6, ka[0][0], ka[0][1]);
  if (MASKED) { s0 = MFMA32(__builtin_bit_cast(bf16x8, ka[0][0]), bq[0], s0); s1 = MFMA32(__builtin_bit_cast(bf16x8, ka[0][1]), bq[0], s1); }
  else        { s0 = MFMA32(__builtin_bit_cast(bf16x8, ka[0][0]), bq[0], biasp); s1 = MFMA32(__builtin_bit_cast(bf16x8, ka[0][1]), bq[0], biasp); }
  __builtin_amdgcn_sched_barrier(0);
  LGKM_WAIT2(4, ka[1][0], ka[1][1]);
  s0 = MFMA32(__builtin_bit_cast(bf16x8, ka[1][0]), bq[1], s0); s1 = MFMA32(__builtin_bit_cast(bf16x8, ka[1][1]), bq[1], s1);
  __builtin_amdgcn_sched_barrier(0);
  LGKM_WAIT2(2, ka[2][0], ka[2][1]);
  s0 = MFMA32(__builtin_bit_cast(bf16x8, ka[2][0]), bq[2], s0); s1 = MFMA32(__builtin_bit_cast(bf16x8, ka[2][1]), bq[2], s1);
  __builtin_amdgcn_sched_barrier(0);
  LGKM_WAIT2(0, ka[3][0], ka[3][1]);
  s0 = MFMA32(__builtin_bit_cast(bf16x8, ka[3][0]), bq[3], s0); s1 = MFMA32(__builtin_bit_cast(bf16x8, ka[3][1]), bq[3], s1);
  if (MAXONLY) {
    float m0 = fmaxf(s0[0], s0[1]), m1 = fmaxf(s1[0], s1[1]);
#pragma unroll
    for (int r = 2; r < 16; r += 2) { m0 = fmaxf(fmaxf(m0, s0[r]), s0[r + 1]); m1 = fmaxf(fmaxf(m1, s1[r]), s1[r + 1]); }
    mref = fmaxf(mref, half_swap_max(fmaxf(m0 + soff0, m1 + soff1)));
    return;
  }
  const float nm0 = (soff0 - mref) * c1, nm1 = (soff1 - mref) * c1;
  float l0 = 0.f, l1 = 0.f;
#pragma unroll
  for (int r = 0; r < 16; ++r) {
    s0[r] = __builtin_amdgcn_exp2f(__builtin_fmaf(s0[r], c1, nm0));
    s1[r] = __builtin_amdgcn_exp2f(__builtin_fmaf(s1[r], c1, nm1));
    l0 += s0[r]; asm("" : "+v"(l0));
    l1 += s1[r]; asm("" : "+v"(l1));
  }
  lsum += l0 + l1;
#pragma unroll
  for (int kk = 0; kk < 2; ++kk) {
    pw[kk] = make_uint4(cvtpk(s0[8 * kk], s0[8 * kk + 1]), cvtpk(s0[8 * kk + 2], s0[8 * kk + 3]), cvtpk(s0[8 * kk + 4], s0[8 * kk + 5]), cvtpk(s0[8 * kk + 6], s0[8 * kk + 7]));
    pw[2 + kk] = make_uint4(cvtpk(s1[8 * kk], s1[8 * kk + 1]), cvtpk(s1[8 * kk + 2], s1[8 * kk + 3]), cvtpk(s1[8 * kk + 4], s1[8 * kk + 5]), cvtpk(s1[8 * kk + 6], s1[8 * kk + 7]));
  }
}

__device__ __forceinline__ void attn_pv(f32x16 (&o)[4], const uint4 (&pw)[4], unsigned vaddr, const unsigned (&voff)[4]) {
  unsigned a[4];
#pragma unroll
  for (int d = 0; d < 4; ++d) a[d] = vaddr + voff[d];
  v2i_t f[4][2];
#define PV_ISSUE(i) { DS_RD_TR16(f[(i) & 3][0], a[(i) & 3], ((i) >> 2) * 4096); DS_RD_TR16(f[(i) & 3][1], a[(i) & 3], ((i) >> 2) * 4096 + 2048); }
#define PV_STEP(i, n) { if ((i) + 3 < 16) PV_ISSUE((i) + 3); LGKM_WAIT2(n, f[(i) & 3][0], f[(i) & 3][1]); \
    const v4i_t va = {f[(i) & 3][0][0], f[(i) & 3][0][1], f[(i) & 3][1][0], f[(i) & 3][1][1]}; \
    o[(i) & 3] = MFMA32(__builtin_bit_cast(bf16x8, va), __builtin_bit_cast(bf16x8, pw[(i) >> 2]), o[(i) & 3]); }
  PV_ISSUE(0); PV_ISSUE(1); PV_ISSUE(2);
  PV_STEP(0, 6); PV_STEP(1, 6); PV_STEP(2, 6); PV_STEP(3, 6); PV_STEP(4, 6); PV_STEP(5, 6); PV_STEP(6, 6); PV_STEP(7, 6);
  PV_STEP(8, 6); PV_STEP(9, 6); PV_STEP(10, 6); PV_STEP(11, 6); PV_STEP(12, 6); PV_STEP(13, 4); PV_STEP(14, 2); PV_STEP(15, 0);
#undef PV_ISSUE
#undef PV_STEP
}

__device__ __forceinline__ void attn_unit(char* lds, const bf16_t* __restrict__ proj, bf16_t* mix, const float* __restrict__ subg, const unsigned* __restrict__ kmax, float lam, int b, int h, int t) {
  const int tix = opaque_tid();
  const int tid = tix, lane = tid & 63, r32 = lane & 31, hi = lane >> 5;
  const int wid = __builtin_amdgcn_readfirstlane(tid >> 6);
  const int c = wid >> 2, qg = wid & 3;
  const int q0 = NMETA + 128 * t, qw0 = q0 + 32 * qg, qpos = qw0 + r32;
  const size_t rowb = (size_t)b * LP;
  const int NT = 2 * t + 3;
  const int dist = h == 0 ? 710 : h == 1 ? 2840 : (1 << 24);
  const int js0 = q0 - dist > 0 ? (q0 - dist) >> 6 : 0;
  char* Qs = lds;
  char* KV = lds + 32768;
  const float sl8 = exp2f(1.0f - 2.0f * (float)h);
  __syncthreads();
  attn_issue_kv(KV, proj + (rowb + 64 * js0) * INC + h * 128, tid, wid);
#pragma unroll
  for (int i = 0; i < 4; ++i) {
    const int g = i * 512 + tid, row = g >> 4, pos = g & 15;
    uint4 v = *(const uint4*)(proj + (rowb + q0 + row) * INC + h * 128 + ((pos ^ (row & 15)) << 3));
    *(uint4*)(Qs + g * 16) = v;
  }
  f32x16 o[4];
#pragma unroll
  for (int i = 0; i < 4; ++i)
#pragma unroll
    for (int r = 0; r < 16; ++r) o[i][r] = 0.f;
  float lsum = 0.f;
  f32x16 biasp;
#pragma unroll
  for (int r = 0; r < 16; ++r) biasp[r] = sl8 * (float)((r & 3) + 8 * (r >> 2));
  const int qrow = 32 * qg + r32;
  const char* qbase = Qs + qrow * 256;
  const int qsw = qrow & 15;
  float mref; bool loose;
  int* lflag = (int*)(lds + 131072);
  {
    float kn2 = 0.f;
    if (lane < 16) {
      const uint4* kp = (const uint4*)(proj + (rowb + lane) * INC + 512 + h * 128 + c * 64);
#pragma unroll
      for (int i = 0; i < 8; ++i) { const uint4 w = kp[i]; kn2 = dot8(w, w, kn2); }
    }
    kn2 = fmaxf(wave_max(kn2), __uint_as_float(kmax[b * 8 + h * 2 + c]));
    if (tid == 0) *lflag = 0;
    __syncthreads();
    float qn2 = 0.f;
#pragma unroll
    for (int ks = 0; ks < 4; ++ks) { const uint4 w = *(const uint4*)(qbase + (((c * 8 + ks * 2 + hi) ^ qsw) << 4)); qn2 = dot8(w, w, qn2); }
    qn2 = half_swap_sum(qn2);
    const float bound = sqrtf(qn2 * kn2) * 1.02f;
    mref = bound - 60.0f / (0.125f * 1.4426950408889634f);
    float sd = 0.f;
#pragma unroll
    for (int ks = 0; ks < 4; ++ks) {
      const uint4 wq = *(const uint4*)(qbase + (((c * 8 + ks * 2 + hi) ^ qsw) << 4));
      const uint4 wk = *(const uint4*)(proj + (rowb + qpos) * INC + 512 + h * 128 + (c * 8 + ks * 2 + hi) * 8);
      sd = dot8(wq, wk, sd);
    }
    sd = half_swap_sum(sd);
    loose = (bound - sd) * (0.125f * 1.4426950408889634f) > 170.0f;
  }
  bf16x8 bq[4];
  unsigned koff[4], voff[4];
  const unsigned lds0 = (unsigned)(size_t)LDSP(char, lds);
  {
    const int q4 = (lane & 15) >> 2, g1 = (lane >> 4) & 1, p4 = lane & 3;
#pragma unroll
    for (int ks = 0; ks < 4; ++ks) {
      const int ch = (c * 8 + ks * 2 + hi) ^ qsw;
      bq[ks] = *(const bf16x8*)(qbase + (ch << 4));
      koff[ks] = (unsigned)(r32 * 256 + (ch << 4));
      voff[ks] = (unsigned)(16384 + (4 * hi + q4) * 256 + (8 * (ks ^ q4) + 4 * g1 + p4) * 8);
    }
  }
  uint4 pw[4];
  if (__any(loose) && lane == 0) *lflag = 1;
  __syncthreads();
  int js = js0;
  if (*lflag) {
    js = 0;
    if (js0 > 0) {
      asm volatile("s_waitcnt vmcnt(0)" ::: "memory");
      __syncthreads();
      attn_issue_kv(KV, proj + rowb * INC + h * 128, tid, wid);
    }
    float mx = -1e30f; int sl = 0;
    for (int j = 0; j < NT; ++j) {
      asm volatile("s_waitcnt vmcnt(0)" ::: "memory");
      __syncthreads();
      if (j + 1 < NT) attn_issue_kv(KV + (sl == 2 ? 0 : sl + 1) * 32768, proj + (rowb + 64 * (j + 1)) * INC + h * 128, tid, wid);
      if (64 * j <= qw0 + 31) {
        const int kq = 64 * j + 4 * hi - qpos;
        if (64 * j + 63 > qw0) attn_qk<true, true>(pw, mx, lsum, bq, koff, lds0 + 32768 + sl * 32768, kq, sl8, biasp);
        else attn_qk<false, true>(pw, mx, lsum, bq, koff, lds0 + 32768 + sl * 32768, kq, sl8, biasp);
      }
      sl = (sl == 2 ? 0 : sl + 1);
    }
    mref = mx;
    __syncthreads();
    attn_issue_kv(KV, proj + rowb * INC + h * 128, tid, wid);
  }
  bool have = false;
  int slot = 0, pslot = 0;
  for (int j = js; j <= NT; ++j) {
    if (j < NT) {
      asm volatile("s_waitcnt vmcnt(0)" ::: "memory");
      __syncthreads();
      if (j + 1 < NT) attn_issue_kv(KV + (slot == 2 ? 0 : slot + 1) * 32768, proj + (rowb + 64 * (j + 1)) * INC + h * 128, tid, wid);
    }
    if (have) { attn_pv(o, pw, lds0 + 32768 + pslot * 32768, voff); have = false; }
    if (j < NT && 64 * j <= qw0 + 31) {
      const unsigned kb = lds0 + 32768 + slot * 32768;
      const int kq = 64 * j + 4 * hi - qpos;
      if (64 * j + 63 > qw0) attn_qk<true, false>(pw, mref, lsum, bq, koff, kb, kq, sl8, biasp);
      else attn_qk<false, false>(pw, mref, lsum, bq, koff, kb, kq, sl8, biasp);
      if (c == 0) attn_pv(o, pw, kb, voff); else have = true;
    }
    pslot = slot; slot = (slot == 2 ? 0 : slot + 1);
  }
  const float sc = (c == 0 ? 1.0f : lam) / half_swap_sum(lsum);
  __syncthreads();
  float* X = (float*)(lds + 32768);
  if (c == 1) {
#pragma unroll
    for (int i = 0; i < 4; ++i)
#pragma unroll
      for (int r = 0; r < 16; ++r) X[(qg * 64 + i * 16 + r) * 64 + lane] = o[i][r] * sc;
  }
  __syncthreads();
  if (c == 0) {
    float ss = 0.f;
#pragma unroll
    for (int i = 0; i < 4; ++i) {
#pragma unroll
      for (int r = 0; r < 16; ++r) { float v = o[i][r] * sc - X[(qg * 64 + i * 16 + r) * 64 + lane]; o[i][r] = v; ss += v * v; }
      __builtin_amdgcn_sched_barrier(0);
    }
    ss = half_swap_sum(ss);
    const float rstd = rsqrtf(ss * (1.0f / 128.0f) + EPS) * (1.0f - LAM_INIT);
    bf16_t* orow = mix + (rowb + qpos) * D + h * 128;
#pragma unroll
    for (int i = 0; i < 4; ++i) {
#pragma unroll
      for (int g = 0; g < 4; ++g) {
        const int dv0 = 32 * i + 8 * g + 4 * hi;
        const float4 sg = *(const float4*)(subg + dv0);
        uint2 w; w.x = cvtpk(o[i][4 * g] * rstd * sg.x, o[i][4 * g + 1] * rstd * sg.y); w.y = cvtpk(o[i][4 * g + 2] * rstd * sg.z, o[i][4 * g + 3] * rstd * sg.w);
        *(uint2*)(orow + dv0) = w;
      }
      __builtin_amdgcn_sched_barrier(0);
    }
  }
}


__device__ __forceinline__ void p_norm1_rows(int G, const float* __restrict__ x, const float* __restrict__ meta, const float* __restrict__ g1, bf16_t* xn1) {
  const int tix = opaque_tid();
  const int lane = tix & 63, wv = blockIdx.x * 8 + (tix >> 6);
  float4 g[4];
#pragma unroll
  for (int q = 0; q < 4; ++q) g[q] = ((const float4*)g1)[q * 64 + lane];
  for (int row = wv * 2; row < ROWS; row += G * 16) {
    float4 v[2][4];
#pragma unroll
    for (int r = 0; r < 2; ++r) {
      const float* src = hrow_ptr(x, meta, row + r);
#pragma unroll
      for (int q = 0; q < 4; ++q) v[r][q] = src ? ((const float4*)src)[q * 64 + lane] : make_float4(0.f, 0.f, 0.f, 0.f);
    }
#pragma unroll
    for (int r = 0; r < 2; ++r) {
      float ss = 0.f;
#pragma unroll
      for (int q = 0; q < 4; ++q) ss += (v[r][q].x * v[r][q].x + v[r][q].y * v[r][q].y) + (v[r][q].z * v[r][q].z + v[r][q].w * v[r][q].w);
      const float rstd = rsqrtf(wave_sum(ss) * (1.0f / D) + EPS);
#pragma unroll
      for (int q = 0; q < 4; ++q) {
        uint2 o; o.x = cvtpk(v[r][q].x * rstd * g[q].x, v[r][q].y * rstd * g[q].y); o.y = cvtpk(v[r][q].z * rstd * g[q].z, v[r][q].w * rstd * g[q].w);
        ((uint2*)(xn1 + (size_t)(row + r) * D))[q * 64 + lane] = o;
      }
    }
  }
}

__device__ __forceinline__ void conv_unit(char* lds, const bf16_t* __restrict__ proj, bf16_t* mix, const float* __restrict__ cw, const float* __restrict__ cb,
                                          const float* __restrict__ gng, const float* __restrict__ gnb, int b, int pos0) {
  const int tix = opaque_tid();
  const int c = tix;
  float* U = (float*)lds;
  __syncthreads();
  {
    const int lane = tix & 63, wv = tix >> 6;
    uint4 ra[8], rg[8];
#pragma unroll
    for (int i = 0; i < 8; ++i) {
      const int r = wv + 8 * i, pos = pos0 - 30 + r;
      ra[i] = make_uint4(0, 0, 0, 0); rg[i] = make_uint4(0, 0, 0, 0);
      if (r < 62 && pos >= 0) {
        const bf16_t* pr = proj + ((size_t)b * LP + pos) * INC + 8 * lane;
        ra[i] = *(const uint4*)(pr + 1536); rg[i] = *(const uint4*)(pr + 2048);
      }
    }
#pragma unroll
    for (int i = 0; i < 8; ++i) {
      const int r = wv + 8 * i;
      if (r < 62) {
        const unsigned av[4] = {ra[i].x, ra[i].y, ra[i].z, ra[i].w}, gv[4] = {rg[i].x, rg[i].y, rg[i].z, rg[i].w};
        float u[8];
#pragma unroll
        for (int q = 0; q < 4; ++q) {
          const float a0 = __uint_as_float(av[q] << 16), a1 = __uint_as_float(av[q] & 0xffff0000u), g0 = __uint_as_float(gv[q] << 16), g1 = __uint_as_float(gv[q] & 0xffff0000u);
          u[2 * q] = a0 / (1.0f + __expf(-g0)); u[2 * q + 1] = a1 / (1.0f + __expf(-g1));
        }
        *(float4*)(U + r * 512 + 8 * lane) = make_float4(u[0], u[1], u[2], u[3]);
        *(float4*)(U + r * 512 + 8 * lane + 4) = make_float4(u[4], u[5], u[6], u[7]);
      }
    }
  }
  float w[31];
#pragma unroll
  for (int j = 0; j < 31; ++j) w[j] = cw[j * 512 + c];
  const float bias = cb[c], gg = gng[c], gb2 = gnb[c];
  __syncthreads();
#pragma unroll 1
  for (int t0 = 0; t0 < 32; t0 += 4) {
    float y[4] = {bias, bias, bias, bias};
#pragma unroll
    for (int r = 0; r < 34; ++r) {
      const float u = U[(t0 + r) * 512 + c];
#pragma unroll
      for (int q = 0; q < 4; ++q) { const int j = r - q; if (j >= 0 && j < 31) y[q] = fmaf(w[j], u, y[q]); }
    }
#pragma unroll
    for (int q = 0; q < 4; ++q) {
      float sm = row16_sum(y[q]);
      sm += __shfl_xor(sm, 16); sm = half_swap_sum(sm);
      const float d = y[q] - sm * (1.0f / 64.0f);
      float vr = row16_sum(d * d);
      vr += __shfl_xor(vr, 16); vr = half_swap_sum(vr);
      const float n = d * rsqrtf(vr * (1.0f / 64.0f) + EPS) * gg + gb2;
      mix[((size_t)b * LP + pos0 + t0 + q) * D + 512 + c] = f2bf(n / (1.0f + __expf(-n)));
    }
  }
}


__device__ __forceinline__ void ce_desc(float& a, float& b) { const float hi = fmaxf(a, b), lo = fminf(a, b); a = hi; b = lo; }
__device__ __forceinline__ void ce_asc(float& a, float& b) { const float hi = fmaxf(a, b), lo = fminf(a, b); a = lo; b = hi; }
template <int N> __device__ __forceinline__ void bitonic_sort_desc(float (&v)[N]) {
#pragma unroll
  for (int k = 2; k <= N; k <<= 1)
#pragma unroll
    for (int j = k >> 1; j > 0; j >>= 1)
#pragma unroll
      for (int i = 0; i < N; ++i) { const int l = i ^ j; if (l > i) { if ((i & k) == 0) ce_desc(v[i], v[l]); else ce_asc(v[i], v[l]); } }
}
template <int N> __device__ __forceinline__ void bitonic_merge_desc(float (&v)[N]) {
#pragma unroll
  for (int j = N >> 1; j > 0; j >>= 1)
#pragma unroll
    for (int i = 0; i < N; ++i) { const int l = i ^ j; if (l > i) ce_desc(v[i], v[l]); }
}
__host__ __device__ constexpr int cand_slot(int i, int j) { int s = 0; for (int ii = 0; ii < i; ++ii) s += 16 / (ii + 1); return s + j; }

template <int O, int N> __device__ __forceinline__ void oddeven_sort16_desc(float (&v)[N]) {
  ce_desc(v[O + 0], v[O + 1]);
  ce_desc(v[O + 2], v[O + 3]);
  ce_desc(v[O + 4], v[O + 5]);
  ce_desc(v[O + 6], v[O + 7]);
  ce_desc(v[O + 8], v[O + 9]);
  ce_desc(v[O + 10], v[O + 11]);
  ce_desc(v[O + 12], v[O + 13]);
  ce_desc(v[O + 14], v[O + 15]);
  ce_desc(v[O + 0], v[O + 2]);
  ce_desc(v[O + 1], v[O + 3]);
  ce_desc(v[O + 4], v[O + 6]);
  ce_desc(v[O + 5], v[O + 7]);
  ce_desc(v[O + 8], v[O + 10]);
  ce_desc(v[O + 9], v[O + 11]);
  ce_desc(v[O + 12], v[O + 14]);
  ce_desc(v[O + 13], v[O + 15]);
  ce_desc(v[O + 1], v[O + 2]);
  ce_desc(v[O + 5], v[O + 6]);
  ce_desc(v[O + 9], v[O + 10]);
  ce_desc(v[O + 13], v[O + 14]);
  ce_desc(v[O + 0], v[O + 4]);
  ce_desc(v[O + 1], v[O + 5]);
  ce_desc(v[O + 2], v[O + 6]);
  ce_desc(v[O + 3], v[O + 7]);
  ce_desc(v[O + 8], v[O + 12]);
  ce_desc(v[O + 9], v[O + 13]);
  ce_desc(v[O + 10], v[O + 14]);
  ce_desc(v[O + 11], v[O + 15]);
  ce_desc(v[O + 2], v[O + 4]);
  ce_desc(v[O + 3], v[O + 5]);
  ce_desc(v[O + 10], v[O + 12]);
  ce_desc(v[O + 11], v[O + 13]);
  ce_desc(v[O + 1], v[O + 2]);
  ce_desc(v[O + 3], v[O + 4]);
  ce_desc(v[O + 5], v[O + 6]);
  ce_desc(v[O + 9], v[O + 10]);
  ce_desc(v[O + 11], v[O + 12]);
  ce_desc(v[O + 13], v[O + 14]);
  ce_desc(v[O + 0], v[O + 8]);
  ce_desc(v[O + 1], v[O + 9]);
  ce_desc(v[O + 2], v[O + 10]);
  ce_desc(v[O + 3], v[O + 11]);
  ce_desc(v[O + 4], v[O + 12]);
  ce_desc(v[O + 5], v[O + 13]);
  ce_desc(v[O + 6], v[O + 14]);
  ce_desc(v[O + 7], v[O + 15]);
  ce_desc(v[O + 4], v[O + 8]);
  ce_desc(v[O + 5], v[O + 9]);
  ce_desc(v[O + 6], v[O + 10]);
  ce_desc(v[O + 7], v[O + 11]);
  ce_desc(v[O + 2], v[O + 4]);
  ce_desc(v[O + 3], v[O + 5]);
  ce_desc(v[O + 6], v[O + 8]);
  ce_desc(v[O + 7], v[O + 9]);
  ce_desc(v[O + 10], v[O + 12]);
  ce_desc(v[O + 11], v[O + 13]);
  ce_desc(v[O + 1], v[O + 2]);
  ce_desc(v[O + 3], v[O + 4]);
  ce_desc(v[O + 5], v[O + 6]);
  ce_desc(v[O + 7], v[O + 8]);
  ce_desc(v[O + 9], v[O + 10]);
  ce_desc(v[O + 11], v[O + 12]);
  ce_desc(v[O + 13], v[O + 14]);
}
__device__ __forceinline__ void peer_load_q(bf16x8 (&xq)[2][4], const bf16_t* qp, int row0, int h, int wid, int fr, int fq) {
  const bf16_t* xrow = qp + (size_t)(row0 + wid * 16 + fr) * 2048 + h * 256 + fq * 8;
#pragma unroll
  for (int p = 0; p < 2; ++p)
#pragma unroll
    for (int ks = 0; ks < 4; ++ks) asm volatile("global_load_dwordx4 %0, %1, off" : "=v"(xq[p][ks]) : "v"(xrow + p * 128 + ks * 32));
}
__device__ __forceinline__ void peer_topk_unit(char* lds, const bf16_t* __restrict__ qp, const bf16_t* __restrict__ skb, const float* __restrict__ rowss, int* eb, float* gb, int row0, int h, bool stage,
                                               bf16x8 (&xq)[2][4], int next_row0, int next_h) {
  const int tix = opaque_tid();
  const int tid = tix, lane = tid & 63, wid = tid >> 6, fr = lane & 15, fq = lane >> 4;
  if (stage) {
  __syncthreads();
#pragma unroll
  for (int i = 0; i < 8; ++i) {
    const int g = i * 512 + tid, row = g >> 4, pos = g & 15;
    *(uint4*)(lds + g * 16) = *(const uint4*)(skb + ((size_t)(h * 2) * 128 + row) * 128 + ((pos ^ (row & 15)) << 3));
  }
  if (tid < 64) {
    int i = 0, base = 0;
    while (i < 15 && tid >= base + 16 / (i + 1)) { base += 16 / (i + 1); ++i; }
    ((int*)(lds + 65536))[tid] = (i << 4) | ((tid - base) & 15);
  }
  __syncthreads();
  }
  const int tok = row0 + wid * 16 + fr;
  asm volatile("s_waitcnt vmcnt(0)" : "+v"(xq[0][0]), "+v"(xq[0][1]), "+v"(xq[0][2]), "+v"(xq[0][3]), "+v"(xq[1][0]), "+v"(xq[1][1]), "+v"(xq[1][2]), "+v"(xq[1][3]));
  float top[2][16];
#pragma unroll
  for (int p = 0; p < 2; ++p) {
    f32x4 acc[8];
#pragma unroll
    for (int i = 0; i < 8; ++i) acc[i] = (f32x4){0.f, 0.f, 0.f, 0.f};
#pragma unroll
    for (int ks = 0; ks < 4; ++ks) {
      const bf16x8 xb = xq[p][ks];
      const int ch = ks * 4 + fq;
#pragma unroll
      for (int nt = 0; nt < 8; ++nt) {
        const int r = p * 128 + nt * 16 + fr;
        const bf16x8 wa = *(const bf16x8*)(lds + r * 256 + ((ch ^ (r & 15)) << 4));
        acc[nt] = __builtin_amdgcn_mfma_f32_16x16x32_bf16(wa, xb, acc[nt], 0, 0, 0);
      }
    }
    if (p == 1 && next_row0 >= 0) { peer_load_q(xq, qp, next_row0, next_h, wid, fr, fq); __builtin_amdgcn_sched_barrier(0); }
    float v[32];
#pragma unroll
    for (int nt = 0; nt < 8; ++nt)
#pragma unroll
      for (int r = 0; r < 4; ++r) v[nt * 4 + r] = __uint_as_float((__float_as_uint(acc[nt][r]) & ~127u) | (unsigned)(nt * 16 + fq * 4 + r));
    oddeven_sort16_desc<0>(v); oddeven_sort16_desc<16>(v);
    float t[16];
#pragma unroll
    for (int i = 0; i < 16; ++i) t[i] = fmaxf(v[i], v[31 - i]);
    bitonic_merge_desc<16>(t);
#pragma unroll
    for (int rnd = 0; rnd < 2; ++rnd) {
      float pb[16];
#pragma unroll
      for (int i = 0; i < 16; ++i) pb[i] = __shfl_xor(t[15 - i], rnd == 0 ? 16 : 32);
#pragma unroll
      for (int i = 0; i < 16; ++i) t[i] = fmaxf(t[i], pb[i]);
      bitonic_merge_desc<16>(t);
    }
#pragma unroll
    for (int i = 0; i < 16; ++i) top[p][i] = t[i];
  }
  int* ST = (int*)(lds + 65536);
  int* IDX = (int*)(lds + 65536 + 256) + (wid * 16 + fr) * 32;
#define SEL4(arr, q) (fq == 0 ? arr[q] : fq == 1 ? arr[4 + (q)] : fq == 2 ? arr[8 + (q)] : arr[12 + (q)])
  {
    int4 ia, ib;
    ia.x = __float_as_uint(SEL4(top[0], 0)) & 127; ia.y = __float_as_uint(SEL4(top[0], 1)) & 127; ia.z = __float_as_uint(SEL4(top[0], 2)) & 127; ia.w = __float_as_uint(SEL4(top[0], 3)) & 127;
    ib.x = __float_as_uint(SEL4(top[1], 0)) & 127; ib.y = __float_as_uint(SEL4(top[1], 1)) & 127; ib.z = __float_as_uint(SEL4(top[1], 2)) & 127; ib.w = __float_as_uint(SEL4(top[1], 3)) & 127;
    *(int4*)(IDX + 4 * fq) = ia; *(int4*)(IDX + 16 + 4 * fq) = ib;
  }
  float cv[16];
  {
    const float NEGV = -3.0e38f;
    float am[16], bm[16];
#pragma unroll
    for (int i = 0; i < 16; ++i) { am[i] = __uint_as_float(__float_as_uint(top[0][i]) & ~127u); bm[i] = __uint_as_float(__float_as_uint(top[1][i]) & ~127u); }
#define CAND(i, j) __uint_as_float((__float_as_uint(am[i] + bm[j]) & ~63u) | (unsigned)cand_slot(i, j))
    float A[16], B[16], C[16], Dd[8], E[8], F[16];
#pragma unroll
    for (int j = 0; j < 16; ++j) A[j] = CAND(0, j);
#pragma unroll
    for (int j = 0; j < 8; ++j) { B[j] = CAND(1, j); B[15 - j] = CAND(8 + j, 0); }
    bitonic_merge_desc<16>(B);
#pragma unroll
    for (int j = 0; j < 5; ++j) C[j] = CAND(2, j);
#pragma unroll
    for (int j = 5; j < 12; ++j) C[j] = NEGV;
#pragma unroll
    for (int j = 0; j < 4; ++j) C[15 - j] = CAND(3, j);
    bitonic_merge_desc<16>(C);
    Dd[0] = CAND(4, 0); Dd[1] = CAND(4, 1); Dd[2] = CAND(4, 2); Dd[3] = NEGV; Dd[4] = NEGV; Dd[5] = NEGV; Dd[6] = CAND(5, 1); Dd[7] = CAND(5, 0);
    bitonic_merge_desc<8>(Dd);
    E[0] = CAND(6, 0); E[1] = CAND(6, 1); E[2] = NEGV; E[3] = NEGV; E[4] = NEGV; E[5] = NEGV; E[6] = CAND(7, 1); E[7] = CAND(7, 0);
    bitonic_merge_desc<8>(E);
#pragma unroll
    for (int j = 0; j < 8; ++j) { F[j] = Dd[j]; F[15 - j] = E[j]; }
    bitonic_merge_desc<16>(F);
#undef CAND
#pragma unroll
    for (int j = 0; j < 16; ++j) { A[j] = fmaxf(A[j], B[15 - j]); C[j] = fmaxf(C[j], F[15 - j]); }
    bitonic_merge_desc<16>(A);
    bitonic_merge_desc<16>(C);
#pragma unroll
    for (int j = 0; j < 16; ++j) cv[j] = fmaxf(A[j], C[15 - j]);
    bitonic_merge_desc<16>(cv);
  }
  float ex[16]; float sum = 0.f;
  const float c0v = __uint_as_float(__float_as_uint(cv[0]) & ~63u);
  const float rs = row_rstd(rowss, (size_t)tok);
#pragma unroll
  for (int i = 0; i < 16; ++i) { ex[i] = __expf((__uint_as_float(__float_as_uint(cv[i]) & ~63u) - c0v) * rs); sum += ex[i]; }
  const float inv = 1.0f / sum;
  int e4[4]; float g4[4];
#pragma unroll
  for (int q = 0; q < 4; ++q) {
    const int slot = __float_as_uint(SEL4(cv, q)) & 63;
    const int ij = ST[slot];
    e4[q] = IDX[ij >> 4] * 128 + IDX[16 + (ij & 15)];
    g4[q] = SEL4(ex, q) * inv;
  }
#undef SEL4
  *(int4*)(eb + ((size_t)tok * 8 + h) * 16 + 4 * fq) = make_int4(e4[0], e4[1], e4[2], e4[3]);
  *(float4*)(gb + ((size_t)tok * 8 + h) * 16 + 4 * fq) = make_float4(g4[0], g4[1], g4[2], g4[3]);
}

__device__ __forceinline__ void p_cvt_bf16(int blk, int nblk, const float* __restrict__ src, bf16_t* dst, size_t n8) {
  const int tix = opaque_tid();
  for (size_t i = (size_t)blk * 512 + tix; i < n8; i += (size_t)nblk * 512) {
    const float4 a = ((const float4*)src)[2 * i], b = ((const float4*)src)[2 * i + 1];
    uint4 w; w.x = cvtpk(a.x, a.y); w.y = cvtpk(a.z, a.w); w.z = cvtpk(b.x, b.y); w.w = cvtpk(b.z, b.w);
    ((uint4*)dst)[i] = w;
  }
}


__device__ __forceinline__ unsigned pack_i8x4(float a, float b, float c, float d) {
  const int ia = (int)rintf(a), ib = (int)rintf(b), ic = (int)rintf(c), id = (int)rintf(d);
  return (unsigned)(ia & 255) | ((unsigned)(ib & 255) << 8) | ((unsigned)(ic & 255) << 16) | ((unsigned)id << 24);
}
__device__ __forceinline__ void p_cvt_fp4_rows(int blk, int nblk, const float* __restrict__ src, unsigned* dst, float* inv) {
  const int tix = opaque_tid();
  const int lane = tix & 63, wid = tix >> 6;
  for (int r0 = blk * 8 + wid; r0 < 16384; r0 += nblk * 16) {
    float4 v[2][4];
#pragma unroll
    for (int h = 0; h < 2; ++h) {
      const int r = r0 + h * nblk * 8;
      if (r < 16384) {
        const float4* sp = (const float4*)(src + (size_t)r * D);
#pragma unroll
        for (int k = 0; k < 4; ++k) v[h][k] = sp[k * 64 + lane];
      }
    }
#pragma unroll
    for (int h = 0; h < 2; ++h) {
      const int r = r0 + h * nblk * 8;
      if (r >= 16384) break;
      float am = 0.f;
#pragma unroll
      for (int k = 0; k < 4; ++k) am = fmaxf(am, fmaxf(fmaxf(fabsf(v[h][k].x), fabsf(v[h][k].y)), fmaxf(fabsf(v[h][k].z), fabsf(v[h][k].w))));
      am = wave_max(am);
      const float sc = am > 0.f ? 6.0f / am : 1.0f;
#pragma unroll
      for (int k = 0; k < 4; ++k) {
        unsigned w = 0;
        w = __builtin_amdgcn_cvt_scalef32_pk_fp4_f32(w, v[h][k].x * sc, v[h][k].y * sc, 1.0f, 0);
        w = __builtin_amdgcn_cvt_scalef32_pk_fp4_f32(w, v[h][k].z * sc, v[h][k].w * sc, 1.0f, 1);
        const unsigned wp = (unsigned)__shfl_xor((int)w, 1);
        if ((lane & 1) == 0) dst[((size_t)k * 16384 + r) * 32 + (lane >> 1)] = (w & 0xffffu) | (wp << 16);
      }
      if (lane == 0) inv[r] = am > 0.f ? am * (1.0f / 6.0f) : 1.0f;
    }
  }
}
__device__ __forceinline__ void p_cvt_i4_rows(int blk, int nblk, const float* __restrict__ src, unsigned* dst, float* inv, const float* __restrict__ csc) {
  const int tix = opaque_tid();
  const int lane = tix & 63, wid = tix >> 6;
  for (int r0 = blk * 8 + wid; r0 < 16384; r0 += nblk * 16) {
    float4 v[2][4];
#pragma unroll
    for (int h = 0; h < 2; ++h) {
      const int r = r0 + h * nblk * 8;
      if (r < 16384) {
        const float4* sp = (const float4*)(src + (size_t)r * D);
#pragma unroll
        for (int k = 0; k < 4; ++k) v[h][k] = sp[k * 64 + lane];
      }
    }
#pragma unroll
    for (int h = 0; h < 2; ++h) {
      const int r = r0 + h * nblk * 8;
      if (r >= 16384) break;
      if (csc) {
#pragma unroll
        for (int k = 0; k < 4; ++k) { const float4 g = ((const float4*)csc)[k * 64 + lane]; v[h][k].x *= g.x; v[h][k].y *= g.y; v[h][k].z *= g.z; v[h][k].w *= g.w; }
      }
#pragma unroll
      for (int k = 0; k < 4; ++k) {
        const float am = wave_max(fmaxf(fmaxf(fabsf(v[h][k].x), fabsf(v[h][k].y)), fmaxf(fabsf(v[h][k].z), fabsf(v[h][k].w))));
        const float sc = am > 0.f ? 7.0f / am : 1.0f;
        const unsigned w = (unsigned)((int)rintf(v[h][k].x * sc) & 15) | ((unsigned)((int)rintf(v[h][k].y * sc) & 15) << 8) | ((unsigned)((int)rintf(v[h][k].z * sc) & 15) << 16) | ((unsigned)((int)rintf(v[h][k].w * sc) & 15) << 24);
        const unsigned wp = (unsigned)__shfl_xor((int)w, 1);
        if ((lane & 1) == 0) dst[((size_t)k * 16384 + r) * 32 + (lane >> 1)] = w | (wp << 4);
        if (lane == 0) inv[r * 4 + k] = am > 0.f ? am * (1.0f / 7.0f) : 1.0f;
      }
    }
  }
}


__device__ __forceinline__ unsigned xcc_id() { return (unsigned)__builtin_amdgcn_s_getreg((3 << 11) | 20) & 7u; }

typedef __attribute__((address_space(1))) const unsigned char gbyte_t;
typedef unsigned u32x4_t __attribute__((ext_vector_type(4)));
typedef __attribute__((address_space(1))) const u32x4_t gu32x4_t;
__device__ __forceinline__ gbyte_t* uniform_ptr(const unsigned char* p) {
  const unsigned long long v = (unsigned long long)p;
  const unsigned lo = __builtin_amdgcn_readfirstlane((unsigned)v), hi = __builtin_amdgcn_readfirstlane((unsigned)(v >> 32));
  return (gbyte_t*)(((unsigned long long)hi << 32) | lo);
}
__device__ __forceinline__ void ds_issue(uint4 (&u)[16], const int* El  , gbyte_t* tab  , unsigned loff  ) {
  int ev[16];
#pragma unroll
  for (int q = 0; q < 4; ++q) { const int4 t = *(const int4*)(El + 4 * q); ev[4 * q] = t.x; ev[4 * q + 1] = t.y; ev[4 * q + 2] = t.z; ev[4 * q + 3] = t.w; }
#pragma unroll
  for (int it = 0; it < 16; ++it) { const u32x4_t t = *(gu32x4_t*)(tab + (size_t)(((unsigned)ev[it] << 7) + loff)); u[it] = make_uint4(t[0], t[1], t[2], t[3]); }
}
__device__ __forceinline__ void ds_u_compute(const uint4 (&u)[16], const unsigned* XHl, const unsigned* XLl  , float xs  ,
                                             float* __restrict__ pout, int j) {
  const uint4 xh = *(const uint4*)XHl, xl = *(const uint4*)XLl;
  float d[16];
#pragma unroll
  for (int it = 0; it < 16; ++it) {
    int ah, al;
    asm("v_dot8_i32_i4 %0, %1, %2, 0" : "=v"(ah) : "v"(u[it].x), "v"(xh.x));
    asm("v_dot8_i32_i4 %0, %1, %2, 0" : "=v"(al) : "v"(u[it].x), "v"(xl.x));
    ah = __builtin_amdgcn_sdot8((int)u[it].y, (int)xh.y, ah, false); al = __builtin_amdgcn_sdot8((int)u[it].y, (int)xl.y, al, false);
    ah = __builtin_amdgcn_sdot8((int)u[it].z, (int)xh.z, ah, false); al = __builtin_amdgcn_sdot8((int)u[it].z, (int)xl.z, al, false);
    ah = __builtin_amdgcn_sdot8((int)u[it].w, (int)xh.w, ah, false); al = __builtin_amdgcn_sdot8((int)u[it].w, (int)xl.w, al, false);
    d[it] = (float)(ah * 16 + al) * xs;
  }
  const bool b2 = (j & 4) != 0, b1 = (j & 2) != 0, b0 = (j & 1) != 0;
  float t8[8], t4[4], t2[2];
#pragma unroll
  for (int i = 0; i < 8; ++i) {
    const float send = b2 ? d[i] : d[i + 8], keep = b2 ? d[i + 8] : d[i];
    t8[i] = keep + __builtin_bit_cast(float, __builtin_amdgcn_update_dpp(0, __builtin_bit_cast(int, send), 0x141, 0xf, 0xf, true));
  }
#pragma unroll
  for (int i = 0; i < 4; ++i) {
    const float send = b1 ? t8[i] : t8[i + 4], keep = b1 ? t8[i + 4] : t8[i];
    t4[i] = keep + __builtin_bit_cast(float, __builtin_amdgcn_update_dpp(0, __builtin_bit_cast(int, send), 0x4E, 0xf, 0xf, true));
  }
#pragma unroll
  for (int i = 0; i < 2; ++i) {
    const float send = b0 ? t4[i] : t4[i + 2], keep = b0 ? t4[i + 2] : t4[i];
    t2[i] = keep + __builtin_bit_cast(float, __builtin_amdgcn_update_dpp(0, __builtin_bit_cast(int, send), 0xB1, 0xf, 0xf, true));
  }
  *(float2*)pout = make_float2(t2[0], t2[1]);
}
__device__ __forceinline__ unsigned bytes_add8(unsigned x) { return ((x & 0x7F7F7F7Fu) + 0x08080808u) ^ (x & 0x80808080u); }
__device__ __forceinline__ void ds_u_chunk(char* wl  , int lane, int tk0, int s  , const unsigned char* __restrict__ xi8, const float* __restrict__ xsc,
                                           const int* __restrict__ eb, const unsigned char* __restrict__ ut4, float* __restrict__ partial) {
  const int b = tk0 / SEQ, sq = tk0 - b * SEQ;
  const size_t row0 = (size_t)b * LP + NMETA + sq;
  const int j = lane & 7, gi = lane >> 3;
  int* El = (int*)wl;
  unsigned* XH = (unsigned*)(wl + 8192);
  unsigned* XL = (unsigned*)(wl + 8192 + 2048);
  float* Sl = (float*)(wl + 8192 + 4096);
#pragma unroll
  for (int i = 0; i < 8; ++i) *(int4*)(El + (i * 64 + lane) * 4) = *(const int4*)(eb + row0 * 128 + (i * 64 + lane) * 4);
  {
    const int t = lane >> 2, part = lane & 3;
    const uint4* xp = (const uint4*)(xi8 + (row0 + t) * D + 256 * s + 64 * part);
    uint4 w4[4];
#pragma unroll
    for (int i = 0; i < 4; ++i) w4[i] = xp[i];
    unsigned hi[8], lo[8];
#pragma unroll
    for (int i = 0; i < 4; ++i) {
      const unsigned tA0 = bytes_add8(w4[i].x), tB0 = bytes_add8(w4[i].y), tA1 = bytes_add8(w4[i].z), tB1 = bytes_add8(w4[i].w);
      lo[2 * i] = ((tA0 & 0x0F0F0F0Fu) | ((tB0 & 0x0F0F0F0Fu) << 4)) ^ 0x88888888u; hi[2 * i] = ((tA0 >> 4) & 0x0F0F0F0Fu) | (tB0 & 0xF0F0F0F0u);
      lo[2 * i + 1] = ((tA1 & 0x0F0F0F0Fu) | ((tB1 & 0x0F0F0F0Fu) << 4)) ^ 0x88888888u; hi[2 * i + 1] = ((tA1 >> 4) & 0x0F0F0F0Fu) | (tB1 & 0xF0F0F0F0u);
    }
    uint4* dh = (uint4*)(XH + t * 32 + 8 * part); uint4* dl = (uint4*)(XL + t * 32 + 8 * part);
    dh[0] = make_uint4(hi[0], hi[1], hi[2], hi[3]); dh[1] = make_uint4(hi[4], hi[5], hi[6], hi[7]);
    dl[0] = make_uint4(lo[0], lo[1], lo[2], lo[3]); dl[1] = make_uint4(lo[4], lo[5], lo[6], lo[7]);
    Sl[lane] = xsc[(row0 + t) * 16 + 4 * s + part];
  }
  gbyte_t* tab = uniform_ptr(ut4 + (size_t)s * (16384 * 128));
  const unsigned loff = 16u * (unsigned)j;
  float* pout = partial + ((size_t)tk0 * 4 + s) * 128 + gi * 16 + 2 * j;
  uint4 ua[16], ub[16];
  ds_issue(ua, El + gi * 16, tab, loff);
#pragma unroll 1
  for (int t = 0; t < 16; t += 2) {
    ds_issue(ub, El + (t + 1) * 128 + gi * 16, tab, loff);
    ds_u_compute(ua, XH + t * 32 + 4 * j, XL + t * 32 + 4 * j, Sl[4 * t + (j >> 1)], pout + (size_t)t * 512, j);
    if (t + 2 < 16) ds_issue(ua, El + (t + 2) * 128 + gi * 16, tab, loff);
    ds_u_compute(ub, XH + (t + 1) * 32 + 4 * j, XL + (t + 1) * 32 + 4 * j, Sl[4 * (t + 1) + (j >> 1)], pout + (size_t)(t + 1) * 512, j);
  }
}

typedef float f32x2v __attribute__((ext_vector_type(2)));
__device__ __forceinline__ void ds_v_compute(const uint4 (&v)[16], const float* Wl  , int lane, int j, int gi, size_t row, int tk, int s,
                                             const bf16_t* __restrict__ hb, float* __restrict__ out, float* __restrict__ ssq) {
  const int c0 = 256 * s + 32 * j + 4 * gi;
  const uint2 hwq = *(const uint2*)(hb + row * D + c0);
  float w[16];
#pragma unroll
  for (int q = 0; q < 4; ++q) { const float4 f = *(const float4*)(Wl + 4 * q); w[4 * q] = f.x; w[4 * q + 1] = f.y; w[4 * q + 2] = f.z; w[4 * q + 3] = f.w; }
  f32x2v acc[16];
#pragma unroll
  for (int i = 0; i < 16; ++i) acc[i] = (f32x2v){0.f, 0.f};
#pragma unroll
  for (int it = 0; it < 16; ++it) {
    const unsigned wv[4] = {v[it].x, v[it].y, v[it].z, v[it].w};
    const f32x2v w2 = {w[it], w[it]};
#pragma unroll
    for (int q = 0; q < 4; ++q) {
      acc[4 * q] = __builtin_elementwise_fma(w2, __builtin_amdgcn_cvt_scalef32_pk_f32_fp4(wv[q], 1.0f, 0), acc[4 * q]);
      acc[4 * q + 1] = __builtin_elementwise_fma(w2, __builtin_amdgcn_cvt_scalef32_pk_f32_fp4(wv[q], 1.0f, 1), acc[4 * q + 1]);
      acc[4 * q + 2] = __builtin_elementwise_fma(w2, __builtin_amdgcn_cvt_scalef32_pk_f32_fp4(wv[q], 1.0f, 2), acc[4 * q + 2]);
      acc[4 * q + 3] = __builtin_elementwise_fma(w2, __builtin_amdgcn_cvt_scalef32_pk_f32_fp4(wv[q], 1.0f, 3), acc[4 * q + 3]);
    }
  }
  float t16[16], t8[8], t4[4];
#pragma unroll
  for (int i = 0; i < 16; ++i) {
    const float a = (i & 1) ? acc[i >> 1].y : acc[i >> 1].x, b = (i & 1) ? acc[8 + (i >> 1)].y : acc[8 + (i >> 1)].x;
    auto rr = __builtin_amdgcn_permlane32_swap(__float_as_uint(a), __float_as_uint(b), false, false);
    t16[i] = __uint_as_float(rr[0]) + __uint_as_float(rr[1]);
  }
#pragma unroll
  for (int i = 0; i < 8; ++i) {
    auto rr = __builtin_amdgcn_permlane16_swap(__float_as_uint(t16[i]), __float_as_uint(t16[i + 8]), false, false);
    t8[i] = __uint_as_float(rr[0]) + __uint_as_float(rr[1]);
  }
  const bool b3 = (lane & 8) != 0;
#pragma unroll
  for (int i = 0; i < 4; ++i) {
    const float send = b3 ? t8[i] : t8[i + 4], keep = b3 ? t8[i + 4] : t8[i];
    t4[i] = keep + __builtin_bit_cast(float, __builtin_amdgcn_update_dpp(0, __builtin_bit_cast(int, send), 0x128, 0xf, 0xf, true));
  }
  const float o0 = __uint_as_float(hwq.x << 16) + t4[0], o1 = __uint_as_float(hwq.x & 0xffff0000u) + t4[1], o2 = __uint_as_float(hwq.y << 16) + t4[2], o3 = __uint_as_float(hwq.y & 0xffff0000u) + t4[3];
  *(float4*)(out + (size_t)tk * D + c0) = make_float4(o0, o1, o2, o3);
  const float ss = wave_sum(o0 * o0 + o1 * o1 + o2 * o2 + o3 * o3);
  if (lane == 0) ssq[(size_t)tk * 4 + s] = ss;
}
__device__ __forceinline__ void ds_v_chunk(char* wl, int lane, int tk0, int s  , const bf16_t* __restrict__ hb, const int* __restrict__ eb, const float* __restrict__ wbuf,
                                           const unsigned char* __restrict__ vt4, float* __restrict__ out, float* __restrict__ ssq) {
  const int b = tk0 / SEQ, sq = tk0 - b * SEQ;
  const size_t row0 = (size_t)b * LP + NMETA + sq;
  const int j = lane & 7, gi = lane >> 3;
  int* El = (int*)wl;
  float* Wl = (float*)(wl + 8192);
#pragma unroll
  for (int i = 0; i < 8; ++i) {
    *(int4*)(El + (i * 64 + lane) * 4) = *(const int4*)(eb + row0 * 128 + (i * 64 + lane) * 4);
    *(float4*)(Wl + (i * 64 + lane) * 4) = *(const float4*)(wbuf + (size_t)tk0 * 128 + (i * 64 + lane) * 4);
  }
  gbyte_t* tab = uniform_ptr(vt4 + (size_t)s * (16384 * 128));
  const unsigned loff = 16u * (unsigned)j;
  uint4 va[16], vb[16];
  ds_issue(va, El + gi * 16, tab, loff);
#pragma unroll 1
  for (int t = 0; t < 16; t += 2) {
    ds_issue(vb, El + (t + 1) * 128 + gi * 16, tab, loff);
    ds_v_compute(va, Wl + t * 128 + gi * 16, lane, j, gi, row0 + t, tk0 + t, s, hb, out, ssq);
    if (t + 2 < 16) ds_issue(va, El + (t + 2) * 128 + gi * 16, tab, loff);
    ds_v_compute(vb, Wl + (t + 1) * 128 + gi * 16, lane, j, gi, row0 + t + 1, tk0 + t + 1, s, hb, out, ssq);
  }
}


struct EpiBf16 {
  bf16_t* out; int ld; int use_scale; unsigned* kmax;
  __device__ __forceinline__ void store8(size_t row, int col, const float (&v)[8], float& tmax) const {
    if (kmax && col >= 512 && col < 1024) {
      float ss = 0.f;
#pragma unroll
      for (int i = 0; i < 8; ++i) ss += v[i] * v[i];
      tmax = fmaxf(tmax, sum8(ss));
    }
    uint4 w; w.x = cvtpk(v[0], v[1]); w.y = cvtpk(v[2], v[3]); w.z = cvtpk(v[4], v[5]); w.w = cvtpk(v[6], v[7]);
    *(uint4*)(out + row * ld + col) = w;
  }
  __device__ __forceinline__ void finish(float tmax, size_t row, int col) const {
    if (kmax && col >= 512 && col < 1024) {
      tmax = wave_max(tmax);
      if ((threadIdx.x & 63) == 0) atomicMax(kmax + (row / LP) * 8 + ((col - 512) >> 6), __float_as_uint(tmax));
    }
  }
};
struct EpiResid2 {
  const float* x; const float* meta; float* h2; bf16_t* hb; float* rowss; unsigned char* xi8; float* xsc;
  __device__ __forceinline__ void finish(float, size_t, int) const {}
  __device__ __forceinline__ void store8(size_t row, int col, const float (&v)[8], float&) const {
    const float* src = hrow_ptr(x, meta, (int)row);
    const float4 a = *(const float4*)(src + col), b = *(const float4*)(src + col + 4);
    const float o[8] = {a.x + v[0], a.y + v[1], a.z + v[2], a.w + v[3], b.x + v[4], b.y + v[5], b.z + v[6], b.w + v[7]};
    uint4 w; w.x = cvtpk(o[0], o[1]); w.y = cvtpk(o[2], o[3]); w.z = cvtpk(o[4], o[5]); w.w = cvtpk(o[6], o[7]);
    *(uint4*)(hb + row * D + col) = w;
    float ss = 0.f;
#pragma unroll
    for (int i = 0; i < 8; ++i) ss += o[i] * o[i];
    ss = sum8(ss);
    if ((threadIdx.x & 7) == 0) rowss[row * 16 + (col >> 6)] = ss;
    {
      float am = fmaxf(fmaxf(fmaxf(fabsf(o[0]), fabsf(o[1])), fmaxf(fabsf(o[2]), fabsf(o[3]))), fmaxf(fmaxf(fabsf(o[4]), fabsf(o[5])), fmaxf(fabsf(o[6]), fabsf(o[7]))));
      am = fmaxf(am, __builtin_bit_cast(float, __builtin_amdgcn_update_dpp(0, __builtin_bit_cast(int, am), 0x141, 0xf, 0xf, true)));
      am = fmaxf(am, __builtin_bit_cast(float, __builtin_amdgcn_update_dpp(0, __builtin_bit_cast(int, am), 0xB1, 0xf, 0xf, true)));
      am = fmaxf(am, __builtin_bit_cast(float, __builtin_amdgcn_update_dpp(0, __builtin_bit_cast(int, am), 0x4E, 0xf, 0xf, true)));
      const float sc = am > 0.f ? 119.0f / am : 1.0f;
      *(uint2*)(xi8 + row * D + col) = make_uint2(pack_i8x4(o[0] * sc, o[1] * sc, o[2] * sc, o[3] * sc), pack_i8x4(o[4] * sc, o[5] * sc, o[6] * sc, o[7] * sc));
      if ((threadIdx.x & 7) == 0) xsc[row * 16 + (col >> 6)] = am > 0.f ? am * (1.0f / 119.0f) : 1.0f;
    }
  }
};

__device__ __forceinline__ int g8_lds_byte(int r, int c) {
  const int st = (r >> 4) * 2 + (c >> 5), rr = r & 15, cc = c & 31, ob = rr * 64 + cc * 2;
  return st * 1024 + (ob ^ (((ob >> 9) & 1) << 5));
}
__device__ __forceinline__ void g8_stage_rc(int b, int& R, int& C) {
  const int st = b / 1024, sb = b % 1024, swz = sb ^ (((sb >> 9) & 1) << 5);
  R = (st >> 1) * 16 + swz / 64; C = (st & 1) * 32 + (swz % 64) / 2;
}
template <class Epi>
__device__ __forceinline__ void gemm256(char* lds, const bf16_t* __restrict__ X, int ldx, const bf16_t* __restrict__ Wt, int ldw, int K, size_t xrow0, int n0, const Epi& epi) {
  const int tix = opaque_tid();
  const int tid = tix, lane = tid & 63;
  const int wid = __builtin_amdgcn_readfirstlane(tid >> 6);
  const int wr = wid >> 2, wc = wid & 3, fr = lane & 15, fq = lane >> 4;
  f32x4 acc[2][2][4][2];
#pragma unroll
  for (int i = 0; i < 2; ++i)
#pragma unroll
    for (int j = 0; j < 2; ++j)
#pragma unroll
      for (int m = 0; m < 4; ++m)
#pragma unroll
        for (int n = 0; n < 2; ++n) acc[i][j][m][n] = (f32x4){0.f, 0.f, 0.f, 0.f};
  bf16x8 At[4][2], B0[2][2], B1[2][2];
  const int nt = K >> 6;
  const char* xg[2]; const char* wg[2];
#pragma unroll
  for (int i = 0; i < 2; ++i) {
    int R, C; g8_stage_rc(tid * 16 + i * 8192, R, C);
    xg[i] = (const char*)(X + (xrow0 + R) * ldx + C);
    wg[i] = (const char*)(Wt + (size_t)(n0 + R) * ldw + C);
  }
#define G8_SA(b, h) (lds + ((b) * 2 + (h)) * 16384)
#define G8_SB(b, h) (lds + (4 + (b) * 2 + (h)) * 16384)
#define G8_STAGE_A(b, h, kt) do { _Pragma("unroll") for (int i_ = 0; i_ < 2; ++i_) \
    __builtin_amdgcn_global_load_lds((const unsigned*)(xg[i_] + (size_t)(h) * 128 * ldx * 2 + (kt) * 128), LDSP(unsigned, G8_SA(b, h) + wid * 1024 + i_ * 8192), 16, 0, 0); } while (0)
#define G8_STAGE_B(b, h, kt) do { _Pragma("unroll") for (int i_ = 0; i_ < 2; ++i_) \
    __builtin_amdgcn_global_load_lds((const unsigned*)(wg[i_] + (size_t)(h) * 128 * ldw * 2 + (kt) * 128), LDSP(unsigned, G8_SB(b, h) + wid * 1024 + i_ * 8192), 16, 0, 0); } while (0)
#define G8_LDA(dst, b, h) _Pragma("unroll") for (int m = 0; m < 4; ++m) _Pragma("unroll") for (int k = 0; k < 2; ++k) \
    dst[m][k] = *(const bf16x8*)(G8_SA(b, h) + g8_lds_byte(wr * 64 + m * 16 + fr, k * 32 + fq * 8))
#define G8_LDB(dst, b, h) _Pragma("unroll") for (int n = 0; n < 2; ++n) _Pragma("unroll") for (int k = 0; k < 2; ++k) \
    dst[n][k] = *(const bf16x8*)(G8_SB(b, h) + g8_lds_byte(wc * 32 + n * 16 + fr, k * 32 + fq * 8))
#define G8_MMA(ai, bj, At_, Bt_) do { __builtin_amdgcn_s_setprio(1); \
    _Pragma("unroll") for (int m = 0; m < 4; ++m) _Pragma("unroll") for (int n = 0; n < 2; ++n) _Pragma("unroll") for (int k = 0; k < 2; ++k) \
      acc[ai][bj][m][n] = __builtin_amdgcn_mfma_f32_16x16x32_bf16(Bt_[n][k], At_[m][k], acc[ai][bj][m][n], 0, 0, 0); \
    __builtin_amdgcn_s_setprio(0); } while (0)
#define G8_WAIT_V(n) asm volatile("s_waitcnt vmcnt(" #n ")" ::: "memory")
#define G8_WAIT_L(n) asm volatile("s_waitcnt lgkmcnt(" #n ")" ::: "memory")
#define G8_BAR __builtin_amdgcn_s_barrier()
#define G8_SCHED __builtin_amdgcn_sched_barrier(0)
  __syncthreads();
  G8_STAGE_B(0, 0, 0); G8_STAGE_A(0, 0, 0); G8_STAGE_B(0, 1, 0); G8_STAGE_A(0, 1, 0);
  if (wr == 1) G8_BAR;
  G8_WAIT_V(4); G8_BAR;
  G8_STAGE_B(1, 0, 1); G8_STAGE_A(1, 0, 1); G8_STAGE_B(1, 1, 1);
  G8_WAIT_V(6); G8_BAR;
#pragma unroll 1
  for (int t = 0; t < nt - 2; t += 2) {
    G8_LDB(B0, 0, 0); G8_SCHED; G8_LDA(At, 0, 0); G8_STAGE_A(1, 1, t + 1);
    G8_WAIT_L(8); G8_BAR; G8_WAIT_L(0); G8_MMA(0, 0, At, B0); G8_BAR; G8_SCHED;
    G8_LDB(B1, 0, 1); G8_STAGE_B(0, 0, t + 2);
    G8_BAR; G8_WAIT_L(0); G8_MMA(0, 1, At, B1); G8_BAR;
    G8_LDA(At, 0, 1); G8_STAGE_A(0, 0, t + 2);
    G8_BAR; G8_WAIT_L(0); G8_MMA(1, 0, At, B0); G8_BAR; G8_SCHED;
    G8_STAGE_B(0, 1, t + 2);
    G8_WAIT_V(6); G8_BAR; G8_MMA(1, 1, At, B1); G8_BAR;
    G8_LDB(B0, 1, 0); G8_SCHED; G8_LDA(At, 1, 0); G8_STAGE_A(0, 1, t + 2);
    G8_WAIT_L(8); G8_BAR; G8_WAIT_L(0); G8_MMA(0, 0, At, B0); G8_BAR; G8_SCHED;
    G8_LDB(B1, 1, 1); G8_STAGE_B(1, 0, t + 3);
    G8_BAR; G8_WAIT_L(0); G8_MMA(0, 1, At, B1); G8_BAR;
    G8_LDA(At, 1, 1); G8_STAGE_A(1, 0, t + 3);
    G8_BAR; G8_WAIT_L(0); G8_MMA(1, 0, At, B0); G8_BAR; G8_SCHED;
    G8_STAGE_B(1, 1, t + 3);
    G8_WAIT_V(6); G8_BAR; G8_MMA(1, 1, At, B1); G8_BAR;
  }
  { G8_LDB(B0, 0, 0); G8_LDA(At, 0, 0); G8_STAGE_A(1, 1, nt - 1);
    G8_BAR; G8_WAIT_L(0); G8_MMA(0, 0, At, B0); G8_BAR;
    G8_LDB(B1, 0, 1); G8_BAR; G8_WAIT_L(0); G8_MMA(0, 1, At, B1); G8_BAR;
    G8_LDA(At, 0, 1); G8_WAIT_V(4); G8_BAR; G8_WAIT_L(0); G8_MMA(1, 0, At, B0); G8_MMA(1, 1, At, B1); G8_BAR; }
  { G8_LDB(B0, 1, 0); G8_LDA(At, 1, 0); G8_WAIT_V(2); G8_BAR; G8_WAIT_L(0); G8_MMA(0, 0, At, B0); G8_BAR;
    G8_LDB(B1, 1, 1); G8_WAIT_V(0); G8_BAR; G8_WAIT_L(0); G8_MMA(0, 1, At, B1); G8_BAR;
    G8_LDA(At, 1, 1); G8_BAR; G8_WAIT_L(0); G8_MMA(1, 0, At, B0); G8_MMA(1, 1, At, B1); G8_BAR; }
  if (wr == 0) G8_BAR;
#undef G8_SA
#undef G8_SB
#undef G8_STAGE_A
#undef G8_STAGE_B
#undef G8_LDA
#undef G8_LDB
#undef G8_MMA
#undef G8_WAIT_V
#undef G8_WAIT_L
#undef G8_BAR
#undef G8_SCHED
  float tmax = 0.f;
  const int wm2 = wid >> 2, seg = wid & 3;
#pragma unroll
  for (int ai = 0; ai < 2; ++ai) {
    __syncthreads();
#pragma unroll
    for (int bj = 0; bj < 2; ++bj)
#pragma unroll
      for (int m = 0; m < 4; ++m)
#pragma unroll
        for (int n = 0; n < 2; ++n) {
          const int row = wr * 64 + m * 16 + fr, chunk = bj * 32 + wc * 8 + n * 4 + fq;
          *(f32x4*)(lds + row * 1024 + ((chunk ^ (row & 7)) << 4)) = acc[ai][bj][m][n];
        }
    __syncthreads();
#pragma unroll
    for (int i = 0; i < 8; ++i) {
      const int row = wm2 * 64 + 8 * i + (lane >> 3), c8 = lane & 7, ch = seg * 16 + 2 * c8;
      const f32x4 v0 = *(const f32x4*)(lds + row * 1024 + ((ch ^ (row & 7)) << 4)), v1 = *(const f32x4*)(lds + row * 1024 + (((ch + 1) ^ (row & 7)) << 4));
      const float v[8] = {v0[0], v0[1], v0[2], v0[3], v1[0], v1[1], v1[2], v1[3]};
      epi.store8(xrow0 + ai * 128 + row, n0 + seg * 64 + 8 * c8, v, tmax);
    }
  }
  epi.finish(tmax, xrow0, n0 + seg * 64);
}

__device__ __forceinline__ void meta_proj(char* lds, int blk, const bf16_t* __restrict__ xn1, const bf16_t* __restrict__ wt_in, bf16_t* proj) {
  const int tix = opaque_tid();
  float* red = (float*)lds;
  __syncthreads();
  float part = 0.f;
  const int o = tix % 160, kp = tix / 160;
  if (tix < 480) {
    const int row = o / 10, n = blk * 10 + o % 10;
    const int k0 = kp * 352, k1 = kp == 2 ? 1024 : k0 + 352;
    const bf16_t* xr = xn1 + (size_t)row * D; const bf16_t* wr = wt_in + (size_t)n * D;
    for (int k = k0; k < k1; k += 8) {
      const uint4 a = *(const uint4*)(xr + k), b = *(const uint4*)(wr + k);
      part = dot8(a, b, part);
    }
    red[tix] = part;
  }
  __syncthreads();
  if (tix < 160) {
    const float v = red[tix] + red[tix + 160] + red[tix + 320];
    const int row = tix / 10, n = blk * 10 + tix % 10;
    const bf16_t bv = f2bf(v);
#pragma unroll
    for (int b = 0; b < BATCH; ++b) proj[((size_t)b * LP + row) * INC + n] = bv;
  }
}

__device__ __forceinline__ void p_transpose(int t, float* smem, const float* __restrict__ W, bf16_t* Wt, int K, int N, const float* __restrict__ ksc) {
  const int tix = opaque_tid();
  float (*T)[65] = (float (*)[65])smem;
  const int nbx = N / 64, k0 = (t / nbx) * 64, n0 = (t % nbx) * 64, tid = (tix & 255);
  const int j = tid & 63, i0 = tid >> 6;
#pragma unroll
  for (int ii = 0; ii < 16; ++ii) { int i = i0 + 4 * ii; T[i][j] = W[(size_t)(k0 + i) * N + n0 + j] * (ksc ? ksc[k0 + i] : 1.0f); }
  __syncthreads();
#pragma unroll
  for (int ii = 0; ii < 16; ++ii) { int jj = i0 + 4 * ii; Wt[(size_t)(n0 + jj) * K + k0 + j] = f2bf(T[j][jj]); }
  __syncthreads();
}

#define XB_TMO      128
#define XB_XCNT(j)  (256  + 64 * (j))
#define XB_XSUB(j)  (1280 + 64 * (j))
#define XB_XGEN(j)  (2304 + 64 * (j))
#define XB_TOP      3328
#define XB_TOPGEN   3392
#define XCD_BAR_WORDS 3456
#define XB_SPIN_CAP (1u << 18)
#define LAS __attribute__((address_space(3)))

__device__ __forceinline__ unsigned xb_ld(unsigned* p)              { return __hip_atomic_load(p, __ATOMIC_RELAXED, __HIP_MEMORY_SCOPE_AGENT); }
__device__ __forceinline__ unsigned xb_add(unsigned* p, unsigned v) { return __hip_atomic_fetch_add(p, v, __ATOMIC_RELAXED, __HIP_MEMORY_SCOPE_AGENT); }
__device__ __forceinline__ unsigned xb_xcc_id() { return (unsigned)__builtin_amdgcn_s_getreg((3 << 11) | 20) & 0xFu; }
#define XB_SPIN(cond, bar) do { unsigned _sp = 0; while (cond) { __builtin_amdgcn_s_sleep(1); \
    if ((++_sp & 255u) == 0u) { if (xb_ld(&(bar)[XB_TMO])) break; if (_sp > XB_SPIN_CAP) { atomicAdd(&(bar)[XB_TMO], 1u); break; } } } } while (0)

struct XcdBarrier {
    unsigned* bar; unsigned x;
    volatile LAS unsigned* st;
};

__device__ __forceinline__ XcdBarrier xcd_barrier_post(unsigned* bar, volatile LAS unsigned* st) {
    XcdBarrier b; b.bar = bar; b.x = xb_xcc_id(); b.st = st;
    if (threadIdx.x == 0) (void)xb_add(&bar[XB_XCNT(b.x)], 1u);
    return b;
}
__device__ __forceinline__ void xcd_barrier_complete(unsigned* bar, unsigned x, unsigned& nloc, unsigned& nx) {
    const unsigned G = gridDim.x * gridDim.y * gridDim.z;
    unsigned sum, cnt, mine, sp = 0u;
    for (;;) {
        sum = 0u; cnt = 0u; mine = 0u;
#pragma unroll
        for (unsigned j = 0; j < 16; ++j) { const unsigned c = xb_ld(&bar[XB_XCNT(j)]); sum += c; cnt += (c > 0u) ? 1u : 0u; mine = (j == x) ? c : mine; }
        if (sum == G) break;
        __builtin_amdgcn_s_sleep(1);
        if ((++sp & 255u) == 0u) { if (xb_ld(&bar[XB_TMO])) break; if (sp > XB_SPIN_CAP) { atomicAdd(&bar[XB_TMO], 1u); break; } }
    }
    nloc = mine > 0u ? mine : 1u; nx = cnt > 0u ? cnt : 1u;
}

__device__ __forceinline__ void xcd_barrier(const XcdBarrier& b) {
    asm volatile("s_waitcnt vmcnt(0)" ::: "memory");
    __syncthreads();
    if (threadIdx.x == 0) {
        unsigned* bar = b.bar;
        __builtin_amdgcn_s_waitcnt(0);
        unsigned nloc = b.st[0], nx = b.st[1];
        if (nloc == 0u) { xcd_barrier_complete(bar, b.x, nloc, nx); b.st[0] = nloc; b.st[1] = nx; }
        const unsigned old = xb_add(&bar[XB_XSUB(b.x)], 1u);
        const unsigned gen = old / nloc;
        if (old + 1u == (gen + 1u) * nloc) {
            __builtin_amdgcn_fence(__ATOMIC_RELEASE, "agent");
            asm volatile("s_waitcnt vmcnt(0)" ::: "memory");
            const unsigned og = xb_add(&bar[XB_TOP], 1u);
            const unsigned tg = og / nx;
            if (og + 1u == (tg + 1u) * nx) xb_add(&bar[XB_TOPGEN], 1u);
            else XB_SPIN(xb_ld(&bar[XB_TOPGEN]) == tg, bar);
            __builtin_amdgcn_fence(__ATOMIC_ACQUIRE, "agent");
            xb_add(&bar[XB_XGEN(b.x)], 1u);
            asm volatile("s_waitcnt vmcnt(0)" ::: "memory");
        } else {
            XB_SPIN(xb_ld(&bar[XB_XGEN(b.x)]) == gen, bar);
            __builtin_amdgcn_fence(__ATOMIC_ACQUIRE, "agent");
            asm volatile("s_waitcnt vmcnt(0)" ::: "memory");
        }
    }
    __syncthreads();
}


struct Params {
  const float *x, *meta, *g1, *w_in, *lq1, *lk1, *lq2, *lk2, *subg, *conv_w, *conv_b, *gn_g, *gn_b, *w_out, *g2, *wq, *sk, *ut, *vt, *fg;
  float* out; float* scal; bf16_t* r1; bf16_t* r2; float* h2; int* eb; float* gb; bf16_t* wt_in; bf16_t* wt_out; bf16_t* wt_q; bf16_t* skb; unsigned char* ut8; unsigned char* vt8; float* uinv; float* vinv; float* wbuf; float* ssq; bf16_t* hb; float* rowss; int use_cg_sync; int pad0;
};

__global__ void __launch_bounds__(512, 2) mega(Params p) {
  cg::grid_group grid = cg::this_grid();
  __shared__ __attribute__((aligned(16))) char smem_c[131072 + 256];
  float* smem = (float*)smem_c;
  const int G = gridDim.x, vh = threadIdx.x >> 8;
  volatile LAS unsigned* xb_st = (volatile LAS unsigned*)(smem_c + 131072 + 16);
  if (threadIdx.x == 0) { xb_st[0] = 0u; xb_st[1] = 0u; }
  __syncthreads();
  const XcdBarrier xbar = xcd_barrier_post((unsigned*)(p.scal + 1024), xb_st);
  bf16_t* xn1 = p.r1; bf16_t* mix = p.r1; bf16_t* proj = p.r2; bf16_t* qp = p.r2;
  p_norm1_rows(G, p.x, p.meta, p.g1, xn1);
  if (blockIdx.x == 0 && threadIdx.x < 64) {
    const int t = threadIdx.x;
    const float a = wave_sum(p.lq1[t] * p.lk1[t]), b2 = wave_sum(p.lq2[t] * p.lk2[t]);
    if (t == 0) p.scal[0] = expf(a) - expf(b2) + LAM_INIT;
  }
  for (int b = blockIdx.x; b < (640 + 256 + 512) / 2; b += G) {
    const int bb = b * 2 + vh; float* sm = smem + vh * (64 * 65);
    if (bb < 640) p_transpose(bb, sm, p.w_in, p.wt_in, D, INC, nullptr);
    else if (bb < 896) p_transpose(bb - 640, sm, p.w_out, p.wt_out, D, D, nullptr);
    else p_transpose(bb - 896, sm, p.wq, p.wt_q, D, 2048, p.g2);
  }
  p_cvt_bf16(blockIdx.x, G, p.sk, p.skb, (size_t)16 * 128 * 128 / 8);
  p_cvt_i4_rows(blockIdx.x, G, p.ut, (unsigned*)p.ut8, p.uinv, p.g2);
  p_cvt_fp4_rows(blockIdx.x, G, p.vt, (unsigned*)p.vt8, p.vinv);
  if (p.use_cg_sync) grid.sync(); else xcd_barrier(xbar);
  for (int b = blockIdx.x; b < 128 * 10; b += G) {
    const int xi = (b >> 3), mt = (b & 7) * 16 + xi / 10, nt = xi % 10;
    gemm256(smem_c, xn1, D, p.wt_in, D, D, (size_t)(mt >> 4) * LP + NMETA + 256 * (mt & 15), nt * 256, EpiBf16{proj, INC, 0, (unsigned*)(p.scal + 640)});
  }
  for (int b = blockIdx.x; b < 256; b += G) meta_proj(smem_c, b, xn1, p.wt_in, proj);
  for (int i = blockIdx.x * 512 + threadIdx.x; i < BATCH * (LP - LREAL) * 128; i += G * 512) {
    const int c = i & 127, r = i >> 7, b = r / (LP - LREAL), pos = LREAL + r - b * (LP - LREAL);
    *(uint4*)(proj + ((size_t)b * LP + pos) * INC + 512 + 8 * c) = make_uint4(0, 0, 0, 0);
  }
  xcd_barrier(xbar);
  {
    const float lam = p.scal[0];
    unsigned* aq = (unsigned*)(p.scal + 384);
    volatile int* ubox = (volatile int*)(smem_c + 131072 + 32);
    const unsigned x = xcc_id();
    for (int qi = 0; qi < 8; ++qi) {
      const int bq_ = (int)((x + qi) & 7u);
      for (;;) {
        if (threadIdx.x == 0) *ubox = (int)__hip_atomic_fetch_add(aq + bq_ * 16, 1u, __ATOMIC_RELAXED, __HIP_MEMORY_SCOPE_AGENT);
        __syncthreads();
        const int i = *ubox;
        if (i >= 256) break;
        if (i < 128) attn_unit(smem_c, proj, mix, p.subg, (const unsigned*)(p.scal + 640), lam, bq_, i & 3, 31 - (i >> 2));
        else conv_unit(smem_c, proj, mix, p.conv_w, p.conv_b, p.gn_g, p.gn_b, bq_, NMETA + 32 * (i - 128));
      }
      __syncthreads();
    }
  }
  xcd_barrier(xbar);
  for (int b = blockIdx.x; b < 128 * 4; b += G) {
    const int xi = (b >> 3), mt = (b & 7) * 16 + (xi >> 2), nt = xi & 3;
    gemm256(smem_c, mix, D, p.wt_out, D, D, (size_t)(mt >> 4) * LP + NMETA + 256 * (mt & 15), nt * 256, EpiResid2{p.x, p.meta, p.h2, p.hb, p.rowss, (unsigned char*)p.h2, (float*)((char*)p.h2 + (size_t)ROWS * D)});
  }
  xcd_barrier(xbar);
  for (int b = blockIdx.x; b < 128 * 8; b += G) {
    const int xi = (b >> 3), mt = (b & 7) * 16 + (xi >> 3), nt = xi & 7;
    gemm256(smem_c, p.hb, D, p.wt_q, D, D, (size_t)(mt >> 4) * LP + NMETA + 256 * (mt & 15), nt * 256, EpiBf16{qp, 2048, 0, nullptr});
  }
  xcd_barrier(xbar);
  {
    int hprev = -1;
    bf16x8 xq[2][4];
    const int tx = opaque_tid();
    if ((int)blockIdx.x < 256 * 8) { const int rt = blockIdx.x >> 3; peer_load_q(xq, qp, (rt >> 5) * LP + NMETA + 128 * (rt & 31), blockIdx.x & 7, tx >> 6, tx & 15, (tx & 63) >> 4); }
    for (int u = blockIdx.x; u < 256 * 8; u += G) {
      const int rt = u >> 3, h = u & 7;
      const int un = u + G, rtn = un >> 3;
      peer_topk_unit(smem_c, qp, p.skb, p.rowss, p.eb, p.gb, (rt >> 5) * LP + NMETA + 128 * (rt & 31), h, h != hprev, xq, un < 256 * 8 ? (rtn >> 5) * LP + NMETA + 128 * (rtn & 31) : -1, un & 7);
      hprev = h;
    }
  }
  xcd_barrier(xbar);
  {
    const int tix = opaque_tid();
    const int lane = tix & 63;
    const int NTOK = BATCH * SEQ;
    float* partial = (float*)qp;
    unsigned* qh = (unsigned*)(p.scal + 128);
    const unsigned x = xcc_id();
    for (int qi = 0; qi < 4; ++qi) {
      const int s = (int)((x + qi) & 3u);
      for (;;) {
        unsigned st = 0;
        if (lane == 0) st = __hip_atomic_fetch_add(qh + s * 16, 16u, __ATOMIC_RELAXED, __HIP_MEMORY_SCOPE_AGENT);
        st = __builtin_amdgcn_readfirstlane(st);
        if (st >= (unsigned)NTOK) break;
        ds_u_chunk(smem_c + (tix >> 6) * 16384, lane, (int)st, s, (const unsigned char*)p.h2, (const float*)((const char*)p.h2 + (size_t)ROWS * D), p.eb, p.ut8, partial);
      }
    }
    xcd_barrier(xbar);
    for (size_t i = (size_t)blockIdx.x * 512 + tix; i < (size_t)NTOK * 128; i += (size_t)G * 512) {
      const int tk = (int)(i >> 7), k = (int)(i & 127);
      const int b = tk / SEQ, sq = tk - b * SEQ;
      const size_t row = (size_t)b * LP + NMETA + sq;
      const int e = p.eb[row * 128 + k];
      const float4 us = ((const float4*)p.uinv)[e];
      float a = partial[((size_t)tk * 4 + 0) * 128 + k] * us.x + partial[((size_t)tk * 4 + 1) * 128 + k] * us.y + partial[((size_t)tk * 4 + 2) * 128 + k] * us.z + partial[((size_t)tk * 4 + 3) * 128 + k] * us.w;
      a *= row_rstd(p.rowss, row);
      p.wbuf[i] = p.gb[row * 128 + k] * 0.5f * a * (1.0f + erff(a * 0.70710678118654752f)) * p.vinv[e];
    }
    xcd_barrier(xbar);
    for (int qi = 0; qi < 4; ++qi) {
      const int s = (int)((x + qi) & 3u);
      for (;;) {
        unsigned st = 0;
        if (lane == 0) st = __hip_atomic_fetch_add(qh + (8 + s) * 16, 16u, __ATOMIC_RELAXED, __HIP_MEMORY_SCOPE_AGENT);
        st = __builtin_amdgcn_readfirstlane(st);
        if (st >= (unsigned)NTOK) break;
        ds_v_chunk(smem_c + (tix >> 6) * 16384, lane, (int)st, s, p.hb, p.eb, p.wbuf, p.vt8, p.h2  , p.ssq);
      }
    }
    xcd_barrier(xbar);
    {
      const int wv = blockIdx.x * 8 + (tix >> 6);
      for (int tk = wv * 2; tk < NTOK; tk += G * 16) {
        float4 o[2][4]; float sv[2];
#pragma unroll
        for (int r = 0; r < 2; ++r) {
#pragma unroll
          for (int q = 0; q < 4; ++q) o[r][q] = ((const float4*)p.h2)[(size_t)(tk + r) * 256 + q * 64 + lane];
          sv[r] = lane < 4 ? p.ssq[(size_t)(tk + r) * 4 + lane] : 0.f;
        }
#pragma unroll
        for (int r = 0; r < 2; ++r) {
          const float rstd = rsqrtf(wave_sum(sv[r]) * (1.0f / D) + EPS);
#pragma unroll
          for (int q = 0; q < 4; ++q) {
            const float4 f = ((const float4*)p.fg)[q * 64 + lane];
            float4 v = o[r][q];
            v.x *= rstd * f.x; v.y *= rstd * f.y; v.z *= rstd * f.z; v.w *= rstd * f.w;
            ((float4*)p.out)[(size_t)(tk + r) * 256 + q * 64 + lane] = v;
          }
        }
      }
    }
  }
}

extern "C" void kernel_launch(void* const* d_in, const int* in_sizes, int n_in, void* d_out, int out_size, void* d_ws, size_t ws_size, hipStream_t stream) {
  static int grid_blocks = 0;
  if (!grid_blocks) {
    int dev = 0, cus = 0, per_cu = 0;
    hipGetDevice(&dev);
    hipDeviceGetAttribute(&cus, hipDeviceAttributeMultiprocessorCount, dev);
    hipOccupancyMaxActiveBlocksPerMultiprocessor(&per_cu, mega, 512, 0);
    if (per_cu > 1) per_cu = 1;
    if (per_cu < 1) per_cu = 1;
    grid_blocks = cus * per_cu;
  }
  Params p{};
  const float** pp = (const float**)&p;
  for (int i = 0; i < 20; ++i) pp[i] = (const float*)d_in[i];
  p.out = (float*)d_out;
  char* ws = (char*)d_ws;
  size_t off = 0;
  p.scal = (float*)(ws + off); off += 32768;
  p.r1 = (bf16_t*)(ws + off); off += (size_t)ROWS * D * 2;
  p.r2 = (bf16_t*)(ws + off); off += (size_t)ROWS * INC * 2;
  p.h2 = (float*)(ws + off); off += (size_t)ROWS * D * 4;
  p.wt_in = (bf16_t*)(ws + off); off += (size_t)INC * D * 2;
  p.wt_out = (bf16_t*)(ws + off); off += (size_t)D * D * 2;
  p.wt_q = (bf16_t*)(ws + off); off += (size_t)2048 * D * 2;
  p.skb = (bf16_t*)(ws + off); off += (size_t)16 * 128 * 128 * 2;
  p.ut8 = (unsigned char*)(ws + off); off += (size_t)16384 * D;
  p.vt8 = (unsigned char*)(ws + off); off += (size_t)16384 * D;
  p.uinv = (float*)(ws + off); off += 262144;
  p.vinv = (float*)(ws + off); off += 65536;
  p.wbuf = (float*)(ws + off); off += (size_t)BATCH * SEQ * 128 * 4;
  p.ssq = (float*)(ws + off); off += (size_t)BATCH * SEQ * 8 * 4;
  p.hb = (bf16_t*)(ws + off); off += (size_t)ROWS * D * 2;
  p.rowss = (float*)(ws + off); off += (size_t)ROWS * 16 * 4;
  p.eb = (int*)((char*)p.r2 + (size_t)ROWS * 2048 * 2);
  p.gb = (float*)((char*)p.eb + (size_t)ROWS * 128 * 4);
  hipMemsetAsync(d_ws, 0, 32768, stream);
  void* args[] = {&p};
  hipError_t e = hipLaunchCooperativeKernel((void*)mega, dim3(grid_blocks), dim3(512), args, 0, stream);
  if (e != hipSuccess) fprintf(stderr, "cooperative launch failed: %s (grid %d)\n", hipGetErrorString(e), grid_blocks);
}
```

```cpp
#include <hip/hip_runtime.h>
#include <hip/hip_cooperative_groups.h>
#include <cstdio>
namespace cg = cooperative_groups;
#include <stdint.h>
#include <math.h>

typedef unsigned short bf16_t;
typedef short bf16x8 __attribute__((ext_vector_type(8)));
typedef float f32x4 __attribute__((ext_vector_type(4)));

constexpr int D = 1024, BATCH = 8, SEQ = 4096, NMETA = 16, LREAL = NMETA + SEQ  , LP = 4224, ROWS = BATCH * LP;
constexpr int INC = 2560;
constexpr float EPS = 1e-6f;
constexpr float LAM_INIT = 0.2f;

__device__ __forceinline__ float bf2f(unsigned v) { return __uint_as_float(v << 16); }
__device__ __forceinline__ bf16_t f2bf(float f) { unsigned u = __float_as_uint(f); u += 0x7fffu + ((u >> 16) & 1u); return (bf16_t)(u >> 16); }
__device__ __forceinline__ unsigned pack2(float a, float b) { return (unsigned)f2bf(a) | ((unsigned)f2bf(b) << 16); }

__device__ __forceinline__ float4 ld_nt4(const float4* p) { const f32x4 t = __builtin_nontemporal_load((const f32x4*)p); return make_float4(t[0], t[1], t[2], t[3]); }
__device__ __forceinline__ uint4 ld_nt_u4(const uint4* p) { typedef unsigned u4v __attribute__((ext_vector_type(4))); const u4v t = __builtin_nontemporal_load((const u4v*)p); return make_uint4(t[0], t[1], t[2], t[3]); }
template <int CTRL> __device__ __forceinline__ float dpp_get(float v) { return __builtin_bit_cast(float, __builtin_amdgcn_update_dpp(0, __builtin_bit_cast(int, v), CTRL, 0xf, 0xf, true)); }
__device__ __forceinline__ float wave_sum(float v) {
  v += dpp_get<0xB1>(v); v += dpp_get<0x4E>(v); v += dpp_get<0x141>(v); v += dpp_get<0x140>(v);
  { auto r = __builtin_amdgcn_permlane16_swap(__float_as_uint(v), __float_as_uint(v), false, false); v = __uint_as_float(r[0]) + __uint_as_float(r[1]); }
  { auto r = __builtin_amdgcn_permlane32_swap(__float_as_uint(v), __float_as_uint(v), false, false); v = __uint_as_float(r[0]) + __uint_as_float(r[1]); }
  return v;
}
__device__ __forceinline__ float wave_max(float v) {
  v = fmaxf(v, dpp_get<0xB1>(v)); v = fmaxf(v, dpp_get<0x4E>(v)); v = fmaxf(v, dpp_get<0x141>(v)); v = fmaxf(v, dpp_get<0x140>(v));
  { auto r = __builtin_amdgcn_permlane16_swap(__float_as_uint(v), __float_as_uint(v), false, false); v = fmaxf(__uint_as_float(r[0]), __uint_as_float(r[1])); }
  { auto r = __builtin_amdgcn_permlane32_swap(__float_as_uint(v), __float_as_uint(v), false, false); v = fmaxf(__uint_as_float(r[0]), __uint_as_float(r[1])); }
  return v;
}

template <int CTRL> __device__ __forceinline__ float dpp_add(float v) { return v + __builtin_bit_cast(float, __builtin_amdgcn_update_dpp(0, __builtin_bit_cast(int, v), CTRL, 0xf, 0xf, true)); }
__device__ __forceinline__ float sum8(float v) { v = dpp_add<0x141>(v); v = dpp_add<0xB1>(v); v = dpp_add<0x4E>(v); return v; }
typedef __bf16 bf16v2 __attribute__((ext_vector_type(2)));
__device__ __forceinline__ float dot8(uint4 a, uint4 b, float acc) {
  acc = __builtin_amdgcn_fdot2_f32_bf16(__builtin_bit_cast(bf16v2, a.x), __builtin_bit_cast(bf16v2, b.x), acc, false);
  acc = __builtin_amdgcn_fdot2_f32_bf16(__builtin_bit_cast(bf16v2, a.y), __builtin_bit_cast(bf16v2, b.y), acc, false);
  acc = __builtin_amdgcn_fdot2_f32_bf16(__builtin_bit_cast(bf16v2, a.z), __builtin_bit_cast(bf16v2, b.z), acc, false);
  acc = __builtin_amdgcn_fdot2_f32_bf16(__builtin_bit_cast(bf16v2, a.w), __builtin_bit_cast(bf16v2, b.w), acc, false);
  return acc;
}
__device__ __forceinline__ float row_rstd(const float* __restrict__ rowss, size_t row) {
  const float4 a = *(const float4*)(rowss + row * 16), b = *(const float4*)(rowss + row * 16 + 4), c = *(const float4*)(rowss + row * 16 + 8), d = *(const float4*)(rowss + row * 16 + 12);
  const float t = ((a.x + a.y) + (a.z + a.w)) + ((b.x + b.y) + (b.z + b.w)) + ((c.x + c.y) + (c.z + c.w)) + ((d.x + d.y) + (d.z + d.w));
  return rsqrtf(t * (1.0f / D) + EPS);
}
__device__ __forceinline__ float row16_sum(float v) {
  v += __builtin_bit_cast(float, __builtin_amdgcn_update_dpp(0, __builtin_bit_cast(int, v), 0x128, 0xf, 0xf, true));
  v += __builtin_bit_cast(float, __builtin_amdgcn_update_dpp(0, __builtin_bit_cast(int, v), 0x124, 0xf, 0xf, true));
  v += __builtin_bit_cast(float, __builtin_amdgcn_update_dpp(0, __builtin_bit_cast(int, v), 0x122, 0xf, 0xf, true));
  v += __builtin_bit_cast(float, __builtin_amdgcn_update_dpp(0, __builtin_bit_cast(int, v), 0x121, 0xf, 0xf, true));
  return v;
}
__device__ __forceinline__ int opaque_tid() { int t = threadIdx.x; asm volatile("" : "+v"(t)); return t; }

__device__ __forceinline__ const float* hrow_ptr(const float* x, const float* meta, int row) {
  int b = row / LP, pos = row - b * LP;
  if (pos < NMETA) return meta + (size_t)pos * D;
  if (pos < LREAL) return x + ((size_t)b * SEQ + (pos - NMETA)) * D;
  return nullptr;
}


typedef float f32x16 __attribute__((ext_vector_type(16)));
typedef short v4i16_t __attribute__((ext_vector_type(4)));
typedef __bf16 bf16v2_t __attribute__((ext_vector_type(2)));
typedef float f32x2_t __attribute__((ext_vector_type(2)));
#define LDSP(T, p) ((__attribute__((address_space(3))) T*)(p))
#define MFMA32(a, b, c) __builtin_amdgcn_mfma_f32_32x32x16_bf16((a), (b), (c), 0, 0, 0)
__device__ __forceinline__ unsigned cvtpk(float lo, float hi) { f32x2_t v = {lo, hi}; return __builtin_bit_cast(unsigned, __builtin_convertvector(v, bf16v2_t)); }
__device__ __forceinline__ float half_swap_max(float m) { auto rr = __builtin_amdgcn_permlane32_swap(__float_as_uint(m), __float_as_uint(m), false, false); return fmaxf(__uint_as_float(rr[0]), __uint_as_float(rr[1])); }
__device__ __forceinline__ float half_swap_sum(float m) { auto rr = __builtin_amdgcn_permlane32_swap(__float_as_uint(m), __float_as_uint(m), false, false); return __uint_as_float(rr[0]) + __uint_as_float(rr[1]); }

__device__ __forceinline__ void attn_issue_kv(char* kvbuf, const bf16_t* __restrict__ kvrow0  , int tid, int wid) {
  const char* base = (const char*)kvrow0;
#pragma unroll
  for (int i = 0; i < 2; ++i) {
    const int g = i * 512 + tid, row = g >> 4, pos = g & 15;
    const unsigned offk = (unsigned)(row * (INC * 2) + 1024 + ((pos ^ (row & 15)) << 4));
    const unsigned offv = (unsigned)(row * (INC * 2) + 2048 + ((pos ^ ((row & 3) << 2)) << 4));
    __builtin_amdgcn_global_load_lds((const unsigned*)(base + offk), LDSP(unsigned, kvbuf + (i * 512 + wid * 64) * 16), 16, 0, 0);
    __builtin_amdgcn_global_load_lds((const unsigned*)(base + offv), LDSP(unsigned, kvbuf + 16384 + (i * 512 + wid * 64) * 16), 16, 0, 0);
  }
}

typedef int v2i_t __attribute__((ext_vector_type(2)));
typedef int v4i_t __attribute__((ext_vector_type(4)));
#define DS_RD_B128(dst, addr, off) asm volatile("ds_read_b128 %0, %1 offset:%2" : "=v"(dst) : "v"(addr), "n"(off))
#define DS_RD_TR16(dst, addr, off) asm volatile("ds_read_b64_tr_b16 %0, %1 offset:%2" : "=v"(dst) : "v"(addr), "n"(off))
#define LGKM_WAIT2(n, x, y) asm volatile("s_waitcnt lgkmcnt(%2)" : "+v"(x), "+v"(y) : "n"(n))

template <bool MASKED, bool MAXONLY>
__device__ __forceinline__ void attn_qk(uint4 (&pw)[4], float& mref, float& lsum, const bf16x8 (&bq)[4], const unsigned (&koff)[4], unsigned kaddr, int kq, float sl8, const f32x16& biasp) {
  const float c1 = 0.125f * 1.4426950408889634f;
  v4i_t ka[4][2];
#pragma unroll
  for (int ks = 0; ks < 4; ++ks) {
    const unsigned a = kaddr + koff[ks];
    DS_RD_B128(ka[ks][0], a, 0);
    DS_RD_B128(ka[ks][1], a, 8192);
  }
  f32x16 s0, s1;
  float soff0, soff1;
  if (MASKED) {
    const float a1 = sl8, a2 = 2.0f * sl8, a3 = 3.0f * sl8, b8 = 8.0f * sl8;
    float gb = sl8 * (float)kq;
#pragma unroll
    for (int g = 0; g < 4; ++g) { s0[4 * g] = gb; s0[4 * g + 1] = gb + a1; s0[4 * g + 2] = gb + a2; s0[4 * g + 3] = gb + a3; gb += b8; }
#pragma unroll
    for (int g = 0; g < 4; ++g) { s1[4 * g] = gb; s1[4 * g + 1] = gb + a1; s1[4 * g + 2] = gb + a2; s1[4 * g + 3] = gb + a3; gb += b8; }
#pragma unroll
    for (int r = 0; r < 16; ++r) { s0[r] = s0[r] > 0.f ? -1e30f : s0[r]; s1[r] = s1[r] > 0.f ? -1e30f : s1[r]; }
    soff0 = 0.f; soff1 = 0.f;
  } else {
    soff0 = sl8 * (float)kq; soff1 = soff0 + 32.0f * sl8;
  }
  LGKM_WAIT2(6, ka[0][0], ka[0][1]);
  if (MASKED) { s0 = MFMA32(__builtin_bit_cast(bf16x8, ka[0][0]), bq[0], s0); s1 = MFMA32(__builtin_bit_cast(bf16x8, ka[0][1]), bq[0], s1); }
  else        { s0 = MFMA32(__builtin_bit_cast(bf16x8, ka[0][0]), bq[0], biasp); s1 = MFMA32(__builtin_bit_cast(bf16x8, ka[0][1]), bq[0], biasp); }
  __builtin_amdgcn_sched_barrier(0);
  LGKM_WAIT2(4, ka[1][0], ka[1][1]);
  s0 = MFMA32(__builtin_bit_cast(bf16x8, ka[1][0]), bq[1], s0); s1 = MFMA32(__builtin_bit_cast(bf16x8, ka[1][1]), bq[1], s1);
  __builtin_amdgcn_sched_barrier(0);
  LGKM_WAIT2(2, ka[2][0], ka[2][1]);
  s0 = MFMA32(__builtin_bit_cast(bf16x8, ka[2][0]), bq[2], s0); s1 = MFMA32(__builtin_bit_cast(bf16x8, ka[2][1]), bq[2], s1);
  __builtin_amdgcn_sched_barrier(0);
  LGKM_WAIT2(0, ka[3][0], ka[3][1]);
  s0 = MFMA32(__builtin_bit_cast(bf16x8, ka[3][0]), bq[3], s0); s1 = MFMA32(__builtin_bit_cast(bf16x8, ka[3][1]), bq[3], s1);
  if (MAXONLY) {
    float m0 = fmaxf(s0[0], s0[1]), m1 = fmaxf(s1[0], s1[1]);
#pragma unroll
    for (int r = 2; r < 16; r += 2) { m0 = fmaxf(fmaxf(m0, s0[r]), s0[r + 1]); m1 = fmaxf(fmaxf(m1, s1[r]), s1[r + 1]); }
    mref = fmaxf(mref, half_swap_max(fmaxf(m0 + soff0, m1 + soff1)));
    return;
  }
  const float nm0 = (soff0 - mref) * c1, nm1 = (soff1 - mref) * c1;
  float l0 = 0.f, l1 = 0.f;
#pragma unroll
  for (int r = 0; r < 16; ++r) {
    s0[r] = __builtin_amdgcn_exp2f(__builtin_fmaf(s0[r], c1, nm0));
    s1[r] = __builtin_amdgcn_exp2f(__builtin_fmaf(s1[r], c1, nm1));
    l0 += s0[r]; asm("" : "+v"(l0));
    l1 += s1[r]; asm("" : "+v"(l1));
  }
  lsum += l0 + l1;
#pragma unroll
  for (int kk = 0; kk < 2; ++kk) {
    pw[kk] = make_uint4(cvtpk(s0[8 * kk], s0[8 * kk + 1]), cvtpk(s0[8 * kk + 2], s0[8 * kk + 3]), cvtpk(s0[8 * kk + 4], s0[8 * kk + 5]), cvtpk(s0[8 * kk + 6], s0[8 * kk + 7]));
    pw[2 + kk] = make_uint4(cvtpk(s1[8 * kk], s1[8 * kk + 1]), cvtpk(s1[8 * kk + 2], s1[8 * kk + 3]), cvtpk(s1[8 * kk + 4], s1[8 * kk + 5]), cvtpk(s1[8 * kk + 6], s1[8 * kk + 7]));
  }
}

__device__ __forceinline__ void attn_pv(f32x16 (&o)[4], const uint4 (&pw)[4], unsigned vaddr, const unsigned (&voff)[4]) {
  unsigned a[4];
#pragma unroll
  for (int d = 0; d < 4; ++d) a[d] = vaddr + voff[d];
  v2i_t f[4][2];
#define PV_ISSUE(i) { DS_RD_TR16(f[(i) & 3][0], a[(i) & 3], ((i) >> 2) * 4096); DS_RD_TR16(f[(i) & 3][1], a[(i) & 3], ((i) >> 2) * 4096 + 2048); }
#define PV_STEP(i, n) { if ((i) + 3 < 16) PV_ISSUE((i) + 3); LGKM_WAIT2(n, f[(i) & 3][0], f[(i) & 3][1]); \
    const v4i_t va = {f[(i) & 3][0][0], f[(i) & 3][0][1], f[(i) & 3][1][0], f[(i) & 3][1][1]}; \
    o[(i) & 3] = MFMA32(__builtin_bit_cast(bf16x8, va), __builtin_bit_cast(bf16x8, pw[(i) >> 2]), o[(i) & 3]); }
  PV_ISSUE(0); PV_ISSUE(1); PV_ISSUE(2);
  PV_STEP(0, 6); PV_STEP(1, 6); PV_STEP(2, 6); PV_STEP(3, 6); PV_STEP(4, 6); PV_STEP(5, 6); PV_STEP(6, 6); PV_STEP(7, 6);
  PV_STEP(8, 6); PV_STEP(9, 6); PV_STEP(10, 6); PV_STEP(11, 6); PV_STEP(12, 6); PV_STEP(13, 4); PV_STEP(14, 2); PV_STEP(15, 0);
#undef PV_ISSUE
#undef PV_STEP
}

__device__ __forceinline__ void attn_unit(char* lds, const bf16_t* __restrict__ proj, bf16_t* mix, const float* __restrict__ subg, const unsigned* __restrict__ kmax, float lam, int b, int h, int t) {
  const int tix = opaque_tid();
  const int tid = tix, lane = tid & 63, r32 = lane & 31, hi = lane >> 5;
  const int wid = __builtin_amdgcn_readfirstlane(tid >> 6);
  const int c = wid >> 2, qg = wid & 3;
  const int q0 = NMETA + 128 * t, qw0 = q0 + 32 * qg, qpos = qw0 + r32;
  const size_t rowb = (size_t)b * LP;
  const int NT = 2 * t + 3;
  const int dist = h == 0 ? 588 : h == 1 ? 2352 : (1 << 24);
  const int js0 = q0 - dist > 0 ? (q0 - dist) >> 6 : 0;
  char* Qs = lds;
  char* KV = lds + 32768;
  const float sl8 = exp2f(1.0f - 2.0f * (float)h);
  __syncthreads();
  attn_issue_kv(KV, proj + (rowb + 64 * js0) * INC + h * 128, tid, wid);
  uint4 wkd[4];
#pragma unroll
  for (int ks = 0; ks < 4; ++ks) wkd[ks] = *(const uint4*)(proj + (rowb + qpos) * INC + 512 + h * 128 + (c * 8 + ks * 2 + hi) * 8);
  asm volatile("" ::: "memory");
#pragma unroll
  for (int i = 0; i < 4; ++i) {
    const int g = i * 512 + tid, row = g >> 4, pos = g & 15;
    uint4 v = *(const uint4*)(proj + (rowb + q0 + row) * INC + h * 128 + ((pos ^ (row & 15)) << 3));
    *(uint4*)(Qs + g * 16) = v;
  }
  f32x16 o[4];
#pragma unroll
  for (int i = 0; i < 4; ++i)
#pragma unroll
    for (int r = 0; r < 16; ++r) o[i][r] = 0.f;
  float lsum = 0.f;
  f32x16 biasp;
#pragma unroll
  for (int r = 0; r < 16; ++r) biasp[r] = sl8 * (float)((r & 3) + 8 * (r >> 2));
  const int qrow = 32 * qg + r32;
  const char* qbase = Qs + qrow * 256;
  const int qsw = qrow & 15;
  float mref; bool loose;
  int* lflag = (int*)(lds + 131072);
  {
    float kn2 = 0.f;
    if (lane < 16) {
      const uint4* kp = (const uint4*)(proj + (rowb + lane) * INC + 512 + h * 128 + c * 64);
#pragma unroll
      for (int i = 0; i < 8; ++i) { const uint4 w = kp[i]; kn2 = dot8(w, w, kn2); }
    }
    kn2 = fmaxf(wave_max(kn2), __uint_as_float(kmax[b * 8 + h * 2 + c]));
    if (tid == 0) *lflag = 0;
    __syncthreads();
    float qn2 = 0.f;
#pragma unroll
    for (int ks = 0; ks < 4; ++ks) { const uint4 w = *(const uint4*)(qbase + (((c * 8 + ks * 2 + hi) ^ qsw) << 4)); qn2 = dot8(w, w, qn2); }
    qn2 = half_swap_sum(qn2);
    const float bound = sqrtf(qn2 * kn2) * 1.02f;
    mref = bound - 60.0f / (0.125f * 1.4426950408889634f);
    float sd = 0.f;
#pragma unroll
    for (int ks = 0; ks < 4; ++ks) {
      const uint4 wq = *(const uint4*)(qbase + (((c * 8 + ks * 2 + hi) ^ qsw) << 4));
      sd = dot8(wq, wkd[ks], sd);
    }
    sd = half_swap_sum(sd);
    loose = (bound - sd) * (0.125f * 1.4426950408889634f) > 170.0f;
  }
  bf16x8 bq[4];
  unsigned koff[4], voff[4];
  const unsigned lds0 = (unsigned)(size_t)LDSP(char, lds);
  {
    const int q4 = (lane & 15) >> 2, g1 = (lane >> 4) & 1, p4 = lane & 3;
#pragma unroll
    for (int ks = 0; ks < 4; ++ks) {
      const int ch = (c * 8 + ks * 2 + hi) ^ qsw;
      bq[ks] = *(const bf16x8*)(qbase + (ch << 4));
      koff[ks] = (unsigned)(r32 * 256 + (ch << 4));
      voff[ks] = (unsigned)(16384 + (4 * hi + q4) * 256 + (8 * (ks ^ q4) + 4 * g1 + p4) * 8);
    }
  }
  uint4 pw[4];
  if (__any(loose) && lane == 0) *lflag = 1;
  __syncthreads();
  int js = js0;
  if (*lflag) {
    js = 0;
    if (js0 > 0) {
      asm volatile("s_waitcnt vmcnt(0)" ::: "memory");
      __syncthreads();
      attn_issue_kv(KV, proj + rowb * INC + h * 128, tid, wid);
    }
    float mx = -1e30f; int sl = 0;
    for (int j = 0; j < NT; ++j) {
      asm volatile("s_waitcnt vmcnt(0)" ::: "memory");
      __syncthreads();
      if (j + 1 < NT) attn_issue_kv(KV + (sl == 2 ? 0 : sl + 1) * 32768, proj + (rowb + 64 * (j + 1)) * INC + h * 128, tid, wid);
      if (64 * j <= qw0 + 31) {
        const int kq = 64 * j + 4 * hi - qpos;
        if (64 * j + 63 > qw0) attn_qk<true, true>(pw, mx, lsum, bq, koff, lds0 + 32768 + sl * 32768, kq, sl8, biasp);
        else attn_qk<false, true>(pw, mx, lsum, bq, koff, lds0 + 32768 + sl * 32768, kq, sl8, biasp);
      }
      sl = (sl == 2 ? 0 : sl + 1);
    }
    mref = mx;
    __syncthreads();
    attn_issue_kv(KV, proj + rowb * INC + h * 128, tid, wid);
  }
  bool have = false;
  int slot = 0, pslot = 0;
  for (int j = js; j <= NT; ++j) {
    if (j < NT) {
      asm volatile("s_waitcnt vmcnt(0)" ::: "memory");
      __syncthreads();
      if (j + 1 < NT) attn_issue_kv(KV + (slot == 2 ? 0 : slot + 1) * 32768, proj + (rowb + 64 * (j + 1)) * INC + h * 128, tid, wid);
    }
    if (have) { attn_pv(o, pw, lds0 + 32768 + pslot * 32768, voff); have = false; }
    if (j < NT && 64 * j <= qw0 + 31) {
      const unsigned kb = lds0 + 32768 + slot * 32768;
      const int kq = 64 * j + 4 * hi - qpos;
      if (64 * j + 63 > qw0) attn_qk<true, false>(pw, mref, lsum, bq, koff, kb, kq, sl8, biasp);
      else attn_qk<false, false>(pw, mref, lsum, bq, koff, kb, kq, sl8, biasp);
      if (c == 0) attn_pv(o, pw, kb, voff); else have = true;
    }
    pslot = slot; slot = (slot == 2 ? 0 : slot + 1);
  }
  const float sc = (c == 0 ? 1.0f : lam) / half_swap_sum(lsum);
  __syncthreads();
  float* X = (float*)(lds + 32768);
  if (c == 1) {
#pragma unroll
    for (int i = 0; i < 4; ++i)
#pragma unroll
      for (int r = 0; r < 16; ++r) X[(qg * 64 + i * 16 + r) * 64 + lane] = o[i][r] * sc;
  }
  __syncthreads();
  if (c == 0) {
    float ss = 0.f;
#pragma unroll
    for (int i = 0; i < 4; ++i) {
#pragma unroll
      for (int r = 0; r < 16; ++r) { float v = o[i][r] * sc - X[(qg * 64 + i * 16 + r) * 64 + lane]; o[i][r] = v; ss += v * v; }
      __builtin_amdgcn_sched_barrier(0);
    }
    ss = half_swap_sum(ss);
    const float rstd = rsqrtf(ss * (1.0f / 128.0f) + EPS) * (1.0f - LAM_INIT);
    bf16_t* orow = mix + (rowb + qpos) * D + h * 128;
#pragma unroll
    for (int i = 0; i < 4; ++i) {
#pragma unroll
      for (int g = 0; g < 4; ++g) {
        const int dv0 = 32 * i + 8 * g + 4 * hi;
        const float4 sg = *(const float4*)(subg + dv0);
        uint2 w; w.x = cvtpk(o[i][4 * g] * rstd * sg.x, o[i][4 * g + 1] * rstd * sg.y); w.y = cvtpk(o[i][4 * g + 2] * rstd * sg.z, o[i][4 * g + 3] * rstd * sg.w);
        *(uint2*)(orow + dv0) = w;
      }
      __builtin_amdgcn_sched_barrier(0);
    }
  }
}


__device__ __forceinline__ void p_norm1_rows(int G, const float* __restrict__ x, const float* __restrict__ meta, const float* __restrict__ g1, bf16_t* xn1) {
  const int tix = opaque_tid();
  const int lane = tix & 63, wv = blockIdx.x * 8 + (tix >> 6);
  float4 g[4];
#pragma unroll
  for (int q = 0; q < 4; ++q) g[q] = ((const float4*)g1)[q * 64 + lane];
  for (int row = wv * 2; row < ROWS; row += G * 16) {
    float4 v[2][4];
#pragma unroll
    for (int r = 0; r < 2; ++r) {
      const float* src = hrow_ptr(x, meta, row + r);
#pragma unroll
      for (int q = 0; q < 4; ++q) v[r][q] = src ? ld_nt4((const float4*)src + q * 64 + lane) : make_float4(0.f, 0.f, 0.f, 0.f);
    }
#pragma unroll
    for (int r = 0; r < 2; ++r) {
      float ss = 0.f;
#pragma unroll
      for (int q = 0; q < 4; ++q) ss += (v[r][q].x * v[r][q].x + v[r][q].y * v[r][q].y) + (v[r][q].z * v[r][q].z + v[r][q].w * v[r][q].w);
      const float rstd = rsqrtf(wave_sum(ss) * (1.0f / D) + EPS);
#pragma unroll
      for (int q = 0; q < 4; ++q) {
        uint2 o; o.x = cvtpk(v[r][q].x * rstd * g[q].x, v[r][q].y * rstd * g[q].y); o.y = cvtpk(v[r][q].z * rstd * g[q].z, v[r][q].w * rstd * g[q].w);
        ((uint2*)(xn1 + (size_t)(row + r) * D))[q * 64 + lane] = o;
      }
    }
  }
}

__device__ __forceinline__ void conv_unit(char* lds, const bf16_t* __restrict__ proj, bf16_t* mix, const float* __restrict__ cw, const float* __restrict__ cb,
                                          const float* __restrict__ gng, const float* __restrict__ gnb, int b, int pos0) {
  const int tix = opaque_tid();
  const int c = tix;
  float* U = (float*)lds;
  __syncthreads();
  f32x2_t wp[32];
  {
    float wprev = 0.f;
#pragma unroll
    for (int j = 0; j < 32; ++j) { const float wj = j < 31 ? cw[j * 512 + c] : 0.f; wp[j] = (f32x2_t){wj, wprev}; wprev = wj; }
  }
  const float bias = cb[c], gg = gng[c], gb2 = gnb[c];
  {
    const int lane = tix & 63, wv = tix >> 6;
    uint4 ra[8], rg[8];
#pragma unroll
    for (int i = 0; i < 8; ++i) {
      const int r = wv + 8 * i, pos = pos0 - 30 + r;
      ra[i] = make_uint4(0, 0, 0, 0); rg[i] = make_uint4(0, 0, 0, 0);
      if (r < 62 && pos >= 0) {
        const bf16_t* pr = proj + ((size_t)b * LP + pos) * INC + 8 * lane;
        ra[i] = *(const uint4*)(pr + 1536); rg[i] = *(const uint4*)(pr + 2048);
      }
    }
#pragma unroll
    for (int i = 0; i < 8; ++i) {
      const int r = wv + 8 * i;
      if (r < 62) {
        const unsigned av[4] = {ra[i].x, ra[i].y, ra[i].z, ra[i].w}, gv[4] = {rg[i].x, rg[i].y, rg[i].z, rg[i].w};
        float u[8];
#pragma unroll
        for (int q = 0; q < 4; ++q) {
          const float a0 = __uint_as_float(av[q] << 16), a1 = __uint_as_float(av[q] & 0xffff0000u), g0 = __uint_as_float(gv[q] << 16), g1 = __uint_as_float(gv[q] & 0xffff0000u);
          u[2 * q] = a0 * __builtin_amdgcn_rcpf(1.0f + __expf(-g0)); u[2 * q + 1] = a1 * __builtin_amdgcn_rcpf(1.0f + __expf(-g1));
        }
        *(float4*)(U + r * 512 + 8 * lane) = make_float4(u[0], u[1], u[2], u[3]);
        *(float4*)(U + r * 512 + 8 * lane + 4) = make_float4(u[4], u[5], u[6], u[7]);
      }
    }
  }
  __syncthreads();
  float yall[32];
#pragma unroll
  for (int t0 = 0; t0 < 32; t0 += 8) {
    f32x2_t y2[4];
#pragma unroll
    for (int q2 = 0; q2 < 4; ++q2) y2[q2] = (f32x2_t){bias, bias};
#pragma unroll
    for (int r = 0; r < 38; ++r) {
      const float u = U[(t0 + r) * 512 + c];
      const f32x2_t uu = {u, u};
#pragma unroll
      for (int q2 = 0; q2 < 4; ++q2) { const int j = r - 2 * q2; if (j >= 0 && j < 32) y2[q2] = __builtin_elementwise_fma(wp[j], uu, y2[q2]); }
    }
#pragma unroll
    for (int q2 = 0; q2 < 4; ++q2) { yall[t0 + 2 * q2] = y2[q2].x; yall[t0 + 2 * q2 + 1] = y2[q2].y; }
    __builtin_amdgcn_sched_barrier(0);
  }
  float red;
  {
    const int ln = tix & 63;
    float n32[32], n16[16], n8[8], n4[4], n2[2];
#pragma unroll
    for (int i = 0; i < 32; ++i) {
      auto rr = __builtin_amdgcn_permlane32_swap(__float_as_uint(yall[i]), __float_as_uint(yall[i] * yall[i]), false, false);
      n32[i] = __uint_as_float(rr[0]) + __uint_as_float(rr[1]);
    }
#pragma unroll
    for (int i = 0; i < 16; ++i) {
      auto rr = __builtin_amdgcn_permlane16_swap(__float_as_uint(n32[i]), __float_as_uint(n32[i + 16]), false, false);
      n16[i] = __uint_as_float(rr[0]) + __uint_as_float(rr[1]);
    }
    const bool b3 = (ln & 8) != 0, b2 = (ln & 4) != 0, b1 = (ln & 2) != 0, b0 = (ln & 1) != 0;
#pragma unroll
    for (int i = 0; i < 8; ++i) {
      const float send = b3 ? n16[i] : n16[i + 8], keep = b3 ? n16[i + 8] : n16[i];
      n8[i] = keep + __builtin_bit_cast(float, __builtin_amdgcn_update_dpp(0, __builtin_bit_cast(int, send), 0x128, 0xf, 0xf, true));
    }
#pragma unroll
    for (int i = 0; i < 4; ++i) {
      const float send = b2 ? n8[i] : n8[i + 4], keep = b2 ? n8[i + 4] : n8[i];
      n4[i] = keep + __builtin_bit_cast(float, __builtin_amdgcn_update_dpp(0, __builtin_bit_cast(int, send), 0x141, 0xf, 0xf, true));
    }
#pragma unroll
    for (int i = 0; i < 2; ++i) {
      const float send = b1 ? n4[i] : n4[i + 2], keep = b1 ? n4[i + 2] : n4[i];
      n2[i] = keep + __builtin_bit_cast(float, __builtin_amdgcn_update_dpp(0, __builtin_bit_cast(int, send), 0x4E, 0xf, 0xf, true));
    }
    {
      const float send = b0 ? n2[0] : n2[1], keep = b0 ? n2[1] : n2[0];
      red = keep + __builtin_bit_cast(float, __builtin_amdgcn_update_dpp(0, __builtin_bit_cast(int, send), 0xB1, 0xf, 0xf, true));
    }
  }
  float mean_l, rstd_l;
  {
    auto rr = __builtin_amdgcn_permlane32_swap(__float_as_uint(red), __float_as_uint(red), false, false);
    const float sy = __uint_as_float(rr[0]), sq = __uint_as_float(rr[1]);
    mean_l = sy * (1.0f / 64.0f);
    rstd_l = rsqrtf(fmaxf(sq * (1.0f / 64.0f) - mean_l * mean_l, 0.f) + EPS);
  }
  bf16_t* mixp = mix + ((size_t)b * LP + pos0) * D + 512 + c;
#pragma unroll
  for (int t = 0; t < 32; ++t) {
    const float mt = __builtin_bit_cast(float, __builtin_amdgcn_readlane(__builtin_bit_cast(int, mean_l), t));
    const float rt = __builtin_bit_cast(float, __builtin_amdgcn_readlane(__builtin_bit_cast(int, rstd_l), t));
    const float n = (yall[t] - mt) * rt * gg + gb2;
    mixp[(size_t)t * D] = f2bf(n * __builtin_amdgcn_rcpf(1.0f + __expf(-n)));
    if ((t & 3) == 3) __builtin_amdgcn_sched_barrier(0);
  }
}


__device__ __forceinline__ void ce_desc(float& a, float& b) { const float hi = fmaxf(a, b), lo = fminf(a, b); a = hi; b = lo; }
__device__ __forceinline__ void ce_asc(float& a, float& b) { const float hi = fmaxf(a, b), lo = fminf(a, b); a = lo; b = hi; }
template <int N> __device__ __forceinline__ void bitonic_sort_desc(float (&v)[N]) {
#pragma unroll
  for (int k = 2; k <= N; k <<= 1)
#pragma unroll
    for (int j = k >> 1; j > 0; j >>= 1)
#pragma unroll
      for (int i = 0; i < N; ++i) { const int l = i ^ j; if (l > i) { if ((i & k) == 0) ce_desc(v[i], v[l]); else ce_asc(v[i], v[l]); } }
}
template <int N> __device__ __forceinline__ void bitonic_merge_desc(float (&v)[N]) {
#pragma unroll
  for (int j = N >> 1; j > 0; j >>= 1)
#pragma unroll
    for (int i = 0; i < N; ++i) { const int l = i ^ j; if (l > i) ce_desc(v[i], v[l]); }
}
__host__ __device__ constexpr int cand_slot(int i, int j) { int s = 0; for (int ii = 0; ii < i; ++ii) s += 16 / (ii + 1); return s + j; }

template <int O, int N> __device__ __forceinline__ void oddeven_sort16_desc(float (&v)[N]) {
  ce_desc(v[O + 0], v[O + 1]);
  ce_desc(v[O + 2], v[O + 3]);
  ce_desc(v[O + 4], v[O + 5]);
  ce_desc(v[O + 6], v[O + 7]);
  ce_desc(v[O + 8], v[O + 9]);
  ce_desc(v[O + 10], v[O + 11]);
  ce_desc(v[O + 12], v[O + 13]);
  ce_desc(v[O + 14], v[O + 15]);
  ce_desc(v[O + 0], v[O + 2]);
  ce_desc(v[O + 1], v[O + 3]);
  ce_desc(v[O + 4], v[O + 6]);
  ce_desc(v[O + 5], v[O + 7]);
  ce_desc(v[O + 8], v[O + 10]);
  ce_desc(v[O + 9], v[O + 11]);
  ce_desc(v[O + 12], v[O + 14]);
  ce_desc(v[O + 13], v[O + 15]);
  ce_desc(v[O + 1], v[O + 2]);
  ce_desc(v[O + 5], v[O + 6]);
  ce_desc(v[O + 9], v[O + 10]);
  ce_desc(v[O + 13], v[O + 14]);
  ce_desc(v[O + 0], v[O + 4]);
  ce_desc(v[O + 1], v[O + 5]);
  ce_desc(v[O + 2], v[O + 6]);
  ce_desc(v[O + 3], v[O + 7]);
  ce_desc(v[O + 8], v[O + 12]);
  ce_desc(v[O + 9], v[O + 13]);
  ce_desc(v[O + 10], v[O + 14]);
  ce_desc(v[O + 11], v[O + 15]);
  ce_desc(v[O + 2], v[O + 4]);
  ce_desc(v[O + 3], v[O + 5]);
  ce_desc(v[O + 10], v[O + 12]);
  ce_desc(v[O + 11], v[O + 13]);
  ce_desc(v[O + 1], v[O + 2]);
  ce_desc(v[O + 3], v[O + 4]);
  ce_desc(v[O + 5], v[O + 6]);
  ce_desc(v[O + 9], v[O + 10]);
  ce_desc(v[O + 11], v[O + 12]);
  ce_desc(v[O + 13], v[O + 14]);
  ce_desc(v[O + 0], v[O + 8]);
  ce_desc(v[O + 1], v[O + 9]);
  ce_desc(v[O + 2], v[O + 10]);
  ce_desc(v[O + 3], v[O + 11]);
  ce_desc(v[O + 4], v[O + 12]);
  ce_desc(v[O + 5], v[O + 13]);
  ce_desc(v[O + 6], v[O + 14]);
  ce_desc(v[O + 7], v[O + 15]);
  ce_desc(v[O + 4], v[O + 8]);
  ce_desc(v[O + 5], v[O + 9]);
  ce_desc(v[O + 6], v[O + 10]);
  ce_desc(v[O + 7], v[O + 11]);
  ce_desc(v[O + 2], v[O + 4]);
  ce_desc(v[O + 3], v[O + 5]);
  ce_desc(v[O + 6], v[O + 8]);
  ce_desc(v[O + 7], v[O + 9]);
  ce_desc(v[O + 10], v[O + 12]);
  ce_desc(v[O + 11], v[O + 13]);
  ce_desc(v[O + 1], v[O + 2]);
  ce_desc(v[O + 3], v[O + 4]);
  ce_desc(v[O + 5], v[O + 6]);
  ce_desc(v[O + 7], v[O + 8]);
  ce_desc(v[O + 9], v[O + 10]);
  ce_desc(v[O + 11], v[O + 12]);
  ce_desc(v[O + 13], v[O + 14]);
}
__device__ __forceinline__ void peer_stage_subkeys(char* lds, const bf16_t* __restrict__ skb, int h, int tid) {
  __syncthreads();
#pragma unroll
  for (int i = 0; i < 8; ++i) {
    const int g = i * 512 + tid, row = g >> 4, pos = g & 15;
    *(uint4*)(lds + g * 16) = *(const uint4*)(skb + ((size_t)(h * 2) * 128 + row) * 128 + ((pos ^ (row & 15)) << 3));
  }
  if (tid < 64) {
    int i = 0, base = 0;
    while (i < 15 && tid >= base + 16 / (i + 1)) { base += 16 / (i + 1); ++i; }
    ((int*)(lds + 65536))[tid] = (i << 4) | ((tid - base) & 15);
  }
  __syncthreads();
}
__device__ __forceinline__ void peer_load_qh(bf16x8 (&xh)[8], const bf16_t* qp, int row0, int h, int p, int wid, int r32, int hi) {
  const bf16_t* xrow = qp + (size_t)(row0 + wid * 32 + r32) * 2048 + h * 256 + p * 128 + hi * 8;
#pragma unroll
  for (int ks = 0; ks < 8; ++ks) asm volatile("global_load_dwordx4 %0, %1, off" : "=v"(xh[ks]) : "v"(xrow + ks * 16));
}
#define XQ_WAIT(x) asm volatile("s_waitcnt vmcnt(0)" : "+v"(x[0]), "+v"(x[1]), "+v"(x[2]), "+v"(x[3]), "+v"(x[4]), "+v"(x[5]), "+v"(x[6]), "+v"(x[7]))
__device__ __forceinline__ float sel2f(float a, float b, int hi) { asm("" : "+v"(a), "+v"(b)); return hi ? b : a; }
template <int P>
__device__ __forceinline__ void peer_half_scores(const char* lds, const bf16x8 (&xq)[8], int r32, int hi, f32x16 (&acc)[4]) {
#pragma unroll
  for (int kb = 0; kb < 4; ++kb)
#pragma unroll
    for (int r = 0; r < 16; ++r) acc[kb][r] = 0.f;
#pragma unroll
  for (int ks = 0; ks < 8; ++ks) {
    const int ch = 2 * ks + hi;
#pragma unroll
    for (int kb = 0; kb < 4; ++kb) {
      const int r = P * 128 + kb * 32 + r32;
      const bf16x8 wa = *(const bf16x8*)(lds + r * 256 + ((ch ^ (r & 15)) << 4));
      acc[kb] = MFMA32(wa, xq[ks], acc[kb]);
    }
  }
}
__device__ __forceinline__ void peer_lane_top16(const f32x16 (&acc)[4], int hi, float (&t)[16]) {
  float v[64];
#pragma unroll
  for (int kb = 0; kb < 4; ++kb)
#pragma unroll
    for (int r = 0; r < 16; ++r) v[kb * 16 + r] = __uint_as_float((__float_as_uint(acc[kb][r]) & ~127u) | (unsigned)(kb * 32 + (r & 3) + 8 * (r >> 2) + 4 * hi));
  oddeven_sort16_desc<0>(v); oddeven_sort16_desc<16>(v); oddeven_sort16_desc<32>(v); oddeven_sort16_desc<48>(v);
  float ta[16];
#pragma unroll
  for (int i = 0; i < 16; ++i) { ta[i] = fmaxf(v[i], v[31 - i]); t[i] = fmaxf(v[32 + i], v[63 - i]); }
  bitonic_merge_desc<16>(ta); bitonic_merge_desc<16>(t);
#pragma unroll
  for (int i = 0; i < 16; ++i) t[i] = fmaxf(t[i], ta[15 - i]);
  bitonic_merge_desc<16>(t);
}
__device__ __forceinline__ void peer_half_top16(const f32x16 (&acc)[4], int hi, float (&tout)[16]) {
  float t[16];
  peer_lane_top16(acc, hi, t);
  {
    float pb[16];
#pragma unroll
    for (int i = 0; i < 16; ++i) {
      auto rr = __builtin_amdgcn_permlane32_swap(__float_as_uint(t[15 - i]), __float_as_uint(t[15 - i]), false, false);
      pb[i] = __uint_as_float(hi ? rr[0] : rr[1]);
    }
#pragma unroll
    for (int i = 0; i < 16; ++i) t[i] = fmaxf(t[i], pb[i]);
    bitonic_merge_desc<16>(t);
  }
#pragma unroll
  for (int i = 0; i < 16; ++i) tout[i] = t[i];
}
template <int P>
__device__ __forceinline__ void peer_half_scores_top16(const char* lds, const bf16x8 (&xq)[8], int r32, int hi, float (&tout)[16]) {
  f32x16 acc[4];
  peer_half_scores<P>(lds, xq, r32, hi, acc);
  peer_half_top16(acc, hi, tout);
}
__device__ __forceinline__ void peer_topk_unit32(char* lds, const bf16_t* __restrict__ qp, const bf16_t* __restrict__ skb, const float* __restrict__ rowss, int* eb, float* gb, int row0, int h, bool stage,
                                                 bf16x8 (&xq0)[8]  , int next_row0, int next_h) {
  const int tix = opaque_tid();
  const int tid = tix, lane = tid & 63, wid = tid >> 6, r32 = lane & 31, hi = lane >> 5;
  if (stage) peer_stage_subkeys(lds, skb, h, tid);
  const int tok = row0 + wid * 32 + r32;
  bf16x8 xq1[8];
  peer_load_qh(xq1, qp, row0, h, 1, wid, r32, hi);
  float top0[16], top1[16];
  asm volatile("s_waitcnt vmcnt(8)" : "+v"(xq0[0]), "+v"(xq0[1]), "+v"(xq0[2]), "+v"(xq0[3]), "+v"(xq0[4]), "+v"(xq0[5]), "+v"(xq0[6]), "+v"(xq0[7]));
  peer_half_scores_top16<0>(lds, xq0, r32, hi, top0);
  XQ_WAIT(xq1);
  {
    f32x16 acc[4];
    peer_half_scores<1>(lds, xq1, r32, hi, acc);
    if (next_row0 >= 0) { peer_load_qh(xq0, qp, next_row0, next_h, 0, wid, r32, hi); __builtin_amdgcn_sched_barrier(0); }
    peer_half_top16(acc, hi, top1);
  }
  int* ST = (int*)(lds + 65536);
  int* IDX = (int*)(lds + 65536 + 256) + (wid * 32 + r32) * 32;
#define SEL2(arr, q) sel2f(arr[q], arr[8 + (q)], hi)
  {
    int4 ia0, ia1, ib0, ib1;
    ia0.x = __float_as_uint(SEL2(top0, 0)) & 127; ia0.y = __float_as_uint(SEL2(top0, 1)) & 127; ia0.z = __float_as_uint(SEL2(top0, 2)) & 127; ia0.w = __float_as_uint(SEL2(top0, 3)) & 127;
    ia1.x = __float_as_uint(SEL2(top0, 4)) & 127; ia1.y = __float_as_uint(SEL2(top0, 5)) & 127; ia1.z = __float_as_uint(SEL2(top0, 6)) & 127; ia1.w = __float_as_uint(SEL2(top0, 7)) & 127;
    ib0.x = __float_as_uint(SEL2(top1, 0)) & 127; ib0.y = __float_as_uint(SEL2(top1, 1)) & 127; ib0.z = __float_as_uint(SEL2(top1, 2)) & 127; ib0.w = __float_as_uint(SEL2(top1, 3)) & 127;
    ib1.x = __float_as_uint(SEL2(top1, 4)) & 127; ib1.y = __float_as_uint(SEL2(top1, 5)) & 127; ib1.z = __float_as_uint(SEL2(top1, 6)) & 127; ib1.w = __float_as_uint(SEL2(top1, 7)) & 127;
    *(int4*)(IDX + 8 * hi) = ia0; *(int4*)(IDX + 8 * hi + 4) = ia1; *(int4*)(IDX + 16 + 8 * hi) = ib0; *(int4*)(IDX + 16 + 8 * hi + 4) = ib1;
  }
  float cv[16];
  {
    const float NEGV = -3.0e38f;
    float am[16], bm[16];
#pragma unroll
    for (int i = 0; i < 16; ++i) { am[i] = __uint_as_float(__float_as_uint(top0[i]) & ~127u); bm[i] = __uint_as_float(__float_as_uint(top1[i]) & ~127u); }
#define CAND(i, j) __uint_as_float((__float_as_uint(am[i] + bm[j]) & ~63u) | (unsigned)cand_slot(i, j))
    float A[16], B[16], C[16], Dd[8], E[8], F[16];
#pragma unroll
    for (int j = 0; j < 16; ++j) A[j] = CAND(0, j);
#pragma unroll
    for (int j = 0; j < 8; ++j) { B[j] = CAND(1, j); B[15 - j] = CAND(8 + j, 0); }
    bitonic_merge_desc<16>(B);
#pragma unroll
    for (int j = 0; j < 5; ++j) C[j] = CAND(2, j);
#pragma unroll
    for (int j = 5; j < 12; ++j) C[j] = NEGV;
#pragma unroll
    for (int j = 0; j < 4; ++j) C[15 - j] = CAND(3, j);
    bitonic_merge_desc<16>(C);
    Dd[0] = CAND(4, 0); Dd[1] = CAND(4, 1); Dd[2] = CAND(4, 2); Dd[3] = NEGV; Dd[4] = NEGV; Dd[5] = NEGV; Dd[6] = CAND(5, 1); Dd[7] = CAND(5, 0);
    bitonic_merge_desc<8>(Dd);
    E[0] = CAND(6, 0); E[1] = CAND(6, 1); E[2] = NEGV; E[3] = NEGV; E[4] = NEGV; E[5] = NEGV; E[6] = CAND(7, 1); E[7] = CAND(7, 0);
    bitonic_merge_desc<8>(E);
#pragma unroll
    for (int j = 0; j < 8; ++j) { F[j] = Dd[j]; F[15 - j] = E[j]; }
    bitonic_merge_desc<16>(F);
#undef CAND
#pragma unroll
    for (int j = 0; j < 16; ++j) { A[j] = fmaxf(A[j], B[15 - j]); C[j] = fmaxf(C[j], F[15 - j]); }
    bitonic_merge_desc<16>(A);
    bitonic_merge_desc<16>(C);
#pragma unroll
    for (int j = 0; j < 16; ++j) cv[j] = fmaxf(A[j], C[15 - j]);
    bitonic_merge_desc<16>(cv);
  }
  float ex[16]; float sum = 0.f;
  const float c0v = __uint_as_float(__float_as_uint(cv[0]) & ~63u);
  const float rs = row_rstd(rowss, (size_t)tok);
#pragma unroll
  for (int i = 0; i < 16; ++i) { ex[i] = __expf((__uint_as_float(__float_as_uint(cv[i]) & ~63u) - c0v) * rs); sum += ex[i]; }
  const float inv = 1.0f / sum;
  int e8[8]; float g8[8];
#pragma unroll
  for (int q = 0; q < 8; ++q) {
    const int slot = __float_as_uint(SEL2(cv, q)) & 63;
    const int ij = ST[slot];
    e8[q] = (IDX[ij >> 4] * 128 + IDX[16 + (ij & 15)]) << 7;
    g8[q] = SEL2(ex, q) * inv;
  }
#undef SEL2
  int* ep = eb + ((size_t)tok * 8 + h) * 16 + 8 * hi; float* gp = gb + ((size_t)tok * 8 + h) * 16 + 8 * hi;
  *(int4*)ep = make_int4(e8[0], e8[1], e8[2], e8[3]); *(int4*)(ep + 4) = make_int4(e8[4], e8[5], e8[6], e8[7]);
  *(float4*)gp = make_float4(g8[0], g8[1], g8[2], g8[3]); *(float4*)(gp + 4) = make_float4(g8[4], g8[5], g8[6], g8[7]);
}

__device__ __forceinline__ void peer_load_qg(bf16x8 (&xh)[8], const bf16_t* qp, int row0, int h, int p, int g, int wid, int r32, int hi) {
  const bf16_t* xrow = qp + (size_t)(row0 + wid * 64 + g * 32 + r32) * 2048 + h * 256 + p * 128 + hi * 8;
#pragma unroll
  for (int ks = 0; ks < 8; ++ks) asm volatile("global_load_dwordx4 %0, %1, off nt" : "=v"(xh[ks]) : "v"(xrow + ks * 16));
}
#define XQ_WAIT8(x) asm volatile("s_waitcnt vmcnt(8)" : "+v"(x[0]), "+v"(x[1]), "+v"(x[2]), "+v"(x[3]), "+v"(x[4]), "+v"(x[5]), "+v"(x[6]), "+v"(x[7]))
__device__ __forceinline__ void peer_swap_merge(const float (&ta)[16], const float (&tb)[16], float (&t)[16]) {
  float o0[16], o1[16];
#pragma unroll
  for (int i = 0; i < 16; ++i) {
    auto rr = __builtin_amdgcn_permlane32_swap(__float_as_uint(ta[i]), __float_as_uint(tb[i]), false, false);
    o0[i] = __uint_as_float(rr[0]); o1[i] = __uint_as_float(rr[1]);
  }
#pragma unroll
  for (int i = 0; i < 16; ++i) t[i] = fmaxf(o0[i], o1[15 - i]);
  bitonic_merge_desc<16>(t);
}
__device__ __forceinline__ void peer_topk_unit64(char* lds, const bf16_t* __restrict__ qp, const bf16_t* __restrict__ skb, const float* __restrict__ rowss, int* eb, float* gb, float* rs_out  , int row0, int h, bool stage) {
  const int tix = opaque_tid();
  const int tid = tix, lane = tid & 63, wid = tid >> 6, r32 = lane & 31, hi = lane >> 5;
  if (stage) peer_stage_subkeys(lds, skb, h, tid);
  const int tok = row0 + wid * 64 + lane;
  bf16x8 xa[8], xb[8];
  float top0[16], top1[16];
  {
    float ta[16], tb[16];
    f32x16 acc[4];
    peer_load_qg(xa, qp, row0, h, 0, 0, wid, r32, hi);
    peer_load_qg(xb, qp, row0, h, 0, 1, wid, r32, hi);
    XQ_WAIT8(xa);
    peer_half_scores<0>(lds, xa, r32, hi, acc);
    peer_lane_top16(acc, hi, ta);
    peer_load_qg(xa, qp, row0, h, 1, 0, wid, r32, hi); __builtin_amdgcn_sched_barrier(0);
    XQ_WAIT8(xb);
    peer_half_scores<0>(lds, xb, r32, hi, acc);
    peer_lane_top16(acc, hi, tb);
    peer_load_qg(xb, qp, row0, h, 1, 1, wid, r32, hi); __builtin_amdgcn_sched_barrier(0);
    peer_swap_merge(ta, tb, top0);
    XQ_WAIT8(xa);
    peer_half_scores<1>(lds, xa, r32, hi, acc);
    peer_lane_top16(acc, hi, ta);
    XQ_WAIT(xb);
    peer_half_scores<1>(lds, xb, r32, hi, acc);
    peer_lane_top16(acc, hi, tb);
    peer_swap_merge(ta, tb, top1);
  }
  int* ST = (int*)(lds + 65536);
  unsigned char* IDX = (unsigned char*)(lds + 65536 + 256) + (wid * 64 + lane) * 32;
  {
    unsigned wa[4], wb[4];
#pragma unroll
    for (int q = 0; q < 4; ++q) {
      wa[q] = (__float_as_uint(top0[4 * q]) & 127u) | ((__float_as_uint(top0[4 * q + 1]) & 127u) << 8) | ((__float_as_uint(top0[4 * q + 2]) & 127u) << 16) | ((__float_as_uint(top0[4 * q + 3]) & 127u) << 24);
      wb[q] = (__float_as_uint(top1[4 * q]) & 127u) | ((__float_as_uint(top1[4 * q + 1]) & 127u) << 8) | ((__float_as_uint(top1[4 * q + 2]) & 127u) << 16) | ((__float_as_uint(top1[4 * q + 3]) & 127u) << 24);
    }
    *(uint4*)IDX = make_uint4(wa[0], wa[1], wa[2], wa[3]); *(uint4*)(IDX + 16) = make_uint4(wb[0], wb[1], wb[2], wb[3]);
  }
  float cv[16];
  {
    const float NEGV = -3.0e38f;
    float am[16], bm[16];
#pragma unroll
    for (int i = 0; i < 16; ++i) { am[i] = __uint_as_float(__float_as_uint(top0[i]) & ~127u); bm[i] = __uint_as_float(__float_as_uint(top1[i]) & ~127u); }
#define CAND(i, j) __uint_as_float((__float_as_uint(am[i] + bm[j]) & ~63u) | (unsigned)cand_slot(i, j))
    float A[16], B[16], C[16], Dd[8], E[8], F[16];
#pragma unroll
    for (int j = 0; j < 16; ++j) A[j] = CAND(0, j);
#pragma unroll
    for (int j = 0; j < 8; ++j) { B[j] = CAND(1, j); B[15 - j] = CAND(8 + j, 0); }
    bitonic_merge_desc<16>(B);
#pragma unroll
    for (int j = 0; j < 5; ++j) C[j] = CAND(2, j);
#pragma unroll
    for (int j = 5; j < 12; ++j) C[j] = NEGV;
#pragma unroll
    for (int j = 0; j < 4; ++j) C[15 - j] = CAND(3, j);
    bitonic_merge_desc<16>(C);
    Dd[0] = CAND(4, 0); Dd[1] = CAND(4, 1); Dd[2] = CAND(4, 2); Dd[3] = NEGV; Dd[4] = NEGV; Dd[5] = NEGV; Dd[6] = CAND(5, 1); Dd[7] = CAND(5, 0);
    bitonic_merge_desc<8>(Dd);
    E[0] = CAND(6, 0); E[1] = CAND(6, 1); E[2] = NEGV; E[3] = NEGV; E[4] = NEGV; E[5] = NEGV; E[6] = CAND(7, 1); E[7] = CAND(7, 0);
    bitonic_merge_desc<8>(E);
#pragma unroll
    for (int j = 0; j < 8; ++j) { F[j] = Dd[j]; F[15 - j] = E[j]; }
    bitonic_merge_desc<16>(F);
#undef CAND
#pragma unroll
    for (int j = 0; j < 16; ++j) { A[j] = fmaxf(A[j], B[15 - j]); C[j] = fmaxf(C[j], F[15 - j]); }
    bitonic_merge_desc<16>(A);
    bitonic_merge_desc<16>(C);
#pragma unroll
    for (int j = 0; j < 16; ++j) cv[j] = fmaxf(A[j], C[15 - j]);
    bitonic_merge_desc<16>(cv);
  }
  const float c0v = __uint_as_float(__float_as_uint(cv[0]) & ~63u);
  const float rs = row_rstd(rowss, (size_t)tok);
  if (h == 0) rs_out[tok] = rs;
  float ex[16]; float sum = 0.f;
#pragma unroll
  for (int i = 0; i < 16; ++i) { ex[i] = __expf((__uint_as_float(__float_as_uint(cv[i]) & ~63u) - c0v) * rs); sum += ex[i]; }
  const float inv = 1.0f / sum;
  unsigned short* ep = (unsigned short*)eb + ((size_t)tok * 8 + h) * 16; bf16_t* gp = (bf16_t*)gb + ((size_t)tok * 8 + h) * 16;
  unsigned e2[8], g2[8];
#pragma unroll
  for (int q4 = 0; q4 < 4; ++q4) {
    int e4[4];
#pragma unroll
    for (int q = 0; q < 4; ++q) {
      const int ij = ST[__float_as_uint(cv[4 * q4 + q]) & 63];
      e4[q] = (int)IDX[ij >> 4] * 128 + (int)IDX[16 + (ij & 15)];
    }
    e2[2 * q4] = (unsigned)e4[0] | ((unsigned)e4[1] << 16); e2[2 * q4 + 1] = (unsigned)e4[2] | ((unsigned)e4[3] << 16);
    g2[2 * q4] = cvtpk(ex[4 * q4] * inv, ex[4 * q4 + 1] * inv); g2[2 * q4 + 1] = cvtpk(ex[4 * q4 + 2] * inv, ex[4 * q4 + 3] * inv);
  }
  *(uint4*)ep = make_uint4(e2[0], e2[1], e2[2], e2[3]); *(uint4*)(ep + 8) = make_uint4(e2[4], e2[5], e2[6], e2[7]);
  *(uint4*)gp = make_uint4(g2[0], g2[1], g2[2], g2[3]); *(uint4*)(gp + 8) = make_uint4(g2[4], g2[5], g2[6], g2[7]);
}

__device__ __forceinline__ void p_cvt_bf16(int blk, int nblk, const float* __restrict__ src, bf16_t* dst, size_t n8) {
  const int tix = opaque_tid();
  for (size_t i = (size_t)blk * 512 + tix; i < n8; i += (size_t)nblk * 512) {
    const float4 a = ((const float4*)src)[2 * i], b = ((const float4*)src)[2 * i + 1];
    uint4 w; w.x = cvtpk(a.x, a.y); w.y = cvtpk(a.z, a.w); w.z = cvtpk(b.x, b.y); w.w = cvtpk(b.z, b.w);
    ((uint4*)dst)[i] = w;
  }
}


__device__ __forceinline__ unsigned pack_i8x4(float a, float b, float c, float d) {
  const int ia = (int)rintf(a), ib = (int)rintf(b), ic = (int)rintf(c), id = (int)rintf(d);
  return (unsigned)(ia & 255) | ((unsigned)(ib & 255) << 8) | ((unsigned)(ic & 255) << 16) | ((unsigned)id << 24);
}
template <int OFFS  > __device__ __forceinline__ void p_cvt_i4_rows(int blk, int nblk, const float* __restrict__ src, unsigned* dst, float* inv, const float* __restrict__ csc) {
  const int tix = opaque_tid();
  const int lane = tix & 63, wid = tix >> 6;
  for (int r0 = blk * 8 + wid; r0 < 16384; r0 += nblk * 16) {
    float4 v[2][4];
#pragma unroll
    for (int h = 0; h < 2; ++h) {
      const int r = r0 + h * nblk * 8;
      if (r < 16384) {
        const float4* sp = (const float4*)(src + (size_t)r * D);
#pragma unroll
        for (int k = 0; k < 4; ++k) v[h][k] = ld_nt4(sp + k * 64 + lane);
      }
    }
#pragma unroll
    for (int h = 0; h < 2; ++h) {
      const int r = r0 + h * nblk * 8;
      if (r >= 16384) break;
      if (csc) {
#pragma unroll
        for (int k = 0; k < 4; ++k) { const float4 g = ((const float4*)csc)[k * 64 + lane]; v[h][k].x *= g.x; v[h][k].y *= g.y; v[h][k].z *= g.z; v[h][k].w *= g.w; }
      }
#pragma unroll
      for (int k = 0; k < 4; ++k) {
        const float am = wave_max(fmaxf(fmaxf(fabsf(v[h][k].x), fabsf(v[h][k].y)), fmaxf(fabsf(v[h][k].z), fabsf(v[h][k].w))));
        const float sc = am > 0.f ? 7.0f / am : 1.0f;
        const int of = (lane & 1) ? 0 : OFFS;
        const unsigned w = (unsigned)(((int)rintf(v[h][k].x * sc) + of) & 15) | ((unsigned)(((int)rintf(v[h][k].y * sc) + of) & 15) << 8) | ((unsigned)(((int)rintf(v[h][k].z * sc) + of) & 15) << 16) | ((unsigned)(((int)rintf(v[h][k].w * sc) + of) & 15) << 24);
        const unsigned wp = (unsigned)__builtin_amdgcn_update_dpp(0, (int)w, 0xB1, 0xf, 0xf, true);
        if ((lane & 1) == 0) dst[((size_t)k * 16384 + r) * 32 + (lane >> 1)] = w | (wp << 4);
        if (lane == 0) ((bf16_t*)inv)[r * 8 + k] = f2bf(am > 0.f ? am * (1.0f / 7.0f) : 1.0f);
      }
    }
  }
}


__device__ __forceinline__ unsigned xcc_id() { return (unsigned)__builtin_amdgcn_s_getreg((3 << 11) | 20) & 7u; }

typedef __attribute__((address_space(1))) const unsigned char gbyte_t;
typedef unsigned u32x4_t __attribute__((ext_vector_type(4)));
typedef __attribute__((address_space(1))) const u32x4_t gu32x4_t;
__device__ __forceinline__ gbyte_t* uniform_ptr(const unsigned char* p) {
  const unsigned long long v = (unsigned long long)p;
  const unsigned lo = __builtin_amdgcn_readfirstlane((unsigned)v), hi = __builtin_amdgcn_readfirstlane((unsigned)(v >> 32));
  return (gbyte_t*)(((unsigned long long)hi << 32) | lo);
}
__device__ __forceinline__ void ds_issue(uint4 (&u)[16], const int* El  , gbyte_t* tab  , unsigned loff  ) {
  int ev[16];
#pragma unroll
  for (int q = 0; q < 4; ++q) { const int4 t = *(const int4*)(El + 4 * q); ev[4 * q] = t.x; ev[4 * q + 1] = t.y; ev[4 * q + 2] = t.z; ev[4 * q + 3] = t.w; }
#pragma unroll
  for (int it = 0; it < 16; ++it) { const u32x4_t t = *(gu32x4_t*)(tab + (size_t)((unsigned)ev[it] | loff)); u[it] = make_uint4(t[0], t[1], t[2], t[3]); }
}
__device__ __forceinline__ void ds_u_compute(const uint4 (&u)[16], const unsigned* XHl, const unsigned* XLl  , float xs  ,
                                             bf16_t* __restrict__ pout, int j) {
  const uint4 xh = *(const uint4*)XHl, xl = *(const uint4*)XLl;
  float d[16];
#pragma unroll
  for (int it = 0; it < 16; ++it) {
    int ah, al;
    asm("v_dot8_i32_i4 %0, %1, %2, 0" : "=v"(ah) : "v"(u[it].x), "v"(xh.x));
    asm("v_dot8_i32_i4 %0, %1, %2, 0" : "=v"(al) : "v"(u[it].x), "v"(xl.x));
    ah = __builtin_amdgcn_sdot8((int)u[it].y, (int)xh.y, ah, false); al = __builtin_amdgcn_sdot8((int)u[it].y, (int)xl.y, al, false);
    ah = __builtin_amdgcn_sdot8((int)u[it].z, (int)xh.z, ah, false); al = __builtin_amdgcn_sdot8((int)u[it].z, (int)xl.z, al, false);
    ah = __builtin_amdgcn_sdot8((int)u[it].w, (int)xh.w, ah, false); al = __builtin_amdgcn_sdot8((int)u[it].w, (int)xl.w, al, false);
    d[it] = (float)(ah * 16 + al) * xs;
  }
  const bool b2 = (j & 4) != 0, b1 = (j & 2) != 0, b0 = (j & 1) != 0;
  float t8[8], t4[4], t2[2];
#pragma unroll
  for (int i = 0; i < 8; ++i) {
    const float send = b2 ? d[i] : d[i + 8], keep = b2 ? d[i + 8] : d[i];
    t8[i] = keep + __builtin_bit_cast(float, __builtin_amdgcn_update_dpp(0, __builtin_bit_cast(int, send), 0x141, 0xf, 0xf, true));
  }
#pragma unroll
  for (int i = 0; i < 4; ++i) {
    const float send = b1 ? t8[i] : t8[i + 4], keep = b1 ? t8[i + 4] : t8[i];
    t4[i] = keep + __builtin_bit_cast(float, __builtin_amdgcn_update_dpp(0, __builtin_bit_cast(int, send), 0x4E, 0xf, 0xf, true));
  }
#pragma unroll
  for (int i = 0; i < 2; ++i) {
    const float send = b0 ? t4[i] : t4[i + 2], keep = b0 ? t4[i + 2] : t4[i];
    t2[i] = keep + __builtin_bit_cast(float, __builtin_amdgcn_update_dpp(0, __builtin_bit_cast(int, send), 0xB1, 0xf, 0xf, true));
  }
  *(unsigned*)pout = cvtpk(t2[0], t2[1]);
}
__device__ __forceinline__ unsigned bytes_add8(unsigned x) { return ((x & 0x7F7F7F7Fu) + 0x08080808u) ^ (x & 0x80808080u); }
__device__ __forceinline__ void ds_u_chunk(char* wl  , int lane, int tk0, int s  , const unsigned char* __restrict__ xi8, const float* __restrict__ xsc,
                                           const int* __restrict__ eb, const unsigned char* __restrict__ ut4, float* __restrict__ partial) {
  const int b = tk0 / SEQ, sq = tk0 - b * SEQ;
  const size_t row0 = (size_t)b * LP + NMETA + sq;
  const int j = lane & 7, gi = lane >> 3;
  int* El = (int*)wl;
  unsigned* XH = (unsigned*)(wl + 8192);
  unsigned* XL = (unsigned*)(wl + 8192 + 2048);
  float* Sl = (float*)(wl + 8192 + 4096);
#pragma unroll
  for (int i = 0; i < 4; ++i) {
    const uint4 w = *(const uint4*)((const unsigned short*)eb + row0 * 128 + (i * 64 + lane) * 8);
    *(int4*)(El + (i * 64 + lane) * 8) = make_int4((int)((w.x & 0xffffu) << 7), (int)((w.x >> 16) << 7), (int)((w.y & 0xffffu) << 7), (int)((w.y >> 16) << 7));
    *(int4*)(El + (i * 64 + lane) * 8 + 4) = make_int4((int)((w.z & 0xffffu) << 7), (int)((w.z >> 16) << 7), (int)((w.w & 0xffffu) << 7), (int)((w.w >> 16) << 7));
  }
  {
    const int t = lane >> 2, part = lane & 3;
    const uint4* xp = (const uint4*)(xi8 + (row0 + t) * D + 256 * s + 64 * part);
    uint4 w4[4];
#pragma unroll
    for (int i = 0; i < 4; ++i) w4[i] = xp[i];
    unsigned hi[8], lo[8];
#pragma unroll
    for (int i = 0; i < 4; ++i) {
      const unsigned tA0 = bytes_add8(w4[i].x), tB0 = bytes_add8(w4[i].y), tA1 = bytes_add8(w4[i].z), tB1 = bytes_add8(w4[i].w);
      lo[2 * i] = ((tA0 & 0x0F0F0F0Fu) | ((tB0 & 0x0F0F0F0Fu) << 4)) ^ 0x88888888u; hi[2 * i] = ((tA0 >> 4) & 0x0F0F0F0Fu) | (tB0 & 0xF0F0F0F0u);
      lo[2 * i + 1] = ((tA1 & 0x0F0F0F0Fu) | ((tB1 & 0x0F0F0F0Fu) << 4)) ^ 0x88888888u; hi[2 * i + 1] = ((tA1 >> 4) & 0x0F0F0F0Fu) | (tB1 & 0xF0F0F0F0u);
    }
    uint4* dh = (uint4*)(XH + t * 32 + 8 * part); uint4* dl = (uint4*)(XL + t * 32 + 8 * part);
    dh[0] = make_uint4(hi[0], hi[1], hi[2], hi[3]); dh[1] = make_uint4(hi[4], hi[5], hi[6], hi[7]);
    dl[0] = make_uint4(lo[0], lo[1], lo[2], lo[3]); dl[1] = make_uint4(lo[4], lo[5], lo[6], lo[7]);
    Sl[lane] = xsc[(row0 + t) * 16 + 4 * s + part];
  }
  gbyte_t* tab = uniform_ptr(ut4 + (size_t)s * (16384 * 128));
  const unsigned loff = 16u * (unsigned)j;
  bf16_t* pout = (bf16_t*)partial + ((size_t)tk0 * 4 + s) * 128 + gi * 16 + 2 * j;
  uint4 ua[16], ub[16];
  ds_issue(ua, El + gi * 16, tab, loff);
#pragma unroll 1
  for (int t = 0; t < 16; t += 2) {
    ds_issue(ub, El + (t + 1) * 128 + gi * 16, tab, loff);
    ds_u_compute(ua, XH + t * 32 + 4 * j, XL + t * 32 + 4 * j, Sl[4 * t + (j >> 1)], pout + (size_t)t * 512, j);
    if (t + 2 < 16) ds_issue(ua, El + (t + 2) * 128 + gi * 16, tab, loff);
    ds_u_compute(ub, XH + (t + 1) * 32 + 4 * j, XL + (t + 1) * 32 + 4 * j, Sl[4 * (t + 1) + (j >> 1)], pout + (size_t)(t + 1) * 512, j);
  }
}

typedef int i32x4 __attribute__((ext_vector_type(4)));
__device__ __forceinline__ void ds_v_compute(const uint4 (&v)[16], const unsigned* Wl  , const int* Cl  , const float* Sl  ,
                                             const unsigned (&sel)[4], int lane, int j, int gi, size_t row, int tk, int s, const bf16_t* __restrict__ hb, float* __restrict__ out, float* __restrict__ ssq) {
  const int c0 = 256 * s + 32 * j + 4 * gi;
  const uint2 hwq = *(const uint2*)(hb + row * D + c0);
  const uint4 w4 = *(const uint4*)Wl;
  const int cg = *Cl;
  const float sc = *Sl;
  const unsigned wd[4] = {w4.x, w4.y, w4.z, w4.w};
  i32x4 accq[8];
  const i32x4 cinit = {cg, cg, cg, cg};
#pragma unroll
  for (int it = 0; it < 16; ++it) {
    const unsigned wv[4] = {v[it].x, v[it].y, v[it].z, v[it].w};
    const int A = (int)__builtin_amdgcn_perm(0u, wd[it >> 2], sel[it & 3]);
#pragma unroll
    for (int q = 0; q < 4; ++q) {
      const int blo = (int)(wv[q] & 0x0F0F0F0Fu);
      accq[2 * q] = __builtin_amdgcn_mfma_i32_4x4x4i8(A, blo, it == 0 ? cinit : accq[2 * q], 0, 0, 0);
      accq[2 * q + 1] = __builtin_amdgcn_mfma_i32_4x4x4i8(A, (int)wv[q], it == 0 ? cinit : accq[2 * q + 1], 0, 0, 0);
    }
  }
  typedef _Float16 h2_t __attribute__((ext_vector_type(2)));
  h2_t p8[8], p4[4], p2[2];
  int x[16];
#pragma unroll
  for (int c = 0; c < 16; ++c) { auto rr = __builtin_amdgcn_permlane32_swap((unsigned)accq[c >> 2][c & 3], (unsigned)accq[4 + (c >> 2)][c & 3], false, false); x[c] = (int)rr[0] + (int)rr[1]; }
#pragma unroll
  for (int c = 0; c < 16; ++c) if ((c >> 2) & 1) x[c] = (x[c] - x[c - 4]) >> 4;
#pragma unroll
  for (int r = 0; r < 8; ++r) p8[r] = __builtin_bit_cast(h2_t, __builtin_amdgcn_cvt_pkrtz((float)x[2 * r], (float)x[2 * r + 1]));
#pragma unroll
  for (int i = 0; i < 4; ++i) {
    auto rr = __builtin_amdgcn_permlane16_swap(__builtin_bit_cast(unsigned, p8[i]), __builtin_bit_cast(unsigned, p8[i + 4]), false, false);
    p4[i] = __builtin_bit_cast(h2_t, (unsigned)rr[0]) + __builtin_bit_cast(h2_t, (unsigned)rr[1]);
  }
  const bool b3 = (lane & 8) != 0;
#pragma unroll
  for (int i = 0; i < 2; ++i) {
    const unsigned send = b3 ? __builtin_bit_cast(unsigned, p4[i]) : __builtin_bit_cast(unsigned, p4[i + 2]), keep = b3 ? __builtin_bit_cast(unsigned, p4[i + 2]) : __builtin_bit_cast(unsigned, p4[i]);
    p2[i] = __builtin_bit_cast(h2_t, keep) + __builtin_bit_cast(h2_t, (unsigned)__builtin_amdgcn_update_dpp(0, (int)send, 0x128, 0xf, 0xf, true));
  }
  const float t4[4] = {(float)p2[0].x, (float)p2[0].y, (float)p2[1].x, (float)p2[1].y};
  const float o0 = fmaf(t4[0], sc, __uint_as_float(hwq.x << 16)), o1 = fmaf(t4[1], sc, __uint_as_float(hwq.x & 0xffff0000u)), o2 = fmaf(t4[2], sc, __uint_as_float(hwq.y << 16)), o3 = fmaf(t4[3], sc, __uint_as_float(hwq.y & 0xffff0000u));
  *(uint2*)((bf16_t*)out + (size_t)tk * D + c0) = make_uint2(cvtpk(o0, o1), cvtpk(o2, o3));
}
__device__ __forceinline__ void ds_v_chunk(char* wl, int lane, int tk0, int s  , const bf16_t* __restrict__ hb, const int* __restrict__ eb, const unsigned char* __restrict__ wq  ,
                                           const int* __restrict__ aux  , const float* __restrict__ wsc  , const unsigned char* __restrict__ vt4, float* __restrict__ out, float* __restrict__ ssq) {
  const int b = tk0 / SEQ, sq = tk0 - b * SEQ;
  const size_t row0 = (size_t)b * LP + NMETA + sq;
  const int j = lane & 7, gi = lane >> 3;
  int* El = (int*)wl;
  unsigned* Wl = (unsigned*)(wl + 8192);
  int* Cl = (int*)(wl + 10240);
  float* Sl = (float*)(wl + 10752);
#pragma unroll
  for (int i = 0; i < 4; ++i) {
    const uint4 w = *(const uint4*)((const unsigned short*)eb + row0 * 128 + (i * 64 + lane) * 8);
    *(int4*)(El + (i * 64 + lane) * 8) = make_int4((int)((w.x & 0xffffu) << 7), (int)((w.x >> 16) << 7), (int)((w.y & 0xffffu) << 7), (int)((w.y >> 16) << 7));
    *(int4*)(El + (i * 64 + lane) * 8 + 4) = make_int4((int)((w.z & 0xffffu) << 7), (int)((w.z >> 16) << 7), (int)((w.w & 0xffffu) << 7), (int)((w.w >> 16) << 7));
  }
#pragma unroll
  for (int i = 0; i < 2; ++i) { const int idx = i * 64 + lane; *(uint4*)(Wl + idx * 4) = *(const uint4*)(wq + ((size_t)(tk0 + (idx >> 3)) * 4 + s) * 128 + (idx & 7) * 16); }
  *(int2*)(Cl + lane * 2) = *(const int2*)(aux + ((size_t)(tk0 + (lane >> 2)) * 4 + s) * 8 + (lane & 3) * 2);
  if (lane < 16) Sl[lane] = wsc[tk0 + lane];
  unsigned sel[4];
#pragma unroll
  for (int m = 0; m < 4; ++m) sel[m] = (0x0c0c0c0cu & ~(0xFFu << (8 * (lane & 3)))) | ((unsigned)m << (8 * (lane & 3)));
  gbyte_t* tab = uniform_ptr(vt4 + (size_t)s * (16384 * 128));
  const unsigned loff = 16u * (unsigned)j;
  uint4 va[16], vb[16];
  ds_issue(va, El + gi * 16, tab, loff);
#pragma unroll 1
  for (int t = 0; t < 16; t += 2) {
    ds_issue(vb, El + (t + 1) * 128 + gi * 16, tab, loff);
    ds_v_compute(va, Wl + t * 32 + gi * 4, Cl + t * 8 + gi, Sl + t, sel, lane, j, gi, row0 + t, tk0 + t, s, hb, out, ssq);
    if (t + 2 < 16) ds_issue(va, El + (t + 2) * 128 + gi * 16, tab, loff);
    ds_v_compute(vb, Wl + (t + 1) * 32 + gi * 4, Cl + (t + 1) * 8 + gi, Sl + t + 1, sel, lane, j, gi, row0 + t + 1, tk0 + t + 1, s, hb, out, ssq);
  }
}


constexpr int WREG = 20224, WBUF = 10112;
__device__ __forceinline__ void ds_issue16(uint4 (&u)[16], const unsigned short* El  , gbyte_t* tab  , unsigned loff  ) {
  const uint4 a = *(const uint4*)El, b = *(const uint4*)(El + 8);
  const unsigned w[8] = {a.x, a.y, a.z, a.w, b.x, b.y, b.z, b.w};
#pragma unroll
  for (int i = 0; i < 8; ++i) {
    const unsigned e0 = ((w[i] << 7) & 0x007FFF80u) | loff, e1 = ((w[i] >> 9) & 0x007FFF80u) | loff;
    const u32x4_t t0 = *(gu32x4_t*)(tab + (size_t)e0); u[2 * i] = make_uint4(t0[0], t0[1], t0[2], t0[3]);
    const u32x4_t t1 = *(gu32x4_t*)(tab + (size_t)e1); u[2 * i + 1] = make_uint4(t1[0], t1[1], t1[2], t1[3]);
  }
}
__device__ __forceinline__ int ds_pop(unsigned* qh4  , unsigned x, int& qi, int lane, int& s_out) {
  while (qi < 4) {
    const int s = (int)((x + (unsigned)qi) & 3u);
    unsigned st = 0;
    if (lane == 0) st = __hip_atomic_fetch_add(qh4 + s * 16, 16u, __ATOMIC_RELAXED, __HIP_MEMORY_SCOPE_AGENT);
    st = __builtin_amdgcn_readfirstlane(st);
    if (st < (unsigned)(BATCH * SEQ)) { s_out = s; return (int)st; }
    ++qi;
  }
  return -1;
}
__device__ __forceinline__ size_t ds_row0(int tk0) { const int b = tk0 / SEQ; return (size_t)b * LP + NMETA + (tk0 - b * SEQ); }

__device__ __forceinline__ void ds_v_stage(char* buf, int lane, int tk0, int s, const int* __restrict__ eb, const unsigned char* __restrict__ wq, const int* __restrict__ aux, const float* __restrict__ wsc) {
  const size_t row0 = ds_row0(tk0);
  uint4 idw[4], ww[2];
#pragma unroll
  for (int i = 0; i < 4; ++i) idw[i] = *(const uint4*)((const unsigned short*)eb + row0 * 128 + (i * 64 + lane) * 8);
#pragma unroll
  for (int i = 0; i < 2; ++i) { const int idx = i * 64 + lane; ww[i] = *(const uint4*)(wq + ((size_t)(tk0 + (idx >> 3)) * 4 + s) * 128 + (idx & 7) * 16); }
  const int2 cc = *(const int2*)(aux + ((size_t)(tk0 + (lane >> 2)) * 4 + s) * 8 + (lane & 3) * 2);
  const float ws = wsc[tk0 + (lane & 15)];
#pragma unroll
  for (int i = 0; i < 4; ++i) *(uint4*)(buf + (i * 64 + lane) * 16) = idw[i];
#pragma unroll
  for (int i = 0; i < 2; ++i) *(uint4*)(buf + 4096 + (i * 64 + lane) * 16) = ww[i];
  *(int2*)(buf + 6144 + lane * 8) = cc;
  if (lane < 16) *(float*)(buf + 6656 + lane * 4) = ws;
}
__device__ __forceinline__ void ds_v_pass(char* wl  , int lane, unsigned* qh4, unsigned x, const bf16_t* __restrict__ hb, const int* __restrict__ eb, const unsigned char* __restrict__ wq,
                                          const int* __restrict__ aux, const float* __restrict__ wsc, const unsigned char* __restrict__ vt4, float* __restrict__ out) {
  const int j = lane & 7, gi = lane >> 3;
  const unsigned loff = 16u * (unsigned)j;
  unsigned sel[4];
#pragma unroll
  for (int m = 0; m < 4; ++m) sel[m] = (0x0c0c0c0cu & ~(0xFFu << (8 * (lane & 3)))) | ((unsigned)m << (8 * (lane & 3)));
  int qi = 0, s_cur = 0;
  int tk_cur = ds_pop(qh4, x, qi, lane, s_cur);
  if (tk_cur < 0) return;
  int bsel = 0;
  ds_v_stage(wl, lane, tk_cur, s_cur, eb, wq, aux, wsc);
  gbyte_t* tab = uniform_ptr(vt4 + (size_t)s_cur * (16384 * 128));
  uint4 va[16], vb[16];
  ds_issue16(va, (const unsigned short*)wl + gi * 16, tab, loff);
  for (;;) {
    char* buf = wl + bsel * WBUF; char* bufn = wl + (bsel ^ 1) * WBUF;
    const unsigned short* El = (const unsigned short*)buf;
    const unsigned* Wl = (const unsigned*)(buf + 4096); const int* Cl = (const int*)(buf + 6144); const float* Sl = (const float*)(buf + 6656);
    const size_t row0 = ds_row0(tk_cur);
    const int s_try = (int)((x + (unsigned)qi) & 3u);
    unsigned raw = 0;
    if (lane == 0) raw = __hip_atomic_fetch_add(qh4 + s_try * 16, 16u, __ATOMIC_RELAXED, __HIP_MEMORY_SCOPE_AGENT);
    int tk_n = -1, s_n = 0;
    gbyte_t* tabn = tab;
#pragma unroll 1
    for (int t = 0; t < 16; t += 2) {
      ds_issue16(vb, El + (t + 1) * 128 + gi * 16, tab, loff);
      ds_v_compute(va, Wl + t * 32 + gi * 4, Cl + t * 8 + gi, Sl + t, sel, lane, j, gi, row0 + t, tk_cur + t, s_cur, hb, out, nullptr);
      if (t == 6) {
        const unsigned st = __builtin_amdgcn_readfirstlane(raw);
        if (st < (unsigned)(BATCH * SEQ)) { tk_n = (int)st; s_n = s_try; } else { ++qi; tk_n = ds_pop(qh4, x, qi, lane, s_n); }
        if (tk_n >= 0) { ds_v_stage(bufn, lane, tk_n, s_n, eb, wq, aux, wsc); tabn = uniform_ptr(vt4 + (size_t)s_n * (16384 * 128)); }
      }
      if (t + 2 < 16) ds_issue16(va, El + (t + 2) * 128 + gi * 16, tab, loff);
      else if (tk_n >= 0) ds_issue16(va, (const unsigned short*)bufn + gi * 16, tabn, loff);
      ds_v_compute(vb, Wl + (t + 1) * 32 + gi * 4, Cl + (t + 1) * 8 + gi, Sl + t + 1, sel, lane, j, gi, row0 + t + 1, tk_cur + t + 1, s_cur, hb, out, nullptr);
    }
    if (tk_n < 0) break;
    tk_cur = tk_n; s_cur = s_n; tab = tabn; bsel ^= 1;
  }
}

__device__ __forceinline__ void ds_u_stage(char* buf, int lane, int tk0, int s, const int* __restrict__ eb, const unsigned char* __restrict__ xi8, const float* __restrict__ xsc) {
  const size_t row0 = ds_row0(tk0);
  uint4 idw[4];
#pragma unroll
  for (int i = 0; i < 4; ++i) idw[i] = *(const uint4*)((const unsigned short*)eb + row0 * 128 + (i * 64 + lane) * 8);
  const int t = lane >> 2, part = lane & 3;
  const uint4* xp = (const uint4*)(xi8 + (row0 + t) * D + 256 * s + 64 * part);
  uint4 w4[4];
#pragma unroll
  for (int i = 0; i < 4; ++i) w4[i] = xp[i];
  const float sc = xsc[(row0 + t) * 16 + 4 * s + part];
#pragma unroll
  for (int i = 0; i < 4; ++i) *(uint4*)(buf + (i * 64 + lane) * 16) = idw[i];
  unsigned hi[8], lo[8];
#pragma unroll
  for (int i = 0; i < 4; ++i) {
    const unsigned tA0 = bytes_add8(w4[i].x), tB0 = bytes_add8(w4[i].y), tA1 = bytes_add8(w4[i].z), tB1 = bytes_add8(w4[i].w);
    lo[2 * i] = ((tA0 & 0x0F0F0F0Fu) | ((tB0 & 0x0F0F0F0Fu) << 4)) ^ 0x88888888u; hi[2 * i] = ((tA0 >> 4) & 0x0F0F0F0Fu) | (tB0 & 0xF0F0F0F0u);
    lo[2 * i + 1] = ((tA1 & 0x0F0F0F0Fu) | ((tB1 & 0x0F0F0F0Fu) << 4)) ^ 0x88888888u; hi[2 * i + 1] = ((tA1 >> 4) & 0x0F0F0F0Fu) | (tB1 & 0xF0F0F0F0u);
  }
  unsigned* XH = (unsigned*)(buf + 4096); unsigned* XL = (unsigned*)(buf + 6144);
  uint4* dh = (uint4*)(XH + t * 32 + 8 * part); uint4* dl = (uint4*)(XL + t * 32 + 8 * part);
  dh[0] = make_uint4(hi[0], hi[1], hi[2], hi[3]); dh[1] = make_uint4(hi[4], hi[5], hi[6], hi[7]);
  dl[0] = make_uint4(lo[0], lo[1], lo[2], lo[3]); dl[1] = make_uint4(lo[4], lo[5], lo[6], lo[7]);
  *(float*)(buf + 8192 + lane * 4) = sc;
}
__device__ __forceinline__ void ds_u_pass(char* wl, int lane, unsigned* qh4, unsigned x, const unsigned char* __restrict__ xi8, const float* __restrict__ xsc, const int* __restrict__ eb,
                                          const unsigned char* __restrict__ ut4, float* __restrict__ partial) {
  const int j = lane & 7, gi = lane >> 3;
  const unsigned loff = 16u * (unsigned)j;
  int qi = 0, s_cur = 0;
  int tk_cur = ds_pop(qh4, x, qi, lane, s_cur);
  if (tk_cur < 0) return;
  int bsel = 0;
  ds_u_stage(wl, lane, tk_cur, s_cur, eb, xi8, xsc);
  gbyte_t* tab = uniform_ptr(ut4 + (size_t)s_cur * (16384 * 128));
  uint4 ua[16], ub[16];
  ds_issue16(ua, (const unsigned short*)wl + gi * 16, tab, loff);
  for (;;) {
    char* buf = wl + bsel * WBUF; char* bufn = wl + (bsel ^ 1) * WBUF;
    const unsigned short* El = (const unsigned short*)buf;
    const unsigned* XH = (const unsigned*)(buf + 4096); const unsigned* XL = (const unsigned*)(buf + 6144); const float* Sl = (const float*)(buf + 8192);
    bf16_t* pout = (bf16_t*)partial + ((size_t)tk_cur * 4 + s_cur) * 128 + gi * 16 + 2 * j;
    const int s_try = (int)((x + (unsigned)qi) & 3u);
    unsigned raw = 0;
    if (lane == 0) raw = __hip_atomic_fetch_add(qh4 + s_try * 16, 16u, __ATOMIC_RELAXED, __HIP_MEMORY_SCOPE_AGENT);
    int tk_n = -1, s_n = 0;
    gbyte_t* tabn = tab;
#pragma unroll 1
    for (int t = 0; t < 16; t += 2) {
      ds_issue16(ub, El + (t + 1) * 128 + gi * 16, tab, loff);
      ds_u_compute(ua, XH + t * 32 + 4 * j, XL + t * 32 + 4 * j, Sl[4 * t + (j >> 1)], pout + (size_t)t * 512, j);
      if (t == 6) {
        const unsigned st = __builtin_amdgcn_readfirstlane(raw);
        if (st < (unsigned)(BATCH * SEQ)) { tk_n = (int)st; s_n = s_try; } else { ++qi; tk_n = ds_pop(qh4, x, qi, lane, s_n); }
        if (tk_n >= 0) { ds_u_stage(bufn, lane, tk_n, s_n, eb, xi8, xsc); tabn = uniform_ptr(ut4 + (size_t)s_n * (16384 * 128)); }
      }
      if (t + 2 < 16) ds_issue16(ua, El + (t + 2) * 128 + gi * 16, tab, loff);
      else if (tk_n >= 0) ds_issue16(ua, (const unsigned short*)bufn + gi * 16, tabn, loff);
      ds_u_compute(ub, XH + (t + 1) * 32 + 4 * j, XL + (t + 1) * 32 + 4 * j, Sl[4 * (t + 1) + (j >> 1)], pout + (size_t)(t + 1) * 512, j);
    }
    if (tk_n < 0) break;
    tk_cur = tk_n; s_cur = s_n; tab = tabn; bsel ^= 1;
  }
}


struct EpiBf16 {
  bf16_t* out; int ld; int use_scale; unsigned* kmax;
  __device__ __forceinline__ void store8(size_t row, int col, const float (&v)[8], float& tmax) const {
    if (kmax && col >= 512 && col < 1024) {
      float ss = 0.f;
#pragma unroll
      for (int i = 0; i < 8; ++i) ss += v[i] * v[i];
      tmax = fmaxf(tmax, sum8(ss));
    }
    uint4 w; w.x = cvtpk(v[0], v[1]); w.y = cvtpk(v[2], v[3]); w.z = cvtpk(v[4], v[5]); w.w = cvtpk(v[6], v[7]);
    *(uint4*)(out + row * ld + col) = w;
  }
  __device__ __forceinline__ void finish(float tmax, size_t row, int col) const {
    if (kmax && col >= 512 && col < 1024) {
      tmax = wave_max(tmax);
      if ((threadIdx.x & 63) == 0) atomicMax(kmax + (row / LP) * 8 + ((col - 512) >> 6), __float_as_uint(tmax));
    }
  }
};
struct EpiResid2 {
  const float* x; const float* meta; float* h2; bf16_t* hb; float* rowss; unsigned char* xi8; float* xsc;
  __device__ __forceinline__ void finish(float, size_t, int) const {}
  __device__ __forceinline__ void store8(size_t row, int col, const float (&v)[8], float&) const {
    const float* src = hrow_ptr(x, meta, (int)row);
    const float4 a = ld_nt4((const float4*)(src + col)), b = ld_nt4((const float4*)(src + col + 4));
    const float o[8] = {a.x + v[0], a.y + v[1], a.z + v[2], a.w + v[3], b.x + v[4], b.y + v[5], b.z + v[6], b.w + v[7]};
    uint4 w; w.x = cvtpk(o[0], o[1]); w.y = cvtpk(o[2], o[3]); w.z = cvtpk(o[4], o[5]); w.w = cvtpk(o[6], o[7]);
    *(uint4*)(hb + row * D + col) = w;
    float ss = 0.f;
#pragma unroll
    for (int i = 0; i < 8; ++i) ss += o[i] * o[i];
    ss = sum8(ss);
    if ((threadIdx.x & 7) == 0) rowss[row * 16 + (col >> 6)] = ss;
    {
      float am = fmaxf(fmaxf(fmaxf(fabsf(o[0]), fabsf(o[1])), fmaxf(fabsf(o[2]), fabsf(o[3]))), fmaxf(fmaxf(fabsf(o[4]), fabsf(o[5])), fmaxf(fabsf(o[6]), fabsf(o[7]))));
      am = fmaxf(am, __builtin_bit_cast(float, __builtin_amdgcn_update_dpp(0, __builtin_bit_cast(int, am), 0x141, 0xf, 0xf, true)));
      am = fmaxf(am, __builtin_bit_cast(float, __builtin_amdgcn_update_dpp(0, __builtin_bit_cast(int, am), 0xB1, 0xf, 0xf, true)));
      am = fmaxf(am, __builtin_bit_cast(float, __builtin_amdgcn_update_dpp(0, __builtin_bit_cast(int, am), 0x4E, 0xf, 0xf, true)));
      const float sc = am > 0.f ? 119.0f / am : 1.0f;
      *(uint2*)(xi8 + row * D + col) = make_uint2(pack_i8x4(o[0] * sc, o[1] * sc, o[2] * sc, o[3] * sc), pack_i8x4(o[4] * sc, o[5] * sc, o[6] * sc, o[7] * sc));
      if ((threadIdx.x & 7) == 0) xsc[row * 16 + (col >> 6)] = am > 0.f ? am * (1.0f / 119.0f) : 1.0f;
    }
  }
};

__device__ __forceinline__ int g8_lds_byte(int r, int c) {
  const int st = (r >> 4) * 2 + (c >> 5), rr = r & 15, cc = c & 31, ob = rr * 64 + cc * 2;
  return st * 1024 + (ob ^ (((ob >> 9) & 1) << 5));
}
__device__ __forceinline__ void g8_stage_rc(int b, int& R, int& C) {
  const int st = b / 1024, sb = b % 1024, swz = sb ^ (((sb >> 9) & 1) << 5);
  R = (st >> 1) * 16 + swz / 64; C = (st & 1) * 32 + (swz % 64) / 2;
}
template <class Epi>
__device__ __forceinline__ void gemm256(char* lds, const bf16_t* __restrict__ X, int ldx, const bf16_t* __restrict__ Wt, int ldw, int K, size_t xrow0, int n0, const Epi& epi) {
  const int tix = opaque_tid();
  const int tid = tix, lane = tid & 63;
  const int wid = __builtin_amdgcn_readfirstlane(tid >> 6);
  const int wr = wid >> 2, wc = wid & 3, fr = lane & 15, fq = lane >> 4;
  f32x4 acc[2][2][4][2];
#pragma unroll
  for (int i = 0; i < 2; ++i)
#pragma unroll
    for (int j = 0; j < 2; ++j)
#pragma unroll
      for (int m = 0; m < 4; ++m)
#pragma unroll
        for (int n = 0; n < 2; ++n) acc[i][j][m][n] = (f32x4){0.f, 0.f, 0.f, 0.f};
  bf16x8 At[4][2], B0[2][2], B1[2][2];
  const int nt = K >> 6;
  const char* xg[2]; const char* wg[2];
#pragma unroll
  for (int i = 0; i < 2; ++i) {
    int R, C; g8_stage_rc(tid * 16 + i * 8192, R, C);
    xg[i] = (const char*)(X + (xrow0 + R) * ldx + C);
    wg[i] = (const char*)(Wt + (size_t)(n0 + R) * ldw + C);
  }
#define G8_SA(b, h) (lds + ((b) * 2 + (h)) * 16384)
#define G8_SB(b, h) (lds + (4 + (b) * 2 + (h)) * 16384)
#define G8_STAGE_A(b, h, kt) do { _Pragma("unroll") for (int i_ = 0; i_ < 2; ++i_) \
    __builtin_amdgcn_global_load_lds((const unsigned*)(xg[i_] + (size_t)(h) * 128 * ldx * 2 + (kt) * 128), LDSP(unsigned, G8_SA(b, h) + wid * 1024 + i_ * 8192), 16, 0, 0); } while (0)
#define G8_STAGE_B(b, h, kt) do { _Pragma("unroll") for (int i_ = 0; i_ < 2; ++i_) \
    __builtin_amdgcn_global_load_lds((const unsigned*)(wg[i_] + (size_t)(h) * 128 * ldw * 2 + (kt) * 128), LDSP(unsigned, G8_SB(b, h) + wid * 1024 + i_ * 8192), 16, 0, 0); } while (0)
#define G8_LDA(dst, b, h) _Pragma("unroll") for (int m = 0; m < 4; ++m) _Pragma("unroll") for (int k = 0; k < 2; ++k) \
    dst[m][k] = *(const bf16x8*)(G8_SA(b, h) + g8_lds_byte(wr * 64 + m * 16 + fr, k * 32 + fq * 8))
#define G8_LDB(dst, b, h) _Pragma("unroll") for (int n = 0; n < 2; ++n) _Pragma("unroll") for (int k = 0; k < 2; ++k) \
    dst[n][k] = *(const bf16x8*)(G8_SB(b, h) + g8_lds_byte(wc * 32 + n * 16 + fr, k * 32 + fq * 8))
#define G8_MMA(ai, bj, At_, Bt_) do { __builtin_amdgcn_s_setprio(1); \
    _Pragma("unroll") for (int m = 0; m < 4; ++m) _Pragma("unroll") for (int n = 0; n < 2; ++n) _Pragma("unroll") for (int k = 0; k < 2; ++k) \
      acc[ai][bj][m][n] = __builtin_amdgcn_mfma_f32_16x16x32_bf16(Bt_[n][k], At_[m][k], acc[ai][bj][m][n], 0, 0, 0); \
    __builtin_amdgcn_s_setprio(0); } while (0)
#define G8_WAIT_V(n) asm volatile("s_waitcnt vmcnt(" #n ")" ::: "memory")
#define G8_WAIT_L(n) asm volatile("s_waitcnt lgkmcnt(" #n ")" ::: "memory")
#define G8_BAR __builtin_amdgcn_s_barrier()
#define G8_SCHED __builtin_amdgcn_sched_barrier(0)
  __syncthreads();
  G8_STAGE_B(0, 0, 0); G8_STAGE_A(0, 0, 0); G8_STAGE_B(0, 1, 0); G8_STAGE_A(0, 1, 0);
  if (wr == 1) G8_BAR;
  G8_WAIT_V(4); G8_BAR;
  G8_STAGE_B(1, 0, 1); G8_STAGE_A(1, 0, 1); G8_STAGE_B(1, 1, 1);
  G8_WAIT_V(6); G8_BAR;
#pragma unroll 1
  for (int t = 0; t < nt - 2; t += 2) {
    G8_LDB(B0, 0, 0); G8_SCHED; G8_LDA(At, 0, 0); G8_STAGE_A(1, 1, t + 1);
    G8_WAIT_L(8); G8_BAR; G8_WAIT_L(0); G8_MMA(0, 0, At, B0); G8_BAR; G8_SCHED;
    G8_LDB(B1, 0, 1); G8_STAGE_B(0, 0, t + 2);
    G8_BAR; G8_WAIT_L(0); G8_MMA(0, 1, At, B1); G8_BAR;
    G8_LDA(At, 0, 1); G8_STAGE_A(0, 0, t + 2);
    G8_BAR; G8_WAIT_L(0); G8_MMA(1, 0, At, B0); G8_BAR; G8_SCHED;
    G8_STAGE_B(0, 1, t + 2);
    G8_WAIT_V(6); G8_BAR; G8_MMA(1, 1, At, B1); G8_BAR;
    G8_LDB(B0, 1, 0); G8_SCHED; G8_LDA(At, 1, 0); G8_STAGE_A(0, 1, t + 2);
    G8_WAIT_L(8); G8_BAR; G8_WAIT_L(0); G8_MMA(0, 0, At, B0); G8_BAR; G8_SCHED;
    G8_LDB(B1, 1, 1); G8_STAGE_B(1, 0, t + 3);
    G8_BAR; G8_WAIT_L(0); G8_MMA(0, 1, At, B1); G8_BAR;
    G8_LDA(At, 1, 1); G8_STAGE_A(1, 0, t + 3);
    G8_BAR; G8_WAIT_L(0); G8_MMA(1, 0, At, B0); G8_BAR; G8_SCHED;
    G8_STAGE_B(1, 1, t + 3);
    G8_WAIT_V(6); G8_BAR; G8_MMA(1, 1, At, B1); G8_BAR;
  }
  { G8_LDB(B0, 0, 0); G8_LDA(At, 0, 0); G8_STAGE_A(1, 1, nt - 1);
    G8_BAR; G8_WAIT_L(0); G8_MMA(0, 0, At, B0); G8_BAR;
    G8_LDB(B1, 0, 1); G8_BAR; G8_WAIT_L(0); G8_MMA(0, 1, At, B1); G8_BAR;
    G8_LDA(At, 0, 1); G8_WAIT_V(4); G8_BAR; G8_WAIT_L(0); G8_MMA(1, 0, At, B0); G8_MMA(1, 1, At, B1); G8_BAR; }
  { G8_LDB(B0, 1, 0); G8_LDA(At, 1, 0); G8_WAIT_V(2); G8_BAR; G8_WAIT_L(0); G8_MMA(0, 0, At, B0); G8_BAR;
    G8_LDB(B1, 1, 1); G8_WAIT_V(0); G8_BAR; G8_WAIT_L(0); G8_MMA(0, 1, At, B1); G8_BAR;
    G8_LDA(At, 1, 1); G8_BAR; G8_WAIT_L(0); G8_MMA(1, 0, At, B0); G8_MMA(1, 1, At, B1); G8_BAR; }
  if (wr == 0) G8_BAR;
#undef G8_SA
#undef G8_SB
#undef G8_STAGE_A
#undef G8_STAGE_B
#undef G8_LDA
#undef G8_LDB
#undef G8_MMA
#undef G8_WAIT_V
#undef G8_WAIT_L
#undef G8_BAR
#undef G8_SCHED
  float tmax = 0.f;
  const int wm2 = wid >> 2, seg = wid & 3;
#pragma unroll
  for (int ai = 0; ai < 2; ++ai) {
    __syncthreads();
#pragma unroll
    for (int bj = 0; bj < 2; ++bj)
#pragma unroll
      for (int m = 0; m < 4; ++m)
#pragma unroll
        for (int n = 0; n < 2; ++n) {
          const int row = wr * 64 + m * 16 + fr, chunk = bj * 32 + wc * 8 + n * 4 + fq;
          *(f32x4*)(lds + row * 1024 + ((chunk ^ (row & 7)) << 4)) = acc[ai][bj][m][n];
        }
    __syncthreads();
#pragma unroll
    for (int i = 0; i < 8; ++i) {
      const int row = wm2 * 64 + 8 * i + (lane >> 3), c8 = lane & 7, ch = seg * 16 + 2 * c8;
      const f32x4 v0 = *(const f32x4*)(lds + row * 1024 + ((ch ^ (row & 7)) << 4)), v1 = *(const f32x4*)(lds + row * 1024 + (((ch + 1) ^ (row & 7)) << 4));
      const float v[8] = {v0[0], v0[1], v0[2], v0[3], v1[0], v1[1], v1[2], v1[3]};
      epi.store8(xrow0 + ai * 128 + row, n0 + seg * 64 + 8 * c8, v, tmax);
    }
  }
  epi.finish(tmax, xrow0, n0 + seg * 64);
}

__device__ __forceinline__ void meta_proj(char* lds, int blk, const bf16_t* __restrict__ xn1, const bf16_t* __restrict__ wt_in, bf16_t* proj) {
  const int tix = opaque_tid();
  float* red = (float*)lds;
  __syncthreads();
  float part = 0.f;
  const int o = tix % 160, kp = tix / 160;
  if (tix < 480) {
    const int row = o / 10, n = blk * 10 + o % 10;
    const int k0 = kp * 352, k1 = kp == 2 ? 1024 : k0 + 352;
    const bf16_t* xr = xn1 + (size_t)row * D; const bf16_t* wr = wt_in + (size_t)n * D;
    for (int k = k0; k < k1; k += 8) {
      const uint4 a = *(const uint4*)(xr + k), b = *(const uint4*)(wr + k);
      part = dot8(a, b, part);
    }
    red[tix] = part;
  }
  __syncthreads();
  if (tix < 160) {
    const float v = red[tix] + red[tix + 160] + red[tix + 320];
    const int row = tix / 10, n = blk * 10 + tix % 10;
    const bf16_t bv = f2bf(v);
#pragma unroll
    for (int b = 0; b < BATCH; ++b) proj[((size_t)b * LP + row) * INC + n] = bv;
  }
}

__device__ __forceinline__ void p_transpose(int t, float* smem, const float* __restrict__ W, bf16_t* Wt, int K, int N, const float* __restrict__ ksc) {
  const int tix = opaque_tid();
  float (*T)[65] = (float (*)[65])smem;
  const int nbx = N / 64, k0 = (t / nbx) * 64, n0 = (t % nbx) * 64, tid = (tix & 255);
  const int j4 = tid & 15, i0 = tid >> 4;
  float4 v[4];
#pragma unroll
  for (int ii = 0; ii < 4; ++ii) v[ii] = ld_nt4((const float4*)(W + (size_t)(k0 + i0 + 16 * ii) * N + n0 + 4 * j4));
#pragma unroll
  for (int ii = 0; ii < 4; ++ii) {
    const int i = i0 + 16 * ii;
    const float sc = ksc ? ksc[k0 + i] : 1.0f;
    T[i][4 * j4] = v[ii].x * sc; T[i][4 * j4 + 1] = v[ii].y * sc; T[i][4 * j4 + 2] = v[ii].z * sc; T[i][4 * j4 + 3] = v[ii].w * sc;
  }
  __syncthreads();
  const int n = tid >> 2, kc = tid & 3;
#pragma unroll
  for (int h = 0; h < 2; ++h) {
    const int kk = (kc + 4 * h) * 8;
    *(uint4*)(Wt + (size_t)(n0 + n) * K + k0 + kk) = make_uint4(pack2(T[kk][n], T[kk + 1][n]), pack2(T[kk + 2][n], T[kk + 3][n]), pack2(T[kk + 4][n], T[kk + 5][n]), pack2(T[kk + 6][n], T[kk + 7][n]));
  }
  __syncthreads();
}

#define XB_TMO      128
#define XB_XCNT(j)  (256  + 64 * (j))
#define XB_XSUB(j)  (1280 + 64 * (j))
#define XB_XGEN(j)  (2304 + 64 * (j))
#define XB_TOP      3328
#define XB_TOPGEN   3392
#define XCD_BAR_WORDS 3456
#define XB_SPIN_CAP (1u << 18)
#define LAS __attribute__((address_space(3)))

__device__ __forceinline__ unsigned xb_ld(unsigned* p)              { return __hip_atomic_load(p, __ATOMIC_RELAXED, __HIP_MEMORY_SCOPE_AGENT); }
__device__ __forceinline__ unsigned xb_add(unsigned* p, unsigned v) { return __hip_atomic_fetch_add(p, v, __ATOMIC_RELAXED, __HIP_MEMORY_SCOPE_AGENT); }
__device__ __forceinline__ unsigned xb_xcc_id() { return (unsigned)__builtin_amdgcn_s_getreg((3 << 11) | 20) & 0xFu; }
#define XB_SPIN(cond, bar) do { unsigned _sp = 0; while (cond) { __builtin_amdgcn_s_sleep(1); \
    if ((++_sp & 255u) == 0u) { if (xb_ld(&(bar)[XB_TMO])) break; if (_sp > XB_SPIN_CAP) { atomicAdd(&(bar)[XB_TMO], 1u); break; } } } } while (0)

struct XcdBarrier {
    unsigned* bar; unsigned x;
    volatile LAS unsigned* st;
};

__device__ __forceinline__ XcdBarrier xcd_barrier_post(unsigned* bar, volatile LAS unsigned* st) {
    XcdBarrier b; b.bar = bar; b.x = xb_xcc_id(); b.st = st;
    if (threadIdx.x == 0) (void)xb_add(&bar[XB_XCNT(b.x)], 1u);
    return b;
}
__device__ __forceinline__ void xcd_barrier_complete(unsigned* bar, unsigned x, unsigned& nloc, unsigned& nx) {
    const unsigned G = gridDim.x * gridDim.y * gridDim.z;
    unsigned sum, cnt, mine, sp = 0u;
    for (;;) {
        sum = 0u; cnt = 0u; mine = 0u;
#pragma unroll
        for (unsigned j = 0; j < 16; ++j) { const unsigned c = xb_ld(&bar[XB_XCNT(j)]); sum += c; cnt += (c > 0u) ? 1u : 0u; mine = (j == x) ? c : mine; }
        if (sum == G) break;
        __builtin_amdgcn_s_sleep(1);
        if ((++sp & 255u) == 0u) { if (xb_ld(&bar[XB_TMO])) break; if (sp > XB_SPIN_CAP) { atomicAdd(&bar[XB_TMO], 1u); break; } }
    }
    nloc = mine > 0u ? mine : 1u; nx = cnt > 0u ? cnt : 1u;
}

__device__ __forceinline__ void xcd_barrier(const XcdBarrier& b) {
    asm volatile("s_waitcnt vmcnt(0)" ::: "memory");
    __syncthreads();
    if (threadIdx.x == 0) {
        unsigned* bar = b.bar;
        __builtin_amdgcn_s_waitcnt(0);
        unsigned nloc = b.st[0], nx = b.st[1];
        if (nloc == 0u) { xcd_barrier_complete(bar, b.x, nloc, nx); b.st[0] = nloc; b.st[1] = nx; }
        const unsigned old = xb_add(&bar[XB_XSUB(b.x)], 1u);
        const unsigned gen = old / nloc;
        if (old + 1u == (gen + 1u) * nloc) {
            __builtin_amdgcn_fence(__ATOMIC_RELEASE, "agent");
            asm volatile("s_waitcnt vmcnt(0)" ::: "memory");
            const unsigned og = xb_add(&bar[XB_TOP], 1u);
            const unsigned tg = og / nx;
            if (og + 1u == (tg + 1u) * nx) xb_add(&bar[XB_TOPGEN], 1u);
            else XB_SPIN(xb_ld(&bar[XB_TOPGEN]) == tg, bar);
            __builtin_amdgcn_fence(__ATOMIC_ACQUIRE, "agent");
            xb_add(&bar[XB_XGEN(b.x)], 1u);
            asm volatile("s_waitcnt vmcnt(0)" ::: "memory");
        } else {
            XB_SPIN(xb_ld(&bar[XB_XGEN(b.x)]) == gen, bar);
            __builtin_amdgcn_fence(__ATOMIC_ACQUIRE, "agent");
            asm volatile("s_waitcnt vmcnt(0)" ::: "memory");
        }
    }
    __syncthreads();
}


struct Params {
  const float *x, *meta, *g1, *w_in, *lq1, *lk1, *lq2, *lk2, *subg, *conv_w, *conv_b, *gn_g, *gn_b, *w_out, *g2, *wq, *sk, *ut, *vt, *fg;
  float* out; float* scal; bf16_t* r1; bf16_t* r2; float* h2; int* eb; float* gb; bf16_t* wt_in; bf16_t* wt_out; bf16_t* wt_q; bf16_t* skb; unsigned char* ut8; unsigned char* vt8; float* uinv; float* vinv; float* wbuf; float* ssq; bf16_t* hb; float* rowss; int use_cg_sync; int pad0;
};

__global__ void __launch_bounds__(512, 2) mega(Params p) {
  cg::grid_group grid = cg::this_grid();
  __shared__ __attribute__((aligned(16))) char smem_c[163840];
  float* smem = (float*)smem_c;
  const int G = gridDim.x, vh = threadIdx.x >> 8;
  volatile LAS unsigned* xb_st = (volatile LAS unsigned*)(smem_c + 131072 + 16);
  if (threadIdx.x == 0) { xb_st[0] = 0u; xb_st[1] = 0u; }
  __syncthreads();
  const XcdBarrier xbar = xcd_barrier_post((unsigned*)(p.scal + 1024), xb_st);
  bf16_t* xn1 = p.r1; bf16_t* mix = p.r1; bf16_t* proj = p.r2; bf16_t* qp = p.r2;
  p_norm1_rows(G, p.x, p.meta, p.g1, xn1);
  if (blockIdx.x == 0 && threadIdx.x < 64) {
    const int t = threadIdx.x;
    const float a = wave_sum(p.lq1[t] * p.lk1[t]), b2 = wave_sum(p.lq2[t] * p.lk2[t]);
    if (t == 0) p.scal[0] = expf(a) - expf(b2) + LAM_INIT;
  }
  for (int b = blockIdx.x; b < (640 + 256 + 512) / 2; b += G) {
    const int bb = b * 2 + vh; float* sm = smem + vh * (64 * 65);
    if (bb < 640) p_transpose(bb, sm, p.w_in, p.wt_in, D, INC, nullptr);
    else if (bb < 896) p_transpose(bb - 640, sm, p.w_out, p.wt_out, D, D, nullptr);
    else p_transpose(bb - 896, sm, p.wq, p.wt_q, D, 2048, p.g2);
  }
  p_cvt_bf16(blockIdx.x, G, p.sk, p.skb, (size_t)16 * 128 * 128 / 8);
  p_cvt_i4_rows<0>(blockIdx.x, G, p.ut, (unsigned*)p.ut8, (float*)(p.vt8 + 8388608), p.g2);
  p_cvt_i4_rows<8>(blockIdx.x, G, p.vt, (unsigned*)p.vt8, (float*)(p.vt8 + 8388608) + 2  , nullptr);
  if (p.use_cg_sync) grid.sync(); else xcd_barrier(xbar);
  for (int b = blockIdx.x; b < 128 * 10; b += G) {
    const int xi = (b >> 3), mt = (b & 7) * 16 + xi / 10, nt = xi % 10;
    gemm256(smem_c, xn1, D, p.wt_in, D, D, (size_t)(mt >> 4) * LP + NMETA + 256 * (mt & 15), nt * 256, EpiBf16{proj, INC, 0, (unsigned*)(p.scal + 640)});
  }
  for (int b = blockIdx.x; b < 256; b += G) meta_proj(smem_c, b, xn1, p.wt_in, proj);
  for (int i = blockIdx.x * 512 + threadIdx.x; i < BATCH * (LP - LREAL) * 128; i += G * 512) {
    const int c = i & 127, r = i >> 7, b = r / (LP - LREAL), pos = LREAL + r - b * (LP - LREAL);
    *(uint4*)(proj + ((size_t)b * LP + pos) * INC + 512 + 8 * c) = make_uint4(0, 0, 0, 0);
  }
  xcd_barrier(xbar);
  {
    const float lam = p.scal[0];
    unsigned* aq = (unsigned*)(p.scal + 384);
    volatile int* ubox = (volatile int*)(smem_c + 131072 + 32);
    const unsigned x = xcc_id();
    volatile int* hbox = (volatile int*)(smem_c + 131072 + 64);
    for (int qi = 0; qi < 8; ++qi) {
      const int bq_ = (int)((x + qi) & 7u);
      if (qi == 1) {
        if (threadIdx.x < 8) hbox[threadIdx.x] = (int)__hip_atomic_load(aq + threadIdx.x * 16, __ATOMIC_RELAXED, __HIP_MEMORY_SCOPE_AGENT);
        __syncthreads();
      }
      if (qi >= 1 && hbox[bq_] >= 256) continue;
      int nxt = 0;
      if (threadIdx.x == 0) nxt = (int)__hip_atomic_fetch_add(aq + bq_ * 16, 1u, __ATOMIC_RELAXED, __HIP_MEMORY_SCOPE_AGENT);
      for (;;) {
        if (threadIdx.x == 0) *ubox = nxt;
        __syncthreads();
        const int i = *ubox;
        if (i >= 256) break;
        if (threadIdx.x == 0) nxt = (int)__hip_atomic_fetch_add(aq + bq_ * 16, 1u, __ATOMIC_RELAXED, __HIP_MEMORY_SCOPE_AGENT);
        if (i < 128) attn_unit(smem_c, proj, mix, p.subg, (const unsigned*)(p.scal + 640), lam, bq_, i & 3, 31 - (i >> 2));
        else conv_unit(smem_c, proj, mix, p.conv_w, p.conv_b, p.gn_g, p.gn_b, bq_, NMETA + 32 * (i - 128));
      }
      __syncthreads();
    }
  }
  xcd_barrier(xbar);
  for (int b = blockIdx.x; b < 128 * 4; b += G) {
    const int xi = (b >> 3), mt = (b & 7) * 16 + (xi >> 2), nt = xi & 3;
    gemm256(smem_c, mix, D, p.wt_out, D, D, (size_t)(mt >> 4) * LP + NMETA + 256 * (mt & 15), nt * 256, EpiResid2{p.x, p.meta, p.h2, p.hb, p.rowss, (unsigned char*)p.h2, (float*)((char*)p.h2 + (size_t)ROWS * D)});
  }
  xcd_barrier(xbar);
  for (int b = blockIdx.x; b < 128 * 8; b += G) {
    const int xi = (b >> 3), mt = (b & 7) * 16 + (xi >> 3), nt = xi & 7;
    gemm256(smem_c, p.hb, D, p.wt_q, D, D, (size_t)(mt >> 4) * LP + NMETA + 256 * (mt & 15), nt * 256, EpiBf16{qp, 2048, 0, nullptr});
  }
  xcd_barrier(xbar);
  {
    int hprev = -1;
    for (int u = blockIdx.x; u < 64 * 8; u += G) {
      const int rt = u >> 3, h = u & 7;
      peer_topk_unit64(smem_c, qp, p.skb, p.rowss, p.eb, p.gb, p.uinv  , (rt >> 3) * LP + NMETA + 512 * (rt & 7), h, h != hprev);
      hprev = h;
    }
  }
  xcd_barrier(xbar);
  {
    const int tix = opaque_tid();
    const int lane = tix & 63;
    const int NTOK = BATCH * SEQ;
    float* partial = (float*)qp;
    unsigned* qh = (unsigned*)(p.scal + 128);
    const unsigned x = xcc_id();
    ds_u_pass(smem_c + (tix >> 6) * WREG, lane, qh, x, (const unsigned char*)p.h2, (const float*)((const char*)p.h2 + (size_t)ROWS * D), p.eb, p.ut8, partial);
    xcd_barrier(xbar);
    {
      const uint4* sc8 = (const uint4*)(p.vt8 + 8388608);
      unsigned short* wq16 = (unsigned short*)p.wbuf;
      int* aux = (int*)(p.ut8 + 8388608);
      float* wsc = p.ssq + (size_t)NTOK * 4;
      for (int tk = blockIdx.x * 8 + (tix >> 6); tk < NTOK; tk += G * 8) {
        const int b = tk / SEQ, sq = tk - b * SEQ;
        const size_t row = (size_t)b * LP + NMETA + sq;
        const unsigned ew = __builtin_nontemporal_load((const unsigned*)((const unsigned short*)p.eb + row * 128 + 2 * lane));
        const unsigned gw = __builtin_nontemporal_load((const unsigned*)((const bf16_t*)p.gb + row * 128 + 2 * lane));
        const float2 gg = make_float2(__uint_as_float(gw << 16), __uint_as_float(gw & 0xffff0000u));
        float2 pa[4];
#pragma unroll
        for (int s = 0; s < 4; ++s) { const unsigned w = __builtin_nontemporal_load((const unsigned*)((const bf16_t*)partial + ((size_t)tk * 4 + s) * 128 + 2 * lane)); pa[s] = make_float2(__uint_as_float(w << 16), __uint_as_float(w & 0xffff0000u)); }
        const int e0 = (int)(ew & 0xffffu), e1 = (int)(ew >> 16);
        const uint4 s0 = sc8[e0], s1 = sc8[e1];
        const float4 us0 = make_float4(__uint_as_float(s0.x << 16), __uint_as_float(s0.x & 0xffff0000u), __uint_as_float(s0.y << 16), __uint_as_float(s0.y & 0xffff0000u));
        const float4 vs0 = make_float4(__uint_as_float(s0.z << 16), __uint_as_float(s0.z & 0xffff0000u), __uint_as_float(s0.w << 16), __uint_as_float(s0.w & 0xffff0000u));
        const float4 us1 = make_float4(__uint_as_float(s1.x << 16), __uint_as_float(s1.x & 0xffff0000u), __uint_as_float(s1.y << 16), __uint_as_float(s1.y & 0xffff0000u));
        const float4 vs1 = make_float4(__uint_as_float(s1.z << 16), __uint_as_float(s1.z & 0xffff0000u), __uint_as_float(s1.w << 16), __uint_as_float(s1.w & 0xffff0000u));
        const float rstd = p.uinv[row];
        const float a0 = (pa[0].x * us0.x + pa[1].x * us0.y + pa[2].x * us0.z + pa[3].x * us0.w) * rstd;
        const float a1 = (pa[0].y * us1.x + pa[1].y * us1.y + pa[2].y * us1.z + pa[3].y * us1.w) * rstd;
        const float w0 = gg.x * 0.5f * a0 * (1.0f + erff(a0 * 0.70710678118654752f)), w1 = gg.y * 0.5f * a1 * (1.0f + erff(a1 * 0.70710678118654752f));
        const float wp0[4] = {w0 * vs0.x, w0 * vs0.y, w0 * vs0.z, w0 * vs0.w}, wp1[4] = {w1 * vs1.x, w1 * vs1.y, w1 * vs1.z, w1 * vs1.w};
        float m = 0.f;
#pragma unroll
        for (int s = 0; s < 4; ++s) m = fmaxf(m, fmaxf(fabsf(wp0[s]), fabsf(wp1[s])));
        m = wave_max(m);
        const float scq = m > 0.f ? 72.0f / m : 0.f;
#pragma unroll
        for (int s = 0; s < 4; ++s) {
          const int q0 = (int)rintf(wp0[s] * scq), q1 = (int)rintf(wp1[s] * scq);
          wq16[((size_t)tk * 4 + s) * 64 + lane] = (unsigned short)((q0 & 255) | ((q1 & 255) << 8));
          const float gs = sum8((float)(q0 + q1));
          if ((lane & 7) == 0) aux[((size_t)tk * 4 + s) * 8 + (lane >> 3)] = -8 * (int)gs;
        }
        if (lane == 0) wsc[tk] = m * (1.0f / 72.0f);
      }
    }
    xcd_barrier(xbar);
    ds_v_pass(smem_c + (tix >> 6) * WREG, lane, qh + 8 * 16, x, p.hb, p.eb, (const unsigned char*)p.wbuf, (const int*)(p.ut8 + 8388608), p.ssq + (size_t)NTOK * 4, p.vt8, p.h2  );
    xcd_barrier(xbar);
    {
      const int wv = blockIdx.x * 8 + (tix >> 6);
      const bf16_t* hbf = (const bf16_t*)p.h2;
      for (int tk = wv * 2; tk < NTOK; tk += G * 16) {
        uint4 o[2][2]; float sv[2];
#pragma unroll
        for (int r = 0; r < 2; ++r) {
#pragma unroll
          for (int q = 0; q < 2; ++q) o[r][q] = ld_nt_u4((const uint4*)(hbf + (size_t)(tk + r) * D + q * 512 + lane * 8));
        }
        float f[2][2][8];
#pragma unroll
        for (int r = 0; r < 2; ++r) {
          sv[r] = 0.f;
#pragma unroll
          for (int q = 0; q < 2; ++q) {
            const unsigned w[4] = {o[r][q].x, o[r][q].y, o[r][q].z, o[r][q].w};
#pragma unroll
            for (int i = 0; i < 4; ++i) { f[r][q][2 * i] = __uint_as_float(w[i] << 16); f[r][q][2 * i + 1] = __uint_as_float(w[i] & 0xffff0000u); sv[r] += f[r][q][2 * i] * f[r][q][2 * i] + f[r][q][2 * i + 1] * f[r][q][2 * i + 1]; }
          }
        }
#pragma unroll
        for (int r = 0; r < 2; ++r) {
          const float rstd = rsqrtf(wave_sum(sv[r]) * (1.0f / D) + EPS);
#pragma unroll
          for (int q = 0; q < 2; ++q) {
            const float4 g0 = *(const float4*)(p.fg + q * 512 + lane * 8), g1 = *(const float4*)(p.fg + q * 512 + lane * 8 + 4);
            float* op = p.out + (size_t)(tk + r) * D + q * 512 + lane * 8;
            *(float4*)op = make_float4(f[r][q][0] * rstd * g0.x, f[r][q][1] * rstd * g0.y, f[r][q][2] * rstd * g0.z, f[r][q][3] * rstd * g0.w);
            *(float4*)(op + 4) = make_float4(f[r][q][4] * rstd * g1.x, f[r][q][5] * rstd * g1.y, f[r][q][6] * rstd * g1.z, f[r][q][7] * rstd * g1.w);
          }
        }
      }
    }
  }
}

extern "C" void kernel_launch(void* const* d_in, const int* in_sizes, int n_in, void* d_out, int out_size, void* d_ws, size_t ws_size, hipStream_t stream) {
  static int grid_blocks = 0;
  if (!grid_blocks) {
    int dev = 0, cus = 0, per_cu = 0;
    hipGetDevice(&dev);
    hipDeviceGetAttribute(&cus, hipDeviceAttributeMultiprocessorCount, dev);
    hipOccupancyMaxActiveBlocksPerMultiprocessor(&per_cu, mega, 512, 0);
    if (per_cu > 1) per_cu = 1;
    if (per_cu < 1) per_cu = 1;
    grid_blocks = cus * per_cu;
  }
  Params p{};
  const float** pp = (const float**)&p;
  for (int i = 0; i < 20; ++i) pp[i] = (const float*)d_in[i];
  p.out = (float*)d_out;
  char* ws = (char*)d_ws;
  size_t off = 0;
  p.scal = (float*)(ws + off); off += 32768;
  p.r1 = (bf16_t*)(ws + off); off += (size_t)ROWS * D * 2;
  p.r2 = (bf16_t*)(ws + off); off += (size_t)ROWS * INC * 2;
  p.h2 = (float*)(ws + off); off += (size_t)ROWS * D * 4;
  p.wt_in = (bf16_t*)(ws + off); off += (size_t)INC * D * 2;
  p.wt_out = (bf16_t*)(ws + off); off += (size_t)D * D * 2;
  p.wt_q = (bf16_t*)(ws + off); off += (size_t)2048 * D * 2;
  p.skb = (bf16_t*)(ws + off); off += (size_t)16 * 128 * 128 * 2;
  p.ut8 = (unsigned char*)(ws + off); off += (size_t)16384 * D;
  p.vt8 = (unsigned char*)(ws + off); off += (size_t)16384 * D;
  p.uinv = (float*)(ws + off); off += 262144;
  p.vinv = (float*)(ws + off); off += 65536;
  p.wbuf = (float*)(ws + off); off += (size_t)BATCH * SEQ * 128 * 4;
  p.ssq = (float*)(ws + off); off += (size_t)BATCH * SEQ * 8 * 4;
  p.hb = (bf16_t*)(ws + off); off += (size_t)ROWS * D * 2;
  p.rowss = (float*)(ws + off); off += (size_t)ROWS * 16 * 4;
  p.eb = (int*)((char*)p.r2 + (size_t)ROWS * 2048 * 2);
  p.gb = (float*)((char*)p.eb + (size_t)ROWS * 128 * 4);
  hipMemsetAsync(d_ws, 0, 32768, stream);
  void* args[] = {&p};
  hipError_t e = hipLaunchCooperativeKernel((void*)mega, dim3(grid_blocks), dim3(512), args, 0, stream);
  if (e != hipSuccess) fprintf(stderr, "cooperative launch failed: %s (grid %d)\n", hipGetErrorString(e), grid_blocks);
}
```
